# Optimizing an MI355X kernel written in HIP

```python
import jax
import jax.numpy as jnp
from jax import lax
import numpy as np

D_MODEL = 2048
BATCH = 1
SEQ = 16384
DEPTH = 4

GRID_W = 64
CTX_LEN = 256
N_MOD = 9
D_FF = 5504
DN_ALPHA = (2 * DEPTH) ** 0.25
DN_BETA = (8 * DEPTH) ** -0.25
LN_EPS = 1e-5
RMS_EPS = 1e-6
CHUNK = 64
ROPE_BASE = 10000.0

GLA_HEADS = 4
GLA_DK = 128
GLA_DV = 256
GLA_GATE_RANK = 16
GLA_GATE_NORM = 16.0
RET_HEADS = 4
RET_DK = 128
RET_DV = 256
GLA_QK = GLA_HEADS * GLA_DK
GLA_V = GLA_HEADS * GLA_DV
RET_QK = RET_HEADS * RET_DK
RET_V = RET_HEADS * RET_DV
EVEN_SPLITS = (GLA_QK, GLA_QK, GLA_V, GLA_V, GLA_GATE_RANK, GLA_GATE_RANK, RET_QK, RET_QK, RET_V, RET_V)
EVEN_IN = 2 * GLA_QK + 2 * GLA_V + 2 * GLA_GATE_RANK + 2 * RET_QK + 2 * RET_V
EVEN_MIX = GLA_V + RET_V

MLA_HEADS = 16
MLA_Q_RANK = 512
MLA_KV_RANK = 512
MLA_NOPE = 128
MLA_ROPE = 64
MLA_DV = 128
MLA_IN = MLA_Q_RANK + MLA_KV_RANK + MLA_ROPE
MLA_SCALE = (MLA_NOPE + MLA_ROPE) ** -0.5
MLA_MIX = MLA_HEADS * MLA_DV
Q_BLOCK = 128

kernel_name = 'hybrid_gla_retnet_mla_flow_trunk'


def layer_norm(x, g, b):
    xf = x.astype(jnp.float32)
    mu = jnp.mean(xf, axis=-1, keepdims=True)
    var = jnp.mean(jnp.square(xf - mu), axis=-1, keepdims=True)
    y = (xf - mu) * lax.rsqrt(var + LN_EPS)
    return (y * g + b).astype(x.dtype)


def rms_norm(x, w=None):
    xf = x.astype(jnp.float32)
    y = xf * lax.rsqrt(jnp.mean(jnp.square(xf), axis=-1, keepdims=True) + RMS_EPS)
    if w is not None:
        y = y * w
    return y.astype(x.dtype)


def modulate(x, shift, scale):
    return x * (1.0 + scale) + shift


def swiglu(h, w_in, w_out):
    gate, up = jnp.split(h @ w_in, 2, axis=-1)
    return (jax.nn.silu(gate) * up) @ w_out


def ffn_sublayer(x, shift, scale, gate, w_in, w_out, g, b):
    y = swiglu(modulate(x, shift, scale), w_in, w_out)
    return layer_norm(DN_ALPHA * x + 0.5 * gate * y, g, b)


def to_heads(a, n_heads):
    B, T, _ = a.shape
    return a.reshape(B, T, n_heads, -1).transpose(0, 2, 1, 3)


def from_heads(a):
    B, H, T, d = a.shape
    return a.transpose(0, 2, 1, 3).reshape(B, T, H * d)


def rope_tables(pos, dim):
    inv = ROPE_BASE ** (-jnp.arange(0, dim, 2, dtype=jnp.float32) / dim)
    ang = pos.astype(jnp.float32)[:, None] * inv[None, :]
    ang = jnp.concatenate([ang, ang], axis=-1)
    return jnp.cos(ang), jnp.sin(ang)


def apply_rope(x, cos, sin):
    x1, x2 = jnp.split(x, 2, axis=-1)
    rot = jnp.concatenate([-x2, x1], axis=-1)
    return x * cos.astype(x.dtype) + rot * sin.astype(x.dtype)


def axial_tables(n_tokens, dim):
    rows = n_tokens // GRID_W
    row = jnp.repeat(jnp.arange(rows), GRID_W)
    col = jnp.tile(jnp.arange(GRID_W), rows)
    return rope_tables(row, dim // 2), rope_tables(col, dim // 2)


def apply_axial(x, tables):
    (cos_r, sin_r), (cos_c, sin_c) = tables
    x_r, x_c = jnp.split(x, 2, axis=-1)
    return jnp.concatenate([apply_rope(x_r, cos_r, sin_r), apply_rope(x_c, cos_c, sin_c)], axis=-1)


def chunks(a):
    B, H, T, d = a.shape
    return jnp.moveaxis(a.reshape(B, H, T // CHUNK, CHUNK, d), 2, 0)


def unchunk(a):
    n, B, H, C, d = a.shape
    return jnp.moveaxis(a, 0, 2).reshape(B, H, n * C, d)


def gla_scan(q, k, v, log_g, s0):
    causal = jnp.tril(jnp.ones((CHUNK, CHUNK), dtype=bool))[:, :, None]

    def step(S, inp):
        qc, kc, vc, gc = (a.astype(jnp.float32) for a in inp)
        b = jnp.cumsum(gc, axis=2)
        rel = jnp.exp(jnp.where(causal, b[:, :, :, None, :] - b[:, :, None, :, :], -jnp.inf))
        A = jnp.einsum('bhid,bhjd,bhijd->bhij', qc, kc, rel)
        o = jnp.einsum('bhij,bhje->bhie', A, vc) + jnp.einsum('bhid,bhde->bhie', qc * jnp.exp(b), S)
        b_end = b[:, :, -1:, :]
        S = jnp.exp(b_end)[:, :, 0, :, None] * S + jnp.einsum('bhjd,bhje->bhde', kc * jnp.exp(b_end - b), vc)
        return S, o

    S, o = lax.scan(step, s0, (chunks(q), chunks(k), chunks(v), chunks(log_g)))
    return unchunk(o), S


def retention_scan(q, k, v, s0, log_gamma):
    idx = jnp.arange(CHUNK, dtype=jnp.float32)
    causal = jnp.tril(jnp.ones((CHUNK, CHUNK), dtype=bool))
    lg = log_gamma[:, None, None]
    dmat = jnp.exp(jnp.where(causal, lg * (idx[:, None] - idx[None, :]), -jnp.inf))
    q_dec = jnp.exp(log_gamma[:, None] * (idx + 1.0))[:, :, None]
    k_dec = jnp.exp(log_gamma[:, None] * (CHUNK - 1.0 - idx))[:, :, None]
    s_dec = jnp.exp(log_gamma * CHUNK)[:, None, None]

    def step(S, inp):
        qc, kc, vc = (a.astype(jnp.float32) for a in inp)
        A = jnp.einsum('bhid,bhjd->bhij', qc, kc) * dmat
        o = jnp.einsum('bhij,bhje->bhie', A, vc) + jnp.einsum('bhid,bhde->bhie', qc * q_dec, S)
        S = s_dec * S + jnp.einsum('bhjd,bhje->bhde', kc * k_dec, vc)
        return S, o

    S, o = lax.scan(step, s0, (chunks(q), chunks(k), chunks(v)))
    return unchunk(o), S


def flip_t(a):
    return jnp.flip(a, axis=2)


def bidir(run_f, run_b, ctx_f, lat_f, ctx_b, lat_b, s0):
    o_cf, s_f = run_f(ctx_f, s0)
    o_lf, _ = run_f(lat_f, s_f)
    o_cb, s_b = run_b(tuple(flip_t(a) for a in ctx_b), s0)
    o_lb, _ = run_b(tuple(flip_t(a) for a in lat_b), s_b)
    return o_cf + flip_t(o_cb), o_lf + flip_t(o_lb)


def even_project(h, w_in, wg_f, bg_f, wg_b, bg_b, ret_rope):
    offs = [int(o) for o in np.cumsum(EVEN_SPLITS)[:-1]]
    gq, gk, gv, gr, gdf, gdb, rq, rk, rv, rg = jnp.split(h @ w_in, offs, axis=-1)
    gla_q = to_heads(gq, GLA_HEADS) * (GLA_DK ** -0.5)
    gla_k = to_heads(gk, GLA_HEADS)
    gla_v = to_heads(gv, GLA_HEADS)
    lg_f = to_heads(jax.nn.log_sigmoid((gdf @ wg_f + bg_f).astype(jnp.float32)) / GLA_GATE_NORM, GLA_HEADS)
    lg_b = to_heads(jax.nn.log_sigmoid((gdb @ wg_b + bg_b).astype(jnp.float32)) / GLA_GATE_NORM, GLA_HEADS)
    ret_q = to_heads(rq, RET_HEADS)
    ret_k = to_heads(rk, RET_HEADS) * (RET_DK ** -0.5)
    if ret_rope is not None:
        ret_q = apply_rope(ret_q, *ret_rope)
        ret_k = apply_rope(ret_k, *ret_rope)
    ret_v = to_heads(rv, RET_HEADS)
    return gla_q, gla_k, gla_v, lg_f, lg_b, gr, ret_q, ret_k, ret_v, rg


def even_output(gla_o, gla_r, ret_o, ret_g, norm_w, w_out):
    dt = gla_r.dtype
    ga = from_heads(rms_norm(gla_o, norm_w)).astype(dt) * jax.nn.silu(gla_r)
    ra = from_heads(rms_norm(ret_o)).astype(dt) * jax.nn.silu(ret_g)
    return jnp.concatenate([ga, ra], axis=-1) @ w_out


def even_mixer(h_ctx, h_lat, ret_rope, w_in, wg_f, bg_f, wg_b, bg_b, norm_w, w_out, need_ctx):
    c_gq, c_gk, c_gv, c_lf, c_lb, c_gr, c_rq, c_rk, c_rv, c_rg = even_project(h_ctx, w_in, wg_f, bg_f, wg_b, bg_b, None)
    l_gq, l_gk, l_gv, l_lf, l_lb, l_gr, l_rq, l_rk, l_rv, l_rg = even_project(h_lat, w_in, wg_f, bg_f, wg_b, bg_b, ret_rope)
    B = h_lat.shape[0]
    gla = lambda t, s: gla_scan(*t, s)
    g_ctx, g_lat = bidir(gla, gla,
                         (c_gq, c_gk, c_gv, c_lf), (l_gq, l_gk, l_gv, l_lf),
                         (c_gq, c_gk, c_gv, c_lb), (l_gq, l_gk, l_gv, l_lb),
                         jnp.zeros((B, GLA_HEADS, GLA_DK, GLA_DV), jnp.float32))
    scales = jnp.arange(RET_HEADS, dtype=jnp.float32)
    lg_fwd = jnp.log1p(-jnp.exp2(-5.0 - scales))
    lg_bwd = jnp.log1p(-jnp.exp2(-5.5 - scales))
    ret_f = lambda t, s: retention_scan(*t, s, lg_fwd)
    ret_b = lambda t, s: retention_scan(*t, s, lg_bwd)
    r_ctx_in = (c_rq, c_rk, c_rv)
    r_lat_in = (l_rq, l_rk, l_rv)
    r_ctx, r_lat = bidir(ret_f, ret_b, r_ctx_in, r_lat_in, r_ctx_in, r_lat_in,
                         jnp.zeros((B, RET_HEADS, RET_DK, RET_DV), jnp.float32))
    y_lat = even_output(g_lat, l_gr, r_lat, l_rg, norm_w, w_out)
    y_ctx = even_output(g_ctx, c_gr, r_ctx, c_rg, norm_w, w_out) if need_ctx else None
    return y_ctx, y_lat


def mla_project(h, w_in, q_norm_w, kv_norm_w, w_uq, w_ukv, axial):
    cq, ckv, k_rope = jnp.split(h @ w_in, [MLA_Q_RANK, MLA_Q_RANK + MLA_KV_RANK], axis=-1)
    q = to_heads(rms_norm(cq, q_norm_w) @ w_uq, MLA_HEADS)
    q_nope, q_rope = q[..., :MLA_NOPE], q[..., MLA_NOPE:]
    kv = to_heads(rms_norm(ckv, kv_norm_w) @ w_ukv, MLA_HEADS)
    k_nope, v = kv[..., :MLA_NOPE], kv[..., MLA_NOPE:]
    if axial is not None:
        q_rope = apply_axial(q_rope, axial)
        k_rope = apply_axial(k_rope, axial)
    return q_nope, q_rope, k_nope, k_rope, v


def mla_attend(qn, qr, kn, kr, v):
    s = jnp.einsum('bhqd,bhkd->bhqk', qn, kn) + jnp.einsum('bhqr,bkr->bhqk', qr, kr)
    p = jax.nn.softmax(s.astype(jnp.float32) * MLA_SCALE, axis=-1).astype(v.dtype)
    return jnp.einsum('bhqk,bhkd->bhqd', p, v)


def mla_blocked(qn, qr, kn, kr, v):
    B, H, T, _ = qn.shape
    nb = T // Q_BLOCK
    blk = lambda a: jnp.moveaxis(a.reshape(B, H, nb, Q_BLOCK, a.shape[-1]), 2, 0)
    o = lax.map(lambda qs: mla_attend(qs[0], qs[1], kn, kr, v), (blk(qn), blk(qr)))
    return jnp.moveaxis(o, 0, 2).reshape(B, H, T, MLA_DV)


def odd_mixer(h_ctx, h_lat, axial, w_in, q_norm_w, kv_norm_w, w_uq, w_ukv, w_out, need_ctx):
    qn_c, qr_c, kn_c, kr_c, v_c = mla_project(h_ctx, w_in, q_norm_w, kv_norm_w, w_uq, w_ukv, None)
    qn_l, qr_l, kn_l, kr_l, v_l = mla_project(h_lat, w_in, q_norm_w, kv_norm_w, w_uq, w_ukv, axial)
    kn = jnp.concatenate([kn_c, kn_l], axis=2)
    kr = jnp.concatenate([kr_c, kr_l], axis=1)
    v = jnp.concatenate([v_c, v_l], axis=2)
    y_lat = from_heads(mla_blocked(qn_l, qr_l, kn, kr, v)) @ w_out
    y_ctx = from_heads(mla_attend(qn_c, qr_c, kn_c, kr_c, v_c)) @ w_out if need_ctx else None
    return y_ctx, y_lat


def setup_inputs(seed: int = 0) -> dict:
    key = jax.random.key(seed)
    k = jax.random.split(key, 23)
    d = D_MODEL
    n_even = (DEPTH + 1) // 2
    n_odd = DEPTH // 2

    def nrm(i, shape, scale):
        return jax.random.normal(k[i], shape, jnp.float32) * scale

    return {
        'x': nrm(0, (BATCH, SEQ, d), 1.0),
        'c': nrm(1, (BATCH, d), 1.0),
        'ctx': nrm(2, (BATCH, CTX_LEN, d), 1.0),
        'c_ctx': nrm(3, (d,), 1.0),
        'w_ada': nrm(4, (DEPTH, d, N_MOD * d), d ** -0.5),
        'b_ada': nrm(5, (DEPTH, N_MOD * d), 0.02),
        'ln_g': 1.0 + nrm(6, (DEPTH, 3, d), 0.02),
        'ln_b': nrm(7, (DEPTH, 3, d), 0.02),
        'w_ffn_in': nrm(8, (DEPTH, 2, d, 2 * D_FF), d ** -0.5),
        'w_ffn_out': nrm(9, (DEPTH, 2, D_FF, d), D_FF ** -0.5 * DN_BETA),
        'ev_w_in': nrm(10, (n_even, d, EVEN_IN), d ** -0.5),
        'ev_gla_wg_f': nrm(11, (n_even, GLA_GATE_RANK, GLA_QK), GLA_GATE_RANK ** -0.5),
        'ev_gla_bg_f': nrm(12, (n_even, GLA_QK), 0.02),
        'ev_gla_wg_b': nrm(13, (n_even, GLA_GATE_RANK, GLA_QK), GLA_GATE_RANK ** -0.5),
        'ev_gla_bg_b': nrm(14, (n_even, GLA_QK), 0.02),
        'ev_gla_norm': 1.0 + nrm(15, (n_even, GLA_DV), 0.02),
        'ev_w_out': nrm(16, (n_even, EVEN_MIX, d), EVEN_MIX ** -0.5 * DN_BETA),
        'od_w_in': nrm(17, (n_odd, d, MLA_IN), d ** -0.5),
        'od_q_norm': 1.0 + nrm(18, (n_odd, MLA_Q_RANK), 0.02),
        'od_kv_norm': 1.0 + nrm(19, (n_odd, MLA_KV_RANK), 0.02),
        'od_w_uq': nrm(20, (n_odd, MLA_Q_RANK, MLA_HEADS * (MLA_NOPE + MLA_ROPE)), MLA_Q_RANK ** -0.5),
        'od_w_ukv': nrm(21, (n_odd, MLA_KV_RANK, MLA_HEADS * (MLA_NOPE + MLA_DV)), MLA_KV_RANK ** -0.5),
        'od_w_out': nrm(22, (n_odd, MLA_MIX, d), MLA_MIX ** -0.5 * DN_BETA),
    }


def reference(x, c, ctx, c_ctx, w_ada, b_ada, ln_g, ln_b, w_ffn_in, w_ffn_out,
              ev_w_in, ev_gla_wg_f, ev_gla_bg_f, ev_gla_wg_b, ev_gla_bg_b, ev_gla_norm, ev_w_out,
              od_w_in, od_q_norm, od_kv_norm, od_w_uq, od_w_ukv, od_w_out):
    n_lat = x.shape[1]
    axial = axial_tables(n_lat, MLA_ROPE)
    ret_rope = rope_tables(jnp.arange(n_lat), RET_DK)
    s_c = jax.nn.silu(c)
    s_cc = jax.nn.silu(c_ctx)
    x_lat, x_ctx = x, ctx
    for l in range(DEPTH):
        need_ctx = l < DEPTH - 1
        m_lat = jnp.split((s_c @ w_ada[l] + b_ada[l])[:, None, :], N_MOD, axis=-1)
        m_ctx = jnp.split((s_cc @ w_ada[l] + b_ada[l])[None, None, :], N_MOD, axis=-1)
        x_ctx = ffn_sublayer(x_ctx, *m_ctx[0:3], w_ffn_in[l, 0], w_ffn_out[l, 0], ln_g[l, 0], ln_b[l, 0])
        x_lat = ffn_sublayer(x_lat, *m_lat[0:3], w_ffn_in[l, 0], w_ffn_out[l, 0], ln_g[l, 0], ln_b[l, 0])
        h_ctx = modulate(x_ctx, m_ctx[3], m_ctx[4])
        h_lat = modulate(x_lat, m_lat[3], m_lat[4])
        if l % 2 == 0:
            e = l // 2
            y_ctx, y_lat = even_mixer(h_ctx, h_lat, ret_rope, ev_w_in[e], ev_gla_wg_f[e], ev_gla_bg_f[e],
                                      ev_gla_wg_b[e], ev_gla_bg_b[e], ev_gla_norm[e], ev_w_out[e], need_ctx)
        else:
            o = l // 2
            y_ctx, y_lat = odd_mixer(h_ctx, h_lat, axial, od_w_in[o], od_q_norm[o], od_kv_norm[o],
                                     od_w_uq[o], od_w_ukv[o], od_w_out[o], need_ctx)
        x_lat = layer_norm(DN_ALPHA * x_lat + m_lat[5] * y_lat, ln_g[l, 1], ln_b[l, 1])
        x_lat = ffn_sublayer(x_lat, *m_lat[6:9], w_ffn_in[l, 1], w_ffn_out[l, 1], ln_g[l, 2], ln_b[l, 2])
        if need_ctx:
            x_ctx = layer_norm(DN_ALPHA * x_ctx + m_ctx[5] * y_ctx, ln_g[l, 1], ln_b[l, 1])
            x_ctx = ffn_sublayer(x_ctx, *m_ctx[6:9], w_ffn_in[l, 1], w_ffn_out[l, 1], ln_g[l, 2], ln_b[l, 2])
    return x_lat
```

```cpp
#include <hip/hip_runtime.h>
#include <cstdio>
#include <cstdint>

#define GAS __attribute__((address_space(1)))
#define LAS __attribute__((address_space(3)))
typedef unsigned short bf16;
typedef short bf16x8 __attribute__((ext_vector_type(8)));
typedef short s16x4 __attribute__((ext_vector_type(4)));
typedef float f32x4 __attribute__((ext_vector_type(4)));
typedef float f32x2 __attribute__((ext_vector_type(2)));
typedef float f32x16 __attribute__((ext_vector_type(16)));
typedef unsigned u32x4 __attribute__((ext_vector_type(4)));
typedef unsigned u32x2 __attribute__((ext_vector_type(2)));

constexpr int DM = 2048, NCTX = 256, NLAT = 16384, T = NCTX + NLAT, DEPTH = 4, DFF = 5504;
constexpr int NADA = 9 * DM;
constexpr int EV_N = 6400, OD_N = 1280;
constexpr int NCH = T / 64;
constexpr float DN_ALPHA = 1.6817928305074290f;
constexpr float LN_EPS = 1e-5f, RMS_EPS = 1e-6f;
constexpr int NWAVES = 8, NTHR = 512;
constexpr int LDS_BYTES = 147456;
constexpr int LDS_CTL = LDS_BYTES - 256;

constexpr size_t al256(size_t x) { return (x + 255) / 256 * 256; }
constexpr size_t WS_CTL = 0, CTL_BYTES = 1u << 20;
constexpr size_t WS_MODP = WS_CTL + CTL_BYTES;
constexpr size_t WS_MOD = WS_MODP + al256((size_t)8 * 2 * 4 * NADA * 4);
constexpr size_t WS_RT = WS_MOD + al256((size_t)4 * 2 * NADA * 4);
constexpr size_t WS_AXR = WS_RT + al256((size_t)NLAT * 64 * 8);
constexpr size_t WS_AXC = WS_AXR + al256(256 * 16 * 8);
constexpr size_t WS_WFI = WS_AXC + al256(64 * 16 * 8);
constexpr size_t SZ_WFI = (size_t)2 * DFF * DM * 2;
constexpr size_t WS_WFO = WS_WFI + 8 * SZ_WFI;
constexpr size_t SZ_WFO = (size_t)DM * DFF * 2;
constexpr size_t WS_EWI = WS_WFO + 8 * SZ_WFO;
constexpr size_t SZ_EWI = (size_t)EV_N * DM * 2;
constexpr size_t WS_EWO = WS_EWI + 2 * SZ_EWI;
constexpr size_t SZ_SQ = (size_t)DM * DM * 2;
constexpr size_t WS_OWI = WS_EWO + 2 * SZ_SQ;
constexpr size_t SZ_OWI = (size_t)OD_N * DM * 2;
constexpr size_t WS_OUQ = WS_OWI + 2 * SZ_OWI;
constexpr size_t SZ_OUQ = (size_t)3072 * 512 * 2;
constexpr size_t WS_OUKV = WS_OUQ + 2 * SZ_OUQ;
constexpr size_t SZ_OUKV = (size_t)4096 * 512 * 2;
constexpr size_t WS_OWO = WS_OUKV + 2 * SZ_OUKV;
constexpr size_t WS_X = WS_OWO + 2 * SZ_SQ;
constexpr size_t WS_H = WS_X + (size_t)T * DM * 4;
constexpr size_t WS_HID = WS_H + (size_t)T * DM * 2;
constexpr size_t WS_MIX = WS_HID + (size_t)T * DFF * 2;
constexpr size_t WS_PROJ = WS_MIX + (size_t)T * DM * 2;
constexpr size_t WS_U = WS_PROJ + (size_t)T * EV_N * 2;
constexpr size_t SZ_U = (size_t)2 * 8 * NCH * 256 * 128 * 2;
constexpr size_t WS_S = WS_U + SZ_U;
constexpr size_t WS_OI = WS_S + SZ_U;
constexpr size_t WS_QT = WS_OI + (size_t)T * DM * 4;
constexpr size_t WS_DEC = WS_QT + (size_t)2 * T * 1024 * 2;
constexpr size_t WS_END_EVEN = WS_DEC + al256((size_t)2 * 8 * NCH * 128 * 4);
constexpr size_t WS_CQN = WS_U;
constexpr size_t WS_CKVN = WS_CQN + (size_t)T * 512 * 2;
constexpr size_t WS_KR = WS_CKVN + (size_t)T * 512 * 2;
constexpr size_t WS_QB = WS_KR + al256((size_t)T * 64 * 2);
constexpr size_t WS_KVB = WS_QB + (size_t)T * 3072 * 2;
constexpr size_t WS_END_ODD = WS_KVB + (size_t)T * 4096 * 2;
constexpr size_t WS_END = WS_END_EVEN > WS_END_ODD ? WS_END_EVEN : WS_END_ODD;

#define RLX_AGENT __ATOMIC_RELAXED, __HIP_MEMORY_SCOPE_AGENT
#define LDS_WAIT() asm volatile("s_waitcnt lgkmcnt(0)" ::: "memory")
#define VM_WAIT() asm volatile("s_waitcnt vmcnt(0)" ::: "memory")
__device__ __forceinline__ unsigned cvt_pk_bf16(float lo, float hi) { unsigned r; asm volatile("v_cvt_pk_bf16_f32 %0, %1, %2" : "=v"(r) : "v"(lo), "v"(hi)); return r; }
__device__ __forceinline__ float bflo(unsigned w) { return __uint_as_float(w << 16); }
__device__ __forceinline__ float bfhi(unsigned w) { return __uint_as_float(w & 0xffff0000u); }
__device__ __forceinline__ float bf2f(bf16 b) { return __uint_as_float(((unsigned)b) << 16); }
__device__ __forceinline__ bf16 f2bf(float f) { return (bf16)(cvt_pk_bf16(f, 0.f) & 0xffffu); }
__device__ __forceinline__ float wave_sum(float v) {
#pragma unroll
    for (int o = 1; o < 64; o <<= 1) v += __shfl_xor(v, o);
    return v;
}
__device__ __forceinline__ float silu_f(float g) { return g * __builtin_amdgcn_rcpf(1.0f + __builtin_amdgcn_exp2f(-1.4426950408889634f * g)); }

namespace pg8 {
#define PG8_LAS __attribute__((address_space(3)))
typedef unsigned short bf16_t;
constexpr int BM = 256, BK = 64, HALF = 128, HTB = HALF * BK * 2, STAGE_BYTES = 8 * HTB, NXCD = 8, WGM = 8;
__host__ __device__ __forceinline__ int lds_byte(int r, int c) { const int st = (r >> 4) * 2 + (c >> 5), rr = r & 15, cc = c & 31, ob = rr * 64 + cc * 2; return st * 1024 + (ob ^ (((ob >> 9) & 1) << 5)); }
__host__ __device__ __forceinline__ void stage_rc(int b, int& R, int& C) { const int st = b / 1024, sb = b % 1024, swz = sb ^ (((sb >> 9) & 1) << 5); R = (st >> 1) * 16 + swz / 64; C = (st & 1) * 32 + (swz % 64) / 2; }
__host__ __device__ __forceinline__ int perm32(int rho) { const int n = rho >> 4, i = rho & 15; return 8 * (i >> 2) + 4 * n + (i & 3); }
struct Unit { int pm, pn; };
struct Gemm { const bf16_t* A; const bf16_t* Bt; int M, N, K, lda, ldb; };
struct StaticOrder {
    int nM, nN, nwg, G, c;
    __host__ __device__ void init(int M, int N, int G_, int c_) { nM = M / BM; nN = N / BM; nwg = nM * nN; G = G_; c = c_; }
    __host__ __device__ bool next(int i, Unit& u) const {
        const long L = (long)i * G + c; if (L >= nwg) return false;
        int wgid = (int)L; { const int q = nwg / NXCD, r = nwg % NXCD, xcd = wgid % NXCD, off = wgid / NXCD; wgid = (xcd < r ? xcd * (q + 1) : r * (q + 1) + (xcd - r) * q) + off; }
        const int nig = WGM * nN, gid = wgid / nig, fm = gid * WGM, gsz = (nM - fm) < WGM ? (nM - fm) : WGM;
        u.pm = fm + ((wgid % nig) % gsz); u.pn = (wgid % nig) / gsz; return true;
    }
    __device__ __forceinline__ void a_ready(const Unit&) const {}
    __device__ __forceinline__ void done(const Unit&) const {}
};
struct EpiBf16 {
    static constexpr bool PERM = true;
    bf16_t* O; int ldc;
    __device__ __forceinline__ void operator()(const f32x4 (&acc)[2][2][4][2], const Unit& u, int wr, int wc, int fr, int fq) const {
        const int row0 = u.pm * BM + wr * 64 + fr, col0 = u.pn * BM + wc * 32 + 8 * fq;
        asm volatile("s_nop 15" ::: "memory");
#pragma unroll
        for (int ai = 0; ai < 2; ++ai)
#pragma unroll
            for (int m = 0; m < 4; ++m) { bf16_t* rowp = O + (size_t)(row0 + ai * HALF + m * 16) * ldc + col0;
#pragma unroll
                for (int bj = 0; bj < 2; ++bj) { const f32x4 v0 = acc[ai][bj][m][0], v1 = acc[ai][bj][m][1];
                    u32x4 w; w.x = cvt_pk_bf16(v0[0], v0[1]); w.y = cvt_pk_bf16(v0[2], v0[3]); w.z = cvt_pk_bf16(v1[0], v1[1]); w.w = cvt_pk_bf16(v1[2], v1[3]);
                    *(u32x4*)(rowp + bj * HALF) = w; } }
    }
};
struct EpiSwiGLU {
    static constexpr bool PERM = true;
    bf16_t* O; int ldc;
    __device__ __forceinline__ void operator()(const f32x4 (&acc)[2][2][4][2], const Unit& u, int wr, int wc, int fr, int fq) const {
        const int row0 = u.pm * BM + wr * 64 + fr, col0 = u.pn * HALF + wc * 32 + 8 * fq;
#pragma unroll
        for (int ai = 0; ai < 2; ++ai)
#pragma unroll
            for (int m = 0; m < 4; ++m) { bf16_t* rowp = O + (size_t)(row0 + ai * HALF + m * 16) * ldc + col0;
                float h[8];
#pragma unroll
                for (int n = 0; n < 2; ++n)
#pragma unroll
                    for (int j = 0; j < 4; ++j) h[n * 4 + j] = silu_f(acc[ai][0][m][n][j]) * acc[ai][1][m][n][j];
                u32x4 w; w.x = cvt_pk_bf16(h[0], h[1]); w.y = cvt_pk_bf16(h[2], h[3]); w.z = cvt_pk_bf16(h[4], h[5]); w.w = cvt_pk_bf16(h[6], h[7]);
                *(u32x4*)rowp = w; asm volatile("" ::: "memory"); }
    }
};
struct EpiResid {
    static constexpr bool PERM = false;
    float* X; const float* gv_lat; const float* gv_ctx; float gs;
    __device__ __forceinline__ void operator()(const f32x4 (&acc)[2][2][4][2], const Unit& u, int wr, int wc, int fr, int fq) const {
        const int row0 = u.pm * BM + wr * 64 + fr, col0 = u.pn * BM + wc * 32 + 4 * fq;
        const float* gv = (u.pm == 0) ? gv_ctx : gv_lat;
        f32x4 g[2][2];
#pragma unroll
        for (int bj = 0; bj < 2; ++bj)
#pragma unroll
            for (int n = 0; n < 2; ++n) g[bj][n] = *(const f32x4*)(gv + col0 + bj * HALF + n * 16) * gs;
#pragma unroll
        for (int ai = 0; ai < 2; ++ai)
#pragma unroll
            for (int m = 0; m < 4; ++m) { float* rowp = X + (size_t)(row0 + ai * HALF + m * 16) * DM + col0;
#pragma unroll
                for (int bj = 0; bj < 2; ++bj)
#pragma unroll
                    for (int n = 0; n < 2; ++n) { const f32x4 x = *(const f32x4*)(rowp + bj * HALF + n * 16); *(f32x4*)(rowp + bj * HALF + n * 16) = x * DN_ALPHA + g[bj][n] * acc[ai][bj][m][n]; }
                if (m & 1) asm volatile("" ::: "memory"); }
    }
};

template <class Epi, class Sched, bool ALIGN_EPI = true, bool SP2 = true>
__device__ __forceinline__ void gemm_phase(PG8_LAS unsigned char* lds, const Gemm g, const Sched& S, const Epi& E) {
    int tid = threadIdx.x; asm volatile("" : "+v"(tid));
    const int wid = __builtin_amdgcn_readfirstlane(tid >> 6), lane = tid & 63, wr = wid >> 2, wc = wid & 3, fr = lane & 15, fq = lane >> 4;
    const int K = g.K, nt = K / BK;
    unsigned voffA[2], voffB[2];
#pragma unroll
    for (int i = 0; i < 2; ++i) { int R, C; stage_rc(tid * 16 + i * 8192, R, C); const int Rb = Epi::PERM ? ((R & ~31) + perm32(R & 31)) : R;
        voffA[i] = (unsigned)(R * g.lda + C) * 2u; voffB[i] = (unsigned)(Rb * g.ldb + C) * 2u; }
    const size_t kstep = (size_t)(BK * 2);
    const size_t hstepA = (size_t)HALF * g.lda * 2, hstepB = (size_t)HALF * g.ldb * 2;
    const size_t tstepA = 2 * hstepA, tstepB = 2 * hstepB;
    const unsigned ldsw = (unsigned)wid * 1024u;
    const int aoff = lds_byte(wr * 64 + fr, fq * 8), boff = lds_byte(wc * 32 + fr, fq * 8);
#define PG8_SA(b, h) (((b) * 2 + (h)) * HTB)
#define PG8_SB(b, h) ((4 + (b) * 2 + (h)) * HTB)
#define PG8_STAGE(bufoff, gbase, voff) do { _Pragma("unroll") for (int _i = 0; _i < 2; ++_i) \
        __builtin_amdgcn_global_load_lds((const unsigned*)((const char*)(gbase) + (voff)[_i]), (PG8_LAS unsigned*)(lds + (bufoff) + ldsw + _i * 8192), 16, 0, 0); } while (0)
#define PG8_LDA(dst, b, h) do { _Pragma("unroll") for (int m = 0; m < 4; ++m) _Pragma("unroll") for (int k = 0; k < 2; ++k) dst[m][k] = *(const PG8_LAS bf16x8*)(lds + PG8_SA(b, h) + aoff + m * 2048 + k * 1024); } while (0)
#define PG8_LDB(dst, b, h) do { _Pragma("unroll") for (int n = 0; n < 2; ++n) _Pragma("unroll") for (int k = 0; k < 2; ++k) dst[n][k] = *(const PG8_LAS bf16x8*)(lds + PG8_SB(b, h) + boff + n * 2048 + k * 1024); } while (0)
#define PG8_MMA(ai, bj, At, Bt) do { __builtin_amdgcn_s_setprio(1); _Pragma("unroll") for (int m = 0; m < 4; ++m) _Pragma("unroll") for (int n = 0; n < 2; ++n) _Pragma("unroll") for (int k = 0; k < 2; ++k) \
        acc[ai][bj][m][n] = __builtin_amdgcn_mfma_f32_16x16x32_bf16(Bt[n][k], At[m][k], acc[ai][bj][m][n], 0, 0, 0); __builtin_amdgcn_s_setprio(0); } while (0)
#define PG8_WAIT_V(n) asm volatile("s_waitcnt vmcnt(" #n ")" ::: "memory")
#define PG8_WAIT_L(n) asm volatile("s_waitcnt lgkmcnt(" #n ")" ::: "memory")
#define PG8_BAR __builtin_amdgcn_s_barrier()
#define PG8_SCHED __builtin_amdgcn_sched_barrier(0)
    Unit cur, nxt; int ui = 0;
    if (!S.next(0, cur)) return;
    f32x4 acc[2][2][4][2];
#pragma unroll
    for (int a = 0; a < 2; ++a)
#pragma unroll
        for (int b = 0; b < 2; ++b)
#pragma unroll
            for (int m = 0; m < 4; ++m)
#pragma unroll
                for (int n = 0; n < 2; ++n) acc[a][b][m][n] = (f32x4){0.f, 0.f, 0.f, 0.f};
    bf16x8 At[4][2], B0[2][2], B1[2][2];
    const char* cA = (const char*)g.A + (size_t)cur.pm * tstepA; const char* cB = (const char*)g.Bt + (size_t)cur.pn * tstepB;
    S.a_ready(cur);
    if constexpr (SP2) {
        PG8_STAGE(PG8_SB(0, 0), cB, voffB); PG8_STAGE(PG8_SB(0, 1), cB + hstepB, voffB); PG8_STAGE(PG8_SA(0, 0), cA, voffA); PG8_STAGE(PG8_SA(0, 1), cA + hstepA, voffA);
        if (wr == 1) PG8_BAR;
        PG8_WAIT_V(2); PG8_BAR;
        PG8_STAGE(PG8_SB(1, 0), cB + kstep, voffB); PG8_STAGE(PG8_SA(1, 0), cA + kstep, voffA); PG8_STAGE(PG8_SB(1, 1), cB + hstepB + kstep, voffB);
        PG8_WAIT_V(6); PG8_BAR;
    } else {
        PG8_STAGE(PG8_SB(0, 0), cB, voffB); PG8_STAGE(PG8_SA(0, 0), cA, voffA); PG8_STAGE(PG8_SB(0, 1), cB + hstepB, voffB); PG8_STAGE(PG8_SA(0, 1), cA + hstepA, voffA);
        if (wr == 1) PG8_BAR;
        PG8_WAIT_V(4); PG8_BAR;
        PG8_STAGE(PG8_SB(1, 0), cB + kstep, voffB); PG8_STAGE(PG8_SA(1, 0), cA + kstep, voffA); PG8_STAGE(PG8_SB(1, 1), cB + hstepB + kstep, voffB);
        PG8_WAIT_V(6); PG8_BAR;
    }
    for (;;) {
        const bool has_next = S.next(ui + 1, nxt);
        const char* nA = has_next ? (const char*)g.A + (size_t)nxt.pm * tstepA : cA; const char* nB = has_next ? (const char*)g.Bt + (size_t)nxt.pn * tstepB : cB;
        for (int t = 0; t < nt; t += 2) {
            const bool last = (t == nt - 2);
            const char* a1 = cA + (size_t)(t + 1) * kstep;
            const char* a2 = last ? nA : cA + (size_t)(t + 2) * kstep; const char* b2 = last ? nB : cB + (size_t)(t + 2) * kstep;
            const char* a3 = a2 + kstep; const char* b3 = b2 + kstep;
            if (last && has_next) S.a_ready(nxt);
            if constexpr (SP2) {
            PG8_LDB(B0, 0, 0); PG8_LDB(B1, 0, 1); PG8_SCHED; PG8_LDA(At, 0, 0); PG8_STAGE(PG8_SA(1, 1), a1 + hstepA, voffA);
            PG8_WAIT_V(8); PG8_WAIT_L(0); PG8_BAR; PG8_MMA(0, 0, At, B0); PG8_MMA(0, 1, At, B1); PG8_BAR; PG8_SCHED;
            PG8_LDA(At, 0, 1); PG8_STAGE(PG8_SB(0, 0), b2, voffB); PG8_STAGE(PG8_SB(0, 1), b2 + hstepB, voffB); PG8_STAGE(PG8_SA(0, 0), a2, voffA);
            PG8_WAIT_V(8); PG8_WAIT_L(0); PG8_BAR; PG8_MMA(1, 0, At, B0); PG8_MMA(1, 1, At, B1); PG8_BAR; PG8_SCHED;
            PG8_LDB(B0, 1, 0); PG8_LDB(B1, 1, 1); PG8_SCHED; PG8_LDA(At, 1, 0); PG8_STAGE(PG8_SA(0, 1), a2 + hstepA, voffA);
            PG8_WAIT_V(8); PG8_WAIT_L(0); PG8_BAR; PG8_MMA(0, 0, At, B0); PG8_MMA(0, 1, At, B1); PG8_BAR; PG8_SCHED;
            PG8_LDA(At, 1, 1); PG8_STAGE(PG8_SB(1, 0), b3, voffB); PG8_STAGE(PG8_SB(1, 1), b3 + hstepB, voffB); PG8_STAGE(PG8_SA(1, 0), a3, voffA);
            PG8_WAIT_V(8); PG8_WAIT_L(0); PG8_BAR; PG8_MMA(1, 0, At, B0); PG8_MMA(1, 1, At, B1); PG8_BAR; PG8_SCHED;
            } else {
            PG8_LDB(B0, 0, 0); PG8_SCHED; PG8_LDA(At, 0, 0); PG8_STAGE(PG8_SA(1, 1), a1 + hstepA, voffA);
            PG8_WAIT_L(8); PG8_BAR; PG8_WAIT_L(0); PG8_MMA(0, 0, At, B0); PG8_BAR; PG8_SCHED;
            PG8_LDB(B1, 0, 1); PG8_STAGE(PG8_SB(0, 0), b2, voffB);
            PG8_BAR; PG8_WAIT_L(0); PG8_MMA(0, 1, At, B1); PG8_BAR;
            PG8_LDA(At, 0, 1); PG8_STAGE(PG8_SA(0, 0), a2, voffA);
            PG8_BAR; PG8_WAIT_L(0); PG8_MMA(1, 0, At, B0); PG8_BAR; PG8_SCHED;
            PG8_STAGE(PG8_SB(0, 1), b2 + hstepB, voffB);
            PG8_WAIT_V(6); PG8_BAR; PG8_MMA(1, 1, At, B1); PG8_BAR;
            PG8_LDB(B0, 1, 0); PG8_SCHED; PG8_LDA(At, 1, 0); PG8_STAGE(PG8_SA(0, 1), a2 + hstepA, voffA);
            PG8_WAIT_L(8); PG8_BAR; PG8_WAIT_L(0); PG8_MMA(0, 0, At, B0); PG8_BAR; PG8_SCHED;
            PG8_LDB(B1, 1, 1); PG8_STAGE(PG8_SB(1, 0), b3, voffB);
            PG8_BAR; PG8_WAIT_L(0); PG8_MMA(0, 1, At, B1); PG8_BAR;
            PG8_LDA(At, 1, 1); PG8_STAGE(PG8_SA(1, 0), a3, voffA);
            PG8_BAR; PG8_WAIT_L(0); PG8_MMA(1, 0, At, B0); PG8_BAR; PG8_SCHED;
            PG8_STAGE(PG8_SB(1, 1), b3 + hstepB, voffB);
            PG8_WAIT_V(6); PG8_BAR; PG8_MMA(1, 1, At, B1); PG8_BAR;
            }
        }
        if constexpr (ALIGN_EPI) { if (wr == 0) PG8_BAR; }
        E(acc, cur, wr, wc, fr, fq); S.done(cur);
        if (!has_next) break;
#pragma unroll
        for (int a = 0; a < 2; ++a)
#pragma unroll
            for (int b = 0; b < 2; ++b)
#pragma unroll
                for (int m = 0; m < 4; ++m)
#pragma unroll
                    for (int n = 0; n < 2; ++n) acc[a][b][m][n] = (f32x4){0.f, 0.f, 0.f, 0.f};
        cur = nxt; cA = nA; cB = nB; ++ui;
        if constexpr (ALIGN_EPI) { if (wr == 1) PG8_BAR; }
    }
    PG8_WAIT_V(0);
    if constexpr (!ALIGN_EPI) { if (wr == 0) PG8_BAR; }
    PG8_BAR;
#undef PG8_SA
#undef PG8_SB
#undef PG8_STAGE
#undef PG8_LDA
#undef PG8_LDB
#undef PG8_MMA
#undef PG8_WAIT_V
#undef PG8_WAIT_L
#undef PG8_BAR
#undef PG8_SCHED
}
}

#define XB_TMO      128
#define XB_XCNT(j)  (256  + 64 * (j))
#define XB_XSUB(j)  (1280 + 64 * (j))
#define XB_XGEN(j)  (2304 + 64 * (j))
#define XB_TOP      3328
#define XB_TOPGEN   3392
#define XCD_BAR_WORDS 3456
#define XB_SPIN_CAP (1u << 18)
__device__ __forceinline__ unsigned xb_ld(unsigned* p)              { return __hip_atomic_load(p, __ATOMIC_RELAXED, __HIP_MEMORY_SCOPE_AGENT); }
__device__ __forceinline__ unsigned xb_add(unsigned* p, unsigned v) { return __hip_atomic_fetch_add(p, v, __ATOMIC_RELAXED, __HIP_MEMORY_SCOPE_AGENT); }
__device__ __forceinline__ unsigned xb_xcc_id() { return (unsigned)__builtin_amdgcn_s_getreg((3 << 11) | 20) & 0xFu; }
#define XB_SPIN(cond, bar) do { unsigned _sp = 0; while (cond) { __builtin_amdgcn_s_sleep(1); \
    if ((++_sp & 255u) == 0u) { if (xb_ld(&(bar)[XB_TMO])) break; if (_sp > XB_SPIN_CAP) { atomicAdd(&(bar)[XB_TMO], 1u); break; } } } } while (0)
struct XcdBarrier { unsigned* bar; unsigned x; volatile LAS unsigned* st; };
__device__ __forceinline__ XcdBarrier xcd_barrier_post(unsigned* bar, volatile LAS unsigned* st) {
    XcdBarrier b; b.bar = bar; b.x = xb_xcc_id(); b.st = st;
    if (threadIdx.x == 0) (void)xb_add(&bar[XB_XCNT(b.x)], 1u);
    return b;
}
__device__ __forceinline__ void xcd_barrier_complete(unsigned* bar, unsigned x, unsigned& nloc, unsigned& nx) {
    const unsigned G = gridDim.x * gridDim.y * gridDim.z;
    unsigned sum, cnt, mine, sp = 0u;
    for (;;) {
        sum = 0u; cnt = 0u; mine = 0u;
#pragma unroll
        for (unsigned j = 0; j < 16; ++j) { const unsigned c = xb_ld(&bar[XB_XCNT(j)]); sum += c; cnt += (c > 0u) ? 1u : 0u; mine = (j == x) ? c : mine; }
        if (sum == G) break;
        __builtin_amdgcn_s_sleep(1);
        if ((++sp & 255u) == 0u) { if (xb_ld(&bar[XB_TMO])) break; if (sp > XB_SPIN_CAP) { atomicAdd(&bar[XB_TMO], 1u); break; } }
    }
    nloc = mine > 0u ? mine : 1u; nx = cnt > 0u ? cnt : 1u;
}
__device__ __forceinline__ void xcd_barrier(const XcdBarrier& b) {
    asm volatile("s_waitcnt vmcnt(0)" ::: "memory");
    __syncthreads();
    if (threadIdx.x == 0) {
        unsigned* bar = b.bar;
        __builtin_amdgcn_s_waitcnt(0);
        unsigned nloc = b.st[0], nx = b.st[1];
        if (nloc == 0u) { xcd_barrier_complete(bar, b.x, nloc, nx); b.st[0] = nloc; b.st[1] = nx; }
        const unsigned old = xb_add(&bar[XB_XSUB(b.x)], 1u);
        const unsigned gen = old / nloc;
        if (old + 1u == (gen + 1u) * nloc) {
            __builtin_amdgcn_fence(__ATOMIC_RELEASE, "agent");
            asm volatile("s_waitcnt vmcnt(0)" ::: "memory");
            const unsigned og = xb_add(&bar[XB_TOP], 1u);
            const unsigned tg = og / nx;
            if (og + 1u == (tg + 1u) * nx) xb_add(&bar[XB_TOPGEN], 1u);
            else XB_SPIN(xb_ld(&bar[XB_TOPGEN]) == tg, bar);
            __builtin_amdgcn_fence(__ATOMIC_ACQUIRE, "agent");
            xb_add(&bar[XB_XGEN(b.x)], 1u);
            asm volatile("s_waitcnt vmcnt(0)" ::: "memory");
        } else {
            XB_SPIN(xb_ld(&bar[XB_XGEN(b.x)]) == gen, bar);
            __builtin_amdgcn_fence(__ATOMIC_ACQUIRE, "agent");
            asm volatile("s_waitcnt vmcnt(0)" ::: "memory");
        }
    }
    __syncthreads();
}

struct Args { const float* in[23]; float* out; unsigned char* ws; };
struct Frame {
    LAS unsigned char* lds;
    int vcu, G;
    const Args* a; unsigned char* ws;
};
#define PHASE_IDS() int tid = threadIdx.x; asm volatile("" : "+v"(tid)); const int lane = tid & 63, wave = __builtin_amdgcn_readfirstlane(tid >> 6); (void)lane; (void)wave
#define MFMA16(a, b, c) __builtin_amdgcn_mfma_f32_16x16x32_bf16((a), (b), (c), 0, 0, 0)
#define MFMA32(a, b, c) __builtin_amdgcn_mfma_f32_32x32x16_bf16((a), (b), (c), 0, 0, 0)

__device__ __forceinline__ void tr_item(const float* W, int N, int K, bf16* WT, int k0, int n0, int drow0, LAS float* scr, int lane) {
#pragma unroll 8
    for (int i = 0; i < 32; ++i) { const int kk = 2 * i + (lane >> 5); scr[kk * 33 + (lane & 31)] = W[(size_t)(k0 + kk) * N + n0 + (lane & 31)]; }
    LDS_WAIT(); asm volatile("" ::: "memory");
    const int c = lane & 7;
#pragma unroll
    for (int j = 0; j < 4; ++j) { const int n = (lane >> 3) + 8 * j; const LAS float* s = scr + (8 * c) * 33 + n;
        u32x4 o; o.x = cvt_pk_bf16(s[0 * 33], s[1 * 33]); o.y = cvt_pk_bf16(s[2 * 33], s[3 * 33]); o.z = cvt_pk_bf16(s[4 * 33], s[5 * 33]); o.w = cvt_pk_bf16(s[6 * 33], s[7 * 33]);
        *(u32x4*)(WT + (size_t)(drow0 + n) * K + k0 + 8 * c) = o; }
    LDS_WAIT(); asm volatile("" ::: "memory");
}
__device__ __forceinline__ void p0a(Frame& F) {
    PHASE_IDS();
    LAS float* scr = (LAS float*)(F.lds + wave * 8704);
    LAS float* sv = (LAS float*)(F.lds + 8 * 8704);
    for (int i = tid; i < 2 * DM; i += NTHR) { const float v = (i < DM) ? F.a->in[1][i] : F.a->in[3][i - DM]; sv[i] = v / (1.0f + __expf(-v)); }
    __syncthreads();
    const int gw = F.vcu * NWAVES + wave, NGW = F.G * NWAVES;
    constexpr int I0 = 8 * 32 * 344, I1 = 8 * 86 * 64, I2 = 2 * 32 * 193, I3 = 2 * 32 * 64, I4 = 2 * 32 * 34, I5 = 2 * 8 * 96, I6 = 2 * 8 * 128, I7 = 2 * 32 * 64;
    constexpr int NTR = I0 + I1 + I2 + I3 + I4 + I5 + I6 + I7, NADAI = 8 * 288;
    for (int it = gw; it < NTR + NADAI; it += NGW) {
        int r = it;
        if (r < I0) { const int mat = r / 11008, q = r % 11008, kb = q / 344, nb = q % 344, n0 = nb * 32;
            const int j = n0 < DFF ? n0 : n0 - DFF, drow = (j / 128) * 256 + (j % 128) + (n0 < DFF ? 0 : 128);
            tr_item(F.a->in[8] + (size_t)mat * DM * 2 * DFF, 2 * DFF, DM, (bf16*)(F.ws + WS_WFI + mat * SZ_WFI), kb * 64, n0, drow - 0, scr, lane); continue; } r -= I0;
        if (r < I1) { const int mat = r / 5504, q = r % 5504, kb = q / 64, nb = q % 64;
            tr_item(F.a->in[9] + (size_t)mat * DFF * DM, DM, DFF, (bf16*)(F.ws + WS_WFO + mat * SZ_WFO), kb * 64, nb * 32, nb * 32, scr, lane); continue; } r -= I1;
        if (r < I2) { const int mat = r / 6176, q = r % 6176, kb = q / 193, nb = q % 193, n0 = nb * 32;
            const int drow = n0 < 3072 ? n0 : (n0 < 3104 ? 6144 : n0 - 32);
            tr_item(F.a->in[10] + (size_t)mat * DM * 6176, 6176, DM, (bf16*)(F.ws + WS_EWI + mat * SZ_EWI), kb * 64, n0, drow, scr, lane); continue; } r -= I2;
        if (r < I3) { const int mat = r / 2048, q = r % 2048, kb = q / 64, nb = q % 64;
            tr_item(F.a->in[16] + (size_t)mat * DM * DM, DM, DM, (bf16*)(F.ws + WS_EWO + mat * SZ_SQ), kb * 64, nb * 32, nb * 32, scr, lane); continue; } r -= I3;
        if (r < I4) { const int mat = r / 1088, q = r % 1088, kb = q / 34, nb = q % 34;
            tr_item(F.a->in[17] + (size_t)mat * DM * 1088, 1088, DM, (bf16*)(F.ws + WS_OWI + mat * SZ_OWI), kb * 64, nb * 32, nb * 32, scr, lane); continue; } r -= I4;
        if (r < I5) { const int mat = r / 768, q = r % 768, kb = q / 96, nb = q % 96;
            tr_item(F.a->in[20] + (size_t)mat * 512 * 3072, 3072, 512, (bf16*)(F.ws + WS_OUQ + mat * SZ_OUQ), kb * 64, nb * 32, nb * 32, scr, lane); continue; } r -= I5;
        if (r < I6) { const int mat = r / 1024, q = r % 1024, kb = q / 128, nb = q % 128;
            tr_item(F.a->in[21] + (size_t)mat * 512 * 4096, 4096, 512, (bf16*)(F.ws + WS_OUKV + mat * SZ_OUKV), kb * 64, nb * 32, nb * 32, scr, lane); continue; } r -= I6;
        if (r < I7) { const int mat = r / 2048, q = r % 2048, kb = q / 64, nb = q % 64;
            tr_item(F.a->in[22] + (size_t)mat * DM * DM, DM, DM, (bf16*)(F.ws + WS_OWO + mat * SZ_SQ), kb * 64, nb * 32, nb * 32, scr, lane); continue; } r -= I7;
        {
            const int ks = r / 288, cg = r % 288, l = cg / 72, n = (cg % 72) * 256 + lane * 4;
            const float* w = F.a->in[4] + ((size_t)l * DM + ks * 256) * NADA + n;
            f32x4 al = {0.f, 0.f, 0.f, 0.f}, ac = {0.f, 0.f, 0.f, 0.f};
#pragma unroll 8
            for (int k = 0; k < 256; ++k) { const f32x4 wv = *(const f32x4*)(w + (size_t)k * NADA); al += wv * sv[ks * 256 + k]; ac += wv * sv[DM + ks * 256 + k]; }
            float* mp = (float*)(F.ws + WS_MODP);
            *(f32x4*)(mp + (size_t)(ks * 2 + 0) * 4 * NADA + l * NADA + n) = al;
            *(f32x4*)(mp + (size_t)(ks * 2 + 1) * 4 * NADA + l * NADA + n) = ac;
        }
    }
    const int gt = F.vcu * NTHR + tid, NGT = F.G * NTHR;
    for (int i = gt; i < NLAT * 64 + 256 * 16 + 64 * 16; i += NGT) {
        int pos, fi; float inv; f32x2* dst;
        if (i < NLAT * 64) { pos = i >> 6; fi = i & 63; inv = __builtin_amdgcn_exp2f(-(float)fi * (13.287712379549449f / 64.0f)); dst = (f32x2*)(F.ws + WS_RT) + i; }
        else if (i < NLAT * 64 + 4096) { const int j = i - NLAT * 64; pos = j >> 4; fi = j & 15; inv = __builtin_amdgcn_exp2f(-(float)fi * (13.287712379549449f / 16.0f)); dst = (f32x2*)(F.ws + WS_AXR) + j; }
        else { const int j = i - NLAT * 64 - 4096; pos = j >> 4; fi = j & 15; inv = __builtin_amdgcn_exp2f(-(float)fi * (13.287712379549449f / 16.0f)); dst = (f32x2*)(F.ws + WS_AXC) + j; }
        const float ang = (float)pos * inv;
        double rev = (double)ang * 0.15915494309189535; rev -= __builtin_floor(rev);
        const float rv = (float)rev;
        *dst = (f32x2){__builtin_amdgcn_cosf(rv), __builtin_amdgcn_sinf(rv)};
    }
}
__device__ __forceinline__ void p0b(Frame& F) {
    PHASE_IDS();
    const int gt = F.vcu * NTHR + tid, NGT = F.G * NTHR;
    const float* mp = (const float*)(F.ws + WS_MODP); float* mo = (float*)(F.ws + WS_MOD);
    for (int i = gt; i < 4 * 2 * NADA; i += NGT) { const int l = i / (2 * NADA), v = (i / NADA) & 1, n = i % NADA;
        float s = F.a->in[5][l * NADA + n];
#pragma unroll
        for (int ks = 0; ks < 8; ++ks) s += mp[(size_t)(ks * 2 + v) * 4 * NADA + l * NADA + n];
        mo[i] = s; }
}
__device__ __forceinline__ const float* modp(Frame& F, int l, int v, int idx) { return (const float*)(F.ws + WS_MOD) + ((size_t)(l * 2 + v) * 9 + idx) * DM; }

template <int MODE>
__device__ __forceinline__ void row_phase(Frame& F, const float* lng, const float* lnb, const float* sh_l, const float* sc_l, const float* sh_c, const float* sc_c) {
    PHASE_IDS();
    LAS float* V = (LAS float*)F.lds;
    for (int i = tid; i < DM; i += NTHR) { if (MODE != 0) { V[i] = lng[i]; V[DM + i] = lnb[i]; } if (MODE != 2) { V[2 * DM + i] = sh_l[i]; V[3 * DM + i] = sc_l[i]; V[4 * DM + i] = sh_c[i]; V[5 * DM + i] = sc_c[i]; } }
    __syncthreads();
    const int gw = F.vcu * NWAVES + wave, NGW = F.G * NWAVES;
    float* X = (float*)(F.ws + WS_X); bf16* H = (bf16*)(F.ws + WS_H);
    for (int t = gw; t < T; t += NGW) {
        if (MODE == 2 && t < NCTX) continue;
        const float* src = (MODE == 0) ? (t < NCTX ? F.a->in[2] + (size_t)t * DM : F.a->in[0] + (size_t)(t - NCTX) * DM) : X + (size_t)t * DM;
        f32x4 v[8]; float s = 0.f;
#pragma unroll
        for (int j = 0; j < 8; ++j) { v[j] = *((const f32x4*)src + lane + 64 * j); s += (v[j].x + v[j].y) + (v[j].z + v[j].w); }
        if (MODE != 0) {
            const float mean = wave_sum(s) * (1.f / DM); float s2 = 0.f;
#pragma unroll
            for (int j = 0; j < 8; ++j) { v[j] = v[j] - mean; s2 += (v[j].x * v[j].x + v[j].y * v[j].y) + (v[j].z * v[j].z + v[j].w * v[j].w); }
            const float rstd = 1.f / sqrtf(wave_sum(s2) * (1.f / DM) + LN_EPS);
#pragma unroll
            for (int j = 0; j < 8; ++j) { const f32x4 g = *((const LAS f32x4*)V + lane + 64 * j), b = *((const LAS f32x4*)(V + DM) + lane + 64 * j); v[j] = v[j] * rstd * g + b; }
        }
        if (MODE == 2) {
            float* o = F.a->out + (size_t)(t - NCTX) * DM;
#pragma unroll
            for (int j = 0; j < 8; ++j) *((f32x4*)o + lane + 64 * j) = v[j];
        } else {
            float* o = X + (size_t)t * DM; bf16* h = H + (size_t)t * DM;
            const LAS float* shv = V + (t < NCTX ? 4 * DM : 2 * DM); const LAS float* scv = V + (t < NCTX ? 5 * DM : 3 * DM);
#pragma unroll
            for (int j = 0; j < 8; ++j) { *((f32x4*)o + lane + 64 * j) = v[j];
                const f32x4 sh = *((const LAS f32x4*)shv + lane + 64 * j), sc = *((const LAS f32x4*)scv + lane + 64 * j);
                const f32x4 m = v[j] * (sc + 1.0f) + sh; u32x2 w; w.x = cvt_pk_bf16(m.x, m.y); w.y = cvt_pk_bf16(m.z, m.w);
                *((u32x2*)h + lane + 64 * j) = w; }
        }
    }
    __syncthreads();
}

constexpr int L1_QRAW = 0, L1_KRAW = 16384, L1_GD = 32768, L1_PART = 36864, L1_QT = 40960, L1_KT = 58368, L1_KTT = 75776, L1_VT = 94208, L1_P = 131072;
constexpr float INV_SQRT_DK = 0.08838834764831845f;

template <int DIR>
__device__ __forceinline__ void s1_dir(Frame& F, int e, int hh, int c, bool lat, f32x4 (&pacc)[2]) {
    const bool is_gla = hh < 4; const int hd = hh & 3, t0 = c * 64;
    PHASE_IDS(); const int w = wave, fr = lane & 15, fq = lane >> 4;
    LAS unsigned char* lds = F.lds;
    const int ch = tid & 127, tq = tid >> 7;
    float lgv[16];
    if (is_gla) {
        const float* wg = F.a->in[DIR ? 13 : 11] + (size_t)e * 16 * 512 + hd * 128 + ch; const float bgv = F.a->in[DIR ? 14 : 12][e * 512 + hd * 128 + ch];
        float wv[16];
#pragma unroll
        for (int r = 0; r < 16; ++r) wv[r] = wg[r * 512];
#pragma unroll
        for (int i = 0; i < 16; ++i) { const int tt = 16 * tq + (DIR ? 15 - i : i);
            const u32x4 g0 = *(const LAS u32x4*)(lds + L1_GD + tt * 64 + DIR * 32), g1 = *(const LAS u32x4*)(lds + L1_GD + tt * 64 + DIR * 32 + 16);
            float x = bgv;
            x += bflo(g0.x) * wv[0] + bfhi(g0.x) * wv[1] + bflo(g0.y) * wv[2] + bfhi(g0.y) * wv[3] + bflo(g0.z) * wv[4] + bfhi(g0.z) * wv[5] + bflo(g0.w) * wv[6] + bfhi(g0.w) * wv[7];
            x += bflo(g1.x) * wv[8] + bfhi(g1.x) * wv[9] + bflo(g1.y) * wv[10] + bfhi(g1.y) * wv[11] + bflo(g1.z) * wv[12] + bfhi(g1.z) * wv[13] + bflo(g1.w) * wv[14] + bfhi(g1.w) * wv[15];
            lgv[i] = (fminf(x, 0.f) - __logf(1.0f + __expf(-fabsf(x)))) * (1.0f / 16.0f); }
    } else {
        const float lg = log1pf(-exp2f((DIR ? -5.5f : -5.0f) - (float)hd));
#pragma unroll
        for (int i = 0; i < 16; ++i) lgv[i] = lg;
    }
    float ls = 0.f;
#pragma unroll
    for (int i = 0; i < 16; ++i) ls += lgv[i];
    LAS float* part = (LAS float*)(lds + L1_PART);
    part[tq * 128 + ch] = ls;
    __syncthreads();
    float b = 0.f;
#pragma unroll
    for (int q = 0; q < 4; ++q) { const float pv = part[q * 128 + ch]; if (DIR ? (q > tq) : (q < tq)) b += pv; }
    bf16* QTg = (bf16*)(F.ws + WS_QT) + (size_t)DIR * T * 1024;
    const f32x2* RT = (const f32x2*)(F.ws + WS_RT);
    float kt[16];
#pragma unroll
    for (int i = 0; i < 16; ++i) { const int tt = 16 * tq + (DIR ? 15 - i : i);
        b += lgv[i];
        float qv = bf2f(*(const LAS bf16*)(lds + L1_QRAW + tt * 256 + ch * 2)), kv = bf2f(*(const LAS bf16*)(lds + L1_KRAW + tt * 256 + ch * 2));
        if (!is_gla && lat) {
            const float qp = bf2f(*(const LAS bf16*)(lds + L1_QRAW + tt * 256 + (ch ^ 64) * 2)), kp = bf2f(*(const LAS bf16*)(lds + L1_KRAW + tt * 256 + (ch ^ 64) * 2));
            const f32x2 cs = RT[(size_t)(t0 + tt - NCTX) * 64 + (ch & 63)];
            if (ch < 64) { qv = qv * cs.x - qp * cs.y; kv = kv * cs.x - kp * cs.y; } else { qv = qv * cs.x + qp * cs.y; kv = kv * cs.x + kp * cs.y; }
        }
        const float eb = __expf(b), ebi = __expf(-b);
        const float qs = qv * eb * (is_gla ? INV_SQRT_DK : 1.0f), ks = kv * ebi * (is_gla ? 1.0f : INV_SQRT_DK);
        const bf16 qb = f2bf(qs);
        *(LAS bf16*)(lds + L1_QT + tt * 272 + ch * 2) = qb;
        *(LAS bf16*)(lds + L1_KT + tt * 272 + ch * 2) = f2bf(ks);
        QTg[(size_t)(t0 + tt) * 1024 + hh * 128 + ch] = qb;
        kt[DIR ? 15 - i : i] = ks;
        if (i == 15 && tq == (DIR ? 0 : 3)) ((float*)(F.ws + WS_DEC))[((size_t)(DIR * 8 + hh) * NCH + c) * 128 + ch] = eb;
    }
    { u32x4 w0, w1; w0.x = cvt_pk_bf16(kt[0], kt[1]); w0.y = cvt_pk_bf16(kt[2], kt[3]); w0.z = cvt_pk_bf16(kt[4], kt[5]); w0.w = cvt_pk_bf16(kt[6], kt[7]);
      w1.x = cvt_pk_bf16(kt[8], kt[9]); w1.y = cvt_pk_bf16(kt[10], kt[11]); w1.z = cvt_pk_bf16(kt[12], kt[13]); w1.w = cvt_pk_bf16(kt[14], kt[15]);
      *(LAS u32x4*)(lds + L1_KTT + ch * 144 + tq * 32) = w0; *(LAS u32x4*)(lds + L1_KTT + ch * 144 + tq * 32 + 16) = w1; }
    __syncthreads();
    { const int mi = w >> 1, nj0 = 2 * (w & 1);
      f32x4 pd[2] = {{0.f, 0.f, 0.f, 0.f}, {0.f, 0.f, 0.f, 0.f}};
#pragma unroll
      for (int ks = 0; ks < 4; ++ks) { const bf16x8 a = *(const LAS bf16x8*)(lds + L1_QT + (16 * mi + fr) * 272 + (32 * ks + 8 * fq) * 2);
#pragma unroll
          for (int j = 0; j < 2; ++j) { const bf16x8 bb = *(const LAS bf16x8*)(lds + L1_KT + (16 * (nj0 + j) + fr) * 272 + (32 * ks + 8 * fq) * 2); pd[j] = MFMA16(a, bb, pd[j]); } }
#pragma unroll
      for (int j = 0; j < 2; ++j)
#pragma unroll
          for (int r = 0; r < 4; ++r) { const int ii = 16 * mi + 4 * fq + r, jj = 16 * (nj0 + j) + fr; if (DIR ? (jj >= ii) : (jj <= ii)) pacc[j][r] += pd[j][r]; } }
    { bf16* Ug = (bf16*)(F.ws + WS_U) + ((size_t)(DIR * 8 + hh) * NCH + c) * 256 * 128;
      bf16x8 bv[2][2];
#pragma unroll
      for (int nj = 0; nj < 2; ++nj)
#pragma unroll
          for (int ks = 0; ks < 2; ++ks) bv[nj][ks] = *(const LAS bf16x8*)(lds + L1_VT + (32 * w + 16 * nj + fr) * 144 + (32 * ks + 8 * fq) * 2);
#pragma unroll
      for (int mi = 0; mi < 8; ++mi) {
          f32x4 u[2] = {{0.f, 0.f, 0.f, 0.f}, {0.f, 0.f, 0.f, 0.f}};
#pragma unroll
          for (int ks = 0; ks < 2; ++ks) { const bf16x8 a = *(const LAS bf16x8*)(lds + L1_KTT + (16 * mi + fr) * 144 + (32 * ks + 8 * fq) * 2);
#pragma unroll
              for (int nj = 0; nj < 2; ++nj) u[nj] = MFMA16(a, bv[nj][ks], u[nj]); }
          asm volatile("s_nop 15" : "+v"(u[0]), "+v"(u[1]));
#pragma unroll
          for (int nj = 0; nj < 2; ++nj) { u32x2 o; o.x = cvt_pk_bf16(u[nj][0], u[nj][1]); o.y = cvt_pk_bf16(u[nj][2], u[nj][3]);
              *(u32x2*)(Ug + (size_t)(32 * w + 16 * nj + fr) * 128 + 16 * mi + 4 * fq) = o; } } }
    __syncthreads();
}

__device__ __forceinline__ void s1_phase(Frame& F, int e) {
    PHASE_IDS(); LAS unsigned char* lds = F.lds; const int w = wave, fr = lane & 15, fq = lane >> 4;
    const bf16* P = (const bf16*)(F.ws + WS_PROJ);
    for (int item = blockIdx.x; item < 8 * NCH; item += F.G) {
        const int c = item >> 3, hh = item & 7, hd = hh & 3, t0 = c * 64; const bool is_gla = hh < 4, lat = c >= 4;
        const int qcol = is_gla ? 128 * hd : 3072 + 128 * hd, kcol = qcol + 512, vcol = is_gla ? 1024 + 256 * hd : 4096 + 256 * hd;
#pragma unroll
        for (int i = 0; i < 2; ++i) { const int id = tid + 512 * i, r = id >> 4, cc = id & 15;
            *(LAS u32x4*)(lds + L1_QRAW + r * 256 + cc * 16) = *(const u32x4*)(P + (size_t)(t0 + r) * EV_N + qcol + cc * 8);
            *(LAS u32x4*)(lds + L1_KRAW + r * 256 + cc * 16) = *(const u32x4*)(P + (size_t)(t0 + r) * EV_N + kcol + cc * 8); }
#pragma unroll
        for (int i = 0; i < 4; ++i) { const int id = tid + 512 * i, r = id >> 5, cc = id & 31;
            const u32x4 v = *(const u32x4*)(P + (size_t)(t0 + r) * EV_N + vcol + cc * 8);
            LAS bf16* vt = (LAS bf16*)(lds + L1_VT) + (cc * 8) * 72 + r;
            vt[0 * 72] = (bf16)(v.x & 0xffff); vt[1 * 72] = (bf16)(v.x >> 16); vt[2 * 72] = (bf16)(v.y & 0xffff); vt[3 * 72] = (bf16)(v.y >> 16);
            vt[4 * 72] = (bf16)(v.z & 0xffff); vt[5 * 72] = (bf16)(v.z >> 16); vt[6 * 72] = (bf16)(v.w & 0xffff); vt[7 * 72] = (bf16)(v.w >> 16); }
        if (is_gla && tid < 256) { const int r = tid >> 2, cc = tid & 3; *(LAS u32x4*)(lds + L1_GD + r * 64 + cc * 16) = *(const u32x4*)(P + (size_t)(t0 + r) * EV_N + 6144 + cc * 8); }
        __syncthreads();
        f32x4 pacc[2] = {{0.f, 0.f, 0.f, 0.f}, {0.f, 0.f, 0.f, 0.f}};
        s1_dir<0>(F, e, hh, c, lat, pacc);
        s1_dir<1>(F, e, hh, c, lat, pacc);
        { const int mi = w >> 1, nj0 = 2 * (w & 1);
#pragma unroll
          for (int j = 0; j < 2; ++j)
#pragma unroll
              for (int r = 0; r < 4; ++r) *(LAS bf16*)(lds + L1_P + (16 * mi + 4 * fq + r) * 144 + (16 * (nj0 + j) + fr) * 2) = f2bf(pacc[j][r]); }
        __syncthreads();
        { float* OI = (float*)(F.ws + WS_OI);
          bf16x8 bv[2][2];
#pragma unroll
          for (int nj = 0; nj < 2; ++nj)
#pragma unroll
              for (int ks = 0; ks < 2; ++ks) bv[nj][ks] = *(const LAS bf16x8*)(lds + L1_VT + (32 * w + 16 * nj + fr) * 144 + (32 * ks + 8 * fq) * 2);
#pragma unroll
          for (int mi = 0; mi < 4; ++mi) {
              f32x4 o[2] = {{0.f, 0.f, 0.f, 0.f}, {0.f, 0.f, 0.f, 0.f}};
#pragma unroll
              for (int ks = 0; ks < 2; ++ks) { const bf16x8 a = *(const LAS bf16x8*)(lds + L1_P + (16 * mi + fr) * 144 + (32 * ks + 8 * fq) * 2);
#pragma unroll
                  for (int nj = 0; nj < 2; ++nj) o[nj] = MFMA16(a, bv[nj][ks], o[nj]); }
#pragma unroll
              for (int nj = 0; nj < 2; ++nj)
#pragma unroll
                  for (int r = 0; r < 4; ++r) OI[(size_t)(t0 + 16 * mi + 4 * fq + r) * DM + hh * 256 + 32 * w + 16 * nj + fr] = o[nj][r]; } }
        __syncthreads();
    }
}

__device__ __forceinline__ void s2_phase(Frame& F) {
    PHASE_IDS();
    const int gt = F.vcu * NTHR + tid, NGT = F.G * NTHR;
    for (int idx = gt; idx < 2 * 8 * 256 * 32; idx += NGT) {
        const int dk4 = idx & 31, ee = (idx >> 5) & 255, dh = idx >> 13, dir = dh >> 3;
        const bf16* U = (const bf16*)(F.ws + WS_U) + (size_t)dh * NCH * 256 * 128 + (size_t)ee * 128 + dk4 * 4;
        bf16* S = (bf16*)(F.ws + WS_S) + (size_t)dh * NCH * 256 * 128 + (size_t)ee * 128 + dk4 * 4;
        const float* D = (const float*)(F.ws + WS_DEC) + (size_t)dh * NCH * 128 + dk4 * 4;
        f32x4 s = {0.f, 0.f, 0.f, 0.f};
#pragma unroll 4
        for (int step = 0; step < NCH; ++step) {
            const int c = dir ? (step < 4 ? 3 - step : NCH + 3 - step) : step;
            const u32x2 uu = *(const u32x2*)(U + (size_t)c * 256 * 128); const f32x4 d = *(const f32x4*)(D + (size_t)c * 128);
            u32x2 so; so.x = cvt_pk_bf16(s.x, s.y); so.y = cvt_pk_bf16(s.z, s.w);
            *(u32x2*)(S + (size_t)c * 256 * 128) = so;
            s.x = d.x * (s.x + bflo(uu.x)); s.y = d.y * (s.y + bfhi(uu.x)); s.z = d.z * (s.z + bflo(uu.y)); s.w = d.w * (s.w + bfhi(uu.y));
        }
    }
}

constexpr int L3_QF = 0, L3_QB = 17408, L3_RED = 34816;
__device__ __forceinline__ void s3_phase(Frame& F, int e) {
    PHASE_IDS(); LAS unsigned char* lds = F.lds; const int w = wave, fr = lane & 15, fq = lane >> 4;
    const bf16* P = (const bf16*)(F.ws + WS_PROJ); const bf16* QTg = (const bf16*)(F.ws + WS_QT); const float* OI = (const float*)(F.ws + WS_OI);
    bf16* MIX = (bf16*)(F.ws + WS_MIX);
    for (int item = blockIdx.x; item < 8 * NCH; item += F.G) {
        const int c = item >> 3, hh = item & 7, hd = hh & 3, t0 = c * 64; const bool is_gla = hh < 4;
        const int gcol = is_gla ? 2048 + 256 * hd : 5120 + 256 * hd;
#pragma unroll
        for (int dir = 0; dir < 2; ++dir)
#pragma unroll
            for (int i = 0; i < 2; ++i) { const int id = tid + 512 * i, r = id >> 4, cc = id & 15;
                *(LAS u32x4*)(lds + (dir ? L3_QB : L3_QF) + r * 272 + cc * 16) = *(const u32x4*)(QTg + (size_t)dir * T * 1024 + (size_t)(t0 + r) * 1024 + hh * 128 + cc * 8); }
        __syncthreads();
        f32x4 o[4][2];
#pragma unroll
        for (int mi = 0; mi < 4; ++mi)
#pragma unroll
            for (int nj = 0; nj < 2; ++nj) o[mi][nj] = (f32x4){0.f, 0.f, 0.f, 0.f};
#pragma unroll
        for (int dir = 0; dir < 2; ++dir) {
            const bf16* Sg = (const bf16*)(F.ws + WS_S) + ((size_t)(dir * 8 + hh) * NCH + c) * 256 * 128;
#pragma unroll
            for (int ks = 0; ks < 4; ++ks) {
                bf16x8 bv[2];
#pragma unroll
                for (int nj = 0; nj < 2; ++nj) bv[nj] = *(const bf16x8*)(Sg + (size_t)(32 * w + 16 * nj + fr) * 128 + 32 * ks + 8 * fq);
#pragma unroll
                for (int mi = 0; mi < 4; ++mi) { const bf16x8 a = *(const LAS bf16x8*)(lds + (dir ? L3_QB : L3_QF) + (16 * mi + fr) * 272 + (32 * ks + 8 * fq) * 2);
#pragma unroll
                    for (int nj = 0; nj < 2; ++nj) o[mi][nj] = MFMA16(a, bv[nj], o[mi][nj]); } } }
        LAS float* red = (LAS float*)(lds + L3_RED);
#pragma unroll
        for (int mi = 0; mi < 4; ++mi)
#pragma unroll
            for (int r = 0; r < 4; ++r) { const int ii = 16 * mi + 4 * fq + r; float sq = 0.f;
#pragma unroll
                for (int nj = 0; nj < 2; ++nj) { o[mi][nj][r] += OI[(size_t)(t0 + ii) * DM + hh * 256 + 32 * w + 16 * nj + fr]; sq += o[mi][nj][r] * o[mi][nj][r]; }
                sq += __shfl_xor(sq, 1); sq += __shfl_xor(sq, 2); sq += __shfl_xor(sq, 4); sq += __shfl_xor(sq, 8);
                if (fr == 0) red[ii * 8 + w] = sq; }
        __syncthreads();
        float nw[2];
#pragma unroll
        for (int nj = 0; nj < 2; ++nj) nw[nj] = is_gla ? F.a->in[15][e * 256 + 32 * w + 16 * nj + fr] : 1.0f;
#pragma unroll
        for (int mi = 0; mi < 4; ++mi)
#pragma unroll
            for (int r = 0; r < 4; ++r) { const int ii = 16 * mi + 4 * fq + r;
                const f32x4 r0 = *(const LAS f32x4*)(red + ii * 8), r1 = *(const LAS f32x4*)(red + ii * 8 + 4);
                const float rstd = 1.0f / sqrtf(((r0.x + r0.y) + (r0.z + r0.w) + (r1.x + r1.y) + (r1.z + r1.w)) * (1.0f / 256.0f) + RMS_EPS);
#pragma unroll
                for (int nj = 0; nj < 2; ++nj) { const int ee = 32 * w + 16 * nj + fr;
                    const float gt = bf2f(P[(size_t)(t0 + ii) * EV_N + gcol + ee]);
                    MIX[(size_t)(t0 + ii) * DM + hh * 256 + ee] = f2bf(o[mi][nj][r] * rstd * nw[nj] * silu_f(gt)); } }
        __syncthreads();
    }
}

__device__ __forceinline__ void e1_phase(Frame& F, int o) {
    PHASE_IDS();
    const int gw = F.vcu * NWAVES + wave, NGW = F.G * NWAVES;
    const bf16* P = (const bf16*)(F.ws + WS_PROJ); bf16* CQN = (bf16*)(F.ws + WS_CQN); bf16* CKVN = (bf16*)(F.ws + WS_CKVN); bf16* KR = (bf16*)(F.ws + WS_KR);
    const float* wq = F.a->in[18] + o * 512 + lane * 8; const float* wkv = F.a->in[19] + o * 512 + lane * 8;
    const f32x4 wq0 = *(const f32x4*)wq, wq1 = *(const f32x4*)(wq + 4), wk0 = *(const f32x4*)wkv, wk1 = *(const f32x4*)(wkv + 4);
    const f32x2* AXR = (const f32x2*)(F.ws + WS_AXR); const f32x2* AXC = (const f32x2*)(F.ws + WS_AXC);
    for (int t = gw; t < T; t += NGW) {
        const bf16* p = P + (size_t)t * OD_N;
        const u32x4 a = *(const u32x4*)(p + lane * 8), b = *(const u32x4*)(p + 512 + lane * 8);
        float x[8] = {bflo(a.x), bfhi(a.x), bflo(a.y), bfhi(a.y), bflo(a.z), bfhi(a.z), bflo(a.w), bfhi(a.w)};
        float y[8] = {bflo(b.x), bfhi(b.x), bflo(b.y), bfhi(b.y), bflo(b.z), bfhi(b.z), bflo(b.w), bfhi(b.w)};
        float sx = 0.f, sy = 0.f;
#pragma unroll
        for (int j = 0; j < 8; ++j) { sx += x[j] * x[j]; sy += y[j] * y[j]; }
        const float rx = 1.0f / sqrtf(wave_sum(sx) * (1.0f / 512.0f) + RMS_EPS), ry = 1.0f / sqrtf(wave_sum(sy) * (1.0f / 512.0f) + RMS_EPS);
        u32x4 oq, ok;
        oq.x = cvt_pk_bf16(x[0] * rx * wq0.x, x[1] * rx * wq0.y); oq.y = cvt_pk_bf16(x[2] * rx * wq0.z, x[3] * rx * wq0.w); oq.z = cvt_pk_bf16(x[4] * rx * wq1.x, x[5] * rx * wq1.y); oq.w = cvt_pk_bf16(x[6] * rx * wq1.z, x[7] * rx * wq1.w);
        ok.x = cvt_pk_bf16(y[0] * ry * wk0.x, y[1] * ry * wk0.y); ok.y = cvt_pk_bf16(y[2] * ry * wk0.z, y[3] * ry * wk0.w); ok.z = cvt_pk_bf16(y[4] * ry * wk1.x, y[5] * ry * wk1.y); ok.w = cvt_pk_bf16(y[6] * ry * wk1.z, y[7] * ry * wk1.w);
        *(u32x4*)(CQN + (size_t)t * 512 + lane * 8) = oq; *(u32x4*)(CKVN + (size_t)t * 512 + lane * 8) = ok;
        float v = bf2f(p[1024 + lane]); const float pr = __shfl_xor(v, 16);
        if (t >= NCTX) { const int pp = t - NCTX, pos = (lane & 32) ? (pp & 63) : (pp >> 6); const f32x2 cs = ((lane & 32) ? AXC : AXR)[pos * 16 + (lane & 15)];
            v = (lane & 16) ? v * cs.x + pr * cs.y : v * cs.x - pr * cs.y; }
        KR[(size_t)t * 64 + lane] = f2bf(v);
    }
}

namespace att {
constexpr int KVBLK = 64;
constexpr float SCALE = 0.07216878364870322f;
constexpr float THR = 8.f;
constexpr int SHM_K = 64 * 384, SHM_V = 64 * 256;
constexpr int A_V = 0, A_K = 2 * SHM_V, A_WS = 2 * SHM_V + 2 * SHM_K;
#define SBAR() __builtin_amdgcn_sched_barrier(0)
__device__ __forceinline__ int crow(int r, int hi) { return (r & 3) + 8 * (r >> 2) + 4 * hi; }
__device__ __forceinline__ void partialSM(f32x16& p0, f32x16& p1, float& m_reg, float& mn, float& alpha) {
    constexpr float C = SCALE * 1.4426950408889634f;
    float pmax = p0[0];
#pragma unroll
    for (int r = 1; r < 16; ++r) pmax = fmaxf(pmax, p0[r]);
#pragma unroll
    for (int r = 0; r < 16; ++r) pmax = fmaxf(pmax, p1[r]);
    { auto rr = __builtin_amdgcn_permlane32_swap(__float_as_uint(pmax), __float_as_uint(pmax), false, false);
      pmax = fmaxf(__uint_as_float(rr[0]), __uint_as_float(rr[1])); }
    if (__builtin_expect(__all(pmax - m_reg <= THR / SCALE), 1)) { mn = m_reg; alpha = 1.f; }
    else { mn = fmaxf(m_reg, pmax); alpha = __builtin_amdgcn_exp2f((m_reg - mn) * C); m_reg = mn; }
    const float mnC = -mn * C;
#pragma unroll
    for (int r = 0; r < 16; ++r) p0[r] = fmaf(p0[r], C, mnC);
#pragma unroll
    for (int r = 0; r < 16; ++r) p1[r] = fmaf(p1[r], C, mnC);
#pragma unroll
    for (int r = 0; r < 16; ++r) p0[r] = __builtin_amdgcn_exp2f(p0[r]);
}
__device__ __forceinline__ void finishSM(f32x16& p0, f32x16& p1, float alpha, float& l_reg, bf16x8& pa0, bf16x8& pa1, bf16x8& pa2, bf16x8& pa3) {
#pragma unroll
    for (int r = 0; r < 16; ++r) p1[r] = __builtin_amdgcn_exp2f(p1[r]);
    float ps = 0;
#pragma unroll
    for (int r = 0; r < 16; ++r) ps += p0[r];
#pragma unroll
    for (int r = 0; r < 16; ++r) ps += p1[r];
    { auto rr = __builtin_amdgcn_permlane32_swap(__float_as_uint(ps), __float_as_uint(ps), false, false);
      ps = __uint_as_float(rr[0]) + __uint_as_float(rr[1]); }
    l_reg = l_reg * alpha + ps;
#define PK4(P, BASE, OUT) do { unsigned a0 = cvt_pk_bf16(P[BASE + 0], P[BASE + 1]), a1 = cvt_pk_bf16(P[BASE + 2], P[BASE + 3]);   \
    unsigned b0 = cvt_pk_bf16(P[BASE + 4], P[BASE + 5]), b1 = cvt_pk_bf16(P[BASE + 6], P[BASE + 7]);                              \
    auto r0 = __builtin_amdgcn_permlane32_swap(a0, b0, false, false); auto r1 = __builtin_amdgcn_permlane32_swap(a1, b1, false, false); \
    u32x4 w = {r0[0], r1[0], r0[1], r1[1]}; OUT = *reinterpret_cast<bf16x8*>(&w); } while (0)
    PK4(p0, 0, pa0); PK4(p0, 8, pa1); PK4(p1, 0, pa2); PK4(p1, 8, pa3);
#undef PK4
}
__device__ __forceinline__ int kswz(int row, int g) { return row * 384 + (((g & ~7) | ((g & 7) ^ ((row >> 1) & 7))) << 4); }
__device__ __forceinline__ void qkt(f32x16& p0, f32x16& p1, const LAS unsigned char* Ks, const bf16x8 (&qr)[12], const int (&kx)[4]) {
    p0 = f32x16{}; p1 = f32x16{};
#pragma unroll
    for (int d0 = 0; d0 < 12; ++d0) {
        const bf16x8 b0 = *(const LAS bf16x8*)(Ks + kx[d0 & 3] + (d0 >> 2) * 128);
        const bf16x8 b1 = *(const LAS bf16x8*)(Ks + kx[d0 & 3] + (d0 >> 2) * 128 + 32 * 384);
        p0 = MFMA32(b0, qr[d0], p0);
        p1 = MFMA32(b1, qr[d0], p1); }
}
__device__ __forceinline__ int v_st(int k, int c) { const int kk = (k & ~0xC) | ((k & 4) << 1) | ((k & 8) >> 1); return ((kk >> 3) * 4 + (c >> 5)) * 512 + ((kk & 7) * 32 + (c & 31)) * 2; }
__device__ __forceinline__ int v_rd_base(int lane) { return ((lane & 3) << 3) | (((lane >> 2) & 3) << 6) | (((lane >> 4) & 1) << 5) | (((lane >> 5) & 1) << 8); }
constexpr int v_rd_off(int d0, int ks, int half) { return d0 * 512 + ks * 4096 + half * 2048; }
template <int OFF> __device__ __forceinline__ s16x4 tr_read(int vb) {
    s16x4 r; asm volatile("ds_read_b64_tr_b16 %0, %1 offset:%2" : "=&v"(r) : "v"(vb), "i"(OFF) : "memory"); return r;
}
template <int D0> __device__ __forceinline__ void pv_one(f32x16& od, int vb, bf16x8 pa0, bf16x8 pa1, bf16x8 pa2, bf16x8 pa3) {
    const s16x4 l0 = tr_read<v_rd_off(D0, 0, 0)>(vb), h0 = tr_read<v_rd_off(D0, 0, 1)>(vb), l1 = tr_read<v_rd_off(D0, 1, 0)>(vb), h1 = tr_read<v_rd_off(D0, 1, 1)>(vb);
    const s16x4 l2 = tr_read<v_rd_off(D0, 2, 0)>(vb), h2 = tr_read<v_rd_off(D0, 2, 1)>(vb), l3 = tr_read<v_rd_off(D0, 3, 0)>(vb), h3 = tr_read<v_rd_off(D0, 3, 1)>(vb);
    asm volatile("s_waitcnt lgkmcnt(0)" ::: "memory"); SBAR();
#define PK(L, H) (bf16x8){L[0], L[1], L[2], L[3], H[0], H[1], H[2], H[3]}
    od = MFMA32(pa0, PK(l0, h0), od);
    od = MFMA32(pa1, PK(l1, h1), od);
    od = MFMA32(pa2, PK(l2, h2), od);
    od = MFMA32(pa3, PK(l3, h3), od);
#undef PK
}
__device__ __forceinline__ void pv_d0(f32x16 (&o)[4], int vb, bf16x8 pa0, bf16x8 pa1, bf16x8 pa2, bf16x8 pa3) {
    pv_one<0>(o[0], vb, pa0, pa1, pa2, pa3); pv_one<1>(o[1], vb, pa0, pa1, pa2, pa3); pv_one<2>(o[2], vb, pa0, pa1, pa2, pa3); pv_one<3>(o[3], vb, pa0, pa1, pa2, pa3);
}
__device__ __forceinline__ void rope_pair(bf16x8& a, bf16x8& b, const f32x2* cs) {
    u32x4 ua = *reinterpret_cast<u32x4*>(&a), ub = *reinterpret_cast<u32x4*>(&b); u32x4 oa, ob;
#pragma unroll
    for (int j = 0; j < 4; ++j) { const f32x2 c0 = cs[2 * j], c1 = cs[2 * j + 1];
        const float x1l = bflo(ua[j]), x1h = bfhi(ua[j]), x2l = bflo(ub[j]), x2h = bfhi(ub[j]);
        oa[j] = cvt_pk_bf16(x1l * c0.x - x2l * c0.y, x1h * c1.x - x2h * c1.y);
        ob[j] = cvt_pk_bf16(x2l * c0.x + x1l * c0.y, x2h * c1.x + x1h * c1.y); }
    a = *reinterpret_cast<bf16x8*>(&oa); b = *reinterpret_cast<bf16x8*>(&ob);
}
__device__ __forceinline__ void unit(Frame& F, int h, int qrow0, int nkeys) {
    LAS unsigned char* lds = F.lds;
    PHASE_IDS(); const int wid = wave, r32 = lane & 31, hi = lane >> 5;
    const bf16* QB = (const bf16*)(F.ws + WS_QB); const bf16* KVB = (const bf16*)(F.ws + WS_KVB); const bf16* KR = (const bf16*)(F.ws + WS_KR);
    LAS unsigned char* V_lds = lds + A_V; LAS unsigned char* K_lds = lds + A_K;
    LAS float* wsl = (LAS float*)(lds + A_WS) + wid * 64; LAS float* li_l = wsl; LAS float* al_l = wsl + 32;
    float m_reg = -1e30f, l_reg = 0; f32x16 o[4] = {}; bf16x8 qr[12];
    const int qt = qrow0 + wid * 32 + r32;
    const bf16* Qw = QB + (size_t)qt * 3072 + 192 * h + hi * 8;
#pragma unroll
    for (int d0 = 0; d0 < 12; ++d0) qr[d0] = *(const bf16x8*)(Qw + d0 * 16);
    if (qt >= NCTX) { const int pp = qt - NCTX;
        rope_pair(qr[8], qr[9], (const f32x2*)(F.ws + WS_AXR) + (pp >> 6) * 16 + hi * 8);
        rope_pair(qr[10], qr[11], (const f32x2*)(F.ws + WS_AXC) + (pp & 63) * 16 + hi * 8); }
    const unsigned char* wsb = F.ws;
    unsigned koff[3], kfl = 0u; int kdst[3];
#pragma unroll
    for (int i = 0; i < 3; ++i) { const int id = tid + 512 * i, row = id / 24, g = id % 24;
        if (g < 16) { koff[i] = (unsigned)WS_KVB + (unsigned)(row * 4096 + 256 * h + g * 8) * 2u; kfl |= 1u << i; } else { koff[i] = (unsigned)WS_KR + (unsigned)(row * 64 + (g - 16) * 8) * 2u; }
        kdst[i] = kswz(row, g); }
    const int sr = tid >> 4, sc = (tid & 15) * 8, vst0 = v_st(sr, sc);
    const unsigned voff = (unsigned)WS_KVB + (unsigned)(sr * 4096 + 256 * h + 128 + sc) * 2u;
    const int vb0 = (int)(unsigned)(uintptr_t)V_lds + v_rd_base(lane);
    int kx[4];
#pragma unroll
    for (int q = 0; q < 4; ++q) kx[q] = r32 * 384 + ((((2 * q) | hi) ^ ((r32 >> 1) & 7)) << 4);
    bf16x8 sk0, sk1, sk2, sv0, sv1;
#define SLOAD(jt) do { const unsigned vo_ = voff + (unsigned)(jt) * (64u * 4096u * 2u); sv0 = *(const bf16x8*)(wsb + vo_); sv1 = *(const bf16x8*)(wsb + vo_ + 32u * 4096u * 2u); \
    const unsigned kt_ = (unsigned)(jt) * 8192u; \
    sk0 = *(const bf16x8*)(wsb + koff[0] + (kt_ << ((kfl & 1u) * 6u))); sk1 = *(const bf16x8*)(wsb + koff[1] + (kt_ << (((kfl >> 1) & 1u) * 6u))); sk2 = *(const bf16x8*)(wsb + koff[2] + (kt_ << (((kfl >> 2) & 1u) * 6u))); } while (0)
#define SWRITE(b) do { *(LAS bf16x8*)(V_lds + (b) * SHM_V + vst0) = sv0; *(LAS bf16x8*)(V_lds + (b) * SHM_V + vst0 + 8192) = sv1; \
    *(LAS bf16x8*)(K_lds + (b) * SHM_K + kdst[0]) = sk0; *(LAS bf16x8*)(K_lds + (b) * SHM_K + kdst[1]) = sk1; *(LAS bf16x8*)(K_lds + (b) * SHM_K + kdst[2]) = sk2; } while (0)
#define SWAIT() asm volatile("s_waitcnt vmcnt(0)" ::: "memory")
#define RESC(a) do { if (__any((a) < 1.f)) { if (hi == 0) al_l[r32] = (a); asm volatile("s_waitcnt lgkmcnt(0)" ::: "memory"); \
    _Pragma("unroll") for (int d = 0; d < 4; ++d) _Pragma("unroll") for (int r = 0; r < 16; ++r) o[d][r] *= al_l[crow(r, hi)]; } } while (0)
    f32x16 p0, p1; float mn, al; bf16x8 pa0, pa1, pa2, pa3; const int NT = nkeys / KVBLK;
    SLOAD(0); SWAIT(); SWRITE(0); SLOAD(1); __syncthreads();
    for (int j = 0; j < NT; ++j) {
        const int buf = j & 1;
        if (j + 1 < NT) { SWAIT(); SWRITE(buf ^ 1); if (j + 2 < NT) SLOAD(j + 2); }
        SBAR(); qkt(p0, p1, K_lds + buf * SHM_K, qr, kx);
        partialSM(p0, p1, m_reg, mn, al);
        RESC(al);
        finishSM(p0, p1, al, l_reg, pa0, pa1, pa2, pa3); SBAR();
        pv_d0(o, vb0 + buf * SHM_V, pa0, pa1, pa2, pa3);
        __syncthreads();
    }
    if (hi == 0) li_l[r32] = l_reg; asm volatile("s_waitcnt lgkmcnt(0)" ::: "memory");
    float rli[16];
#pragma unroll
    for (int r = 0; r < 16; ++r) rli[r] = __builtin_amdgcn_rcpf(li_l[crow(r, hi)]);
    unsigned orow0 = (unsigned)(qrow0 + wid * 32) * DM + 128 * h; asm volatile("" : "+v"(orow0));
    bf16* Ow = (bf16*)(F.ws + WS_MIX) + orow0;
#pragma unroll
    for (int r = 0; r < 16; ++r) { const int orow = crow(r, hi);
#pragma unroll
        for (int d0 = 0; d0 < 4; ++d0) Ow[(size_t)orow * DM + d0 * 32 + r32] = f2bf(o[d0][r] * rli[r]); }
    __syncthreads();
#undef SLOAD
#undef SWRITE
#undef SWAIT
#undef RESC
}
}

__device__ __forceinline__ void attn_phase(Frame& F) {
    for (int i = 0; i < 5; ++i) {
        const int u = i * F.G + F.vcu; int h, q0, nk;
        if (i < 4) { if (u >= 1024) continue; h = u >> 6; q0 = NCTX + 256 * (u & 63); nk = T; } else { if (F.vcu >= 16) continue; h = F.vcu; q0 = 0; nk = NCTX; }
        att::unit(F, h, q0, nk);
    }
}


#ifdef DBG
constexpr int DBG_W_BAD = 64, DBG_W_SSQ = 65, DBG_W_CNT = 66, DBG_W_MAX = 67;
__device__ __forceinline__ void dbg_scan(Frame& F, int id, size_t off, size_t nbytes, bool is_bf) {
    PHASE_IDS();
    const u32x4* p = (const u32x4*)(F.ws + off); const size_t n = nbytes / 16; bool bad = false;
    for (size_t i = (size_t)F.vcu * NTHR + tid; i < n; i += (size_t)F.G * NTHR) { const u32x4 v = p[i];
#pragma unroll
        for (int j = 0; j < 4; ++j) { if (is_bf) { bad |= ((v[j] & 0x7f80u) == 0x7f80u) | ((v[j] & 0x7f800000u) == 0x7f800000u); } else bad |= ((v[j] & 0x7f800000u) == 0x7f800000u); } }
    if (__any(bad) && lane == 0) atomicMax((unsigned*)(F.ws + WS_CTL) + DBG_W_BAD, (unsigned)(100000 - id));
}
__device__ __forceinline__ void dbg_max(Frame& F, size_t off, size_t nbytes, bool is_bf) {
    PHASE_IDS();
    const u32x4* p = (const u32x4*)(F.ws + off); const size_t n = nbytes / 16; unsigned mx = 0u;
    for (size_t i = (size_t)F.vcu * NTHR + tid; i < n; i += (size_t)F.G * NTHR) { const u32x4 v = p[i];
#pragma unroll
        for (int j = 0; j < 4; ++j) { if (is_bf) { const unsigned a0 = (v[j] << 16) & 0x7fffffffu, a1 = v[j] & 0x7fff0000u; if (a0 < 0x7f800000u) mx = max(mx, a0); if (a1 < 0x7f800000u) mx = max(mx, a1); } else { const unsigned a0 = v[j] & 0x7fffffffu; if (a0 < 0x7f800000u) mx = max(mx, a0); } } }
#pragma unroll
    for (int o = 1; o < 64; o <<= 1) mx = max(mx, (unsigned)__shfl_xor((int)mx, o));
    if (lane == 0) atomicMax((unsigned*)(F.ws + WS_CTL) + DBG_W_MAX, mx);
}
#define DBGSCAN(id, off, nbytes, isbf) dbg_scan(F, (id), (off), (nbytes), (isbf))
#else
#define DBGSCAN(id, off, nbytes, isbf) do {} while (0)
#endif

__global__ void __launch_bounds__(NTHR, 2) fwd_kernel(Args args) {
    extern __shared__ __attribute__((aligned(16))) unsigned char lds_raw[];
    Frame F;
    F.lds = (LAS unsigned char*)lds_raw;
    F.G = gridDim.x; { const int bx = blockIdx.x; F.vcu = (F.G % 8 == 0) ? (bx % 8) * (F.G / 8) + bx / 8 : bx; }
    F.a = &args; F.ws = args.ws;
    volatile LAS unsigned* ctlw = (volatile LAS unsigned*)(F.lds + LDS_CTL);
    if (threadIdx.x < 16) ctlw[threadIdx.x] = 0u;
    __syncthreads();
    XcdBarrier bar = xcd_barrier_post((unsigned*)(F.ws + WS_CTL) + 4096, ctlw);
#define GRID_BAR() xcd_barrier(bar)

#ifndef SK_P0
    p0a(F);
#endif
    GRID_BAR();
    p0b(F); GRID_BAR();
    DBGSCAN(1, WS_MOD, (size_t)4 * 2 * NADA * 4, false);
    row_phase<0>(F, nullptr, nullptr, modp(F, 0, 0, 0), modp(F, 0, 0, 1), modp(F, 0, 1, 0), modp(F, 0, 1, 1)); GRID_BAR();
    DBGSCAN(2, WS_X, (size_t)T * DM * 4, false); DBGSCAN(3, WS_H, (size_t)T * DM * 2, true);

    const pg8::bf16_t* Hb = (const pg8::bf16_t*)(F.ws + WS_H);
    for (int s = 0; s < 3 * DEPTH; ++s) {
        const int l = s / 3, r = s % 3;
        const pg8::bf16_t* A2; const pg8::bf16_t* B2; int K2;
        if (r != 1) {
            const int f = r >> 1;
            pg8::Gemm g{Hb, (const pg8::bf16_t*)(F.ws + WS_WFI + (size_t)(l * 2 + f) * SZ_WFI), T, 2 * DFF, DM, DM, DM};
            pg8::StaticOrder S; S.init(T, 2 * DFF, F.G, (int)blockIdx.x);
            pg8::EpiSwiGLU E{(pg8::bf16_t*)(F.ws + WS_HID), DFF};
#ifndef SK_SW
            pg8::gemm_phase<pg8::EpiSwiGLU, pg8::StaticOrder>(F.lds, g, S, E);
#endif
            GRID_BAR();
            DBGSCAN(10 + 10 * s, WS_HID, (size_t)T * DFF * 2, true);
            A2 = (const pg8::bf16_t*)(F.ws + WS_HID); B2 = (const pg8::bf16_t*)(F.ws + WS_WFO + (size_t)(l * 2 + f) * SZ_WFO); K2 = DFF;
        } else if ((l & 1) == 0) {
            const int e = l >> 1;
            { pg8::Gemm g{Hb, (const pg8::bf16_t*)(F.ws + WS_EWI + (size_t)e * SZ_EWI), T, EV_N, DM, DM, DM};
              pg8::StaticOrder S; S.init(T, EV_N, F.G, (int)blockIdx.x);
              pg8::EpiBf16 E{(pg8::bf16_t*)(F.ws + WS_PROJ), EV_N};
#ifndef SK_G1
              pg8::gemm_phase<pg8::EpiBf16, pg8::StaticOrder>(F.lds, g, S, E);
#endif
            }
            GRID_BAR();
            DBGSCAN(10 + 10 * s, WS_PROJ, (size_t)T * EV_N * 2 - 0, true);
#ifdef DBG
            if (s == 1) dbg_max(F, WS_PROJ, (size_t)T * EV_N * 2, true);
#endif
#ifndef SK_S1
            s1_phase(F, e);
#endif
            GRID_BAR();
            DBGSCAN(11 + 10 * s, WS_U, SZ_U, true); DBGSCAN(16 + 10 * s, WS_OI, (size_t)T * DM * 4, false); DBGSCAN(17 + 10 * s, WS_QT, (size_t)2 * T * 1024 * 2, true); DBGSCAN(18 + 10 * s, WS_DEC, (size_t)2 * 8 * NCH * 128 * 4, false);
#ifndef SK_S2
            s2_phase(F);
#endif
            GRID_BAR();
            DBGSCAN(12 + 10 * s, WS_S, SZ_U, true);
#ifndef SK_S3
            s3_phase(F, e);
#endif
            GRID_BAR();
            DBGSCAN(13 + 10 * s, WS_MIX, (size_t)T * DM * 2, true);
            A2 = (const pg8::bf16_t*)(F.ws + WS_MIX); B2 = (const pg8::bf16_t*)(F.ws + WS_EWO + (size_t)e * SZ_SQ); K2 = DM;
        } else {
            const int o = l >> 1;
            { pg8::Gemm g{Hb, (const pg8::bf16_t*)(F.ws + WS_OWI + (size_t)o * SZ_OWI), T, OD_N, DM, DM, DM};
              pg8::StaticOrder S; S.init(T, OD_N, F.G, (int)blockIdx.x);
              pg8::EpiBf16 E{(pg8::bf16_t*)(F.ws + WS_PROJ), OD_N};
#ifndef SK_G2
              pg8::gemm_phase<pg8::EpiBf16, pg8::StaticOrder>(F.lds, g, S, E);
#endif
            }
            GRID_BAR();
#ifndef SK_E1
            e1_phase(F, o);
#endif
            GRID_BAR();
            DBGSCAN(11 + 10 * s, WS_CQN, (size_t)T * 512 * 2 * 2, true); DBGSCAN(11 + 10 * s, WS_KR, (size_t)T * 64 * 2, true);
            for (int q = 0; q < 2; ++q) {
                pg8::Gemm g{(const pg8::bf16_t*)(F.ws + (q ? WS_CKVN : WS_CQN)), (const pg8::bf16_t*)(F.ws + (q ? WS_OUKV + (size_t)o * SZ_OUKV : WS_OUQ + (size_t)o * SZ_OUQ)), T, q ? 4096 : 3072, 512, 512, 512};
                pg8::StaticOrder S; S.init(T, g.N, F.G, (int)blockIdx.x);
                pg8::EpiBf16 E{(pg8::bf16_t*)(F.ws + (q ? WS_KVB : WS_QB)), g.N};
#ifndef SK_G3
                pg8::gemm_phase<pg8::EpiBf16, pg8::StaticOrder>(F.lds, g, S, E);
#endif
            }
            GRID_BAR();
            DBGSCAN(12 + 10 * s, WS_QB, (size_t)T * 3072 * 2, true); DBGSCAN(12 + 10 * s, WS_KVB, (size_t)T * 4096 * 2, true);
#ifndef SK_ATT
            attn_phase(F);
#endif
            GRID_BAR();
            DBGSCAN(13 + 10 * s, WS_MIX, (size_t)T * DM * 2, true);
            A2 = (const pg8::bf16_t*)(F.ws + WS_MIX); B2 = (const pg8::bf16_t*)(F.ws + WS_OWO + (size_t)o * SZ_SQ); K2 = DM;
        }
        {
            pg8::Gemm g{A2, B2, T, DM, K2, K2, K2};
            pg8::StaticOrder S; S.init(T, DM, F.G, (int)blockIdx.x);
            pg8::EpiResid E{(float*)(F.ws + WS_X), modp(F, l, 0, 3 * r + 2), modp(F, l, 1, 3 * r + 2), (r != 1) ? 0.5f : 1.0f};
#ifndef SK_RES
            pg8::gemm_phase<pg8::EpiResid, pg8::StaticOrder>(F.lds, g, S, E);
#endif
        }
        GRID_BAR();
        DBGSCAN(14 + 10 * s, WS_X, (size_t)T * DM * 4, false);
        const float* lng = F.a->in[6] + (size_t)(l * 3 + r) * DM; const float* lnb = F.a->in[7] + (size_t)(l * 3 + r) * DM;
        if (s + 1 < 3 * DEPTH) { const int l2 = (s + 1) / 3, r2 = (s + 1) % 3;
            row_phase<1>(F, lng, lnb, modp(F, l2, 0, 3 * r2), modp(F, l2, 0, 3 * r2 + 1), modp(F, l2, 1, 3 * r2), modp(F, l2, 1, 3 * r2 + 1));
            GRID_BAR();
            DBGSCAN(15 + 10 * s, WS_X, (size_t)T * DM * 4, false); DBGSCAN(15 + 10 * s, WS_H, (size_t)T * DM * 2, true);
#if defined(DBG) && defined(DBG_STOP)
            if (s == DBG_STOP) break;
#endif
        } else {
#ifndef DBG
            row_phase<2>(F, lng, lnb, nullptr, nullptr, nullptr, nullptr);
#endif
        }
    }
#ifdef DBG
    {
        PHASE_IDS();
        const float* X = (const float*)(F.ws + WS_X); float ssq = 0.f; float cnt = 0.f;
        for (size_t i = (size_t)F.vcu * NTHR + tid; i < (size_t)T * DM; i += (size_t)F.G * NTHR) { const float v = X[i]; if ((__float_as_uint(v) & 0x7f800000u) != 0x7f800000u) { ssq += v * v; cnt += 1.f; } }
        ssq = wave_sum(ssq); cnt = wave_sum(cnt);
        if (lane == 0) { atomicAdd((float*)(F.ws + WS_CTL) + DBG_W_SSQ, ssq); atomicAdd((float*)(F.ws + WS_CTL) + DBG_W_CNT, cnt); }
        GRID_BAR();
        const unsigned badw = __hip_atomic_load((unsigned*)(F.ws + WS_CTL) + DBG_W_BAD, RLX_AGENT);
        const float tss = __hip_atomic_load((float*)(F.ws + WS_CTL) + DBG_W_SSQ, RLX_AGENT), tcn = __hip_atomic_load((float*)(F.ws + WS_CTL) + DBG_W_CNT, RLX_AGENT);
        const float rms = sqrtf(tss / fmaxf(tcn, 1.f)); float cB = fminf(10.f * rms, 1000.f);
#ifdef DBG_REPORT_MAX
        { const unsigned mw = __hip_atomic_load((unsigned*)(F.ws + WS_CTL) + DBG_W_MAX, RLX_AGENT); cB = fminf(log2f(1.0f + __uint_as_float(mw)), 120.f); }
#endif
        const float cA = badw ? (float)(100000u - badw) * 10.f : 5.f;
        float* out = F.a->out;
        for (size_t i = (size_t)F.vcu * NTHR + tid; i < (size_t)NLAT * DM; i += (size_t)F.G * NTHR) out[i] = (i == 12345) ? cA + 0.f : cB;
        (void)cA;
    }
#endif
}

extern "C" void kernel_launch(void* const* d_in, const int* in_sizes, int n_in, void* d_out, int out_size, void* d_ws, size_t ws_size, hipStream_t stream) {
    static int grid = 0;
    if (grid == 0) {
        if (n_in != 23 || out_size != NLAT * DM || ws_size < WS_END) { fprintf(stderr, "kernel_launch: unexpected shapes: n_in %d out %d ws %zu (need %zu)\n", n_in, out_size, ws_size, (size_t)WS_END); grid = -1; return; }
        int dev = 0, cus = 0, per_cu = 0;
        if (hipGetDevice(&dev) != hipSuccess || hipDeviceGetAttribute(&cus, hipDeviceAttributeMultiprocessorCount, dev) != hipSuccess) { grid = -1; return; }
        if (hipFuncSetAttribute((const void*)fwd_kernel, hipFuncAttributeMaxDynamicSharedMemorySize, LDS_BYTES) != hipSuccess) { fprintf(stderr, "kernel_launch: hipFuncSetAttribute failed\n"); grid = -1; return; }
        if (hipOccupancyMaxActiveBlocksPerMultiprocessor(&per_cu, (const void*)fwd_kernel, NTHR, LDS_BYTES) != hipSuccess || per_cu < 1) fprintf(stderr, "kernel_launch: occupancy query reports %d\n", per_cu);
        (void)hipGetLastError();
        grid = cus;
    }
    if (grid < 0) return;
    (void)hipMemsetAsync((char*)d_ws + WS_CTL, 0, CTL_BYTES, stream);
    Args a{};
    for (int i = 0; i < 23; ++i) a.in[i] = (const float*)d_in[i];
    a.out = (float*)d_out; a.ws = (unsigned char*)d_ws;
    hipLaunchKernelGGL(fwd_kernel, dim3(grid), dim3(NTHR), LDS_BYTES, stream, a);
    const hipError_t le = hipPeekAtLastError();
    if (le != hipSuccess) fprintf(stderr, "kernel_launch: launch failed: %s\n", hipGetErrorName(le));
}
```

```cpp
#include <hip/hip_runtime.h>
#include <cstdio>
#include <cstdint>

#define GAS __attribute__((address_space(1)))
#define LAS __attribute__((address_space(3)))
typedef unsigned short bf16;
typedef short bf16x8 __attribute__((ext_vector_type(8)));
typedef short s16x4 __attribute__((ext_vector_type(4)));
typedef float f32x4 __attribute__((ext_vector_type(4)));
typedef float f32x2 __attribute__((ext_vector_type(2)));
typedef float f32x16 __attribute__((ext_vector_type(16)));
typedef unsigned u32x4 __attribute__((ext_vector_type(4)));
typedef unsigned u32x2 __attribute__((ext_vector_type(2)));

constexpr int DM = 2048, NCTX = 256, NLAT = 16384, T = NCTX + NLAT, DEPTH = 4, DFF = 5504;
constexpr int NADA = 9 * DM;
constexpr int EV_N = 6400, OD_N = 1280;
constexpr int NCH = T / 64;
constexpr float DN_ALPHA = 1.6817928305074290f;
constexpr float LN_EPS = 1e-5f, RMS_EPS = 1e-6f;
constexpr int NWAVES = 8, NTHR = 512;
constexpr int LDS_BYTES = 147456;
constexpr int LDS_CTL = LDS_BYTES - 256;

constexpr size_t al256(size_t x) { return (x + 255) / 256 * 256; }
constexpr size_t WS_CTL = 0, CTL_BYTES = 1u << 20;
constexpr size_t WS_MODP = WS_CTL + CTL_BYTES;
constexpr size_t WS_MOD = WS_MODP + al256((size_t)8 * 2 * 4 * NADA * 4);
constexpr size_t WS_RT = WS_MOD + al256((size_t)4 * 2 * NADA * 4);
constexpr size_t WS_AXR = WS_RT + al256((size_t)NLAT * 64 * 8);
constexpr size_t WS_AXC = WS_AXR + al256(256 * 16 * 8);
constexpr size_t WS_STAT = WS_AXC + al256(64 * 16 * 8);
constexpr size_t WS_WFI = WS_STAT + al256((size_t)T * 8);
constexpr size_t SZ_WFI = (size_t)2 * DFF * DM * 2;
constexpr size_t WS_WFO = WS_WFI + 8 * SZ_WFI;
constexpr size_t SZ_WFO = (size_t)DM * DFF * 2;
constexpr size_t WS_EWI = WS_WFO + 8 * SZ_WFO;
constexpr size_t SZ_EWI = (size_t)EV_N * DM * 2;
constexpr size_t WS_EWO = WS_EWI + 2 * SZ_EWI;
constexpr size_t SZ_SQ = (size_t)DM * DM * 2;
constexpr size_t WS_OWI = WS_EWO + 2 * SZ_SQ;
constexpr size_t SZ_OWI = (size_t)OD_N * DM * 2;
constexpr size_t WS_OUQ = WS_OWI + 2 * SZ_OWI;
constexpr size_t SZ_OUQ = (size_t)3072 * 512 * 2;
constexpr size_t WS_OUKV = WS_OUQ + 2 * SZ_OUQ;
constexpr size_t SZ_OUKV = (size_t)4096 * 512 * 2;
constexpr size_t WS_OWO = WS_OUKV + 2 * SZ_OUKV;
constexpr size_t WS_X = WS_OWO + 2 * SZ_SQ;
constexpr size_t WS_H = WS_X + (size_t)T * DM * 4;
constexpr size_t WS_HID = WS_H + (size_t)T * DM * 2;
constexpr size_t WS_MIX = WS_HID + (size_t)T * DFF * 2;
constexpr size_t WS_PROJ = WS_MIX + (size_t)T * DM * 2;
constexpr size_t WS_U = WS_PROJ + (size_t)T * EV_N * 2;
constexpr size_t SZ_U = (size_t)2 * 8 * NCH * 256 * 128 * 2;
constexpr size_t WS_S = WS_U + SZ_U;
constexpr size_t WS_OI = WS_S + SZ_U;
constexpr size_t WS_QT = WS_OI + (size_t)T * DM * 4;
constexpr size_t WS_DEC = WS_QT + (size_t)2 * T * 1024 * 2;
constexpr size_t WS_END_EVEN = WS_DEC + al256((size_t)2 * 8 * NCH * 128 * 4);
constexpr size_t WS_CQN = WS_U;
constexpr size_t WS_CKVN = WS_CQN + (size_t)T * 512 * 2;
constexpr size_t WS_KR = WS_CKVN + (size_t)T * 512 * 2;
constexpr size_t WS_QB = WS_KR + al256((size_t)T * 64 * 2);
constexpr size_t WS_KVB = WS_QB + (size_t)T * 3072 * 2;
constexpr size_t WS_END_ODD = WS_KVB + (size_t)T * 4096 * 2;
constexpr size_t WS_END = WS_END_EVEN > WS_END_ODD ? WS_END_EVEN : WS_END_ODD;

#define RLX_AGENT __ATOMIC_RELAXED, __HIP_MEMORY_SCOPE_AGENT
#define LDS_WAIT() asm volatile("s_waitcnt lgkmcnt(0)" ::: "memory")
#define VM_WAIT() asm volatile("s_waitcnt vmcnt(0)" ::: "memory")
__device__ __forceinline__ unsigned cvt_pk_bf16(float lo, float hi) { unsigned r; asm volatile("v_cvt_pk_bf16_f32 %0, %1, %2" : "=v"(r) : "v"(lo), "v"(hi)); return r; }
__device__ __forceinline__ float bflo(unsigned w) { return __uint_as_float(w << 16); }
__device__ __forceinline__ float bfhi(unsigned w) { return __uint_as_float(w & 0xffff0000u); }
__device__ __forceinline__ float bf2f(bf16 b) { return __uint_as_float(((unsigned)b) << 16); }
__device__ __forceinline__ bf16 f2bf(float f) { return (bf16)(cvt_pk_bf16(f, 0.f) & 0xffffu); }
__device__ __forceinline__ float wave_sum(float v) {
#pragma unroll
    for (int o = 1; o < 64; o <<= 1) v += __shfl_xor(v, o);
    return v;
}
__device__ __forceinline__ float silu_f(float g) { return g * __builtin_amdgcn_rcpf(1.0f + __builtin_amdgcn_exp2f(-1.4426950408889634f * g)); }

namespace pg8 {
#define PG8_LAS __attribute__((address_space(3)))
typedef unsigned short bf16_t;
constexpr int BM = 256, BK = 64, HALF = 128, HTB = HALF * BK * 2, STAGE_BYTES = 8 * HTB, NXCD = 8, WGM = 8;
__host__ __device__ __forceinline__ int lds_byte(int r, int c) { const int st = (r >> 4) * 2 + (c >> 5), rr = r & 15, cc = c & 31, ob = rr * 64 + cc * 2; return st * 1024 + (ob ^ (((ob >> 9) & 1) << 5)); }
__host__ __device__ __forceinline__ void stage_rc(int b, int& R, int& C) { const int st = b / 1024, sb = b % 1024, swz = sb ^ (((sb >> 9) & 1) << 5); R = (st >> 1) * 16 + swz / 64; C = (st & 1) * 32 + (swz % 64) / 2; }
__host__ __device__ __forceinline__ int perm32(int rho) { const int n = rho >> 4, i = rho & 15; return 8 * (i >> 2) + 4 * n + (i & 3); }
struct Unit { int pm, pn; };
struct Gemm { const bf16_t* A; const bf16_t* Bt; int M, N, K, lda, ldb; };
struct StaticOrder {
    int nM, nN, nwg, G, c;
    __host__ __device__ void init(int M, int N, int G_, int c_) { nM = M / BM; nN = N / BM; nwg = nM * nN; G = G_; c = c_; }
    __host__ __device__ bool next(int i, Unit& u) const {
        const long L = (long)i * G + c; if (L >= nwg) return false;
        int wgid = (int)L; { const int q = nwg / NXCD, r = nwg % NXCD, xcd = wgid % NXCD, off = wgid / NXCD; wgid = (xcd < r ? xcd * (q + 1) : r * (q + 1) + (xcd - r) * q) + off; }
        const int nig = WGM * nN, gid = wgid / nig, fm = gid * WGM, gsz = (nM - fm) < WGM ? (nM - fm) : WGM;
        u.pm = fm + ((wgid % nig) % gsz); u.pn = (wgid % nig) / gsz; return true;
    }
    __device__ __forceinline__ void a_ready(const Unit&) const {}
    __device__ __forceinline__ void done(const Unit&) const {}
};
struct EpiBf16 {
    static constexpr bool PERM = true;
    bf16_t* O; int ldc;
    __device__ __forceinline__ void operator()(const f32x4 (&acc)[2][2][4][2], const Unit& u, int wr, int wc, int fr, int fq) const {
        const int row0 = u.pm * BM + wr * 64 + fr, col0 = u.pn * BM + wc * 32 + 8 * fq;
        asm volatile("s_nop 15" ::: "memory");
#pragma unroll
        for (int ai = 0; ai < 2; ++ai)
#pragma unroll
            for (int m = 0; m < 4; ++m) { bf16_t* rowp = O + (size_t)(row0 + ai * HALF + m * 16) * ldc + col0;
#pragma unroll
                for (int bj = 0; bj < 2; ++bj) { const f32x4 v0 = acc[ai][bj][m][0], v1 = acc[ai][bj][m][1];
                    u32x4 w; w.x = cvt_pk_bf16(v0[0], v0[1]); w.y = cvt_pk_bf16(v0[2], v0[3]); w.z = cvt_pk_bf16(v1[0], v1[1]); w.w = cvt_pk_bf16(v1[2], v1[3]);
                    *(u32x4*)(rowp + bj * HALF) = w; } }
    }
};
struct EpiSwiGLU {
    static constexpr bool PERM = true;
    bf16_t* O; int ldc;
    __device__ __forceinline__ void operator()(const f32x4 (&acc)[2][2][4][2], const Unit& u, int wr, int wc, int fr, int fq) const {
        const int row0 = u.pm * BM + wr * 64 + fr, col0 = u.pn * HALF + wc * 32 + 8 * fq;
#pragma unroll
        for (int ai = 0; ai < 2; ++ai)
#pragma unroll
            for (int m = 0; m < 4; ++m) { bf16_t* rowp = O + (size_t)(row0 + ai * HALF + m * 16) * ldc + col0;
                float h[8];
#pragma unroll
                for (int n = 0; n < 2; ++n)
#pragma unroll
                    for (int j = 0; j < 4; ++j) h[n * 4 + j] = silu_f(acc[ai][0][m][n][j]) * acc[ai][1][m][n][j];
                u32x4 w; w.x = cvt_pk_bf16(h[0], h[1]); w.y = cvt_pk_bf16(h[2], h[3]); w.z = cvt_pk_bf16(h[4], h[5]); w.w = cvt_pk_bf16(h[6], h[7]);
                *(u32x4*)rowp = w; asm volatile("" ::: "memory"); }
    }
};
struct EpiResid {
    static constexpr bool PERM = false;
    float* X; const float* gv; float gs; const float* stat; const float* lng; const float* lnb; int has_ln;
    __device__ __forceinline__ void operator()(const f32x4 (&acc)[2][2][4][2], const Unit& u, int wr, int wc, int fr, int fq) const {
        const int row0 = u.pm * BM + wr * 64 + fr, col0 = u.pn * BM + wc * 32 + 4 * fq;
        f32x2 st[2][4];
#pragma unroll
        for (int ai = 0; ai < 2; ++ai)
#pragma unroll
            for (int m = 0; m < 4; ++m) { st[ai][m] = has_ln ? *(const f32x2*)(stat + (size_t)(row0 + ai * HALF + m * 16) * 2) : (f32x2){0.f, 1.f}; st[ai][m].y *= DN_ALPHA; }
#pragma unroll
        for (int bj = 0; bj < 2; ++bj)
#pragma unroll
            for (int n = 0; n < 2; ++n) { const int c = col0 + bj * HALF + n * 16;
                const f32x4 g = *(const f32x4*)(gv + c) * gs;
                const f32x4 G = has_ln ? *(const f32x4*)(lng + c) : (f32x4){1.f, 1.f, 1.f, 1.f}, B = has_ln ? *(const f32x4*)(lnb + c) * DN_ALPHA : (f32x4){0.f, 0.f, 0.f, 0.f};
#pragma unroll
                for (int ai = 0; ai < 2; ++ai)
#pragma unroll
                    for (int m = 0; m < 4; ++m) { float* p = X + (size_t)(row0 + ai * HALF + m * 16) * DM + c;
                        const f32x4 z = *(const f32x4*)p; *(f32x4*)p = (z - st[ai][m].x) * st[ai][m].y * G + B + g * acc[ai][bj][m][n]; }
                asm volatile("" ::: "memory"); }
    }
};

template <class Epi, class Sched, bool ALIGN_EPI = true, bool SP2 = true>
__device__ __forceinline__ void gemm_phase(PG8_LAS unsigned char* lds, const Gemm g, const Sched& S, const Epi& E) {
    int tid = threadIdx.x; asm volatile("" : "+v"(tid));
    const int wid = __builtin_amdgcn_readfirstlane(tid >> 6), lane = tid & 63, wr = wid >> 2, wc = wid & 3, fr = lane & 15, fq = lane >> 4;
    const int K = g.K, nt = K / BK;
    unsigned voffA[2], voffB[2];
#pragma unroll
    for (int i = 0; i < 2; ++i) { int R, C; stage_rc(tid * 16 + i * 8192, R, C); const int Rb = Epi::PERM ? ((R & ~31) + perm32(R & 31)) : R;
        voffA[i] = (unsigned)(R * g.lda + C) * 2u; voffB[i] = (unsigned)(Rb * g.ldb + C) * 2u; }
    const size_t kstep = (size_t)(BK * 2);
    const size_t hstepA = (size_t)HALF * g.lda * 2, hstepB = (size_t)HALF * g.ldb * 2;
    const size_t tstepA = 2 * hstepA, tstepB = 2 * hstepB;
    const unsigned ldsw = (unsigned)wid * 1024u;
    const int aoff = lds_byte(wr * 64 + fr, fq * 8), boff = lds_byte(wc * 32 + fr, fq * 8);
#define PG8_SA(b, h) (((b) * 2 + (h)) * HTB)
#define PG8_SB(b, h) ((4 + (b) * 2 + (h)) * HTB)
#define PG8_STAGE(bufoff, gbase, voff) do { _Pragma("unroll") for (int _i = 0; _i < 2; ++_i) \
        __builtin_amdgcn_global_load_lds((const unsigned*)((const char*)(gbase) + (voff)[_i]), (PG8_LAS unsigned*)(lds + (bufoff) + ldsw + _i * 8192), 16, 0, 0); } while (0)
#define PG8_LDA(dst, b, h) do { _Pragma("unroll") for (int m = 0; m < 4; ++m) _Pragma("unroll") for (int k = 0; k < 2; ++k) dst[m][k] = *(const PG8_LAS bf16x8*)(lds + PG8_SA(b, h) + aoff + m * 2048 + k * 1024); } while (0)
#define PG8_LDB(dst, b, h) do { _Pragma("unroll") for (int n = 0; n < 2; ++n) _Pragma("unroll") for (int k = 0; k < 2; ++k) dst[n][k] = *(const PG8_LAS bf16x8*)(lds + PG8_SB(b, h) + boff + n * 2048 + k * 1024); } while (0)
#define PG8_MMA(ai, bj, At, Bt) do { __builtin_amdgcn_s_setprio(1); _Pragma("unroll") for (int m = 0; m < 4; ++m) _Pragma("unroll") for (int n = 0; n < 2; ++n) _Pragma("unroll") for (int k = 0; k < 2; ++k) \
        acc[ai][bj][m][n] = __builtin_amdgcn_mfma_f32_16x16x32_bf16(Bt[n][k], At[m][k], acc[ai][bj][m][n], 0, 0, 0); __builtin_amdgcn_s_setprio(0); } while (0)
#define PG8_WAIT_V(n) asm volatile("s_waitcnt vmcnt(" #n ")" ::: "memory")
#define PG8_WAIT_L(n) asm volatile("s_waitcnt lgkmcnt(" #n ")" ::: "memory")
#define PG8_BAR __builtin_amdgcn_s_barrier()
#define PG8_SCHED __builtin_amdgcn_sched_barrier(0)
    Unit cur, nxt; int ui = 0;
    if (!S.next(0, cur)) return;
    f32x4 acc[2][2][4][2];
#pragma unroll
    for (int a = 0; a < 2; ++a)
#pragma unroll
        for (int b = 0; b < 2; ++b)
#pragma unroll
            for (int m = 0; m < 4; ++m)
#pragma unroll
                for (int n = 0; n < 2; ++n) acc[a][b][m][n] = (f32x4){0.f, 0.f, 0.f, 0.f};
    bf16x8 At[4][2], B0[2][2], B1[2][2];
    const char* cA = (const char*)g.A + (size_t)cur.pm * tstepA; const char* cB = (const char*)g.Bt + (size_t)cur.pn * tstepB;
    S.a_ready(cur);
    if constexpr (SP2) {
        PG8_STAGE(PG8_SB(0, 0), cB, voffB); PG8_STAGE(PG8_SB(0, 1), cB + hstepB, voffB); PG8_STAGE(PG8_SA(0, 0), cA, voffA); PG8_STAGE(PG8_SA(0, 1), cA + hstepA, voffA);
        if (wr == 1) PG8_BAR;
        PG8_WAIT_V(2); PG8_BAR;
        PG8_STAGE(PG8_SB(1, 0), cB + kstep, voffB); PG8_STAGE(PG8_SA(1, 0), cA + kstep, voffA); PG8_STAGE(PG8_SB(1, 1), cB + hstepB + kstep, voffB);
        PG8_WAIT_V(6); PG8_BAR;
    } else {
        PG8_STAGE(PG8_SB(0, 0), cB, voffB); PG8_STAGE(PG8_SA(0, 0), cA, voffA); PG8_STAGE(PG8_SB(0, 1), cB + hstepB, voffB); PG8_STAGE(PG8_SA(0, 1), cA + hstepA, voffA);
        if (wr == 1) PG8_BAR;
        PG8_WAIT_V(4); PG8_BAR;
        PG8_STAGE(PG8_SB(1, 0), cB + kstep, voffB); PG8_STAGE(PG8_SA(1, 0), cA + kstep, voffA); PG8_STAGE(PG8_SB(1, 1), cB + hstepB + kstep, voffB);
        PG8_WAIT_V(6); PG8_BAR;
    }
    for (;;) {
        const bool has_next = S.next(ui + 1, nxt);
        const char* nA = has_next ? (const char*)g.A + (size_t)nxt.pm * tstepA : cA; const char* nB = has_next ? (const char*)g.Bt + (size_t)nxt.pn * tstepB : cB;
        for (int t = 0; t < nt; t += 2) {
            const bool last = (t == nt - 2);
            const char* a1 = cA + (size_t)(t + 1) * kstep;
            const char* a2 = last ? nA : cA + (size_t)(t + 2) * kstep; const char* b2 = last ? nB : cB + (size_t)(t + 2) * kstep;
            const char* a3 = a2 + kstep; const char* b3 = b2 + kstep;
            if (last && has_next) S.a_ready(nxt);
            if constexpr (SP2) {
            PG8_LDB(B0, 0, 0); PG8_LDB(B1, 0, 1); PG8_SCHED; PG8_LDA(At, 0, 0); PG8_STAGE(PG8_SA(1, 1), a1 + hstepA, voffA);
            PG8_WAIT_V(8); PG8_WAIT_L(0); PG8_BAR; PG8_MMA(0, 0, At, B0); PG8_MMA(0, 1, At, B1); PG8_BAR; PG8_SCHED;
            PG8_LDA(At, 0, 1); PG8_STAGE(PG8_SB(0, 0), b2, voffB); PG8_STAGE(PG8_SB(0, 1), b2 + hstepB, voffB); PG8_STAGE(PG8_SA(0, 0), a2, voffA);
            PG8_WAIT_V(8); PG8_WAIT_L(0); PG8_BAR; PG8_MMA(1, 0, At, B0); PG8_MMA(1, 1, At, B1); PG8_BAR; PG8_SCHED;
            PG8_LDB(B0, 1, 0); PG8_LDB(B1, 1, 1); PG8_SCHED; PG8_LDA(At, 1, 0); PG8_STAGE(PG8_SA(0, 1), a2 + hstepA, voffA);
            PG8_WAIT_V(8); PG8_WAIT_L(0); PG8_BAR; PG8_MMA(0, 0, At, B0); PG8_MMA(0, 1, At, B1); PG8_BAR; PG8_SCHED;
            PG8_LDA(At, 1, 1); PG8_STAGE(PG8_SB(1, 0), b3, voffB); PG8_STAGE(PG8_SB(1, 1), b3 + hstepB, voffB); PG8_STAGE(PG8_SA(1, 0), a3, voffA);
            PG8_WAIT_V(8); PG8_WAIT_L(0); PG8_BAR; PG8_MMA(1, 0, At, B0); PG8_MMA(1, 1, At, B1); PG8_BAR; PG8_SCHED;
            } else {
            PG8_LDB(B0, 0, 0); PG8_SCHED; PG8_LDA(At, 0, 0); PG8_STAGE(PG8_SA(1, 1), a1 + hstepA, voffA);
            PG8_WAIT_L(8); PG8_BAR; PG8_WAIT_L(0); PG8_MMA(0, 0, At, B0); PG8_BAR; PG8_SCHED;
            PG8_LDB(B1, 0, 1); PG8_STAGE(PG8_SB(0, 0), b2, voffB);
            PG8_BAR; PG8_WAIT_L(0); PG8_MMA(0, 1, At, B1); PG8_BAR;
            PG8_LDA(At, 0, 1); PG8_STAGE(PG8_SA(0, 0), a2, voffA);
            PG8_BAR; PG8_WAIT_L(0); PG8_MMA(1, 0, At, B0); PG8_BAR; PG8_SCHED;
            PG8_STAGE(PG8_SB(0, 1), b2 + hstepB, voffB);
            PG8_WAIT_V(6); PG8_BAR; PG8_MMA(1, 1, At, B1); PG8_BAR;
            PG8_LDB(B0, 1, 0); PG8_SCHED; PG8_LDA(At, 1, 0); PG8_STAGE(PG8_SA(0, 1), a2 + hstepA, voffA);
            PG8_WAIT_L(8); PG8_BAR; PG8_WAIT_L(0); PG8_MMA(0, 0, At, B0); PG8_BAR; PG8_SCHED;
            PG8_LDB(B1, 1, 1); PG8_STAGE(PG8_SB(1, 0), b3, voffB);
            PG8_BAR; PG8_WAIT_L(0); PG8_MMA(0, 1, At, B1); PG8_BAR;
            PG8_LDA(At, 1, 1); PG8_STAGE(PG8_SA(1, 0), a3, voffA);
            PG8_BAR; PG8_WAIT_L(0); PG8_MMA(1, 0, At, B0); PG8_BAR; PG8_SCHED;
            PG8_STAGE(PG8_SB(1, 1), b3 + hstepB, voffB);
            PG8_WAIT_V(6); PG8_BAR; PG8_MMA(1, 1, At, B1); PG8_BAR;
            }
        }
        if constexpr (ALIGN_EPI) { if (wr == 0) PG8_BAR; }
        E(acc, cur, wr, wc, fr, fq); S.done(cur);
        if (!has_next) break;
#pragma unroll
        for (int a = 0; a < 2; ++a)
#pragma unroll
            for (int b = 0; b < 2; ++b)
#pragma unroll
                for (int m = 0; m < 4; ++m)
#pragma unroll
                    for (int n = 0; n < 2; ++n) acc[a][b][m][n] = (f32x4){0.f, 0.f, 0.f, 0.f};
        cur = nxt; cA = nA; cB = nB; ++ui;
        if constexpr (ALIGN_EPI) { if (wr == 1) PG8_BAR; }
    }
    PG8_WAIT_V(0);
    if constexpr (!ALIGN_EPI) { if (wr == 0) PG8_BAR; }
    PG8_BAR;
#undef PG8_SA
#undef PG8_SB
#undef PG8_STAGE
#undef PG8_LDA
#undef PG8_LDB
#undef PG8_MMA
#undef PG8_WAIT_V
#undef PG8_WAIT_L
#undef PG8_BAR
#undef PG8_SCHED
}
}

#define XB_TMO      128
#define XB_XCNT(j)  (256  + 64 * (j))
#define XB_XSUB(j)  (1280 + 64 * (j))
#define XB_XGEN(j)  (2304 + 64 * (j))
#define XB_TOP      3328
#define XB_TOPGEN   3392
#define XCD_BAR_WORDS 3456
#define XB_SPIN_CAP (1u << 18)
__device__ __forceinline__ unsigned xb_ld(unsigned* p)              { return __hip_atomic_load(p, __ATOMIC_RELAXED, __HIP_MEMORY_SCOPE_AGENT); }
__device__ __forceinline__ unsigned xb_add(unsigned* p, unsigned v) { return __hip_atomic_fetch_add(p, v, __ATOMIC_RELAXED, __HIP_MEMORY_SCOPE_AGENT); }
__device__ __forceinline__ unsigned xb_xcc_id() { return (unsigned)__builtin_amdgcn_s_getreg((3 << 11) | 20) & 0xFu; }
#define XB_SPIN(cond, bar) do { unsigned _sp = 0; while (cond) { __builtin_amdgcn_s_sleep(1); \
    if ((++_sp & 255u) == 0u) { if (xb_ld(&(bar)[XB_TMO])) break; if (_sp > XB_SPIN_CAP) { atomicAdd(&(bar)[XB_TMO], 1u); break; } } } } while (0)
struct XcdBarrier { unsigned* bar; unsigned x; volatile LAS unsigned* st; };
__device__ __forceinline__ XcdBarrier xcd_barrier_post(unsigned* bar, volatile LAS unsigned* st) {
    XcdBarrier b; b.bar = bar; b.x = xb_xcc_id(); b.st = st;
    if (threadIdx.x == 0) (void)xb_add(&bar[XB_XCNT(b.x)], 1u);
    return b;
}
__device__ __forceinline__ void xcd_barrier_complete(unsigned* bar, unsigned x, unsigned& nloc, unsigned& nx) {
    const unsigned G = gridDim.x * gridDim.y * gridDim.z;
    unsigned sum, cnt, mine, sp = 0u;
    for (;;) {
        sum = 0u; cnt = 0u; mine = 0u;
#pragma unroll
        for (unsigned j = 0; j < 16; ++j) { const unsigned c = xb_ld(&bar[XB_XCNT(j)]); sum += c; cnt += (c > 0u) ? 1u : 0u; mine = (j == x) ? c : mine; }
        if (sum == G) break;
        __builtin_amdgcn_s_sleep(1);
        if ((++sp & 255u) == 0u) { if (xb_ld(&bar[XB_TMO])) break; if (sp > XB_SPIN_CAP) { atomicAdd(&bar[XB_TMO], 1u); break; } }
    }
    nloc = mine > 0u ? mine : 1u; nx = cnt > 0u ? cnt : 1u;
}
__device__ __forceinline__ void xcd_barrier(const XcdBarrier& b0) {
    asm volatile("s_waitcnt vmcnt(0)" ::: "memory");
    __syncthreads();
    if (threadIdx.x == 0) {
        XcdBarrier b = b0; b.x = xb_xcc_id();
        unsigned* bar = b.bar;
        __builtin_amdgcn_s_waitcnt(0);
        unsigned nloc = b.st[0], nx = b.st[1];
        if (nloc == 0u) { xcd_barrier_complete(bar, b.x, nloc, nx); b.st[0] = nloc; b.st[1] = nx; }
        const unsigned old = xb_add(&bar[XB_XSUB(b.x)], 1u);
        const unsigned gen = old / nloc;
        if (old + 1u == (gen + 1u) * nloc) {
            __builtin_amdgcn_fence(__ATOMIC_RELEASE, "agent");
            asm volatile("s_waitcnt vmcnt(0)" ::: "memory");
            const unsigned og = xb_add(&bar[XB_TOP], 1u);
            const unsigned tg = og / nx;
            if (og + 1u == (tg + 1u) * nx) xb_add(&bar[XB_TOPGEN], 1u);
            else XB_SPIN(xb_ld(&bar[XB_TOPGEN]) == tg, bar);
            __builtin_amdgcn_fence(__ATOMIC_ACQUIRE, "agent");
            xb_add(&bar[XB_XGEN(b.x)], 1u);
            asm volatile("s_waitcnt vmcnt(0)" ::: "memory");
        } else {
            XB_SPIN(xb_ld(&bar[XB_XGEN(b.x)]) == gen, bar);
            __builtin_amdgcn_fence(__ATOMIC_ACQUIRE, "agent");
            asm volatile("s_waitcnt vmcnt(0)" ::: "memory");
        }
    }
    __syncthreads();
}

struct Args { const float* in[23]; float* out; unsigned char* ws; };
struct Frame {
    LAS unsigned char* lds;
    int vcu, G;
    const Args* a; unsigned char* ws;
};
#define PHASE_IDS() int tid = threadIdx.x; asm volatile("" : "+v"(tid)); const int lane = tid & 63, wave = __builtin_amdgcn_readfirstlane(tid >> 6); (void)lane; (void)wave
#define MFMA16(a, b, c) __builtin_amdgcn_mfma_f32_16x16x32_bf16((a), (b), (c), 0, 0, 0)
#define MFMA32(a, b, c) __builtin_amdgcn_mfma_f32_32x32x16_bf16((a), (b), (c), 0, 0, 0)

__device__ __forceinline__ void tr_item(const float* W, int N, int K, bf16* WT, int k0, int n0, int drow0, LAS float* scr, int lane) {
#pragma unroll 8
    for (int i = 0; i < 32; ++i) { const int kk = 2 * i + (lane >> 5); scr[kk * 33 + (lane & 31)] = W[(size_t)(k0 + kk) * N + n0 + (lane & 31)]; }
    LDS_WAIT(); asm volatile("" ::: "memory");
    const int c = lane & 7;
#pragma unroll
    for (int j = 0; j < 4; ++j) { const int n = (lane >> 3) + 8 * j; const LAS float* s = scr + (8 * c) * 33 + n;
        u32x4 o; o.x = cvt_pk_bf16(s[0 * 33], s[1 * 33]); o.y = cvt_pk_bf16(s[2 * 33], s[3 * 33]); o.z = cvt_pk_bf16(s[4 * 33], s[5 * 33]); o.w = cvt_pk_bf16(s[6 * 33], s[7 * 33]);
        *(u32x4*)(WT + (size_t)(drow0 + n) * K + k0 + 8 * c) = o; }
    LDS_WAIT(); asm volatile("" ::: "memory");
}
__device__ __forceinline__ void p0a(Frame& F) {
    PHASE_IDS();
    LAS float* scr = (LAS float*)(F.lds + wave * 8704);
    LAS float* sv = (LAS float*)(F.lds + 8 * 8704);
    for (int i = tid; i < 2 * DM; i += NTHR) { const float v = (i < DM) ? F.a->in[1][i] : F.a->in[3][i - DM]; sv[i] = v / (1.0f + __expf(-v)); }
    __syncthreads();
    const int gw = F.vcu * NWAVES + wave, NGW = F.G * NWAVES;
    constexpr int I0 = 8 * 32 * 344, I1 = 8 * 86 * 64, I2 = 2 * 32 * 193, I3 = 2 * 32 * 64, I4 = 2 * 32 * 34, I5 = 2 * 8 * 96, I6 = 2 * 8 * 128, I7 = 2 * 32 * 64;
    constexpr int NTR = I0 + I1 + I2 + I3 + I4 + I5 + I6 + I7, NADAI = 8 * 288;
    for (int it = gw; it < NTR + NADAI; it += NGW) {
        int r = it;
        if (r < I0) { const int mat = r / 11008, q = r % 11008, kb = q / 344, nb = q % 344, n0 = nb * 32;
            const int j = n0 < DFF ? n0 : n0 - DFF, drow = (j / 128) * 256 + (j % 128) + (n0 < DFF ? 0 : 128);
            tr_item(F.a->in[8] + (size_t)mat * DM * 2 * DFF, 2 * DFF, DM, (bf16*)(F.ws + WS_WFI + mat * SZ_WFI), kb * 64, n0, drow - 0, scr, lane); continue; } r -= I0;
        if (r < I1) { const int mat = r / 5504, q = r % 5504, kb = q / 64, nb = q % 64;
            tr_item(F.a->in[9] + (size_t)mat * DFF * DM, DM, DFF, (bf16*)(F.ws + WS_WFO + mat * SZ_WFO), kb * 64, nb * 32, nb * 32, scr, lane); continue; } r -= I1;
        if (r < I2) { const int mat = r / 6176, q = r % 6176, kb = q / 193, nb = q % 193, n0 = nb * 32;
            const int drow = n0 < 3072 ? n0 : (n0 < 3104 ? 6144 : n0 - 32);
            tr_item(F.a->in[10] + (size_t)mat * DM * 6176, 6176, DM, (bf16*)(F.ws + WS_EWI + mat * SZ_EWI), kb * 64, n0, drow, scr, lane); continue; } r -= I2;
        if (r < I3) { const int mat = r / 2048, q = r % 2048, kb = q / 64, nb = q % 64;
            tr_item(F.a->in[16] + (size_t)mat * DM * DM, DM, DM, (bf16*)(F.ws + WS_EWO + mat * SZ_SQ), kb * 64, nb * 32, nb * 32, scr, lane); continue; } r -= I3;
        if (r < I4) { const int mat = r / 1088, q = r % 1088, kb = q / 34, nb = q % 34;
            tr_item(F.a->in[17] + (size_t)mat * DM * 1088, 1088, DM, (bf16*)(F.ws + WS_OWI + mat * SZ_OWI), kb * 64, nb * 32, nb * 32, scr, lane); continue; } r -= I4;
        if (r < I5) { const int mat = r / 768, q = r % 768, kb = q / 96, nb = q % 96;
            tr_item(F.a->in[20] + (size_t)mat * 512 * 3072, 3072, 512, (bf16*)(F.ws + WS_OUQ + mat * SZ_OUQ), kb * 64, nb * 32, nb * 32, scr, lane); continue; } r -= I5;
        if (r < I6) { const int mat = r / 1024, q = r % 1024, kb = q / 128, nb = q % 128;
            tr_item(F.a->in[21] + (size_t)mat * 512 * 4096, 4096, 512, (bf16*)(F.ws + WS_OUKV + mat * SZ_OUKV), kb * 64, nb * 32, nb * 32, scr, lane); continue; } r -= I6;
        if (r < I7) { const int mat = r / 2048, q = r % 2048, kb = q / 64, nb = q % 64;
            tr_item(F.a->in[22] + (size_t)mat * DM * DM, DM, DM, (bf16*)(F.ws + WS_OWO + mat * SZ_SQ), kb * 64, nb * 32, nb * 32, scr, lane); continue; } r -= I7;
        {
            const int ks = r / 288, cg = r % 288, l = cg / 72, n = (cg % 72) * 256 + lane * 4;
            const float* w = F.a->in[4] + ((size_t)l * DM + ks * 256) * NADA + n;
            f32x4 al = {0.f, 0.f, 0.f, 0.f}, ac = {0.f, 0.f, 0.f, 0.f};
#pragma unroll 8
            for (int k = 0; k < 256; ++k) { const f32x4 wv = *(const f32x4*)(w + (size_t)k * NADA); al += wv * sv[ks * 256 + k]; ac += wv * sv[DM + ks * 256 + k]; }
            float* mp = (float*)(F.ws + WS_MODP);
            *(f32x4*)(mp + (size_t)(ks * 2 + 0) * 4 * NADA + l * NADA + n) = al;
            *(f32x4*)(mp + (size_t)(ks * 2 + 1) * 4 * NADA + l * NADA + n) = ac;
        }
    }
    const int gt = F.vcu * NTHR + tid, NGT = F.G * NTHR;
    for (int i = gt; i < NLAT * 64 + 256 * 16 + 64 * 16; i += NGT) {
        int pos, fi; float inv; f32x2* dst;
        if (i < NLAT * 64) { pos = i >> 6; fi = i & 63; inv = __builtin_amdgcn_exp2f(-(float)fi * (13.287712379549449f / 64.0f)); dst = (f32x2*)(F.ws + WS_RT) + i; }
        else if (i < NLAT * 64 + 4096) { const int j = i - NLAT * 64; pos = j >> 4; fi = j & 15; inv = __builtin_amdgcn_exp2f(-(float)fi * (13.287712379549449f / 16.0f)); dst = (f32x2*)(F.ws + WS_AXR) + j; }
        else { const int j = i - NLAT * 64 - 4096; pos = j >> 4; fi = j & 15; inv = __builtin_amdgcn_exp2f(-(float)fi * (13.287712379549449f / 16.0f)); dst = (f32x2*)(F.ws + WS_AXC) + j; }
        const float ang = (float)pos * inv;
        double rev = (double)ang * 0.15915494309189535; rev -= __builtin_floor(rev);
        const float rv = (float)rev;
        *dst = (f32x2){__builtin_amdgcn_cosf(rv), __builtin_amdgcn_sinf(rv)};
    }
}
__device__ __forceinline__ void p0b(Frame& F) {
    PHASE_IDS();
    const int gt = F.vcu * NTHR + tid, NGT = F.G * NTHR;
    const float* mp = (const float*)(F.ws + WS_MODP); float* mo = (float*)(F.ws + WS_MOD);
    for (int i = gt; i < 4 * 2 * NADA; i += NGT) { const int l = i / (2 * NADA), v = (i / NADA) & 1, n = i % NADA;
        float s = F.a->in[5][l * NADA + n];
#pragma unroll
        for (int ks = 0; ks < 8; ++ks) s += mp[(size_t)(ks * 2 + v) * 4 * NADA + l * NADA + n];
        mo[i] = s; }
}
__device__ __forceinline__ const float* modp(Frame& F, int l, int v, int idx) { return (const float*)(F.ws + WS_MOD) + ((size_t)(l * 2 + v) * 9 + idx) * DM; }

template <int MODE>
__device__ __forceinline__ void row_phase(Frame& F, const float* lng, const float* lnb, const float* sh_l, const float* sc_l, const float* sh_c, const float* sc_c) {
    PHASE_IDS();
    LAS float* V = (LAS float*)F.lds;
    for (int i = tid; i < DM; i += NTHR) { if (MODE != 0) { V[i] = lng[i]; V[DM + i] = lnb[i]; } if (MODE != 2) { V[2 * DM + i] = sh_l[i]; V[3 * DM + i] = sc_l[i]; V[4 * DM + i] = sh_c[i]; V[5 * DM + i] = sc_c[i]; } }
    __syncthreads();
    const int gw = F.vcu * NWAVES + wave, NGW = F.G * NWAVES;
    float* X = (float*)(F.ws + WS_X); bf16* H = (bf16*)(F.ws + WS_H);
    for (int t = gw; t < T; t += NGW) {
        if (MODE == 2 && t < NCTX) continue;
        const float* src = (MODE == 0) ? (t < NCTX ? F.a->in[2] + (size_t)t * DM : F.a->in[0] + (size_t)(t - NCTX) * DM) : X + (size_t)t * DM;
        f32x4 v[8]; float s = 0.f; float mean_ = 0.f, rstd_ = 1.f;
#pragma unroll
        for (int j = 0; j < 8; ++j) { v[j] = *((const f32x4*)src + lane + 64 * j); s += (v[j].x + v[j].y) + (v[j].z + v[j].w); }
        if (MODE != 0) {
            const float mean = wave_sum(s) * (1.f / DM); float s2 = 0.f;
#pragma unroll
            for (int j = 0; j < 8; ++j) { v[j] = v[j] - mean; s2 += (v[j].x * v[j].x + v[j].y * v[j].y) + (v[j].z * v[j].z + v[j].w * v[j].w); }
            const float rstd = 1.f / sqrtf(wave_sum(s2) * (1.f / DM) + LN_EPS); mean_ = mean; rstd_ = rstd;
#pragma unroll
            for (int j = 0; j < 8; ++j) { const f32x4 g = *((const LAS f32x4*)V + lane + 64 * j), b = *((const LAS f32x4*)(V + DM) + lane + 64 * j); v[j] = v[j] * rstd * g + b; }
        }
        if (MODE == 1 && lane == 0) *(f32x2*)((float*)(F.ws + WS_STAT) + (size_t)t * 2) = (f32x2){mean_, rstd_};
        if (MODE == 2) {
            float* o = F.a->out + (size_t)(t - NCTX) * DM;
#pragma unroll
            for (int j = 0; j < 8; ++j) *((f32x4*)o + lane + 64 * j) = v[j];
        } else {
            float* o = X + (size_t)t * DM; bf16* h = H + (size_t)t * DM;
            const LAS float* shv = V + (t < NCTX ? 4 * DM : 2 * DM); const LAS float* scv = V + (t < NCTX ? 5 * DM : 3 * DM);
#pragma unroll
            for (int j = 0; j < 8; ++j) {
                const f32x4 sh = *((const LAS f32x4*)shv + lane + 64 * j), sc = *((const LAS f32x4*)scv + lane + 64 * j);
                const f32x4 m = v[j] * (sc + 1.0f) + sh; u32x2 w; w.x = cvt_pk_bf16(m.x, m.y); w.y = cvt_pk_bf16(m.z, m.w);
                *((u32x2*)h + lane + 64 * j) = w; }
        }
    }
    __syncthreads();
}


__device__ __forceinline__ void ctx_resid_small(Frame& F, float* X, const bf16* A, const bf16* Bt, int K, const float* gv, float gs, const float* stat, const float* lng, const float* lnb, int has_ln) {
    PHASE_IDS(); const int fr = lane & 15, fq = lane >> 4;
    const int nks = K >> 5, last = wave + 8 * ((nks - 1 - wave) >> 3), trips = (((nks + 7) >> 3) + 3) & ~3;
    for (int item = blockIdx.x; item < 256; item += F.G) {
        const int mt = item >> 5, nt = item & 31;
        f32x4 acc[2][4];
#pragma unroll
        for (int i = 0; i < 2; ++i)
#pragma unroll
            for (int j = 0; j < 4; ++j) acc[i][j] = (f32x4){0.f, 0.f, 0.f, 0.f};
        const bf16* Ap = A + (size_t)(32 * mt + fr) * K + 8 * fq;
        const bf16* Bp = Bt + (size_t)(64 * nt + fr) * K + 8 * fq;
        bf16x8 a0[2], b0[4], a1[2], b1[4], a2[2], b2[4], a3[2], b3[4];
#define CS_LOAD(a, b, i_) do { const int so_ = 32 * min(wave + 8 * (i_), last); _Pragma("unroll") for (int i = 0; i < 2; ++i) a[i] = *(const bf16x8*)(Ap + (size_t)(16 * i) * K + so_); \
        _Pragma("unroll") for (int i = 0; i < 4; ++i) b[i] = *(const bf16x8*)(Bp + (size_t)(16 * i) * K + so_); } while (0)
#define CS_MMA(a, b, i_) do { __builtin_amdgcn_sched_barrier(0); if (wave + 8 * (i_) < nks) { _Pragma("unroll") for (int i = 0; i < 2; ++i) _Pragma("unroll") for (int j = 0; j < 4; ++j) acc[i][j] = MFMA16(a[i], b[j], acc[i][j]); } __builtin_amdgcn_sched_barrier(0); } while (0)
        CS_LOAD(a0, b0, 0); CS_LOAD(a1, b1, 1); CS_LOAD(a2, b2, 2);
        for (int it = 0; it < trips; it += 4) {
            CS_LOAD(a3, b3, it + 3); CS_MMA(a0, b0, it);
            CS_LOAD(a0, b0, it + 4); CS_MMA(a1, b1, it + 1);
            CS_LOAD(a1, b1, it + 5); CS_MMA(a2, b2, it + 2);
            CS_LOAD(a2, b2, it + 6); CS_MMA(a3, b3, it + 3);
        }
#undef CS_LOAD
#undef CS_MMA
        LAS float* P = (LAS float*)F.lds + wave * 2048;
#pragma unroll
        for (int i = 0; i < 2; ++i)
#pragma unroll
            for (int j = 0; j < 4; ++j)
#pragma unroll
                for (int r = 0; r < 4; ++r) P[(16 * i + 4 * fq + r) * 64 + 16 * j + fr] = acc[i][j][r];
        __syncthreads();
        const int row = tid >> 4, c0 = (tid & 15) * 4;
        f32x4 s0 = {0.f, 0.f, 0.f, 0.f};
#pragma unroll
        for (int w = 0; w < 8; ++w) s0 += *(const LAS f32x4*)((LAS float*)F.lds + w * 2048 + row * 64 + c0);
        float* xp = X + (size_t)(32 * mt + row) * DM + 64 * nt + c0;
        const f32x4 g0 = *(const f32x4*)(gv + 64 * nt + c0) * gs;
        f32x4 x0 = *(const f32x4*)xp;
        if (has_ln) { const f32x2 st = *(const f32x2*)(stat + (size_t)(32 * mt + row) * 2); x0 = (x0 - st.x) * st.y * *(const f32x4*)(lng + 64 * nt + c0) + *(const f32x4*)(lnb + 64 * nt + c0); }
        *(f32x4*)xp = x0 * DN_ALPHA + g0 * s0;
        __syncthreads();
    }
}


__device__ __forceinline__ void init_x_by_owners(Frame& F) {
    PHASE_IDS();
    float* X = (float*)(F.ws + WS_X);
    pg8::StaticOrder S; S.init(NLAT, DM, F.G, (int)blockIdx.x); pg8::Unit u;
    for (int i = 0; S.next(i, u); ++i) {
        const int c4 = (tid & 63) * 4, r0 = tid >> 6;
#pragma unroll 4
        for (int rr = r0; rr < 256; rr += 8) { const size_t lr = (size_t)u.pm * 256 + rr; *(f32x4*)(X + (lr + NCTX) * DM + u.pn * 256 + c4) = *(const f32x4*)(F.a->in[0] + lr * DM + u.pn * 256 + c4); }
    }
    for (int item = blockIdx.x; item < 256; item += F.G) { const int mt = item >> 5, nt = item & 31, row = tid >> 4, c0 = (tid & 15) * 4;
        const size_t o = (size_t)(32 * mt + row) * DM + 64 * nt + c0; *(f32x4*)(X + o) = *(const f32x4*)(F.a->in[2] + o); }
}

constexpr int L1_QRAW = 0, L1_KRAW = 16384, L1_GD = 32768, L1_PART = 36864, L1_QT = 40960, L1_KT = 58368, L1_KTT = 75776, L1_VT = 94208, L1_P = 131072;
constexpr float INV_SQRT_DK = 0.08838834764831845f;

template <int DIR>
__device__ __forceinline__ void s1_dir(Frame& F, int e, int hh, int c, bool lat, f32x4 (&pacc)[2], const float (&wv)[16], const float bgv, const f32x2 (&csv)[16]) {
    const bool is_gla = hh < 4; const int hd = hh & 3, t0 = c * 64;
    PHASE_IDS(); const int w = wave, fr = lane & 15, fq = lane >> 4;
    LAS unsigned char* lds = F.lds;
    const int ch = tid & 127, tq = tid >> 7;
    float lgv[16];
    if (is_gla) {
#pragma unroll
        for (int i = 0; i < 16; ++i) { const int tt = 16 * tq + (DIR ? 15 - i : i);
            const u32x4 g0 = *(const LAS u32x4*)(lds + L1_GD + tt * 64 + DIR * 32), g1 = *(const LAS u32x4*)(lds + L1_GD + tt * 64 + DIR * 32 + 16);
            float x = bgv;
            x += bflo(g0.x) * wv[0] + bfhi(g0.x) * wv[1] + bflo(g0.y) * wv[2] + bfhi(g0.y) * wv[3] + bflo(g0.z) * wv[4] + bfhi(g0.z) * wv[5] + bflo(g0.w) * wv[6] + bfhi(g0.w) * wv[7];
            x += bflo(g1.x) * wv[8] + bfhi(g1.x) * wv[9] + bflo(g1.y) * wv[10] + bfhi(g1.y) * wv[11] + bflo(g1.z) * wv[12] + bfhi(g1.z) * wv[13] + bflo(g1.w) * wv[14] + bfhi(g1.w) * wv[15];
            lgv[i] = (fminf(x, 0.f) - __logf(1.0f + __expf(-fabsf(x)))) * (1.0f / 16.0f); }
    } else {
        const float lg = log1pf(-exp2f((DIR ? -5.5f : -5.0f) - (float)hd));
#pragma unroll
        for (int i = 0; i < 16; ++i) lgv[i] = lg;
    }
    float ls = 0.f;
#pragma unroll
    for (int i = 0; i < 16; ++i) ls += lgv[i];
    LAS float* part = (LAS float*)(lds + L1_PART);
    part[tq * 128 + ch] = ls;
    __syncthreads();
    float b = 0.f;
#pragma unroll
    for (int q = 0; q < 4; ++q) { const float pv = part[q * 128 + ch]; if (DIR ? (q > tq) : (q < tq)) b += pv; }
    bf16* QTg = (bf16*)(F.ws + WS_QT) + (size_t)DIR * T * 1024;
    float kt[16];
#pragma unroll
    for (int i = 0; i < 16; ++i) { const int tt = 16 * tq + (DIR ? 15 - i : i);
        b += lgv[i];
        float qv = bf2f(*(const LAS bf16*)(lds + L1_QRAW + tt * 256 + ch * 2)), kv = bf2f(*(const LAS bf16*)(lds + L1_KRAW + tt * 256 + ch * 2));
        if (!is_gla && lat) {
            const float qp = bf2f(*(const LAS bf16*)(lds + L1_QRAW + tt * 256 + (ch ^ 64) * 2)), kp = bf2f(*(const LAS bf16*)(lds + L1_KRAW + tt * 256 + (ch ^ 64) * 2));
            const f32x2 cs = csv[DIR ? 15 - i : i];
            if (ch < 64) { qv = qv * cs.x - qp * cs.y; kv = kv * cs.x - kp * cs.y; } else { qv = qv * cs.x + qp * cs.y; kv = kv * cs.x + kp * cs.y; }
        }
        const float eb = __expf(b), ebi = __expf(-b);
        const float qs = qv * eb * (is_gla ? INV_SQRT_DK : 1.0f), ks = kv * ebi * (is_gla ? 1.0f : INV_SQRT_DK);
        const bf16 qb = f2bf(qs);
        *(LAS bf16*)(lds + L1_QT + tt * 272 + ch * 2) = qb;
        *(LAS bf16*)(lds + L1_KT + tt * 272 + ch * 2) = f2bf(ks);
        kt[DIR ? 15 - i : i] = ks;
        if (i == 15 && tq == (DIR ? 0 : 3)) ((float*)(F.ws + WS_DEC))[((size_t)(DIR * 8 + hh) * NCH + c) * 128 + ch] = eb;
    }
    { u32x4 w0, w1; w0.x = cvt_pk_bf16(kt[0], kt[1]); w0.y = cvt_pk_bf16(kt[2], kt[3]); w0.z = cvt_pk_bf16(kt[4], kt[5]); w0.w = cvt_pk_bf16(kt[6], kt[7]);
      w1.x = cvt_pk_bf16(kt[8], kt[9]); w1.y = cvt_pk_bf16(kt[10], kt[11]); w1.z = cvt_pk_bf16(kt[12], kt[13]); w1.w = cvt_pk_bf16(kt[14], kt[15]);
      *(LAS u32x4*)(lds + L1_KTT + ch * 144 + tq * 32) = w0; *(LAS u32x4*)(lds + L1_KTT + ch * 144 + tq * 32 + 16) = w1; }
    __syncthreads();
#pragma unroll
    for (int i = 0; i < 2; ++i) { const int id = tid + 512 * i, r = id >> 4, cc = id & 15;
        *(u32x4*)(QTg + (size_t)(t0 + r) * 1024 + hh * 128 + cc * 8) = *(const LAS u32x4*)(lds + L1_QT + r * 272 + cc * 16); }
    { const int mi = w >> 1, nj0 = 2 * (w & 1);
      f32x4 pd[2] = {{0.f, 0.f, 0.f, 0.f}, {0.f, 0.f, 0.f, 0.f}};
#pragma unroll
      for (int ks = 0; ks < 4; ++ks) { const bf16x8 a = *(const LAS bf16x8*)(lds + L1_QT + (16 * mi + fr) * 272 + (32 * ks + 8 * fq) * 2);
#pragma unroll
          for (int j = 0; j < 2; ++j) { const bf16x8 bb = *(const LAS bf16x8*)(lds + L1_KT + (16 * (nj0 + j) + fr) * 272 + (32 * ks + 8 * fq) * 2); pd[j] = MFMA16(a, bb, pd[j]); } }
#pragma unroll
      for (int j = 0; j < 2; ++j)
#pragma unroll
          for (int r = 0; r < 4; ++r) { const int ii = 16 * mi + 4 * fq + r, jj = 16 * (nj0 + j) + fr; if (DIR ? (jj >= ii) : (jj <= ii)) pacc[j][r] += pd[j][r]; } }
    { bf16* Ug = (bf16*)(F.ws + WS_U) + ((size_t)(DIR * 8 + hh) * NCH + c) * 256 * 128;
      bf16x8 bv[2][2];
#pragma unroll
      for (int nj = 0; nj < 2; ++nj)
#pragma unroll
          for (int ks = 0; ks < 2; ++ks) bv[nj][ks] = *(const LAS bf16x8*)(lds + L1_VT + (32 * w + 16 * nj + fr) * 144 + (32 * ks + 8 * fq) * 2);
#pragma unroll
      for (int mi = 0; mi < 8; ++mi) {
          f32x4 u[2] = {{0.f, 0.f, 0.f, 0.f}, {0.f, 0.f, 0.f, 0.f}};
#pragma unroll
          for (int ks = 0; ks < 2; ++ks) { const bf16x8 a = *(const LAS bf16x8*)(lds + L1_KTT + (16 * mi + fr) * 144 + (32 * ks + 8 * fq) * 2);
#pragma unroll
              for (int nj = 0; nj < 2; ++nj) u[nj] = MFMA16(a, bv[nj][ks], u[nj]); }
          asm volatile("s_nop 15" : "+v"(u[0]), "+v"(u[1]));
#pragma unroll
          for (int nj = 0; nj < 2; ++nj) { u32x2 o; o.x = cvt_pk_bf16(u[nj][0], u[nj][1]); o.y = cvt_pk_bf16(u[nj][2], u[nj][3]);
              *(u32x2*)(Ug + (size_t)(32 * w + 16 * nj + fr) * 128 + 16 * mi + 4 * fq) = o; } } }
    __syncthreads();
}

__device__ __forceinline__ void s1_phase(Frame& F, int e) {
    PHASE_IDS(); LAS unsigned char* lds = F.lds; const int w = wave, fr = lane & 15, fq = lane >> 4;
    const bf16* P = (const bf16*)(F.ws + WS_PROJ);
    for (int item = blockIdx.x; item < 8 * NCH; item += F.G) {
        const int c = item >> 3, hh = item & 7, hd = hh & 3, t0 = c * 64; const bool is_gla = hh < 4, lat = c >= 4;
        const int qcol = is_gla ? 128 * hd : 3072 + 128 * hd, kcol = qcol + 512, vcol = is_gla ? 1024 + 256 * hd : 4096 + 256 * hd;
#pragma unroll
        for (int i = 0; i < 2; ++i) { const int id = tid + 512 * i, r = id >> 4, cc = id & 15;
            *(LAS u32x4*)(lds + L1_QRAW + r * 256 + cc * 16) = *(const u32x4*)(P + (size_t)(t0 + r) * EV_N + qcol + cc * 8);
            *(LAS u32x4*)(lds + L1_KRAW + r * 256 + cc * 16) = *(const u32x4*)(P + (size_t)(t0 + r) * EV_N + kcol + cc * 8); }
#pragma unroll
        for (int i = 0; i < 4; ++i) { const int id = tid + 512 * i, r = id & 63, cc = id >> 6;
            const u32x4 v = *(const u32x4*)(P + (size_t)(t0 + r) * EV_N + vcol + cc * 8);
            LAS bf16* vt = (LAS bf16*)(lds + L1_VT) + (cc * 8) * 72 + r;
            vt[0 * 72] = (bf16)(v.x & 0xffff); vt[1 * 72] = (bf16)(v.x >> 16); vt[2 * 72] = (bf16)(v.y & 0xffff); vt[3 * 72] = (bf16)(v.y >> 16);
            vt[4 * 72] = (bf16)(v.z & 0xffff); vt[5 * 72] = (bf16)(v.z >> 16); vt[6 * 72] = (bf16)(v.w & 0xffff); vt[7 * 72] = (bf16)(v.w >> 16); }
        if (is_gla && tid < 256) { const int r = tid >> 2, cc = tid & 3; *(LAS u32x4*)(lds + L1_GD + r * 64 + cc * 16) = *(const u32x4*)(P + (size_t)(t0 + r) * EV_N + 6144 + cc * 8); }
        float wvf[16], wvb[16], bgf = 0.f, bgb = 0.f; f32x2 csv[16];
        { const int ch = tid & 127, tq = tid >> 7;
#pragma unroll
          for (int r = 0; r < 16; ++r) { wvf[r] = 0.f; wvb[r] = 0.f; csv[r] = (f32x2){1.f, 0.f}; }
          if (is_gla) {
              const float* wgf = F.a->in[11] + (size_t)e * 16 * 512 + hd * 128 + ch; const float* wgb = F.a->in[13] + (size_t)e * 16 * 512 + hd * 128 + ch;
#pragma unroll
              for (int r = 0; r < 16; ++r) { wvf[r] = wgf[r * 512]; wvb[r] = wgb[r * 512]; }
              bgf = F.a->in[12][e * 512 + hd * 128 + ch]; bgb = F.a->in[14][e * 512 + hd * 128 + ch];
          } else if (lat) {
              const f32x2* RT = (const f32x2*)(F.ws + WS_RT) + (size_t)(t0 + 16 * tq - NCTX) * 64 + (ch & 63);
#pragma unroll
              for (int r = 0; r < 16; ++r) csv[r] = RT[r * 64];
          } }
        __syncthreads();
        f32x4 pacc[2] = {{0.f, 0.f, 0.f, 0.f}, {0.f, 0.f, 0.f, 0.f}};
        s1_dir<0>(F, e, hh, c, lat, pacc, wvf, bgf, csv);
        s1_dir<1>(F, e, hh, c, lat, pacc, wvb, bgb, csv);
        { const int mi = w >> 1, nj0 = 2 * (w & 1);
#pragma unroll
          for (int j = 0; j < 2; ++j)
#pragma unroll
              for (int r = 0; r < 4; ++r) *(LAS bf16*)(lds + L1_P + (16 * mi + 4 * fq + r) * 144 + (16 * (nj0 + j) + fr) * 2) = f2bf(pacc[j][r]); }
        __syncthreads();
        { float* OI = (float*)(F.ws + WS_OI);
          bf16x8 bv[2][2];
#pragma unroll
          for (int nj = 0; nj < 2; ++nj)
#pragma unroll
              for (int ks = 0; ks < 2; ++ks) bv[nj][ks] = *(const LAS bf16x8*)(lds + L1_VT + (32 * w + 16 * nj + fr) * 144 + (32 * ks + 8 * fq) * 2);
#pragma unroll
          for (int mi = 0; mi < 4; ++mi) {
              f32x4 o[2] = {{0.f, 0.f, 0.f, 0.f}, {0.f, 0.f, 0.f, 0.f}};
#pragma unroll
              for (int ks = 0; ks < 2; ++ks) { const bf16x8 a = *(const LAS bf16x8*)(lds + L1_P + (16 * mi + fr) * 144 + (32 * ks + 8 * fq) * 2);
#pragma unroll
                  for (int nj = 0; nj < 2; ++nj) o[nj] = MFMA16(a, bv[nj][ks], o[nj]); }
#pragma unroll
              for (int nj = 0; nj < 2; ++nj)
#pragma unroll
                  for (int r = 0; r < 4; ++r) ((LAS float*)lds)[(16 * mi + 4 * fq + r) * 260 + 32 * w + 16 * nj + fr] = o[nj][r]; }
          __syncthreads();
#pragma unroll
          for (int i = 0; i < 8; ++i) { const int id = tid + 512 * i, r = id >> 6, cc = id & 63;
              *(f32x4*)(OI + (size_t)(t0 + r) * DM + hh * 256 + cc * 4) = *(const LAS f32x4*)((LAS float*)lds + r * 260 + cc * 4); } }
        __syncthreads();
    }
}

__device__ __forceinline__ void s2_phase(Frame& F) {
    PHASE_IDS();
    const int gt = F.vcu * NTHR + tid, NGT = F.G * NTHR;
    for (int idx = gt; idx < 2 * 8 * 256 * 32; idx += NGT) {
        const int dk4 = idx & 31, ee = (idx >> 5) & 255, dh = idx >> 13, dir = dh >> 3;
        const bf16* U = (const bf16*)(F.ws + WS_U) + (size_t)dh * NCH * 256 * 128 + (size_t)ee * 128 + dk4 * 4;
        bf16* S = (bf16*)(F.ws + WS_S) + (size_t)dh * NCH * 256 * 128 + (size_t)ee * 128 + dk4 * 4;
        const float* D = (const float*)(F.ws + WS_DEC) + (size_t)dh * NCH * 128 + dk4 * 4;
        f32x4 s = {0.f, 0.f, 0.f, 0.f};
#pragma unroll 13
        for (int step = 0; step < NCH; ++step) {
            const int c = dir ? (step < 4 ? 3 - step : NCH + 3 - step) : step;
            const u32x2 uu = *(const u32x2*)(U + (size_t)c * 256 * 128); const f32x4 d = *(const f32x4*)(D + (size_t)c * 128);
            u32x2 so; so.x = cvt_pk_bf16(s.x, s.y); so.y = cvt_pk_bf16(s.z, s.w);
            *(u32x2*)(S + (size_t)c * 256 * 128) = so;
            s.x = d.x * (s.x + bflo(uu.x)); s.y = d.y * (s.y + bfhi(uu.x)); s.z = d.z * (s.z + bflo(uu.y)); s.w = d.w * (s.w + bfhi(uu.y));
        }
    }
}

constexpr int L3_QF = 0, L3_QB = 17408, L3_OL = 34816;
__device__ __forceinline__ void s3_phase(Frame& F, int e) {
    PHASE_IDS(); LAS unsigned char* lds = F.lds; const int w = wave, fr = lane & 15, fq = lane >> 4;
    const bf16* P = (const bf16*)(F.ws + WS_PROJ); const bf16* QTg = (const bf16*)(F.ws + WS_QT); const float* OI = (const float*)(F.ws + WS_OI);
    bf16* MIX = (bf16*)(F.ws + WS_MIX);
    for (int item = blockIdx.x; item < 8 * NCH; item += F.G) {
        const int c = item >> 3, hh = item & 7, hd = hh & 3, t0 = c * 64; const bool is_gla = hh < 4;
        const int gcol = is_gla ? 2048 + 256 * hd : 5120 + 256 * hd;
#pragma unroll
        for (int dir = 0; dir < 2; ++dir)
#pragma unroll
            for (int i = 0; i < 2; ++i) { const int id = tid + 512 * i, r = id >> 4, cc = id & 15;
                *(LAS u32x4*)(lds + (dir ? L3_QB : L3_QF) + r * 272 + cc * 16) = *(const u32x4*)(QTg + (size_t)dir * T * 1024 + (size_t)(t0 + r) * 1024 + hh * 128 + cc * 8); }
        bf16x8 bv[2][4][2];
#pragma unroll
        for (int dir = 0; dir < 2; ++dir) { const bf16* Sg = (const bf16*)(F.ws + WS_S) + ((size_t)(dir * 8 + hh) * NCH + c) * 256 * 128;
#pragma unroll
            for (int ks = 0; ks < 4; ++ks)
#pragma unroll
                for (int nj = 0; nj < 2; ++nj) bv[dir][ks][nj] = *(const bf16x8*)(Sg + (size_t)(32 * w + 16 * nj + fr) * 128 + 32 * ks + 8 * fq); }
        __builtin_amdgcn_sched_barrier(0);
        __syncthreads();
        f32x4 o[4][2];
#pragma unroll
        for (int mi = 0; mi < 4; ++mi)
#pragma unroll
            for (int nj = 0; nj < 2; ++nj) o[mi][nj] = (f32x4){0.f, 0.f, 0.f, 0.f};
#pragma unroll
        for (int dir = 0; dir < 2; ++dir) {
#pragma unroll
            for (int ks = 0; ks < 4; ++ks) {
#pragma unroll
                for (int mi = 0; mi < 4; ++mi) { const bf16x8 a = *(const LAS bf16x8*)(lds + (dir ? L3_QB : L3_QF) + (16 * mi + fr) * 272 + (32 * ks + 8 * fq) * 2);
#pragma unroll
                    for (int nj = 0; nj < 2; ++nj) o[mi][nj] = MFMA16(a, bv[dir][ks][nj], o[mi][nj]); } } }
        LAS float* OL = (LAS float*)(lds + L3_OL);
#pragma unroll
        for (int mi = 0; mi < 4; ++mi)
#pragma unroll
            for (int nj = 0; nj < 2; ++nj)
#pragma unroll
                for (int r = 0; r < 4; ++r) OL[(16 * mi + 4 * fq + r) * 260 + 32 * w + 16 * nj + fr] = o[mi][nj][r];
        __syncthreads();
        { const int tk = tid >> 3, seg = tid & 7;
          f32x4 v[4][2]; float sq = 0.f;
#pragma unroll
          for (int g = 0; g < 4; ++g) { const int ee = 64 * g + 8 * seg; const float* oi = OI + (size_t)(t0 + tk) * DM + hh * 256 + ee;
              v[g][0] = *(const LAS f32x4*)(OL + tk * 260 + ee) + *(const f32x4*)oi; v[g][1] = *(const LAS f32x4*)(OL + tk * 260 + ee + 4) + *(const f32x4*)(oi + 4);
              sq += (v[g][0].x * v[g][0].x + v[g][0].y * v[g][0].y) + (v[g][0].z * v[g][0].z + v[g][0].w * v[g][0].w) + (v[g][1].x * v[g][1].x + v[g][1].y * v[g][1].y) + (v[g][1].z * v[g][1].z + v[g][1].w * v[g][1].w); }
          sq += __shfl_xor(sq, 1); sq += __shfl_xor(sq, 2); sq += __shfl_xor(sq, 4);
          const float rstd = 1.0f / sqrtf(sq * (1.0f / 256.0f) + RMS_EPS);
#pragma unroll
          for (int g = 0; g < 4; ++g) { const int ee = 64 * g + 8 * seg;
              const u32x4 gt = *(const u32x4*)(P + (size_t)(t0 + tk) * EV_N + gcol + ee);
              f32x4 n0 = {1.f, 1.f, 1.f, 1.f}, n1 = {1.f, 1.f, 1.f, 1.f};
              if (is_gla) { n0 = *(const f32x4*)(F.a->in[15] + e * 256 + ee); n1 = *(const f32x4*)(F.a->in[15] + e * 256 + ee + 4); }
              const f32x4 a0 = v[g][0] * rstd * n0, a1 = v[g][1] * rstd * n1;
              u32x4 ow; ow.x = cvt_pk_bf16(a0.x * silu_f(bflo(gt.x)), a0.y * silu_f(bfhi(gt.x))); ow.y = cvt_pk_bf16(a0.z * silu_f(bflo(gt.y)), a0.w * silu_f(bfhi(gt.y)));
              ow.z = cvt_pk_bf16(a1.x * silu_f(bflo(gt.z)), a1.y * silu_f(bfhi(gt.z))); ow.w = cvt_pk_bf16(a1.z * silu_f(bflo(gt.w)), a1.w * silu_f(bfhi(gt.w)));
              *(u32x4*)(MIX + (size_t)(t0 + tk) * DM + hh * 256 + ee) = ow; } }
        __syncthreads();
    }
}

__device__ __forceinline__ void e1_phase(Frame& F, int o) {
    PHASE_IDS();
    const int gw = F.vcu * NWAVES + wave, NGW = F.G * NWAVES;
    const bf16* P = (const bf16*)(F.ws + WS_PROJ); bf16* CQN = (bf16*)(F.ws + WS_CQN); bf16* CKVN = (bf16*)(F.ws + WS_CKVN); bf16* KR = (bf16*)(F.ws + WS_KR);
    const float* wq = F.a->in[18] + o * 512 + lane * 8; const float* wkv = F.a->in[19] + o * 512 + lane * 8;
    const f32x4 wq0 = *(const f32x4*)wq, wq1 = *(const f32x4*)(wq + 4), wk0 = *(const f32x4*)wkv, wk1 = *(const f32x4*)(wkv + 4);
    const f32x2* AXR = (const f32x2*)(F.ws + WS_AXR); const f32x2* AXC = (const f32x2*)(F.ws + WS_AXC);
    for (int t = gw; t < T; t += NGW) {
        const bf16* p = P + (size_t)t * OD_N;
        const u32x4 a = *(const u32x4*)(p + lane * 8), b = *(const u32x4*)(p + 512 + lane * 8);
        float x[8] = {bflo(a.x), bfhi(a.x), bflo(a.y), bfhi(a.y), bflo(a.z), bfhi(a.z), bflo(a.w), bfhi(a.w)};
        float y[8] = {bflo(b.x), bfhi(b.x), bflo(b.y), bfhi(b.y), bflo(b.z), bfhi(b.z), bflo(b.w), bfhi(b.w)};
        float sx = 0.f, sy = 0.f;
#pragma unroll
        for (int j = 0; j < 8; ++j) { sx += x[j] * x[j]; sy += y[j] * y[j]; }
        const float rx = 1.0f / sqrtf(wave_sum(sx) * (1.0f / 512.0f) + RMS_EPS), ry = 1.0f / sqrtf(wave_sum(sy) * (1.0f / 512.0f) + RMS_EPS);
        u32x4 oq, ok;
        oq.x = cvt_pk_bf16(x[0] * rx * wq0.x, x[1] * rx * wq0.y); oq.y = cvt_pk_bf16(x[2] * rx * wq0.z, x[3] * rx * wq0.w); oq.z = cvt_pk_bf16(x[4] * rx * wq1.x, x[5] * rx * wq1.y); oq.w = cvt_pk_bf16(x[6] * rx * wq1.z, x[7] * rx * wq1.w);
        ok.x = cvt_pk_bf16(y[0] * ry * wk0.x, y[1] * ry * wk0.y); ok.y = cvt_pk_bf16(y[2] * ry * wk0.z, y[3] * ry * wk0.w); ok.z = cvt_pk_bf16(y[4] * ry * wk1.x, y[5] * ry * wk1.y); ok.w = cvt_pk_bf16(y[6] * ry * wk1.z, y[7] * ry * wk1.w);
        *(u32x4*)(CQN + (size_t)t * 512 + lane * 8) = oq; *(u32x4*)(CKVN + (size_t)t * 512 + lane * 8) = ok;
        float v = bf2f(p[1024 + lane]); const float pr = __shfl_xor(v, 16);
        if (t >= NCTX) { const int pp = t - NCTX, pos = (lane & 32) ? (pp & 63) : (pp >> 6); const f32x2 cs = ((lane & 32) ? AXC : AXR)[pos * 16 + (lane & 15)];
            v = (lane & 16) ? v * cs.x + pr * cs.y : v * cs.x - pr * cs.y; }
        KR[(size_t)t * 64 + lane] = f2bf(v);
    }
}

namespace att {
constexpr int KVBLK = 64;
constexpr float SCALE = 0.07216878364870322f;
constexpr float THR = 8.f;
constexpr int SHM_K = 64 * 384, SHM_V = 64 * 256;
constexpr int A_V = 0, A_K = 2 * SHM_V, A_WS = 2 * SHM_V + 2 * SHM_K;
#define SBAR() __builtin_amdgcn_sched_barrier(0)
__device__ __forceinline__ int crow(int r, int hi) { return (r & 3) + 8 * (r >> 2) + 4 * hi; }
__device__ __forceinline__ void partialSM(f32x16& p0, f32x16& p1, float& m_reg, float& mn, float& alpha) {
    constexpr float C = SCALE * 1.4426950408889634f;
    float pmax = p0[0];
#pragma unroll
    for (int r = 1; r < 16; ++r) pmax = fmaxf(pmax, p0[r]);
#pragma unroll
    for (int r = 0; r < 16; ++r) pmax = fmaxf(pmax, p1[r]);
    { auto rr = __builtin_amdgcn_permlane32_swap(__float_as_uint(pmax), __float_as_uint(pmax), false, false);
      pmax = fmaxf(__uint_as_float(rr[0]), __uint_as_float(rr[1])); }
    if (__builtin_expect(__all(pmax - m_reg <= THR / SCALE), 1)) { mn = m_reg; alpha = 1.f; }
    else { mn = fmaxf(m_reg, pmax); alpha = __builtin_amdgcn_exp2f((m_reg - mn) * C); m_reg = mn; }
    const float mnC = -mn * C;
#pragma unroll
    for (int r = 0; r < 16; ++r) p0[r] = fmaf(p0[r], C, mnC);
#pragma unroll
    for (int r = 0; r < 16; ++r) p1[r] = fmaf(p1[r], C, mnC);
#pragma unroll
    for (int r = 0; r < 16; ++r) p0[r] = __builtin_amdgcn_exp2f(p0[r]);
}
__device__ __forceinline__ void finishSM(f32x16& p0, f32x16& p1, float alpha, float& l_reg, bf16x8& pa0, bf16x8& pa1, bf16x8& pa2, bf16x8& pa3) {
#pragma unroll
    for (int r = 0; r < 16; ++r) p1[r] = __builtin_amdgcn_exp2f(p1[r]);
    float ps = 0;
#pragma unroll
    for (int r = 0; r < 16; ++r) ps += p0[r];
#pragma unroll
    for (int r = 0; r < 16; ++r) ps += p1[r];
    { auto rr = __builtin_amdgcn_permlane32_swap(__float_as_uint(ps), __float_as_uint(ps), false, false);
      ps = __uint_as_float(rr[0]) + __uint_as_float(rr[1]); }
    l_reg = l_reg * alpha + ps;
#define PK4(P, BASE, OUT) do { unsigned a0 = cvt_pk_bf16(P[BASE + 0], P[BASE + 1]), a1 = cvt_pk_bf16(P[BASE + 2], P[BASE + 3]);   \
    unsigned b0 = cvt_pk_bf16(P[BASE + 4], P[BASE + 5]), b1 = cvt_pk_bf16(P[BASE + 6], P[BASE + 7]);                              \
    auto r0 = __builtin_amdgcn_permlane32_swap(a0, b0, false, false); auto r1 = __builtin_amdgcn_permlane32_swap(a1, b1, false, false); \
    u32x4 w = {r0[0], r1[0], r0[1], r1[1]}; OUT = *reinterpret_cast<bf16x8*>(&w); } while (0)
    PK4(p0, 0, pa0); PK4(p0, 8, pa1); PK4(p1, 0, pa2); PK4(p1, 8, pa3);
#undef PK4
}
__device__ __forceinline__ int kswz(int row, int g) { return row * 384 + (((g & ~7) | ((g & 7) ^ ((row >> 1) & 7))) << 4); }
__device__ __forceinline__ void qkt(f32x16& p0, f32x16& p1, const LAS unsigned char* Ks, const bf16x8 (&qr)[12], const int (&kx)[4]) {
    p0 = f32x16{}; p1 = f32x16{};
    bf16x8 c0 = *(const LAS bf16x8*)(Ks + kx[0]), c1 = *(const LAS bf16x8*)(Ks + kx[0] + 32 * 384), n0, n1;
#pragma unroll
    for (int d0 = 0; d0 < 12; ++d0) {
        if (d0 < 11) { n0 = *(const LAS bf16x8*)(Ks + kx[(d0 + 1) & 3] + ((d0 + 1) >> 2) * 128); n1 = *(const LAS bf16x8*)(Ks + kx[(d0 + 1) & 3] + ((d0 + 1) >> 2) * 128 + 32 * 384); }
        __builtin_amdgcn_sched_barrier(0);
        p0 = MFMA32(c0, qr[d0], p0);
        p1 = MFMA32(c1, qr[d0], p1);
        __builtin_amdgcn_sched_barrier(0);
        c0 = n0; c1 = n1; }
}
__device__ __forceinline__ int v_st(int k, int c) { const int kk = (k & ~0xC) | ((k & 4) << 1) | ((k & 8) >> 1); return ((kk >> 3) * 4 + (c >> 5)) * 512 + ((kk & 7) * 32 + (c & 31)) * 2; }
__device__ __forceinline__ int v_rd_base(int lane) { return ((lane & 3) << 3) | (((lane >> 2) & 3) << 6) | (((lane >> 4) & 1) << 5) | (((lane >> 5) & 1) << 8); }
constexpr int v_rd_off(int d0, int ks, int half) { return d0 * 512 + ks * 4096 + half * 2048; }
template <int OFF> __device__ __forceinline__ s16x4 tr_read(int vb) {
    s16x4 r; asm volatile("ds_read_b64_tr_b16 %0, %1 offset:%2" : "=&v"(r) : "v"(vb), "i"(OFF) : "memory"); return r;
}
template <int D0> __device__ __forceinline__ void pv_one(f32x16& od, int vb, bf16x8 pa0, bf16x8 pa1, bf16x8 pa2, bf16x8 pa3) {
    const s16x4 l0 = tr_read<v_rd_off(D0, 0, 0)>(vb), h0 = tr_read<v_rd_off(D0, 0, 1)>(vb), l1 = tr_read<v_rd_off(D0, 1, 0)>(vb), h1 = tr_read<v_rd_off(D0, 1, 1)>(vb);
    const s16x4 l2 = tr_read<v_rd_off(D0, 2, 0)>(vb), h2 = tr_read<v_rd_off(D0, 2, 1)>(vb), l3 = tr_read<v_rd_off(D0, 3, 0)>(vb), h3 = tr_read<v_rd_off(D0, 3, 1)>(vb);
    asm volatile("s_waitcnt lgkmcnt(0)" ::: "memory"); SBAR();
#define PK(L, H) (bf16x8){L[0], L[1], L[2], L[3], H[0], H[1], H[2], H[3]}
    od = MFMA32(pa0, PK(l0, h0), od);
    od = MFMA32(pa1, PK(l1, h1), od);
    od = MFMA32(pa2, PK(l2, h2), od);
    od = MFMA32(pa3, PK(l3, h3), od);
#undef PK
}
__device__ __forceinline__ void pv_d0(f32x16 (&o)[4], int vb, bf16x8 pa0, bf16x8 pa1, bf16x8 pa2, bf16x8 pa3) {
    pv_one<0>(o[0], vb, pa0, pa1, pa2, pa3); pv_one<1>(o[1], vb, pa0, pa1, pa2, pa3); pv_one<2>(o[2], vb, pa0, pa1, pa2, pa3); pv_one<3>(o[3], vb, pa0, pa1, pa2, pa3);
}
__device__ __forceinline__ void rope_pair(bf16x8& a, bf16x8& b, const f32x2* cs) {
    u32x4 ua = *reinterpret_cast<u32x4*>(&a), ub = *reinterpret_cast<u32x4*>(&b); u32x4 oa, ob;
#pragma unroll
    for (int j = 0; j < 4; ++j) { const f32x2 c0 = cs[2 * j], c1 = cs[2 * j + 1];
        const float x1l = bflo(ua[j]), x1h = bfhi(ua[j]), x2l = bflo(ub[j]), x2h = bfhi(ub[j]);
        oa[j] = cvt_pk_bf16(x1l * c0.x - x2l * c0.y, x1h * c1.x - x2h * c1.y);
        ob[j] = cvt_pk_bf16(x2l * c0.x + x1l * c0.y, x2h * c1.x + x1h * c1.y); }
    a = *reinterpret_cast<bf16x8*>(&oa); b = *reinterpret_cast<bf16x8*>(&ob);
}
__device__ __forceinline__ void unit(Frame& F, int h, int qrow0, int nkeys) {
    LAS unsigned char* lds = F.lds;
    PHASE_IDS(); const int wid = wave, r32 = lane & 31, hi = lane >> 5;
    const bf16* QB = (const bf16*)(F.ws + WS_QB); const bf16* KVB = (const bf16*)(F.ws + WS_KVB); const bf16* KR = (const bf16*)(F.ws + WS_KR);
    LAS unsigned char* V_lds = lds + A_V; LAS unsigned char* K_lds = lds + A_K;
    LAS float* wsl = (LAS float*)(lds + A_WS) + wid * 64; LAS float* li_l = wsl; LAS float* al_l = wsl + 32;
    float m_reg = -1e30f, l_reg = 0; f32x16 o[4] = {}; bf16x8 qr[12];
    const int qt = qrow0 + wid * 32 + r32;
    const bf16* Qw = QB + (size_t)qt * 3072 + 192 * h + hi * 8;
#pragma unroll
    for (int d0 = 0; d0 < 12; ++d0) qr[d0] = *(const bf16x8*)(Qw + d0 * 16);
    if (qt >= NCTX) { const int pp = qt - NCTX;
        rope_pair(qr[8], qr[9], (const f32x2*)(F.ws + WS_AXR) + (pp >> 6) * 16 + hi * 8);
        rope_pair(qr[10], qr[11], (const f32x2*)(F.ws + WS_AXC) + (pp & 63) * 16 + hi * 8); }
    const unsigned char* wsb = F.ws;
    unsigned koff[3], kfl = 0u; int kdst[3];
#pragma unroll
    for (int i = 0; i < 3; ++i) { const int id = tid + 512 * i, row = id / 24, g = id % 24;
        if (g < 16) { koff[i] = (unsigned)WS_KVB + (unsigned)(row * 4096 + 256 * h + g * 8) * 2u; kfl |= 1u << i; } else { koff[i] = (unsigned)WS_KR + (unsigned)(row * 64 + (g - 16) * 8) * 2u; }
        kdst[i] = kswz(row, g); }
    const int sr = tid >> 4, sc = (tid & 15) * 8, vst0 = v_st(sr, sc);
    const unsigned voff = (unsigned)WS_KVB + (unsigned)(sr * 4096 + 256 * h + 128 + sc) * 2u;
    const int vb0 = (int)(unsigned)(uintptr_t)V_lds + v_rd_base(lane);
    int kx[4];
#pragma unroll
    for (int q = 0; q < 4; ++q) kx[q] = r32 * 384 + ((((2 * q) | hi) ^ ((r32 >> 1) & 7)) << 4);
    bf16x8 sk0, sk1, sk2, sv0, sv1;
#define SLOAD(jt) do { const unsigned vo_ = voff + (unsigned)(jt) * (64u * 4096u * 2u); sv0 = *(const bf16x8*)(wsb + vo_); sv1 = *(const bf16x8*)(wsb + vo_ + 32u * 4096u * 2u); \
    const unsigned kt_ = (unsigned)(jt) * 8192u; \
    sk0 = *(const bf16x8*)(wsb + koff[0] + (kt_ << ((kfl & 1u) * 6u))); sk1 = *(const bf16x8*)(wsb + koff[1] + (kt_ << (((kfl >> 1) & 1u) * 6u))); sk2 = *(const bf16x8*)(wsb + koff[2] + (kt_ << (((kfl >> 2) & 1u) * 6u))); } while (0)
#define SWRITE(b) do { *(LAS bf16x8*)(V_lds + (b) * SHM_V + vst0) = sv0; *(LAS bf16x8*)(V_lds + (b) * SHM_V + vst0 + 8192) = sv1; \
    *(LAS bf16x8*)(K_lds + (b) * SHM_K + kdst[0]) = sk0; *(LAS bf16x8*)(K_lds + (b) * SHM_K + kdst[1]) = sk1; *(LAS bf16x8*)(K_lds + (b) * SHM_K + kdst[2]) = sk2; } while (0)
#define SWAIT() asm volatile("s_waitcnt vmcnt(0)" ::: "memory")
#define RESC(a) do { if (__any((a) < 1.f)) { if (hi == 0) al_l[r32] = (a); asm volatile("s_waitcnt lgkmcnt(0)" ::: "memory"); \
    _Pragma("unroll") for (int d = 0; d < 4; ++d) _Pragma("unroll") for (int r = 0; r < 16; ++r) o[d][r] *= al_l[crow(r, hi)]; } } while (0)
    f32x16 p0, p1; float mn, al; bf16x8 pa0, pa1, pa2, pa3; const int NT = nkeys / KVBLK;
#define ABAR() do { asm volatile("s_waitcnt lgkmcnt(0)" ::: "memory"); __builtin_amdgcn_s_barrier(); asm volatile("" ::: "memory"); } while (0)
#define ASTAGE(j) do { if ((j) + 1 < NT) { SWAIT(); SWRITE(((j) & 1) ^ 1); } if ((j) + 2 < NT) SLOAD((j) + 2); } while (0)
#define AQK(j) do { SBAR(); qkt(p0, p1, K_lds + ((j) & 1) * SHM_K, qr, kx); SBAR(); partialSM(p0, p1, m_reg, mn, al); } while (0)
#define ASP(j) do { RESC(al); finishSM(p0, p1, al, l_reg, pa0, pa1, pa2, pa3); SBAR(); pv_d0(o, vb0 + ((j) & 1) * SHM_V, pa0, pa1, pa2, pa3); } while (0)
    SLOAD(0); SWAIT(); SWRITE(0); SLOAD(1); ABAR();
    if ((wid >> 2) == 0) {
        for (int j = 0; j < NT; ++j) { AQK(j); ABAR(); ASTAGE(j); ASP(j); ABAR(); }
        ABAR();
    } else {
        ABAR();
        for (int j = 0; j < NT; ++j) { ASTAGE(j); AQK(j); ABAR(); ASP(j); ABAR(); }
    }
#undef ABAR
#undef ASTAGE
#undef AQK
#undef ASP
    if (hi == 0) li_l[r32] = l_reg; asm volatile("s_waitcnt lgkmcnt(0)" ::: "memory");
    float rli[16];
#pragma unroll
    for (int r = 0; r < 16; ++r) rli[r] = __builtin_amdgcn_rcpf(li_l[crow(r, hi)]);
    unsigned orow0 = (unsigned)(qrow0 + wid * 32) * DM + 128 * h; asm volatile("" : "+v"(orow0));
    bf16* Ow = (bf16*)(F.ws + WS_MIX) + orow0;
#pragma unroll
    for (int r = 0; r < 16; ++r) { const int orow = crow(r, hi);
#pragma unroll
        for (int d0 = 0; d0 < 4; ++d0) Ow[(size_t)orow * DM + d0 * 32 + r32] = f2bf(o[d0][r] * rli[r]); }
    __syncthreads();
#undef SLOAD
#undef SWRITE
#undef SWAIT
#undef RESC
}
}

__device__ __forceinline__ void attn_phase(Frame& F) {
    for (int u = F.vcu; u < 1024 + 16; u += F.G) {
        if (u < 1024) att::unit(F, u >> 6, NCTX + 256 * (u & 63), T);
        else att::unit(F, u - 1024, 0, NCTX);
    }
}

#ifdef DBG
constexpr int DBG_W_BAD = 64, DBG_W_SSQ = 65, DBG_W_CNT = 66, DBG_W_MAX = 67;
__device__ __forceinline__ void dbg_scan(Frame& F, int id, size_t off, size_t nbytes, bool is_bf) {
    PHASE_IDS();
    const u32x4* p = (const u32x4*)(F.ws + off); const size_t n = nbytes / 16; bool bad = false;
    for (size_t i = (size_t)F.vcu * NTHR + tid; i < n; i += (size_t)F.G * NTHR) { const u32x4 v = p[i];
#pragma unroll
        for (int j = 0; j < 4; ++j) { if (is_bf) { bad |= ((v[j] & 0x7f80u) == 0x7f80u) | ((v[j] & 0x7f800000u) == 0x7f800000u); } else bad |= ((v[j] & 0x7f800000u) == 0x7f800000u); } }
    if (__any(bad) && lane == 0) atomicMax((unsigned*)(F.ws + WS_CTL) + DBG_W_BAD, (unsigned)(100000 - id));
}
__device__ __forceinline__ void dbg_max(Frame& F, size_t off, size_t nbytes, bool is_bf) {
    PHASE_IDS();
    const u32x4* p = (const u32x4*)(F.ws + off); const size_t n = nbytes / 16; unsigned mx = 0u;
    for (size_t i = (size_t)F.vcu * NTHR + tid; i < n; i += (size_t)F.G * NTHR) { const u32x4 v = p[i];
#pragma unroll
        for (int j = 0; j < 4; ++j) { if (is_bf) { const unsigned a0 = (v[j] << 16) & 0x7fffffffu, a1 = v[j] & 0x7fff0000u; if (a0 < 0x7f800000u) mx = max(mx, a0); if (a1 < 0x7f800000u) mx = max(mx, a1); } else { const unsigned a0 = v[j] & 0x7fffffffu; if (a0 < 0x7f800000u) mx = max(mx, a0); } } }
#pragma unroll
    for (int o = 1; o < 64; o <<= 1) mx = max(mx, (unsigned)__shfl_xor((int)mx, o));
    if (lane == 0) atomicMax((unsigned*)(F.ws + WS_CTL) + DBG_W_MAX, mx);
}
#define DBGSCAN(id, off, nbytes, isbf) dbg_scan(F, (id), (off), (nbytes), (isbf))
#else
#define DBGSCAN(id, off, nbytes, isbf) do {} while (0)
#endif

#ifndef RES_ALIGN
#define RES_ALIGN true
#endif
#ifndef RES_SP2
#define RES_SP2 true
#endif
__global__ void __launch_bounds__(NTHR, 2) fwd_kernel(Args args) {
    extern __shared__ __attribute__((aligned(16))) unsigned char lds_raw[];
    Frame F;
    F.lds = (LAS unsigned char*)lds_raw;
    F.G = gridDim.x; { const int bx = blockIdx.x; F.vcu = (F.G % 8 == 0) ? (bx % 8) * (F.G / 8) + bx / 8 : bx; }
    F.a = &args; F.ws = args.ws;
    volatile LAS unsigned* ctlw = (volatile LAS unsigned*)(F.lds + LDS_CTL);
    if (threadIdx.x < 16) ctlw[threadIdx.x] = 0u;
    __syncthreads();
    XcdBarrier bar = xcd_barrier_post((unsigned*)(F.ws + WS_CTL) + 4096, ctlw);
#define GRID_BAR() xcd_barrier(bar)
#ifdef DBG_TIME
    unsigned long long t_prev = __builtin_amdgcn_s_memrealtime();
#define TSTAMP(cat) do { if (blockIdx.x == 0 && threadIdx.x == 0) { const unsigned long long t_now = __builtin_amdgcn_s_memrealtime(); unsigned long long* tw = (unsigned long long*)(F.ws + WS_CTL) + 64 + (cat); *tw = *tw + (t_now - t_prev); t_prev = t_now; } } while (0)
#else
#define TSTAMP(cat) do {} while (0)
#endif

#ifndef SK_P0
    p0a(F);
#ifdef DUP_P0
    p0a(F);
#endif
#endif
    GRID_BAR();
    p0b(F); GRID_BAR();
    DBGSCAN(1, WS_MOD, (size_t)4 * 2 * NADA * 4, false);
    init_x_by_owners(F);
    row_phase<0>(F, nullptr, nullptr, modp(F, 0, 0, 0), modp(F, 0, 0, 1), modp(F, 0, 1, 0), modp(F, 0, 1, 1)); GRID_BAR(); TSTAMP(0);
    DBGSCAN(2, WS_X, (size_t)T * DM * 4, false); DBGSCAN(3, WS_H, (size_t)T * DM * 2, true);

    const pg8::bf16_t* Hb = (const pg8::bf16_t*)(F.ws + WS_H);
    for (int s = 0; s < 3 * DEPTH; ++s) {
        const int l = s / 3, r = s % 3;
        const pg8::bf16_t* A2; const pg8::bf16_t* B2; int K2;
        if (r != 1) {
            const int f = r >> 1;
            pg8::Gemm g{Hb, (const pg8::bf16_t*)(F.ws + WS_WFI + (size_t)(l * 2 + f) * SZ_WFI), T, 2 * DFF, DM, DM, DM};
            pg8::StaticOrder S; S.init(T, 2 * DFF, F.G, (int)blockIdx.x);
            pg8::EpiSwiGLU E{(pg8::bf16_t*)(F.ws + WS_HID), DFF};
#ifndef SK_SW
            pg8::gemm_phase<pg8::EpiSwiGLU, pg8::StaticOrder>(F.lds, g, S, E);
#endif
#ifdef DUP_SW
            pg8::gemm_phase<pg8::EpiSwiGLU, pg8::StaticOrder>(F.lds, g, S, E);
#endif
            GRID_BAR(); TSTAMP(1);
            DBGSCAN(10 + 10 * s, WS_HID, (size_t)T * DFF * 2, true);
            A2 = (const pg8::bf16_t*)(F.ws + WS_HID); B2 = (const pg8::bf16_t*)(F.ws + WS_WFO + (size_t)(l * 2 + f) * SZ_WFO); K2 = DFF;
        } else if ((l & 1) == 0) {
            const int e = l >> 1;
            { pg8::Gemm g{Hb, (const pg8::bf16_t*)(F.ws + WS_EWI + (size_t)e * SZ_EWI), T, EV_N, DM, DM, DM};
              pg8::StaticOrder S; S.init(T, EV_N, F.G, (int)blockIdx.x);
              pg8::EpiBf16 E{(pg8::bf16_t*)(F.ws + WS_PROJ), EV_N};
#ifndef SK_G1
              pg8::gemm_phase<pg8::EpiBf16, pg8::StaticOrder>(F.lds, g, S, E);
#endif
            }
            GRID_BAR(); TSTAMP(4);
            DBGSCAN(10 + 10 * s, WS_PROJ, (size_t)T * EV_N * 2 - 0, true);
#ifdef DBG
            if (s == 1) dbg_max(F, WS_PROJ, (size_t)T * EV_N * 2, true);
#endif
#ifndef SK_S1
            s1_phase(F, e);
#ifdef DUP_S1
            s1_phase(F, e);
#endif
#endif
            GRID_BAR(); TSTAMP(5);
            DBGSCAN(11 + 10 * s, WS_U, SZ_U, true); DBGSCAN(16 + 10 * s, WS_OI, (size_t)T * DM * 4, false); DBGSCAN(17 + 10 * s, WS_QT, (size_t)2 * T * 1024 * 2, true); DBGSCAN(18 + 10 * s, WS_DEC, (size_t)2 * 8 * NCH * 128 * 4, false);
#ifndef SK_S2
            s2_phase(F);
#ifdef DUP_S2
            s2_phase(F);
#endif
#endif
            GRID_BAR(); TSTAMP(6);
            DBGSCAN(12 + 10 * s, WS_S, SZ_U, true);
#ifndef SK_S3
            s3_phase(F, e);
#ifdef DUP_S3
            s3_phase(F, e);
#endif
#endif
            GRID_BAR(); TSTAMP(7);
            DBGSCAN(13 + 10 * s, WS_MIX, (size_t)T * DM * 2, true);
            A2 = (const pg8::bf16_t*)(F.ws + WS_MIX); B2 = (const pg8::bf16_t*)(F.ws + WS_EWO + (size_t)e * SZ_SQ); K2 = DM;
        } else {
            const int o = l >> 1;
            { pg8::Gemm g{Hb, (const pg8::bf16_t*)(F.ws + WS_OWI + (size_t)o * SZ_OWI), T, OD_N, DM, DM, DM};
              pg8::StaticOrder S; S.init(T, OD_N, F.G, (int)blockIdx.x);
              pg8::EpiBf16 E{(pg8::bf16_t*)(F.ws + WS_PROJ), OD_N};
#ifndef SK_G2
              pg8::gemm_phase<pg8::EpiBf16, pg8::StaticOrder>(F.lds, g, S, E);
#endif
            }
            GRID_BAR();
#ifndef SK_E1
            e1_phase(F, o);
#endif
            GRID_BAR();
            DBGSCAN(11 + 10 * s, WS_CQN, (size_t)T * 512 * 2 * 2, true); DBGSCAN(11 + 10 * s, WS_KR, (size_t)T * 64 * 2, true);
            for (int q = 0; q < 2; ++q) {
                pg8::Gemm g{(const pg8::bf16_t*)(F.ws + (q ? WS_CKVN : WS_CQN)), (const pg8::bf16_t*)(F.ws + (q ? WS_OUKV + (size_t)o * SZ_OUKV : WS_OUQ + (size_t)o * SZ_OUQ)), T, q ? 4096 : 3072, 512, 512, 512};
                pg8::StaticOrder S; S.init(T, g.N, F.G, (int)blockIdx.x);
                pg8::EpiBf16 E{(pg8::bf16_t*)(F.ws + (q ? WS_KVB : WS_QB)), g.N};
#ifndef SK_G3
                pg8::gemm_phase<pg8::EpiBf16, pg8::StaticOrder>(F.lds, g, S, E);
#endif
            }
            GRID_BAR(); TSTAMP(8);
            DBGSCAN(12 + 10 * s, WS_QB, (size_t)T * 3072 * 2, true); DBGSCAN(12 + 10 * s, WS_KVB, (size_t)T * 4096 * 2, true);
#ifndef SK_ATT
            attn_phase(F);
#ifdef DUP_ATT
            attn_phase(F);
#endif
#endif
            GRID_BAR(); TSTAMP(9);
            DBGSCAN(13 + 10 * s, WS_MIX, (size_t)T * DM * 2, true);
            A2 = (const pg8::bf16_t*)(F.ws + WS_MIX); B2 = (const pg8::bf16_t*)(F.ws + WS_OWO + (size_t)o * SZ_SQ); K2 = DM;
        }
        {
            pg8::Gemm g{A2 + (size_t)NCTX * K2, B2, NLAT, DM, K2, K2, K2};
            pg8::StaticOrder S; S.init(NLAT, DM, F.G, (int)blockIdx.x);
            const int sp = s > 0 ? s - 1 : 0;
            const float* plng = F.a->in[6] + (size_t)sp * DM; const float* plnb = F.a->in[7] + (size_t)sp * DM; const float* stat = (const float*)(F.ws + WS_STAT);
            pg8::EpiResid E{(float*)(F.ws + WS_X) + (size_t)NCTX * DM, modp(F, l, 0, 3 * r + 2), (r != 1) ? 0.5f : 1.0f, stat + (size_t)NCTX * 2, plng, plnb, s > 0 ? 1 : 0};
#ifndef SK_RES
            pg8::gemm_phase<pg8::EpiResid, pg8::StaticOrder, RES_ALIGN, RES_SP2>(F.lds, g, S, E);
#endif
            ctx_resid_small(F, (float*)(F.ws + WS_X), (const bf16*)A2, (const bf16*)B2, K2, modp(F, l, 1, 3 * r + 2), (r != 1) ? 0.5f : 1.0f, stat, plng, plnb, s > 0 ? 1 : 0);
#ifdef DUP_SMALL_OFF
            ctx_resid_small(F, (float*)(F.ws + WS_OI), (const bf16*)A2, (const bf16*)B2, K2, modp(F, l, 1, 3 * r + 2), (r != 1) ? 0.5f : 1.0f);
            ctx_resid_small(F, (float*)(F.ws + WS_OI), (const bf16*)A2, (const bf16*)B2, K2, modp(F, l, 1, 3 * r + 2), (r != 1) ? 0.5f : 1.0f);
#endif
#ifdef DUP_RES
            { pg8::EpiResid E2{(float*)(F.ws + WS_OI) + (size_t)NCTX * DM, modp(F, l, 0, 3 * r + 2), 0.5f, stat, plng, plnb, 0};
              pg8::gemm_phase<pg8::EpiResid, pg8::StaticOrder>(F.lds, g, S, E2); }
#endif
        }
        GRID_BAR(); TSTAMP(r != 1 ? 2 : 10);
        DBGSCAN(14 + 10 * s, WS_X, (size_t)T * DM * 4, false);
        const float* lng = F.a->in[6] + (size_t)(l * 3 + r) * DM; const float* lnb = F.a->in[7] + (size_t)(l * 3 + r) * DM;
        if (s + 1 < 3 * DEPTH) { const int l2 = (s + 1) / 3, r2 = (s + 1) % 3;
            row_phase<1>(F, lng, lnb, modp(F, l2, 0, 3 * r2), modp(F, l2, 0, 3 * r2 + 1), modp(F, l2, 1, 3 * r2), modp(F, l2, 1, 3 * r2 + 1));
            GRID_BAR(); TSTAMP(3);
            DBGSCAN(15 + 10 * s, WS_X, (size_t)T * DM * 4, false); DBGSCAN(15 + 10 * s, WS_H, (size_t)T * DM * 2, true);
#if defined(DBG) && defined(DBG_STOP)
            if (s == DBG_STOP) break;
#endif
        } else {
#ifndef DBG
            row_phase<2>(F, lng, lnb, nullptr, nullptr, nullptr, nullptr);
#endif
        }
    }
#ifdef DBG_TIME
    {   PHASE_IDS(); GRID_BAR();
        const unsigned long long* tw = (const unsigned long long*)(F.ws + WS_CTL) + 64;
        const float tA = (float)__hip_atomic_load(tw + DBG_TA, RLX_AGENT) * 1e-5f, tB = (float)__hip_atomic_load(tw + DBG_TB, RLX_AGENT) * 1e-5f;
        const float cB = DBG_TSCALE * tB, cA = cB; (void)tA;
        float* out = F.a->out;
        for (size_t i = (size_t)F.vcu * NTHR + tid; i < (size_t)NLAT * DM; i += (size_t)F.G * NTHR) out[i] = (i == 12345) ? cA : cB;
    }
#endif
#ifdef DBG
    {
        PHASE_IDS();
        const float* X = (const float*)(F.ws + WS_X); float ssq = 0.f; float cnt = 0.f;
        for (size_t i = (size_t)F.vcu * NTHR + tid; i < (size_t)T * DM; i += (size_t)F.G * NTHR) { const float v = X[i]; if ((__float_as_uint(v) & 0x7f800000u) != 0x7f800000u) { ssq += v * v; cnt += 1.f; } }
        ssq = wave_sum(ssq); cnt = wave_sum(cnt);
        if (lane == 0) { atomicAdd((float*)(F.ws + WS_CTL) + DBG_W_SSQ, ssq); atomicAdd((float*)(F.ws + WS_CTL) + DBG_W_CNT, cnt); }
        GRID_BAR();
        const unsigned badw = __hip_atomic_load((unsigned*)(F.ws + WS_CTL) + DBG_W_BAD, RLX_AGENT);
        const float tss = __hip_atomic_load((float*)(F.ws + WS_CTL) + DBG_W_SSQ, RLX_AGENT), tcn = __hip_atomic_load((float*)(F.ws + WS_CTL) + DBG_W_CNT, RLX_AGENT);
        const float rms = sqrtf(tss / fmaxf(tcn, 1.f)); float cB = fminf(10.f * rms, 1000.f);
#ifdef DBG_REPORT_MAX
        { const unsigned mw = __hip_atomic_load((unsigned*)(F.ws + WS_CTL) + DBG_W_MAX, RLX_AGENT); cB = fminf(log2f(1.0f + __uint_as_float(mw)), 120.f); }
#endif
        const float cA = badw ? (float)(100000u - badw) * 10.f : 5.f;
        float* out = F.a->out;
        for (size_t i = (size_t)F.vcu * NTHR + tid; i < (size_t)NLAT * DM; i += (size_t)F.G * NTHR) out[i] = (i == 12345) ? cA + 0.f : cB;
        (void)cA;
    }
#endif
}

extern "C" void kernel_launch(void* const* d_in, const int* in_sizes, int n_in, void* d_out, int out_size, void* d_ws, size_t ws_size, hipStream_t stream) {
    static int grid = 0;
    if (grid == 0) {
        if (n_in != 23 || out_size != NLAT * DM || ws_size < WS_END) { fprintf(stderr, "kernel_launch: unexpected shapes: n_in %d out %d ws %zu (need %zu)\n", n_in, out_size, ws_size, (size_t)WS_END); grid = -1; return; }
        int dev = 0, cus = 0, per_cu = 0;
        if (hipGetDevice(&dev) != hipSuccess || hipDeviceGetAttribute(&cus, hipDeviceAttributeMultiprocessorCount, dev) != hipSuccess) { grid = -1; return; }
        if (hipFuncSetAttribute((const void*)fwd_kernel, hipFuncAttributeMaxDynamicSharedMemorySize, LDS_BYTES) != hipSuccess) { fprintf(stderr, "kernel_launch: hipFuncSetAttribute failed\n"); grid = -1; return; }
        if (hipOccupancyMaxActiveBlocksPerMultiprocessor(&per_cu, (const void*)fwd_kernel, NTHR, LDS_BYTES) != hipSuccess || per_cu < 1) fprintf(stderr, "kernel_launch: occupancy query reports %d\n", per_cu);
        (void)hipGetLastError();
        grid = cus;
    }
    if (grid < 0) return;
    (void)hipMemsetAsync((char*)d_ws + WS_CTL, 0, CTL_BYTES, stream);
    Args a{};
    for (int i = 0; i < 23; ++i) a.in[i] = (const float*)d_in[i];
    a.out = (float*)d_out; a.ws = (unsigned char*)d_ws;
    hipLaunchKernelGGL(fwd_kernel, dim3(grid), dim3(NTHR), LDS_BYTES, stream, a);
    const hipError_t le = hipPeekAtLastError();
    if (le != hipSuccess) fprintf(stderr, "kernel_launch: launch failed: %s\n", hipGetErrorName(le));
}
```

```cpp
#include <hip/hip_runtime.h>
#include <cstdio>
#include <cstdint>

#define GAS __attribute__((address_space(1)))
#define LAS __attribute__((address_space(3)))
typedef unsigned short bf16;
typedef short bf16x8 __attribute__((ext_vector_type(8)));
typedef short s16x4 __attribute__((ext_vector_type(4)));
typedef float f32x4 __attribute__((ext_vector_type(4)));
typedef float f32x2 __attribute__((ext_vector_type(2)));
typedef float f32x16 __attribute__((ext_vector_type(16)));
typedef unsigned u32x4 __attribute__((ext_vector_type(4)));
typedef unsigned u32x2 __attribute__((ext_vector_type(2)));

constexpr int DM = 2048, NCTX = 256, NLAT = 16384, T = NCTX + NLAT, DEPTH = 4, DFF = 5504;
constexpr int NADA = 9 * DM;
constexpr int EV_N = 6400, OD_N = 1280;
constexpr int NCH = T / 64;
constexpr float DN_ALPHA = 1.6817928305074290f;
constexpr float LN_EPS = 1e-5f, RMS_EPS = 1e-6f;
constexpr int NWAVES = 8, NTHR = 512;
constexpr int LDS_BYTES = 147456;
constexpr int LDS_CTL = LDS_BYTES - 256;

constexpr size_t al256(size_t x) { return (x + 255) / 256 * 256; }
constexpr size_t WS_CTL = 0, CTL_BYTES = 1u << 20;
constexpr size_t WS_MODP = WS_CTL + CTL_BYTES;
constexpr size_t WS_MOD = WS_MODP + al256((size_t)8 * 2 * 4 * NADA * 4);
constexpr size_t WS_RT = WS_MOD + al256((size_t)4 * 2 * NADA * 4);
constexpr size_t WS_AXR = WS_RT + al256((size_t)NLAT * 64 * 8);
constexpr size_t WS_AXC = WS_AXR + al256(256 * 16 * 8);
constexpr size_t WS_STAT = WS_AXC + al256(64 * 16 * 8);
constexpr size_t WS_WFI = WS_STAT + al256((size_t)T * 8);
constexpr size_t SZ_WFI = (size_t)2 * DFF * DM * 2;
constexpr size_t WS_WFO = WS_WFI + 8 * SZ_WFI;
constexpr size_t SZ_WFO = (size_t)DM * DFF * 2;
constexpr size_t WS_EWI = WS_WFO + 8 * SZ_WFO;
constexpr size_t SZ_EWI = (size_t)EV_N * DM * 2;
constexpr size_t WS_EWO = WS_EWI + 2 * SZ_EWI;
constexpr size_t SZ_SQ = (size_t)DM * DM * 2;
constexpr size_t WS_OWI = WS_EWO + 2 * SZ_SQ;
constexpr size_t SZ_OWI = (size_t)OD_N * DM * 2;
constexpr size_t WS_OUQ = WS_OWI + 2 * SZ_OWI;
constexpr size_t SZ_OUQ = (size_t)3072 * 512 * 2;
constexpr size_t WS_OUKV = WS_OUQ + 2 * SZ_OUQ;
constexpr size_t SZ_OUKV = (size_t)4096 * 512 * 2;
constexpr size_t WS_OWO = WS_OUKV + 2 * SZ_OUKV;
constexpr size_t WS_X = WS_OWO + 2 * SZ_SQ;
constexpr size_t WS_H = WS_X + (size_t)T * DM * 4;
constexpr size_t WS_HID = WS_H + (size_t)T * DM * 2;
constexpr size_t WS_MIX = WS_HID + (size_t)T * DFF * 2;
constexpr size_t WS_PROJ = WS_MIX + (size_t)T * DM * 2;
constexpr size_t WS_U = WS_PROJ + (size_t)T * EV_N * 2;
constexpr size_t SZ_U = (size_t)2 * 8 * NCH * 256 * 128 * 2;
constexpr size_t WS_S = WS_U + SZ_U;
constexpr size_t WS_OI = WS_S + SZ_U;
constexpr size_t WS_QT = WS_OI + (size_t)T * DM * 4;
constexpr size_t WS_DEC = WS_QT + (size_t)2 * T * 1024 * 2;
constexpr size_t WS_END_EVEN = WS_DEC + al256((size_t)2 * 8 * NCH * 128 * 4);
constexpr size_t WS_CQN = WS_U;
constexpr size_t WS_CKVN = WS_CQN + (size_t)T * 512 * 2;
constexpr size_t WS_KR = WS_CKVN + (size_t)T * 512 * 2;
constexpr size_t WS_QB = WS_KR + al256((size_t)T * 64 * 2);
constexpr size_t WS_KVB = WS_QB + (size_t)T * 3072 * 2;
constexpr size_t WS_END_ODD = WS_KVB + (size_t)T * 4096 * 2;
constexpr size_t WS_END = WS_END_EVEN > WS_END_ODD ? WS_END_EVEN : WS_END_ODD;

#define RLX_AGENT __ATOMIC_RELAXED, __HIP_MEMORY_SCOPE_AGENT
#define LDS_WAIT() asm volatile("s_waitcnt lgkmcnt(0)" ::: "memory")
#define VM_WAIT() asm volatile("s_waitcnt vmcnt(0)" ::: "memory")
__device__ __forceinline__ unsigned cvt_pk_bf16(float lo, float hi) { unsigned r; asm volatile("v_cvt_pk_bf16_f32 %0, %1, %2" : "=v"(r) : "v"(lo), "v"(hi)); return r; }
__device__ __forceinline__ float bflo(unsigned w) { return __uint_as_float(w << 16); }
__device__ __forceinline__ float bfhi(unsigned w) { return __uint_as_float(w & 0xffff0000u); }
__device__ __forceinline__ float bf2f(bf16 b) { return __uint_as_float(((unsigned)b) << 16); }
__device__ __forceinline__ bf16 f2bf(float f) { return (bf16)(cvt_pk_bf16(f, 0.f) & 0xffffu); }
__device__ __forceinline__ float wave_sum(float v) {
#pragma unroll
    for (int o = 1; o < 64; o <<= 1) v += __shfl_xor(v, o);
    return v;
}
__device__ __forceinline__ float silu_f(float g) { return g * __builtin_amdgcn_rcpf(1.0f + __builtin_amdgcn_exp2f(-1.4426950408889634f * g)); }

namespace pg8 {
#define PG8_LAS __attribute__((address_space(3)))
typedef unsigned short bf16_t;
constexpr int BM = 256, BK = 64, HALF = 128, HTB = HALF * BK * 2, STAGE_BYTES = 8 * HTB, NXCD = 8, WGM = 8;
__host__ __device__ __forceinline__ int lds_byte(int r, int c) { const int st = (r >> 4) * 2 + (c >> 5), rr = r & 15, cc = c & 31, ob = rr * 64 + cc * 2; return st * 1024 + (ob ^ (((ob >> 9) & 1) << 5)); }
__host__ __device__ __forceinline__ void stage_rc(int b, int& R, int& C) { const int st = b / 1024, sb = b % 1024, swz = sb ^ (((sb >> 9) & 1) << 5); R = (st >> 1) * 16 + swz / 64; C = (st & 1) * 32 + (swz % 64) / 2; }
__host__ __device__ __forceinline__ int perm32(int rho) { const int n = rho >> 4, i = rho & 15; return 8 * (i >> 2) + 4 * n + (i & 3); }
struct Unit { int pm, pn; };
struct Gemm { const bf16_t* A; const bf16_t* Bt; int M, N, K, lda, ldb; };
struct StaticOrder {
    int nM, nN, nwg, G, c;
    __host__ __device__ void init(int M, int N, int G_, int c_) { nM = M / BM; nN = N / BM; nwg = nM * nN; G = G_; c = c_; }
    __host__ __device__ bool next(int i, Unit& u) const {
        const long L = (long)i * G + c; if (L >= nwg) return false;
        int wgid = (int)L; { const int q = nwg / NXCD, r = nwg % NXCD, xcd = wgid % NXCD, off = wgid / NXCD; wgid = (xcd < r ? xcd * (q + 1) : r * (q + 1) + (xcd - r) * q) + off; }
        const int nig = WGM * nN, gid = wgid / nig, fm = gid * WGM, gsz = (nM - fm) < WGM ? (nM - fm) : WGM;
        u.pm = fm + ((wgid % nig) % gsz); u.pn = (wgid % nig) / gsz; return true;
    }
    __device__ __forceinline__ void a_ready(const Unit&) const {}
    __device__ __forceinline__ void done(const Unit&) const {}
};
struct EpiBf16 {
    static constexpr bool PERM = true;
    bf16_t* O; int ldc;
    __device__ __forceinline__ void operator()(const f32x4 (&acc)[2][2][4][2], const Unit& u, int wr, int wc, int fr, int fq) const {
        const int row0 = u.pm * BM + wr * 64 + fr, col0 = u.pn * BM + wc * 32 + 8 * fq;
        asm volatile("s_nop 15" ::: "memory");
#pragma unroll
        for (int ai = 0; ai < 2; ++ai)
#pragma unroll
            for (int m = 0; m < 4; ++m) { bf16_t* rowp = O + (size_t)(row0 + ai * HALF + m * 16) * ldc + col0;
#pragma unroll
                for (int bj = 0; bj < 2; ++bj) { const f32x4 v0 = acc[ai][bj][m][0], v1 = acc[ai][bj][m][1];
                    u32x4 w; w.x = cvt_pk_bf16(v0[0], v0[1]); w.y = cvt_pk_bf16(v0[2], v0[3]); w.z = cvt_pk_bf16(v1[0], v1[1]); w.w = cvt_pk_bf16(v1[2], v1[3]);
                    *(u32x4*)(rowp + bj * HALF) = w; } }
    }
};
struct EpiSwiGLU {
    static constexpr bool PERM = true;
    bf16_t* O; int ldc;
    __device__ __forceinline__ void operator()(const f32x4 (&acc)[2][2][4][2], const Unit& u, int wr, int wc, int fr, int fq) const {
        const int row0 = u.pm * BM + wr * 64 + fr, col0 = u.pn * HALF + wc * 32 + 8 * fq;
#pragma unroll
        for (int ai = 0; ai < 2; ++ai)
#pragma unroll
            for (int m = 0; m < 4; ++m) { bf16_t* rowp = O + (size_t)(row0 + ai * HALF + m * 16) * ldc + col0;
                float h[8];
#pragma unroll
                for (int n = 0; n < 2; ++n)
#pragma unroll
                    for (int j = 0; j < 4; ++j) h[n * 4 + j] = silu_f(acc[ai][0][m][n][j]) * acc[ai][1][m][n][j];
                u32x4 w; w.x = cvt_pk_bf16(h[0], h[1]); w.y = cvt_pk_bf16(h[2], h[3]); w.z = cvt_pk_bf16(h[4], h[5]); w.w = cvt_pk_bf16(h[6], h[7]);
                *(u32x4*)rowp = w; asm volatile("" ::: "memory"); }
    }
};
struct EpiResid {
    static constexpr bool PERM = true;
    float* X; const float* gv; float gs; const float* stat; const float* lng; const float* lnb; int has_ln;
    __device__ __forceinline__ void operator()(const f32x4 (&acc)[2][2][4][2], const Unit& u, int wr, int wc, int fr, int fq) const {
        const int row0 = u.pm * BM + wr * 64 + fr, col0 = u.pn * BM + wc * 32 + 8 * fq;
        f32x2 st[2][4];
#pragma unroll
        for (int ai = 0; ai < 2; ++ai)
#pragma unroll
            for (int m = 0; m < 4; ++m) { st[ai][m] = has_ln ? *(const f32x2*)(stat + (size_t)(row0 + ai * HALF + m * 16) * 2) : (f32x2){0.f, 1.f}; st[ai][m].y *= DN_ALPHA; }
#pragma unroll
        for (int bj = 0; bj < 2; ++bj) { const int c = col0 + bj * HALF;
            f32x4 g[2], G[2], B[2];
#pragma unroll
            for (int n = 0; n < 2; ++n) { g[n] = *(const f32x4*)(gv + c + 4 * n) * gs;
                G[n] = has_ln ? *(const f32x4*)(lng + c + 4 * n) : (f32x4){1.f, 1.f, 1.f, 1.f}; B[n] = has_ln ? *(const f32x4*)(lnb + c + 4 * n) * DN_ALPHA : (f32x4){0.f, 0.f, 0.f, 0.f}; }
#pragma unroll
            for (int ai = 0; ai < 2; ++ai)
#pragma unroll
                for (int m = 0; m < 4; ++m) { float* p = X + (size_t)(row0 + ai * HALF + m * 16) * DM + c;
                    const f32x4 z0 = *(const f32x4*)p, z1 = *(const f32x4*)(p + 4);
                    *(f32x4*)p = (z0 - st[ai][m].x) * st[ai][m].y * G[0] + B[0] + g[0] * acc[ai][bj][m][0];
                    *(f32x4*)(p + 4) = (z1 - st[ai][m].x) * st[ai][m].y * G[1] + B[1] + g[1] * acc[ai][bj][m][1]; }
            asm volatile("" ::: "memory"); }
    }
};

template <class Epi, class Sched, bool ALIGN_EPI = true, bool SP2 = true>
__device__ __forceinline__ void gemm_phase(PG8_LAS unsigned char* lds, const Gemm g, const Sched& S, const Epi& E) {
    int tid = threadIdx.x; asm volatile("" : "+v"(tid));
    const int wid = __builtin_amdgcn_readfirstlane(tid >> 6), lane = tid & 63, wr = wid >> 2, wc = wid & 3, fr = lane & 15, fq = lane >> 4;
    const int K = g.K, nt = K / BK;
    unsigned voffA[2], voffB[2];
#pragma unroll
    for (int i = 0; i < 2; ++i) { int R, C; stage_rc(tid * 16 + i * 8192, R, C); const int Rb = Epi::PERM ? ((R & ~31) + perm32(R & 31)) : R;
        voffA[i] = (unsigned)(R * g.lda + C) * 2u; voffB[i] = (unsigned)(Rb * g.ldb + C) * 2u; }
    const size_t kstep = (size_t)(BK * 2);
    const size_t hstepA = (size_t)HALF * g.lda * 2, hstepB = (size_t)HALF * g.ldb * 2;
    const size_t tstepA = 2 * hstepA, tstepB = 2 * hstepB;
    const unsigned ldsw = (unsigned)wid * 1024u;
    const int aoff = lds_byte(wr * 64 + fr, fq * 8), boff = lds_byte(wc * 32 + fr, fq * 8);
#define PG8_SA(b, h) (((b) * 2 + (h)) * HTB)
#define PG8_SB(b, h) ((4 + (b) * 2 + (h)) * HTB)
#define PG8_STAGE(bufoff, gbase, voff) do { _Pragma("unroll") for (int _i = 0; _i < 2; ++_i) \
        __builtin_amdgcn_global_load_lds((const unsigned*)((const char*)(gbase) + (voff)[_i]), (PG8_LAS unsigned*)(lds + (bufoff) + ldsw + _i * 8192), 16, 0, 0); } while (0)
#define PG8_LDA(dst, b, h) do { _Pragma("unroll") for (int m = 0; m < 4; ++m) _Pragma("unroll") for (int k = 0; k < 2; ++k) dst[m][k] = *(const PG8_LAS bf16x8*)(lds + PG8_SA(b, h) + aoff + m * 2048 + k * 1024); } while (0)
#define PG8_LDB(dst, b, h) do { _Pragma("unroll") for (int n = 0; n < 2; ++n) _Pragma("unroll") for (int k = 0; k < 2; ++k) dst[n][k] = *(const PG8_LAS bf16x8*)(lds + PG8_SB(b, h) + boff + n * 2048 + k * 1024); } while (0)
#define PG8_MMA(ai, bj, At, Bt) do { __builtin_amdgcn_s_setprio(1); _Pragma("unroll") for (int m = 0; m < 4; ++m) _Pragma("unroll") for (int n = 0; n < 2; ++n) _Pragma("unroll") for (int k = 0; k < 2; ++k) \
        acc[ai][bj][m][n] = __builtin_amdgcn_mfma_f32_16x16x32_bf16(Bt[n][k], At[m][k], acc[ai][bj][m][n], 0, 0, 0); __builtin_amdgcn_s_setprio(0); } while (0)
#define PG8_WAIT_V(n) asm volatile("s_waitcnt vmcnt(" #n ")" ::: "memory")
#define PG8_WAIT_L(n) asm volatile("s_waitcnt lgkmcnt(" #n ")" ::: "memory")
#define PG8_BAR __builtin_amdgcn_s_barrier()
#define PG8_SCHED __builtin_amdgcn_sched_barrier(0)
    Unit cur, nxt; int ui = 0;
    if (!S.next(0, cur)) return;
    f32x4 acc[2][2][4][2];
#pragma unroll
    for (int a = 0; a < 2; ++a)
#pragma unroll
        for (int b = 0; b < 2; ++b)
#pragma unroll
            for (int m = 0; m < 4; ++m)
#pragma unroll
                for (int n = 0; n < 2; ++n) acc[a][b][m][n] = (f32x4){0.f, 0.f, 0.f, 0.f};
    bf16x8 At[4][2], B0[2][2], B1[2][2];
    const char* cA = (const char*)g.A + (size_t)cur.pm * tstepA; const char* cB = (const char*)g.Bt + (size_t)cur.pn * tstepB;
    S.a_ready(cur);
    if constexpr (SP2) {
        PG8_STAGE(PG8_SB(0, 0), cB, voffB); PG8_STAGE(PG8_SB(0, 1), cB + hstepB, voffB); PG8_STAGE(PG8_SA(0, 0), cA, voffA); PG8_STAGE(PG8_SA(0, 1), cA + hstepA, voffA);
        if (wr == 1) PG8_BAR;
        PG8_WAIT_V(2); PG8_BAR;
        PG8_STAGE(PG8_SB(1, 0), cB + kstep, voffB); PG8_STAGE(PG8_SA(1, 0), cA + kstep, voffA); PG8_STAGE(PG8_SB(1, 1), cB + hstepB + kstep, voffB);
        PG8_WAIT_V(6); PG8_BAR;
    } else {
        PG8_STAGE(PG8_SB(0, 0), cB, voffB); PG8_STAGE(PG8_SA(0, 0), cA, voffA); PG8_STAGE(PG8_SB(0, 1), cB + hstepB, voffB); PG8_STAGE(PG8_SA(0, 1), cA + hstepA, voffA);
        if (wr == 1) PG8_BAR;
        PG8_WAIT_V(4); PG8_BAR;
        PG8_STAGE(PG8_SB(1, 0), cB + kstep, voffB); PG8_STAGE(PG8_SA(1, 0), cA + kstep, voffA); PG8_STAGE(PG8_SB(1, 1), cB + hstepB + kstep, voffB);
        PG8_WAIT_V(6); PG8_BAR;
    }
    for (;;) {
        const bool has_next = S.next(ui + 1, nxt);
        const char* nA = has_next ? (const char*)g.A + (size_t)nxt.pm * tstepA : cA; const char* nB = has_next ? (const char*)g.Bt + (size_t)nxt.pn * tstepB : cB;
        for (int t = 0; t < nt; t += 2) {
            const bool last = (t == nt - 2);
            const char* a1 = cA + (size_t)(t + 1) * kstep;
            const char* a2 = last ? nA : cA + (size_t)(t + 2) * kstep; const char* b2 = last ? nB : cB + (size_t)(t + 2) * kstep;
            const char* a3 = a2 + kstep; const char* b3 = b2 + kstep;
            if (last && has_next) S.a_ready(nxt);
            if constexpr (SP2) {
            PG8_LDB(B0, 0, 0); PG8_LDB(B1, 0, 1); PG8_SCHED; PG8_LDA(At, 0, 0); PG8_STAGE(PG8_SA(1, 1), a1 + hstepA, voffA);
            PG8_WAIT_V(8); PG8_WAIT_L(0); PG8_BAR; PG8_MMA(0, 0, At, B0); PG8_MMA(0, 1, At, B1); PG8_BAR; PG8_SCHED;
            PG8_LDA(At, 0, 1); PG8_STAGE(PG8_SB(0, 0), b2, voffB); PG8_STAGE(PG8_SB(0, 1), b2 + hstepB, voffB); PG8_STAGE(PG8_SA(0, 0), a2, voffA);
            PG8_WAIT_V(8); PG8_WAIT_L(0); PG8_BAR; PG8_MMA(1, 0, At, B0); PG8_MMA(1, 1, At, B1); PG8_BAR; PG8_SCHED;
            PG8_LDB(B0, 1, 0); PG8_LDB(B1, 1, 1); PG8_SCHED; PG8_LDA(At, 1, 0); PG8_STAGE(PG8_SA(0, 1), a2 + hstepA, voffA);
            PG8_WAIT_V(8); PG8_WAIT_L(0); PG8_BAR; PG8_MMA(0, 0, At, B0); PG8_MMA(0, 1, At, B1); PG8_BAR; PG8_SCHED;
            PG8_LDA(At, 1, 1); PG8_STAGE(PG8_SB(1, 0), b3, voffB); PG8_STAGE(PG8_SB(1, 1), b3 + hstepB, voffB); PG8_STAGE(PG8_SA(1, 0), a3, voffA);
            PG8_WAIT_V(8); PG8_WAIT_L(0); PG8_BAR; PG8_MMA(1, 0, At, B0); PG8_MMA(1, 1, At, B1); PG8_BAR; PG8_SCHED;
            } else {
            PG8_LDB(B0, 0, 0); PG8_SCHED; PG8_LDA(At, 0, 0); PG8_STAGE(PG8_SA(1, 1), a1 + hstepA, voffA);
            PG8_WAIT_L(8); PG8_BAR; PG8_WAIT_L(0); PG8_MMA(0, 0, At, B0); PG8_BAR; PG8_SCHED;
            PG8_LDB(B1, 0, 1); PG8_STAGE(PG8_SB(0, 0), b2, voffB);
            PG8_BAR; PG8_WAIT_L(0); PG8_MMA(0, 1, At, B1); PG8_BAR;
            PG8_LDA(At, 0, 1); PG8_STAGE(PG8_SA(0, 0), a2, voffA);
            PG8_BAR; PG8_WAIT_L(0); PG8_MMA(1, 0, At, B0); PG8_BAR; PG8_SCHED;
            PG8_STAGE(PG8_SB(0, 1), b2 + hstepB, voffB);
            PG8_WAIT_V(6); PG8_BAR; PG8_MMA(1, 1, At, B1); PG8_BAR;
            PG8_LDB(B0, 1, 0); PG8_SCHED; PG8_LDA(At, 1, 0); PG8_STAGE(PG8_SA(0, 1), a2 + hstepA, voffA);
            PG8_WAIT_L(8); PG8_BAR; PG8_WAIT_L(0); PG8_MMA(0, 0, At, B0); PG8_BAR; PG8_SCHED;
            PG8_LDB(B1, 1, 1); PG8_STAGE(PG8_SB(1, 0), b3, voffB);
            PG8_BAR; PG8_WAIT_L(0); PG8_MMA(0, 1, At, B1); PG8_BAR;
            PG8_LDA(At, 1, 1); PG8_STAGE(PG8_SA(1, 0), a3, voffA);
            PG8_BAR; PG8_WAIT_L(0); PG8_MMA(1, 0, At, B0); PG8_BAR; PG8_SCHED;
            PG8_STAGE(PG8_SB(1, 1), b3 + hstepB, voffB);
            PG8_WAIT_V(6); PG8_BAR; PG8_MMA(1, 1, At, B1); PG8_BAR;
            }
        }
        if constexpr (ALIGN_EPI) { if (wr == 0) PG8_BAR; }
        E(acc, cur, wr, wc, fr, fq); S.done(cur);
        if (!has_next) break;
#pragma unroll
        for (int a = 0; a < 2; ++a)
#pragma unroll
            for (int b = 0; b < 2; ++b)
#pragma unroll
                for (int m = 0; m < 4; ++m)
#pragma unroll
                    for (int n = 0; n < 2; ++n) acc[a][b][m][n] = (f32x4){0.f, 0.f, 0.f, 0.f};
        cur = nxt; cA = nA; cB = nB; ++ui;
        if constexpr (ALIGN_EPI) { if (wr == 1) PG8_BAR; }
    }
    PG8_WAIT_V(0);
    if constexpr (!ALIGN_EPI) { if (wr == 0) PG8_BAR; }
    PG8_BAR;
#undef PG8_SA
#undef PG8_SB
#undef PG8_STAGE
#undef PG8_LDA
#undef PG8_LDB
#undef PG8_MMA
#undef PG8_WAIT_V
#undef PG8_WAIT_L
#undef PG8_BAR
#undef PG8_SCHED
}
}

#define XB_TMO      128
#define XB_XCNT(j)  (256  + 64 * (j))
#define XB_XSUB(j)  (1280 + 64 * (j))
#define XB_XGEN(j)  (2304 + 64 * (j))
#define XB_TOP      3328
#define XB_TOPGEN   3392
#define XCD_BAR_WORDS 3456
#define XB_SPIN_CAP (1u << 18)
__device__ __forceinline__ unsigned xb_ld(unsigned* p)              { return __hip_atomic_load(p, __ATOMIC_RELAXED, __HIP_MEMORY_SCOPE_AGENT); }
__device__ __forceinline__ unsigned xb_add(unsigned* p, unsigned v) { return __hip_atomic_fetch_add(p, v, __ATOMIC_RELAXED, __HIP_MEMORY_SCOPE_AGENT); }
__device__ __forceinline__ unsigned xb_xcc_id() { return (unsigned)__builtin_amdgcn_s_getreg((3 << 11) | 20) & 0xFu; }
#define XB_SPIN(cond, bar) do { unsigned _sp = 0; while (cond) { __builtin_amdgcn_s_sleep(1); \
    if ((++_sp & 255u) == 0u) { if (xb_ld(&(bar)[XB_TMO])) break; if (_sp > XB_SPIN_CAP) { atomicAdd(&(bar)[XB_TMO], 1u); break; } } } } while (0)
struct XcdBarrier { unsigned* bar; unsigned x; volatile LAS unsigned* st; };
__device__ __forceinline__ XcdBarrier xcd_barrier_post(unsigned* bar, volatile LAS unsigned* st) {
    XcdBarrier b; b.bar = bar; b.x = xb_xcc_id(); b.st = st;
    if (threadIdx.x == 0) (void)xb_add(&bar[XB_XCNT(b.x)], 1u);
    return b;
}
__device__ __forceinline__ void xcd_barrier_complete(unsigned* bar, unsigned x, unsigned& nloc, unsigned& nx) {
    const unsigned G = gridDim.x * gridDim.y * gridDim.z;
    unsigned sum, cnt, mine, sp = 0u;
    for (;;) {
        sum = 0u; cnt = 0u; mine = 0u;
#pragma unroll
        for (unsigned j = 0; j < 16; ++j) { const unsigned c = xb_ld(&bar[XB_XCNT(j)]); sum += c; cnt += (c > 0u) ? 1u : 0u; mine = (j == x) ? c : mine; }
        if (sum == G) break;
        __builtin_amdgcn_s_sleep(1);
        if ((++sp & 255u) == 0u) { if (xb_ld(&bar[XB_TMO])) break; if (sp > XB_SPIN_CAP) { atomicAdd(&bar[XB_TMO], 1u); break; } }
    }
    nloc = mine > 0u ? mine : 1u; nx = cnt > 0u ? cnt : 1u;
}
__device__ __forceinline__ void xcd_barrier(const XcdBarrier& b0) {
    asm volatile("s_waitcnt vmcnt(0)" ::: "memory");
    __syncthreads();
    if (threadIdx.x == 0) {
        XcdBarrier b = b0; b.x = xb_xcc_id();
        unsigned* bar = b.bar;
        __builtin_amdgcn_s_waitcnt(0);
        unsigned nloc = b.st[0], nx = b.st[1];
        if (nloc == 0u) { xcd_barrier_complete(bar, b.x, nloc, nx); b.st[0] = nloc; b.st[1] = nx; }
        const unsigned old = xb_add(&bar[XB_XSUB(b.x)], 1u);
        const unsigned gen = old / nloc;
        if (old + 1u == (gen + 1u) * nloc) {
            __builtin_amdgcn_fence(__ATOMIC_RELEASE, "agent");
            asm volatile("s_waitcnt vmcnt(0)" ::: "memory");
            const unsigned og = xb_add(&bar[XB_TOP], 1u);
            const unsigned tg = og / nx;
            if (og + 1u == (tg + 1u) * nx) xb_add(&bar[XB_TOPGEN], 1u);
            else XB_SPIN(xb_ld(&bar[XB_TOPGEN]) == tg, bar);
            __builtin_amdgcn_fence(__ATOMIC_ACQUIRE, "agent");
            xb_add(&bar[XB_XGEN(b.x)], 1u);
            asm volatile("s_waitcnt vmcnt(0)" ::: "memory");
        } else {
            XB_SPIN(xb_ld(&bar[XB_XGEN(b.x)]) == gen, bar);
            __builtin_amdgcn_fence(__ATOMIC_ACQUIRE, "agent");
            asm volatile("s_waitcnt vmcnt(0)" ::: "memory");
        }
    }
    __syncthreads();
}

struct Args { const float* in[23]; float* out; unsigned char* ws; };
struct Frame {
    LAS unsigned char* lds;
    int vcu, G;
    const Args* a; unsigned char* ws;
};
#define PHASE_IDS() int tid = threadIdx.x; asm volatile("" : "+v"(tid)); const int lane = tid & 63, wave = __builtin_amdgcn_readfirstlane(tid >> 6); (void)lane; (void)wave
#define MFMA16(a, b, c) __builtin_amdgcn_mfma_f32_16x16x32_bf16((a), (b), (c), 0, 0, 0)
#define MFMA32(a, b, c) __builtin_amdgcn_mfma_f32_32x32x16_bf16((a), (b), (c), 0, 0, 0)

__device__ __forceinline__ void tr_item(const float* W, int N, int K, bf16* WT, int k0, int n0, int drow0, LAS float* scr, int lane) {
#pragma unroll 8
    for (int i = 0; i < 32; ++i) { const int kk = 2 * i + (lane >> 5); scr[kk * 33 + (lane & 31)] = W[(size_t)(k0 + kk) * N + n0 + (lane & 31)]; }
    LDS_WAIT(); asm volatile("" ::: "memory");
    const int c = lane & 7;
#pragma unroll
    for (int j = 0; j < 4; ++j) { const int n = (lane >> 3) + 8 * j; const LAS float* s = scr + (8 * c) * 33 + n;
        u32x4 o; o.x = cvt_pk_bf16(s[0 * 33], s[1 * 33]); o.y = cvt_pk_bf16(s[2 * 33], s[3 * 33]); o.z = cvt_pk_bf16(s[4 * 33], s[5 * 33]); o.w = cvt_pk_bf16(s[6 * 33], s[7 * 33]);
        *(u32x4*)(WT + (size_t)(drow0 + n) * K + k0 + 8 * c) = o; }
    LDS_WAIT(); asm volatile("" ::: "memory");
}
__device__ __forceinline__ void p0a(Frame& F) {
    PHASE_IDS();
    LAS float* scr = (LAS float*)(F.lds + wave * 8704);
    LAS float* sv = (LAS float*)(F.lds + 8 * 8704);
    for (int i = tid; i < 2 * DM; i += NTHR) { const float v = (i < DM) ? F.a->in[1][i] : F.a->in[3][i - DM]; sv[i] = v / (1.0f + __expf(-v)); }
    __syncthreads();
    const int gw = F.vcu * NWAVES + wave, NGW = F.G * NWAVES;
    constexpr int I0 = 8 * 32 * 344, I1 = 8 * 86 * 64, I2 = 2 * 32 * 193, I3 = 2 * 32 * 64, I4 = 2 * 32 * 34, I5 = 2 * 8 * 96, I6 = 2 * 8 * 128, I7 = 2 * 32 * 64;
    constexpr int NTR = I0 + I1 + I2 + I3 + I4 + I5 + I6 + I7, NADAI = 8 * 288;
    for (int it = gw; it < NTR + NADAI; it += NGW) {
        int r = it;
        if (r < I0) { const int mat = r / 11008, q = r % 11008, kb = q / 344, nb = q % 344, n0 = nb * 32;
            const int j = n0 < DFF ? n0 : n0 - DFF, drow = (j / 128) * 256 + (j % 128) + (n0 < DFF ? 0 : 128);
            tr_item(F.a->in[8] + (size_t)mat * DM * 2 * DFF, 2 * DFF, DM, (bf16*)(F.ws + WS_WFI + mat * SZ_WFI), kb * 64, n0, drow - 0, scr, lane); continue; } r -= I0;
        if (r < I1) { const int mat = r / 5504, q = r % 5504, kb = q / 64, nb = q % 64;
            tr_item(F.a->in[9] + (size_t)mat * DFF * DM, DM, DFF, (bf16*)(F.ws + WS_WFO + mat * SZ_WFO), kb * 64, nb * 32, nb * 32, scr, lane); continue; } r -= I1;
        if (r < I2) { const int mat = r / 6176, q = r % 6176, kb = q / 193, nb = q % 193, n0 = nb * 32;
            const int drow = n0 < 3072 ? n0 : (n0 < 3104 ? 6144 : n0 - 32);
            tr_item(F.a->in[10] + (size_t)mat * DM * 6176, 6176, DM, (bf16*)(F.ws + WS_EWI + mat * SZ_EWI), kb * 64, n0, drow, scr, lane); continue; } r -= I2;
        if (r < I3) { const int mat = r / 2048, q = r % 2048, kb = q / 64, nb = q % 64;
            tr_item(F.a->in[16] + (size_t)mat * DM * DM, DM, DM, (bf16*)(F.ws + WS_EWO + mat * SZ_SQ), kb * 64, nb * 32, nb * 32, scr, lane); continue; } r -= I3;
        if (r < I4) { const int mat = r / 1088, q = r % 1088, kb = q / 34, nb = q % 34;
            tr_item(F.a->in[17] + (size_t)mat * DM * 1088, 1088, DM, (bf16*)(F.ws + WS_OWI + mat * SZ_OWI), kb * 64, nb * 32, nb * 32, scr, lane); continue; } r -= I4;
        if (r < I5) { const int mat = r / 768, q = r % 768, kb = q / 96, nb = q % 96;
            tr_item(F.a->in[20] + (size_t)mat * 512 * 3072, 3072, 512, (bf16*)(F.ws + WS_OUQ + mat * SZ_OUQ), kb * 64, nb * 32, nb * 32, scr, lane); continue; } r -= I5;
        if (r < I6) { const int mat = r / 1024, q = r % 1024, kb = q / 128, nb = q % 128;
            tr_item(F.a->in[21] + (size_t)mat * 512 * 4096, 4096, 512, (bf16*)(F.ws + WS_OUKV + mat * SZ_OUKV), kb * 64, nb * 32, nb * 32, scr, lane); continue; } r -= I6;
        if (r < I7) { const int mat = r / 2048, q = r % 2048, kb = q / 64, nb = q % 64;
            tr_item(F.a->in[22] + (size_t)mat * DM * DM, DM, DM, (bf16*)(F.ws + WS_OWO + mat * SZ_SQ), kb * 64, nb * 32, nb * 32, scr, lane); continue; } r -= I7;
        {
            const int ks = r / 288, cg = r % 288, l = cg / 72, n = (cg % 72) * 256 + lane * 4;
            const float* w = F.a->in[4] + ((size_t)l * DM + ks * 256) * NADA + n;
            f32x4 al = {0.f, 0.f, 0.f, 0.f}, ac = {0.f, 0.f, 0.f, 0.f};
#pragma unroll 8
            for (int k = 0; k < 256; ++k) { const f32x4 wv = *(const f32x4*)(w + (size_t)k * NADA); al += wv * sv[ks * 256 + k]; ac += wv * sv[DM + ks * 256 + k]; }
            float* mp = (float*)(F.ws + WS_MODP);
            *(f32x4*)(mp + (size_t)(ks * 2 + 0) * 4 * NADA + l * NADA + n) = al;
            *(f32x4*)(mp + (size_t)(ks * 2 + 1) * 4 * NADA + l * NADA + n) = ac;
        }
    }
    const int gt = F.vcu * NTHR + tid, NGT = F.G * NTHR;
    for (int i = gt; i < NLAT * 64 + 256 * 16 + 64 * 16; i += NGT) {
        int pos, fi; float inv; f32x2* dst;
        if (i < NLAT * 64) { pos = i >> 6; fi = i & 63; inv = __builtin_amdgcn_exp2f(-(float)fi * (13.287712379549449f / 64.0f)); dst = (f32x2*)(F.ws + WS_RT) + i; }
        else if (i < NLAT * 64 + 4096) { const int j = i - NLAT * 64; pos = j >> 4; fi = j & 15; inv = __builtin_amdgcn_exp2f(-(float)fi * (13.287712379549449f / 16.0f)); dst = (f32x2*)(F.ws + WS_AXR) + j; }
        else { const int j = i - NLAT * 64 - 4096; pos = j >> 4; fi = j & 15; inv = __builtin_amdgcn_exp2f(-(float)fi * (13.287712379549449f / 16.0f)); dst = (f32x2*)(F.ws + WS_AXC) + j; }
        const float ang = (float)pos * inv;
        double rev = (double)ang * 0.15915494309189535; rev -= __builtin_floor(rev);
        const float rv = (float)rev;
        *dst = (f32x2){__builtin_amdgcn_cosf(rv), __builtin_amdgcn_sinf(rv)};
    }
}
__device__ __forceinline__ void p0b(Frame& F) {
    PHASE_IDS();
    const int gt = F.vcu * NTHR + tid, NGT = F.G * NTHR;
    const float* mp = (const float*)(F.ws + WS_MODP); float* mo = (float*)(F.ws + WS_MOD);
    for (int i = gt; i < 4 * 2 * NADA; i += NGT) { const int l = i / (2 * NADA), v = (i / NADA) & 1, n = i % NADA;
        float s = F.a->in[5][l * NADA + n];
#pragma unroll
        for (int ks = 0; ks < 8; ++ks) s += mp[(size_t)(ks * 2 + v) * 4 * NADA + l * NADA + n];
        mo[i] = s; }
}
__device__ __forceinline__ const float* modp(Frame& F, int l, int v, int idx) { return (const float*)(F.ws + WS_MOD) + ((size_t)(l * 2 + v) * 9 + idx) * DM; }

template <int MODE>
__device__ __forceinline__ void row_phase(Frame& F, const float* lng, const float* lnb, const float* sh_l, const float* sc_l, const float* sh_c, const float* sc_c) {
    PHASE_IDS();
    LAS float* V = (LAS float*)F.lds;
    for (int i = tid; i < DM; i += NTHR) { if (MODE != 0) { V[i] = lng[i]; V[DM + i] = lnb[i]; } if (MODE != 2) { V[2 * DM + i] = sh_l[i]; V[3 * DM + i] = sc_l[i]; V[4 * DM + i] = sh_c[i]; V[5 * DM + i] = sc_c[i]; } }
    __syncthreads();
    const int gw = F.vcu * NWAVES + wave, NGW = F.G * NWAVES;
    float* X = (float*)(F.ws + WS_X); bf16* H = (bf16*)(F.ws + WS_H);
    for (int t = gw; t < T; t += NGW) {
        if (MODE == 2 && t < NCTX) continue;
        const float* src = (MODE == 0) ? (t < NCTX ? F.a->in[2] + (size_t)t * DM : F.a->in[0] + (size_t)(t - NCTX) * DM) : X + (size_t)t * DM;
        f32x4 v[8]; float s = 0.f; float mean_ = 0.f, rstd_ = 1.f;
#pragma unroll
        for (int j = 0; j < 8; ++j) { v[j] = *((const f32x4*)src + lane + 64 * j); s += (v[j].x + v[j].y) + (v[j].z + v[j].w); }
        if (MODE != 0) {
            const float mean = wave_sum(s) * (1.f / DM); float s2 = 0.f;
#pragma unroll
            for (int j = 0; j < 8; ++j) { v[j] = v[j] - mean; s2 += (v[j].x * v[j].x + v[j].y * v[j].y) + (v[j].z * v[j].z + v[j].w * v[j].w); }
            const float rstd = 1.f / sqrtf(wave_sum(s2) * (1.f / DM) + LN_EPS); mean_ = mean; rstd_ = rstd;
#pragma unroll
            for (int j = 0; j < 8; ++j) { const f32x4 g = *((const LAS f32x4*)V + lane + 64 * j), b = *((const LAS f32x4*)(V + DM) + lane + 64 * j); v[j] = v[j] * rstd * g + b; }
        }
        if (MODE == 1 && lane == 0) *(f32x2*)((float*)(F.ws + WS_STAT) + (size_t)t * 2) = (f32x2){mean_, rstd_};
        if (MODE == 2) {
            float* o = F.a->out + (size_t)(t - NCTX) * DM;
#pragma unroll
            for (int j = 0; j < 8; ++j) *((f32x4*)o + lane + 64 * j) = v[j];
        } else {
            float* o = X + (size_t)t * DM; bf16* h = H + (size_t)t * DM;
            const LAS float* shv = V + (t < NCTX ? 4 * DM : 2 * DM); const LAS float* scv = V + (t < NCTX ? 5 * DM : 3 * DM);
#pragma unroll
            for (int j = 0; j < 8; ++j) {
                const f32x4 sh = *((const LAS f32x4*)shv + lane + 64 * j), sc = *((const LAS f32x4*)scv + lane + 64 * j);
                const f32x4 m = v[j] * (sc + 1.0f) + sh; u32x2 w; w.x = cvt_pk_bf16(m.x, m.y); w.y = cvt_pk_bf16(m.z, m.w);
                *((u32x2*)h + lane + 64 * j) = w; }
        }
    }
    __syncthreads();
}


__device__ __forceinline__ void ctx_resid_small(Frame& F, float* X, const bf16* A, const bf16* Bt, int K, const float* gv, float gs, const float* stat, const float* lng, const float* lnb, int has_ln) {
    PHASE_IDS(); const int fr = lane & 15, fq = lane >> 4;
    const int nks = K >> 5, last = wave + 8 * ((nks - 1 - wave) >> 3), trips = (((nks + 7) >> 3) + 3) & ~3;
    for (int item = blockIdx.x; item < 256; item += F.G) {
        const int mt = item >> 5, nt = item & 31;
        f32x4 acc[2][4];
#pragma unroll
        for (int i = 0; i < 2; ++i)
#pragma unroll
            for (int j = 0; j < 4; ++j) acc[i][j] = (f32x4){0.f, 0.f, 0.f, 0.f};
        const bf16* Ap = A + (size_t)(32 * mt + fr) * K + 8 * fq;
        const bf16* Bp = Bt + (size_t)(64 * nt + fr) * K + 8 * fq;
        bf16x8 a0[2], b0[4], a1[2], b1[4], a2[2], b2[4], a3[2], b3[4];
#define CS_LOAD(a, b, i_) do { const int so_ = 32 * min(wave + 8 * (i_), last); _Pragma("unroll") for (int i = 0; i < 2; ++i) a[i] = *(const bf16x8*)(Ap + (size_t)(16 * i) * K + so_); \
        _Pragma("unroll") for (int i = 0; i < 4; ++i) b[i] = *(const bf16x8*)(Bp + (size_t)(16 * i) * K + so_); } while (0)
#define CS_MMA(a, b, i_) do { __builtin_amdgcn_sched_barrier(0); if (wave + 8 * (i_) < nks) { _Pragma("unroll") for (int i = 0; i < 2; ++i) _Pragma("unroll") for (int j = 0; j < 4; ++j) acc[i][j] = MFMA16(a[i], b[j], acc[i][j]); } __builtin_amdgcn_sched_barrier(0); } while (0)
        CS_LOAD(a0, b0, 0); CS_LOAD(a1, b1, 1); CS_LOAD(a2, b2, 2);
        for (int it = 0; it < trips; it += 4) {
            CS_LOAD(a3, b3, it + 3); CS_MMA(a0, b0, it);
            CS_LOAD(a0, b0, it + 4); CS_MMA(a1, b1, it + 1);
            CS_LOAD(a1, b1, it + 5); CS_MMA(a2, b2, it + 2);
            CS_LOAD(a2, b2, it + 6); CS_MMA(a3, b3, it + 3);
        }
#undef CS_LOAD
#undef CS_MMA
        LAS float* P = (LAS float*)F.lds + wave * 2048;
#pragma unroll
        for (int i = 0; i < 2; ++i)
#pragma unroll
            for (int j = 0; j < 4; ++j)
#pragma unroll
                for (int r = 0; r < 4; ++r) P[(16 * i + 4 * fq + r) * 64 + 16 * j + fr] = acc[i][j][r];
        __syncthreads();
        const int row = tid >> 4, c0 = (tid & 15) * 4;
        f32x4 s0 = {0.f, 0.f, 0.f, 0.f};
#pragma unroll
        for (int w = 0; w < 8; ++w) s0 += *(const LAS f32x4*)((LAS float*)F.lds + w * 2048 + row * 64 + c0);
        float* xp = X + (size_t)(32 * mt + row) * DM + 64 * nt + c0;
        const f32x4 g0 = *(const f32x4*)(gv + 64 * nt + c0) * gs;
        f32x4 x0 = *(const f32x4*)xp;
        if (has_ln) { const f32x2 st = *(const f32x2*)(stat + (size_t)(32 * mt + row) * 2); x0 = (x0 - st.x) * st.y * *(const f32x4*)(lng + 64 * nt + c0) + *(const f32x4*)(lnb + 64 * nt + c0); }
        *(f32x4*)xp = x0 * DN_ALPHA + g0 * s0;
        __syncthreads();
    }
}


__device__ __forceinline__ void init_x_by_owners(Frame& F) {
    PHASE_IDS();
    float* X = (float*)(F.ws + WS_X);
    pg8::StaticOrder S; S.init(NLAT, DM, F.G, (int)blockIdx.x); pg8::Unit u;
    for (int i = 0; S.next(i, u); ++i) {
        const int c4 = (tid & 63) * 4, r0 = tid >> 6;
#pragma unroll 4
        for (int rr = r0; rr < 256; rr += 8) { const size_t lr = (size_t)u.pm * 256 + rr; *(f32x4*)(X + (lr + NCTX) * DM + u.pn * 256 + c4) = *(const f32x4*)(F.a->in[0] + lr * DM + u.pn * 256 + c4); }
    }
    for (int item = blockIdx.x; item < 256; item += F.G) { const int mt = item >> 5, nt = item & 31, row = tid >> 4, c0 = (tid & 15) * 4;
        const size_t o = (size_t)(32 * mt + row) * DM + 64 * nt + c0; *(f32x4*)(X + o) = *(const f32x4*)(F.a->in[2] + o); }
}

constexpr int L1_QRAW = 0, L1_KRAW = 16384, L1_GD = 32768, L1_PART = 36864, L1_QT = 40960, L1_KT = 58368, L1_KTT = 75776, L1_VT = 94208, L1_P = 131072;
constexpr float INV_SQRT_DK = 0.08838834764831845f;

template <int DIR>
__device__ __forceinline__ void s1_dir(Frame& F, int e, int hh, int c, bool lat, f32x4 (&pacc)[2], const float (&wv)[16], const float bgv, const f32x2 (&csv)[16]) {
    const bool is_gla = hh < 4; const int hd = hh & 3, t0 = c * 64;
    PHASE_IDS(); const int w = wave, fr = lane & 15, fq = lane >> 4;
    LAS unsigned char* lds = F.lds;
    const int ch = tid & 127, tq = tid >> 7;
    float lgv[16];
    if (is_gla) {
#pragma unroll
        for (int i = 0; i < 16; ++i) { const int tt = 16 * tq + (DIR ? 15 - i : i);
            const u32x4 g0 = *(const LAS u32x4*)(lds + L1_GD + tt * 64 + DIR * 32), g1 = *(const LAS u32x4*)(lds + L1_GD + tt * 64 + DIR * 32 + 16);
            float x = bgv;
            x += bflo(g0.x) * wv[0] + bfhi(g0.x) * wv[1] + bflo(g0.y) * wv[2] + bfhi(g0.y) * wv[3] + bflo(g0.z) * wv[4] + bfhi(g0.z) * wv[5] + bflo(g0.w) * wv[6] + bfhi(g0.w) * wv[7];
            x += bflo(g1.x) * wv[8] + bfhi(g1.x) * wv[9] + bflo(g1.y) * wv[10] + bfhi(g1.y) * wv[11] + bflo(g1.z) * wv[12] + bfhi(g1.z) * wv[13] + bflo(g1.w) * wv[14] + bfhi(g1.w) * wv[15];
            lgv[i] = (fminf(x, 0.f) - __logf(1.0f + __expf(-fabsf(x)))) * (1.0f / 16.0f); }
    } else {
        const float lg = log1pf(-exp2f((DIR ? -5.5f : -5.0f) - (float)hd));
#pragma unroll
        for (int i = 0; i < 16; ++i) lgv[i] = lg;
    }
    float ls = 0.f;
#pragma unroll
    for (int i = 0; i < 16; ++i) ls += lgv[i];
    LAS float* part = (LAS float*)(lds + L1_PART);
    part[tq * 128 + ch] = ls;
    __syncthreads();
    float b = 0.f;
#pragma unroll
    for (int q = 0; q < 4; ++q) { const float pv = part[q * 128 + ch]; if (DIR ? (q > tq) : (q < tq)) b += pv; }
    bf16* QTg = (bf16*)(F.ws + WS_QT) + (size_t)DIR * T * 1024;
    float kt[16];
#pragma unroll
    for (int i = 0; i < 16; ++i) { const int tt = 16 * tq + (DIR ? 15 - i : i);
        b += lgv[i];
        float qv = bf2f(*(const LAS bf16*)(lds + L1_QRAW + tt * 256 + ch * 2)), kv = bf2f(*(const LAS bf16*)(lds + L1_KRAW + tt * 256 + ch * 2));
        if (!is_gla && lat) {
            const float qp = bf2f(*(const LAS bf16*)(lds + L1_QRAW + tt * 256 + (ch ^ 64) * 2)), kp = bf2f(*(const LAS bf16*)(lds + L1_KRAW + tt * 256 + (ch ^ 64) * 2));
            const f32x2 cs = csv[DIR ? 15 - i : i];
            if (ch < 64) { qv = qv * cs.x - qp * cs.y; kv = kv * cs.x - kp * cs.y; } else { qv = qv * cs.x + qp * cs.y; kv = kv * cs.x + kp * cs.y; }
        }
        const float eb = __expf(b), ebi = __expf(-b);
        const float qs = qv * eb * (is_gla ? INV_SQRT_DK : 1.0f), ks = kv * ebi * (is_gla ? 1.0f : INV_SQRT_DK);
        const bf16 qb = f2bf(qs);
        *(LAS bf16*)(lds + L1_QT + tt * 272 + ch * 2) = qb;
        *(LAS bf16*)(lds + L1_KT + tt * 272 + ch * 2) = f2bf(ks);
        kt[DIR ? 15 - i : i] = ks;
        if (i == 15 && tq == (DIR ? 0 : 3)) ((float*)(F.ws + WS_DEC))[((size_t)(DIR * 8 + hh) * NCH + c) * 128 + ch] = eb;
    }
    { u32x4 w0, w1; w0.x = cvt_pk_bf16(kt[0], kt[1]); w0.y = cvt_pk_bf16(kt[2], kt[3]); w0.z = cvt_pk_bf16(kt[4], kt[5]); w0.w = cvt_pk_bf16(kt[6], kt[7]);
      w1.x = cvt_pk_bf16(kt[8], kt[9]); w1.y = cvt_pk_bf16(kt[10], kt[11]); w1.z = cvt_pk_bf16(kt[12], kt[13]); w1.w = cvt_pk_bf16(kt[14], kt[15]);
      *(LAS u32x4*)(lds + L1_KTT + ch * 144 + tq * 32) = w0; *(LAS u32x4*)(lds + L1_KTT + ch * 144 + tq * 32 + 16) = w1; }
    __syncthreads();
#pragma unroll
    for (int i = 0; i < 2; ++i) { const int id = tid + 512 * i, r = id >> 4, cc = id & 15;
        *(u32x4*)(QTg + (size_t)(t0 + r) * 1024 + hh * 128 + cc * 8) = *(const LAS u32x4*)(lds + L1_QT + r * 272 + cc * 16); }
    { const int mi = w >> 1, nj0 = 2 * (w & 1);
      f32x4 pd[2] = {{0.f, 0.f, 0.f, 0.f}, {0.f, 0.f, 0.f, 0.f}};
#pragma unroll
      for (int ks = 0; ks < 4; ++ks) { const bf16x8 a = *(const LAS bf16x8*)(lds + L1_QT + (16 * mi + fr) * 272 + (32 * ks + 8 * fq) * 2);
#pragma unroll
          for (int j = 0; j < 2; ++j) { const bf16x8 bb = *(const LAS bf16x8*)(lds + L1_KT + (16 * (nj0 + j) + fr) * 272 + (32 * ks + 8 * fq) * 2); pd[j] = MFMA16(a, bb, pd[j]); } }
#pragma unroll
      for (int j = 0; j < 2; ++j)
#pragma unroll
          for (int r = 0; r < 4; ++r) { const int ii = 16 * mi + 4 * fq + r, jj = 16 * (nj0 + j) + fr; if (DIR ? (jj >= ii) : (jj <= ii)) pacc[j][r] += pd[j][r]; } }
    { bf16* Ug = (bf16*)(F.ws + WS_U) + ((size_t)(DIR * 8 + hh) * NCH + c) * 256 * 128;
      bf16x8 bv[2][2];
#pragma unroll
      for (int nj = 0; nj < 2; ++nj)
#pragma unroll
          for (int ks = 0; ks < 2; ++ks) bv[nj][ks] = *(const LAS bf16x8*)(lds + L1_VT + (32 * w + 16 * nj + fr) * 144 + (32 * ks + 8 * fq) * 2);
#pragma unroll
      for (int mi = 0; mi < 8; ++mi) {
          f32x4 u[2] = {{0.f, 0.f, 0.f, 0.f}, {0.f, 0.f, 0.f, 0.f}};
#pragma unroll
          for (int ks = 0; ks < 2; ++ks) { const bf16x8 a = *(const LAS bf16x8*)(lds + L1_KTT + (16 * mi + fr) * 144 + (32 * ks + 8 * fq) * 2);
#pragma unroll
              for (int nj = 0; nj < 2; ++nj) u[nj] = MFMA16(a, bv[nj][ks], u[nj]); }
          asm volatile("s_nop 15" : "+v"(u[0]), "+v"(u[1]));
#pragma unroll
          for (int nj = 0; nj < 2; ++nj) { u32x2 o; o.x = cvt_pk_bf16(u[nj][0], u[nj][1]); o.y = cvt_pk_bf16(u[nj][2], u[nj][3]);
              *(u32x2*)(Ug + (size_t)(32 * w + 16 * nj + fr) * 128 + 16 * mi + 4 * fq) = o; } } }
    __syncthreads();
}

__device__ __forceinline__ void s1_phase(Frame& F, int e) {
    PHASE_IDS(); LAS unsigned char* lds = F.lds; const int w = wave, fr = lane & 15, fq = lane >> 4;
    const bf16* P = (const bf16*)(F.ws + WS_PROJ);
    for (int item = blockIdx.x; item < 8 * NCH; item += F.G) {
        const int c = item >> 3, hh = item & 7, hd = hh & 3, t0 = c * 64; const bool is_gla = hh < 4, lat = c >= 4;
        const int qcol = is_gla ? 128 * hd : 3072 + 128 * hd, kcol = qcol + 512, vcol = is_gla ? 1024 + 256 * hd : 4096 + 256 * hd;
#pragma unroll
        for (int i = 0; i < 2; ++i) { const int id = tid + 512 * i, r = id >> 4, cc = id & 15;
            *(LAS u32x4*)(lds + L1_QRAW + r * 256 + cc * 16) = *(const u32x4*)(P + (size_t)(t0 + r) * EV_N + qcol + cc * 8);
            *(LAS u32x4*)(lds + L1_KRAW + r * 256 + cc * 16) = *(const u32x4*)(P + (size_t)(t0 + r) * EV_N + kcol + cc * 8); }
#pragma unroll
        for (int i = 0; i < 4; ++i) { const int id = tid + 512 * i, r = id & 63, cc = id >> 6;
            const u32x4 v = *(const u32x4*)(P + (size_t)(t0 + r) * EV_N + vcol + cc * 8);
            LAS bf16* vt = (LAS bf16*)(lds + L1_VT) + (cc * 8) * 72 + r;
            vt[0 * 72] = (bf16)(v.x & 0xffff); vt[1 * 72] = (bf16)(v.x >> 16); vt[2 * 72] = (bf16)(v.y & 0xffff); vt[3 * 72] = (bf16)(v.y >> 16);
            vt[4 * 72] = (bf16)(v.z & 0xffff); vt[5 * 72] = (bf16)(v.z >> 16); vt[6 * 72] = (bf16)(v.w & 0xffff); vt[7 * 72] = (bf16)(v.w >> 16); }
        if (is_gla && tid < 256) { const int r = tid >> 2, cc = tid & 3; *(LAS u32x4*)(lds + L1_GD + r * 64 + cc * 16) = *(const u32x4*)(P + (size_t)(t0 + r) * EV_N + 6144 + cc * 8); }
        float wvf[16], wvb[16], bgf = 0.f, bgb = 0.f; f32x2 csv[16];
        { const int ch = tid & 127, tq = tid >> 7;
#pragma unroll
          for (int r = 0; r < 16; ++r) { wvf[r] = 0.f; wvb[r] = 0.f; csv[r] = (f32x2){1.f, 0.f}; }
          if (is_gla) {
              const float* wgf = F.a->in[11] + (size_t)e * 16 * 512 + hd * 128 + ch; const float* wgb = F.a->in[13] + (size_t)e * 16 * 512 + hd * 128 + ch;
#pragma unroll
              for (int r = 0; r < 16; ++r) { wvf[r] = wgf[r * 512]; wvb[r] = wgb[r * 512]; }
              bgf = F.a->in[12][e * 512 + hd * 128 + ch]; bgb = F.a->in[14][e * 512 + hd * 128 + ch];
          } else if (lat) {
              const f32x2* RT = (const f32x2*)(F.ws + WS_RT) + (size_t)(t0 + 16 * tq - NCTX) * 64 + (ch & 63);
#pragma unroll
              for (int r = 0; r < 16; ++r) csv[r] = RT[r * 64];
          } }
        __syncthreads();
        f32x4 pacc[2] = {{0.f, 0.f, 0.f, 0.f}, {0.f, 0.f, 0.f, 0.f}};
        s1_dir<0>(F, e, hh, c, lat, pacc, wvf, bgf, csv);
        s1_dir<1>(F, e, hh, c, lat, pacc, wvb, bgb, csv);
        { const int mi = w >> 1, nj0 = 2 * (w & 1);
#pragma unroll
          for (int j = 0; j < 2; ++j)
#pragma unroll
              for (int r = 0; r < 4; ++r) *(LAS bf16*)(lds + L1_P + (16 * mi + 4 * fq + r) * 144 + (16 * (nj0 + j) + fr) * 2) = f2bf(pacc[j][r]); }
        __syncthreads();
        { float* OI = (float*)(F.ws + WS_OI);
          bf16x8 bv[2][2];
#pragma unroll
          for (int nj = 0; nj < 2; ++nj)
#pragma unroll
              for (int ks = 0; ks < 2; ++ks) bv[nj][ks] = *(const LAS bf16x8*)(lds + L1_VT + (32 * w + 16 * nj + fr) * 144 + (32 * ks + 8 * fq) * 2);
#pragma unroll
          for (int mi = 0; mi < 4; ++mi) {
              f32x4 o[2] = {{0.f, 0.f, 0.f, 0.f}, {0.f, 0.f, 0.f, 0.f}};
#pragma unroll
              for (int ks = 0; ks < 2; ++ks) { const bf16x8 a = *(const LAS bf16x8*)(lds + L1_P + (16 * mi + fr) * 144 + (32 * ks + 8 * fq) * 2);
#pragma unroll
                  for (int nj = 0; nj < 2; ++nj) o[nj] = MFMA16(a, bv[nj][ks], o[nj]); }
#pragma unroll
              for (int nj = 0; nj < 2; ++nj)
#pragma unroll
                  for (int r = 0; r < 4; ++r) ((LAS float*)lds)[(16 * mi + 4 * fq + r) * 260 + 32 * w + 16 * nj + fr] = o[nj][r]; }
          __syncthreads();
#pragma unroll
          for (int i = 0; i < 8; ++i) { const int id = tid + 512 * i, r = id >> 6, cc = id & 63;
              *(f32x4*)(OI + (size_t)(t0 + r) * DM + hh * 256 + cc * 4) = *(const LAS f32x4*)((LAS float*)lds + r * 260 + cc * 4); } }
        __syncthreads();
    }
}

__device__ __forceinline__ void s2_phase(Frame& F) {
    PHASE_IDS();
    const int gt = F.vcu * NTHR + tid, NGT = F.G * NTHR;
    for (int idx = gt; idx < 2 * 8 * 256 * 32; idx += NGT) {
        const int dk4 = idx & 31, ee = (idx >> 5) & 255, dh = idx >> 13, dir = dh >> 3;
        const bf16* U = (const bf16*)(F.ws + WS_U) + (size_t)dh * NCH * 256 * 128 + (size_t)ee * 128 + dk4 * 4;
        bf16* S = (bf16*)(F.ws + WS_S) + (size_t)dh * NCH * 256 * 128 + (size_t)ee * 128 + dk4 * 4;
        const float* D = (const float*)(F.ws + WS_DEC) + (size_t)dh * NCH * 128 + dk4 * 4;
        f32x4 s = {0.f, 0.f, 0.f, 0.f};
#pragma unroll 13
        for (int step = 0; step < NCH; ++step) {
            const int c = dir ? (step < 4 ? 3 - step : NCH + 3 - step) : step;
            const u32x2 uu = *(const u32x2*)(U + (size_t)c * 256 * 128); const f32x4 d = *(const f32x4*)(D + (size_t)c * 128);
            u32x2 so; so.x = cvt_pk_bf16(s.x, s.y); so.y = cvt_pk_bf16(s.z, s.w);
            *(u32x2*)(S + (size_t)c * 256 * 128) = so;
            s.x = d.x * (s.x + bflo(uu.x)); s.y = d.y * (s.y + bfhi(uu.x)); s.z = d.z * (s.z + bflo(uu.y)); s.w = d.w * (s.w + bfhi(uu.y));
        }
    }
}

constexpr int L3_QF = 0, L3_QB = 17408, L3_OL = 34816;
__device__ __forceinline__ void s3_phase(Frame& F, int e) {
    PHASE_IDS(); LAS unsigned char* lds = F.lds; const int w = wave, fr = lane & 15, fq = lane >> 4;
    const bf16* P = (const bf16*)(F.ws + WS_PROJ); const bf16* QTg = (const bf16*)(F.ws + WS_QT); const float* OI = (const float*)(F.ws + WS_OI);
    bf16* MIX = (bf16*)(F.ws + WS_MIX);
    for (int item = blockIdx.x; item < 8 * NCH; item += F.G) {
        const int c = item >> 3, hh = item & 7, hd = hh & 3, t0 = c * 64; const bool is_gla = hh < 4;
        const int gcol = is_gla ? 2048 + 256 * hd : 5120 + 256 * hd;
#pragma unroll
        for (int dir = 0; dir < 2; ++dir)
#pragma unroll
            for (int i = 0; i < 2; ++i) { const int id = tid + 512 * i, r = id >> 4, cc = id & 15;
                *(LAS u32x4*)(lds + (dir ? L3_QB : L3_QF) + r * 272 + cc * 16) = *(const u32x4*)(QTg + (size_t)dir * T * 1024 + (size_t)(t0 + r) * 1024 + hh * 128 + cc * 8); }
        bf16x8 bv[2][4][2];
#pragma unroll
        for (int dir = 0; dir < 2; ++dir) { const bf16* Sg = (const bf16*)(F.ws + WS_S) + ((size_t)(dir * 8 + hh) * NCH + c) * 256 * 128;
#pragma unroll
            for (int ks = 0; ks < 4; ++ks)
#pragma unroll
                for (int nj = 0; nj < 2; ++nj) bv[dir][ks][nj] = *(const bf16x8*)(Sg + (size_t)(32 * w + 16 * nj + fr) * 128 + 32 * ks + 8 * fq); }
        __builtin_amdgcn_sched_barrier(0);
        __syncthreads();
        f32x4 o[4][2];
#pragma unroll
        for (int mi = 0; mi < 4; ++mi)
#pragma unroll
            for (int nj = 0; nj < 2; ++nj) o[mi][nj] = (f32x4){0.f, 0.f, 0.f, 0.f};
#pragma unroll
        for (int dir = 0; dir < 2; ++dir) {
#pragma unroll
            for (int ks = 0; ks < 4; ++ks) {
#pragma unroll
                for (int mi = 0; mi < 4; ++mi) { const bf16x8 a = *(const LAS bf16x8*)(lds + (dir ? L3_QB : L3_QF) + (16 * mi + fr) * 272 + (32 * ks + 8 * fq) * 2);
#pragma unroll
                    for (int nj = 0; nj < 2; ++nj) o[mi][nj] = MFMA16(a, bv[dir][ks][nj], o[mi][nj]); } } }
        LAS float* OL = (LAS float*)(lds + L3_OL);
#pragma unroll
        for (int mi = 0; mi < 4; ++mi)
#pragma unroll
            for (int nj = 0; nj < 2; ++nj)
#pragma unroll
                for (int r = 0; r < 4; ++r) OL[(16 * mi + 4 * fq + r) * 260 + 32 * w + 16 * nj + fr] = o[mi][nj][r];
        __syncthreads();
        { const int tk = tid >> 3, seg = tid & 7;
          f32x4 v[4][2]; float sq = 0.f;
#pragma unroll
          for (int g = 0; g < 4; ++g) { const int ee = 64 * g + 8 * seg; const float* oi = OI + (size_t)(t0 + tk) * DM + hh * 256 + ee;
              v[g][0] = *(const LAS f32x4*)(OL + tk * 260 + ee) + *(const f32x4*)oi; v[g][1] = *(const LAS f32x4*)(OL + tk * 260 + ee + 4) + *(const f32x4*)(oi + 4);
              sq += (v[g][0].x * v[g][0].x + v[g][0].y * v[g][0].y) + (v[g][0].z * v[g][0].z + v[g][0].w * v[g][0].w) + (v[g][1].x * v[g][1].x + v[g][1].y * v[g][1].y) + (v[g][1].z * v[g][1].z + v[g][1].w * v[g][1].w); }
          sq += __shfl_xor(sq, 1); sq += __shfl_xor(sq, 2); sq += __shfl_xor(sq, 4);
          const float rstd = 1.0f / sqrtf(sq * (1.0f / 256.0f) + RMS_EPS);
#pragma unroll
          for (int g = 0; g < 4; ++g) { const int ee = 64 * g + 8 * seg;
              const u32x4 gt = *(const u32x4*)(P + (size_t)(t0 + tk) * EV_N + gcol + ee);
              f32x4 n0 = {1.f, 1.f, 1.f, 1.f}, n1 = {1.f, 1.f, 1.f, 1.f};
              if (is_gla) { n0 = *(const f32x4*)(F.a->in[15] + e * 256 + ee); n1 = *(const f32x4*)(F.a->in[15] + e * 256 + ee + 4); }
              const f32x4 a0 = v[g][0] * rstd * n0, a1 = v[g][1] * rstd * n1;
              u32x4 ow; ow.x = cvt_pk_bf16(a0.x * silu_f(bflo(gt.x)), a0.y * silu_f(bfhi(gt.x))); ow.y = cvt_pk_bf16(a0.z * silu_f(bflo(gt.y)), a0.w * silu_f(bfhi(gt.y)));
              ow.z = cvt_pk_bf16(a1.x * silu_f(bflo(gt.z)), a1.y * silu_f(bfhi(gt.z))); ow.w = cvt_pk_bf16(a1.z * silu_f(bflo(gt.w)), a1.w * silu_f(bfhi(gt.w)));
              *(u32x4*)(MIX + (size_t)(t0 + tk) * DM + hh * 256 + ee) = ow; } }
        __syncthreads();
    }
}

__device__ __forceinline__ void e1_phase(Frame& F, int o) {
    PHASE_IDS();
    const int gw = F.vcu * NWAVES + wave, NGW = F.G * NWAVES;
    const bf16* P = (const bf16*)(F.ws + WS_PROJ); bf16* CQN = (bf16*)(F.ws + WS_CQN); bf16* CKVN = (bf16*)(F.ws + WS_CKVN); bf16* KR = (bf16*)(F.ws + WS_KR);
    const float* wq = F.a->in[18] + o * 512 + lane * 8; const float* wkv = F.a->in[19] + o * 512 + lane * 8;
    const f32x4 wq0 = *(const f32x4*)wq, wq1 = *(const f32x4*)(wq + 4), wk0 = *(const f32x4*)wkv, wk1 = *(const f32x4*)(wkv + 4);
    const f32x2* AXR = (const f32x2*)(F.ws + WS_AXR); const f32x2* AXC = (const f32x2*)(F.ws + WS_AXC);
    for (int t = gw; t < T; t += NGW) {
        const bf16* p = P + (size_t)t * OD_N;
        const u32x4 a = *(const u32x4*)(p + lane * 8), b = *(const u32x4*)(p + 512 + lane * 8);
        float x[8] = {bflo(a.x), bfhi(a.x), bflo(a.y), bfhi(a.y), bflo(a.z), bfhi(a.z), bflo(a.w), bfhi(a.w)};
        float y[8] = {bflo(b.x), bfhi(b.x), bflo(b.y), bfhi(b.y), bflo(b.z), bfhi(b.z), bflo(b.w), bfhi(b.w)};
        float sx = 0.f, sy = 0.f;
#pragma unroll
        for (int j = 0; j < 8; ++j) { sx += x[j] * x[j]; sy += y[j] * y[j]; }
        const float rx = 1.0f / sqrtf(wave_sum(sx) * (1.0f / 512.0f) + RMS_EPS), ry = 1.0f / sqrtf(wave_sum(sy) * (1.0f / 512.0f) + RMS_EPS);
        u32x4 oq, ok;
        oq.x = cvt_pk_bf16(x[0] * rx * wq0.x, x[1] * rx * wq0.y); oq.y = cvt_pk_bf16(x[2] * rx * wq0.z, x[3] * rx * wq0.w); oq.z = cvt_pk_bf16(x[4] * rx * wq1.x, x[5] * rx * wq1.y); oq.w = cvt_pk_bf16(x[6] * rx * wq1.z, x[7] * rx * wq1.w);
        ok.x = cvt_pk_bf16(y[0] * ry * wk0.x, y[1] * ry * wk0.y); ok.y = cvt_pk_bf16(y[2] * ry * wk0.z, y[3] * ry * wk0.w); ok.z = cvt_pk_bf16(y[4] * ry * wk1.x, y[5] * ry * wk1.y); ok.w = cvt_pk_bf16(y[6] * ry * wk1.z, y[7] * ry * wk1.w);
        *(u32x4*)(CQN + (size_t)t * 512 + lane * 8) = oq; *(u32x4*)(CKVN + (size_t)t * 512 + lane * 8) = ok;
        float v = bf2f(p[1024 + lane]); const float pr = __shfl_xor(v, 16);
        if (t >= NCTX) { const int pp = t - NCTX, pos = (lane & 32) ? (pp & 63) : (pp >> 6); const f32x2 cs = ((lane & 32) ? AXC : AXR)[pos * 16 + (lane & 15)];
            v = (lane & 16) ? v * cs.x + pr * cs.y : v * cs.x - pr * cs.y; }
        KR[(size_t)t * 64 + lane] = f2bf(v);
    }
}

namespace att {
constexpr int KVBLK = 64;
constexpr float SCALE = 0.07216878364870322f;
constexpr float THR = 8.f;
constexpr int SHM_K = 64 * 384, SHM_V = 64 * 256;
constexpr int A_V = 0, A_K = 2 * SHM_V, A_WS = 2 * SHM_V + 2 * SHM_K;
#define SBAR() __builtin_amdgcn_sched_barrier(0)
__device__ __forceinline__ int crow(int r, int hi) { return (r & 3) + 8 * (r >> 2) + 4 * hi; }
__device__ __forceinline__ void partialSM(f32x16& p0, f32x16& p1, float& m_reg, float& mn, float& alpha) {
    constexpr float C = SCALE * 1.4426950408889634f;
    float pmax = p0[0];
#pragma unroll
    for (int r = 1; r < 16; ++r) pmax = fmaxf(pmax, p0[r]);
#pragma unroll
    for (int r = 0; r < 16; ++r) pmax = fmaxf(pmax, p1[r]);
    { auto rr = __builtin_amdgcn_permlane32_swap(__float_as_uint(pmax), __float_as_uint(pmax), false, false);
      pmax = fmaxf(__uint_as_float(rr[0]), __uint_as_float(rr[1])); }
    if (__builtin_expect(__all(pmax - m_reg <= THR / SCALE), 1)) { mn = m_reg; alpha = 1.f; }
    else { mn = fmaxf(m_reg, pmax); alpha = __builtin_amdgcn_exp2f((m_reg - mn) * C); m_reg = mn; }
    const float mnC = -mn * C;
#pragma unroll
    for (int r = 0; r < 16; ++r) p0[r] = fmaf(p0[r], C, mnC);
#pragma unroll
    for (int r = 0; r < 16; ++r) p1[r] = fmaf(p1[r], C, mnC);
#pragma unroll
    for (int r = 0; r < 16; ++r) p0[r] = __builtin_amdgcn_exp2f(p0[r]);
}
__device__ __forceinline__ void finishSM(f32x16& p0, f32x16& p1, float alpha, float& l_reg, bf16x8& pa0, bf16x8& pa1, bf16x8& pa2, bf16x8& pa3) {
#pragma unroll
    for (int r = 0; r < 16; ++r) p1[r] = __builtin_amdgcn_exp2f(p1[r]);
    float ps = 0;
#pragma unroll
    for (int r = 0; r < 16; ++r) ps += p0[r];
#pragma unroll
    for (int r = 0; r < 16; ++r) ps += p1[r];
    { auto rr = __builtin_amdgcn_permlane32_swap(__float_as_uint(ps), __float_as_uint(ps), false, false);
      ps = __uint_as_float(rr[0]) + __uint_as_float(rr[1]); }
    l_reg = l_reg * alpha + ps;
#define PK4(P, BASE, OUT) do { unsigned a0 = cvt_pk_bf16(P[BASE + 0], P[BASE + 1]), a1 = cvt_pk_bf16(P[BASE + 2], P[BASE + 3]);   \
    unsigned b0 = cvt_pk_bf16(P[BASE + 4], P[BASE + 5]), b1 = cvt_pk_bf16(P[BASE + 6], P[BASE + 7]);                              \
    auto r0 = __builtin_amdgcn_permlane32_swap(a0, b0, false, false); auto r1 = __builtin_amdgcn_permlane32_swap(a1, b1, false, false); \
    u32x4 w = {r0[0], r1[0], r0[1], r1[1]}; OUT = *reinterpret_cast<bf16x8*>(&w); } while (0)
    PK4(p0, 0, pa0); PK4(p0, 8, pa1); PK4(p1, 0, pa2); PK4(p1, 8, pa3);
#undef PK4
}
__device__ __forceinline__ int kswz(int row, int g) { return row * 384 + (((g & ~7) | ((g & 7) ^ ((row >> 1) & 7))) << 4); }
__device__ __forceinline__ void qkt(f32x16& p0, f32x16& p1, const LAS unsigned char* Ks, const bf16x8 (&qr)[12], const int (&kx)[4]) {
    p0 = f32x16{}; p1 = f32x16{};
    bf16x8 c0 = *(const LAS bf16x8*)(Ks + kx[0]), c1 = *(const LAS bf16x8*)(Ks + kx[0] + 32 * 384), n0, n1;
#pragma unroll
    for (int d0 = 0; d0 < 12; ++d0) {
        if (d0 < 11) { n0 = *(const LAS bf16x8*)(Ks + kx[(d0 + 1) & 3] + ((d0 + 1) >> 2) * 128); n1 = *(const LAS bf16x8*)(Ks + kx[(d0 + 1) & 3] + ((d0 + 1) >> 2) * 128 + 32 * 384); }
        __builtin_amdgcn_sched_barrier(0);
        p0 = MFMA32(c0, qr[d0], p0);
        p1 = MFMA32(c1, qr[d0], p1);
        __builtin_amdgcn_sched_barrier(0);
        c0 = n0; c1 = n1; }
}
__device__ __forceinline__ int v_st(int k, int c) { const int kk = (k & ~0xC) | ((k & 4) << 1) | ((k & 8) >> 1); return ((kk >> 3) * 4 + (c >> 5)) * 512 + ((kk & 7) * 32 + (c & 31)) * 2; }
__device__ __forceinline__ int v_rd_base(int lane) { return ((lane & 3) << 3) | (((lane >> 2) & 3) << 6) | (((lane >> 4) & 1) << 5) | (((lane >> 5) & 1) << 8); }
constexpr int v_rd_off(int d0, int ks, int half) { return d0 * 512 + ks * 4096 + half * 2048; }
template <int OFF> __device__ __forceinline__ s16x4 tr_read(int vb) {
    s16x4 r; asm volatile("ds_read_b64_tr_b16 %0, %1 offset:%2" : "=&v"(r) : "v"(vb), "i"(OFF) : "memory"); return r;
}
template <int D0> __device__ __forceinline__ void pv_one(f32x16& od, int vb, bf16x8 pa0, bf16x8 pa1, bf16x8 pa2, bf16x8 pa3) {
    const s16x4 l0 = tr_read<v_rd_off(D0, 0, 0)>(vb), h0 = tr_read<v_rd_off(D0, 0, 1)>(vb), l1 = tr_read<v_rd_off(D0, 1, 0)>(vb), h1 = tr_read<v_rd_off(D0, 1, 1)>(vb);
    const s16x4 l2 = tr_read<v_rd_off(D0, 2, 0)>(vb), h2 = tr_read<v_rd_off(D0, 2, 1)>(vb), l3 = tr_read<v_rd_off(D0, 3, 0)>(vb), h3 = tr_read<v_rd_off(D0, 3, 1)>(vb);
    asm volatile("s_waitcnt lgkmcnt(0)" ::: "memory"); SBAR();
#define PK(L, H) (bf16x8){L[0], L[1], L[2], L[3], H[0], H[1], H[2], H[3]}
    od = MFMA32(pa0, PK(l0, h0), od);
    od = MFMA32(pa1, PK(l1, h1), od);
    od = MFMA32(pa2, PK(l2, h2), od);
    od = MFMA32(pa3, PK(l3, h3), od);
#undef PK
}
__device__ __forceinline__ void pv_d0(f32x16 (&o)[4], int vb, bf16x8 pa0, bf16x8 pa1, bf16x8 pa2, bf16x8 pa3) {
    pv_one<0>(o[0], vb, pa0, pa1, pa2, pa3); pv_one<1>(o[1], vb, pa0, pa1, pa2, pa3); pv_one<2>(o[2], vb, pa0, pa1, pa2, pa3); pv_one<3>(o[3], vb, pa0, pa1, pa2, pa3);
}
__device__ __forceinline__ void rope_pair(bf16x8& a, bf16x8& b, const f32x2* cs) {
    u32x4 ua = *reinterpret_cast<u32x4*>(&a), ub = *reinterpret_cast<u32x4*>(&b); u32x4 oa, ob;
#pragma unroll
    for (int j = 0; j < 4; ++j) { const f32x2 c0 = cs[2 * j], c1 = cs[2 * j + 1];
        const float x1l = bflo(ua[j]), x1h = bfhi(ua[j]), x2l = bflo(ub[j]), x2h = bfhi(ub[j]);
        oa[j] = cvt_pk_bf16(x1l * c0.x - x2l * c0.y, x1h * c1.x - x2h * c1.y);
        ob[j] = cvt_pk_bf16(x2l * c0.x + x1l * c0.y, x2h * c1.x + x1h * c1.y); }
    a = *reinterpret_cast<bf16x8*>(&oa); b = *reinterpret_cast<bf16x8*>(&ob);
}
__device__ __forceinline__ void unit(Frame& F, int h, int qrow0, int nkeys) {
    LAS unsigned char* lds = F.lds;
    PHASE_IDS(); const int wid = wave, r32 = lane & 31, hi = lane >> 5;
    const bf16* QB = (const bf16*)(F.ws + WS_QB); const bf16* KVB = (const bf16*)(F.ws + WS_KVB); const bf16* KR = (const bf16*)(F.ws + WS_KR);
    LAS unsigned char* V_lds = lds + A_V; LAS unsigned char* K_lds = lds + A_K;
    LAS float* wsl = (LAS float*)(lds + A_WS) + wid * 64; LAS float* li_l = wsl; LAS float* al_l = wsl + 32;
    float m_reg = -1e30f, l_reg = 0; f32x16 o[4] = {}; bf16x8 qr[12];
    const int qt = qrow0 + wid * 32 + r32;
    const bf16* Qw = QB + (size_t)qt * 3072 + 192 * h + hi * 8;
#pragma unroll
    for (int d0 = 0; d0 < 12; ++d0) qr[d0] = *(const bf16x8*)(Qw + d0 * 16);
    if (qt >= NCTX) { const int pp = qt - NCTX;
        rope_pair(qr[8], qr[9], (const f32x2*)(F.ws + WS_AXR) + (pp >> 6) * 16 + hi * 8);
        rope_pair(qr[10], qr[11], (const f32x2*)(F.ws + WS_AXC) + (pp & 63) * 16 + hi * 8); }
    const unsigned char* wsb = F.ws;
    unsigned koff[3], kfl = 0u; int kdst[3];
#pragma unroll
    for (int i = 0; i < 3; ++i) { const int id = tid + 512 * i, row = id / 24, g = id % 24;
        if (g < 16) { koff[i] = (unsigned)WS_KVB + (unsigned)(row * 4096 + 256 * h + g * 8) * 2u; kfl |= 1u << i; } else { koff[i] = (unsigned)WS_KR + (unsigned)(row * 64 + (g - 16) * 8) * 2u; }
        kdst[i] = kswz(row, g); }
    const int sr = tid >> 4, sc = (tid & 15) * 8, vst0 = v_st(sr, sc);
    const unsigned voff = (unsigned)WS_KVB + (unsigned)(sr * 4096 + 256 * h + 128 + sc) * 2u;
    const int vb0 = (int)(unsigned)(uintptr_t)V_lds + v_rd_base(lane);
    int kx[4];
#pragma unroll
    for (int q = 0; q < 4; ++q) kx[q] = r32 * 384 + ((((2 * q) | hi) ^ ((r32 >> 1) & 7)) << 4);
    bf16x8 sk0, sk1, sk2, sv0, sv1;
#define SLOAD(jt) do { const unsigned vo_ = voff + (unsigned)(jt) * (64u * 4096u * 2u); sv0 = *(const bf16x8*)(wsb + vo_); sv1 = *(const bf16x8*)(wsb + vo_ + 32u * 4096u * 2u); \
    const unsigned kt_ = (unsigned)(jt) * 8192u; \
    sk0 = *(const bf16x8*)(wsb + koff[0] + (kt_ << ((kfl & 1u) * 6u))); sk1 = *(const bf16x8*)(wsb + koff[1] + (kt_ << (((kfl >> 1) & 1u) * 6u))); sk2 = *(const bf16x8*)(wsb + koff[2] + (kt_ << (((kfl >> 2) & 1u) * 6u))); } while (0)
#define SWRITE(b) do { *(LAS bf16x8*)(V_lds + (b) * SHM_V + vst0) = sv0; *(LAS bf16x8*)(V_lds + (b) * SHM_V + vst0 + 8192) = sv1; \
    *(LAS bf16x8*)(K_lds + (b) * SHM_K + kdst[0]) = sk0; *(LAS bf16x8*)(K_lds + (b) * SHM_K + kdst[1]) = sk1; *(LAS bf16x8*)(K_lds + (b) * SHM_K + kdst[2]) = sk2; } while (0)
#define SWAIT() asm volatile("s_waitcnt vmcnt(0)" ::: "memory")
#define RESC(a) do { if (__any((a) < 1.f)) { if (hi == 0) al_l[r32] = (a); asm volatile("s_waitcnt lgkmcnt(0)" ::: "memory"); \
    _Pragma("unroll") for (int d = 0; d < 4; ++d) _Pragma("unroll") for (int r = 0; r < 16; ++r) o[d][r] *= al_l[crow(r, hi)]; } } while (0)
    f32x16 p0, p1; float mn, al; bf16x8 pa0, pa1, pa2, pa3; const int NT = nkeys / KVBLK;
#define ABAR() do { asm volatile("s_waitcnt lgkmcnt(0)" ::: "memory"); __builtin_amdgcn_s_barrier(); asm volatile("" ::: "memory"); } while (0)
#define ASTAGE(j) do { if ((j) + 1 < NT) { SWAIT(); SWRITE(((j) & 1) ^ 1); } if ((j) + 2 < NT) SLOAD((j) + 2); } while (0)
#define AQK(j) do { SBAR(); qkt(p0, p1, K_lds + ((j) & 1) * SHM_K, qr, kx); SBAR(); partialSM(p0, p1, m_reg, mn, al); } while (0)
#define ASP(j) do { RESC(al); finishSM(p0, p1, al, l_reg, pa0, pa1, pa2, pa3); SBAR(); pv_d0(o, vb0 + ((j) & 1) * SHM_V, pa0, pa1, pa2, pa3); } while (0)
    SLOAD(0); SWAIT(); SWRITE(0); SLOAD(1); ABAR();
    if ((wid >> 2) == 0) {
        for (int j = 0; j < NT; ++j) { AQK(j); ABAR(); ASTAGE(j); ASP(j); ABAR(); }
        ABAR();
    } else {
        ABAR();
        for (int j = 0; j < NT; ++j) { ASTAGE(j); AQK(j); ABAR(); ASP(j); ABAR(); }
    }
#undef ABAR
#undef ASTAGE
#undef AQK
#undef ASP
    if (hi == 0) li_l[r32] = l_reg; asm volatile("s_waitcnt lgkmcnt(0)" ::: "memory");
    float rli[16];
#pragma unroll
    for (int r = 0; r < 16; ++r) rli[r] = __builtin_amdgcn_rcpf(li_l[crow(r, hi)]);
    unsigned orow0 = (unsigned)(qrow0 + wid * 32) * DM + 128 * h; asm volatile("" : "+v"(orow0));
    bf16* Ow = (bf16*)(F.ws + WS_MIX) + orow0;
#pragma unroll
    for (int r = 0; r < 16; ++r) { const int orow = crow(r, hi);
#pragma unroll
        for (int d0 = 0; d0 < 4; ++d0) Ow[(size_t)orow * DM + d0 * 32 + r32] = f2bf(o[d0][r] * rli[r]); }
    __syncthreads();
#undef SLOAD
#undef SWRITE
#undef SWAIT
#undef RESC
}
}

__device__ __forceinline__ void attn_phase(Frame& F) {
    for (int u = F.vcu; u < 1024 + 16; u += F.G) {
        if (u < 1024) att::unit(F, u >> 6, NCTX + 256 * (u & 63), T);
        else att::unit(F, u - 1024, 0, NCTX);
    }
}

#ifdef DBG
constexpr int DBG_W_BAD = 64, DBG_W_SSQ = 65, DBG_W_CNT = 66, DBG_W_MAX = 67;
__device__ __forceinline__ void dbg_scan(Frame& F, int id, size_t off, size_t nbytes, bool is_bf) {
    PHASE_IDS();
    const u32x4* p = (const u32x4*)(F.ws + off); const size_t n = nbytes / 16; bool bad = false;
    for (size_t i = (size_t)F.vcu * NTHR + tid; i < n; i += (size_t)F.G * NTHR) { const u32x4 v = p[i];
#pragma unroll
        for (int j = 0; j < 4; ++j) { if (is_bf) { bad |= ((v[j] & 0x7f80u) == 0x7f80u) | ((v[j] & 0x7f800000u) == 0x7f800000u); } else bad |= ((v[j] & 0x7f800000u) == 0x7f800000u); } }
    if (__any(bad) && lane == 0) atomicMax((unsigned*)(F.ws + WS_CTL) + DBG_W_BAD, (unsigned)(100000 - id));
}
__device__ __forceinline__ void dbg_max(Frame& F, size_t off, size_t nbytes, bool is_bf) {
    PHASE_IDS();
    const u32x4* p = (const u32x4*)(F.ws + off); const size_t n = nbytes / 16; unsigned mx = 0u;
    for (size_t i = (size_t)F.vcu * NTHR + tid; i < n; i += (size_t)F.G * NTHR) { const u32x4 v = p[i];
#pragma unroll
        for (int j = 0; j < 4; ++j) { if (is_bf) { const unsigned a0 = (v[j] << 16) & 0x7fffffffu, a1 = v[j] & 0x7fff0000u; if (a0 < 0x7f800000u) mx = max(mx, a0); if (a1 < 0x7f800000u) mx = max(mx, a1); } else { const unsigned a0 = v[j] & 0x7fffffffu; if (a0 < 0x7f800000u) mx = max(mx, a0); } } }
#pragma unroll
    for (int o = 1; o < 64; o <<= 1) mx = max(mx, (unsigned)__shfl_xor((int)mx, o));
    if (lane == 0) atomicMax((unsigned*)(F.ws + WS_CTL) + DBG_W_MAX, mx);
}
#define DBGSCAN(id, off, nbytes, isbf) dbg_scan(F, (id), (off), (nbytes), (isbf))
#else
#define DBGSCAN(id, off, nbytes, isbf) do {} while (0)
#endif

#ifndef RES_ALIGN
#define RES_ALIGN true
#endif
#ifndef RES_SP2
#define RES_SP2 true
#endif
__global__ void __launch_bounds__(NTHR, 2) fwd_kernel(Args args) {
    extern __shared__ __attribute__((aligned(16))) unsigned char lds_raw[];
    Frame F;
    F.lds = (LAS unsigned char*)lds_raw;
    F.G = gridDim.x; { const int bx = blockIdx.x; F.vcu = (F.G % 8 == 0) ? (bx % 8) * (F.G / 8) + bx / 8 : bx; }
    F.a = &args; F.ws = args.ws;
    volatile LAS unsigned* ctlw = (volatile LAS unsigned*)(F.lds + LDS_CTL);
    if (threadIdx.x < 16) ctlw[threadIdx.x] = 0u;
    __syncthreads();
    XcdBarrier bar = xcd_barrier_post((unsigned*)(F.ws + WS_CTL) + 4096, ctlw);
#define GRID_BAR() xcd_barrier(bar)
#ifdef DBG_TIME
    unsigned long long t_prev = __builtin_amdgcn_s_memrealtime();
#define TSTAMP(cat) do { if (blockIdx.x == 0 && threadIdx.x == 0) { const unsigned long long t_now = __builtin_amdgcn_s_memrealtime(); unsigned long long* tw = (unsigned long long*)(F.ws + WS_CTL) + 64 + (cat); *tw = *tw + (t_now - t_prev); t_prev = t_now; } } while (0)
#else
#define TSTAMP(cat) do {} while (0)
#endif

#ifndef SK_P0
    p0a(F);
#ifdef DUP_P0
    p0a(F);
#endif
#endif
    GRID_BAR();
    p0b(F); GRID_BAR();
    DBGSCAN(1, WS_MOD, (size_t)4 * 2 * NADA * 4, false);
    init_x_by_owners(F);
    row_phase<0>(F, nullptr, nullptr, modp(F, 0, 0, 0), modp(F, 0, 0, 1), modp(F, 0, 1, 0), modp(F, 0, 1, 1)); GRID_BAR(); TSTAMP(0);
    DBGSCAN(2, WS_X, (size_t)T * DM * 4, false); DBGSCAN(3, WS_H, (size_t)T * DM * 2, true);

    const pg8::bf16_t* Hb = (const pg8::bf16_t*)(F.ws + WS_H);
    for (int s = 0; s < 3 * DEPTH; ++s) {
        const int l = s / 3, r = s % 3;
        const pg8::bf16_t* A2; const pg8::bf16_t* B2; int K2;
        if (r != 1) {
            const int f = r >> 1;
            pg8::Gemm g{Hb, (const pg8::bf16_t*)(F.ws + WS_WFI + (size_t)(l * 2 + f) * SZ_WFI), T, 2 * DFF, DM, DM, DM};
            pg8::StaticOrder S; S.init(T, 2 * DFF, F.G, (int)blockIdx.x);
            pg8::EpiSwiGLU E{(pg8::bf16_t*)(F.ws + WS_HID), DFF};
#ifndef SK_SW
            pg8::gemm_phase<pg8::EpiSwiGLU, pg8::StaticOrder>(F.lds, g, S, E);
#endif
#ifdef DUP_SW
            pg8::gemm_phase<pg8::EpiSwiGLU, pg8::StaticOrder>(F.lds, g, S, E);
#endif
            GRID_BAR(); TSTAMP(1);
            DBGSCAN(10 + 10 * s, WS_HID, (size_t)T * DFF * 2, true);
            A2 = (const pg8::bf16_t*)(F.ws + WS_HID); B2 = (const pg8::bf16_t*)(F.ws + WS_WFO + (size_t)(l * 2 + f) * SZ_WFO); K2 = DFF;
        } else if ((l & 1) == 0) {
            const int e = l >> 1;
            { pg8::Gemm g{Hb, (const pg8::bf16_t*)(F.ws + WS_EWI + (size_t)e * SZ_EWI), T, EV_N, DM, DM, DM};
              pg8::StaticOrder S; S.init(T, EV_N, F.G, (int)blockIdx.x);
              pg8::EpiBf16 E{(pg8::bf16_t*)(F.ws + WS_PROJ), EV_N};
#ifndef SK_G1
              pg8::gemm_phase<pg8::EpiBf16, pg8::StaticOrder>(F.lds, g, S, E);
#endif
            }
            GRID_BAR(); TSTAMP(4);
            DBGSCAN(10 + 10 * s, WS_PROJ, (size_t)T * EV_N * 2 - 0, true);
#ifdef DBG
            if (s == 1) dbg_max(F, WS_PROJ, (size_t)T * EV_N * 2, true);
#endif
#ifndef SK_S1
            s1_phase(F, e);
#ifdef DUP_S1
            s1_phase(F, e);
#endif
#endif
            GRID_BAR(); TSTAMP(5);
            DBGSCAN(11 + 10 * s, WS_U, SZ_U, true); DBGSCAN(16 + 10 * s, WS_OI, (size_t)T * DM * 4, false); DBGSCAN(17 + 10 * s, WS_QT, (size_t)2 * T * 1024 * 2, true); DBGSCAN(18 + 10 * s, WS_DEC, (size_t)2 * 8 * NCH * 128 * 4, false);
#ifndef SK_S2
            s2_phase(F);
#ifdef DUP_S2
            s2_phase(F);
#endif
#endif
            GRID_BAR(); TSTAMP(6);
            DBGSCAN(12 + 10 * s, WS_S, SZ_U, true);
#ifndef SK_S3
            s3_phase(F, e);
#ifdef DUP_S3
            s3_phase(F, e);
#endif
#endif
            GRID_BAR(); TSTAMP(7);
            DBGSCAN(13 + 10 * s, WS_MIX, (size_t)T * DM * 2, true);
            A2 = (const pg8::bf16_t*)(F.ws + WS_MIX); B2 = (const pg8::bf16_t*)(F.ws + WS_EWO + (size_t)e * SZ_SQ); K2 = DM;
        } else {
            const int o = l >> 1;
            { pg8::Gemm g{Hb, (const pg8::bf16_t*)(F.ws + WS_OWI + (size_t)o * SZ_OWI), T, OD_N, DM, DM, DM};
              pg8::StaticOrder S; S.init(T, OD_N, F.G, (int)blockIdx.x);
              pg8::EpiBf16 E{(pg8::bf16_t*)(F.ws + WS_PROJ), OD_N};
#ifndef SK_G2
              pg8::gemm_phase<pg8::EpiBf16, pg8::StaticOrder>(F.lds, g, S, E);
#endif
            }
            GRID_BAR();
#ifndef SK_E1
            e1_phase(F, o);
#endif
            GRID_BAR();
            DBGSCAN(11 + 10 * s, WS_CQN, (size_t)T * 512 * 2 * 2, true); DBGSCAN(11 + 10 * s, WS_KR, (size_t)T * 64 * 2, true);
            for (int q = 0; q < 2; ++q) {
                pg8::Gemm g{(const pg8::bf16_t*)(F.ws + (q ? WS_CKVN : WS_CQN)), (const pg8::bf16_t*)(F.ws + (q ? WS_OUKV + (size_t)o * SZ_OUKV : WS_OUQ + (size_t)o * SZ_OUQ)), T, q ? 4096 : 3072, 512, 512, 512};
                pg8::StaticOrder S; S.init(T, g.N, F.G, (int)blockIdx.x);
                pg8::EpiBf16 E{(pg8::bf16_t*)(F.ws + (q ? WS_KVB : WS_QB)), g.N};
#ifndef SK_G3
                pg8::gemm_phase<pg8::EpiBf16, pg8::StaticOrder>(F.lds, g, S, E);
#endif
            }
            GRID_BAR(); TSTAMP(8);
            DBGSCAN(12 + 10 * s, WS_QB, (size_t)T * 3072 * 2, true); DBGSCAN(12 + 10 * s, WS_KVB, (size_t)T * 4096 * 2, true);
#ifndef SK_ATT
            attn_phase(F);
#ifdef DUP_ATT
            attn_phase(F);
#endif
#endif
            GRID_BAR(); TSTAMP(9);
            DBGSCAN(13 + 10 * s, WS_MIX, (size_t)T * DM * 2, true);
            A2 = (const pg8::bf16_t*)(F.ws + WS_MIX); B2 = (const pg8::bf16_t*)(F.ws + WS_OWO + (size_t)o * SZ_SQ); K2 = DM;
        }
        {
            pg8::Gemm g{A2 + (size_t)NCTX * K2, B2, NLAT, DM, K2, K2, K2};
            pg8::StaticOrder S; S.init(NLAT, DM, F.G, (int)blockIdx.x);
            const int sp = s > 0 ? s - 1 : 0;
            const float* plng = F.a->in[6] + (size_t)sp * DM; const float* plnb = F.a->in[7] + (size_t)sp * DM; const float* stat = (const float*)(F.ws + WS_STAT);
            pg8::EpiResid E{(float*)(F.ws + WS_X) + (size_t)NCTX * DM, modp(F, l, 0, 3 * r + 2), (r != 1) ? 0.5f : 1.0f, stat + (size_t)NCTX * 2, plng, plnb, s > 0 ? 1 : 0};
#ifndef SK_RES
            pg8::gemm_phase<pg8::EpiResid, pg8::StaticOrder, RES_ALIGN, RES_SP2>(F.lds, g, S, E);
#endif
            ctx_resid_small(F, (float*)(F.ws + WS_X), (const bf16*)A2, (const bf16*)B2, K2, modp(F, l, 1, 3 * r + 2), (r != 1) ? 0.5f : 1.0f, stat, plng, plnb, s > 0 ? 1 : 0);
#ifdef DUP_SMALL_OFF
            ctx_resid_small(F, (float*)(F.ws + WS_OI), (const bf16*)A2, (const bf16*)B2, K2, modp(F, l, 1, 3 * r + 2), (r != 1) ? 0.5f : 1.0f);
            ctx_resid_small(F, (float*)(F.ws + WS_OI), (const bf16*)A2, (const bf16*)B2, K2, modp(F, l, 1, 3 * r + 2), (r != 1) ? 0.5f : 1.0f);
#endif
#ifdef DUP_RES
            { pg8::EpiResid E2{(float*)(F.ws + WS_OI) + (size_t)NCTX * DM, modp(F, l, 0, 3 * r + 2), 0.5f, stat, plng, plnb, 0};
              pg8::gemm_phase<pg8::EpiResid, pg8::StaticOrder>(F.lds, g, S, E2); }
#endif
        }
        GRID_BAR(); TSTAMP(r != 1 ? 2 : 10);
        DBGSCAN(14 + 10 * s, WS_X, (size_t)T * DM * 4, false);
        const float* lng = F.a->in[6] + (size_t)(l * 3 + r) * DM; const float* lnb = F.a->in[7] + (size_t)(l * 3 + r) * DM;
        if (s + 1 < 3 * DEPTH) { const int l2 = (s + 1) / 3, r2 = (s + 1) % 3;
            row_phase<1>(F, lng, lnb, modp(F, l2, 0, 3 * r2), modp(F, l2, 0, 3 * r2 + 1), modp(F, l2, 1, 3 * r2), modp(F, l2, 1, 3 * r2 + 1));
            GRID_BAR(); TSTAMP(3);
            DBGSCAN(15 + 10 * s, WS_X, (size_t)T * DM * 4, false); DBGSCAN(15 + 10 * s, WS_H, (size_t)T * DM * 2, true);
#if defined(DBG) && defined(DBG_STOP)
            if (s == DBG_STOP) break;
#endif
        } else {
#ifndef DBG
            row_phase<2>(F, lng, lnb, nullptr, nullptr, nullptr, nullptr);
#endif
        }
    }
#ifdef DBG_TIME
    {   PHASE_IDS(); GRID_BAR();
        const unsigned long long* tw = (const unsigned long long*)(F.ws + WS_CTL) + 64;
        const float tA = (float)__hip_atomic_load(tw + DBG_TA, RLX_AGENT) * 1e-5f, tB = (float)__hip_atomic_load(tw + DBG_TB, RLX_AGENT) * 1e-5f;
        const float cB = DBG_TSCALE * tB, cA = cB; (void)tA;
        float* out = F.a->out;
        for (size_t i = (size_t)F.vcu * NTHR + tid; i < (size_t)NLAT * DM; i += (size_t)F.G * NTHR) out[i] = (i == 12345) ? cA : cB;
    }
#endif
#ifdef DBG
    {
        PHASE_IDS();
        const float* X = (const float*)(F.ws + WS_X); float ssq = 0.f; float cnt = 0.f;
        for (size_t i = (size_t)F.vcu * NTHR + tid; i < (size_t)T * DM; i += (size_t)F.G * NTHR) { const float v = X[i]; if ((__float_as_uint(v) & 0x7f800000u) != 0x7f800000u) { ssq += v * v; cnt += 1.f; } }
        ssq = wave_sum(ssq); cnt = wave_sum(cnt);
        if (lane == 0) { atomicAdd((float*)(F.ws + WS_CTL) + DBG_W_SSQ, ssq); atomicAdd((float*)(F.ws + WS_CTL) + DBG_W_CNT, cnt); }
        GRID_BAR();
        const unsigned badw = __hip_atomic_load((unsigned*)(F.ws + WS_CTL) + DBG_W_BAD, RLX_AGENT);
        const float tss = __hip_atomic_load((float*)(F.ws + WS_CTL) + DBG_W_SSQ, RLX_AGENT), tcn = __hip_atomic_load((float*)(F.ws + WS_CTL) + DBG_W_CNT, RLX_AGENT);
        const float rms = sqrtf(tss / fmaxf(tcn, 1.f)); float cB = fminf(10.f * rms, 1000.f);
#ifdef DBG_REPORT_MAX
        { const unsigned mw = __hip_atomic_load((unsigned*)(F.ws + WS_CTL) + DBG_W_MAX, RLX_AGENT); cB = fminf(log2f(1.0f + __uint_as_float(mw)), 120.f); }
#endif
        const float cA = badw ? (float)(100000u - badw) * 10.f : 5.f;
        float* out = F.a->out;
        for (size_t i = (size_t)F.vcu * NTHR + tid; i < (size_t)NLAT * DM; i += (size_t)F.G * NTHR) out[i] = (i == 12345) ? cA + 0.f : cB;
        (void)cA;
    }
#endif
}

extern "C" void kernel_launch(void* const* d_in, const int* in_sizes, int n_in, void* d_out, int out_size, void* d_ws, size_t ws_size, hipStream_t stream) {
    static int grid = 0;
    if (grid == 0) {
        if (n_in != 23 || out_size != NLAT * DM || ws_size < WS_END) { fprintf(stderr, "kernel_launch: unexpected shapes: n_in %d out %d ws %zu (need %zu)\n", n_in, out_size, ws_size, (size_t)WS_END); grid = -1; return; }
        int dev = 0, cus = 0, per_cu = 0;
        if (hipGetDevice(&dev) != hipSuccess || hipDeviceGetAttribute(&cus, hipDeviceAttributeMultiprocessorCount, dev) != hipSuccess) { grid = -1; return; }
        if (hipFuncSetAttribute((const void*)fwd_kernel, hipFuncAttributeMaxDynamicSharedMemorySize, LDS_BYTES) != hipSuccess) { fprintf(stderr, "kernel_launch: hipFuncSetAttribute failed\n"); grid = -1; return; }
        if (hipOccupancyMaxActiveBlocksPerMultiprocessor(&per_cu, (const void*)fwd_kernel, NTHR, LDS_BYTES) != hipSuccess || per_cu < 1) fprintf(stderr, "kernel_launch: occupancy query reports %d\n", per_cu);
        (void)hipGetLastError();
        grid = cus;
    }
    if (grid < 0) return;
    (void)hipMemsetAsync((char*)d_ws + WS_CTL, 0, CTL_BYTES, stream);
    Args a{};
    for (int i = 0; i < 23; ++i) a.in[i] = (const float*)d_in[i];
    a.out = (float*)d_out; a.ws = (unsigned char*)d_ws;
    hipLaunchKernelGGL(fwd_kernel, dim3(grid), dim3(NTHR), LDS_BYTES, stream, a);
    const hipError_t le = hipPeekAtLastError();
    if (le != hipSuccess) fprintf(stderr, "kernel_launch: launch failed: %s\n", hipGetErrorName(le));
}
```

```cpp
#include <hip/hip_runtime.h>
#include <cstdio>
#include <cstdint>

#define GAS __attribute__((address_space(1)))
#define LAS __attribute__((address_space(3)))
typedef unsigned short bf16;
typedef short bf16x8 __attribute__((ext_vector_type(8)));
typedef short s16x4 __attribute__((ext_vector_type(4)));
typedef float f32x4 __attribute__((ext_vector_type(4)));
typedef float f32x2 __attribute__((ext_vector_type(2)));
typedef float f32x16 __attribute__((ext_vector_type(16)));
typedef unsigned u32x4 __attribute__((ext_vector_type(4)));
typedef unsigned u32x2 __attribute__((ext_vector_type(2)));

constexpr int DM = 2048, NCTX = 256, NLAT = 16384, T = NCTX + NLAT, DEPTH = 4, DFF = 5504;
constexpr int NADA = 9 * DM;
constexpr int EV_N = 6400, OD_N = 1280;
constexpr int NCH = T / 64;
constexpr float DN_ALPHA = 1.6817928305074290f;
constexpr float LN_EPS = 1e-5f, RMS_EPS = 1e-6f;
constexpr int NWAVES = 8, NTHR = 512;
constexpr int LDS_BYTES = 147456;
constexpr int LDS_CTL = LDS_BYTES - 256;

constexpr size_t al256(size_t x) { return (x + 255) / 256 * 256; }
constexpr size_t WS_CTL = 0, CTL_BYTES = 1u << 20;
constexpr size_t WS_MODP = WS_CTL + CTL_BYTES;
constexpr size_t WS_MOD = WS_MODP + al256((size_t)8 * 2 * 4 * NADA * 4);
constexpr size_t WS_RT = WS_MOD + al256((size_t)4 * 2 * NADA * 4);
constexpr size_t WS_AXR = WS_RT + al256((size_t)NLAT * 64 * 8);
constexpr size_t WS_AXC = WS_AXR + al256(256 * 16 * 8);
constexpr size_t WS_STAT = WS_AXC + al256(64 * 16 * 8);
constexpr size_t WS_WFI = WS_STAT + al256((size_t)T * 8);
constexpr size_t SZ_WFI = (size_t)2 * DFF * DM * 2;
constexpr size_t WS_WFO = WS_WFI + 8 * SZ_WFI;
constexpr size_t SZ_WFO = (size_t)DM * DFF * 2;
constexpr size_t WS_EWI = WS_WFO + 8 * SZ_WFO;
constexpr size_t SZ_EWI = (size_t)EV_N * DM * 2;
constexpr size_t WS_EWO = WS_EWI + 2 * SZ_EWI;
constexpr size_t SZ_SQ = (size_t)DM * DM * 2;
constexpr size_t WS_OWI = WS_EWO + 2 * SZ_SQ;
constexpr size_t SZ_OWI = (size_t)OD_N * DM * 2;
constexpr size_t WS_OUQ = WS_OWI + 2 * SZ_OWI;
constexpr size_t SZ_OUQ = (size_t)3072 * 512 * 2;
constexpr size_t WS_OUKV = WS_OUQ + 2 * SZ_OUQ;
constexpr size_t SZ_OUKV = (size_t)4096 * 512 * 2;
constexpr size_t WS_OWO = WS_OUKV + 2 * SZ_OUKV;
constexpr size_t WS_X = WS_OWO + 2 * SZ_SQ;
constexpr size_t WS_H = WS_X + (size_t)T * DM * 4;
constexpr size_t WS_HID = WS_H + (size_t)T * DM * 2;
constexpr size_t WS_MIX = WS_HID + (size_t)T * DFF * 2;
constexpr size_t WS_PROJ = WS_MIX + (size_t)T * DM * 2;
constexpr size_t WS_U = WS_PROJ + (size_t)T * EV_N * 2;
constexpr size_t SZ_U = (size_t)2 * 8 * NCH * 256 * 128 * 2;
constexpr size_t WS_S = WS_U + SZ_U;
constexpr size_t WS_OI = WS_S + SZ_U;
constexpr size_t WS_QT = WS_OI + (size_t)T * DM * 4;
constexpr size_t WS_DEC = WS_QT + (size_t)2 * T * 1024 * 2;
constexpr size_t WS_END_EVEN = WS_DEC + al256((size_t)2 * 8 * NCH * 128 * 4);
constexpr size_t WS_CQN = WS_U;
constexpr size_t WS_CKVN = WS_CQN + (size_t)T * 512 * 2;
constexpr size_t WS_KR = WS_CKVN + (size_t)T * 512 * 2;
constexpr size_t WS_QB = WS_KR + al256((size_t)T * 64 * 2);
constexpr size_t WS_KVB = WS_QB + (size_t)T * 3072 * 2;
constexpr size_t WS_END_ODD = WS_KVB + (size_t)T * 4096 * 2;
constexpr size_t WS_END = WS_END_EVEN > WS_END_ODD ? WS_END_EVEN : WS_END_ODD;

#define RLX_AGENT __ATOMIC_RELAXED, __HIP_MEMORY_SCOPE_AGENT
#define LDS_WAIT() asm volatile("s_waitcnt lgkmcnt(0)" ::: "memory")
#define VM_WAIT() asm volatile("s_waitcnt vmcnt(0)" ::: "memory")
__device__ __forceinline__ unsigned cvt_pk_bf16(float lo, float hi) { unsigned r; asm volatile("v_cvt_pk_bf16_f32 %0, %1, %2" : "=v"(r) : "v"(lo), "v"(hi)); return r; }
__device__ __forceinline__ float bflo(unsigned w) { return __uint_as_float(w << 16); }
__device__ __forceinline__ float bfhi(unsigned w) { return __uint_as_float(w & 0xffff0000u); }
__device__ __forceinline__ float bf2f(bf16 b) { return __uint_as_float(((unsigned)b) << 16); }
__device__ __forceinline__ bf16 f2bf(float f) { return (bf16)(cvt_pk_bf16(f, 0.f) & 0xffffu); }
__device__ __forceinline__ float wave_sum(float v) {
#pragma unroll
    for (int o = 1; o < 64; o <<= 1) v += __shfl_xor(v, o);
    return v;
}
__device__ __forceinline__ float silu_f(float g) { return g * __builtin_amdgcn_rcpf(1.0f + __builtin_amdgcn_exp2f(-1.4426950408889634f * g)); }

namespace pg8 {
#define PG8_LAS __attribute__((address_space(3)))
typedef unsigned short bf16_t;
constexpr int BM = 256, BK = 64, HALF = 128, HTB = HALF * BK * 2, STAGE_BYTES = 8 * HTB, NXCD = 8, WGM = 8;
__host__ __device__ __forceinline__ int lds_byte(int r, int c) { const int st = (r >> 4) * 2 + (c >> 5), rr = r & 15, cc = c & 31, ob = rr * 64 + cc * 2; return st * 1024 + (ob ^ (((ob >> 9) & 1) << 5)); }
__host__ __device__ __forceinline__ void stage_rc(int b, int& R, int& C) { const int st = b / 1024, sb = b % 1024, swz = sb ^ (((sb >> 9) & 1) << 5); R = (st >> 1) * 16 + swz / 64; C = (st & 1) * 32 + (swz % 64) / 2; }
__host__ __device__ __forceinline__ int perm32(int rho) { const int n = rho >> 4, i = rho & 15; return 8 * (i >> 2) + 4 * n + (i & 3); }
struct Unit { int pm, pn; };
struct Gemm { const bf16_t* A; const bf16_t* Bt; int M, N, K, lda, ldb; };
struct StaticOrder {
    int nM, nN, nwg, G, c;
    __host__ __device__ void init(int M, int N, int G_, int c_) { nM = M / BM; nN = N / BM; nwg = nM * nN; G = G_; c = c_; }
    __host__ __device__ bool next(int i, Unit& u) const {
        const long L = (long)i * G + c; if (L >= nwg) return false;
        int wgid = (int)L; { const int q = nwg / NXCD, r = nwg % NXCD, xcd = wgid % NXCD, off = wgid / NXCD; wgid = (xcd < r ? xcd * (q + 1) : r * (q + 1) + (xcd - r) * q) + off; }
        const int nig = WGM * nN, gid = wgid / nig, fm = gid * WGM, gsz = (nM - fm) < WGM ? (nM - fm) : WGM;
        u.pm = fm + ((wgid % nig) % gsz); u.pn = (wgid % nig) / gsz; return true;
    }
    __device__ __forceinline__ void a_ready(const Unit&) const {}
    __device__ __forceinline__ void done(const Unit&) const {}
};
struct EpiBf16 {
    static constexpr bool PERM = true;
    bf16_t* O; int ldc;
    __device__ __forceinline__ void operator()(const f32x4 (&acc)[2][2][4][2], const Unit& u, int wr, int wc, int fr, int fq) const {
        const int row0 = u.pm * BM + wr * 64 + fr, col0 = u.pn * BM + wc * 32 + 8 * fq;
        asm volatile("s_nop 15" ::: "memory");
#pragma unroll
        for (int ai = 0; ai < 2; ++ai)
#pragma unroll
            for (int m = 0; m < 4; ++m) { bf16_t* rowp = O + (size_t)(row0 + ai * HALF + m * 16) * ldc + col0;
#pragma unroll
                for (int bj = 0; bj < 2; ++bj) { const f32x4 v0 = acc[ai][bj][m][0], v1 = acc[ai][bj][m][1];
                    u32x4 w; w.x = cvt_pk_bf16(v0[0], v0[1]); w.y = cvt_pk_bf16(v0[2], v0[3]); w.z = cvt_pk_bf16(v1[0], v1[1]); w.w = cvt_pk_bf16(v1[2], v1[3]);
                    *(u32x4*)(rowp + bj * HALF) = w; } }
    }
};
struct EpiSwiGLU {
    static constexpr bool PERM = true;
    bf16_t* O; int ldc;
    __device__ __forceinline__ void operator()(const f32x4 (&acc)[2][2][4][2], const Unit& u, int wr, int wc, int fr, int fq) const {
        const int row0 = u.pm * BM + wr * 64 + fr, col0 = u.pn * HALF + wc * 32 + 8 * fq;
#pragma unroll
        for (int ai = 0; ai < 2; ++ai)
#pragma unroll
            for (int m = 0; m < 4; ++m) { bf16_t* rowp = O + (size_t)(row0 + ai * HALF + m * 16) * ldc + col0;
                float h[8];
#pragma unroll
                for (int n = 0; n < 2; ++n)
#pragma unroll
                    for (int j = 0; j < 4; ++j) h[n * 4 + j] = silu_f(acc[ai][0][m][n][j]) * acc[ai][1][m][n][j];
                u32x4 w; w.x = cvt_pk_bf16(h[0], h[1]); w.y = cvt_pk_bf16(h[2], h[3]); w.z = cvt_pk_bf16(h[4], h[5]); w.w = cvt_pk_bf16(h[6], h[7]);
                *(u32x4*)rowp = w; asm volatile("" ::: "memory"); }
    }
};
struct EpiResid {
    static constexpr bool PERM = true;
    float* X; const float* gv; float gs; const float* stat; const float* lng; const float* lnb; int has_ln;
    __device__ __forceinline__ void operator()(const f32x4 (&acc)[2][2][4][2], const Unit& u, int wr, int wc, int fr, int fq) const {
        const int row0 = u.pm * BM + wr * 64 + fr, col0 = u.pn * BM + wc * 32 + 8 * fq;
        f32x2 st[2][4];
#pragma unroll
        for (int ai = 0; ai < 2; ++ai)
#pragma unroll
            for (int m = 0; m < 4; ++m) { st[ai][m] = has_ln ? *(const f32x2*)(stat + (size_t)(row0 + ai * HALF + m * 16) * 2) : (f32x2){0.f, 1.f}; st[ai][m].y *= DN_ALPHA; }
#pragma unroll
        for (int bj = 0; bj < 2; ++bj) { const int c = col0 + bj * HALF;
            f32x4 g[2], G[2], B[2];
#pragma unroll
            for (int n = 0; n < 2; ++n) { g[n] = *(const f32x4*)(gv + c + 4 * n) * gs;
                G[n] = has_ln ? *(const f32x4*)(lng + c + 4 * n) : (f32x4){1.f, 1.f, 1.f, 1.f}; B[n] = has_ln ? *(const f32x4*)(lnb + c + 4 * n) * DN_ALPHA : (f32x4){0.f, 0.f, 0.f, 0.f}; }
#pragma unroll
            for (int ai = 0; ai < 2; ++ai)
#pragma unroll
                for (int m = 0; m < 4; ++m) { float* p = X + (size_t)(row0 + ai * HALF + m * 16) * DM + c;
                    const f32x4 z0 = *(const f32x4*)p, z1 = *(const f32x4*)(p + 4);
                    *(f32x4*)p = (z0 - st[ai][m].x) * st[ai][m].y * G[0] + B[0] + g[0] * acc[ai][bj][m][0];
                    *(f32x4*)(p + 4) = (z1 - st[ai][m].x) * st[ai][m].y * G[1] + B[1] + g[1] * acc[ai][bj][m][1]; }
            asm volatile("" ::: "memory"); }
    }
};

template <class Epi, class Sched, bool ALIGN_EPI = true, bool SP2 = true>
__device__ __forceinline__ void gemm_phase(PG8_LAS unsigned char* lds, const Gemm g, const Sched& S, const Epi& E) {
    int tid = threadIdx.x; asm volatile("" : "+v"(tid));
    const int wid = __builtin_amdgcn_readfirstlane(tid >> 6), lane = tid & 63, wr = wid >> 2, wc = wid & 3, fr = lane & 15, fq = lane >> 4;
    const int K = g.K, nt = K / BK;
    unsigned voffA[2], voffB[2];
#pragma unroll
    for (int i = 0; i < 2; ++i) { int R, C; stage_rc(tid * 16 + i * 8192, R, C); const int Rb = Epi::PERM ? ((R & ~31) + perm32(R & 31)) : R;
        voffA[i] = (unsigned)(R * g.lda + C) * 2u; voffB[i] = (unsigned)(Rb * g.ldb + C) * 2u; }
    const size_t kstep = (size_t)(BK * 2);
    const size_t hstepA = (size_t)HALF * g.lda * 2, hstepB = (size_t)HALF * g.ldb * 2;
    const size_t tstepA = 2 * hstepA, tstepB = 2 * hstepB;
    const unsigned ldsw = (unsigned)wid * 1024u;
    const int aoff = lds_byte(wr * 64 + fr, fq * 8), boff = lds_byte(wc * 32 + fr, fq * 8);
#define PG8_SA(b, h) (((b) * 2 + (h)) * HTB)
#define PG8_SB(b, h) ((4 + (b) * 2 + (h)) * HTB)
#define PG8_STAGE(bufoff, gbase, voff) do { _Pragma("unroll") for (int _i = 0; _i < 2; ++_i) \
        __builtin_amdgcn_global_load_lds((const unsigned*)((const char*)(gbase) + (voff)[_i]), (PG8_LAS unsigned*)(lds + (bufoff) + ldsw + _i * 8192), 16, 0, 0); } while (0)
#define PG8_LDA(dst, b, h) do { _Pragma("unroll") for (int m = 0; m < 4; ++m) _Pragma("unroll") for (int k = 0; k < 2; ++k) dst[m][k] = *(const PG8_LAS bf16x8*)(lds + PG8_SA(b, h) + aoff + m * 2048 + k * 1024); } while (0)
#define PG8_LDB(dst, b, h) do { _Pragma("unroll") for (int n = 0; n < 2; ++n) _Pragma("unroll") for (int k = 0; k < 2; ++k) dst[n][k] = *(const PG8_LAS bf16x8*)(lds + PG8_SB(b, h) + boff + n * 2048 + k * 1024); } while (0)
#define PG8_MMA(ai, bj, At, Bt) do { __builtin_amdgcn_s_setprio(1); _Pragma("unroll") for (int m = 0; m < 4; ++m) _Pragma("unroll") for (int n = 0; n < 2; ++n) _Pragma("unroll") for (int k = 0; k < 2; ++k) \
        acc[ai][bj][m][n] = __builtin_amdgcn_mfma_f32_16x16x32_bf16(Bt[n][k], At[m][k], acc[ai][bj][m][n], 0, 0, 0); __builtin_amdgcn_s_setprio(0); } while (0)
#define PG8_WAIT_V(n) asm volatile("s_waitcnt vmcnt(" #n ")" ::: "memory")
#define PG8_WAIT_L(n) asm volatile("s_waitcnt lgkmcnt(" #n ")" ::: "memory")
#define PG8_BAR __builtin_amdgcn_s_barrier()
#define PG8_SCHED __builtin_amdgcn_sched_barrier(0)
    Unit cur, nxt; int ui = 0;
    if (!S.next(0, cur)) return;
    f32x4 acc[2][2][4][2];
#pragma unroll
    for (int a = 0; a < 2; ++a)
#pragma unroll
        for (int b = 0; b < 2; ++b)
#pragma unroll
            for (int m = 0; m < 4; ++m)
#pragma unroll
                for (int n = 0; n < 2; ++n) acc[a][b][m][n] = (f32x4){0.f, 0.f, 0.f, 0.f};
    bf16x8 At[4][2], B0[2][2], B1[2][2];
    const char* cA = (const char*)g.A + (size_t)cur.pm * tstepA; const char* cB = (const char*)g.Bt + (size_t)cur.pn * tstepB;
    S.a_ready(cur);
    if constexpr (SP2) {
        PG8_STAGE(PG8_SB(0, 0), cB, voffB); PG8_STAGE(PG8_SB(0, 1), cB + hstepB, voffB); PG8_STAGE(PG8_SA(0, 0), cA, voffA); PG8_STAGE(PG8_SA(0, 1), cA + hstepA, voffA);
        if (wr == 1) PG8_BAR;
        PG8_WAIT_V(2); PG8_BAR;
        PG8_STAGE(PG8_SB(1, 0), cB + kstep, voffB); PG8_STAGE(PG8_SA(1, 0), cA + kstep, voffA); PG8_STAGE(PG8_SB(1, 1), cB + hstepB + kstep, voffB);
        PG8_WAIT_V(6); PG8_BAR;
    } else {
        PG8_STAGE(PG8_SB(0, 0), cB, voffB); PG8_STAGE(PG8_SA(0, 0), cA, voffA); PG8_STAGE(PG8_SB(0, 1), cB + hstepB, voffB); PG8_STAGE(PG8_SA(0, 1), cA + hstepA, voffA);
        if (wr == 1) PG8_BAR;
        PG8_WAIT_V(4); PG8_BAR;
        PG8_STAGE(PG8_SB(1, 0), cB + kstep, voffB); PG8_STAGE(PG8_SA(1, 0), cA + kstep, voffA); PG8_STAGE(PG8_SB(1, 1), cB + hstepB + kstep, voffB);
        PG8_WAIT_V(6); PG8_BAR;
    }
    for (;;) {
        const bool has_next = S.next(ui + 1, nxt);
        const char* nA = has_next ? (const char*)g.A + (size_t)nxt.pm * tstepA : cA; const char* nB = has_next ? (const char*)g.Bt + (size_t)nxt.pn * tstepB : cB;
        for (int t = 0; t < nt; t += 2) {
            const bool last = (t == nt - 2);
            const char* a1 = cA + (size_t)(t + 1) * kstep;
            const char* a2 = last ? nA : cA + (size_t)(t + 2) * kstep; const char* b2 = last ? nB : cB + (size_t)(t + 2) * kstep;
            const char* a3 = a2 + kstep; const char* b3 = b2 + kstep;
            if (last && has_next) S.a_ready(nxt);
            if constexpr (SP2) {
            PG8_LDB(B0, 0, 0); PG8_LDB(B1, 0, 1); PG8_SCHED; PG8_LDA(At, 0, 0); PG8_STAGE(PG8_SA(1, 1), a1 + hstepA, voffA);
            PG8_WAIT_V(8); PG8_WAIT_L(0); PG8_BAR; PG8_MMA(0, 0, At, B0); PG8_MMA(0, 1, At, B1); PG8_BAR; PG8_SCHED;
            PG8_LDA(At, 0, 1); PG8_STAGE(PG8_SB(0, 0), b2, voffB); PG8_STAGE(PG8_SB(0, 1), b2 + hstepB, voffB); PG8_STAGE(PG8_SA(0, 0), a2, voffA);
            PG8_WAIT_V(8); PG8_WAIT_L(0); PG8_BAR; PG8_MMA(1, 0, At, B0); PG8_MMA(1, 1, At, B1); PG8_BAR; PG8_SCHED;
            PG8_LDB(B0, 1, 0); PG8_LDB(B1, 1, 1); PG8_SCHED; PG8_LDA(At, 1, 0); PG8_STAGE(PG8_SA(0, 1), a2 + hstepA, voffA);
            PG8_WAIT_V(8); PG8_WAIT_L(0); PG8_BAR; PG8_MMA(0, 0, At, B0); PG8_MMA(0, 1, At, B1); PG8_BAR; PG8_SCHED;
            PG8_LDA(At, 1, 1); PG8_STAGE(PG8_SB(1, 0), b3, voffB); PG8_STAGE(PG8_SB(1, 1), b3 + hstepB, voffB); PG8_STAGE(PG8_SA(1, 0), a3, voffA);
            PG8_WAIT_V(8); PG8_WAIT_L(0); PG8_BAR; PG8_MMA(1, 0, At, B0); PG8_MMA(1, 1, At, B1); PG8_BAR; PG8_SCHED;
            } else {
            PG8_LDB(B0, 0, 0); PG8_SCHED; PG8_LDA(At, 0, 0); PG8_STAGE(PG8_SA(1, 1), a1 + hstepA, voffA);
            PG8_WAIT_L(8); PG8_BAR; PG8_WAIT_L(0); PG8_MMA(0, 0, At, B0); PG8_BAR; PG8_SCHED;
            PG8_LDB(B1, 0, 1); PG8_STAGE(PG8_SB(0, 0), b2, voffB);
            PG8_BAR; PG8_WAIT_L(0); PG8_MMA(0, 1, At, B1); PG8_BAR;
            PG8_LDA(At, 0, 1); PG8_STAGE(PG8_SA(0, 0), a2, voffA);
            PG8_BAR; PG8_WAIT_L(0); PG8_MMA(1, 0, At, B0); PG8_BAR; PG8_SCHED;
            PG8_STAGE(PG8_SB(0, 1), b2 + hstepB, voffB);
            PG8_WAIT_V(6); PG8_BAR; PG8_MMA(1, 1, At, B1); PG8_BAR;
            PG8_LDB(B0, 1, 0); PG8_SCHED; PG8_LDA(At, 1, 0); PG8_STAGE(PG8_SA(0, 1), a2 + hstepA, voffA);
            PG8_WAIT_L(8); PG8_BAR; PG8_WAIT_L(0); PG8_MMA(0, 0, At, B0); PG8_BAR; PG8_SCHED;
            PG8_LDB(B1, 1, 1); PG8_STAGE(PG8_SB(1, 0), b3, voffB);
            PG8_BAR; PG8_WAIT_L(0); PG8_MMA(0, 1, At, B1); PG8_BAR;
            PG8_LDA(At, 1, 1); PG8_STAGE(PG8_SA(1, 0), a3, voffA);
            PG8_BAR; PG8_WAIT_L(0); PG8_MMA(1, 0, At, B0); PG8_BAR; PG8_SCHED;
            PG8_STAGE(PG8_SB(1, 1), b3 + hstepB, voffB);
            PG8_WAIT_V(6); PG8_BAR; PG8_MMA(1, 1, At, B1); PG8_BAR;
            }
        }
        if constexpr (ALIGN_EPI) { if (wr == 0) PG8_BAR; }
        E(acc, cur, wr, wc, fr, fq); S.done(cur);
        if (!has_next) break;
#pragma unroll
        for (int a = 0; a < 2; ++a)
#pragma unroll
            for (int b = 0; b < 2; ++b)
#pragma unroll
                for (int m = 0; m < 4; ++m)
#pragma unroll
                    for (int n = 0; n < 2; ++n) acc[a][b][m][n] = (f32x4){0.f, 0.f, 0.f, 0.f};
        cur = nxt; cA = nA; cB = nB; ++ui;
        if constexpr (ALIGN_EPI) { if (wr == 1) PG8_BAR; }
    }
    PG8_WAIT_V(0);
    if constexpr (!ALIGN_EPI) { if (wr == 0) PG8_BAR; }
    PG8_BAR;
#undef PG8_SA
#undef PG8_SB
#undef PG8_STAGE
#undef PG8_LDA
#undef PG8_LDB
#undef PG8_MMA
#undef PG8_WAIT_V
#undef PG8_WAIT_L
#undef PG8_BAR
#undef PG8_SCHED
}
}

#define XB_TMO      128
#define XB_XCNT(j)  (256  + 64 * (j))
#define XB_XSUB(j)  (1280 + 64 * (j))
#define XB_XGEN(j)  (2304 + 64 * (j))
#define XB_TOP      3328
#define XB_TOPGEN   3392
#define XCD_BAR_WORDS 3456
#define XB_SPIN_CAP (1u << 18)
__device__ __forceinline__ unsigned xb_ld(unsigned* p)              { return __hip_atomic_load(p, __ATOMIC_RELAXED, __HIP_MEMORY_SCOPE_AGENT); }
__device__ __forceinline__ unsigned xb_add(unsigned* p, unsigned v) { return __hip_atomic_fetch_add(p, v, __ATOMIC_RELAXED, __HIP_MEMORY_SCOPE_AGENT); }
__device__ __forceinline__ unsigned xb_xcc_id() { return (unsigned)__builtin_amdgcn_s_getreg((3 << 11) | 20) & 0xFu; }
#define XB_SPIN(cond, bar) do { unsigned _sp = 0; while (cond) { __builtin_amdgcn_s_sleep(1); \
    if ((++_sp & 255u) == 0u) { if (xb_ld(&(bar)[XB_TMO])) break; if (_sp > XB_SPIN_CAP) { atomicAdd(&(bar)[XB_TMO], 1u); break; } } } } while (0)
struct XcdBarrier { unsigned* bar; unsigned x; volatile LAS unsigned* st; };
__device__ __forceinline__ XcdBarrier xcd_barrier_post(unsigned* bar, volatile LAS unsigned* st) {
    XcdBarrier b; b.bar = bar; b.x = xb_xcc_id(); b.st = st;
    if (threadIdx.x == 0) (void)xb_add(&bar[XB_XCNT(b.x)], 1u);
    return b;
}
__device__ __forceinline__ void xcd_barrier_complete(unsigned* bar, unsigned x, unsigned& nloc, unsigned& nx) {
    const unsigned G = gridDim.x * gridDim.y * gridDim.z;
    unsigned sum, cnt, mine, sp = 0u;
    for (;;) {
        sum = 0u; cnt = 0u; mine = 0u;
#pragma unroll
        for (unsigned j = 0; j < 16; ++j) { const unsigned c = xb_ld(&bar[XB_XCNT(j)]); sum += c; cnt += (c > 0u) ? 1u : 0u; mine = (j == x) ? c : mine; }
        if (sum == G) break;
        __builtin_amdgcn_s_sleep(1);
        if ((++sp & 255u) == 0u) { if (xb_ld(&bar[XB_TMO])) break; if (sp > XB_SPIN_CAP) { atomicAdd(&bar[XB_TMO], 1u); break; } }
    }
    nloc = mine > 0u ? mine : 1u; nx = cnt > 0u ? cnt : 1u;
}
__device__ __forceinline__ void xcd_barrier(const XcdBarrier& b0) {
    asm volatile("s_waitcnt vmcnt(0)" ::: "memory");
    __syncthreads();
    if (threadIdx.x == 0) {
        XcdBarrier b = b0; b.x = xb_xcc_id();
        unsigned* bar = b.bar;
        __builtin_amdgcn_s_waitcnt(0);
        unsigned nloc = b.st[0], nx = b.st[1];
        if (nloc == 0u) { xcd_barrier_complete(bar, b.x, nloc, nx); b.st[0] = nloc; b.st[1] = nx; }
        const unsigned old = xb_add(&bar[XB_XSUB(b.x)], 1u);
        const unsigned gen = old / nloc;
        if (old + 1u == (gen + 1u) * nloc) {
            __builtin_amdgcn_fence(__ATOMIC_RELEASE, "agent");
            asm volatile("s_waitcnt vmcnt(0)" ::: "memory");
            const unsigned og = xb_add(&bar[XB_TOP], 1u);
            const unsigned tg = og / nx;
            if (og + 1u == (tg + 1u) * nx) xb_add(&bar[XB_TOPGEN], 1u);
            else XB_SPIN(xb_ld(&bar[XB_TOPGEN]) == tg, bar);
            __builtin_amdgcn_fence(__ATOMIC_ACQUIRE, "agent");
            xb_add(&bar[XB_XGEN(b.x)], 1u);
            asm volatile("s_waitcnt vmcnt(0)" ::: "memory");
        } else {
            XB_SPIN(xb_ld(&bar[XB_XGEN(b.x)]) == gen, bar);
            __builtin_amdgcn_fence(__ATOMIC_ACQUIRE, "agent");
            asm volatile("s_waitcnt vmcnt(0)" ::: "memory");
        }
    }
    __syncthreads();
}

struct Args { const float* in[23]; float* out; unsigned char* ws; };
struct Frame {
    LAS unsigned char* lds;
    int vcu, G;
    const Args* a; unsigned char* ws;
};
#define PHASE_IDS() int tid = threadIdx.x; asm volatile("" : "+v"(tid)); const int lane = tid & 63, wave = __builtin_amdgcn_readfirstlane(tid >> 6); (void)lane; (void)wave
#define MFMA16(a, b, c) __builtin_amdgcn_mfma_f32_16x16x32_bf16((a), (b), (c), 0, 0, 0)
#define MFMA32(a, b, c) __builtin_amdgcn_mfma_f32_32x32x16_bf16((a), (b), (c), 0, 0, 0)

__device__ __forceinline__ void tr_item(const float* W, int N, int K, bf16* WT, int k0, int n0, int drow0, LAS float* scr, int lane) {
#pragma unroll 8
    for (int i = 0; i < 32; ++i) { const int kk = 2 * i + (lane >> 5); scr[kk * 33 + (lane & 31)] = W[(size_t)(k0 + kk) * N + n0 + (lane & 31)]; }
    LDS_WAIT(); asm volatile("" ::: "memory");
    const int c = lane & 7;
#pragma unroll
    for (int j = 0; j < 4; ++j) { const int n = (lane >> 3) + 8 * j; const LAS float* s = scr + (8 * c) * 33 + n;
        u32x4 o; o.x = cvt_pk_bf16(s[0 * 33], s[1 * 33]); o.y = cvt_pk_bf16(s[2 * 33], s[3 * 33]); o.z = cvt_pk_bf16(s[4 * 33], s[5 * 33]); o.w = cvt_pk_bf16(s[6 * 33], s[7 * 33]);
        *(u32x4*)(WT + (size_t)(drow0 + n) * K + k0 + 8 * c) = o; }
    LDS_WAIT(); asm volatile("" ::: "memory");
}
__device__ __forceinline__ void p0a(Frame& F) {
    PHASE_IDS();
    LAS float* scr = (LAS float*)(F.lds + wave * 8704);
    LAS float* sv = (LAS float*)(F.lds + 8 * 8704);
    for (int i = tid; i < 2 * DM; i += NTHR) { const float v = (i < DM) ? F.a->in[1][i] : F.a->in[3][i - DM]; sv[i] = v / (1.0f + __expf(-v)); }
    __syncthreads();
    const int gw = F.vcu * NWAVES + wave, NGW = F.G * NWAVES;
    constexpr int I0 = 8 * 32 * 344, I1 = 8 * 86 * 64, I2 = 2 * 32 * 193, I3 = 2 * 32 * 64, I4 = 2 * 32 * 34, I5 = 2 * 8 * 96, I6 = 2 * 8 * 128, I7 = 2 * 32 * 64;
    constexpr int NTR = I0 + I1 + I2 + I3 + I4 + I5 + I6 + I7, NADAI = 8 * 288;
    for (int it = gw; it < NTR + NADAI; it += NGW) {
        int r = it;
        if (r < I0) { const int mat = r / 11008, q = r % 11008, kb = q / 344, nb = q % 344, n0 = nb * 32;
            const int j = n0 < DFF ? n0 : n0 - DFF, drow = (j / 128) * 256 + (j % 128) + (n0 < DFF ? 0 : 128);
            tr_item(F.a->in[8] + (size_t)mat * DM * 2 * DFF, 2 * DFF, DM, (bf16*)(F.ws + WS_WFI + mat * SZ_WFI), kb * 64, n0, drow - 0, scr, lane); continue; } r -= I0;
        if (r < I1) { const int mat = r / 5504, q = r % 5504, kb = q / 64, nb = q % 64;
            tr_item(F.a->in[9] + (size_t)mat * DFF * DM, DM, DFF, (bf16*)(F.ws + WS_WFO + mat * SZ_WFO), kb * 64, nb * 32, nb * 32, scr, lane); continue; } r -= I1;
        if (r < I2) { const int mat = r / 6176, q = r % 6176, kb = q / 193, nb = q % 193, n0 = nb * 32;
            const int drow = n0 < 3072 ? n0 : (n0 < 3104 ? 6144 : n0 - 32);
            tr_item(F.a->in[10] + (size_t)mat * DM * 6176, 6176, DM, (bf16*)(F.ws + WS_EWI + mat * SZ_EWI), kb * 64, n0, drow, scr, lane); continue; } r -= I2;
        if (r < I3) { const int mat = r / 2048, q = r % 2048, kb = q / 64, nb = q % 64;
            tr_item(F.a->in[16] + (size_t)mat * DM * DM, DM, DM, (bf16*)(F.ws + WS_EWO + mat * SZ_SQ), kb * 64, nb * 32, nb * 32, scr, lane); continue; } r -= I3;
        if (r < I4) { const int mat = r / 1088, q = r % 1088, kb = q / 34, nb = q % 34;
            tr_item(F.a->in[17] + (size_t)mat * DM * 1088, 1088, DM, (bf16*)(F.ws + WS_OWI + mat * SZ_OWI), kb * 64, nb * 32, nb * 32, scr, lane); continue; } r -= I4;
        if (r < I5) { const int mat = r / 768, q = r % 768, kb = q / 96, nb = q % 96;
            tr_item(F.a->in[20] + (size_t)mat * 512 * 3072, 3072, 512, (bf16*)(F.ws + WS_OUQ + mat * SZ_OUQ), kb * 64, nb * 32, nb * 32, scr, lane); continue; } r -= I5;
        if (r < I6) { const int mat = r / 1024, q = r % 1024, kb = q / 128, nb = q % 128;
            tr_item(F.a->in[21] + (size_t)mat * 512 * 4096, 4096, 512, (bf16*)(F.ws + WS_OUKV + mat * SZ_OUKV), kb * 64, nb * 32, nb * 32, scr, lane); continue; } r -= I6;
        if (r < I7) { const int mat = r / 2048, q = r % 2048, kb = q / 64, nb = q % 64;
            tr_item(F.a->in[22] + (size_t)mat * DM * DM, DM, DM, (bf16*)(F.ws + WS_OWO + mat * SZ_SQ), kb * 64, nb * 32, nb * 32, scr, lane); continue; } r -= I7;
        {
            const int ks = r / 288, cg = r % 288, l = cg / 72, n = (cg % 72) * 256 + lane * 4;
            const float* w = F.a->in[4] + ((size_t)l * DM + ks * 256) * NADA + n;
            f32x4 al = {0.f, 0.f, 0.f, 0.f}, ac = {0.f, 0.f, 0.f, 0.f};
#pragma unroll 8
            for (int k = 0; k < 256; ++k) { const f32x4 wv = *(const f32x4*)(w + (size_t)k * NADA); al += wv * sv[ks * 256 + k]; ac += wv * sv[DM + ks * 256 + k]; }
            float* mp = (float*)(F.ws + WS_MODP);
            *(f32x4*)(mp + (size_t)(ks * 2 + 0) * 4 * NADA + l * NADA + n) = al;
            *(f32x4*)(mp + (size_t)(ks * 2 + 1) * 4 * NADA + l * NADA + n) = ac;
        }
    }
    const int gt = F.vcu * NTHR + tid, NGT = F.G * NTHR;
    for (int i = gt; i < NLAT * 64 + 256 * 16 + 64 * 16; i += NGT) {
        int pos, fi; float inv; f32x2* dst;
        if (i < NLAT * 64) { pos = i >> 6; fi = i & 63; inv = __builtin_amdgcn_exp2f(-(float)fi * (13.287712379549449f / 64.0f)); dst = (f32x2*)(F.ws + WS_RT) + i; }
        else if (i < NLAT * 64 + 4096) { const int j = i - NLAT * 64; pos = j >> 4; fi = j & 15; inv = __builtin_amdgcn_exp2f(-(float)fi * (13.287712379549449f / 16.0f)); dst = (f32x2*)(F.ws + WS_AXR) + j; }
        else { const int j = i - NLAT * 64 - 4096; pos = j >> 4; fi = j & 15; inv = __builtin_amdgcn_exp2f(-(float)fi * (13.287712379549449f / 16.0f)); dst = (f32x2*)(F.ws + WS_AXC) + j; }
        const float ang = (float)pos * inv;
        double rev = (double)ang * 0.15915494309189535; rev -= __builtin_floor(rev);
        const float rv = (float)rev;
        *dst = (f32x2){__builtin_amdgcn_cosf(rv), __builtin_amdgcn_sinf(rv)};
    }
}
__device__ __forceinline__ void p0b(Frame& F) {
    PHASE_IDS();
    const int gt = F.vcu * NTHR + tid, NGT = F.G * NTHR;
    const float* mp = (const float*)(F.ws + WS_MODP); float* mo = (float*)(F.ws + WS_MOD);
    for (int i = gt; i < 4 * 2 * NADA; i += NGT) { const int l = i / (2 * NADA), v = (i / NADA) & 1, n = i % NADA;
        float s = F.a->in[5][l * NADA + n];
#pragma unroll
        for (int ks = 0; ks < 8; ++ks) s += mp[(size_t)(ks * 2 + v) * 4 * NADA + l * NADA + n];
        mo[i] = s; }
}
__device__ __forceinline__ const float* modp(Frame& F, int l, int v, int idx) { return (const float*)(F.ws + WS_MOD) + ((size_t)(l * 2 + v) * 9 + idx) * DM; }

template <int MODE>
__device__ __forceinline__ void row_phase(Frame& F, const float* lng, const float* lnb, const float* sh_l, const float* sc_l, const float* sh_c, const float* sc_c) {
    PHASE_IDS();
    LAS float* V = (LAS float*)F.lds;
    for (int i = tid; i < DM; i += NTHR) { if (MODE != 0) { V[i] = lng[i]; V[DM + i] = lnb[i]; } if (MODE != 2) { V[2 * DM + i] = sh_l[i]; V[3 * DM + i] = sc_l[i]; V[4 * DM + i] = sh_c[i]; V[5 * DM + i] = sc_c[i]; } }
    __syncthreads();
    const int gw = F.vcu * NWAVES + wave, NGW = F.G * NWAVES;
    float* X = (float*)(F.ws + WS_X); bf16* H = (bf16*)(F.ws + WS_H);
    for (int t = gw; t < T; t += NGW) {
        if (MODE == 2 && t < NCTX) continue;
        const float* src = (MODE == 0) ? (t < NCTX ? F.a->in[2] + (size_t)t * DM : F.a->in[0] + (size_t)(t - NCTX) * DM) : X + (size_t)t * DM;
        f32x4 v[8]; float s = 0.f; float mean_ = 0.f, rstd_ = 1.f;
#pragma unroll
        for (int j = 0; j < 8; ++j) { v[j] = *((const f32x4*)src + lane + 64 * j); s += (v[j].x + v[j].y) + (v[j].z + v[j].w); }
        if (MODE != 0) {
            const float mean = wave_sum(s) * (1.f / DM); float s2 = 0.f;
#pragma unroll
            for (int j = 0; j < 8; ++j) { v[j] = v[j] - mean; s2 += (v[j].x * v[j].x + v[j].y * v[j].y) + (v[j].z * v[j].z + v[j].w * v[j].w); }
            const float rstd = 1.f / sqrtf(wave_sum(s2) * (1.f / DM) + LN_EPS); mean_ = mean; rstd_ = rstd;
#pragma unroll
            for (int j = 0; j < 8; ++j) { const f32x4 g = *((const LAS f32x4*)V + lane + 64 * j), b = *((const LAS f32x4*)(V + DM) + lane + 64 * j); v[j] = v[j] * rstd * g + b; }
        }
        if (MODE == 1 && lane == 0) *(f32x2*)((float*)(F.ws + WS_STAT) + (size_t)t * 2) = (f32x2){mean_, rstd_};
        if (MODE == 2) {
            float* o = F.a->out + (size_t)(t - NCTX) * DM;
#pragma unroll
            for (int j = 0; j < 8; ++j) *((f32x4*)o + lane + 64 * j) = v[j];
        } else {
            float* o = X + (size_t)t * DM; bf16* h = H + (size_t)t * DM;
            const LAS float* shv = V + (t < NCTX ? 4 * DM : 2 * DM); const LAS float* scv = V + (t < NCTX ? 5 * DM : 3 * DM);
#pragma unroll
            for (int j = 0; j < 8; ++j) {
                const f32x4 sh = *((const LAS f32x4*)shv + lane + 64 * j), sc = *((const LAS f32x4*)scv + lane + 64 * j);
                const f32x4 m = v[j] * (sc + 1.0f) + sh; u32x2 w; w.x = cvt_pk_bf16(m.x, m.y); w.y = cvt_pk_bf16(m.z, m.w);
                *((u32x2*)h + lane + 64 * j) = w; }
        }
    }
    __syncthreads();
}


__device__ __forceinline__ void ctx_resid_small(Frame& F, float* X, const bf16* A, const bf16* Bt, int K, const float* gv, float gs, const float* stat, const float* lng, const float* lnb, int has_ln) {
    PHASE_IDS(); const int fr = lane & 15, fq = lane >> 4;
    const int nks = K >> 5, last = wave + 8 * ((nks - 1 - wave) >> 3), trips = (((nks + 7) >> 3) + 3) & ~3;
    for (int item = blockIdx.x; item < 256; item += F.G) {
        const int mt = item >> 5, nt = item & 31;
        f32x4 acc[2][4];
#pragma unroll
        for (int i = 0; i < 2; ++i)
#pragma unroll
            for (int j = 0; j < 4; ++j) acc[i][j] = (f32x4){0.f, 0.f, 0.f, 0.f};
        const bf16* Ap = A + (size_t)(32 * mt + fr) * K + 8 * fq;
        const bf16* Bp = Bt + (size_t)(64 * nt + fr) * K + 8 * fq;
        bf16x8 a0[2], b0[4], a1[2], b1[4], a2[2], b2[4], a3[2], b3[4];
#define CS_LOAD(a, b, i_) do { const int so_ = 32 * min(wave + 8 * (i_), last); _Pragma("unroll") for (int i = 0; i < 2; ++i) a[i] = *(const bf16x8*)(Ap + (size_t)(16 * i) * K + so_); \
        _Pragma("unroll") for (int i = 0; i < 4; ++i) b[i] = *(const bf16x8*)(Bp + (size_t)(16 * i) * K + so_); } while (0)
#define CS_MMA(a, b, i_) do { __builtin_amdgcn_sched_barrier(0); if (wave + 8 * (i_) < nks) { _Pragma("unroll") for (int i = 0; i < 2; ++i) _Pragma("unroll") for (int j = 0; j < 4; ++j) acc[i][j] = MFMA16(a[i], b[j], acc[i][j]); } __builtin_amdgcn_sched_barrier(0); } while (0)
        CS_LOAD(a0, b0, 0); CS_LOAD(a1, b1, 1); CS_LOAD(a2, b2, 2);
        for (int it = 0; it < trips; it += 4) {
            CS_LOAD(a3, b3, it + 3); CS_MMA(a0, b0, it);
            CS_LOAD(a0, b0, it + 4); CS_MMA(a1, b1, it + 1);
            CS_LOAD(a1, b1, it + 5); CS_MMA(a2, b2, it + 2);
            CS_LOAD(a2, b2, it + 6); CS_MMA(a3, b3, it + 3);
        }
#undef CS_LOAD
#undef CS_MMA
        LAS float* P = (LAS float*)F.lds + wave * 2048;
#pragma unroll
        for (int i = 0; i < 2; ++i)
#pragma unroll
            for (int j = 0; j < 4; ++j)
#pragma unroll
                for (int r = 0; r < 4; ++r) P[(16 * i + 4 * fq + r) * 64 + 16 * j + fr] = acc[i][j][r];
        __syncthreads();
        const int row = tid >> 4, c0 = (tid & 15) * 4;
        f32x4 s0 = {0.f, 0.f, 0.f, 0.f};
#pragma unroll
        for (int w = 0; w < 8; ++w) s0 += *(const LAS f32x4*)((LAS float*)F.lds + w * 2048 + row * 64 + c0);
        float* xp = X + (size_t)(32 * mt + row) * DM + 64 * nt + c0;
        const f32x4 g0 = *(const f32x4*)(gv + 64 * nt + c0) * gs;
        f32x4 x0 = *(const f32x4*)xp;
        if (has_ln) { const f32x2 st = *(const f32x2*)(stat + (size_t)(32 * mt + row) * 2); x0 = (x0 - st.x) * st.y * *(const f32x4*)(lng + 64 * nt + c0) + *(const f32x4*)(lnb + 64 * nt + c0); }
        *(f32x4*)xp = x0 * DN_ALPHA + g0 * s0;
        __syncthreads();
    }
}


__device__ __forceinline__ void init_x_by_owners(Frame& F) {
    PHASE_IDS();
    float* X = (float*)(F.ws + WS_X);
    pg8::StaticOrder S; S.init(NLAT, DM, F.G, (int)blockIdx.x); pg8::Unit u;
    for (int i = 0; S.next(i, u); ++i) {
        const int c4 = (tid & 63) * 4, r0 = tid >> 6;
#pragma unroll 4
        for (int rr = r0; rr < 256; rr += 8) { const size_t lr = (size_t)u.pm * 256 + rr; *(f32x4*)(X + (lr + NCTX) * DM + u.pn * 256 + c4) = *(const f32x4*)(F.a->in[0] + lr * DM + u.pn * 256 + c4); }
    }
    for (int item = blockIdx.x; item < 256; item += F.G) { const int mt = item >> 5, nt = item & 31, row = tid >> 4, c0 = (tid & 15) * 4;
        const size_t o = (size_t)(32 * mt + row) * DM + 64 * nt + c0; *(f32x4*)(X + o) = *(const f32x4*)(F.a->in[2] + o); }
}

constexpr int L1_QRAW = 0, L1_KRAW = 16384, L1_GD = 32768, L1_PART = 36864, L1_QT = 40960, L1_KT = 58368, L1_KTT = 75776, L1_VT = 94208, L1_P = 131072;
constexpr float INV_SQRT_DK = 0.08838834764831845f;

template <int DIR>
__device__ __forceinline__ void s1_dir(Frame& F, int e, int hh, int c, bool lat, f32x4 (&pacc)[2], const float (&wv)[16], const float bgv, const f32x2 (&csv)[16]) {
    const bool is_gla = hh < 4; const int hd = hh & 3, t0 = c * 64;
    PHASE_IDS(); const int w = wave, fr = lane & 15, fq = lane >> 4;
    LAS unsigned char* lds = F.lds;
    const int ch = tid & 127, tq = tid >> 7;
    float lgv[16];
    if (is_gla) {
#pragma unroll
        for (int i = 0; i < 16; ++i) { const int tt = 16 * tq + (DIR ? 15 - i : i);
            const u32x4 g0 = *(const LAS u32x4*)(lds + L1_GD + tt * 64 + DIR * 32), g1 = *(const LAS u32x4*)(lds + L1_GD + tt * 64 + DIR * 32 + 16);
            float x = bgv;
            x += bflo(g0.x) * wv[0] + bfhi(g0.x) * wv[1] + bflo(g0.y) * wv[2] + bfhi(g0.y) * wv[3] + bflo(g0.z) * wv[4] + bfhi(g0.z) * wv[5] + bflo(g0.w) * wv[6] + bfhi(g0.w) * wv[7];
            x += bflo(g1.x) * wv[8] + bfhi(g1.x) * wv[9] + bflo(g1.y) * wv[10] + bfhi(g1.y) * wv[11] + bflo(g1.z) * wv[12] + bfhi(g1.z) * wv[13] + bflo(g1.w) * wv[14] + bfhi(g1.w) * wv[15];
            lgv[i] = (fminf(x, 0.f) - __logf(1.0f + __expf(-fabsf(x)))) * (1.0f / 16.0f); }
    } else {
        const float lg = log1pf(-exp2f((DIR ? -5.5f : -5.0f) - (float)hd));
#pragma unroll
        for (int i = 0; i < 16; ++i) lgv[i] = lg;
    }
    float ls = 0.f;
#pragma unroll
    for (int i = 0; i < 16; ++i) ls += lgv[i];
    LAS float* part = (LAS float*)(lds + L1_PART);
    part[tq * 128 + ch] = ls;
    __syncthreads();
    float b = 0.f;
#pragma unroll
    for (int q = 0; q < 4; ++q) { const float pv = part[q * 128 + ch]; if (DIR ? (q > tq) : (q < tq)) b += pv; }
    bf16* QTg = (bf16*)(F.ws + WS_QT) + (size_t)DIR * T * 1024;
    float kt[16];
#pragma unroll
    for (int i = 0; i < 16; ++i) { const int tt = 16 * tq + (DIR ? 15 - i : i);
        b += lgv[i];
        float qv = bf2f(*(const LAS bf16*)(lds + L1_QRAW + tt * 256 + ch * 2)), kv = bf2f(*(const LAS bf16*)(lds + L1_KRAW + tt * 256 + ch * 2));
        if (!is_gla && lat) {
            const float qp = bf2f(*(const LAS bf16*)(lds + L1_QRAW + tt * 256 + (ch ^ 64) * 2)), kp = bf2f(*(const LAS bf16*)(lds + L1_KRAW + tt * 256 + (ch ^ 64) * 2));
            const f32x2 cs = csv[DIR ? 15 - i : i];
            if (ch < 64) { qv = qv * cs.x - qp * cs.y; kv = kv * cs.x - kp * cs.y; } else { qv = qv * cs.x + qp * cs.y; kv = kv * cs.x + kp * cs.y; }
        }
        const float eb = __expf(b), ebi = __expf(-b);
        const float qs = qv * eb * (is_gla ? INV_SQRT_DK : 1.0f), ks = kv * ebi * (is_gla ? 1.0f : INV_SQRT_DK);
        const bf16 qb = f2bf(qs);
        *(LAS bf16*)(lds + L1_QT + tt * 272 + ch * 2) = qb;
        *(LAS bf16*)(lds + L1_KT + tt * 272 + ch * 2) = f2bf(ks);
        kt[DIR ? 15 - i : i] = ks;
        if (i == 15 && tq == (DIR ? 0 : 3)) ((float*)(F.ws + WS_DEC))[((size_t)(DIR * 8 + hh) * NCH + c) * 128 + ch] = eb;
    }
    { u32x4 w0, w1; w0.x = cvt_pk_bf16(kt[0], kt[1]); w0.y = cvt_pk_bf16(kt[2], kt[3]); w0.z = cvt_pk_bf16(kt[4], kt[5]); w0.w = cvt_pk_bf16(kt[6], kt[7]);
      w1.x = cvt_pk_bf16(kt[8], kt[9]); w1.y = cvt_pk_bf16(kt[10], kt[11]); w1.z = cvt_pk_bf16(kt[12], kt[13]); w1.w = cvt_pk_bf16(kt[14], kt[15]);
      *(LAS u32x4*)(lds + L1_KTT + ch * 144 + tq * 32) = w0; *(LAS u32x4*)(lds + L1_KTT + ch * 144 + tq * 32 + 16) = w1; }
    __syncthreads();
#pragma unroll
    for (int i = 0; i < 2; ++i) { const int id = tid + 512 * i, r = id >> 4, cc = id & 15;
        *(u32x4*)(QTg + (size_t)(t0 + r) * 1024 + hh * 128 + cc * 8) = *(const LAS u32x4*)(lds + L1_QT + r * 272 + cc * 16); }
    { const int mi = w >> 1, nj0 = 2 * (w & 1);
      f32x4 pd[2] = {{0.f, 0.f, 0.f, 0.f}, {0.f, 0.f, 0.f, 0.f}};
#pragma unroll
      for (int ks = 0; ks < 4; ++ks) { const bf16x8 a = *(const LAS bf16x8*)(lds + L1_QT + (16 * mi + fr) * 272 + (32 * ks + 8 * fq) * 2);
#pragma unroll
          for (int j = 0; j < 2; ++j) { const bf16x8 bb = *(const LAS bf16x8*)(lds + L1_KT + (16 * (nj0 + j) + fr) * 272 + (32 * ks + 8 * fq) * 2); pd[j] = MFMA16(a, bb, pd[j]); } }
#pragma unroll
      for (int j = 0; j < 2; ++j)
#pragma unroll
          for (int r = 0; r < 4; ++r) { const int ii = 16 * mi + 4 * fq + r, jj = 16 * (nj0 + j) + fr; if (DIR ? (jj >= ii) : (jj <= ii)) pacc[j][r] += pd[j][r]; } }
    { bf16* Ug = (bf16*)(F.ws + WS_U) + ((size_t)(DIR * 8 + hh) * NCH + c) * 256 * 128;
      bf16x8 bv[2][2];
#pragma unroll
      for (int nj = 0; nj < 2; ++nj)
#pragma unroll
          for (int ks = 0; ks < 2; ++ks) bv[nj][ks] = *(const LAS bf16x8*)(lds + L1_VT + (32 * w + 16 * nj + fr) * 144 + (32 * ks + 8 * fq) * 2);
#pragma unroll
      for (int P = 0; P < 4; ++P) {
          f32x4 u[2][2] = {{{0.f, 0.f, 0.f, 0.f}, {0.f, 0.f, 0.f, 0.f}}, {{0.f, 0.f, 0.f, 0.f}, {0.f, 0.f, 0.f, 0.f}}};
#pragma unroll
          for (int t = 0; t < 2; ++t)
#pragma unroll
              for (int ks = 0; ks < 2; ++ks) { const bf16x8 a = *(const LAS bf16x8*)(lds + L1_KTT + (32 * P + 8 * (fr >> 2) + 4 * t + (fr & 3)) * 144 + (32 * ks + 8 * fq) * 2);
#pragma unroll
                  for (int nj = 0; nj < 2; ++nj) u[t][nj] = MFMA16(a, bv[nj][ks], u[t][nj]); }
          asm volatile("s_nop 15" : "+v"(u[0][0]), "+v"(u[0][1]), "+v"(u[1][0]), "+v"(u[1][1]));
#pragma unroll
          for (int nj = 0; nj < 2; ++nj) { u32x4 o; o.x = cvt_pk_bf16(u[0][nj][0], u[0][nj][1]); o.y = cvt_pk_bf16(u[0][nj][2], u[0][nj][3]); o.z = cvt_pk_bf16(u[1][nj][0], u[1][nj][1]); o.w = cvt_pk_bf16(u[1][nj][2], u[1][nj][3]);
              *(u32x4*)(Ug + (size_t)(32 * w + 16 * nj + fr) * 128 + 32 * P + 8 * fq) = o; } } }
    __syncthreads();
}

__device__ __forceinline__ void s1_phase(Frame& F, int e) {
    PHASE_IDS(); LAS unsigned char* lds = F.lds; const int w = wave, fr = lane & 15, fq = lane >> 4;
    const bf16* P = (const bf16*)(F.ws + WS_PROJ);
    for (int item = blockIdx.x; item < 8 * NCH; item += F.G) {
        const int c = item >> 3, hh = item & 7, hd = hh & 3, t0 = c * 64; const bool is_gla = hh < 4, lat = c >= 4;
        const int qcol = is_gla ? 128 * hd : 3072 + 128 * hd, kcol = qcol + 512, vcol = is_gla ? 1024 + 256 * hd : 4096 + 256 * hd;
#pragma unroll
        for (int i = 0; i < 2; ++i) { const int id = tid + 512 * i, r = id >> 4, cc = id & 15;
            *(LAS u32x4*)(lds + L1_QRAW + r * 256 + cc * 16) = *(const u32x4*)(P + (size_t)(t0 + r) * EV_N + qcol + cc * 8);
            *(LAS u32x4*)(lds + L1_KRAW + r * 256 + cc * 16) = *(const u32x4*)(P + (size_t)(t0 + r) * EV_N + kcol + cc * 8); }
#pragma unroll
        for (int i = 0; i < 4; ++i) { const int id = tid + 512 * i, r = id & 63, cc = id >> 6;
            const u32x4 v = *(const u32x4*)(P + (size_t)(t0 + r) * EV_N + vcol + cc * 8);
            LAS bf16* vt = (LAS bf16*)(lds + L1_VT) + (cc * 8) * 72 + r;
            vt[0 * 72] = (bf16)(v.x & 0xffff); vt[1 * 72] = (bf16)(v.x >> 16); vt[2 * 72] = (bf16)(v.y & 0xffff); vt[3 * 72] = (bf16)(v.y >> 16);
            vt[4 * 72] = (bf16)(v.z & 0xffff); vt[5 * 72] = (bf16)(v.z >> 16); vt[6 * 72] = (bf16)(v.w & 0xffff); vt[7 * 72] = (bf16)(v.w >> 16); }
        if (is_gla && tid < 256) { const int r = tid >> 2, cc = tid & 3; *(LAS u32x4*)(lds + L1_GD + r * 64 + cc * 16) = *(const u32x4*)(P + (size_t)(t0 + r) * EV_N + 6144 + cc * 8); }
        float wvf[16], wvb[16], bgf = 0.f, bgb = 0.f; f32x2 csv[16];
        { const int ch = tid & 127, tq = tid >> 7;
#pragma unroll
          for (int r = 0; r < 16; ++r) { wvf[r] = 0.f; wvb[r] = 0.f; csv[r] = (f32x2){1.f, 0.f}; }
          if (is_gla) {
              const float* wgf = F.a->in[11] + (size_t)e * 16 * 512 + hd * 128 + ch; const float* wgb = F.a->in[13] + (size_t)e * 16 * 512 + hd * 128 + ch;
#pragma unroll
              for (int r = 0; r < 16; ++r) { wvf[r] = wgf[r * 512]; wvb[r] = wgb[r * 512]; }
              bgf = F.a->in[12][e * 512 + hd * 128 + ch]; bgb = F.a->in[14][e * 512 + hd * 128 + ch];
          } else if (lat) {
              const f32x2* RT = (const f32x2*)(F.ws + WS_RT) + (size_t)(t0 + 16 * tq - NCTX) * 64 + (ch & 63);
#pragma unroll
              for (int r = 0; r < 16; ++r) csv[r] = RT[r * 64];
          } }
        __syncthreads();
        f32x4 pacc[2] = {{0.f, 0.f, 0.f, 0.f}, {0.f, 0.f, 0.f, 0.f}};
        s1_dir<0>(F, e, hh, c, lat, pacc, wvf, bgf, csv);
        s1_dir<1>(F, e, hh, c, lat, pacc, wvb, bgb, csv);
        { const int mi = w >> 1, nj0 = 2 * (w & 1);
#pragma unroll
          for (int j = 0; j < 2; ++j)
#pragma unroll
              for (int r = 0; r < 4; ++r) *(LAS bf16*)(lds + L1_P + (16 * mi + 4 * fq + r) * 144 + (16 * (nj0 + j) + fr) * 2) = f2bf(pacc[j][r]); }
        __syncthreads();
        { float* OI = (float*)(F.ws + WS_OI);
          bf16x8 bv[2][2];
#pragma unroll
          for (int nj = 0; nj < 2; ++nj)
#pragma unroll
              for (int ks = 0; ks < 2; ++ks) bv[nj][ks] = *(const LAS bf16x8*)(lds + L1_VT + (32 * w + 16 * nj + fr) * 144 + (32 * ks + 8 * fq) * 2);
#pragma unroll
          for (int mi = 0; mi < 4; ++mi) {
              f32x4 o[2] = {{0.f, 0.f, 0.f, 0.f}, {0.f, 0.f, 0.f, 0.f}};
#pragma unroll
              for (int ks = 0; ks < 2; ++ks) { const bf16x8 a = *(const LAS bf16x8*)(lds + L1_P + (16 * mi + fr) * 144 + (32 * ks + 8 * fq) * 2);
#pragma unroll
                  for (int nj = 0; nj < 2; ++nj) o[nj] = MFMA16(a, bv[nj][ks], o[nj]); }
#pragma unroll
              for (int nj = 0; nj < 2; ++nj)
#pragma unroll
                  for (int r = 0; r < 4; ++r) ((LAS float*)lds)[(16 * mi + 4 * fq + r) * 260 + 32 * w + 16 * nj + fr] = o[nj][r]; }
          __syncthreads();
#pragma unroll
          for (int i = 0; i < 8; ++i) { const int id = tid + 512 * i, r = id >> 6, cc = id & 63;
              *(f32x4*)(OI + (size_t)(t0 + r) * DM + hh * 256 + cc * 4) = *(const LAS f32x4*)((LAS float*)lds + r * 260 + cc * 4); } }
        __syncthreads();
    }
}

__device__ __forceinline__ void s2_phase(Frame& F) {
    PHASE_IDS();
    const int gt = F.vcu * NTHR + tid, NGT = F.G * NTHR;
    for (int idx = gt; idx < 2 * 8 * 256 * 32; idx += NGT) {
        const int dk4 = idx & 31, ee = (idx >> 5) & 255, dh = idx >> 13, dir = dh >> 3;
        const bf16* U = (const bf16*)(F.ws + WS_U) + (size_t)dh * NCH * 256 * 128 + (size_t)ee * 128 + dk4 * 4;
        bf16* S = (bf16*)(F.ws + WS_S) + (size_t)dh * NCH * 256 * 128 + (size_t)ee * 128 + dk4 * 4;
        const float* D = (const float*)(F.ws + WS_DEC) + (size_t)dh * NCH * 128 + dk4 * 4;
        f32x4 s = {0.f, 0.f, 0.f, 0.f};
#pragma unroll 13
        for (int step = 0; step < NCH; ++step) {
            const int c = dir ? (step < 4 ? 3 - step : NCH + 3 - step) : step;
            const u32x2 uu = *(const u32x2*)(U + (size_t)c * 256 * 128); const f32x4 d = *(const f32x4*)(D + (size_t)c * 128);
            u32x2 so; so.x = cvt_pk_bf16(s.x, s.y); so.y = cvt_pk_bf16(s.z, s.w);
            *(u32x2*)(S + (size_t)c * 256 * 128) = so;
            s.x = d.x * (s.x + bflo(uu.x)); s.y = d.y * (s.y + bfhi(uu.x)); s.z = d.z * (s.z + bflo(uu.y)); s.w = d.w * (s.w + bfhi(uu.y));
        }
    }
}

constexpr int L3_QF = 0, L3_QB = 17408, L3_OL = 34816;
__device__ __forceinline__ void s3_phase(Frame& F, int e) {
    PHASE_IDS(); LAS unsigned char* lds = F.lds; const int w = wave, fr = lane & 15, fq = lane >> 4;
    const bf16* P = (const bf16*)(F.ws + WS_PROJ); const bf16* QTg = (const bf16*)(F.ws + WS_QT); const float* OI = (const float*)(F.ws + WS_OI);
    bf16* MIX = (bf16*)(F.ws + WS_MIX);
    for (int item = blockIdx.x; item < 8 * NCH; item += F.G) {
        const int c = item >> 3, hh = item & 7, hd = hh & 3, t0 = c * 64; const bool is_gla = hh < 4;
        const int gcol = is_gla ? 2048 + 256 * hd : 5120 + 256 * hd;
#pragma unroll
        for (int dir = 0; dir < 2; ++dir)
#pragma unroll
            for (int i = 0; i < 2; ++i) { const int id = tid + 512 * i, r = id >> 4, cc = id & 15;
                *(LAS u32x4*)(lds + (dir ? L3_QB : L3_QF) + r * 272 + cc * 16) = *(const u32x4*)(QTg + (size_t)dir * T * 1024 + (size_t)(t0 + r) * 1024 + hh * 128 + cc * 8); }
        bf16x8 bv[2][4][2];
#pragma unroll
        for (int dir = 0; dir < 2; ++dir) { const bf16* Sg = (const bf16*)(F.ws + WS_S) + ((size_t)(dir * 8 + hh) * NCH + c) * 256 * 128;
#pragma unroll
            for (int ks = 0; ks < 4; ++ks)
#pragma unroll
                for (int nj = 0; nj < 2; ++nj) bv[dir][ks][nj] = *(const bf16x8*)(Sg + (size_t)(32 * w + 16 * nj + fr) * 128 + 32 * ks + 8 * fq); }
        __builtin_amdgcn_sched_barrier(0);
        __syncthreads();
        f32x4 o[4][2];
#pragma unroll
        for (int mi = 0; mi < 4; ++mi)
#pragma unroll
            for (int nj = 0; nj < 2; ++nj) o[mi][nj] = (f32x4){0.f, 0.f, 0.f, 0.f};
#pragma unroll
        for (int dir = 0; dir < 2; ++dir) {
#pragma unroll
            for (int ks = 0; ks < 4; ++ks) {
#pragma unroll
                for (int mi = 0; mi < 4; ++mi) { const bf16x8 a = *(const LAS bf16x8*)(lds + (dir ? L3_QB : L3_QF) + (16 * mi + fr) * 272 + (32 * ks + 8 * fq) * 2);
#pragma unroll
                    for (int nj = 0; nj < 2; ++nj) o[mi][nj] = MFMA16(a, bv[dir][ks][nj], o[mi][nj]); } } }
        LAS float* OL = (LAS float*)(lds + L3_OL);
#pragma unroll
        for (int mi = 0; mi < 4; ++mi)
#pragma unroll
            for (int nj = 0; nj < 2; ++nj)
#pragma unroll
                for (int r = 0; r < 4; ++r) OL[(16 * mi + 4 * fq + r) * 260 + 32 * w + 16 * nj + fr] = o[mi][nj][r];
        __syncthreads();
        { const int tk = tid >> 3, seg = tid & 7;
          f32x4 v[4][2]; float sq = 0.f;
#pragma unroll
          for (int g = 0; g < 4; ++g) { const int ee = 64 * g + 8 * seg; const float* oi = OI + (size_t)(t0 + tk) * DM + hh * 256 + ee;
              v[g][0] = *(const LAS f32x4*)(OL + tk * 260 + ee) + *(const f32x4*)oi; v[g][1] = *(const LAS f32x4*)(OL + tk * 260 + ee + 4) + *(const f32x4*)(oi + 4);
              sq += (v[g][0].x * v[g][0].x + v[g][0].y * v[g][0].y) + (v[g][0].z * v[g][0].z + v[g][0].w * v[g][0].w) + (v[g][1].x * v[g][1].x + v[g][1].y * v[g][1].y) + (v[g][1].z * v[g][1].z + v[g][1].w * v[g][1].w); }
          sq += __shfl_xor(sq, 1); sq += __shfl_xor(sq, 2); sq += __shfl_xor(sq, 4);
          const float rstd = 1.0f / sqrtf(sq * (1.0f / 256.0f) + RMS_EPS);
#pragma unroll
          for (int g = 0; g < 4; ++g) { const int ee = 64 * g + 8 * seg;
              const u32x4 gt = *(const u32x4*)(P + (size_t)(t0 + tk) * EV_N + gcol + ee);
              f32x4 n0 = {1.f, 1.f, 1.f, 1.f}, n1 = {1.f, 1.f, 1.f, 1.f};
              if (is_gla) { n0 = *(const f32x4*)(F.a->in[15] + e * 256 + ee); n1 = *(const f32x4*)(F.a->in[15] + e * 256 + ee + 4); }
              const f32x4 a0 = v[g][0] * rstd * n0, a1 = v[g][1] * rstd * n1;
              u32x4 ow; ow.x = cvt_pk_bf16(a0.x * silu_f(bflo(gt.x)), a0.y * silu_f(bfhi(gt.x))); ow.y = cvt_pk_bf16(a0.z * silu_f(bflo(gt.y)), a0.w * silu_f(bfhi(gt.y)));
              ow.z = cvt_pk_bf16(a1.x * silu_f(bflo(gt.z)), a1.y * silu_f(bfhi(gt.z))); ow.w = cvt_pk_bf16(a1.z * silu_f(bflo(gt.w)), a1.w * silu_f(bfhi(gt.w)));
              *(u32x4*)(MIX + (size_t)(t0 + tk) * DM + hh * 256 + ee) = ow; } }
        __syncthreads();
    }
}

__device__ __forceinline__ void e1_phase(Frame& F, int o) {
    PHASE_IDS();
    const int gw = F.vcu * NWAVES + wave, NGW = F.G * NWAVES;
    const bf16* P = (const bf16*)(F.ws + WS_PROJ); bf16* CQN = (bf16*)(F.ws + WS_CQN); bf16* CKVN = (bf16*)(F.ws + WS_CKVN); bf16* KR = (bf16*)(F.ws + WS_KR);
    const float* wq = F.a->in[18] + o * 512 + lane * 8; const float* wkv = F.a->in[19] + o * 512 + lane * 8;
    const f32x4 wq0 = *(const f32x4*)wq, wq1 = *(const f32x4*)(wq + 4), wk0 = *(const f32x4*)wkv, wk1 = *(const f32x4*)(wkv + 4);
    const f32x2* AXR = (const f32x2*)(F.ws + WS_AXR); const f32x2* AXC = (const f32x2*)(F.ws + WS_AXC);
    for (int t = gw; t < T; t += NGW) {
        const bf16* p = P + (size_t)t * OD_N;
        const u32x4 a = *(const u32x4*)(p + lane * 8), b = *(const u32x4*)(p + 512 + lane * 8);
        float x[8] = {bflo(a.x), bfhi(a.x), bflo(a.y), bfhi(a.y), bflo(a.z), bfhi(a.z), bflo(a.w), bfhi(a.w)};
        float y[8] = {bflo(b.x), bfhi(b.x), bflo(b.y), bfhi(b.y), bflo(b.z), bfhi(b.z), bflo(b.w), bfhi(b.w)};
        float sx = 0.f, sy = 0.f;
#pragma unroll
        for (int j = 0; j < 8; ++j) { sx += x[j] * x[j]; sy += y[j] * y[j]; }
        const float rx = 1.0f / sqrtf(wave_sum(sx) * (1.0f / 512.0f) + RMS_EPS), ry = 1.0f / sqrtf(wave_sum(sy) * (1.0f / 512.0f) + RMS_EPS);
        u32x4 oq, ok;
        oq.x = cvt_pk_bf16(x[0] * rx * wq0.x, x[1] * rx * wq0.y); oq.y = cvt_pk_bf16(x[2] * rx * wq0.z, x[3] * rx * wq0.w); oq.z = cvt_pk_bf16(x[4] * rx * wq1.x, x[5] * rx * wq1.y); oq.w = cvt_pk_bf16(x[6] * rx * wq1.z, x[7] * rx * wq1.w);
        ok.x = cvt_pk_bf16(y[0] * ry * wk0.x, y[1] * ry * wk0.y); ok.y = cvt_pk_bf16(y[2] * ry * wk0.z, y[3] * ry * wk0.w); ok.z = cvt_pk_bf16(y[4] * ry * wk1.x, y[5] * ry * wk1.y); ok.w = cvt_pk_bf16(y[6] * ry * wk1.z, y[7] * ry * wk1.w);
        *(u32x4*)(CQN + (size_t)t * 512 + lane * 8) = oq; *(u32x4*)(CKVN + (size_t)t * 512 + lane * 8) = ok;
        float v = bf2f(p[1024 + lane]); const float pr = __shfl_xor(v, 16);
        if (t >= NCTX) { const int pp = t - NCTX, pos = (lane & 32) ? (pp & 63) : (pp >> 6); const f32x2 cs = ((lane & 32) ? AXC : AXR)[pos * 16 + (lane & 15)];
            v = (lane & 16) ? v * cs.x + pr * cs.y : v * cs.x - pr * cs.y; }
        KR[(size_t)t * 64 + lane] = f2bf(v);
    }
}

namespace att {
constexpr int KVBLK = 64;
constexpr float SCALE = 0.07216878364870322f;
constexpr float THR = 8.f;
constexpr int SHM_K = 64 * 384, SHM_V = 64 * 256;
constexpr int A_V = 0, A_K = 2 * SHM_V, A_WS = 2 * SHM_V + 2 * SHM_K;
#define SBAR() __builtin_amdgcn_sched_barrier(0)
__device__ __forceinline__ int crow(int r, int hi) { return (r & 3) + 8 * (r >> 2) + 4 * hi; }
__device__ __forceinline__ void partialSM(f32x16& p0, f32x16& p1, float& m_reg, float& mn, float& alpha) {
    constexpr float C = SCALE * 1.4426950408889634f;
    float pmax = p0[0];
#pragma unroll
    for (int r = 1; r < 16; ++r) pmax = fmaxf(pmax, p0[r]);
#pragma unroll
    for (int r = 0; r < 16; ++r) pmax = fmaxf(pmax, p1[r]);
    { auto rr = __builtin_amdgcn_permlane32_swap(__float_as_uint(pmax), __float_as_uint(pmax), false, false);
      pmax = fmaxf(__uint_as_float(rr[0]), __uint_as_float(rr[1])); }
    if (__builtin_expect(__all(pmax - m_reg <= THR / SCALE), 1)) { mn = m_reg; alpha = 1.f; }
    else { mn = fmaxf(m_reg, pmax); alpha = __builtin_amdgcn_exp2f((m_reg - mn) * C); m_reg = mn; }
    const float mnC = -mn * C;
#pragma unroll
    for (int r = 0; r < 16; ++r) p0[r] = fmaf(p0[r], C, mnC);
#pragma unroll
    for (int r = 0; r < 16; ++r) p1[r] = fmaf(p1[r], C, mnC);
#pragma unroll
    for (int r = 0; r < 16; ++r) p0[r] = __builtin_amdgcn_exp2f(p0[r]);
}
__device__ __forceinline__ void finishSM(f32x16& p0, f32x16& p1, float alpha, float& l_reg, bf16x8& pa0, bf16x8& pa1, bf16x8& pa2, bf16x8& pa3) {
#pragma unroll
    for (int r = 0; r < 16; ++r) p1[r] = __builtin_amdgcn_exp2f(p1[r]);
    float ps = 0;
#pragma unroll
    for (int r = 0; r < 16; ++r) ps += p0[r];
#pragma unroll
    for (int r = 0; r < 16; ++r) ps += p1[r];
    { auto rr = __builtin_amdgcn_permlane32_swap(__float_as_uint(ps), __float_as_uint(ps), false, false);
      ps = __uint_as_float(rr[0]) + __uint_as_float(rr[1]); }
    l_reg = l_reg * alpha + ps;
#define PK4(P, BASE, OUT) do { unsigned a0 = cvt_pk_bf16(P[BASE + 0], P[BASE + 1]), a1 = cvt_pk_bf16(P[BASE + 2], P[BASE + 3]);   \
    unsigned b0 = cvt_pk_bf16(P[BASE + 4], P[BASE + 5]), b1 = cvt_pk_bf16(P[BASE + 6], P[BASE + 7]);                              \
    auto r0 = __builtin_amdgcn_permlane32_swap(a0, b0, false, false); auto r1 = __builtin_amdgcn_permlane32_swap(a1, b1, false, false); \
    u32x4 w = {r0[0], r1[0], r0[1], r1[1]}; OUT = *reinterpret_cast<bf16x8*>(&w); } while (0)
    PK4(p0, 0, pa0); PK4(p0, 8, pa1); PK4(p1, 0, pa2); PK4(p1, 8, pa3);
#undef PK4
}
__device__ __forceinline__ int kswz(int row, int g) { return row * 384 + (((g & ~7) | ((g & 7) ^ ((row >> 1) & 7))) << 4); }
__device__ __forceinline__ void qkt(f32x16& p0, f32x16& p1, const LAS unsigned char* Ks, const bf16x8 (&qr)[12], const int (&kx)[4]) {
    p0 = f32x16{}; p1 = f32x16{};
    bf16x8 c0 = *(const LAS bf16x8*)(Ks + kx[0]), c1 = *(const LAS bf16x8*)(Ks + kx[0] + 32 * 384), n0, n1;
#pragma unroll
    for (int d0 = 0; d0 < 12; ++d0) {
        if (d0 < 11) { n0 = *(const LAS bf16x8*)(Ks + kx[(d0 + 1) & 3] + ((d0 + 1) >> 2) * 128); n1 = *(const LAS bf16x8*)(Ks + kx[(d0 + 1) & 3] + ((d0 + 1) >> 2) * 128 + 32 * 384); }
        __builtin_amdgcn_sched_barrier(0);
        p0 = MFMA32(c0, qr[d0], p0);
        p1 = MFMA32(c1, qr[d0], p1);
        __builtin_amdgcn_sched_barrier(0);
        c0 = n0; c1 = n1; }
}
__device__ __forceinline__ int v_st(int k, int c) { const int kk = (k & ~0xC) | ((k & 4) << 1) | ((k & 8) >> 1); return ((kk >> 3) * 4 + (c >> 5)) * 512 + ((kk & 7) * 32 + (c & 31)) * 2; }
__device__ __forceinline__ int v_rd_base(int lane) { return ((lane & 3) << 3) | (((lane >> 2) & 3) << 6) | (((lane >> 4) & 1) << 5) | (((lane >> 5) & 1) << 8); }
constexpr int v_rd_off(int d0, int ks, int half) { return d0 * 512 + ks * 4096 + half * 2048; }
template <int OFF> __device__ __forceinline__ s16x4 tr_read(int vb) {
    s16x4 r; asm volatile("ds_read_b64_tr_b16 %0, %1 offset:%2" : "=&v"(r) : "v"(vb), "i"(OFF) : "memory"); return r;
}
template <int D0> __device__ __forceinline__ void pv_one(f32x16& od, int vb, bf16x8 pa0, bf16x8 pa1, bf16x8 pa2, bf16x8 pa3) {
    const s16x4 l0 = tr_read<v_rd_off(D0, 0, 0)>(vb), h0 = tr_read<v_rd_off(D0, 0, 1)>(vb), l1 = tr_read<v_rd_off(D0, 1, 0)>(vb), h1 = tr_read<v_rd_off(D0, 1, 1)>(vb);
    const s16x4 l2 = tr_read<v_rd_off(D0, 2, 0)>(vb), h2 = tr_read<v_rd_off(D0, 2, 1)>(vb), l3 = tr_read<v_rd_off(D0, 3, 0)>(vb), h3 = tr_read<v_rd_off(D0, 3, 1)>(vb);
    asm volatile("s_waitcnt lgkmcnt(0)" ::: "memory"); SBAR();
#define PK(L, H) (bf16x8){L[0], L[1], L[2], L[3], H[0], H[1], H[2], H[3]}
    od = MFMA32(pa0, PK(l0, h0), od);
    od = MFMA32(pa1, PK(l1, h1), od);
    od = MFMA32(pa2, PK(l2, h2), od);
    od = MFMA32(pa3, PK(l3, h3), od);
#undef PK
}
__device__ __forceinline__ void pv_d0(f32x16 (&o)[4], int vb, bf16x8 pa0, bf16x8 pa1, bf16x8 pa2, bf16x8 pa3) {
    pv_one<0>(o[0], vb, pa0, pa1, pa2, pa3); pv_one<1>(o[1], vb, pa0, pa1, pa2, pa3); pv_one<2>(o[2], vb, pa0, pa1, pa2, pa3); pv_one<3>(o[3], vb, pa0, pa1, pa2, pa3);
}
__device__ __forceinline__ void rope_pair(bf16x8& a, bf16x8& b, const f32x2* cs) {
    u32x4 ua = *reinterpret_cast<u32x4*>(&a), ub = *reinterpret_cast<u32x4*>(&b); u32x4 oa, ob;
#pragma unroll
    for (int j = 0; j < 4; ++j) { const f32x2 c0 = cs[2 * j], c1 = cs[2 * j + 1];
        const float x1l = bflo(ua[j]), x1h = bfhi(ua[j]), x2l = bflo(ub[j]), x2h = bfhi(ub[j]);
        oa[j] = cvt_pk_bf16(x1l * c0.x - x2l * c0.y, x1h * c1.x - x2h * c1.y);
        ob[j] = cvt_pk_bf16(x2l * c0.x + x1l * c0.y, x2h * c1.x + x1h * c1.y); }
    a = *reinterpret_cast<bf16x8*>(&oa); b = *reinterpret_cast<bf16x8*>(&ob);
}
__device__ __forceinline__ void unit(Frame& F, int h, int qrow0, int nkeys) {
    LAS unsigned char* lds = F.lds;
    PHASE_IDS(); const int wid = wave, r32 = lane & 31, hi = lane >> 5;
    const bf16* QB = (const bf16*)(F.ws + WS_QB); const bf16* KVB = (const bf16*)(F.ws + WS_KVB); const bf16* KR = (const bf16*)(F.ws + WS_KR);
    LAS unsigned char* V_lds = lds + A_V; LAS unsigned char* K_lds = lds + A_K;
    LAS float* wsl = (LAS float*)(lds + A_WS) + wid * 64; LAS float* li_l = wsl; LAS float* al_l = wsl + 32;
    float m_reg = -1e30f, l_reg = 0; f32x16 o[4] = {}; bf16x8 qr[12];
    const int qt = qrow0 + wid * 32 + r32;
    const bf16* Qw = QB + (size_t)qt * 3072 + 192 * h + hi * 8;
#pragma unroll
    for (int d0 = 0; d0 < 12; ++d0) qr[d0] = *(const bf16x8*)(Qw + d0 * 16);
    if (qt >= NCTX) { const int pp = qt - NCTX;
        rope_pair(qr[8], qr[9], (const f32x2*)(F.ws + WS_AXR) + (pp >> 6) * 16 + hi * 8);
        rope_pair(qr[10], qr[11], (const f32x2*)(F.ws + WS_AXC) + (pp & 63) * 16 + hi * 8); }
    const unsigned char* wsb = F.ws;
    unsigned koff[3], kfl = 0u; int kdst[3];
#pragma unroll
    for (int i = 0; i < 3; ++i) { const int id = tid + 512 * i, row = id / 24, g = id % 24;
        if (g < 16) { koff[i] = (unsigned)WS_KVB + (unsigned)(row * 4096 + 256 * h + g * 8) * 2u; kfl |= 1u << i; } else { koff[i] = (unsigned)WS_KR + (unsigned)(row * 64 + (g - 16) * 8) * 2u; }
        kdst[i] = kswz(row, g); }
    const int sr = tid >> 4, sc = (tid & 15) * 8, vst0 = v_st(sr, sc);
    const unsigned voff = (unsigned)WS_KVB + (unsigned)(sr * 4096 + 256 * h + 128 + sc) * 2u;
    const int vb0 = (int)(unsigned)(uintptr_t)V_lds + v_rd_base(lane);
    int kx[4];
#pragma unroll
    for (int q = 0; q < 4; ++q) kx[q] = r32 * 384 + ((((2 * q) | hi) ^ ((r32 >> 1) & 7)) << 4);
    bf16x8 sk0, sk1, sk2, sv0, sv1;
#define SLOAD(jt) do { const unsigned vo_ = voff + (unsigned)(jt) * (64u * 4096u * 2u); sv0 = *(const bf16x8*)(wsb + vo_); sv1 = *(const bf16x8*)(wsb + vo_ + 32u * 4096u * 2u); \
    const unsigned kt_ = (unsigned)(jt) * 8192u; \
    sk0 = *(const bf16x8*)(wsb + koff[0] + (kt_ << ((kfl & 1u) * 6u))); sk1 = *(const bf16x8*)(wsb + koff[1] + (kt_ << (((kfl >> 1) & 1u) * 6u))); sk2 = *(const bf16x8*)(wsb + koff[2] + (kt_ << (((kfl >> 2) & 1u) * 6u))); } while (0)
#define SWRITE(b) do { *(LAS bf16x8*)(V_lds + (b) * SHM_V + vst0) = sv0; *(LAS bf16x8*)(V_lds + (b) * SHM_V + vst0 + 8192) = sv1; \
    *(LAS bf16x8*)(K_lds + (b) * SHM_K + kdst[0]) = sk0; *(LAS bf16x8*)(K_lds + (b) * SHM_K + kdst[1]) = sk1; *(LAS bf16x8*)(K_lds + (b) * SHM_K + kdst[2]) = sk2; } while (0)
#define SWAIT() asm volatile("s_waitcnt vmcnt(0)" ::: "memory")
#define RESC(a) do { if (__any((a) < 1.f)) { if (hi == 0) al_l[r32] = (a); asm volatile("s_waitcnt lgkmcnt(0)" ::: "memory"); \
    _Pragma("unroll") for (int d = 0; d < 4; ++d) _Pragma("unroll") for (int r = 0; r < 16; ++r) o[d][r] *= al_l[crow(r, hi)]; } } while (0)
    f32x16 p0, p1; float mn, al; bf16x8 pa0, pa1, pa2, pa3; const int NT = nkeys / KVBLK;
#define ABAR() do { asm volatile("s_waitcnt lgkmcnt(0)" ::: "memory"); __builtin_amdgcn_s_barrier(); asm volatile("" ::: "memory"); } while (0)
#define ASTAGE(j) do { if ((j) + 1 < NT) { SWAIT(); SWRITE(((j) & 1) ^ 1); } if ((j) + 2 < NT) SLOAD((j) + 2); } while (0)
#define AQK(j) do { SBAR(); qkt(p0, p1, K_lds + ((j) & 1) * SHM_K, qr, kx); SBAR(); partialSM(p0, p1, m_reg, mn, al); } while (0)
#define ASP(j) do { RESC(al); finishSM(p0, p1, al, l_reg, pa0, pa1, pa2, pa3); SBAR(); pv_d0(o, vb0 + ((j) & 1) * SHM_V, pa0, pa1, pa2, pa3); } while (0)
    SLOAD(0); SWAIT(); SWRITE(0); SLOAD(1); ABAR();
    if ((wid >> 2) == 0) {
        for (int j = 0; j < NT; ++j) { AQK(j); ABAR(); ASTAGE(j); ASP(j); ABAR(); }
        ABAR();
    } else {
        ABAR();
        for (int j = 0; j < NT; ++j) { ASTAGE(j); AQK(j); ABAR(); ASP(j); ABAR(); }
    }
#undef ABAR
#undef ASTAGE
#undef AQK
#undef ASP
    if (hi == 0) li_l[r32] = l_reg; asm volatile("s_waitcnt lgkmcnt(0)" ::: "memory");
    float rli[16];
#pragma unroll
    for (int r = 0; r < 16; ++r) rli[r] = __builtin_amdgcn_rcpf(li_l[crow(r, hi)]);
    unsigned orow0 = (unsigned)(qrow0 + wid * 32) * DM + 128 * h; asm volatile("" : "+v"(orow0));
    bf16* Ow = (bf16*)(F.ws + WS_MIX) + orow0;
#pragma unroll
    for (int r = 0; r < 16; ++r) { const int orow = crow(r, hi);
#pragma unroll
        for (int d0 = 0; d0 < 4; ++d0) Ow[(size_t)orow * DM + d0 * 32 + r32] = f2bf(o[d0][r] * rli[r]); }
    __syncthreads();
#undef SLOAD
#undef SWRITE
#undef SWAIT
#undef RESC
}
}

__device__ __forceinline__ void attn_phase(Frame& F) {
    for (int u = F.vcu; u < 1024 + 16; u += F.G) {
        if (u < 1024) att::unit(F, u >> 6, NCTX + 256 * (u & 63), T);
        else att::unit(F, u - 1024, 0, NCTX);
    }
}

#ifdef DBG
constexpr int DBG_W_BAD = 64, DBG_W_SSQ = 65, DBG_W_CNT = 66, DBG_W_MAX = 67;
__device__ __forceinline__ void dbg_scan(Frame& F, int id, size_t off, size_t nbytes, bool is_bf) {
    PHASE_IDS();
    const u32x4* p = (const u32x4*)(F.ws + off); const size_t n = nbytes / 16; bool bad = false;
    for (size_t i = (size_t)F.vcu * NTHR + tid; i < n; i += (size_t)F.G * NTHR) { const u32x4 v = p[i];
#pragma unroll
        for (int j = 0; j < 4; ++j) { if (is_bf) { bad |= ((v[j] & 0x7f80u) == 0x7f80u) | ((v[j] & 0x7f800000u) == 0x7f800000u); } else bad |= ((v[j] & 0x7f800000u) == 0x7f800000u); } }
    if (__any(bad) && lane == 0) atomicMax((unsigned*)(F.ws + WS_CTL) + DBG_W_BAD, (unsigned)(100000 - id));
}
__device__ __forceinline__ void dbg_max(Frame& F, size_t off, size_t nbytes, bool is_bf) {
    PHASE_IDS();
    const u32x4* p = (const u32x4*)(F.ws + off); const size_t n = nbytes / 16; unsigned mx = 0u;
    for (size_t i = (size_t)F.vcu * NTHR + tid; i < n; i += (size_t)F.G * NTHR) { const u32x4 v = p[i];
#pragma unroll
        for (int j = 0; j < 4; ++j) { if (is_bf) { const unsigned a0 = (v[j] << 16) & 0x7fffffffu, a1 = v[j] & 0x7fff0000u; if (a0 < 0x7f800000u) mx = max(mx, a0); if (a1 < 0x7f800000u) mx = max(mx, a1); } else { const unsigned a0 = v[j] & 0x7fffffffu; if (a0 < 0x7f800000u) mx = max(mx, a0); } } }
#pragma unroll
    for (int o = 1; o < 64; o <<= 1) mx = max(mx, (unsigned)__shfl_xor((int)mx, o));
    if (lane == 0) atomicMax((unsigned*)(F.ws + WS_CTL) + DBG_W_MAX, mx);
}
#define DBGSCAN(id, off, nbytes, isbf) dbg_scan(F, (id), (off), (nbytes), (isbf))
#else
#define DBGSCAN(id, off, nbytes, isbf) do {} while (0)
#endif

#ifndef RES_ALIGN
#define RES_ALIGN true
#endif
#ifndef RES_SP2
#define RES_SP2 true
#endif
__global__ void __launch_bounds__(NTHR, 2) fwd_kernel(Args args) {
    extern __shared__ __attribute__((aligned(16))) unsigned char lds_raw[];
    Frame F;
    F.lds = (LAS unsigned char*)lds_raw;
    F.G = gridDim.x; { const int bx = blockIdx.x; F.vcu = (F.G % 8 == 0) ? (bx % 8) * (F.G / 8) + bx / 8 : bx; }
    F.a = &args; F.ws = args.ws;
    volatile LAS unsigned* ctlw = (volatile LAS unsigned*)(F.lds + LDS_CTL);
    if (threadIdx.x < 16) ctlw[threadIdx.x] = 0u;
    __syncthreads();
    XcdBarrier bar = xcd_barrier_post((unsigned*)(F.ws + WS_CTL) + 4096, ctlw);
#define GRID_BAR() xcd_barrier(bar)
#ifdef DBG_TIME
    unsigned long long t_prev = __builtin_amdgcn_s_memrealtime();
#define TSTAMP(cat) do { if (blockIdx.x == 0 && threadIdx.x == 0) { const unsigned long long t_now = __builtin_amdgcn_s_memrealtime(); unsigned long long* tw = (unsigned long long*)(F.ws + WS_CTL) + 64 + (cat); *tw = *tw + (t_now - t_prev); t_prev = t_now; } } while (0)
#else
#define TSTAMP(cat) do {} while (0)
#endif

#ifndef SK_P0
    p0a(F);
#ifdef DUP_P0
    p0a(F);
#endif
#endif
    GRID_BAR();
    p0b(F); GRID_BAR();
    DBGSCAN(1, WS_MOD, (size_t)4 * 2 * NADA * 4, false);
    init_x_by_owners(F);
    row_phase<0>(F, nullptr, nullptr, modp(F, 0, 0, 0), modp(F, 0, 0, 1), modp(F, 0, 1, 0), modp(F, 0, 1, 1)); GRID_BAR(); TSTAMP(0);
    DBGSCAN(2, WS_X, (size_t)T * DM * 4, false); DBGSCAN(3, WS_H, (size_t)T * DM * 2, true);

    const pg8::bf16_t* Hb = (const pg8::bf16_t*)(F.ws + WS_H);
    for (int s = 0; s < 3 * DEPTH; ++s) {
        const int l = s / 3, r = s % 3;
        const pg8::bf16_t* A2; const pg8::bf16_t* B2; int K2;
        if (r != 1) {
            const int f = r >> 1;
            pg8::Gemm g{Hb, (const pg8::bf16_t*)(F.ws + WS_WFI + (size_t)(l * 2 + f) * SZ_WFI), T, 2 * DFF, DM, DM, DM};
            pg8::StaticOrder S; S.init(T, 2 * DFF, F.G, (int)blockIdx.x);
            pg8::EpiSwiGLU E{(pg8::bf16_t*)(F.ws + WS_HID), DFF};
#ifndef SK_SW
            pg8::gemm_phase<pg8::EpiSwiGLU, pg8::StaticOrder>(F.lds, g, S, E);
#endif
#ifdef DUP_SW
            pg8::gemm_phase<pg8::EpiSwiGLU, pg8::StaticOrder>(F.lds, g, S, E);
#endif
            GRID_BAR(); TSTAMP(1);
            DBGSCAN(10 + 10 * s, WS_HID, (size_t)T * DFF * 2, true);
            A2 = (const pg8::bf16_t*)(F.ws + WS_HID); B2 = (const pg8::bf16_t*)(F.ws + WS_WFO + (size_t)(l * 2 + f) * SZ_WFO); K2 = DFF;
        } else if ((l & 1) == 0) {
            const int e = l >> 1;
            { pg8::Gemm g{Hb, (const pg8::bf16_t*)(F.ws + WS_EWI + (size_t)e * SZ_EWI), T, EV_N, DM, DM, DM};
              pg8::StaticOrder S; S.init(T, EV_N, F.G, (int)blockIdx.x);
              pg8::EpiBf16 E{(pg8::bf16_t*)(F.ws + WS_PROJ), EV_N};
#ifndef SK_G1
              pg8::gemm_phase<pg8::EpiBf16, pg8::StaticOrder>(F.lds, g, S, E);
#endif
            }
            GRID_BAR(); TSTAMP(4);
            DBGSCAN(10 + 10 * s, WS_PROJ, (size_t)T * EV_N * 2 - 0, true);
#ifdef DBG
            if (s == 1) dbg_max(F, WS_PROJ, (size_t)T * EV_N * 2, true);
#endif
#ifndef SK_S1
            s1_phase(F, e);
#ifdef DUP_S1
            s1_phase(F, e);
#endif
#endif
            GRID_BAR(); TSTAMP(5);
            DBGSCAN(11 + 10 * s, WS_U, SZ_U, true); DBGSCAN(16 + 10 * s, WS_OI, (size_t)T * DM * 4, false); DBGSCAN(17 + 10 * s, WS_QT, (size_t)2 * T * 1024 * 2, true); DBGSCAN(18 + 10 * s, WS_DEC, (size_t)2 * 8 * NCH * 128 * 4, false);
#ifndef SK_S2
            s2_phase(F);
#ifdef DUP_S2
            s2_phase(F);
#endif
#endif
            GRID_BAR(); TSTAMP(6);
            DBGSCAN(12 + 10 * s, WS_S, SZ_U, true);
#ifndef SK_S3
            s3_phase(F, e);
#ifdef DUP_S3
            s3_phase(F, e);
#endif
#endif
            GRID_BAR(); TSTAMP(7);
            DBGSCAN(13 + 10 * s, WS_MIX, (size_t)T * DM * 2, true);
            A2 = (const pg8::bf16_t*)(F.ws + WS_MIX); B2 = (const pg8::bf16_t*)(F.ws + WS_EWO + (size_t)e * SZ_SQ); K2 = DM;
        } else {
            const int o = l >> 1;
            { pg8::Gemm g{Hb, (const pg8::bf16_t*)(F.ws + WS_OWI + (size_t)o * SZ_OWI), T, OD_N, DM, DM, DM};
              pg8::StaticOrder S; S.init(T, OD_N, F.G, (int)blockIdx.x);
              pg8::EpiBf16 E{(pg8::bf16_t*)(F.ws + WS_PROJ), OD_N};
#ifndef SK_G2
              pg8::gemm_phase<pg8::EpiBf16, pg8::StaticOrder>(F.lds, g, S, E);
#endif
            }
            GRID_BAR();
#ifndef SK_E1
            e1_phase(F, o);
#endif
            GRID_BAR();
            DBGSCAN(11 + 10 * s, WS_CQN, (size_t)T * 512 * 2 * 2, true); DBGSCAN(11 + 10 * s, WS_KR, (size_t)T * 64 * 2, true);
            for (int q = 0; q < 2; ++q) {
                pg8::Gemm g{(const pg8::bf16_t*)(F.ws + (q ? WS_CKVN : WS_CQN)), (const pg8::bf16_t*)(F.ws + (q ? WS_OUKV + (size_t)o * SZ_OUKV : WS_OUQ + (size_t)o * SZ_OUQ)), T, q ? 4096 : 3072, 512, 512, 512};
                pg8::StaticOrder S; S.init(T, g.N, F.G, (int)blockIdx.x);
                pg8::EpiBf16 E{(pg8::bf16_t*)(F.ws + (q ? WS_KVB : WS_QB)), g.N};
#ifndef SK_G3
                pg8::gemm_phase<pg8::EpiBf16, pg8::StaticOrder>(F.lds, g, S, E);
#endif
            }
            GRID_BAR(); TSTAMP(8);
            DBGSCAN(12 + 10 * s, WS_QB, (size_t)T * 3072 * 2, true); DBGSCAN(12 + 10 * s, WS_KVB, (size_t)T * 4096 * 2, true);
#ifndef SK_ATT
            attn_phase(F);
#ifdef DUP_ATT
            attn_phase(F);
#endif
#endif
            GRID_BAR(); TSTAMP(9);
            DBGSCAN(13 + 10 * s, WS_MIX, (size_t)T * DM * 2, true);
            A2 = (const pg8::bf16_t*)(F.ws + WS_MIX); B2 = (const pg8::bf16_t*)(F.ws + WS_OWO + (size_t)o * SZ_SQ); K2 = DM;
        }
        {
            pg8::Gemm g{A2 + (size_t)NCTX * K2, B2, NLAT, DM, K2, K2, K2};
            pg8::StaticOrder S; S.init(NLAT, DM, F.G, (int)blockIdx.x);
            const int sp = s > 0 ? s - 1 : 0;
            const float* plng = F.a->in[6] + (size_t)sp * DM; const float* plnb = F.a->in[7] + (size_t)sp * DM; const float* stat = (const float*)(F.ws + WS_STAT);
            pg8::EpiResid E{(float*)(F.ws + WS_X) + (size_t)NCTX * DM, modp(F, l, 0, 3 * r + 2), (r != 1) ? 0.5f : 1.0f, stat + (size_t)NCTX * 2, plng, plnb, s > 0 ? 1 : 0};
#ifndef SK_RES
            pg8::gemm_phase<pg8::EpiResid, pg8::StaticOrder, RES_ALIGN, RES_SP2>(F.lds, g, S, E);
#endif
            ctx_resid_small(F, (float*)(F.ws + WS_X), (const bf16*)A2, (const bf16*)B2, K2, modp(F, l, 1, 3 * r + 2), (r != 1) ? 0.5f : 1.0f, stat, plng, plnb, s > 0 ? 1 : 0);
#ifdef DUP_SMALL_OFF
            ctx_resid_small(F, (float*)(F.ws + WS_OI), (const bf16*)A2, (const bf16*)B2, K2, modp(F, l, 1, 3 * r + 2), (r != 1) ? 0.5f : 1.0f);
            ctx_resid_small(F, (float*)(F.ws + WS_OI), (const bf16*)A2, (const bf16*)B2, K2, modp(F, l, 1, 3 * r + 2), (r != 1) ? 0.5f : 1.0f);
#endif
#ifdef DUP_RES
            { pg8::EpiResid E2{(float*)(F.ws + WS_OI) + (size_t)NCTX * DM, modp(F, l, 0, 3 * r + 2), 0.5f, stat, plng, plnb, 0};
              pg8::gemm_phase<pg8::EpiResid, pg8::StaticOrder>(F.lds, g, S, E2); }
#endif
        }
        GRID_BAR(); TSTAMP(r != 1 ? 2 : 10);
        DBGSCAN(14 + 10 * s, WS_X, (size_t)T * DM * 4, false);
        const float* lng = F.a->in[6] + (size_t)(l * 3 + r) * DM; const float* lnb = F.a->in[7] + (size_t)(l * 3 + r) * DM;
        if (s + 1 < 3 * DEPTH) { const int l2 = (s + 1) / 3, r2 = (s + 1) % 3;
            row_phase<1>(F, lng, lnb, modp(F, l2, 0, 3 * r2), modp(F, l2, 0, 3 * r2 + 1), modp(F, l2, 1, 3 * r2), modp(F, l2, 1, 3 * r2 + 1));
            GRID_BAR(); TSTAMP(3);
            DBGSCAN(15 + 10 * s, WS_X, (size_t)T * DM * 4, false); DBGSCAN(15 + 10 * s, WS_H, (size_t)T * DM * 2, true);
#if defined(DBG) && defined(DBG_STOP)
            if (s == DBG_STOP) break;
#endif
        } else {
#ifndef DBG
            row_phase<2>(F, lng, lnb, nullptr, nullptr, nullptr, nullptr);
#endif
        }
    }
#ifdef DBG_TIME
    {   PHASE_IDS(); GRID_BAR();
        const unsigned long long* tw = (const unsigned long long*)(F.ws + WS_CTL) + 64;
        const float tA = (float)__hip_atomic_load(tw + DBG_TA, RLX_AGENT) * 1e-5f, tB = (float)__hip_atomic_load(tw + DBG_TB, RLX_AGENT) * 1e-5f;
        const float cB = DBG_TSCALE * tB, cA = cB; (void)tA;
        float* out = F.a->out;
        for (size_t i = (size_t)F.vcu * NTHR + tid; i < (size_t)NLAT * DM; i += (size_t)F.G * NTHR) out[i] = (i == 12345) ? cA : cB;
    }
#endif
#ifdef DBG
    {
        PHASE_IDS();
        const float* X = (const float*)(F.ws + WS_X); float ssq = 0.f; float cnt = 0.f;
        for (size_t i = (size_t)F.vcu * NTHR + tid; i < (size_t)T * DM; i += (size_t)F.G * NTHR) { const float v = X[i]; if ((__float_as_uint(v) & 0x7f800000u) != 0x7f800000u) { ssq += v * v; cnt += 1.f; } }
        ssq = wave_sum(ssq); cnt = wave_sum(cnt);
        if (lane == 0) { atomicAdd((float*)(F.ws + WS_CTL) + DBG_W_SSQ, ssq); atomicAdd((float*)(F.ws + WS_CTL) + DBG_W_CNT, cnt); }
        GRID_BAR();
        const unsigned badw = __hip_atomic_load((unsigned*)(F.ws + WS_CTL) + DBG_W_BAD, RLX_AGENT);
        const float tss = __hip_atomic_load((float*)(F.ws + WS_CTL) + DBG_W_SSQ, RLX_AGENT), tcn = __hip_atomic_load((float*)(F.ws + WS_CTL) + DBG_W_CNT, RLX_AGENT);
        const float rms = sqrtf(tss / fmaxf(tcn, 1.f)); float cB = fminf(10.f * rms, 1000.f);
#ifdef DBG_REPORT_MAX
        { const unsigned mw = __hip_atomic_load((unsigned*)(F.ws + WS_CTL) + DBG_W_MAX, RLX_AGENT); cB = fminf(log2f(1.0f + __uint_as_float(mw)), 120.f); }
#endif
        const float cA = badw ? (float)(100000u - badw) * 10.f : 5.f;
        float* out = F.a->out;
        for (size_t i = (size_t)F.vcu * NTHR + tid; i < (size_t)NLAT * DM; i += (size_t)F.G * NTHR) out[i] = (i == 12345) ? cA + 0.f : cB;
        (void)cA;
    }
#endif
}

extern "C" void kernel_launch(void* const* d_in, const int* in_sizes, int n_in, void* d_out, int out_size, void* d_ws, size_t ws_size, hipStream_t stream) {
    static int grid = 0;
    if (grid == 0) {
        if (n_in != 23 || out_size != NLAT * DM || ws_size < WS_END) { fprintf(stderr, "kernel_launch: unexpected shapes: n_in %d out %d ws %zu (need %zu)\n", n_in, out_size, ws_size, (size_t)WS_END); grid = -1; return; }
        int dev = 0, cus = 0, per_cu = 0;
        if (hipGetDevice(&dev) != hipSuccess || hipDeviceGetAttribute(&cus, hipDeviceAttributeMultiprocessorCount, dev) != hipSuccess) { grid = -1; return; }
        if (hipFuncSetAttribute((const void*)fwd_kernel, hipFuncAttributeMaxDynamicSharedMemorySize, LDS_BYTES) != hipSuccess) { fprintf(stderr, "kernel_launch: hipFuncSetAttribute failed\n"); grid = -1; return; }
        if (hipOccupancyMaxActiveBlocksPerMultiprocessor(&per_cu, (const void*)fwd_kernel, NTHR, LDS_BYTES) != hipSuccess || per_cu < 1) fprintf(stderr, "kernel_launch: occupancy query reports %d\n", per_cu);
        (void)hipGetLastError();
        grid = cus;
    }
    if (grid < 0) return;
    (void)hipMemsetAsync((char*)d_ws + WS_CTL, 0, CTL_BYTES, stream);
    Args a{};
    for (int i = 0; i < 23; ++i) a.in[i] = (const float*)d_in[i];
    a.out = (float*)d_out; a.ws = (unsigned char*)d_ws;
    hipLaunchKernelGGL(fwd_kernel, dim3(grid), dim3(NTHR), LDS_BYTES, stream, a);
    const hipError_t le = hipPeekAtLastError();
    if (le != hipSuccess) fprintf(stderr, "kernel_launch: launch failed: %s\n", hipGetErrorName(le));
}
```

```cpp
#include <hip/hip_runtime.h>
#include <cstdio>
#include <cstdint>

#define GAS __attribute__((address_space(1)))
#define LAS __attribute__((address_space(3)))
typedef unsigned short bf16;
typedef short bf16x8 __attribute__((ext_vector_type(8)));
typedef short s16x4 __attribute__((ext_vector_type(4)));
typedef float f32x4 __attribute__((ext_vector_type(4)));
typedef float f32x2 __attribute__((ext_vector_type(2)));
typedef float f32x16 __attribute__((ext_vector_type(16)));
typedef unsigned u32x4 __attribute__((ext_vector_type(4)));
typedef unsigned u32x2 __attribute__((ext_vector_type(2)));

constexpr int DM = 2048, NCTX = 256, NLAT = 16384, T = NCTX + NLAT, DEPTH = 4, DFF = 5504;
constexpr int NADA = 9 * DM;
constexpr int EV_N = 6400, OD_N = 1280;
constexpr int NCH = T / 64;
constexpr float DN_ALPHA = 1.6817928305074290f;
constexpr float LN_EPS = 1e-5f, RMS_EPS = 1e-6f;
constexpr int NWAVES = 8, NTHR = 512;
constexpr int LDS_BYTES = 147456;
constexpr int LDS_CTL = LDS_BYTES - 256;

constexpr size_t al256(size_t x) { return (x + 255) / 256 * 256; }
constexpr size_t WS_CTL = 0, CTL_BYTES = 1u << 20;
constexpr size_t WS_MODP = WS_CTL + CTL_BYTES;
constexpr size_t WS_MOD = WS_MODP + al256((size_t)8 * 2 * 4 * NADA * 4);
constexpr size_t WS_RT = WS_MOD + al256((size_t)4 * 2 * NADA * 4);
constexpr size_t WS_AXR = WS_RT + al256((size_t)NLAT * 64 * 8);
constexpr size_t WS_AXC = WS_AXR + al256(256 * 16 * 8);
constexpr size_t WS_STAT = WS_AXC + al256(64 * 16 * 8);
constexpr size_t WS_WFI = WS_STAT + al256((size_t)T * 8);
constexpr size_t SZ_WFI = (size_t)2 * DFF * DM * 2;
constexpr size_t WS_WFO = WS_WFI + 8 * SZ_WFI;
constexpr size_t SZ_WFO = (size_t)DM * DFF * 2;
constexpr size_t WS_EWI = WS_WFO + 8 * SZ_WFO;
constexpr size_t SZ_EWI = (size_t)EV_N * DM * 2;
constexpr size_t WS_EWO = WS_EWI + 2 * SZ_EWI;
constexpr size_t SZ_SQ = (size_t)DM * DM * 2;
constexpr size_t WS_OWI = WS_EWO + 2 * SZ_SQ;
constexpr size_t SZ_OWI = (size_t)OD_N * DM * 2;
constexpr size_t WS_OUQ = WS_OWI + 2 * SZ_OWI;
constexpr size_t SZ_OUQ = (size_t)3072 * 512 * 2;
constexpr size_t WS_OUKV = WS_OUQ + 2 * SZ_OUQ;
constexpr size_t SZ_OUKV = (size_t)4096 * 512 * 2;
constexpr size_t WS_OWO = WS_OUKV + 2 * SZ_OUKV;
constexpr size_t WS_X = WS_OWO + 2 * SZ_SQ;
constexpr size_t WS_H = WS_X + (size_t)T * DM * 4;
constexpr size_t WS_HID = WS_H + (size_t)T * DM * 2;
constexpr size_t WS_MIX = WS_HID + (size_t)T * DFF * 2;
constexpr size_t WS_PROJ = WS_MIX + (size_t)T * DM * 2;
constexpr size_t WS_U = WS_PROJ + (size_t)T * EV_N * 2;
constexpr size_t SZ_U = (size_t)2 * 8 * NCH * 256 * 128 * 2;
constexpr size_t WS_S = WS_U + SZ_U;
constexpr size_t WS_OI = WS_S + SZ_U;
constexpr size_t WS_QT = WS_OI + (size_t)T * DM * 4;
constexpr size_t WS_DEC = WS_QT + (size_t)2 * T * 1024 * 2;
constexpr size_t WS_END_EVEN = WS_DEC + al256((size_t)2 * 8 * NCH * 128 * 4);
constexpr size_t WS_CQN = WS_U;
constexpr size_t WS_CKVN = WS_CQN + (size_t)T * 512 * 2;
constexpr size_t WS_KR = WS_CKVN + (size_t)T * 512 * 2;
constexpr size_t WS_QB = WS_KR + al256((size_t)T * 64 * 2);
constexpr size_t WS_KVB = WS_QB + (size_t)T * 3072 * 2;
constexpr size_t WS_END_ODD = WS_KVB + (size_t)T * 4096 * 2;
constexpr size_t WS_END = WS_END_EVEN > WS_END_ODD ? WS_END_EVEN : WS_END_ODD;

#define RLX_AGENT __ATOMIC_RELAXED, __HIP_MEMORY_SCOPE_AGENT
#define LDS_WAIT() asm volatile("s_waitcnt lgkmcnt(0)" ::: "memory")
#define VM_WAIT() asm volatile("s_waitcnt vmcnt(0)" ::: "memory")
__device__ __forceinline__ unsigned cvt_pk_bf16(float lo, float hi) { unsigned r; asm volatile("v_cvt_pk_bf16_f32 %0, %1, %2" : "=v"(r) : "v"(lo), "v"(hi)); return r; }
__device__ __forceinline__ float bflo(unsigned w) { return __uint_as_float(w << 16); }
__device__ __forceinline__ float bfhi(unsigned w) { return __uint_as_float(w & 0xffff0000u); }
__device__ __forceinline__ float bf2f(bf16 b) { return __uint_as_float(((unsigned)b) << 16); }
__device__ __forceinline__ bf16 f2bf(float f) { return (bf16)(cvt_pk_bf16(f, 0.f) & 0xffffu); }
__device__ __forceinline__ float wave_sum(float v) {
#pragma unroll
    for (int o = 1; o < 64; o <<= 1) v += __shfl_xor(v, o);
    return v;
}
__device__ __forceinline__ float silu_f(float g) { return g * __builtin_amdgcn_rcpf(1.0f + __builtin_amdgcn_exp2f(-1.4426950408889634f * g)); }

namespace pg8 {
#define PG8_LAS __attribute__((address_space(3)))
typedef unsigned short bf16_t;
constexpr int BM = 256, BK = 64, HALF = 128, HTB = HALF * BK * 2, STAGE_BYTES = 8 * HTB, NXCD = 8, WGM = 8;
__host__ __device__ __forceinline__ int lds_byte(int r, int c) { const int st = (r >> 4) * 2 + (c >> 5), rr = r & 15, cc = c & 31, ob = rr * 64 + cc * 2; return st * 1024 + (ob ^ (((ob >> 9) & 1) << 5)); }
__host__ __device__ __forceinline__ void stage_rc(int b, int& R, int& C) { const int st = b / 1024, sb = b % 1024, swz = sb ^ (((sb >> 9) & 1) << 5); R = (st >> 1) * 16 + swz / 64; C = (st & 1) * 32 + (swz % 64) / 2; }
__host__ __device__ __forceinline__ int perm32(int rho) { const int n = rho >> 4, i = rho & 15; return 8 * (i >> 2) + 4 * n + (i & 3); }
struct Unit { int pm, pn; };
struct Gemm { const bf16_t* A; const bf16_t* Bt; int M, N, K, lda, ldb; };
struct StaticOrder {
    int nM, nN, nwg, G, c;
    __host__ __device__ void init(int M, int N, int G_, int c_) { nM = M / BM; nN = N / BM; nwg = nM * nN; G = G_; c = c_; }
    __host__ __device__ bool next(int i, Unit& u) const {
        const long L = (long)i * G + c; if (L >= nwg) return false;
        int wgid = (int)L; { const int q = nwg / NXCD, r = nwg % NXCD, xcd = wgid % NXCD, off = wgid / NXCD; wgid = (xcd < r ? xcd * (q + 1) : r * (q + 1) + (xcd - r) * q) + off; }
        const int nig = WGM * nN, gid = wgid / nig, fm = gid * WGM, gsz = (nM - fm) < WGM ? (nM - fm) : WGM;
        u.pm = fm + ((wgid % nig) % gsz); u.pn = (wgid % nig) / gsz; return true;
    }
    __device__ __forceinline__ void a_ready(const Unit&) const {}
    __device__ __forceinline__ void done(const Unit&) const {}
};
struct EpiBf16 {
    static constexpr bool PERM = true;
    bf16_t* O; int ldc;
    __device__ __forceinline__ void operator()(const f32x4 (&acc)[2][2][4][2], const Unit& u, int wr, int wc, int fr, int fq) const {
        const int row0 = u.pm * BM + wr * 64 + fr, col0 = u.pn * BM + wc * 32 + 8 * fq;
        asm volatile("s_nop 15" ::: "memory");
#pragma unroll
        for (int ai = 0; ai < 2; ++ai)
#pragma unroll
            for (int m = 0; m < 4; ++m) { bf16_t* rowp = O + (size_t)(row0 + ai * HALF + m * 16) * ldc + col0;
#pragma unroll
                for (int bj = 0; bj < 2; ++bj) { const f32x4 v0 = acc[ai][bj][m][0], v1 = acc[ai][bj][m][1];
                    u32x4 w; w.x = cvt_pk_bf16(v0[0], v0[1]); w.y = cvt_pk_bf16(v0[2], v0[3]); w.z = cvt_pk_bf16(v1[0], v1[1]); w.w = cvt_pk_bf16(v1[2], v1[3]);
                    *(u32x4*)(rowp + bj * HALF) = w; } }
    }
};
struct EpiSwiGLU {
    static constexpr bool PERM = true;
    bf16_t* O; int ldc;
    __device__ __forceinline__ void operator()(const f32x4 (&acc)[2][2][4][2], const Unit& u, int wr, int wc, int fr, int fq) const {
        const int row0 = u.pm * BM + wr * 64 + fr, col0 = u.pn * HALF + wc * 32 + 8 * fq;
#pragma unroll
        for (int ai = 0; ai < 2; ++ai)
#pragma unroll
            for (int m = 0; m < 4; ++m) { bf16_t* rowp = O + (size_t)(row0 + ai * HALF + m * 16) * ldc + col0;
                float h[8];
#pragma unroll
                for (int n = 0; n < 2; ++n)
#pragma unroll
                    for (int j = 0; j < 4; ++j) h[n * 4 + j] = silu_f(acc[ai][0][m][n][j]) * acc[ai][1][m][n][j];
                u32x4 w; w.x = cvt_pk_bf16(h[0], h[1]); w.y = cvt_pk_bf16(h[2], h[3]); w.z = cvt_pk_bf16(h[4], h[5]); w.w = cvt_pk_bf16(h[6], h[7]);
                *(u32x4*)rowp = w; asm volatile("" ::: "memory"); }
    }
};
struct EpiResid {
    static constexpr bool PERM = true;
    float* X; const float* gv; float gs; const float* stat; const float* lng; const float* lnb; int has_ln;
    __device__ __forceinline__ void operator()(const f32x4 (&acc)[2][2][4][2], const Unit& u, int wr, int wc, int fr, int fq) const {
        const int row0 = u.pm * BM + wr * 64 + fr, col0 = u.pn * BM + wc * 32 + 8 * fq;
        f32x2 st[2][4];
#pragma unroll
        for (int ai = 0; ai < 2; ++ai)
#pragma unroll
            for (int m = 0; m < 4; ++m) { st[ai][m] = has_ln ? *(const f32x2*)(stat + (size_t)(row0 + ai * HALF + m * 16) * 2) : (f32x2){0.f, 1.f}; st[ai][m].y *= DN_ALPHA; }
#pragma unroll
        for (int bj = 0; bj < 2; ++bj) { const int c = col0 + bj * HALF;
            f32x4 g[2], G[2], B[2];
#pragma unroll
            for (int n = 0; n < 2; ++n) { g[n] = *(const f32x4*)(gv + c + 4 * n) * gs;
                G[n] = has_ln ? *(const f32x4*)(lng + c + 4 * n) : (f32x4){1.f, 1.f, 1.f, 1.f}; B[n] = has_ln ? *(const f32x4*)(lnb + c + 4 * n) * DN_ALPHA : (f32x4){0.f, 0.f, 0.f, 0.f}; }
#pragma unroll
            for (int ai = 0; ai < 2; ++ai)
#pragma unroll
                for (int m = 0; m < 4; ++m) { float* p = X + (size_t)(row0 + ai * HALF + m * 16) * DM + c;
                    const f32x4 z0 = *(const f32x4*)p, z1 = *(const f32x4*)(p + 4);
                    *(f32x4*)p = (z0 - st[ai][m].x) * st[ai][m].y * G[0] + B[0] + g[0] * acc[ai][bj][m][0];
                    *(f32x4*)(p + 4) = (z1 - st[ai][m].x) * st[ai][m].y * G[1] + B[1] + g[1] * acc[ai][bj][m][1]; }
            asm volatile("" ::: "memory"); }
    }
};

template <class Epi, class Sched, bool ALIGN_EPI = true, bool SP2 = true>
__device__ __forceinline__ void gemm_phase(PG8_LAS unsigned char* lds, const Gemm g, const Sched& S, const Epi& E) {
    int tid = threadIdx.x; asm volatile("" : "+v"(tid));
    const int wid = __builtin_amdgcn_readfirstlane(tid >> 6), lane = tid & 63, wr = wid >> 2, wc = wid & 3, fr = lane & 15, fq = lane >> 4;
    const int K = g.K, nt = K / BK;
    unsigned voffA[2], voffB[2];
#pragma unroll
    for (int i = 0; i < 2; ++i) { int R, C; stage_rc(tid * 16 + i * 8192, R, C); const int Rb = Epi::PERM ? ((R & ~31) + perm32(R & 31)) : R;
        voffA[i] = (unsigned)(R * g.lda + C) * 2u; voffB[i] = (unsigned)(Rb * g.ldb + C) * 2u; }
    const size_t kstep = (size_t)(BK * 2);
    const size_t hstepA = (size_t)HALF * g.lda * 2, hstepB = (size_t)HALF * g.ldb * 2;
    const size_t tstepA = 2 * hstepA, tstepB = 2 * hstepB;
    const unsigned ldsw = (unsigned)wid * 1024u;
    const int aoff = lds_byte(wr * 64 + fr, fq * 8), boff = lds_byte(wc * 32 + fr, fq * 8);
#define PG8_SA(b, h) (((b) * 2 + (h)) * HTB)
#define PG8_SB(b, h) ((4 + (b) * 2 + (h)) * HTB)
#define PG8_STAGE(bufoff, gbase, voff) do { _Pragma("unroll") for (int _i = 0; _i < 2; ++_i) \
        __builtin_amdgcn_global_load_lds((const unsigned*)((const char*)(gbase) + (voff)[_i]), (PG8_LAS unsigned*)(lds + (bufoff) + ldsw + _i * 8192), 16, 0, 0); } while (0)
#define PG8_LDA(dst, b, h) do { _Pragma("unroll") for (int m = 0; m < 4; ++m) _Pragma("unroll") for (int k = 0; k < 2; ++k) dst[m][k] = *(const PG8_LAS bf16x8*)(lds + PG8_SA(b, h) + aoff + m * 2048 + k * 1024); } while (0)
#define PG8_LDB(dst, b, h) do { _Pragma("unroll") for (int n = 0; n < 2; ++n) _Pragma("unroll") for (int k = 0; k < 2; ++k) dst[n][k] = *(const PG8_LAS bf16x8*)(lds + PG8_SB(b, h) + boff + n * 2048 + k * 1024); } while (0)
#define PG8_MMA(ai, bj, At, Bt) do { __builtin_amdgcn_s_setprio(1); _Pragma("unroll") for (int m = 0; m < 4; ++m) _Pragma("unroll") for (int n = 0; n < 2; ++n) _Pragma("unroll") for (int k = 0; k < 2; ++k) \
        acc[ai][bj][m][n] = __builtin_amdgcn_mfma_f32_16x16x32_bf16(Bt[n][k], At[m][k], acc[ai][bj][m][n], 0, 0, 0); __builtin_amdgcn_s_setprio(0); } while (0)
#define PG8_WAIT_V(n) asm volatile("s_waitcnt vmcnt(" #n ")" ::: "memory")
#define PG8_WAIT_L(n) asm volatile("s_waitcnt lgkmcnt(" #n ")" ::: "memory")
#define PG8_BAR __builtin_amdgcn_s_barrier()
#define PG8_SCHED __builtin_amdgcn_sched_barrier(0)
    Unit cur, nxt; int ui = 0;
    if (!S.next(0, cur)) return;
    f32x4 acc[2][2][4][2];
#pragma unroll
    for (int a = 0; a < 2; ++a)
#pragma unroll
        for (int b = 0; b < 2; ++b)
#pragma unroll
            for (int m = 0; m < 4; ++m)
#pragma unroll
                for (int n = 0; n < 2; ++n) acc[a][b][m][n] = (f32x4){0.f, 0.f, 0.f, 0.f};
    bf16x8 At[4][2], B0[2][2], B1[2][2];
    const char* cA = (const char*)g.A + (size_t)cur.pm * tstepA; const char* cB = (const char*)g.Bt + (size_t)cur.pn * tstepB;
    S.a_ready(cur);
    if constexpr (SP2) {
        PG8_STAGE(PG8_SB(0, 0), cB, voffB); PG8_STAGE(PG8_SB(0, 1), cB + hstepB, voffB); PG8_STAGE(PG8_SA(0, 0), cA, voffA); PG8_STAGE(PG8_SA(0, 1), cA + hstepA, voffA);
        if (wr == 1) PG8_BAR;
        PG8_WAIT_V(2); PG8_BAR;
        PG8_STAGE(PG8_SB(1, 0), cB + kstep, voffB); PG8_STAGE(PG8_SA(1, 0), cA + kstep, voffA); PG8_STAGE(PG8_SB(1, 1), cB + hstepB + kstep, voffB);
        PG8_WAIT_V(6); PG8_BAR;
    } else {
        PG8_STAGE(PG8_SB(0, 0), cB, voffB); PG8_STAGE(PG8_SA(0, 0), cA, voffA); PG8_STAGE(PG8_SB(0, 1), cB + hstepB, voffB); PG8_STAGE(PG8_SA(0, 1), cA + hstepA, voffA);
        if (wr == 1) PG8_BAR;
        PG8_WAIT_V(4); PG8_BAR;
        PG8_STAGE(PG8_SB(1, 0), cB + kstep, voffB); PG8_STAGE(PG8_SA(1, 0), cA + kstep, voffA); PG8_STAGE(PG8_SB(1, 1), cB + hstepB + kstep, voffB);
        PG8_WAIT_V(6); PG8_BAR;
    }
    for (;;) {
        const bool has_next = S.next(ui + 1, nxt);
        const char* nA = has_next ? (const char*)g.A + (size_t)nxt.pm * tstepA : cA; const char* nB = has_next ? (const char*)g.Bt + (size_t)nxt.pn * tstepB : cB;
        for (int t = 0; t < nt; t += 2) {
            const bool last = (t == nt - 2);
            const char* a1 = cA + (size_t)(t + 1) * kstep;
            const char* a2 = last ? nA : cA + (size_t)(t + 2) * kstep; const char* b2 = last ? nB : cB + (size_t)(t + 2) * kstep;
            const char* a3 = a2 + kstep; const char* b3 = b2 + kstep;
            if (last && has_next) S.a_ready(nxt);
            if constexpr (SP2) {
            PG8_LDB(B0, 0, 0); PG8_LDB(B1, 0, 1); PG8_SCHED; PG8_LDA(At, 0, 0); PG8_STAGE(PG8_SA(1, 1), a1 + hstepA, voffA);
            PG8_WAIT_V(8); PG8_WAIT_L(0); PG8_BAR; PG8_MMA(0, 0, At, B0); PG8_MMA(0, 1, At, B1); PG8_BAR; PG8_SCHED;
            PG8_LDA(At, 0, 1); PG8_STAGE(PG8_SB(0, 0), b2, voffB); PG8_STAGE(PG8_SB(0, 1), b2 + hstepB, voffB); PG8_STAGE(PG8_SA(0, 0), a2, voffA);
            PG8_WAIT_V(8); PG8_WAIT_L(0); PG8_BAR; PG8_MMA(1, 0, At, B0); PG8_MMA(1, 1, At, B1); PG8_BAR; PG8_SCHED;
            PG8_LDB(B0, 1, 0); PG8_LDB(B1, 1, 1); PG8_SCHED; PG8_LDA(At, 1, 0); PG8_STAGE(PG8_SA(0, 1), a2 + hstepA, voffA);
            PG8_WAIT_V(8); PG8_WAIT_L(0); PG8_BAR; PG8_MMA(0, 0, At, B0); PG8_MMA(0, 1, At, B1); PG8_BAR; PG8_SCHED;
            PG8_LDA(At, 1, 1); PG8_STAGE(PG8_SB(1, 0), b3, voffB); PG8_STAGE(PG8_SB(1, 1), b3 + hstepB, voffB); PG8_STAGE(PG8_SA(1, 0), a3, voffA);
            PG8_WAIT_V(8); PG8_WAIT_L(0); PG8_BAR; PG8_MMA(1, 0, At, B0); PG8_MMA(1, 1, At, B1); PG8_BAR; PG8_SCHED;
            } else {
            PG8_LDB(B0, 0, 0); PG8_SCHED; PG8_LDA(At, 0, 0); PG8_STAGE(PG8_SA(1, 1), a1 + hstepA, voffA);
            PG8_WAIT_L(8); PG8_BAR; PG8_WAIT_L(0); PG8_MMA(0, 0, At, B0); PG8_BAR; PG8_SCHED;
            PG8_LDB(B1, 0, 1); PG8_STAGE(PG8_SB(0, 0), b2, voffB);
            PG8_BAR; PG8_WAIT_L(0); PG8_MMA(0, 1, At, B1); PG8_BAR;
            PG8_LDA(At, 0, 1); PG8_STAGE(PG8_SA(0, 0), a2, voffA);
            PG8_BAR; PG8_WAIT_L(0); PG8_MMA(1, 0, At, B0); PG8_BAR; PG8_SCHED;
            PG8_STAGE(PG8_SB(0, 1), b2 + hstepB, voffB);
            PG8_WAIT_V(6); PG8_BAR; PG8_MMA(1, 1, At, B1); PG8_BAR;
            PG8_LDB(B0, 1, 0); PG8_SCHED; PG8_LDA(At, 1, 0); PG8_STAGE(PG8_SA(0, 1), a2 + hstepA, voffA);
            PG8_WAIT_L(8); PG8_BAR; PG8_WAIT_L(0); PG8_MMA(0, 0, At, B0); PG8_BAR; PG8_SCHED;
            PG8_LDB(B1, 1, 1); PG8_STAGE(PG8_SB(1, 0), b3, voffB);
            PG8_BAR; PG8_WAIT_L(0); PG8_MMA(0, 1, At, B1); PG8_BAR;
            PG8_LDA(At, 1, 1); PG8_STAGE(PG8_SA(1, 0), a3, voffA);
            PG8_BAR; PG8_WAIT_L(0); PG8_MMA(1, 0, At, B0); PG8_BAR; PG8_SCHED;
            PG8_STAGE(PG8_SB(1, 1), b3 + hstepB, voffB);
            PG8_WAIT_V(6); PG8_BAR; PG8_MMA(1, 1, At, B1); PG8_BAR;
            }
        }
        if constexpr (ALIGN_EPI) { if (wr == 0) PG8_BAR; }
        E(acc, cur, wr, wc, fr, fq); S.done(cur);
        if (!has_next) break;
#pragma unroll
        for (int a = 0; a < 2; ++a)
#pragma unroll
            for (int b = 0; b < 2; ++b)
#pragma unroll
                for (int m = 0; m < 4; ++m)
#pragma unroll
                    for (int n = 0; n < 2; ++n) acc[a][b][m][n] = (f32x4){0.f, 0.f, 0.f, 0.f};
        cur = nxt; cA = nA; cB = nB; ++ui;
        if constexpr (ALIGN_EPI) { if (wr == 1) PG8_BAR; }
    }
    PG8_WAIT_V(0);
    if constexpr (!ALIGN_EPI) { if (wr == 0) PG8_BAR; }
    PG8_BAR;
#undef PG8_SA
#undef PG8_SB
#undef PG8_STAGE
#undef PG8_LDA
#undef PG8_LDB
#undef PG8_MMA
#undef PG8_WAIT_V
#undef PG8_WAIT_L
#undef PG8_BAR
#undef PG8_SCHED
}
}

#define XB_TMO      128
#define XB_XCNT(j)  (256  + 64 * (j))
#define XB_XSUB(j)  (1280 + 64 * (j))
#define XB_XGEN(j)  (2304 + 64 * (j))
#define XB_TOP      3328
#define XB_TOPGEN   3392
#define XCD_BAR_WORDS 3456
#define XB_SPIN_CAP (1u << 18)
__device__ __forceinline__ unsigned xb_ld(unsigned* p)              { return __hip_atomic_load(p, __ATOMIC_RELAXED, __HIP_MEMORY_SCOPE_AGENT); }
__device__ __forceinline__ unsigned xb_add(unsigned* p, unsigned v) { return __hip_atomic_fetch_add(p, v, __ATOMIC_RELAXED, __HIP_MEMORY_SCOPE_AGENT); }
__device__ __forceinline__ unsigned xb_xcc_id() { return (unsigned)__builtin_amdgcn_s_getreg((3 << 11) | 20) & 0xFu; }
#define XB_SPIN(cond, bar) do { unsigned _sp = 0; while (cond) { __builtin_amdgcn_s_sleep(1); \
    if ((++_sp & 255u) == 0u) { if (xb_ld(&(bar)[XB_TMO])) break; if (_sp > XB_SPIN_CAP) { atomicAdd(&(bar)[XB_TMO], 1u); break; } } } } while (0)
struct XcdBarrier { unsigned* bar; unsigned x; volatile LAS unsigned* st; };
__device__ __forceinline__ XcdBarrier xcd_barrier_post(unsigned* bar, volatile LAS unsigned* st) {
    XcdBarrier b; b.bar = bar; b.x = xb_xcc_id(); b.st = st;
    if (threadIdx.x == 0) (void)xb_add(&bar[XB_XCNT(b.x)], 1u);
    return b;
}
__device__ __forceinline__ void xcd_barrier_complete(unsigned* bar, unsigned x, unsigned& nloc, unsigned& nx) {
    const unsigned G = gridDim.x * gridDim.y * gridDim.z;
    unsigned sum, cnt, mine, sp = 0u;
    for (;;) {
        sum = 0u; cnt = 0u; mine = 0u;
#pragma unroll
        for (unsigned j = 0; j < 16; ++j) { const unsigned c = xb_ld(&bar[XB_XCNT(j)]); sum += c; cnt += (c > 0u) ? 1u : 0u; mine = (j == x) ? c : mine; }
        if (sum == G) break;
        __builtin_amdgcn_s_sleep(1);
        if ((++sp & 255u) == 0u) { if (xb_ld(&bar[XB_TMO])) break; if (sp > XB_SPIN_CAP) { atomicAdd(&bar[XB_TMO], 1u); break; } }
    }
    nloc = mine > 0u ? mine : 1u; nx = cnt > 0u ? cnt : 1u;
}
__device__ __forceinline__ void xcd_barrier(const XcdBarrier& b0) {
    asm volatile("s_waitcnt vmcnt(0)" ::: "memory");
    __syncthreads();
    if (threadIdx.x == 0) {
        XcdBarrier b = b0; b.x = xb_xcc_id();
        unsigned* bar = b.bar;
        __builtin_amdgcn_s_waitcnt(0);
        unsigned nloc = b.st[0], nx = b.st[1];
        if (nloc == 0u) { xcd_barrier_complete(bar, b.x, nloc, nx); b.st[0] = nloc; b.st[1] = nx; }
        const unsigned old = xb_add(&bar[XB_XSUB(b.x)], 1u);
        const unsigned gen = old / nloc;
        if (old + 1u == (gen + 1u) * nloc) {
            __builtin_amdgcn_fence(__ATOMIC_RELEASE, "agent");
            asm volatile("s_waitcnt vmcnt(0)" ::: "memory");
            const unsigned og = xb_add(&bar[XB_TOP], 1u);
            const unsigned tg = og / nx;
            if (og + 1u == (tg + 1u) * nx) xb_add(&bar[XB_TOPGEN], 1u);
            else XB_SPIN(xb_ld(&bar[XB_TOPGEN]) == tg, bar);
            __builtin_amdgcn_fence(__ATOMIC_ACQUIRE, "agent");
            xb_add(&bar[XB_XGEN(b.x)], 1u);
            asm volatile("s_waitcnt vmcnt(0)" ::: "memory");
        } else {
            XB_SPIN(xb_ld(&bar[XB_XGEN(b.x)]) == gen, bar);
            __builtin_amdgcn_fence(__ATOMIC_ACQUIRE, "agent");
            asm volatile("s_waitcnt vmcnt(0)" ::: "memory");
        }
    }
    __syncthreads();
}

struct Args { const float* in[23]; float* out; unsigned char* ws; };
struct Frame {
    LAS unsigned char* lds;
    int vcu, G;
    const Args* a; unsigned char* ws;
};
#define PHASE_IDS() int tid = threadIdx.x; asm volatile("" : "+v"(tid)); const int lane = tid & 63, wave = __builtin_amdgcn_readfirstlane(tid >> 6); (void)lane; (void)wave
#define MFMA16(a, b, c) __builtin_amdgcn_mfma_f32_16x16x32_bf16((a), (b), (c), 0, 0, 0)
#define MFMA32(a, b, c) __builtin_amdgcn_mfma_f32_32x32x16_bf16((a), (b), (c), 0, 0, 0)

__device__ __forceinline__ void tr_item(const float* W, int N, int K, bf16* WT, int k0, int n0, int drow0, LAS float* scr, int lane) {
#pragma unroll 8
    for (int i = 0; i < 32; ++i) { const int kk = 2 * i + (lane >> 5); scr[kk * 33 + (lane & 31)] = W[(size_t)(k0 + kk) * N + n0 + (lane & 31)]; }
    LDS_WAIT(); asm volatile("" ::: "memory");
    const int c = lane & 7;
#pragma unroll
    for (int j = 0; j < 4; ++j) { const int n = (lane >> 3) + 8 * j; const LAS float* s = scr + (8 * c) * 33 + n;
        u32x4 o; o.x = cvt_pk_bf16(s[0 * 33], s[1 * 33]); o.y = cvt_pk_bf16(s[2 * 33], s[3 * 33]); o.z = cvt_pk_bf16(s[4 * 33], s[5 * 33]); o.w = cvt_pk_bf16(s[6 * 33], s[7 * 33]);
        *(u32x4*)(WT + (size_t)(drow0 + n) * K + k0 + 8 * c) = o; }
    LDS_WAIT(); asm volatile("" ::: "memory");
}
__device__ __forceinline__ void p0a(Frame& F) {
    PHASE_IDS();
    LAS float* scr = (LAS float*)(F.lds + wave * 8704);
    LAS float* sv = (LAS float*)(F.lds + 8 * 8704);
    for (int i = tid; i < 2 * DM; i += NTHR) { const float v = (i < DM) ? F.a->in[1][i] : F.a->in[3][i - DM]; sv[i] = v / (1.0f + __expf(-v)); }
    __syncthreads();
    const int gw = F.vcu * NWAVES + wave, NGW = F.G * NWAVES;
    constexpr int I0 = 8 * 32 * 344, I1 = 8 * 86 * 64, I2 = 2 * 32 * 193, I3 = 2 * 32 * 64, I4 = 2 * 32 * 34, I5 = 2 * 8 * 96, I6 = 2 * 8 * 128, I7 = 2 * 32 * 64;
    constexpr int NTR = I0 + I1 + I2 + I3 + I4 + I5 + I6 + I7, NADAI = 8 * 288;
    for (int it = gw; it < NTR + NADAI; it += NGW) {
        int r = it;
        if (r < I0) { const int mat = r / 11008, q = r % 11008, kb = q / 344, nb = q % 344, n0 = nb * 32;
            const int j = n0 < DFF ? n0 : n0 - DFF, drow = (j / 128) * 256 + (j % 128) + (n0 < DFF ? 0 : 128);
            tr_item(F.a->in[8] + (size_t)mat * DM * 2 * DFF, 2 * DFF, DM, (bf16*)(F.ws + WS_WFI + mat * SZ_WFI), kb * 64, n0, drow - 0, scr, lane); continue; } r -= I0;
        if (r < I1) { const int mat = r / 5504, q = r % 5504, kb = q / 64, nb = q % 64;
            tr_item(F.a->in[9] + (size_t)mat * DFF * DM, DM, DFF, (bf16*)(F.ws + WS_WFO + mat * SZ_WFO), kb * 64, nb * 32, nb * 32, scr, lane); continue; } r -= I1;
        if (r < I2) { const int mat = r / 6176, q = r % 6176, kb = q / 193, nb = q % 193, n0 = nb * 32;
            const int drow = n0 < 3072 ? n0 : (n0 < 3104 ? 6144 : n0 - 32);
            tr_item(F.a->in[10] + (size_t)mat * DM * 6176, 6176, DM, (bf16*)(F.ws + WS_EWI + mat * SZ_EWI), kb * 64, n0, drow, scr, lane); continue; } r -= I2;
        if (r < I3) { const int mat = r / 2048, q = r % 2048, kb = q / 64, nb = q % 64;
            tr_item(F.a->in[16] + (size_t)mat * DM * DM, DM, DM, (bf16*)(F.ws + WS_EWO + mat * SZ_SQ), kb * 64, nb * 32, nb * 32, scr, lane); continue; } r -= I3;
        if (r < I4) { const int mat = r / 1088, q = r % 1088, kb = q / 34, nb = q % 34;
            tr_item(F.a->in[17] + (size_t)mat * DM * 1088, 1088, DM, (bf16*)(F.ws + WS_OWI + mat * SZ_OWI), kb * 64, nb * 32, nb * 32, scr, lane); continue; } r -= I4;
        if (r < I5) { const int mat = r / 768, q = r % 768, kb = q / 96, nb = q % 96;
            tr_item(F.a->in[20] + (size_t)mat * 512 * 3072, 3072, 512, (bf16*)(F.ws + WS_OUQ + mat * SZ_OUQ), kb * 64, nb * 32, nb * 32, scr, lane); continue; } r -= I5;
        if (r < I6) { const int mat = r / 1024, q = r % 1024, kb = q / 128, nb = q % 128;
            tr_item(F.a->in[21] + (size_t)mat * 512 * 4096, 4096, 512, (bf16*)(F.ws + WS_OUKV + mat * SZ_OUKV), kb * 64, nb * 32, nb * 32, scr, lane); continue; } r -= I6;
        if (r < I7) { const int mat = r / 2048, q = r % 2048, kb = q / 64, nb = q % 64;
            tr_item(F.a->in[22] + (size_t)mat * DM * DM, DM, DM, (bf16*)(F.ws + WS_OWO + mat * SZ_SQ), kb * 64, nb * 32, nb * 32, scr, lane); continue; } r -= I7;
        {
            const int ks = r / 288, cg = r % 288, l = cg / 72, n = (cg % 72) * 256 + lane * 4;
            const float* w = F.a->in[4] + ((size_t)l * DM + ks * 256) * NADA + n;
            f32x4 al = {0.f, 0.f, 0.f, 0.f}, ac = {0.f, 0.f, 0.f, 0.f};
#pragma unroll 8
            for (int k = 0; k < 256; ++k) { const f32x4 wv = *(const f32x4*)(w + (size_t)k * NADA); al += wv * sv[ks * 256 + k]; ac += wv * sv[DM + ks * 256 + k]; }
            float* mp = (float*)(F.ws + WS_MODP);
            *(f32x4*)(mp + (size_t)(ks * 2 + 0) * 4 * NADA + l * NADA + n) = al;
            *(f32x4*)(mp + (size_t)(ks * 2 + 1) * 4 * NADA + l * NADA + n) = ac;
        }
    }
    const int gt = F.vcu * NTHR + tid, NGT = F.G * NTHR;
    for (int i = gt; i < NLAT * 64 + 256 * 16 + 64 * 16; i += NGT) {
        int pos, fi; float inv; f32x2* dst;
        if (i < NLAT * 64) { pos = i >> 6; fi = i & 63; inv = __builtin_amdgcn_exp2f(-(float)fi * (13.287712379549449f / 64.0f)); dst = (f32x2*)(F.ws + WS_RT) + i; }
        else if (i < NLAT * 64 + 4096) { const int j = i - NLAT * 64; pos = j >> 4; fi = j & 15; inv = __builtin_amdgcn_exp2f(-(float)fi * (13.287712379549449f / 16.0f)); dst = (f32x2*)(F.ws + WS_AXR) + j; }
        else { const int j = i - NLAT * 64 - 4096; pos = j >> 4; fi = j & 15; inv = __builtin_amdgcn_exp2f(-(float)fi * (13.287712379549449f / 16.0f)); dst = (f32x2*)(F.ws + WS_AXC) + j; }
        const float ang = (float)pos * inv;
        double rev = (double)ang * 0.15915494309189535; rev -= __builtin_floor(rev);
        const float rv = (float)rev;
        *dst = (f32x2){__builtin_amdgcn_cosf(rv), __builtin_amdgcn_sinf(rv)};
    }
}
__device__ __forceinline__ void p0b(Frame& F) {
    PHASE_IDS();
    const int gt = F.vcu * NTHR + tid, NGT = F.G * NTHR;
    const float* mp = (const float*)(F.ws + WS_MODP); float* mo = (float*)(F.ws + WS_MOD);
    for (int i = gt; i < 4 * 2 * NADA; i += NGT) { const int l = i / (2 * NADA), v = (i / NADA) & 1, n = i % NADA;
        float s = F.a->in[5][l * NADA + n];
#pragma unroll
        for (int ks = 0; ks < 8; ++ks) s += mp[(size_t)(ks * 2 + v) * 4 * NADA + l * NADA + n];
        mo[i] = s; }
}
__device__ __forceinline__ const float* modp(Frame& F, int l, int v, int idx) { return (const float*)(F.ws + WS_MOD) + ((size_t)(l * 2 + v) * 9 + idx) * DM; }

template <int MODE>
__device__ __forceinline__ void row_phase(Frame& F, const float* lng, const float* lnb, const float* sh_l, const float* sc_l, const float* sh_c, const float* sc_c) {
    PHASE_IDS();
    LAS float* V = (LAS float*)F.lds;
    for (int i = tid; i < DM; i += NTHR) { if (MODE != 0) { V[i] = lng[i]; V[DM + i] = lnb[i]; } if (MODE != 2) { V[2 * DM + i] = sh_l[i]; V[3 * DM + i] = sc_l[i]; V[4 * DM + i] = sh_c[i]; V[5 * DM + i] = sc_c[i]; } }
    __syncthreads();
    const int gw = F.vcu * NWAVES + wave, NGW = F.G * NWAVES;
    float* X = (float*)(F.ws + WS_X); bf16* H = (bf16*)(F.ws + WS_H);
    for (int t = gw; t < T; t += NGW) {
        if (MODE == 2 && t < NCTX) continue;
        const float* src = (MODE == 0) ? (t < NCTX ? F.a->in[2] + (size_t)t * DM : F.a->in[0] + (size_t)(t - NCTX) * DM) : X + (size_t)t * DM;
        f32x4 v[8]; float s = 0.f; float mean_ = 0.f, rstd_ = 1.f;
#pragma unroll
        for (int j = 0; j < 8; ++j) { v[j] = *((const f32x4*)src + lane + 64 * j); s += (v[j].x + v[j].y) + (v[j].z + v[j].w); }
        if (MODE != 0) {
            const float mean = wave_sum(s) * (1.f / DM); float s2 = 0.f;
#pragma unroll
            for (int j = 0; j < 8; ++j) { v[j] = v[j] - mean; s2 += (v[j].x * v[j].x + v[j].y * v[j].y) + (v[j].z * v[j].z + v[j].w * v[j].w); }
            const float rstd = 1.f / sqrtf(wave_sum(s2) * (1.f / DM) + LN_EPS); mean_ = mean; rstd_ = rstd;
#pragma unroll
            for (int j = 0; j < 8; ++j) { const f32x4 g = *((const LAS f32x4*)V + lane + 64 * j), b = *((const LAS f32x4*)(V + DM) + lane + 64 * j); v[j] = v[j] * rstd * g + b; }
        }
        if (MODE == 1 && lane == 0) *(f32x2*)((float*)(F.ws + WS_STAT) + (size_t)t * 2) = (f32x2){mean_, rstd_};
        if (MODE == 2) {
            float* o = F.a->out + (size_t)(t - NCTX) * DM;
#pragma unroll
            for (int j = 0; j < 8; ++j) *((f32x4*)o + lane + 64 * j) = v[j];
        } else {
            float* o = X + (size_t)t * DM; bf16* h = H + (size_t)t * DM;
            const LAS float* shv = V + (t < NCTX ? 4 * DM : 2 * DM); const LAS float* scv = V + (t < NCTX ? 5 * DM : 3 * DM);
#pragma unroll
            for (int j = 0; j < 8; ++j) {
                const f32x4 sh = *((const LAS f32x4*)shv + lane + 64 * j), sc = *((const LAS f32x4*)scv + lane + 64 * j);
                const f32x4 m = v[j] * (sc + 1.0f) + sh; u32x2 w; w.x = cvt_pk_bf16(m.x, m.y); w.y = cvt_pk_bf16(m.z, m.w);
                *((u32x2*)h + lane + 64 * j) = w; }
        }
    }
    __syncthreads();
}


__device__ __forceinline__ void ctx_resid_small(Frame& F, float* X, const bf16* A, const bf16* Bt, int K, const float* gv, float gs, const float* stat, const float* lng, const float* lnb, int has_ln, int parity) {
    if ((int)(blockIdx.x & 1) != parity) return;
    PHASE_IDS(); const int fr = lane & 15, fq = lane >> 4;
    const int nks = K >> 5, last = wave + 8 * ((nks - 1 - wave) >> 3), trips = (((nks + 7) >> 3) + 3) & ~3;
    for (int item = blockIdx.x; item < 256; item += F.G) {
        const int mt = item >> 5, nt = item & 31;
        f32x4 acc[2][4];
#pragma unroll
        for (int i = 0; i < 2; ++i)
#pragma unroll
            for (int j = 0; j < 4; ++j) acc[i][j] = (f32x4){0.f, 0.f, 0.f, 0.f};
        const bf16* Ap = A + (size_t)(32 * mt + fr) * K + 8 * fq;
        const bf16* Bp = Bt + (size_t)(64 * nt + fr) * K + 8 * fq;
        bf16x8 a0[2], b0[4], a1[2], b1[4], a2[2], b2[4], a3[2], b3[4];
#define CS_LOAD(a, b, i_) do { const int so_ = 32 * min(wave + 8 * (i_), last); _Pragma("unroll") for (int i = 0; i < 2; ++i) a[i] = *(const bf16x8*)(Ap + (size_t)(16 * i) * K + so_); \
        _Pragma("unroll") for (int i = 0; i < 4; ++i) b[i] = *(const bf16x8*)(Bp + (size_t)(16 * i) * K + so_); } while (0)
#define CS_MMA(a, b, i_) do { __builtin_amdgcn_sched_barrier(0); if (wave + 8 * (i_) < nks) { _Pragma("unroll") for (int i = 0; i < 2; ++i) _Pragma("unroll") for (int j = 0; j < 4; ++j) acc[i][j] = MFMA16(a[i], b[j], acc[i][j]); } __builtin_amdgcn_sched_barrier(0); } while (0)
        CS_LOAD(a0, b0, 0); CS_LOAD(a1, b1, 1); CS_LOAD(a2, b2, 2);
        for (int it = 0; it < trips; it += 4) {
            CS_LOAD(a3, b3, it + 3); CS_MMA(a0, b0, it);
            CS_LOAD(a0, b0, it + 4); CS_MMA(a1, b1, it + 1);
            CS_LOAD(a1, b1, it + 5); CS_MMA(a2, b2, it + 2);
            CS_LOAD(a2, b2, it + 6); CS_MMA(a3, b3, it + 3);
        }
#undef CS_LOAD
#undef CS_MMA
        LAS float* P = (LAS float*)F.lds + wave * 2048;
#pragma unroll
        for (int i = 0; i < 2; ++i)
#pragma unroll
            for (int j = 0; j < 4; ++j)
#pragma unroll
                for (int r = 0; r < 4; ++r) P[(16 * i + 4 * fq + r) * 64 + 16 * j + fr] = acc[i][j][r];
        __syncthreads();
        const int row = tid >> 4, c0 = (tid & 15) * 4;
        f32x4 s0 = {0.f, 0.f, 0.f, 0.f};
#pragma unroll
        for (int w = 0; w < 8; ++w) s0 += *(const LAS f32x4*)((LAS float*)F.lds + w * 2048 + row * 64 + c0);
        float* xp = X + (size_t)(32 * mt + row) * DM + 64 * nt + c0;
        const f32x4 g0 = *(const f32x4*)(gv + 64 * nt + c0) * gs;
        f32x4 x0 = *(const f32x4*)xp;
        if (has_ln) { const f32x2 st = *(const f32x2*)(stat + (size_t)(32 * mt + row) * 2); x0 = (x0 - st.x) * st.y * *(const f32x4*)(lng + 64 * nt + c0) + *(const f32x4*)(lnb + 64 * nt + c0); }
        *(f32x4*)xp = x0 * DN_ALPHA + g0 * s0;
        __syncthreads();
    }
}


__device__ __forceinline__ void init_x_by_owners(Frame& F) {
    PHASE_IDS();
    float* X = (float*)(F.ws + WS_X);
    pg8::StaticOrder S; S.init(NLAT, DM, F.G, (int)blockIdx.x); pg8::Unit u;
    for (int i = 0; S.next(i, u); ++i) {
        const int c4 = (tid & 63) * 4, r0 = tid >> 6;
#pragma unroll 4
        for (int rr = r0; rr < 256; rr += 8) { const size_t lr = (size_t)u.pm * 256 + rr; *(f32x4*)(X + (lr + NCTX) * DM + u.pn * 256 + c4) = *(const f32x4*)(F.a->in[0] + lr * DM + u.pn * 256 + c4); }
    }
    for (int item = blockIdx.x; item < 256; item += F.G) { const int mt = item >> 5, nt = item & 31, row = tid >> 4, c0 = (tid & 15) * 4;
        const size_t o = (size_t)(32 * mt + row) * DM + 64 * nt + c0; *(f32x4*)(X + o) = *(const f32x4*)(F.a->in[2] + o); }
}

constexpr int L1_QRAW = 0, L1_KRAW = 16384, L1_GD = 32768, L1_PART = 36864, L1_QT = 40960, L1_KT = 58368, L1_KTT = 75776, L1_VT = 94208, L1_P = 131072;
constexpr float INV_SQRT_DK = 0.08838834764831845f;

template <int DIR>
__device__ __forceinline__ void s1_dir(Frame& F, int e, int hh, int c, bool lat, f32x4 (&pacc)[2], const float (&wv)[16], const float bgv, const f32x2 (&csv)[16]) {
    const bool is_gla = hh < 4; const int hd = hh & 3, t0 = c * 64;
    PHASE_IDS(); const int w = wave, fr = lane & 15, fq = lane >> 4;
    LAS unsigned char* lds = F.lds;
    const int ch = tid & 127, tq = tid >> 7;
    float lgv[16];
    if (is_gla) {
#pragma unroll
        for (int i = 0; i < 16; ++i) { const int tt = 16 * tq + (DIR ? 15 - i : i);
            const u32x4 g0 = *(const LAS u32x4*)(lds + L1_GD + tt * 64 + DIR * 32), g1 = *(const LAS u32x4*)(lds + L1_GD + tt * 64 + DIR * 32 + 16);
            float x = bgv;
            x += bflo(g0.x) * wv[0] + bfhi(g0.x) * wv[1] + bflo(g0.y) * wv[2] + bfhi(g0.y) * wv[3] + bflo(g0.z) * wv[4] + bfhi(g0.z) * wv[5] + bflo(g0.w) * wv[6] + bfhi(g0.w) * wv[7];
            x += bflo(g1.x) * wv[8] + bfhi(g1.x) * wv[9] + bflo(g1.y) * wv[10] + bfhi(g1.y) * wv[11] + bflo(g1.z) * wv[12] + bfhi(g1.z) * wv[13] + bflo(g1.w) * wv[14] + bfhi(g1.w) * wv[15];
            lgv[i] = (fminf(x, 0.f) - __logf(1.0f + __expf(-fabsf(x)))) * (1.0f / 16.0f); }
    } else {
        const float lg = log1pf(-exp2f((DIR ? -5.5f : -5.0f) - (float)hd));
#pragma unroll
        for (int i = 0; i < 16; ++i) lgv[i] = lg;
    }
    float ls = 0.f;
#pragma unroll
    for (int i = 0; i < 16; ++i) ls += lgv[i];
    LAS float* part = (LAS float*)(lds + L1_PART);
    part[tq * 128 + ch] = ls;
    __syncthreads();
    float b = 0.f;
#pragma unroll
    for (int q = 0; q < 4; ++q) { const float pv = part[q * 128 + ch]; if (DIR ? (q > tq) : (q < tq)) b += pv; }
    bf16* QTg = (bf16*)(F.ws + WS_QT) + (size_t)DIR * T * 1024;
    float kt[16];
#pragma unroll
    for (int i = 0; i < 16; ++i) { const int tt = 16 * tq + (DIR ? 15 - i : i);
        b += lgv[i];
        float qv = bf2f(*(const LAS bf16*)(lds + L1_QRAW + tt * 256 + ch * 2)), kv = bf2f(*(const LAS bf16*)(lds + L1_KRAW + tt * 256 + ch * 2));
        if (!is_gla && lat) {
            const float qp = bf2f(*(const LAS bf16*)(lds + L1_QRAW + tt * 256 + (ch ^ 64) * 2)), kp = bf2f(*(const LAS bf16*)(lds + L1_KRAW + tt * 256 + (ch ^ 64) * 2));
            const f32x2 cs = csv[DIR ? 15 - i : i];
            if (ch < 64) { qv = qv * cs.x - qp * cs.y; kv = kv * cs.x - kp * cs.y; } else { qv = qv * cs.x + qp * cs.y; kv = kv * cs.x + kp * cs.y; }
        }
        const float eb = __expf(b), ebi = __expf(-b);
        const float qs = qv * eb * (is_gla ? INV_SQRT_DK : 1.0f), ks = kv * ebi * (is_gla ? 1.0f : INV_SQRT_DK);
        const bf16 qb = f2bf(qs);
        *(LAS bf16*)(lds + L1_QT + tt * 272 + ch * 2) = qb;
        *(LAS bf16*)(lds + L1_KT + tt * 272 + ch * 2) = f2bf(ks);
        kt[DIR ? 15 - i : i] = ks;
        if (i == 15 && tq == (DIR ? 0 : 3)) ((float*)(F.ws + WS_DEC))[((size_t)(DIR * 8 + hh) * NCH + c) * 128 + ch] = eb;
    }
    { u32x4 w0, w1; w0.x = cvt_pk_bf16(kt[0], kt[1]); w0.y = cvt_pk_bf16(kt[2], kt[3]); w0.z = cvt_pk_bf16(kt[4], kt[5]); w0.w = cvt_pk_bf16(kt[6], kt[7]);
      w1.x = cvt_pk_bf16(kt[8], kt[9]); w1.y = cvt_pk_bf16(kt[10], kt[11]); w1.z = cvt_pk_bf16(kt[12], kt[13]); w1.w = cvt_pk_bf16(kt[14], kt[15]);
      *(LAS u32x4*)(lds + L1_KTT + ch * 144 + tq * 32) = w0; *(LAS u32x4*)(lds + L1_KTT + ch * 144 + tq * 32 + 16) = w1; }
    __syncthreads();
#pragma unroll
    for (int i = 0; i < 2; ++i) { const int id = tid + 512 * i, r = id >> 4, cc = id & 15;
        *(u32x4*)(QTg + (size_t)(t0 + r) * 1024 + hh * 128 + cc * 8) = *(const LAS u32x4*)(lds + L1_QT + r * 272 + cc * 16); }
    { const int mi = w >> 1, nj0 = 2 * (w & 1);
      f32x4 pd[2] = {{0.f, 0.f, 0.f, 0.f}, {0.f, 0.f, 0.f, 0.f}};
#pragma unroll
      for (int ks = 0; ks < 4; ++ks) { const bf16x8 a = *(const LAS bf16x8*)(lds + L1_QT + (16 * mi + fr) * 272 + (32 * ks + 8 * fq) * 2);
#pragma unroll
          for (int j = 0; j < 2; ++j) { const bf16x8 bb = *(const LAS bf16x8*)(lds + L1_KT + (16 * (nj0 + j) + fr) * 272 + (32 * ks + 8 * fq) * 2); pd[j] = MFMA16(a, bb, pd[j]); } }
#pragma unroll
      for (int j = 0; j < 2; ++j)
#pragma unroll
          for (int r = 0; r < 4; ++r) { const int ii = 16 * mi + 4 * fq + r, jj = 16 * (nj0 + j) + fr; if (DIR ? (jj >= ii) : (jj <= ii)) pacc[j][r] += pd[j][r]; } }
    { bf16* Ug = (bf16*)(F.ws + WS_U) + ((size_t)(DIR * 8 + hh) * NCH + c) * 256 * 128;
      bf16x8 bv[2][2];
#pragma unroll
      for (int nj = 0; nj < 2; ++nj)
#pragma unroll
          for (int ks = 0; ks < 2; ++ks) bv[nj][ks] = *(const LAS bf16x8*)(lds + L1_VT + (32 * w + 16 * nj + fr) * 144 + (32 * ks + 8 * fq) * 2);
#pragma unroll
      for (int P = 0; P < 4; ++P) {
          f32x4 u[2][2] = {{{0.f, 0.f, 0.f, 0.f}, {0.f, 0.f, 0.f, 0.f}}, {{0.f, 0.f, 0.f, 0.f}, {0.f, 0.f, 0.f, 0.f}}};
#pragma unroll
          for (int t = 0; t < 2; ++t)
#pragma unroll
              for (int ks = 0; ks < 2; ++ks) { const bf16x8 a = *(const LAS bf16x8*)(lds + L1_KTT + (32 * P + 8 * (fr >> 2) + 4 * t + (fr & 3)) * 144 + (32 * ks + 8 * fq) * 2);
#pragma unroll
                  for (int nj = 0; nj < 2; ++nj) u[t][nj] = MFMA16(a, bv[nj][ks], u[t][nj]); }
          asm volatile("s_nop 15" : "+v"(u[0][0]), "+v"(u[0][1]), "+v"(u[1][0]), "+v"(u[1][1]));
#pragma unroll
          for (int nj = 0; nj < 2; ++nj) { u32x4 o; o.x = cvt_pk_bf16(u[0][nj][0], u[0][nj][1]); o.y = cvt_pk_bf16(u[0][nj][2], u[0][nj][3]); o.z = cvt_pk_bf16(u[1][nj][0], u[1][nj][1]); o.w = cvt_pk_bf16(u[1][nj][2], u[1][nj][3]);
              *(u32x4*)(Ug + (size_t)(32 * w + 16 * nj + fr) * 128 + 32 * P + 8 * fq) = o; } } }
    __syncthreads();
}

__device__ __forceinline__ void s1_phase(Frame& F, int e) {
    PHASE_IDS(); LAS unsigned char* lds = F.lds; const int w = wave, fr = lane & 15, fq = lane >> 4;
    const bf16* P = (const bf16*)(F.ws + WS_PROJ);
    for (int item = blockIdx.x; item < 8 * NCH; item += F.G) {
        const int c = item >> 3, hh = item & 7, hd = hh & 3, t0 = c * 64; const bool is_gla = hh < 4, lat = c >= 4;
        const int qcol = is_gla ? 128 * hd : 3072 + 128 * hd, kcol = qcol + 512, vcol = is_gla ? 1024 + 256 * hd : 4096 + 256 * hd;
#pragma unroll
        for (int i = 0; i < 2; ++i) { const int id = tid + 512 * i, r = id >> 4, cc = id & 15;
            *(LAS u32x4*)(lds + L1_QRAW + r * 256 + cc * 16) = *(const u32x4*)(P + (size_t)(t0 + r) * EV_N + qcol + cc * 8);
            *(LAS u32x4*)(lds + L1_KRAW + r * 256 + cc * 16) = *(const u32x4*)(P + (size_t)(t0 + r) * EV_N + kcol + cc * 8); }
#pragma unroll
        for (int i = 0; i < 4; ++i) { const int id = tid + 512 * i, r = id & 63, cc = id >> 6;
            const u32x4 v = *(const u32x4*)(P + (size_t)(t0 + r) * EV_N + vcol + cc * 8);
            LAS bf16* vt = (LAS bf16*)(lds + L1_VT) + (cc * 8) * 72 + r;
            vt[0 * 72] = (bf16)(v.x & 0xffff); vt[1 * 72] = (bf16)(v.x >> 16); vt[2 * 72] = (bf16)(v.y & 0xffff); vt[3 * 72] = (bf16)(v.y >> 16);
            vt[4 * 72] = (bf16)(v.z & 0xffff); vt[5 * 72] = (bf16)(v.z >> 16); vt[6 * 72] = (bf16)(v.w & 0xffff); vt[7 * 72] = (bf16)(v.w >> 16); }
        if (is_gla && tid < 256) { const int r = tid >> 2, cc = tid & 3; *(LAS u32x4*)(lds + L1_GD + r * 64 + cc * 16) = *(const u32x4*)(P + (size_t)(t0 + r) * EV_N + 6144 + cc * 8); }
        float wvf[16], wvb[16], bgf = 0.f, bgb = 0.f; f32x2 csv[16];
        { const int ch = tid & 127, tq = tid >> 7;
#pragma unroll
          for (int r = 0; r < 16; ++r) { wvf[r] = 0.f; wvb[r] = 0.f; csv[r] = (f32x2){1.f, 0.f}; }
          if (is_gla) {
              const float* wgf = F.a->in[11] + (size_t)e * 16 * 512 + hd * 128 + ch; const float* wgb = F.a->in[13] + (size_t)e * 16 * 512 + hd * 128 + ch;
#pragma unroll
              for (int r = 0; r < 16; ++r) { wvf[r] = wgf[r * 512]; wvb[r] = wgb[r * 512]; }
              bgf = F.a->in[12][e * 512 + hd * 128 + ch]; bgb = F.a->in[14][e * 512 + hd * 128 + ch];
          } else if (lat) {
              const f32x2* RT = (const f32x2*)(F.ws + WS_RT) + (size_t)(t0 + 16 * tq - NCTX) * 64 + (ch & 63);
#pragma unroll
              for (int r = 0; r < 16; ++r) csv[r] = RT[r * 64];
          } }
        __syncthreads();
        f32x4 pacc[2] = {{0.f, 0.f, 0.f, 0.f}, {0.f, 0.f, 0.f, 0.f}};
        s1_dir<0>(F, e, hh, c, lat, pacc, wvf, bgf, csv);
        s1_dir<1>(F, e, hh, c, lat, pacc, wvb, bgb, csv);
        { const int mi = w >> 1, nj0 = 2 * (w & 1);
#pragma unroll
          for (int j = 0; j < 2; ++j)
#pragma unroll
              for (int r = 0; r < 4; ++r) *(LAS bf16*)(lds + L1_P + (16 * mi + 4 * fq + r) * 144 + (16 * (nj0 + j) + fr) * 2) = f2bf(pacc[j][r]); }
        __syncthreads();
        { float* OI = (float*)(F.ws + WS_OI);
          bf16x8 bv[2][2];
#pragma unroll
          for (int nj = 0; nj < 2; ++nj)
#pragma unroll
              for (int ks = 0; ks < 2; ++ks) bv[nj][ks] = *(const LAS bf16x8*)(lds + L1_VT + (32 * w + 16 * nj + fr) * 144 + (32 * ks + 8 * fq) * 2);
#pragma unroll
          for (int mi = 0; mi < 4; ++mi) {
              f32x4 o[2] = {{0.f, 0.f, 0.f, 0.f}, {0.f, 0.f, 0.f, 0.f}};
#pragma unroll
              for (int ks = 0; ks < 2; ++ks) { const bf16x8 a = *(const LAS bf16x8*)(lds + L1_P + (16 * mi + fr) * 144 + (32 * ks + 8 * fq) * 2);
#pragma unroll
                  for (int nj = 0; nj < 2; ++nj) o[nj] = MFMA16(a, bv[nj][ks], o[nj]); }
#pragma unroll
              for (int nj = 0; nj < 2; ++nj)
#pragma unroll
                  for (int r = 0; r < 4; ++r) ((LAS float*)lds)[(16 * mi + 4 * fq + r) * 260 + 32 * w + 16 * nj + fr] = o[nj][r]; }
          __syncthreads();
#pragma unroll
          for (int i = 0; i < 8; ++i) { const int id = tid + 512 * i, r = id >> 6, cc = id & 63;
              *(f32x4*)(OI + (size_t)(t0 + r) * DM + hh * 256 + cc * 4) = *(const LAS f32x4*)((LAS float*)lds + r * 260 + cc * 4); } }
        __syncthreads();
    }
}

__device__ __forceinline__ void s2_phase(Frame& F) {
    PHASE_IDS();
    const int gt = F.vcu * NTHR + tid, NGT = F.G * NTHR;
    for (int idx = gt; idx < 2 * 8 * 256 * 32; idx += NGT) {
        const int dk4 = idx & 31, ee = (idx >> 5) & 255, dh = idx >> 13, dir = dh >> 3;
        const bf16* U = (const bf16*)(F.ws + WS_U) + (size_t)dh * NCH * 256 * 128 + (size_t)ee * 128 + dk4 * 4;
        bf16* S = (bf16*)(F.ws + WS_S) + (size_t)dh * NCH * 256 * 128 + (size_t)ee * 128 + dk4 * 4;
        const float* D = (const float*)(F.ws + WS_DEC) + (size_t)dh * NCH * 128 + dk4 * 4;
        f32x4 s = {0.f, 0.f, 0.f, 0.f};
#pragma unroll 13
        for (int step = 0; step < NCH; ++step) {
            const int c = dir ? (step < 4 ? 3 - step : NCH + 3 - step) : step;
            const u32x2 uu = *(const u32x2*)(U + (size_t)c * 256 * 128); const f32x4 d = *(const f32x4*)(D + (size_t)c * 128);
            u32x2 so; so.x = cvt_pk_bf16(s.x, s.y); so.y = cvt_pk_bf16(s.z, s.w);
            *(u32x2*)(S + (size_t)c * 256 * 128) = so;
            s.x = d.x * (s.x + bflo(uu.x)); s.y = d.y * (s.y + bfhi(uu.x)); s.z = d.z * (s.z + bflo(uu.y)); s.w = d.w * (s.w + bfhi(uu.y));
        }
    }
}

constexpr int L3_QF = 0, L3_QB = 17408, L3_OL = 34816;
__device__ __forceinline__ void s3_phase(Frame& F, int e) {
    PHASE_IDS(); LAS unsigned char* lds = F.lds; const int w = wave, fr = lane & 15, fq = lane >> 4;
    const bf16* P = (const bf16*)(F.ws + WS_PROJ); const bf16* QTg = (const bf16*)(F.ws + WS_QT); const float* OI = (const float*)(F.ws + WS_OI);
    bf16* MIX = (bf16*)(F.ws + WS_MIX);
    for (int item = blockIdx.x; item < 8 * NCH; item += F.G) {
        const int c = item >> 3, hh = item & 7, hd = hh & 3, t0 = c * 64; const bool is_gla = hh < 4;
        const int gcol = is_gla ? 2048 + 256 * hd : 5120 + 256 * hd;
#pragma unroll
        for (int dir = 0; dir < 2; ++dir)
#pragma unroll
            for (int i = 0; i < 2; ++i) { const int id = tid + 512 * i, r = id >> 4, cc = id & 15;
                *(LAS u32x4*)(lds + (dir ? L3_QB : L3_QF) + r * 272 + cc * 16) = *(const u32x4*)(QTg + (size_t)dir * T * 1024 + (size_t)(t0 + r) * 1024 + hh * 128 + cc * 8); }
        bf16x8 bv[2][4][2];
#pragma unroll
        for (int dir = 0; dir < 2; ++dir) { const bf16* Sg = (const bf16*)(F.ws + WS_S) + ((size_t)(dir * 8 + hh) * NCH + c) * 256 * 128;
#pragma unroll
            for (int ks = 0; ks < 4; ++ks)
#pragma unroll
                for (int nj = 0; nj < 2; ++nj) bv[dir][ks][nj] = *(const bf16x8*)(Sg + (size_t)(32 * w + 16 * nj + fr) * 128 + 32 * ks + 8 * fq); }
        __builtin_amdgcn_sched_barrier(0);
        __syncthreads();
        f32x4 o[4][2];
#pragma unroll
        for (int mi = 0; mi < 4; ++mi)
#pragma unroll
            for (int nj = 0; nj < 2; ++nj) o[mi][nj] = (f32x4){0.f, 0.f, 0.f, 0.f};
#pragma unroll
        for (int dir = 0; dir < 2; ++dir) {
#pragma unroll
            for (int ks = 0; ks < 4; ++ks) {
#pragma unroll
                for (int mi = 0; mi < 4; ++mi) { const bf16x8 a = *(const LAS bf16x8*)(lds + (dir ? L3_QB : L3_QF) + (16 * mi + fr) * 272 + (32 * ks + 8 * fq) * 2);
#pragma unroll
                    for (int nj = 0; nj < 2; ++nj) o[mi][nj] = MFMA16(a, bv[dir][ks][nj], o[mi][nj]); } } }
        LAS float* OL = (LAS float*)(lds + L3_OL);
#pragma unroll
        for (int mi = 0; mi < 4; ++mi)
#pragma unroll
            for (int nj = 0; nj < 2; ++nj)
#pragma unroll
                for (int r = 0; r < 4; ++r) OL[(16 * mi + 4 * fq + r) * 260 + 32 * w + 16 * nj + fr] = o[mi][nj][r];
        __syncthreads();
        { const int tk = tid >> 3, seg = tid & 7;
          f32x4 v[4][2]; float sq = 0.f;
#pragma unroll
          for (int g = 0; g < 4; ++g) { const int ee = 64 * g + 8 * seg; const float* oi = OI + (size_t)(t0 + tk) * DM + hh * 256 + ee;
              v[g][0] = *(const LAS f32x4*)(OL + tk * 260 + ee) + *(const f32x4*)oi; v[g][1] = *(const LAS f32x4*)(OL + tk * 260 + ee + 4) + *(const f32x4*)(oi + 4);
              sq += (v[g][0].x * v[g][0].x + v[g][0].y * v[g][0].y) + (v[g][0].z * v[g][0].z + v[g][0].w * v[g][0].w) + (v[g][1].x * v[g][1].x + v[g][1].y * v[g][1].y) + (v[g][1].z * v[g][1].z + v[g][1].w * v[g][1].w); }
          sq += __shfl_xor(sq, 1); sq += __shfl_xor(sq, 2); sq += __shfl_xor(sq, 4);
          const float rstd = 1.0f / sqrtf(sq * (1.0f / 256.0f) + RMS_EPS);
#pragma unroll
          for (int g = 0; g < 4; ++g) { const int ee = 64 * g + 8 * seg;
              const u32x4 gt = *(const u32x4*)(P + (size_t)(t0 + tk) * EV_N + gcol + ee);
              f32x4 n0 = {1.f, 1.f, 1.f, 1.f}, n1 = {1.f, 1.f, 1.f, 1.f};
              if (is_gla) { n0 = *(const f32x4*)(F.a->in[15] + e * 256 + ee); n1 = *(const f32x4*)(F.a->in[15] + e * 256 + ee + 4); }
              const f32x4 a0 = v[g][0] * rstd * n0, a1 = v[g][1] * rstd * n1;
              u32x4 ow; ow.x = cvt_pk_bf16(a0.x * silu_f(bflo(gt.x)), a0.y * silu_f(bfhi(gt.x))); ow.y = cvt_pk_bf16(a0.z * silu_f(bflo(gt.y)), a0.w * silu_f(bfhi(gt.y)));
              ow.z = cvt_pk_bf16(a1.x * silu_f(bflo(gt.z)), a1.y * silu_f(bfhi(gt.z))); ow.w = cvt_pk_bf16(a1.z * silu_f(bflo(gt.w)), a1.w * silu_f(bfhi(gt.w)));
              *(u32x4*)(MIX + (size_t)(t0 + tk) * DM + hh * 256 + ee) = ow; } }
        __syncthreads();
    }
}

__device__ __forceinline__ void e1_phase(Frame& F, int o) {
    PHASE_IDS();
    const int gw = F.vcu * NWAVES + wave, NGW = F.G * NWAVES;
    const bf16* P = (const bf16*)(F.ws + WS_PROJ); bf16* CQN = (bf16*)(F.ws + WS_CQN); bf16* CKVN = (bf16*)(F.ws + WS_CKVN); bf16* KR = (bf16*)(F.ws + WS_KR);
    const float* wq = F.a->in[18] + o * 512 + lane * 8; const float* wkv = F.a->in[19] + o * 512 + lane * 8;
    const f32x4 wq0 = *(const f32x4*)wq, wq1 = *(const f32x4*)(wq + 4), wk0 = *(const f32x4*)wkv, wk1 = *(const f32x4*)(wkv + 4);
    const f32x2* AXR = (const f32x2*)(F.ws + WS_AXR); const f32x2* AXC = (const f32x2*)(F.ws + WS_AXC);
    for (int t = gw; t < T; t += NGW) {
        const bf16* p = P + (size_t)t * OD_N;
        const u32x4 a = *(const u32x4*)(p + lane * 8), b = *(const u32x4*)(p + 512 + lane * 8);
        float x[8] = {bflo(a.x), bfhi(a.x), bflo(a.y), bfhi(a.y), bflo(a.z), bfhi(a.z), bflo(a.w), bfhi(a.w)};
        float y[8] = {bflo(b.x), bfhi(b.x), bflo(b.y), bfhi(b.y), bflo(b.z), bfhi(b.z), bflo(b.w), bfhi(b.w)};
        float sx = 0.f, sy = 0.f;
#pragma unroll
        for (int j = 0; j < 8; ++j) { sx += x[j] * x[j]; sy += y[j] * y[j]; }
        const float rx = 1.0f / sqrtf(wave_sum(sx) * (1.0f / 512.0f) + RMS_EPS), ry = 1.0f / sqrtf(wave_sum(sy) * (1.0f / 512.0f) + RMS_EPS);
        u32x4 oq, ok;
        oq.x = cvt_pk_bf16(x[0] * rx * wq0.x, x[1] * rx * wq0.y); oq.y = cvt_pk_bf16(x[2] * rx * wq0.z, x[3] * rx * wq0.w); oq.z = cvt_pk_bf16(x[4] * rx * wq1.x, x[5] * rx * wq1.y); oq.w = cvt_pk_bf16(x[6] * rx * wq1.z, x[7] * rx * wq1.w);
        ok.x = cvt_pk_bf16(y[0] * ry * wk0.x, y[1] * ry * wk0.y); ok.y = cvt_pk_bf16(y[2] * ry * wk0.z, y[3] * ry * wk0.w); ok.z = cvt_pk_bf16(y[4] * ry * wk1.x, y[5] * ry * wk1.y); ok.w = cvt_pk_bf16(y[6] * ry * wk1.z, y[7] * ry * wk1.w);
        *(u32x4*)(CQN + (size_t)t * 512 + lane * 8) = oq; *(u32x4*)(CKVN + (size_t)t * 512 + lane * 8) = ok;
        float v = bf2f(p[1024 + lane]); const float pr = __shfl_xor(v, 16);
        if (t >= NCTX) { const int pp = t - NCTX, pos = (lane & 32) ? (pp & 63) : (pp >> 6); const f32x2 cs = ((lane & 32) ? AXC : AXR)[pos * 16 + (lane & 15)];
            v = (lane & 16) ? v * cs.x + pr * cs.y : v * cs.x - pr * cs.y; }
        KR[(size_t)t * 64 + lane] = f2bf(v);
    }
}

namespace att {
constexpr int KVBLK = 64;
constexpr float SCALE = 0.07216878364870322f;
constexpr float THR = 8.f;
constexpr int SHM_K = 64 * 384, SHM_V = 64 * 256;
constexpr int A_V = 0, A_K = 2 * SHM_V, A_WS = 2 * SHM_V + 2 * SHM_K;
#define SBAR() __builtin_amdgcn_sched_barrier(0)
__device__ __forceinline__ int crow(int r, int hi) { return (r & 3) + 8 * (r >> 2) + 4 * hi; }
__device__ __forceinline__ void partialSM(f32x16& p0, f32x16& p1, float& m_reg, float& mn, float& alpha) {
    constexpr float C = SCALE * 1.4426950408889634f;
    float pmax = p0[0];
#pragma unroll
    for (int r = 1; r < 16; ++r) pmax = fmaxf(pmax, p0[r]);
#pragma unroll
    for (int r = 0; r < 16; ++r) pmax = fmaxf(pmax, p1[r]);
    { auto rr = __builtin_amdgcn_permlane32_swap(__float_as_uint(pmax), __float_as_uint(pmax), false, false);
      pmax = fmaxf(__uint_as_float(rr[0]), __uint_as_float(rr[1])); }
    if (__builtin_expect(__all(pmax - m_reg <= THR / SCALE), 1)) { mn = m_reg; alpha = 1.f; }
    else { mn = fmaxf(m_reg, pmax); alpha = __builtin_amdgcn_exp2f((m_reg - mn) * C); m_reg = mn; }
    const float mnC = -mn * C;
#pragma unroll
    for (int r = 0; r < 16; ++r) p0[r] = fmaf(p0[r], C, mnC);
#pragma unroll
    for (int r = 0; r < 16; ++r) p1[r] = fmaf(p1[r], C, mnC);
#pragma unroll
    for (int r = 0; r < 16; ++r) p0[r] = __builtin_amdgcn_exp2f(p0[r]);
}
__device__ __forceinline__ void finishSM(f32x16& p0, f32x16& p1, float alpha, float& l_reg, bf16x8& pa0, bf16x8& pa1, bf16x8& pa2, bf16x8& pa3) {
#pragma unroll
    for (int r = 0; r < 16; ++r) p1[r] = __builtin_amdgcn_exp2f(p1[r]);
    float ps = 0;
#pragma unroll
    for (int r = 0; r < 16; ++r) ps += p0[r];
#pragma unroll
    for (int r = 0; r < 16; ++r) ps += p1[r];
    { auto rr = __builtin_amdgcn_permlane32_swap(__float_as_uint(ps), __float_as_uint(ps), false, false);
      ps = __uint_as_float(rr[0]) + __uint_as_float(rr[1]); }
    l_reg = l_reg * alpha + ps;
#define PK4(P, BASE, OUT) do { unsigned a0 = cvt_pk_bf16(P[BASE + 0], P[BASE + 1]), a1 = cvt_pk_bf16(P[BASE + 2], P[BASE + 3]);   \
    unsigned b0 = cvt_pk_bf16(P[BASE + 4], P[BASE + 5]), b1 = cvt_pk_bf16(P[BASE + 6], P[BASE + 7]);                              \
    auto r0 = __builtin_amdgcn_permlane32_swap(a0, b0, false, false); auto r1 = __builtin_amdgcn_permlane32_swap(a1, b1, false, false); \
    u32x4 w = {r0[0], r1[0], r0[1], r1[1]}; OUT = *reinterpret_cast<bf16x8*>(&w); } while (0)
    PK4(p0, 0, pa0); PK4(p0, 8, pa1); PK4(p1, 0, pa2); PK4(p1, 8, pa3);
#undef PK4
}
__device__ __forceinline__ int kswz(int row, int g) { return row * 384 + (((g & ~7) | ((g & 7) ^ ((row >> 1) & 7))) << 4); }
__device__ __forceinline__ void qkt(f32x16& p0, f32x16& p1, const LAS unsigned char* Ks, const bf16x8 (&qr)[12], const int (&kx)[4]) {
    p0 = f32x16{}; p1 = f32x16{};
    bf16x8 c0 = *(const LAS bf16x8*)(Ks + kx[0]), c1 = *(const LAS bf16x8*)(Ks + kx[0] + 32 * 384), n0, n1;
#pragma unroll
    for (int d0 = 0; d0 < 12; ++d0) {
        if (d0 < 11) { n0 = *(const LAS bf16x8*)(Ks + kx[(d0 + 1) & 3] + ((d0 + 1) >> 2) * 128); n1 = *(const LAS bf16x8*)(Ks + kx[(d0 + 1) & 3] + ((d0 + 1) >> 2) * 128 + 32 * 384); }
        __builtin_amdgcn_sched_barrier(0);
        p0 = MFMA32(c0, qr[d0], p0);
        p1 = MFMA32(c1, qr[d0], p1);
        __builtin_amdgcn_sched_barrier(0);
        c0 = n0; c1 = n1; }
}
__device__ __forceinline__ int v_st(int k, int c) { const int kk = (k & ~0xC) | ((k & 4) << 1) | ((k & 8) >> 1); return ((kk >> 3) * 4 + (c >> 5)) * 512 + ((kk & 7) * 32 + (c & 31)) * 2; }
__device__ __forceinline__ int v_rd_base(int lane) { return ((lane & 3) << 3) | (((lane >> 2) & 3) << 6) | (((lane >> 4) & 1) << 5) | (((lane >> 5) & 1) << 8); }
constexpr int v_rd_off(int d0, int ks, int half) { return d0 * 512 + ks * 4096 + half * 2048; }
template <int OFF> __device__ __forceinline__ s16x4 tr_read(int vb) {
    s16x4 r; asm volatile("ds_read_b64_tr_b16 %0, %1 offset:%2" : "=&v"(r) : "v"(vb), "i"(OFF) : "memory"); return r;
}
template <int D0> __device__ __forceinline__ void pv_one(f32x16& od, int vb, bf16x8 pa0, bf16x8 pa1, bf16x8 pa2, bf16x8 pa3) {
    const s16x4 l0 = tr_read<v_rd_off(D0, 0, 0)>(vb), h0 = tr_read<v_rd_off(D0, 0, 1)>(vb), l1 = tr_read<v_rd_off(D0, 1, 0)>(vb), h1 = tr_read<v_rd_off(D0, 1, 1)>(vb);
    const s16x4 l2 = tr_read<v_rd_off(D0, 2, 0)>(vb), h2 = tr_read<v_rd_off(D0, 2, 1)>(vb), l3 = tr_read<v_rd_off(D0, 3, 0)>(vb), h3 = tr_read<v_rd_off(D0, 3, 1)>(vb);
    asm volatile("s_waitcnt lgkmcnt(0)" ::: "memory"); SBAR();
#define PK(L, H) (bf16x8){L[0], L[1], L[2], L[3], H[0], H[1], H[2], H[3]}
    od = MFMA32(pa0, PK(l0, h0), od);
    od = MFMA32(pa1, PK(l1, h1), od);
    od = MFMA32(pa2, PK(l2, h2), od);
    od = MFMA32(pa3, PK(l3, h3), od);
#undef PK
}
__device__ __forceinline__ void pv_d0(f32x16 (&o)[4], int vb, bf16x8 pa0, bf16x8 pa1, bf16x8 pa2, bf16x8 pa3) {
    pv_one<0>(o[0], vb, pa0, pa1, pa2, pa3); pv_one<1>(o[1], vb, pa0, pa1, pa2, pa3); pv_one<2>(o[2], vb, pa0, pa1, pa2, pa3); pv_one<3>(o[3], vb, pa0, pa1, pa2, pa3);
}
__device__ __forceinline__ void rope_pair(bf16x8& a, bf16x8& b, const f32x2* cs) {
    u32x4 ua = *reinterpret_cast<u32x4*>(&a), ub = *reinterpret_cast<u32x4*>(&b); u32x4 oa, ob;
#pragma unroll
    for (int j = 0; j < 4; ++j) { const f32x2 c0 = cs[2 * j], c1 = cs[2 * j + 1];
        const float x1l = bflo(ua[j]), x1h = bfhi(ua[j]), x2l = bflo(ub[j]), x2h = bfhi(ub[j]);
        oa[j] = cvt_pk_bf16(x1l * c0.x - x2l * c0.y, x1h * c1.x - x2h * c1.y);
        ob[j] = cvt_pk_bf16(x2l * c0.x + x1l * c0.y, x2h * c1.x + x1h * c1.y); }
    a = *reinterpret_cast<bf16x8*>(&oa); b = *reinterpret_cast<bf16x8*>(&ob);
}
__device__ __forceinline__ void unit(Frame& F, int h, int qrow0, int nkeys) {
    LAS unsigned char* lds = F.lds;
    PHASE_IDS(); const int wid = wave, r32 = lane & 31, hi = lane >> 5;
    const bf16* QB = (const bf16*)(F.ws + WS_QB); const bf16* KVB = (const bf16*)(F.ws + WS_KVB); const bf16* KR = (const bf16*)(F.ws + WS_KR);
    LAS unsigned char* V_lds = lds + A_V; LAS unsigned char* K_lds = lds + A_K;
    LAS float* wsl = (LAS float*)(lds + A_WS) + wid * 64; LAS float* li_l = wsl; LAS float* al_l = wsl + 32;
    float m_reg = -1e30f, l_reg = 0; f32x16 o[4] = {}; bf16x8 qr[12];
    const int qt = qrow0 + wid * 32 + r32;
    const bf16* Qw = QB + (size_t)qt * 3072 + 192 * h + hi * 8;
#pragma unroll
    for (int d0 = 0; d0 < 12; ++d0) qr[d0] = *(const bf16x8*)(Qw + d0 * 16);
    if (qt >= NCTX) { const int pp = qt - NCTX;
        rope_pair(qr[8], qr[9], (const f32x2*)(F.ws + WS_AXR) + (pp >> 6) * 16 + hi * 8);
        rope_pair(qr[10], qr[11], (const f32x2*)(F.ws + WS_AXC) + (pp & 63) * 16 + hi * 8); }
    const unsigned char* wsb = F.ws;
    unsigned koff[3], kfl = 0u; int kdst[3];
#pragma unroll
    for (int i = 0; i < 3; ++i) { const int id = tid + 512 * i, row = id / 24, g = id % 24;
        if (g < 16) { koff[i] = (unsigned)WS_KVB + (unsigned)(row * 4096 + 256 * h + g * 8) * 2u; kfl |= 1u << i; } else { koff[i] = (unsigned)WS_KR + (unsigned)(row * 64 + (g - 16) * 8) * 2u; }
        kdst[i] = kswz(row, g); }
    const int sr = tid >> 4, sc = (tid & 15) * 8, vst0 = v_st(sr, sc);
    const unsigned voff = (unsigned)WS_KVB + (unsigned)(sr * 4096 + 256 * h + 128 + sc) * 2u;
    const int vb0 = (int)(unsigned)(uintptr_t)V_lds + v_rd_base(lane);
    int kx[4];
#pragma unroll
    for (int q = 0; q < 4; ++q) kx[q] = r32 * 384 + ((((2 * q) | hi) ^ ((r32 >> 1) & 7)) << 4);
    bf16x8 sk0, sk1, sk2, sv0, sv1;
#define SLOAD(jt) do { const unsigned vo_ = voff + (unsigned)(jt) * (64u * 4096u * 2u); sv0 = *(const bf16x8*)(wsb + vo_); sv1 = *(const bf16x8*)(wsb + vo_ + 32u * 4096u * 2u); \
    const unsigned kt_ = (unsigned)(jt) * 8192u; \
    sk0 = *(const bf16x8*)(wsb + koff[0] + (kt_ << ((kfl & 1u) * 6u))); sk1 = *(const bf16x8*)(wsb + koff[1] + (kt_ << (((kfl >> 1) & 1u) * 6u))); sk2 = *(const bf16x8*)(wsb + koff[2] + (kt_ << (((kfl >> 2) & 1u) * 6u))); } while (0)
#define SWRITE(b) do { *(LAS bf16x8*)(V_lds + (b) * SHM_V + vst0) = sv0; *(LAS bf16x8*)(V_lds + (b) * SHM_V + vst0 + 8192) = sv1; \
    *(LAS bf16x8*)(K_lds + (b) * SHM_K + kdst[0]) = sk0; *(LAS bf16x8*)(K_lds + (b) * SHM_K + kdst[1]) = sk1; *(LAS bf16x8*)(K_lds + (b) * SHM_K + kdst[2]) = sk2; } while (0)
#define SWAIT() asm volatile("s_waitcnt vmcnt(0)" ::: "memory")
#define RESC(a) do { if (__any((a) < 1.f)) { if (hi == 0) al_l[r32] = (a); asm volatile("s_waitcnt lgkmcnt(0)" ::: "memory"); \
    _Pragma("unroll") for (int d = 0; d < 4; ++d) _Pragma("unroll") for (int r = 0; r < 16; ++r) o[d][r] *= al_l[crow(r, hi)]; } } while (0)
    f32x16 p0, p1; float mn, al; bf16x8 pa0, pa1, pa2, pa3; const int NT = nkeys / KVBLK;
#define ABAR() do { asm volatile("s_waitcnt lgkmcnt(0)" ::: "memory"); __builtin_amdgcn_s_barrier(); asm volatile("" ::: "memory"); } while (0)
#define ASTAGE(j) do { if ((j) + 1 < NT) { SWAIT(); SWRITE(((j) & 1) ^ 1); } if ((j) + 2 < NT) SLOAD((j) + 2); } while (0)
#define AQK(j) do { SBAR(); qkt(p0, p1, K_lds + ((j) & 1) * SHM_K, qr, kx); SBAR(); partialSM(p0, p1, m_reg, mn, al); } while (0)
#define ASP(j) do { RESC(al); finishSM(p0, p1, al, l_reg, pa0, pa1, pa2, pa3); SBAR(); pv_d0(o, vb0 + ((j) & 1) * SHM_V, pa0, pa1, pa2, pa3); } while (0)
    SLOAD(0); SWAIT(); SWRITE(0); SLOAD(1); ABAR();
    if ((wid >> 2) == 0) {
        for (int j = 0; j < NT; ++j) { AQK(j); ABAR(); ASTAGE(j); ASP(j); ABAR(); }
        ABAR();
    } else {
        ABAR();
        for (int j = 0; j < NT; ++j) { ASTAGE(j); AQK(j); ABAR(); ASP(j); ABAR(); }
    }
#undef ABAR
#undef ASTAGE
#undef AQK
#undef ASP
    if (hi == 0) li_l[r32] = l_reg; asm volatile("s_waitcnt lgkmcnt(0)" ::: "memory");
    float rli[16];
#pragma unroll
    for (int r = 0; r < 16; ++r) rli[r] = __builtin_amdgcn_rcpf(li_l[crow(r, hi)]);
    unsigned orow0 = (unsigned)(qrow0 + wid * 32) * DM + 128 * h; asm volatile("" : "+v"(orow0));
    bf16* Ow = (bf16*)(F.ws + WS_MIX) + orow0;
#pragma unroll
    for (int r = 0; r < 16; ++r) { const int orow = crow(r, hi);
#pragma unroll
        for (int d0 = 0; d0 < 4; ++d0) Ow[(size_t)orow * DM + d0 * 32 + r32] = f2bf(o[d0][r] * rli[r]); }
    __syncthreads();
#undef SLOAD
#undef SWRITE
#undef SWAIT
#undef RESC
}
}

__device__ __forceinline__ void attn_phase(Frame& F) {
    for (int u = F.vcu; u < 1024 + 16; u += F.G) {
        if (u < 1024) att::unit(F, u >> 6, NCTX + 256 * (u & 63), T);
        else att::unit(F, u - 1024, 0, NCTX);
    }
}

#ifdef DBG
constexpr int DBG_W_BAD = 64, DBG_W_SSQ = 65, DBG_W_CNT = 66, DBG_W_MAX = 67;
__device__ __forceinline__ void dbg_scan(Frame& F, int id, size_t off, size_t nbytes, bool is_bf) {
    PHASE_IDS();
    const u32x4* p = (const u32x4*)(F.ws + off); const size_t n = nbytes / 16; bool bad = false;
    for (size_t i = (size_t)F.vcu * NTHR + tid; i < n; i += (size_t)F.G * NTHR) { const u32x4 v = p[i];
#pragma unroll
        for (int j = 0; j < 4; ++j) { if (is_bf) { bad |= ((v[j] & 0x7f80u) == 0x7f80u) | ((v[j] & 0x7f800000u) == 0x7f800000u); } else bad |= ((v[j] & 0x7f800000u) == 0x7f800000u); } }
    if (__any(bad) && lane == 0) atomicMax((unsigned*)(F.ws + WS_CTL) + DBG_W_BAD, (unsigned)(100000 - id));
}
__device__ __forceinline__ void dbg_max(Frame& F, size_t off, size_t nbytes, bool is_bf) {
    PHASE_IDS();
    const u32x4* p = (const u32x4*)(F.ws + off); const size_t n = nbytes / 16; unsigned mx = 0u;
    for (size_t i = (size_t)F.vcu * NTHR + tid; i < n; i += (size_t)F.G * NTHR) { const u32x4 v = p[i];
#pragma unroll
        for (int j = 0; j < 4; ++j) { if (is_bf) { const unsigned a0 = (v[j] << 16) & 0x7fffffffu, a1 = v[j] & 0x7fff0000u; if (a0 < 0x7f800000u) mx = max(mx, a0); if (a1 < 0x7f800000u) mx = max(mx, a1); } else { const unsigned a0 = v[j] & 0x7fffffffu; if (a0 < 0x7f800000u) mx = max(mx, a0); } } }
#pragma unroll
    for (int o = 1; o < 64; o <<= 1) mx = max(mx, (unsigned)__shfl_xor((int)mx, o));
    if (lane == 0) atomicMax((unsigned*)(F.ws + WS_CTL) + DBG_W_MAX, mx);
}
#define DBGSCAN(id, off, nbytes, isbf) dbg_scan(F, (id), (off), (nbytes), (isbf))
#else
#define DBGSCAN(id, off, nbytes, isbf) do {} while (0)
#endif

#ifndef RES_ALIGN
#define RES_ALIGN true
#endif
#ifndef RES_SP2
#define RES_SP2 true
#endif
__global__ void __launch_bounds__(NTHR, 2) fwd_kernel(Args args) {
    extern __shared__ __attribute__((aligned(16))) unsigned char lds_raw[];
    Frame F;
    F.lds = (LAS unsigned char*)lds_raw;
    F.G = gridDim.x; { const int bx = blockIdx.x; F.vcu = (F.G % 8 == 0) ? (bx % 8) * (F.G / 8) + bx / 8 : bx; }
    F.a = &args; F.ws = args.ws;
    volatile LAS unsigned* ctlw = (volatile LAS unsigned*)(F.lds + LDS_CTL);
    if (threadIdx.x < 16) ctlw[threadIdx.x] = 0u;
    __syncthreads();
    XcdBarrier bar = xcd_barrier_post((unsigned*)(F.ws + WS_CTL) + 4096, ctlw);
#define GRID_BAR() xcd_barrier(bar)
#ifdef DBG_TIME
    unsigned long long t_prev = __builtin_amdgcn_s_memrealtime();
#define TSTAMP(cat) do { if (blockIdx.x == 0 && threadIdx.x == 0) { const unsigned long long t_now = __builtin_amdgcn_s_memrealtime(); unsigned long long* tw = (unsigned long long*)(F.ws + WS_CTL) + 64 + (cat); *tw = *tw + (t_now - t_prev); t_prev = t_now; } } while (0)
#else
#define TSTAMP(cat) do {} while (0)
#endif

#ifndef SK_P0
    p0a(F);
#ifdef DUP_P0
    p0a(F);
#endif
#endif
    GRID_BAR();
    p0b(F); GRID_BAR();
    DBGSCAN(1, WS_MOD, (size_t)4 * 2 * NADA * 4, false);
    init_x_by_owners(F);
    row_phase<0>(F, nullptr, nullptr, modp(F, 0, 0, 0), modp(F, 0, 0, 1), modp(F, 0, 1, 0), modp(F, 0, 1, 1)); GRID_BAR(); TSTAMP(0);
    DBGSCAN(2, WS_X, (size_t)T * DM * 4, false); DBGSCAN(3, WS_H, (size_t)T * DM * 2, true);

    const pg8::bf16_t* Hb = (const pg8::bf16_t*)(F.ws + WS_H);
    for (int s = 0; s < 3 * DEPTH; ++s) {
        const int l = s / 3, r = s % 3;
        const pg8::bf16_t* A2; const pg8::bf16_t* B2; int K2;
        if (r != 1) {
            const int f = r >> 1;
            pg8::Gemm g{Hb, (const pg8::bf16_t*)(F.ws + WS_WFI + (size_t)(l * 2 + f) * SZ_WFI), T, 2 * DFF, DM, DM, DM};
            pg8::StaticOrder S; S.init(T, 2 * DFF, F.G, (int)blockIdx.x);
            pg8::EpiSwiGLU E{(pg8::bf16_t*)(F.ws + WS_HID), DFF};
#ifndef SK_SW
            pg8::gemm_phase<pg8::EpiSwiGLU, pg8::StaticOrder>(F.lds, g, S, E);
#endif
#ifdef DUP_SW
            pg8::gemm_phase<pg8::EpiSwiGLU, pg8::StaticOrder>(F.lds, g, S, E);
#endif
            GRID_BAR(); TSTAMP(1);
            DBGSCAN(10 + 10 * s, WS_HID, (size_t)T * DFF * 2, true);
            A2 = (const pg8::bf16_t*)(F.ws + WS_HID); B2 = (const pg8::bf16_t*)(F.ws + WS_WFO + (size_t)(l * 2 + f) * SZ_WFO); K2 = DFF;
        } else if ((l & 1) == 0) {
            const int e = l >> 1;
            { pg8::Gemm g{Hb, (const pg8::bf16_t*)(F.ws + WS_EWI + (size_t)e * SZ_EWI), T, EV_N, DM, DM, DM};
              pg8::StaticOrder S; S.init(T, EV_N, F.G, (int)blockIdx.x);
              pg8::EpiBf16 E{(pg8::bf16_t*)(F.ws + WS_PROJ), EV_N};
#ifndef SK_G1
              pg8::gemm_phase<pg8::EpiBf16, pg8::StaticOrder>(F.lds, g, S, E);
#endif
            }
            GRID_BAR(); TSTAMP(4);
            DBGSCAN(10 + 10 * s, WS_PROJ, (size_t)T * EV_N * 2 - 0, true);
#ifdef DBG
            if (s == 1) dbg_max(F, WS_PROJ, (size_t)T * EV_N * 2, true);
#endif
#ifndef SK_S1
            s1_phase(F, e);
#ifdef DUP_S1
            s1_phase(F, e);
#endif
#endif
            GRID_BAR(); TSTAMP(5);
            DBGSCAN(11 + 10 * s, WS_U, SZ_U, true); DBGSCAN(16 + 10 * s, WS_OI, (size_t)T * DM * 4, false); DBGSCAN(17 + 10 * s, WS_QT, (size_t)2 * T * 1024 * 2, true); DBGSCAN(18 + 10 * s, WS_DEC, (size_t)2 * 8 * NCH * 128 * 4, false);
#ifndef SK_S2
            s2_phase(F);
#ifdef DUP_S2
            s2_phase(F);
#endif
#endif
            GRID_BAR(); TSTAMP(6);
            DBGSCAN(12 + 10 * s, WS_S, SZ_U, true);
#ifndef SK_S3
            s3_phase(F, e);
#ifdef DUP_S3
            s3_phase(F, e);
#endif
#endif
            GRID_BAR(); TSTAMP(7);
            DBGSCAN(13 + 10 * s, WS_MIX, (size_t)T * DM * 2, true);
            A2 = (const pg8::bf16_t*)(F.ws + WS_MIX); B2 = (const pg8::bf16_t*)(F.ws + WS_EWO + (size_t)e * SZ_SQ); K2 = DM;
        } else {
            const int o = l >> 1;
            { pg8::Gemm g{Hb, (const pg8::bf16_t*)(F.ws + WS_OWI + (size_t)o * SZ_OWI), T, OD_N, DM, DM, DM};
              pg8::StaticOrder S; S.init(T, OD_N, F.G, (int)blockIdx.x);
              pg8::EpiBf16 E{(pg8::bf16_t*)(F.ws + WS_PROJ), OD_N};
#ifndef SK_G2
              pg8::gemm_phase<pg8::EpiBf16, pg8::StaticOrder>(F.lds, g, S, E);
#endif
            }
            GRID_BAR();
#ifndef SK_E1
            e1_phase(F, o);
#endif
            GRID_BAR();
            DBGSCAN(11 + 10 * s, WS_CQN, (size_t)T * 512 * 2 * 2, true); DBGSCAN(11 + 10 * s, WS_KR, (size_t)T * 64 * 2, true);
            for (int q = 0; q < 2; ++q) {
                pg8::Gemm g{(const pg8::bf16_t*)(F.ws + (q ? WS_CKVN : WS_CQN)), (const pg8::bf16_t*)(F.ws + (q ? WS_OUKV + (size_t)o * SZ_OUKV : WS_OUQ + (size_t)o * SZ_OUQ)), T, q ? 4096 : 3072, 512, 512, 512};
                pg8::StaticOrder S; S.init(T, g.N, F.G, (int)blockIdx.x);
                pg8::EpiBf16 E{(pg8::bf16_t*)(F.ws + (q ? WS_KVB : WS_QB)), g.N};
#ifndef SK_G3
                pg8::gemm_phase<pg8::EpiBf16, pg8::StaticOrder>(F.lds, g, S, E);
#endif
            }
            GRID_BAR(); TSTAMP(8);
            DBGSCAN(12 + 10 * s, WS_QB, (size_t)T * 3072 * 2, true); DBGSCAN(12 + 10 * s, WS_KVB, (size_t)T * 4096 * 2, true);
#ifndef SK_ATT
            attn_phase(F);
#ifdef DUP_ATT
            attn_phase(F);
#endif
#endif
            GRID_BAR(); TSTAMP(9);
            DBGSCAN(13 + 10 * s, WS_MIX, (size_t)T * DM * 2, true);
            A2 = (const pg8::bf16_t*)(F.ws + WS_MIX); B2 = (const pg8::bf16_t*)(F.ws + WS_OWO + (size_t)o * SZ_SQ); K2 = DM;
        }
        {
            pg8::Gemm g{A2 + (size_t)NCTX * K2, B2, NLAT, DM, K2, K2, K2};
            pg8::StaticOrder S; S.init(NLAT, DM, F.G, (int)blockIdx.x);
            const int sp = s > 0 ? s - 1 : 0;
            const float* plng = F.a->in[6] + (size_t)sp * DM; const float* plnb = F.a->in[7] + (size_t)sp * DM; const float* stat = (const float*)(F.ws + WS_STAT);
            pg8::EpiResid E{(float*)(F.ws + WS_X) + (size_t)NCTX * DM, modp(F, l, 0, 3 * r + 2), (r != 1) ? 0.5f : 1.0f, stat + (size_t)NCTX * 2, plng, plnb, s > 0 ? 1 : 0};
            ctx_resid_small(F, (float*)(F.ws + WS_X), (const bf16*)A2, (const bf16*)B2, K2, modp(F, l, 1, 3 * r + 2), (r != 1) ? 0.5f : 1.0f, stat, plng, plnb, s > 0 ? 1 : 0, 1);
#ifndef SK_RES
            pg8::gemm_phase<pg8::EpiResid, pg8::StaticOrder, RES_ALIGN, RES_SP2>(F.lds, g, S, E);
#endif
            ctx_resid_small(F, (float*)(F.ws + WS_X), (const bf16*)A2, (const bf16*)B2, K2, modp(F, l, 1, 3 * r + 2), (r != 1) ? 0.5f : 1.0f, stat, plng, plnb, s > 0 ? 1 : 0, 0);
#ifdef DUP_SMALL_OFF
            ctx_resid_small(F, (float*)(F.ws + WS_OI), (const bf16*)A2, (const bf16*)B2, K2, modp(F, l, 1, 3 * r + 2), (r != 1) ? 0.5f : 1.0f);
            ctx_resid_small(F, (float*)(F.ws + WS_OI), (const bf16*)A2, (const bf16*)B2, K2, modp(F, l, 1, 3 * r + 2), (r != 1) ? 0.5f : 1.0f);
#endif
#ifdef DUP_RES
            { pg8::EpiResid E2{(float*)(F.ws + WS_OI) + (size_t)NCTX * DM, modp(F, l, 0, 3 * r + 2), 0.5f, stat, plng, plnb, 0};
              pg8::gemm_phase<pg8::EpiResid, pg8::StaticOrder>(F.lds, g, S, E2); }
#endif
        }
        GRID_BAR(); TSTAMP(r != 1 ? 2 : 10);
        DBGSCAN(14 + 10 * s, WS_X, (size_t)T * DM * 4, false);
        const float* lng = F.a->in[6] + (size_t)(l * 3 + r) * DM; const float* lnb = F.a->in[7] + (size_t)(l * 3 + r) * DM;
        if (s + 1 < 3 * DEPTH) { const int l2 = (s + 1) / 3, r2 = (s + 1) % 3;
            row_phase<1>(F, lng, lnb, modp(F, l2, 0, 3 * r2), modp(F, l2, 0, 3 * r2 + 1), modp(F, l2, 1, 3 * r2), modp(F, l2, 1, 3 * r2 + 1));
            GRID_BAR(); TSTAMP(3);
            DBGSCAN(15 + 10 * s, WS_X, (size_t)T * DM * 4, false); DBGSCAN(15 + 10 * s, WS_H, (size_t)T * DM * 2, true);
#if defined(DBG) && defined(DBG_STOP)
            if (s == DBG_STOP) break;
#endif
        } else {
#ifndef DBG
            row_phase<2>(F, lng, lnb, nullptr, nullptr, nullptr, nullptr);
#endif
        }
    }
#ifdef DBG_TIME
    {   PHASE_IDS(); GRID_BAR();
        const unsigned long long* tw = (const unsigned long long*)(F.ws + WS_CTL) + 64;
        const float tA = (float)__hip_atomic_load(tw + DBG_TA, RLX_AGENT) * 1e-5f, tB = (float)__hip_atomic_load(tw + DBG_TB, RLX_AGENT) * 1e-5f;
        const float cB = DBG_TSCALE * tB, cA = cB; (void)tA;
        float* out = F.a->out;
        for (size_t i = (size_t)F.vcu * NTHR + tid; i < (size_t)NLAT * DM; i += (size_t)F.G * NTHR) out[i] = (i == 12345) ? cA : cB;
    }
#endif
#ifdef DBG
    {
        PHASE_IDS();
        const float* X = (const float*)(F.ws + WS_X); float ssq = 0.f; float cnt = 0.f;
        for (size_t i = (size_t)F.vcu * NTHR + tid; i < (size_t)T * DM; i += (size_t)F.G * NTHR) { const float v = X[i]; if ((__float_as_uint(v) & 0x7f800000u) != 0x7f800000u) { ssq += v * v; cnt += 1.f; } }
        ssq = wave_sum(ssq); cnt = wave_sum(cnt);
        if (lane == 0) { atomicAdd((float*)(F.ws + WS_CTL) + DBG_W_SSQ, ssq); atomicAdd((float*)(F.ws + WS_CTL) + DBG_W_CNT, cnt); }
        GRID_BAR();
        const unsigned badw = __hip_atomic_load((unsigned*)(F.ws + WS_CTL) + DBG_W_BAD, RLX_AGENT);
        const float tss = __hip_atomic_load((float*)(F.ws + WS_CTL) + DBG_W_SSQ, RLX_AGENT), tcn = __hip_atomic_load((float*)(F.ws + WS_CTL) + DBG_W_CNT, RLX_AGENT);
        const float rms = sqrtf(tss / fmaxf(tcn, 1.f)); float cB = fminf(10.f * rms, 1000.f);
#ifdef DBG_REPORT_MAX
        { const unsigned mw = __hip_atomic_load((unsigned*)(F.ws + WS_CTL) + DBG_W_MAX, RLX_AGENT); cB = fminf(log2f(1.0f + __uint_as_float(mw)), 120.f); }
#endif
        const float cA = badw ? (float)(100000u - badw) * 10.f : 5.f;
        float* out = F.a->out;
        for (size_t i = (size_t)F.vcu * NTHR + tid; i < (size_t)NLAT * DM; i += (size_t)F.G * NTHR) out[i] = (i == 12345) ? cA + 0.f : cB;
        (void)cA;
    }
#endif
}

extern "C" void kernel_launch(void* const* d_in, const int* in_sizes, int n_in, void* d_out, int out_size, void* d_ws, size_t ws_size, hipStream_t stream) {
    static int grid = 0;
    if (grid == 0) {
        if (n_in != 23 || out_size != NLAT * DM || ws_size < WS_END) { fprintf(stderr, "kernel_launch: unexpected shapes: n_in %d out %d ws %zu (need %zu)\n", n_in, out_size, ws_size, (size_t)WS_END); grid = -1; return; }
        int dev = 0, cus = 0, per_cu = 0;
        if (hipGetDevice(&dev) != hipSuccess || hipDeviceGetAttribute(&cus, hipDeviceAttributeMultiprocessorCount, dev) != hipSuccess) { grid = -1; return; }
        if (hipFuncSetAttribute((const void*)fwd_kernel, hipFuncAttributeMaxDynamicSharedMemorySize, LDS_BYTES) != hipSuccess) { fprintf(stderr, "kernel_launch: hipFuncSetAttribute failed\n"); grid = -1; return; }
        if (hipOccupancyMaxActiveBlocksPerMultiprocessor(&per_cu, (const void*)fwd_kernel, NTHR, LDS_BYTES) != hipSuccess || per_cu < 1) fprintf(stderr, "kernel_launch: occupancy query reports %d\n", per_cu);
        (void)hipGetLastError();
        grid = cus;
    }
    if (grid < 0) return;
    (void)hipMemsetAsync((char*)d_ws + WS_CTL, 0, CTL_BYTES, stream);
    Args a{};
    for (int i = 0; i < 23; ++i) a.in[i] = (const float*)d_in[i];
    a.out = (float*)d_out; a.ws = (unsigned char*)d_ws;
    hipLaunchKernelGGL(fwd_kernel, dim3(grid), dim3(NTHR), LDS_BYTES, stream, a);
    const hipError_t le = hipPeekAtLastError();
    if (le != hipSuccess) fprintf(stderr, "kernel_launch: launch failed: %s\n", hipGetErrorName(le));
}
```

```cpp
#include <hip/hip_runtime.h>
#include <cstdio>
#include <cstdint>

#define GAS __attribute__((address_space(1)))
#define LAS __attribute__((address_space(3)))
typedef unsigned short bf16;
typedef short bf16x8 __attribute__((ext_vector_type(8)));
typedef short s16x4 __attribute__((ext_vector_type(4)));
typedef float f32x4 __attribute__((ext_vector_type(4)));
typedef float f32x2 __attribute__((ext_vector_type(2)));
typedef float f32x16 __attribute__((ext_vector_type(16)));
typedef unsigned u32x4 __attribute__((ext_vector_type(4)));
typedef unsigned u32x2 __attribute__((ext_vector_type(2)));

constexpr int DM = 2048, NCTX = 256, NLAT = 16384, T = NCTX + NLAT, DEPTH = 4, DFF = 5504;
constexpr int NADA = 9 * DM;
constexpr int EV_N = 6400, OD_N = 1280;
constexpr int NCH = T / 64;
constexpr float DN_ALPHA = 1.6817928305074290f;
constexpr float LN_EPS = 1e-5f, RMS_EPS = 1e-6f;
constexpr int NWAVES = 8, NTHR = 512;
constexpr int LDS_BYTES = 147456;
constexpr int LDS_CTL = LDS_BYTES - 256;

constexpr size_t al256(size_t x) { return (x + 255) / 256 * 256; }
constexpr size_t WS_CTL = 0, CTL_BYTES = 1u << 20;
constexpr size_t WS_MODP = WS_CTL + CTL_BYTES;
constexpr size_t WS_MOD = WS_MODP + al256((size_t)8 * 2 * 4 * NADA * 4);
constexpr size_t WS_RT = WS_MOD + al256((size_t)4 * 2 * NADA * 4);
constexpr size_t WS_AXR = WS_RT + al256((size_t)NLAT * 64 * 8);
constexpr size_t WS_AXC = WS_AXR + al256(256 * 16 * 8);
constexpr size_t WS_STAT = WS_AXC + al256(64 * 16 * 8);
constexpr size_t WS_WFI = WS_STAT + al256((size_t)T * 8);
constexpr size_t SZ_WFI = (size_t)2 * DFF * DM * 2;
constexpr size_t WS_WFO = WS_WFI + 8 * SZ_WFI;
constexpr size_t SZ_WFO = (size_t)DM * DFF * 2;
constexpr size_t WS_EWI = WS_WFO + 8 * SZ_WFO;
constexpr size_t SZ_EWI = (size_t)EV_N * DM * 2;
constexpr size_t WS_EWO = WS_EWI + 2 * SZ_EWI;
constexpr size_t SZ_SQ = (size_t)DM * DM * 2;
constexpr size_t WS_OWI = WS_EWO + 2 * SZ_SQ;
constexpr size_t SZ_OWI = (size_t)OD_N * DM * 2;
constexpr size_t WS_OUQ = WS_OWI + 2 * SZ_OWI;
constexpr size_t SZ_OUQ = (size_t)3072 * 512 * 2;
constexpr size_t WS_OUKV = WS_OUQ + 2 * SZ_OUQ;
constexpr size_t SZ_OUKV = (size_t)4096 * 512 * 2;
constexpr size_t WS_OWO = WS_OUKV + 2 * SZ_OUKV;
constexpr size_t WS_X = WS_OWO + 2 * SZ_SQ;
constexpr size_t WS_H = WS_X + (size_t)T * DM * 4;
constexpr size_t WS_HID = WS_H + (size_t)T * DM * 2;
constexpr size_t WS_MIX = WS_HID + (size_t)T * DFF * 2;
constexpr size_t WS_PROJ = WS_MIX + (size_t)T * DM * 2;
constexpr size_t WS_U = WS_PROJ + (size_t)T * EV_N * 2;
constexpr size_t SZ_U = (size_t)2 * 8 * NCH * 256 * 128 * 2;
constexpr size_t WS_S = WS_U + SZ_U;
constexpr size_t WS_OI = WS_S + SZ_U;
constexpr size_t WS_QT = WS_OI + (size_t)T * DM * 4;
constexpr size_t WS_DEC = WS_QT + (size_t)2 * T * 1024 * 2;
constexpr size_t WS_END_EVEN = WS_DEC + al256((size_t)2 * 8 * NCH * 128 * 4);
constexpr size_t WS_CQN = WS_U;
constexpr size_t WS_CKVN = WS_CQN + (size_t)T * 512 * 2;
constexpr size_t WS_KR = WS_CKVN + (size_t)T * 512 * 2;
constexpr size_t WS_QB = WS_KR + al256((size_t)T * 64 * 2);
constexpr size_t WS_KVB = WS_QB + (size_t)T * 3072 * 2;
constexpr size_t WS_END_ODD = WS_KVB + (size_t)T * 4096 * 2;
constexpr size_t WS_END = WS_END_EVEN > WS_END_ODD ? WS_END_EVEN : WS_END_ODD;

#define RLX_AGENT __ATOMIC_RELAXED, __HIP_MEMORY_SCOPE_AGENT
#define LDS_WAIT() asm volatile("s_waitcnt lgkmcnt(0)" ::: "memory")
#define VM_WAIT() asm volatile("s_waitcnt vmcnt(0)" ::: "memory")
__device__ __forceinline__ unsigned cvt_pk_bf16(float lo, float hi) { unsigned r; asm volatile("v_cvt_pk_bf16_f32 %0, %1, %2" : "=v"(r) : "v"(lo), "v"(hi)); return r; }
__device__ __forceinline__ float bflo(unsigned w) { return __uint_as_float(w << 16); }
__device__ __forceinline__ float bfhi(unsigned w) { return __uint_as_float(w & 0xffff0000u); }
__device__ __forceinline__ float bf2f(bf16 b) { return __uint_as_float(((unsigned)b) << 16); }
__device__ __forceinline__ bf16 f2bf(float f) { return (bf16)(cvt_pk_bf16(f, 0.f) & 0xffffu); }
__device__ __forceinline__ float wave_sum(float v) {
#pragma unroll
    for (int o = 1; o < 64; o <<= 1) v += __shfl_xor(v, o);
    return v;
}
__device__ __forceinline__ float silu_f(float g) { return g * __builtin_amdgcn_rcpf(1.0f + __builtin_amdgcn_exp2f(-1.4426950408889634f * g)); }

namespace pg8 {
#define PG8_LAS __attribute__((address_space(3)))
typedef unsigned short bf16_t;
constexpr int BM = 256, BK = 64, HALF = 128, HTB = HALF * BK * 2, STAGE_BYTES = 8 * HTB, NXCD = 8, WGM = 8;
__host__ __device__ __forceinline__ int lds_byte(int r, int c) { const int st = (r >> 4) * 2 + (c >> 5), rr = r & 15, cc = c & 31, ob = rr * 64 + cc * 2; return st * 1024 + (ob ^ (((ob >> 9) & 1) << 5)); }
__host__ __device__ __forceinline__ void stage_rc(int b, int& R, int& C) { const int st = b / 1024, sb = b % 1024, swz = sb ^ (((sb >> 9) & 1) << 5); R = (st >> 1) * 16 + swz / 64; C = (st & 1) * 32 + (swz % 64) / 2; }
__host__ __device__ __forceinline__ int perm32(int rho) { const int n = rho >> 4, i = rho & 15; return 8 * (i >> 2) + 4 * n + (i & 3); }
struct Unit { int pm, pn; };
struct Gemm { const bf16_t* A; const bf16_t* Bt; int M, N, K, lda, ldb; };
struct StaticOrder {
    int nM, nN, nwg, G, c;
    __host__ __device__ void init(int M, int N, int G_, int c_) { nM = M / BM; nN = N / BM; nwg = nM * nN; G = G_; c = c_; }
    __host__ __device__ bool next(int i, Unit& u) const {
        const long L = (long)i * G + c; if (L >= nwg) return false;
        int wgid = (int)L; { const int q = nwg / NXCD, r = nwg % NXCD, xcd = wgid % NXCD, off = wgid / NXCD; wgid = (xcd < r ? xcd * (q + 1) : r * (q + 1) + (xcd - r) * q) + off; }
        const int nig = WGM * nN, gid = wgid / nig, fm = gid * WGM, gsz = (nM - fm) < WGM ? (nM - fm) : WGM;
        u.pm = fm + ((wgid % nig) % gsz); u.pn = (wgid % nig) / gsz; return true;
    }
    __device__ __forceinline__ void a_ready(const Unit&) const {}
    __device__ __forceinline__ void done(const Unit&) const {}
};
struct EpiBf16 {
    static constexpr bool PERM = true;
    bf16_t* O; int ldc;
    __device__ __forceinline__ void operator()(const f32x4 (&acc)[2][2][4][2], const Unit& u, int wr, int wc, int fr, int fq) const {
        const int row0 = u.pm * BM + wr * 64 + fr, col0 = u.pn * BM + wc * 32 + 8 * fq;
        asm volatile("s_nop 15" ::: "memory");
#pragma unroll
        for (int ai = 0; ai < 2; ++ai)
#pragma unroll
            for (int m = 0; m < 4; ++m) { bf16_t* rowp = O + (size_t)(row0 + ai * HALF + m * 16) * ldc + col0;
#pragma unroll
                for (int bj = 0; bj < 2; ++bj) { const f32x4 v0 = acc[ai][bj][m][0], v1 = acc[ai][bj][m][1];
                    u32x4 w; w.x = cvt_pk_bf16(v0[0], v0[1]); w.y = cvt_pk_bf16(v0[2], v0[3]); w.z = cvt_pk_bf16(v1[0], v1[1]); w.w = cvt_pk_bf16(v1[2], v1[3]);
                    *(u32x4*)(rowp + bj * HALF) = w; } }
    }
};
struct EpiSwiGLU {
    static constexpr bool PERM = true;
    bf16_t* O; int ldc;
    __device__ __forceinline__ void operator()(const f32x4 (&acc)[2][2][4][2], const Unit& u, int wr, int wc, int fr, int fq) const {
        const int row0 = u.pm * BM + wr * 64 + fr, col0 = u.pn * HALF + wc * 32 + 8 * fq;
#pragma unroll
        for (int ai = 0; ai < 2; ++ai)
#pragma unroll
            for (int m = 0; m < 4; ++m) { bf16_t* rowp = O + (size_t)(row0 + ai * HALF + m * 16) * ldc + col0;
                float h[8];
#pragma unroll
                for (int n = 0; n < 2; ++n)
#pragma unroll
                    for (int j = 0; j < 4; ++j) h[n * 4 + j] = silu_f(acc[ai][0][m][n][j]) * acc[ai][1][m][n][j];
                u32x4 w; w.x = cvt_pk_bf16(h[0], h[1]); w.y = cvt_pk_bf16(h[2], h[3]); w.z = cvt_pk_bf16(h[4], h[5]); w.w = cvt_pk_bf16(h[6], h[7]);
                *(u32x4*)rowp = w; asm volatile("" ::: "memory"); }
    }
};
struct EpiResid {
    static constexpr bool PERM = true;
    float* X; const float* gv; float gs; const float* stat; const float* lng; const float* lnb; int has_ln;
    __device__ __forceinline__ void operator()(const f32x4 (&acc)[2][2][4][2], const Unit& u, int wr, int wc, int fr, int fq) const {
        const int row0 = u.pm * BM + wr * 64 + fr, col0 = u.pn * BM + wc * 32 + 8 * fq;
        f32x2 st[2][4];
#pragma unroll
        for (int ai = 0; ai < 2; ++ai)
#pragma unroll
            for (int m = 0; m < 4; ++m) { st[ai][m] = has_ln ? *(const f32x2*)(stat + (size_t)(row0 + ai * HALF + m * 16) * 2) : (f32x2){0.f, 1.f}; st[ai][m].y *= DN_ALPHA; }
#pragma unroll
        for (int bj = 0; bj < 2; ++bj) { const int c = col0 + bj * HALF;
            f32x4 g[2], G[2], B[2];
#pragma unroll
            for (int n = 0; n < 2; ++n) { g[n] = *(const f32x4*)(gv + c + 4 * n) * gs;
                G[n] = has_ln ? *(const f32x4*)(lng + c + 4 * n) : (f32x4){1.f, 1.f, 1.f, 1.f}; B[n] = has_ln ? *(const f32x4*)(lnb + c + 4 * n) * DN_ALPHA : (f32x4){0.f, 0.f, 0.f, 0.f}; }
#pragma unroll
            for (int ai = 0; ai < 2; ++ai)
#pragma unroll
                for (int m = 0; m < 4; ++m) { float* p = X + (size_t)(row0 + ai * HALF + m * 16) * DM + c;
                    const f32x4 z0 = *(const f32x4*)p, z1 = *(const f32x4*)(p + 4);
                    *(f32x4*)p = (z0 - st[ai][m].x) * st[ai][m].y * G[0] + B[0] + g[0] * acc[ai][bj][m][0];
                    *(f32x4*)(p + 4) = (z1 - st[ai][m].x) * st[ai][m].y * G[1] + B[1] + g[1] * acc[ai][bj][m][1]; }
            asm volatile("" ::: "memory"); }
    }
};

template <class Epi, class Sched, bool ALIGN_EPI = true, bool SP2 = true>
__device__ __forceinline__ void gemm_phase(PG8_LAS unsigned char* lds, const Gemm g, const Sched& S, const Epi& E) {
    int tid = threadIdx.x; asm volatile("" : "+v"(tid));
    const int wid = __builtin_amdgcn_readfirstlane(tid >> 6), lane = tid & 63, wr = wid >> 2, wc = wid & 3, fr = lane & 15, fq = lane >> 4;
    const int K = g.K, nt = K / BK;
    unsigned voffA[2], voffB[2];
#pragma unroll
    for (int i = 0; i < 2; ++i) { int R, C; stage_rc(tid * 16 + i * 8192, R, C); const int Rb = Epi::PERM ? ((R & ~31) + perm32(R & 31)) : R;
        voffA[i] = (unsigned)(R * g.lda + C) * 2u; voffB[i] = (unsigned)(Rb * g.ldb + C) * 2u; }
    const size_t kstep = (size_t)(BK * 2);
    const size_t hstepA = (size_t)HALF * g.lda * 2, hstepB = (size_t)HALF * g.ldb * 2;
    const size_t tstepA = 2 * hstepA, tstepB = 2 * hstepB;
    const unsigned ldsw = (unsigned)wid * 1024u;
    const int aoff = lds_byte(wr * 64 + fr, fq * 8), boff = lds_byte(wc * 32 + fr, fq * 8);
#define PG8_SA(b, h) (((b) * 2 + (h)) * HTB)
#define PG8_SB(b, h) ((4 + (b) * 2 + (h)) * HTB)
#define PG8_STAGE(bufoff, gbase, voff) do { _Pragma("unroll") for (int _i = 0; _i < 2; ++_i) \
        __builtin_amdgcn_global_load_lds((const unsigned*)((const char*)(gbase) + (voff)[_i]), (PG8_LAS unsigned*)(lds + (bufoff) + ldsw + _i * 8192), 16, 0, 0); } while (0)
#define PG8_LDA(dst, b, h) do { _Pragma("unroll") for (int m = 0; m < 4; ++m) _Pragma("unroll") for (int k = 0; k < 2; ++k) dst[m][k] = *(const PG8_LAS bf16x8*)(lds + PG8_SA(b, h) + aoff + m * 2048 + k * 1024); } while (0)
#define PG8_LDB(dst, b, h) do { _Pragma("unroll") for (int n = 0; n < 2; ++n) _Pragma("unroll") for (int k = 0; k < 2; ++k) dst[n][k] = *(const PG8_LAS bf16x8*)(lds + PG8_SB(b, h) + boff + n * 2048 + k * 1024); } while (0)
#define PG8_MMA(ai, bj, At, Bt) do { __builtin_amdgcn_s_setprio(1); _Pragma("unroll") for (int m = 0; m < 4; ++m) _Pragma("unroll") for (int n = 0; n < 2; ++n) _Pragma("unroll") for (int k = 0; k < 2; ++k) \
        acc[ai][bj][m][n] = __builtin_amdgcn_mfma_f32_16x16x32_bf16(Bt[n][k], At[m][k], acc[ai][bj][m][n], 0, 0, 0); __builtin_amdgcn_s_setprio(0); } while (0)
#define PG8_WAIT_V(n) asm volatile("s_waitcnt vmcnt(" #n ")" ::: "memory")
#define PG8_WAIT_L(n) asm volatile("s_waitcnt lgkmcnt(" #n ")" ::: "memory")
#define PG8_BAR __builtin_amdgcn_s_barrier()
#define PG8_SCHED __builtin_amdgcn_sched_barrier(0)
    Unit cur, nxt; int ui = 0;
    if (!S.next(0, cur)) return;
    f32x4 acc[2][2][4][2];
#pragma unroll
    for (int a = 0; a < 2; ++a)
#pragma unroll
        for (int b = 0; b < 2; ++b)
#pragma unroll
            for (int m = 0; m < 4; ++m)
#pragma unroll
                for (int n = 0; n < 2; ++n) acc[a][b][m][n] = (f32x4){0.f, 0.f, 0.f, 0.f};
    bf16x8 At[4][2], B0[2][2], B1[2][2];
    const char* cA = (const char*)g.A + (size_t)cur.pm * tstepA; const char* cB = (const char*)g.Bt + (size_t)cur.pn * tstepB;
    S.a_ready(cur);
    if constexpr (SP2) {
        PG8_STAGE(PG8_SB(0, 0), cB, voffB); PG8_STAGE(PG8_SB(0, 1), cB + hstepB, voffB); PG8_STAGE(PG8_SA(0, 0), cA, voffA); PG8_STAGE(PG8_SA(0, 1), cA + hstepA, voffA);
        if (wr == 1) PG8_BAR;
        PG8_WAIT_V(2); PG8_BAR;
        PG8_STAGE(PG8_SB(1, 0), cB + kstep, voffB); PG8_STAGE(PG8_SA(1, 0), cA + kstep, voffA); PG8_STAGE(PG8_SB(1, 1), cB + hstepB + kstep, voffB);
        PG8_WAIT_V(6); PG8_BAR;
    } else {
        PG8_STAGE(PG8_SB(0, 0), cB, voffB); PG8_STAGE(PG8_SA(0, 0), cA, voffA); PG8_STAGE(PG8_SB(0, 1), cB + hstepB, voffB); PG8_STAGE(PG8_SA(0, 1), cA + hstepA, voffA);
        if (wr == 1) PG8_BAR;
        PG8_WAIT_V(4); PG8_BAR;
        PG8_STAGE(PG8_SB(1, 0), cB + kstep, voffB); PG8_STAGE(PG8_SA(1, 0), cA + kstep, voffA); PG8_STAGE(PG8_SB(1, 1), cB + hstepB + kstep, voffB);
        PG8_WAIT_V(6); PG8_BAR;
    }
    for (;;) {
        const bool has_next = S.next(ui + 1, nxt);
        const char* nA = has_next ? (const char*)g.A + (size_t)nxt.pm * tstepA : cA; const char* nB = has_next ? (const char*)g.Bt + (size_t)nxt.pn * tstepB : cB;
        for (int t = 0; t < nt; t += 2) {
            const bool last = (t == nt - 2);
            const char* a1 = cA + (size_t)(t + 1) * kstep;
            const char* a2 = last ? nA : cA + (size_t)(t + 2) * kstep; const char* b2 = last ? nB : cB + (size_t)(t + 2) * kstep;
            const char* a3 = a2 + kstep; const char* b3 = b2 + kstep;
            if (last && has_next) S.a_ready(nxt);
            if constexpr (SP2) {
            PG8_LDB(B0, 0, 0); PG8_LDB(B1, 0, 1); PG8_SCHED; PG8_LDA(At, 0, 0); PG8_STAGE(PG8_SA(1, 1), a1 + hstepA, voffA);
            PG8_WAIT_V(8); PG8_WAIT_L(0); PG8_BAR; PG8_MMA(0, 0, At, B0); PG8_MMA(0, 1, At, B1); PG8_BAR; PG8_SCHED;
            PG8_LDA(At, 0, 1); PG8_STAGE(PG8_SB(0, 0), b2, voffB); PG8_STAGE(PG8_SB(0, 1), b2 + hstepB, voffB); PG8_STAGE(PG8_SA(0, 0), a2, voffA);
            PG8_WAIT_V(8); PG8_WAIT_L(0); PG8_BAR; PG8_MMA(1, 0, At, B0); PG8_MMA(1, 1, At, B1); PG8_BAR; PG8_SCHED;
            PG8_LDB(B0, 1, 0); PG8_LDB(B1, 1, 1); PG8_SCHED; PG8_LDA(At, 1, 0); PG8_STAGE(PG8_SA(0, 1), a2 + hstepA, voffA);
            PG8_WAIT_V(8); PG8_WAIT_L(0); PG8_BAR; PG8_MMA(0, 0, At, B0); PG8_MMA(0, 1, At, B1); PG8_BAR; PG8_SCHED;
            PG8_LDA(At, 1, 1); PG8_STAGE(PG8_SB(1, 0), b3, voffB); PG8_STAGE(PG8_SB(1, 1), b3 + hstepB, voffB); PG8_STAGE(PG8_SA(1, 0), a3, voffA);
            PG8_WAIT_V(8); PG8_WAIT_L(0); PG8_BAR; PG8_MMA(1, 0, At, B0); PG8_MMA(1, 1, At, B1); PG8_BAR; PG8_SCHED;
            } else {
            PG8_LDB(B0, 0, 0); PG8_SCHED; PG8_LDA(At, 0, 0); PG8_STAGE(PG8_SA(1, 1), a1 + hstepA, voffA);
            PG8_WAIT_L(8); PG8_BAR; PG8_WAIT_L(0); PG8_MMA(0, 0, At, B0); PG8_BAR; PG8_SCHED;
            PG8_LDB(B1, 0, 1); PG8_STAGE(PG8_SB(0, 0), b2, voffB);
            PG8_BAR; PG8_WAIT_L(0); PG8_MMA(0, 1, At, B1); PG8_BAR;
            PG8_LDA(At, 0, 1); PG8_STAGE(PG8_SA(0, 0), a2, voffA);
            PG8_BAR; PG8_WAIT_L(0); PG8_MMA(1, 0, At, B0); PG8_BAR; PG8_SCHED;
            PG8_STAGE(PG8_SB(0, 1), b2 + hstepB, voffB);
            PG8_WAIT_V(6); PG8_BAR; PG8_MMA(1, 1, At, B1); PG8_BAR;
            PG8_LDB(B0, 1, 0); PG8_SCHED; PG8_LDA(At, 1, 0); PG8_STAGE(PG8_SA(0, 1), a2 + hstepA, voffA);
            PG8_WAIT_L(8); PG8_BAR; PG8_WAIT_L(0); PG8_MMA(0, 0, At, B0); PG8_BAR; PG8_SCHED;
            PG8_LDB(B1, 1, 1); PG8_STAGE(PG8_SB(1, 0), b3, voffB);
            PG8_BAR; PG8_WAIT_L(0); PG8_MMA(0, 1, At, B1); PG8_BAR;
            PG8_LDA(At, 1, 1); PG8_STAGE(PG8_SA(1, 0), a3, voffA);
            PG8_BAR; PG8_WAIT_L(0); PG8_MMA(1, 0, At, B0); PG8_BAR; PG8_SCHED;
            PG8_STAGE(PG8_SB(1, 1), b3 + hstepB, voffB);
            PG8_WAIT_V(6); PG8_BAR; PG8_MMA(1, 1, At, B1); PG8_BAR;
            }
        }
        if constexpr (ALIGN_EPI) { if (wr == 0) PG8_BAR; }
        E(acc, cur, wr, wc, fr, fq); S.done(cur);
        if (!has_next) break;
#pragma unroll
        for (int a = 0; a < 2; ++a)
#pragma unroll
            for (int b = 0; b < 2; ++b)
#pragma unroll
                for (int m = 0; m < 4; ++m)
#pragma unroll
                    for (int n = 0; n < 2; ++n) acc[a][b][m][n] = (f32x4){0.f, 0.f, 0.f, 0.f};
        cur = nxt; cA = nA; cB = nB; ++ui;
        if constexpr (ALIGN_EPI) { if (wr == 1) PG8_BAR; }
    }
    PG8_WAIT_V(0);
    if constexpr (!ALIGN_EPI) { if (wr == 0) PG8_BAR; }
    PG8_BAR;
#undef PG8_SA
#undef PG8_SB
#undef PG8_STAGE
#undef PG8_LDA
#undef PG8_LDB
#undef PG8_MMA
#undef PG8_WAIT_V
#undef PG8_WAIT_L
#undef PG8_BAR
#undef PG8_SCHED
}
}

#define XB_TMO      128
#define XB_XCNT(j)  (256  + 64 * (j))
#define XB_XSUB(j)  (1280 + 64 * (j))
#define XB_XGEN(j)  (2304 + 64 * (j))
#define XB_TOP      3328
#define XB_TOPGEN   3392
#define XCD_BAR_WORDS 3456
#define XB_SPIN_CAP (1u << 18)
__device__ __forceinline__ unsigned xb_ld(unsigned* p)              { return __hip_atomic_load(p, __ATOMIC_RELAXED, __HIP_MEMORY_SCOPE_AGENT); }
__device__ __forceinline__ unsigned xb_add(unsigned* p, unsigned v) { return __hip_atomic_fetch_add(p, v, __ATOMIC_RELAXED, __HIP_MEMORY_SCOPE_AGENT); }
__device__ __forceinline__ unsigned xb_xcc_id() { return (unsigned)__builtin_amdgcn_s_getreg((3 << 11) | 20) & 0xFu; }
#define XB_SPIN(cond, bar) do { unsigned _sp = 0; while (cond) { __builtin_amdgcn_s_sleep(1); \
    if ((++_sp & 255u) == 0u) { if (xb_ld(&(bar)[XB_TMO])) break; if (_sp > XB_SPIN_CAP) { atomicAdd(&(bar)[XB_TMO], 1u); break; } } } } while (0)
struct XcdBarrier { unsigned* bar; unsigned x; volatile LAS unsigned* st; };
__device__ __forceinline__ XcdBarrier xcd_barrier_post(unsigned* bar, volatile LAS unsigned* st) {
    XcdBarrier b; b.bar = bar; b.x = xb_xcc_id(); b.st = st;
    if (threadIdx.x == 0) (void)xb_add(&bar[XB_XCNT(b.x)], 1u);
    return b;
}
__device__ __forceinline__ void xcd_barrier_complete(unsigned* bar, unsigned x, unsigned& nloc, unsigned& nx) {
    const unsigned G = gridDim.x * gridDim.y * gridDim.z;
    unsigned sum, cnt, mine, sp = 0u;
    for (;;) {
        sum = 0u; cnt = 0u; mine = 0u;
#pragma unroll
        for (unsigned j = 0; j < 16; ++j) { const unsigned c = xb_ld(&bar[XB_XCNT(j)]); sum += c; cnt += (c > 0u) ? 1u : 0u; mine = (j == x) ? c : mine; }
        if (sum == G) break;
        __builtin_amdgcn_s_sleep(1);
        if ((++sp & 255u) == 0u) { if (xb_ld(&bar[XB_TMO])) break; if (sp > XB_SPIN_CAP) { atomicAdd(&bar[XB_TMO], 1u); break; } }
    }
    nloc = mine > 0u ? mine : 1u; nx = cnt > 0u ? cnt : 1u;
}
__device__ __forceinline__ void xcd_barrier(const XcdBarrier& b0) {
    asm volatile("s_waitcnt vmcnt(0)" ::: "memory");
    __syncthreads();
    if (threadIdx.x == 0) {
        XcdBarrier b = b0; b.x = xb_xcc_id();
        unsigned* bar = b.bar;
        __builtin_amdgcn_s_waitcnt(0);
        unsigned nloc = b.st[0], nx = b.st[1];
        if (nloc == 0u) { xcd_barrier_complete(bar, b.x, nloc, nx); b.st[0] = nloc; b.st[1] = nx; }
        const unsigned old = xb_add(&bar[XB_XSUB(b.x)], 1u);
        const unsigned gen = old / nloc;
        if (old + 1u == (gen + 1u) * nloc) {
            __builtin_amdgcn_fence(__ATOMIC_RELEASE, "agent");
            asm volatile("s_waitcnt vmcnt(0)" ::: "memory");
            const unsigned og = xb_add(&bar[XB_TOP], 1u);
            const unsigned tg = og / nx;
            if (og + 1u == (tg + 1u) * nx) xb_add(&bar[XB_TOPGEN], 1u);
            else XB_SPIN(xb_ld(&bar[XB_TOPGEN]) == tg, bar);
            __builtin_amdgcn_fence(__ATOMIC_ACQUIRE, "agent");
            xb_add(&bar[XB_XGEN(b.x)], 1u);
            asm volatile("s_waitcnt vmcnt(0)" ::: "memory");
        } else {
            XB_SPIN(xb_ld(&bar[XB_XGEN(b.x)]) == gen, bar);
            __builtin_amdgcn_fence(__ATOMIC_ACQUIRE, "agent");
            asm volatile("s_waitcnt vmcnt(0)" ::: "memory");
        }
    }
    __syncthreads();
}

struct Args { const float* in[23]; float* out; unsigned char* ws; };
struct Frame {
    LAS unsigned char* lds;
    int vcu, G;
    const Args* a; unsigned char* ws;
};
#define PHASE_IDS() int tid = threadIdx.x; asm volatile("" : "+v"(tid)); const int lane = tid & 63, wave = __builtin_amdgcn_readfirstlane(tid >> 6); (void)lane; (void)wave
#define MFMA16(a, b, c) __builtin_amdgcn_mfma_f32_16x16x32_bf16((a), (b), (c), 0, 0, 0)
#define MFMA32(a, b, c) __builtin_amdgcn_mfma_f32_32x32x16_bf16((a), (b), (c), 0, 0, 0)

constexpr float ATT_QSCALE = 0.07216878364870322f * 1.4426950408889634f;
__device__ __forceinline__ void tr_item(const float* W, int N, int K, bf16* WT, int k0, int n0, int drow0, LAS float* scr, int lane, float sc = 1.0f) {
#pragma unroll 8
    for (int i = 0; i < 32; ++i) { const int kk = 2 * i + (lane >> 5); scr[kk * 33 + (lane & 31)] = W[(size_t)(k0 + kk) * N + n0 + (lane & 31)]; }
    LDS_WAIT(); asm volatile("" ::: "memory");
    const int c = lane & 7;
#pragma unroll
    for (int j = 0; j < 4; ++j) { const int n = (lane >> 3) + 8 * j; const LAS float* s = scr + (8 * c) * 33 + n;
        u32x4 o; o.x = cvt_pk_bf16(s[0 * 33] * sc, s[1 * 33] * sc); o.y = cvt_pk_bf16(s[2 * 33] * sc, s[3 * 33] * sc); o.z = cvt_pk_bf16(s[4 * 33] * sc, s[5 * 33] * sc); o.w = cvt_pk_bf16(s[6 * 33] * sc, s[7 * 33] * sc);
        *(u32x4*)(WT + (size_t)(drow0 + n) * K + k0 + 8 * c) = o; }
    LDS_WAIT(); asm volatile("" ::: "memory");
}
__device__ __forceinline__ void p0a(Frame& F) {
    PHASE_IDS();
    LAS float* scr = (LAS float*)(F.lds + wave * 8704);
    LAS float* sv = (LAS float*)(F.lds + 8 * 8704);
    for (int i = tid; i < 2 * DM; i += NTHR) { const float v = (i < DM) ? F.a->in[1][i] : F.a->in[3][i - DM]; sv[i] = v / (1.0f + __expf(-v)); }
    __syncthreads();
    const int gw = F.vcu * NWAVES + wave, NGW = F.G * NWAVES;
    constexpr int I0 = 8 * 32 * 344, I1 = 8 * 86 * 64, I2 = 2 * 32 * 193, I3 = 2 * 32 * 64, I4 = 2 * 32 * 34, I5 = 2 * 8 * 96, I6 = 2 * 8 * 128, I7 = 2 * 32 * 64;
    constexpr int NTR = I0 + I1 + I2 + I3 + I4 + I5 + I6 + I7, NADAI = 8 * 288;
    for (int it = gw; it < NTR + NADAI; it += NGW) {
        int r = it;
        if (r < I0) { const int mat = r / 11008, q = r % 11008, kb = q / 344, nb = q % 344, n0 = nb * 32;
            const int j = n0 < DFF ? n0 : n0 - DFF, drow = (j / 128) * 256 + (j % 128) + (n0 < DFF ? 0 : 128);
            tr_item(F.a->in[8] + (size_t)mat * DM * 2 * DFF, 2 * DFF, DM, (bf16*)(F.ws + WS_WFI + mat * SZ_WFI), kb * 64, n0, drow - 0, scr, lane); continue; } r -= I0;
        if (r < I1) { const int mat = r / 5504, q = r % 5504, kb = q / 64, nb = q % 64;
            tr_item(F.a->in[9] + (size_t)mat * DFF * DM, DM, DFF, (bf16*)(F.ws + WS_WFO + mat * SZ_WFO), kb * 64, nb * 32, nb * 32, scr, lane); continue; } r -= I1;
        if (r < I2) { const int mat = r / 6176, q = r % 6176, kb = q / 193, nb = q % 193, n0 = nb * 32;
            const int drow = n0 < 3072 ? n0 : (n0 < 3104 ? 6144 : n0 - 32);
            tr_item(F.a->in[10] + (size_t)mat * DM * 6176, 6176, DM, (bf16*)(F.ws + WS_EWI + mat * SZ_EWI), kb * 64, n0, drow, scr, lane); continue; } r -= I2;
        if (r < I3) { const int mat = r / 2048, q = r % 2048, kb = q / 64, nb = q % 64;
            tr_item(F.a->in[16] + (size_t)mat * DM * DM, DM, DM, (bf16*)(F.ws + WS_EWO + mat * SZ_SQ), kb * 64, nb * 32, nb * 32, scr, lane); continue; } r -= I3;
        if (r < I4) { const int mat = r / 1088, q = r % 1088, kb = q / 34, nb = q % 34;
            tr_item(F.a->in[17] + (size_t)mat * DM * 1088, 1088, DM, (bf16*)(F.ws + WS_OWI + mat * SZ_OWI), kb * 64, nb * 32, nb * 32, scr, lane); continue; } r -= I4;
        if (r < I5) { const int mat = r / 768, q = r % 768, kb = q / 96, nb = q % 96;
            tr_item(F.a->in[20] + (size_t)mat * 512 * 3072, 3072, 512, (bf16*)(F.ws + WS_OUQ + mat * SZ_OUQ), kb * 64, nb * 32, nb * 32, scr, lane, ATT_QSCALE); continue; } r -= I5;
        if (r < I6) { const int mat = r / 1024, q = r % 1024, kb = q / 128, nb = q % 128;
            tr_item(F.a->in[21] + (size_t)mat * 512 * 4096, 4096, 512, (bf16*)(F.ws + WS_OUKV + mat * SZ_OUKV), kb * 64, nb * 32, nb * 32, scr, lane); continue; } r -= I6;
        if (r < I7) { const int mat = r / 2048, q = r % 2048, kb = q / 64, nb = q % 64;
            tr_item(F.a->in[22] + (size_t)mat * DM * DM, DM, DM, (bf16*)(F.ws + WS_OWO + mat * SZ_SQ), kb * 64, nb * 32, nb * 32, scr, lane); continue; } r -= I7;
        {
            const int ks = r / 288, cg = r % 288, l = cg / 72, n = (cg % 72) * 256 + lane * 4;
            const float* w = F.a->in[4] + ((size_t)l * DM + ks * 256) * NADA + n;
            f32x4 al = {0.f, 0.f, 0.f, 0.f}, ac = {0.f, 0.f, 0.f, 0.f};
#pragma unroll 8
            for (int k = 0; k < 256; ++k) { const f32x4 wv = *(const f32x4*)(w + (size_t)k * NADA); al += wv * sv[ks * 256 + k]; ac += wv * sv[DM + ks * 256 + k]; }
            float* mp = (float*)(F.ws + WS_MODP);
            *(f32x4*)(mp + (size_t)(ks * 2 + 0) * 4 * NADA + l * NADA + n) = al;
            *(f32x4*)(mp + (size_t)(ks * 2 + 1) * 4 * NADA + l * NADA + n) = ac;
        }
    }
    const int gt = F.vcu * NTHR + tid, NGT = F.G * NTHR;
    for (int i = gt; i < NLAT * 64 + 256 * 16 + 64 * 16; i += NGT) {
        int pos, fi; float inv; f32x2* dst;
        if (i < NLAT * 64) { pos = i >> 6; fi = i & 63; inv = __builtin_amdgcn_exp2f(-(float)fi * (13.287712379549449f / 64.0f)); dst = (f32x2*)(F.ws + WS_RT) + i; }
        else if (i < NLAT * 64 + 4096) { const int j = i - NLAT * 64; pos = j >> 4; fi = j & 15; inv = __builtin_amdgcn_exp2f(-(float)fi * (13.287712379549449f / 16.0f)); dst = (f32x2*)(F.ws + WS_AXR) + j; }
        else { const int j = i - NLAT * 64 - 4096; pos = j >> 4; fi = j & 15; inv = __builtin_amdgcn_exp2f(-(float)fi * (13.287712379549449f / 16.0f)); dst = (f32x2*)(F.ws + WS_AXC) + j; }
        const float ang = (float)pos * inv;
        double rev = (double)ang * 0.15915494309189535; rev -= __builtin_floor(rev);
        const float rv = (float)rev;
        *dst = (f32x2){__builtin_amdgcn_cosf(rv), __builtin_amdgcn_sinf(rv)};
    }
}
__device__ __forceinline__ void p0b(Frame& F) {
    PHASE_IDS();
    const int gt = F.vcu * NTHR + tid, NGT = F.G * NTHR;
    const float* mp = (const float*)(F.ws + WS_MODP); float* mo = (float*)(F.ws + WS_MOD);
    for (int i = gt; i < 4 * 2 * NADA; i += NGT) { const int l = i / (2 * NADA), v = (i / NADA) & 1, n = i % NADA;
        float s = F.a->in[5][l * NADA + n];
#pragma unroll
        for (int ks = 0; ks < 8; ++ks) s += mp[(size_t)(ks * 2 + v) * 4 * NADA + l * NADA + n];
        mo[i] = s; }
}
__device__ __forceinline__ const float* modp(Frame& F, int l, int v, int idx) { return (const float*)(F.ws + WS_MOD) + ((size_t)(l * 2 + v) * 9 + idx) * DM; }

template <int MODE>
__device__ __forceinline__ void row_phase(Frame& F, const float* lng, const float* lnb, const float* sh_l, const float* sc_l, const float* sh_c, const float* sc_c) {
    PHASE_IDS();
    LAS float* V = (LAS float*)F.lds;
    for (int i = tid; i < DM; i += NTHR) { if (MODE != 0) { V[i] = lng[i]; V[DM + i] = lnb[i]; } if (MODE != 2) { V[2 * DM + i] = sh_l[i]; V[3 * DM + i] = sc_l[i]; V[4 * DM + i] = sh_c[i]; V[5 * DM + i] = sc_c[i]; } }
    __syncthreads();
    const int gw = F.vcu * NWAVES + wave, NGW = F.G * NWAVES;
    float* X = (float*)(F.ws + WS_X); bf16* H = (bf16*)(F.ws + WS_H);
    for (int t = gw; t < T; t += NGW) {
        if (MODE == 2 && t < NCTX) continue;
        const float* src = (MODE == 0) ? (t < NCTX ? F.a->in[2] + (size_t)t * DM : F.a->in[0] + (size_t)(t - NCTX) * DM) : X + (size_t)t * DM;
        f32x4 v[8]; float s = 0.f; float mean_ = 0.f, rstd_ = 1.f;
#pragma unroll
        for (int j = 0; j < 8; ++j) { v[j] = *((const f32x4*)src + lane + 64 * j); s += (v[j].x + v[j].y) + (v[j].z + v[j].w); }
        if (MODE != 0) {
            const float mean = wave_sum(s) * (1.f / DM); float s2 = 0.f;
#pragma unroll
            for (int j = 0; j < 8; ++j) { v[j] = v[j] - mean; s2 += (v[j].x * v[j].x + v[j].y * v[j].y) + (v[j].z * v[j].z + v[j].w * v[j].w); }
            const float rstd = 1.f / sqrtf(wave_sum(s2) * (1.f / DM) + LN_EPS); mean_ = mean; rstd_ = rstd;
#pragma unroll
            for (int j = 0; j < 8; ++j) { const f32x4 g = *((const LAS f32x4*)V + lane + 64 * j), b = *((const LAS f32x4*)(V + DM) + lane + 64 * j); v[j] = v[j] * rstd * g + b; }
        }
        if (MODE == 1 && lane == 0) *(f32x2*)((float*)(F.ws + WS_STAT) + (size_t)t * 2) = (f32x2){mean_, rstd_};
        if (MODE == 2) {
            float* o = F.a->out + (size_t)(t - NCTX) * DM;
#pragma unroll
            for (int j = 0; j < 8; ++j) *((f32x4*)o + lane + 64 * j) = v[j];
        } else {
            float* o = X + (size_t)t * DM; bf16* h = H + (size_t)t * DM;
            const LAS float* shv = V + (t < NCTX ? 4 * DM : 2 * DM); const LAS float* scv = V + (t < NCTX ? 5 * DM : 3 * DM);
#pragma unroll
            for (int j = 0; j < 8; ++j) {
                const f32x4 sh = *((const LAS f32x4*)shv + lane + 64 * j), sc = *((const LAS f32x4*)scv + lane + 64 * j);
                const f32x4 m = v[j] * (sc + 1.0f) + sh; u32x2 w; w.x = cvt_pk_bf16(m.x, m.y); w.y = cvt_pk_bf16(m.z, m.w);
                *((u32x2*)h + lane + 64 * j) = w; }
        }
    }
    __syncthreads();
}


__device__ __forceinline__ void ctx_resid_small(Frame& F, float* X, const bf16* A, const bf16* Bt, int K, const float* gv, float gs, const float* stat, const float* lng, const float* lnb, int has_ln, int parity) {
    if ((int)(blockIdx.x & 1) != parity) return;
    PHASE_IDS(); const int fr = lane & 15, fq = lane >> 4;
    const int nks = K >> 5, last = wave + 8 * ((nks - 1 - wave) >> 3), trips = (((nks + 7) >> 3) + 3) & ~3;
    for (int item = blockIdx.x; item < 256; item += F.G) {
        const int mt = item >> 5, nt = item & 31;
        f32x4 acc[2][4];
#pragma unroll
        for (int i = 0; i < 2; ++i)
#pragma unroll
            for (int j = 0; j < 4; ++j) acc[i][j] = (f32x4){0.f, 0.f, 0.f, 0.f};
        const bf16* Ap = A + (size_t)(32 * mt + fr) * K + 8 * fq;
        const bf16* Bp = Bt + (size_t)(64 * nt + fr) * K + 8 * fq;
        bf16x8 a0[2], b0[4], a1[2], b1[4], a2[2], b2[4], a3[2], b3[4];
#define CS_LOAD(a, b, i_) do { const int so_ = 32 * min(wave + 8 * (i_), last); _Pragma("unroll") for (int i = 0; i < 2; ++i) a[i] = *(const bf16x8*)(Ap + (size_t)(16 * i) * K + so_); \
        _Pragma("unroll") for (int i = 0; i < 4; ++i) b[i] = *(const bf16x8*)(Bp + (size_t)(16 * i) * K + so_); } while (0)
#define CS_MMA(a, b, i_) do { __builtin_amdgcn_sched_barrier(0); if (wave + 8 * (i_) < nks) { _Pragma("unroll") for (int i = 0; i < 2; ++i) _Pragma("unroll") for (int j = 0; j < 4; ++j) acc[i][j] = MFMA16(a[i], b[j], acc[i][j]); } __builtin_amdgcn_sched_barrier(0); } while (0)
        CS_LOAD(a0, b0, 0); CS_LOAD(a1, b1, 1); CS_LOAD(a2, b2, 2);
        for (int it = 0; it < trips; it += 4) {
            CS_LOAD(a3, b3, it + 3); CS_MMA(a0, b0, it);
            CS_LOAD(a0, b0, it + 4); CS_MMA(a1, b1, it + 1);
            CS_LOAD(a1, b1, it + 5); CS_MMA(a2, b2, it + 2);
            CS_LOAD(a2, b2, it + 6); CS_MMA(a3, b3, it + 3);
        }
#undef CS_LOAD
#undef CS_MMA
        LAS float* P = (LAS float*)F.lds + wave * 2048;
#pragma unroll
        for (int i = 0; i < 2; ++i)
#pragma unroll
            for (int j = 0; j < 4; ++j)
#pragma unroll
                for (int r = 0; r < 4; ++r) P[(16 * i + 4 * fq + r) * 64 + 16 * j + fr] = acc[i][j][r];
        __syncthreads();
        const int row = tid >> 4, c0 = (tid & 15) * 4;
        f32x4 s0 = {0.f, 0.f, 0.f, 0.f};
#pragma unroll
        for (int w = 0; w < 8; ++w) s0 += *(const LAS f32x4*)((LAS float*)F.lds + w * 2048 + row * 64 + c0);
        float* xp = X + (size_t)(32 * mt + row) * DM + 64 * nt + c0;
        const f32x4 g0 = *(const f32x4*)(gv + 64 * nt + c0) * gs;
        f32x4 x0 = *(const f32x4*)xp;
        if (has_ln) { const f32x2 st = *(const f32x2*)(stat + (size_t)(32 * mt + row) * 2); x0 = (x0 - st.x) * st.y * *(const f32x4*)(lng + 64 * nt + c0) + *(const f32x4*)(lnb + 64 * nt + c0); }
        *(f32x4*)xp = x0 * DN_ALPHA + g0 * s0;
        __syncthreads();
    }
}


__device__ __forceinline__ void init_x_by_owners(Frame& F) {
    PHASE_IDS();
    float* X = (float*)(F.ws + WS_X);
    pg8::StaticOrder S; S.init(NLAT, DM, F.G, (int)blockIdx.x); pg8::Unit u;
    for (int i = 0; S.next(i, u); ++i) {
        const int c4 = (tid & 63) * 4, r0 = tid >> 6;
#pragma unroll 4
        for (int rr = r0; rr < 256; rr += 8) { const size_t lr = (size_t)u.pm * 256 + rr; *(f32x4*)(X + (lr + NCTX) * DM + u.pn * 256 + c4) = *(const f32x4*)(F.a->in[0] + lr * DM + u.pn * 256 + c4); }
    }
    for (int item = blockIdx.x; item < 256; item += F.G) { const int mt = item >> 5, nt = item & 31, row = tid >> 4, c0 = (tid & 15) * 4;
        const size_t o = (size_t)(32 * mt + row) * DM + 64 * nt + c0; *(f32x4*)(X + o) = *(const f32x4*)(F.a->in[2] + o); }
}

constexpr int L1_QRAW = 0, L1_KRAW = 16384, L1_GD = 32768, L1_PART = 36864, L1_QT = 40960, L1_KT = 58368, L1_KTT = 75776, L1_VT = 94208, L1_P = 131072;
constexpr float INV_SQRT_DK = 0.08838834764831845f;

template <int DIR>
__device__ __forceinline__ void s1_dir(Frame& F, int e, int hh, int c, bool lat, f32x4 (&pacc)[2], const float (&wv)[16], const float bgv, const f32x2 (&csv)[16]) {
    const bool is_gla = hh < 4; const int hd = hh & 3, t0 = c * 64;
    PHASE_IDS(); const int w = wave, fr = lane & 15, fq = lane >> 4;
    LAS unsigned char* lds = F.lds;
    const int ch = tid & 127, tq = tid >> 7;
    float lgv[16];
    if (is_gla) {
#pragma unroll
        for (int i = 0; i < 16; ++i) { const int tt = 16 * tq + (DIR ? 15 - i : i);
            const u32x4 g0 = *(const LAS u32x4*)(lds + L1_GD + tt * 64 + DIR * 32), g1 = *(const LAS u32x4*)(lds + L1_GD + tt * 64 + DIR * 32 + 16);
            float x = bgv;
            x += bflo(g0.x) * wv[0] + bfhi(g0.x) * wv[1] + bflo(g0.y) * wv[2] + bfhi(g0.y) * wv[3] + bflo(g0.z) * wv[4] + bfhi(g0.z) * wv[5] + bflo(g0.w) * wv[6] + bfhi(g0.w) * wv[7];
            x += bflo(g1.x) * wv[8] + bfhi(g1.x) * wv[9] + bflo(g1.y) * wv[10] + bfhi(g1.y) * wv[11] + bflo(g1.z) * wv[12] + bfhi(g1.z) * wv[13] + bflo(g1.w) * wv[14] + bfhi(g1.w) * wv[15];
            lgv[i] = (fminf(x, 0.f) - __logf(1.0f + __expf(-fabsf(x)))) * (1.0f / 16.0f); }
    } else {
        const float lg = log1pf(-exp2f((DIR ? -5.5f : -5.0f) - (float)hd));
#pragma unroll
        for (int i = 0; i < 16; ++i) lgv[i] = lg;
    }
    float ls = 0.f;
#pragma unroll
    for (int i = 0; i < 16; ++i) ls += lgv[i];
    LAS float* part = (LAS float*)(lds + L1_PART);
    part[tq * 128 + ch] = ls;
    __syncthreads();
    float b = 0.f;
#pragma unroll
    for (int q = 0; q < 4; ++q) { const float pv = part[q * 128 + ch]; if (DIR ? (q > tq) : (q < tq)) b += pv; }
    bf16* QTg = (bf16*)(F.ws + WS_QT) + (size_t)DIR * T * 1024;
    float kt[16];
#pragma unroll
    for (int i = 0; i < 16; ++i) { const int tt = 16 * tq + (DIR ? 15 - i : i);
        b += lgv[i];
        float qv = bf2f(*(const LAS bf16*)(lds + L1_QRAW + tt * 256 + ch * 2)), kv = bf2f(*(const LAS bf16*)(lds + L1_KRAW + tt * 256 + ch * 2));
        if (!is_gla && lat) {
            const float qp = bf2f(*(const LAS bf16*)(lds + L1_QRAW + tt * 256 + (ch ^ 64) * 2)), kp = bf2f(*(const LAS bf16*)(lds + L1_KRAW + tt * 256 + (ch ^ 64) * 2));
            const f32x2 cs = csv[DIR ? 15 - i : i];
            if (ch < 64) { qv = qv * cs.x - qp * cs.y; kv = kv * cs.x - kp * cs.y; } else { qv = qv * cs.x + qp * cs.y; kv = kv * cs.x + kp * cs.y; }
        }
        const float eb = __expf(b), ebi = __expf(-b);
        const float qs = qv * eb * (is_gla ? INV_SQRT_DK : 1.0f), ks = kv * ebi * (is_gla ? 1.0f : INV_SQRT_DK);
        const bf16 qb = f2bf(qs);
        *(LAS bf16*)(lds + L1_QT + tt * 272 + ch * 2) = qb;
        *(LAS bf16*)(lds + L1_KT + tt * 272 + ch * 2) = f2bf(ks);
        kt[DIR ? 15 - i : i] = ks;
        if (i == 15 && tq == (DIR ? 0 : 3)) ((float*)(F.ws + WS_DEC))[((size_t)(DIR * 8 + hh) * NCH + c) * 128 + ch] = eb;
    }
    { u32x4 w0, w1; w0.x = cvt_pk_bf16(kt[0], kt[1]); w0.y = cvt_pk_bf16(kt[2], kt[3]); w0.z = cvt_pk_bf16(kt[4], kt[5]); w0.w = cvt_pk_bf16(kt[6], kt[7]);
      w1.x = cvt_pk_bf16(kt[8], kt[9]); w1.y = cvt_pk_bf16(kt[10], kt[11]); w1.z = cvt_pk_bf16(kt[12], kt[13]); w1.w = cvt_pk_bf16(kt[14], kt[15]);
      *(LAS u32x4*)(lds + L1_KTT + ch * 144 + tq * 32) = w0; *(LAS u32x4*)(lds + L1_KTT + ch * 144 + tq * 32 + 16) = w1; }
    __syncthreads();
#pragma unroll
    for (int i = 0; i < 2; ++i) { const int id = tid + 512 * i, r = id >> 4, cc = id & 15;
        *(u32x4*)(QTg + (size_t)(t0 + r) * 1024 + hh * 128 + cc * 8) = *(const LAS u32x4*)(lds + L1_QT + r * 272 + cc * 16); }
    { const int mi = w >> 1, nj0 = 2 * (w & 1);
      f32x4 pd[2] = {{0.f, 0.f, 0.f, 0.f}, {0.f, 0.f, 0.f, 0.f}};
#pragma unroll
      for (int ks = 0; ks < 4; ++ks) { const bf16x8 a = *(const LAS bf16x8*)(lds + L1_QT + (16 * mi + fr) * 272 + (32 * ks + 8 * fq) * 2);
#pragma unroll
          for (int j = 0; j < 2; ++j) { const bf16x8 bb = *(const LAS bf16x8*)(lds + L1_KT + (16 * (nj0 + j) + fr) * 272 + (32 * ks + 8 * fq) * 2); pd[j] = MFMA16(a, bb, pd[j]); } }
#pragma unroll
      for (int j = 0; j < 2; ++j)
#pragma unroll
          for (int r = 0; r < 4; ++r) { const int ii = 16 * mi + 4 * fq + r, jj = 16 * (nj0 + j) + fr; if (DIR ? (jj >= ii) : (jj <= ii)) pacc[j][r] += pd[j][r]; } }
    { bf16* Ug = (bf16*)(F.ws + WS_U) + ((size_t)(DIR * 8 + hh) * NCH + c) * 256 * 128;
      bf16x8 bv[2][2];
#pragma unroll
      for (int nj = 0; nj < 2; ++nj)
#pragma unroll
          for (int ks = 0; ks < 2; ++ks) bv[nj][ks] = *(const LAS bf16x8*)(lds + L1_VT + (32 * w + 16 * nj + fr) * 144 + (32 * ks + 8 * fq) * 2);
#pragma unroll
      for (int P = 0; P < 4; ++P) {
          f32x4 u[2][2] = {{{0.f, 0.f, 0.f, 0.f}, {0.f, 0.f, 0.f, 0.f}}, {{0.f, 0.f, 0.f, 0.f}, {0.f, 0.f, 0.f, 0.f}}};
#pragma unroll
          for (int t = 0; t < 2; ++t)
#pragma unroll
              for (int ks = 0; ks < 2; ++ks) { const bf16x8 a = *(const LAS bf16x8*)(lds + L1_KTT + (32 * P + 8 * (fr >> 2) + 4 * t + (fr & 3)) * 144 + (32 * ks + 8 * fq) * 2);
#pragma unroll
                  for (int nj = 0; nj < 2; ++nj) u[t][nj] = MFMA16(a, bv[nj][ks], u[t][nj]); }
          asm volatile("s_nop 15" : "+v"(u[0][0]), "+v"(u[0][1]), "+v"(u[1][0]), "+v"(u[1][1]));
#pragma unroll
          for (int nj = 0; nj < 2; ++nj) { u32x4 o; o.x = cvt_pk_bf16(u[0][nj][0], u[0][nj][1]); o.y = cvt_pk_bf16(u[0][nj][2], u[0][nj][3]); o.z = cvt_pk_bf16(u[1][nj][0], u[1][nj][1]); o.w = cvt_pk_bf16(u[1][nj][2], u[1][nj][3]);
              *(u32x4*)(Ug + (size_t)(32 * w + 16 * nj + fr) * 128 + 32 * P + 8 * fq) = o; } } }
    __syncthreads();
}

__device__ __forceinline__ void s1_phase(Frame& F, int e) {
    PHASE_IDS(); LAS unsigned char* lds = F.lds; const int w = wave, fr = lane & 15, fq = lane >> 4;
    const bf16* P = (const bf16*)(F.ws + WS_PROJ);
    for (int item = blockIdx.x; item < 8 * NCH; item += F.G) {
        const int c = item >> 3, hh = item & 7, hd = hh & 3, t0 = c * 64; const bool is_gla = hh < 4, lat = c >= 4;
        const int qcol = is_gla ? 128 * hd : 3072 + 128 * hd, kcol = qcol + 512, vcol = is_gla ? 1024 + 256 * hd : 4096 + 256 * hd;
#pragma unroll
        for (int i = 0; i < 2; ++i) { const int id = tid + 512 * i, r = id >> 4, cc = id & 15;
            *(LAS u32x4*)(lds + L1_QRAW + r * 256 + cc * 16) = *(const u32x4*)(P + (size_t)(t0 + r) * EV_N + qcol + cc * 8);
            *(LAS u32x4*)(lds + L1_KRAW + r * 256 + cc * 16) = *(const u32x4*)(P + (size_t)(t0 + r) * EV_N + kcol + cc * 8); }
#pragma unroll
        for (int i = 0; i < 4; ++i) { const int id = tid + 512 * i, r = id & 63, cc = id >> 6;
            const u32x4 v = *(const u32x4*)(P + (size_t)(t0 + r) * EV_N + vcol + cc * 8);
            LAS bf16* vt = (LAS bf16*)(lds + L1_VT) + (cc * 8) * 72 + r;
            vt[0 * 72] = (bf16)(v.x & 0xffff); vt[1 * 72] = (bf16)(v.x >> 16); vt[2 * 72] = (bf16)(v.y & 0xffff); vt[3 * 72] = (bf16)(v.y >> 16);
            vt[4 * 72] = (bf16)(v.z & 0xffff); vt[5 * 72] = (bf16)(v.z >> 16); vt[6 * 72] = (bf16)(v.w & 0xffff); vt[7 * 72] = (bf16)(v.w >> 16); }
        if (is_gla && tid < 256) { const int r = tid >> 2, cc = tid & 3; *(LAS u32x4*)(lds + L1_GD + r * 64 + cc * 16) = *(const u32x4*)(P + (size_t)(t0 + r) * EV_N + 6144 + cc * 8); }
        float wvf[16], wvb[16], bgf = 0.f, bgb = 0.f; f32x2 csv[16];
        { const int ch = tid & 127, tq = tid >> 7;
#pragma unroll
          for (int r = 0; r < 16; ++r) { wvf[r] = 0.f; wvb[r] = 0.f; csv[r] = (f32x2){1.f, 0.f}; }
          if (is_gla) {
              const float* wgf = F.a->in[11] + (size_t)e * 16 * 512 + hd * 128 + ch; const float* wgb = F.a->in[13] + (size_t)e * 16 * 512 + hd * 128 + ch;
#pragma unroll
              for (int r = 0; r < 16; ++r) { wvf[r] = wgf[r * 512]; wvb[r] = wgb[r * 512]; }
              bgf = F.a->in[12][e * 512 + hd * 128 + ch]; bgb = F.a->in[14][e * 512 + hd * 128 + ch];
          } else if (lat) {
              const f32x2* RT = (const f32x2*)(F.ws + WS_RT) + (size_t)(t0 + 16 * tq - NCTX) * 64 + (ch & 63);
#pragma unroll
              for (int r = 0; r < 16; ++r) csv[r] = RT[r * 64];
          } }
        __syncthreads();
        f32x4 pacc[2] = {{0.f, 0.f, 0.f, 0.f}, {0.f, 0.f, 0.f, 0.f}};
        s1_dir<0>(F, e, hh, c, lat, pacc, wvf, bgf, csv);
        s1_dir<1>(F, e, hh, c, lat, pacc, wvb, bgb, csv);
        { const int mi = w >> 1, nj0 = 2 * (w & 1);
#pragma unroll
          for (int j = 0; j < 2; ++j)
#pragma unroll
              for (int r = 0; r < 4; ++r) *(LAS bf16*)(lds + L1_P + (16 * mi + 4 * fq + r) * 144 + (16 * (nj0 + j) + fr) * 2) = f2bf(pacc[j][r]); }
        __syncthreads();
        { float* OI = (float*)(F.ws + WS_OI);
          bf16x8 bv[2][2];
#pragma unroll
          for (int nj = 0; nj < 2; ++nj)
#pragma unroll
              for (int ks = 0; ks < 2; ++ks) bv[nj][ks] = *(const LAS bf16x8*)(lds + L1_VT + (32 * w + 16 * nj + fr) * 144 + (32 * ks + 8 * fq) * 2);
#pragma unroll
          for (int mi = 0; mi < 4; ++mi) {
              f32x4 o[2] = {{0.f, 0.f, 0.f, 0.f}, {0.f, 0.f, 0.f, 0.f}};
#pragma unroll
              for (int ks = 0; ks < 2; ++ks) { const bf16x8 a = *(const LAS bf16x8*)(lds + L1_P + (16 * mi + fr) * 144 + (32 * ks + 8 * fq) * 2);
#pragma unroll
                  for (int nj = 0; nj < 2; ++nj) o[nj] = MFMA16(a, bv[nj][ks], o[nj]); }
#pragma unroll
              for (int nj = 0; nj < 2; ++nj)
#pragma unroll
                  for (int r = 0; r < 4; ++r) ((LAS float*)lds)[(16 * mi + 4 * fq + r) * 260 + 32 * w + 16 * nj + fr] = o[nj][r]; }
          __syncthreads();
#pragma unroll
          for (int i = 0; i < 8; ++i) { const int id = tid + 512 * i, r = id >> 6, cc = id & 63;
              *(f32x4*)(OI + (size_t)(t0 + r) * DM + hh * 256 + cc * 4) = *(const LAS f32x4*)((LAS float*)lds + r * 260 + cc * 4); } }
        __syncthreads();
    }
}

__device__ __forceinline__ void s2_phase(Frame& F) {
    PHASE_IDS();
    const int gt = F.vcu * NTHR + tid, NGT = F.G * NTHR;
    for (int idx = gt; idx < 2 * 8 * 256 * 32; idx += NGT) {
        const int dk4 = idx & 31, ee = (idx >> 5) & 255, dh = idx >> 13, dir = dh >> 3;
        const bf16* U = (const bf16*)(F.ws + WS_U) + (size_t)dh * NCH * 256 * 128 + (size_t)ee * 128 + dk4 * 4;
        bf16* S = (bf16*)(F.ws + WS_S) + (size_t)dh * NCH * 256 * 128 + (size_t)ee * 128 + dk4 * 4;
        const float* D = (const float*)(F.ws + WS_DEC) + (size_t)dh * NCH * 128 + dk4 * 4;
        f32x4 s = {0.f, 0.f, 0.f, 0.f};
#pragma unroll 13
        for (int step = 0; step < NCH; ++step) {
            const int c = dir ? (step < 4 ? 3 - step : NCH + 3 - step) : step;
            const u32x2 uu = *(const u32x2*)(U + (size_t)c * 256 * 128); const f32x4 d = *(const f32x4*)(D + (size_t)c * 128);
            u32x2 so; so.x = cvt_pk_bf16(s.x, s.y); so.y = cvt_pk_bf16(s.z, s.w);
            *(u32x2*)(S + (size_t)c * 256 * 128) = so;
            s.x = d.x * (s.x + bflo(uu.x)); s.y = d.y * (s.y + bfhi(uu.x)); s.z = d.z * (s.z + bflo(uu.y)); s.w = d.w * (s.w + bfhi(uu.y));
        }
    }
}

constexpr int L3_QF = 0, L3_QB = 17408, L3_OL = 34816;
__device__ __forceinline__ void s3_phase(Frame& F, int e) {
    PHASE_IDS(); LAS unsigned char* lds = F.lds; const int w = wave, fr = lane & 15, fq = lane >> 4;
    const bf16* P = (const bf16*)(F.ws + WS_PROJ); const bf16* QTg = (const bf16*)(F.ws + WS_QT); const float* OI = (const float*)(F.ws + WS_OI);
    bf16* MIX = (bf16*)(F.ws + WS_MIX);
    for (int item = blockIdx.x; item < 8 * NCH; item += F.G) {
        const int c = item >> 3, hh = item & 7, hd = hh & 3, t0 = c * 64; const bool is_gla = hh < 4;
        const int gcol = is_gla ? 2048 + 256 * hd : 5120 + 256 * hd;
#pragma unroll
        for (int dir = 0; dir < 2; ++dir)
#pragma unroll
            for (int i = 0; i < 2; ++i) { const int id = tid + 512 * i, r = id >> 4, cc = id & 15;
                *(LAS u32x4*)(lds + (dir ? L3_QB : L3_QF) + r * 272 + cc * 16) = *(const u32x4*)(QTg + (size_t)dir * T * 1024 + (size_t)(t0 + r) * 1024 + hh * 128 + cc * 8); }
        bf16x8 bv[2][4][2];
#pragma unroll
        for (int dir = 0; dir < 2; ++dir) { const bf16* Sg = (const bf16*)(F.ws + WS_S) + ((size_t)(dir * 8 + hh) * NCH + c) * 256 * 128;
#pragma unroll
            for (int ks = 0; ks < 4; ++ks)
#pragma unroll
                for (int nj = 0; nj < 2; ++nj) bv[dir][ks][nj] = *(const bf16x8*)(Sg + (size_t)(32 * w + 16 * nj + fr) * 128 + 32 * ks + 8 * fq); }
        __builtin_amdgcn_sched_barrier(0);
        __syncthreads();
        f32x4 o[4][2];
#pragma unroll
        for (int mi = 0; mi < 4; ++mi)
#pragma unroll
            for (int nj = 0; nj < 2; ++nj) o[mi][nj] = (f32x4){0.f, 0.f, 0.f, 0.f};
#pragma unroll
        for (int dir = 0; dir < 2; ++dir) {
#pragma unroll
            for (int ks = 0; ks < 4; ++ks) {
#pragma unroll
                for (int mi = 0; mi < 4; ++mi) { const bf16x8 a = *(const LAS bf16x8*)(lds + (dir ? L3_QB : L3_QF) + (16 * mi + fr) * 272 + (32 * ks + 8 * fq) * 2);
#pragma unroll
                    for (int nj = 0; nj < 2; ++nj) o[mi][nj] = MFMA16(a, bv[dir][ks][nj], o[mi][nj]); } } }
        LAS float* OL = (LAS float*)(lds + L3_OL);
#pragma unroll
        for (int mi = 0; mi < 4; ++mi)
#pragma unroll
            for (int nj = 0; nj < 2; ++nj)
#pragma unroll
                for (int r = 0; r < 4; ++r) OL[(16 * mi + 4 * fq + r) * 260 + 32 * w + 16 * nj + fr] = o[mi][nj][r];
        __syncthreads();
        { const int tk = tid >> 3, seg = tid & 7;
          f32x4 v[4][2]; float sq = 0.f;
#pragma unroll
          for (int g = 0; g < 4; ++g) { const int ee = 64 * g + 8 * seg; const float* oi = OI + (size_t)(t0 + tk) * DM + hh * 256 + ee;
              v[g][0] = *(const LAS f32x4*)(OL + tk * 260 + ee) + *(const f32x4*)oi; v[g][1] = *(const LAS f32x4*)(OL + tk * 260 + ee + 4) + *(const f32x4*)(oi + 4);
              sq += (v[g][0].x * v[g][0].x + v[g][0].y * v[g][0].y) + (v[g][0].z * v[g][0].z + v[g][0].w * v[g][0].w) + (v[g][1].x * v[g][1].x + v[g][1].y * v[g][1].y) + (v[g][1].z * v[g][1].z + v[g][1].w * v[g][1].w); }
          sq += __shfl_xor(sq, 1); sq += __shfl_xor(sq, 2); sq += __shfl_xor(sq, 4);
          const float rstd = 1.0f / sqrtf(sq * (1.0f / 256.0f) + RMS_EPS);
#pragma unroll
          for (int g = 0; g < 4; ++g) { const int ee = 64 * g + 8 * seg;
              const u32x4 gt = *(const u32x4*)(P + (size_t)(t0 + tk) * EV_N + gcol + ee);
              f32x4 n0 = {1.f, 1.f, 1.f, 1.f}, n1 = {1.f, 1.f, 1.f, 1.f};
              if (is_gla) { n0 = *(const f32x4*)(F.a->in[15] + e * 256 + ee); n1 = *(const f32x4*)(F.a->in[15] + e * 256 + ee + 4); }
              const f32x4 a0 = v[g][0] * rstd * n0, a1 = v[g][1] * rstd * n1;
              u32x4 ow; ow.x = cvt_pk_bf16(a0.x * silu_f(bflo(gt.x)), a0.y * silu_f(bfhi(gt.x))); ow.y = cvt_pk_bf16(a0.z * silu_f(bflo(gt.y)), a0.w * silu_f(bfhi(gt.y)));
              ow.z = cvt_pk_bf16(a1.x * silu_f(bflo(gt.z)), a1.y * silu_f(bfhi(gt.z))); ow.w = cvt_pk_bf16(a1.z * silu_f(bflo(gt.w)), a1.w * silu_f(bfhi(gt.w)));
              *(u32x4*)(MIX + (size_t)(t0 + tk) * DM + hh * 256 + ee) = ow; } }
        __syncthreads();
    }
}

__device__ __forceinline__ void e1_phase(Frame& F, int o) {
    PHASE_IDS();
    const int gw = F.vcu * NWAVES + wave, NGW = F.G * NWAVES;
    const bf16* P = (const bf16*)(F.ws + WS_PROJ); bf16* CQN = (bf16*)(F.ws + WS_CQN); bf16* CKVN = (bf16*)(F.ws + WS_CKVN); bf16* KR = (bf16*)(F.ws + WS_KR);
    const float* wq = F.a->in[18] + o * 512 + lane * 8; const float* wkv = F.a->in[19] + o * 512 + lane * 8;
    const f32x4 wq0 = *(const f32x4*)wq, wq1 = *(const f32x4*)(wq + 4), wk0 = *(const f32x4*)wkv, wk1 = *(const f32x4*)(wkv + 4);
    const f32x2* AXR = (const f32x2*)(F.ws + WS_AXR); const f32x2* AXC = (const f32x2*)(F.ws + WS_AXC);
    for (int t = gw; t < T; t += NGW) {
        const bf16* p = P + (size_t)t * OD_N;
        const u32x4 a = *(const u32x4*)(p + lane * 8), b = *(const u32x4*)(p + 512 + lane * 8);
        float x[8] = {bflo(a.x), bfhi(a.x), bflo(a.y), bfhi(a.y), bflo(a.z), bfhi(a.z), bflo(a.w), bfhi(a.w)};
        float y[8] = {bflo(b.x), bfhi(b.x), bflo(b.y), bfhi(b.y), bflo(b.z), bfhi(b.z), bflo(b.w), bfhi(b.w)};
        float sx = 0.f, sy = 0.f;
#pragma unroll
        for (int j = 0; j < 8; ++j) { sx += x[j] * x[j]; sy += y[j] * y[j]; }
        const float rx = 1.0f / sqrtf(wave_sum(sx) * (1.0f / 512.0f) + RMS_EPS), ry = 1.0f / sqrtf(wave_sum(sy) * (1.0f / 512.0f) + RMS_EPS);
        u32x4 oq, ok;
        oq.x = cvt_pk_bf16(x[0] * rx * wq0.x, x[1] * rx * wq0.y); oq.y = cvt_pk_bf16(x[2] * rx * wq0.z, x[3] * rx * wq0.w); oq.z = cvt_pk_bf16(x[4] * rx * wq1.x, x[5] * rx * wq1.y); oq.w = cvt_pk_bf16(x[6] * rx * wq1.z, x[7] * rx * wq1.w);
        ok.x = cvt_pk_bf16(y[0] * ry * wk0.x, y[1] * ry * wk0.y); ok.y = cvt_pk_bf16(y[2] * ry * wk0.z, y[3] * ry * wk0.w); ok.z = cvt_pk_bf16(y[4] * ry * wk1.x, y[5] * ry * wk1.y); ok.w = cvt_pk_bf16(y[6] * ry * wk1.z, y[7] * ry * wk1.w);
        *(u32x4*)(CQN + (size_t)t * 512 + lane * 8) = oq; *(u32x4*)(CKVN + (size_t)t * 512 + lane * 8) = ok;
        float v = bf2f(p[1024 + lane]); const float pr = __shfl_xor(v, 16);
        if (t >= NCTX) { const int pp = t - NCTX, pos = (lane & 32) ? (pp & 63) : (pp >> 6); const f32x2 cs = ((lane & 32) ? AXC : AXR)[pos * 16 + (lane & 15)];
            v = (lane & 16) ? v * cs.x + pr * cs.y : v * cs.x - pr * cs.y; }
        KR[(size_t)t * 64 + lane] = f2bf(v);
    }
}

namespace att {
constexpr int KVBLK = 64;
constexpr float SCALE = 0.07216878364870322f;
constexpr float THR = 8.f;
constexpr int SHM_K = 64 * 384, SHM_V = 64 * 256;
constexpr int A_V = 0, A_K = 3 * SHM_V, A_WS = 3 * SHM_V + 3 * SHM_K;
#define SBAR() __builtin_amdgcn_sched_barrier(0)
__device__ __forceinline__ int crow(int r, int hi) { return (r & 3) + 8 * (r >> 2) + 4 * hi; }
constexpr float PLIM = 4096.f;
__device__ __forceinline__ void exp_sum(f32x16& p0, f32x16& p1, float& ps) {
#pragma unroll
    for (int r = 0; r < 16; ++r) p0[r] = __builtin_amdgcn_exp2f(p0[r]);
#pragma unroll
    for (int r = 0; r < 16; ++r) p1[r] = __builtin_amdgcn_exp2f(p1[r]);
    ps = p0[0];
#pragma unroll
    for (int r = 1; r < 16; ++r) ps += p0[r];
#pragma unroll
    for (int r = 0; r < 16; ++r) ps += p1[r];
}
__device__ __forceinline__ float row_max32(const f32x16& p0, const f32x16& p1) {
    float pmax = p0[0];
#pragma unroll
    for (int r = 1; r < 16; ++r) pmax = fmaxf(pmax, p0[r]);
#pragma unroll
    for (int r = 0; r < 16; ++r) pmax = fmaxf(pmax, p1[r]);
    auto rr = __builtin_amdgcn_permlane32_swap(__float_as_uint(pmax), __float_as_uint(pmax), false, false);
    return fmaxf(__uint_as_float(rr[0]), __uint_as_float(rr[1]));
}
__device__ __forceinline__ void pack_p(const f32x16& p0, const f32x16& p1, bf16x8& pa0, bf16x8& pa1, bf16x8& pa2, bf16x8& pa3) {
#define PK4(P, BASE, OUT) do { unsigned a0 = cvt_pk_bf16(P[BASE + 0], P[BASE + 1]), a1 = cvt_pk_bf16(P[BASE + 2], P[BASE + 3]);   \
    unsigned b0 = cvt_pk_bf16(P[BASE + 4], P[BASE + 5]), b1 = cvt_pk_bf16(P[BASE + 6], P[BASE + 7]);                              \
    auto r0 = __builtin_amdgcn_permlane32_swap(a0, b0, false, false); auto r1 = __builtin_amdgcn_permlane32_swap(a1, b1, false, false); \
    u32x4 w = {r0[0], r1[0], r0[1], r1[1]}; OUT = *reinterpret_cast<bf16x8*>(&w); } while (0)
    PK4(p0, 0, pa0); PK4(p0, 8, pa1); PK4(p1, 0, pa2); PK4(p1, 8, pa3);
#undef PK4
}
__device__ __forceinline__ int kswz(int row, int g) { return row * 384 + (((g & ~7) | ((g & 7) ^ ((row >> 1) & 7))) << 4); }
__device__ __forceinline__ void qkt(f32x16& p0, f32x16& p1, const LAS unsigned char* Ks, const bf16x8 (&qr)[12], const int (&kx)[4], const f32x16& init) {
    bf16x8 c0 = *(const LAS bf16x8*)(Ks + kx[0]), c1 = *(const LAS bf16x8*)(Ks + kx[0] + 32 * 384), n0, n1;
#pragma unroll
    for (int d0 = 0; d0 < 12; ++d0) {
        if (d0 < 11) { n0 = *(const LAS bf16x8*)(Ks + kx[(d0 + 1) & 3] + ((d0 + 1) >> 2) * 128); n1 = *(const LAS bf16x8*)(Ks + kx[(d0 + 1) & 3] + ((d0 + 1) >> 2) * 128 + 32 * 384); }
        __builtin_amdgcn_sched_barrier(0);
        p0 = MFMA32(c0, qr[d0], d0 == 0 ? init : p0);
        p1 = MFMA32(c1, qr[d0], d0 == 0 ? init : p1);
        __builtin_amdgcn_sched_barrier(0);
        c0 = n0; c1 = n1; }
}
__device__ __forceinline__ int v_st(int k, int c) { const int kk = (k & ~0xC) | ((k & 4) << 1) | ((k & 8) >> 1); return ((kk >> 3) * 4 + (c >> 5)) * 512 + ((kk & 7) * 32 + (c & 31)) * 2; }
__device__ __forceinline__ int v_rd_base(int lane) { return ((lane & 3) << 3) | (((lane >> 2) & 3) << 6) | (((lane >> 4) & 1) << 5) | (((lane >> 5) & 1) << 8); }
constexpr int v_rd_off(int d0, int ks, int half) { return d0 * 512 + ks * 4096 + half * 2048; }
template <int OFF> __device__ __forceinline__ s16x4 tr_read(int vb) {
    s16x4 r; asm volatile("ds_read_b64_tr_b16 %0, %1 offset:%2" : "=&v"(r) : "v"(vb), "i"(OFF) : "memory"); return r;
}
template <int D0> __device__ __forceinline__ void pv_one(f32x16& od, int vb, bf16x8 pa0, bf16x8 pa1, bf16x8 pa2, bf16x8 pa3) {
    const s16x4 l0 = tr_read<v_rd_off(D0, 0, 0)>(vb), h0 = tr_read<v_rd_off(D0, 0, 1)>(vb), l1 = tr_read<v_rd_off(D0, 1, 0)>(vb), h1 = tr_read<v_rd_off(D0, 1, 1)>(vb);
    const s16x4 l2 = tr_read<v_rd_off(D0, 2, 0)>(vb), h2 = tr_read<v_rd_off(D0, 2, 1)>(vb), l3 = tr_read<v_rd_off(D0, 3, 0)>(vb), h3 = tr_read<v_rd_off(D0, 3, 1)>(vb);
    asm volatile("s_waitcnt lgkmcnt(0)" ::: "memory"); SBAR();
#define PK(L, H) (bf16x8){L[0], L[1], L[2], L[3], H[0], H[1], H[2], H[3]}
    od = MFMA32(pa0, PK(l0, h0), od);
    od = MFMA32(pa1, PK(l1, h1), od);
    od = MFMA32(pa2, PK(l2, h2), od);
    od = MFMA32(pa3, PK(l3, h3), od);
#undef PK
}
__device__ __forceinline__ void pv_d0(f32x16 (&o)[4], int vb, bf16x8 pa0, bf16x8 pa1, bf16x8 pa2, bf16x8 pa3) {
    pv_one<0>(o[0], vb, pa0, pa1, pa2, pa3); pv_one<1>(o[1], vb, pa0, pa1, pa2, pa3); pv_one<2>(o[2], vb, pa0, pa1, pa2, pa3); pv_one<3>(o[3], vb, pa0, pa1, pa2, pa3);
}
__device__ __forceinline__ void rope_pair(bf16x8& a, bf16x8& b, const f32x2* cs) {
    u32x4 ua = *reinterpret_cast<u32x4*>(&a), ub = *reinterpret_cast<u32x4*>(&b); u32x4 oa, ob;
#pragma unroll
    for (int j = 0; j < 4; ++j) { const f32x2 c0 = cs[2 * j], c1 = cs[2 * j + 1];
        const float x1l = bflo(ua[j]), x1h = bfhi(ua[j]), x2l = bflo(ub[j]), x2h = bfhi(ub[j]);
        oa[j] = cvt_pk_bf16(x1l * c0.x - x2l * c0.y, x1h * c1.x - x2h * c1.y);
        ob[j] = cvt_pk_bf16(x2l * c0.x + x1l * c0.y, x2h * c1.x + x1h * c1.y); }
    a = *reinterpret_cast<bf16x8*>(&oa); b = *reinterpret_cast<bf16x8*>(&ob);
}
__device__ __forceinline__ void unit(Frame& F, int h, int qrow0, int nkeys) {
    LAS unsigned char* lds = F.lds;
    PHASE_IDS(); const int wid = wave, r32 = lane & 31, hi = lane >> 5;
    const bf16* QB = (const bf16*)(F.ws + WS_QB); const bf16* KVB = (const bf16*)(F.ws + WS_KVB); const bf16* KR = (const bf16*)(F.ws + WS_KR);
    LAS unsigned char* V_lds = lds + A_V; LAS unsigned char* K_lds = lds + A_K;
    LAS float* wsl = (LAS float*)(lds + A_WS) + wid * 64; LAS float* li_l = wsl; LAS float* al_l = wsl + 32;
    float m_reg = -1e30f, l_reg = 0; f32x16 o[4] = {}; bf16x8 qr[12]; f32x16 negm;
    const int qt = qrow0 + wid * 32 + r32;
    const bf16* Qw = QB + (size_t)qt * 3072 + 192 * h + hi * 8;
#pragma unroll
    for (int d0 = 0; d0 < 12; ++d0) qr[d0] = *(const bf16x8*)(Qw + d0 * 16);
    if (qt >= NCTX) { const int pp = qt - NCTX;
        rope_pair(qr[8], qr[9], (const f32x2*)(F.ws + WS_AXR) + (pp >> 6) * 16 + hi * 8);
        rope_pair(qr[10], qr[11], (const f32x2*)(F.ws + WS_AXC) + (pp & 63) * 16 + hi * 8); }
    const unsigned char* wsb = F.ws;
    unsigned koff[3], kfl = 0u; int kdst[3];
#pragma unroll
    for (int i = 0; i < 3; ++i) { const int id = tid + 512 * i, row = id / 24, g = id % 24;
        if (g < 16) { koff[i] = (unsigned)WS_KVB + (unsigned)(row * 4096 + 256 * h + g * 8) * 2u; kfl |= 1u << i; } else { koff[i] = (unsigned)WS_KR + (unsigned)(row * 64 + (g - 16) * 8) * 2u; }
        kdst[i] = kswz(row, g); }
    const int sr = tid >> 4, sc = (tid & 15) * 8, vst0 = v_st(sr, sc);
    const unsigned voff = (unsigned)WS_KVB + (unsigned)(sr * 4096 + 256 * h + 128 + sc) * 2u;
    const int vb0 = (int)(unsigned)(uintptr_t)V_lds + v_rd_base(lane);
    int kx[4];
#pragma unroll
    for (int q = 0; q < 4; ++q) kx[q] = r32 * 384 + ((((2 * q) | hi) ^ ((r32 >> 1) & 7)) << 4);
    bf16x8 sk0, sk1, sk2, sv0, sv1;
#define SLOAD(jt) do { const unsigned vo_ = voff + (unsigned)(jt) * (64u * 4096u * 2u); sv0 = *(const bf16x8*)(wsb + vo_); sv1 = *(const bf16x8*)(wsb + vo_ + 32u * 4096u * 2u); \
    const unsigned kt_ = (unsigned)(jt) * 8192u; \
    sk0 = *(const bf16x8*)(wsb + koff[0] + (kt_ << ((kfl & 1u) * 6u))); sk1 = *(const bf16x8*)(wsb + koff[1] + (kt_ << (((kfl >> 1) & 1u) * 6u))); sk2 = *(const bf16x8*)(wsb + koff[2] + (kt_ << (((kfl >> 2) & 1u) * 6u))); } while (0)
#define SWRITE(b) do { *(LAS bf16x8*)(V_lds + (b) * SHM_V + vst0) = sv0; *(LAS bf16x8*)(V_lds + (b) * SHM_V + vst0 + 8192) = sv1; \
    *(LAS bf16x8*)(K_lds + (b) * SHM_K + kdst[0]) = sk0; *(LAS bf16x8*)(K_lds + (b) * SHM_K + kdst[1]) = sk1; *(LAS bf16x8*)(K_lds + (b) * SHM_K + kdst[2]) = sk2; } while (0)
#define SWAIT() asm volatile("s_waitcnt vmcnt(0)" ::: "memory")
#define NEGM_SET(v) do { const float v_ = (v); _Pragma("unroll") for (int r = 0; r < 16; ++r) negm[r] = v_; asm volatile("" : "+v"(negm)); } while (0)
    f32x16 p0, p1; bf16x8 pa0, pa1, pa2, pa3; const int NT = nkeys / KVBLK;
    NEGM_SET(0.f);
#define ABAR() do { asm volatile("s_waitcnt lgkmcnt(0)" ::: "memory"); __builtin_amdgcn_s_barrier(); asm volatile("" ::: "memory"); } while (0)
#define ASTAGE(j) do { if ((j) + 1 < NT) { SWAIT(); SWRITE(b1); } if ((j) + 2 < NT) SLOAD((j) + 2); } while (0)
#define AQK(j) do { SBAR(); qkt(p0, p1, K_lds + b0 * SHM_K, qr, kx, negm); SBAR(); } while (0)
#define RARE(j) do { _Pragma("nounroll") for (int pass_ = 0; pass_ < 2; ++pass_) { NEGM_SET(pass_ ? -m_reg : 0.f); AQK(j); \
      if (pass_ == 0) { const float mnew_ = fmaxf(m_reg, row_max32(p0, p1)); const float a_ = __builtin_amdgcn_exp2f(m_reg - mnew_); m_reg = mnew_; l_reg *= a_; \
        if (hi == 0) al_l[r32] = a_; asm volatile("s_waitcnt lgkmcnt(0)" ::: "memory"); \
        _Pragma("unroll") for (int d = 0; d < 4; ++d) { SBAR(); _Pragma("unroll") for (int r = 0; r < 16; ++r) o[d][r] *= al_l[crow(r, hi)]; } SBAR(); } } } while (0)
#define ASP(j) do { float ps; exp_sum(p0, p1, ps); \
    if (__builtin_expect((j) == 0 || __any(!(ps <= PLIM)), 0)) { RARE(j); exp_sum(p0, p1, ps); } \
    { auto rr = __builtin_amdgcn_permlane32_swap(__float_as_uint(ps), __float_as_uint(ps), false, false); l_reg += __uint_as_float(rr[0]) + __uint_as_float(rr[1]); } \
    pack_p(p0, p1, pa0, pa1, pa2, pa3); SBAR(); pv_d0(o, vb0 + b0 * SHM_V, pa0, pa1, pa2, pa3); } while (0)
    SLOAD(0); SWAIT(); SWRITE(0); SLOAD(1); ABAR();
    { const bool g1 = __builtin_amdgcn_readfirstlane(wid >> 2) != 0;
      if (g1) ABAR();
      int b0 = 0;
      for (int j = 0; j < NT; ++j) { const int b1 = b0 == 2 ? 0 : b0 + 1; ASTAGE(j); AQK(j); ABAR(); ASP(j); ABAR(); b0 = b1; }
      if (!g1) ABAR(); }
#undef ABAR
#undef ASTAGE
#undef AQK
#undef ASP
#undef RARE
#undef NEGM_SET
    if (hi == 0) li_l[r32] = l_reg; asm volatile("s_waitcnt lgkmcnt(0)" ::: "memory");
    float rli[16];
#pragma unroll
    for (int r = 0; r < 16; ++r) rli[r] = __builtin_amdgcn_rcpf(li_l[crow(r, hi)]);
    unsigned orow0 = (unsigned)(qrow0 + wid * 32) * DM + 128 * h; asm volatile("" : "+v"(orow0));
    bf16* Ow = (bf16*)(F.ws + WS_MIX) + orow0;
#pragma unroll
    for (int r = 0; r < 16; ++r) { const int orow = crow(r, hi);
#pragma unroll
        for (int d0 = 0; d0 < 4; ++d0) Ow[(size_t)orow * DM + d0 * 32 + r32] = f2bf(o[d0][r] * rli[r]); }
    __syncthreads();
#undef SLOAD
#undef SWRITE
#undef SWAIT
}
}

__device__ __forceinline__ void attn_phase(Frame& F) {
    for (int u = F.vcu; u < 1024 + 16; u += F.G) {
        if (u < 1024) att::unit(F, u >> 6, NCTX + 256 * (u & 63), T);
        else att::unit(F, u - 1024, 0, NCTX);
    }
}

#ifdef DBG
constexpr int DBG_W_BAD = 64, DBG_W_SSQ = 65, DBG_W_CNT = 66, DBG_W_MAX = 67;
__device__ __forceinline__ void dbg_scan(Frame& F, int id, size_t off, size_t nbytes, bool is_bf) {
    PHASE_IDS();
    const u32x4* p = (const u32x4*)(F.ws + off); const size_t n = nbytes / 16; bool bad = false;
    for (size_t i = (size_t)F.vcu * NTHR + tid; i < n; i += (size_t)F.G * NTHR) { const u32x4 v = p[i];
#pragma unroll
        for (int j = 0; j < 4; ++j) { if (is_bf) { bad |= ((v[j] & 0x7f80u) == 0x7f80u) | ((v[j] & 0x7f800000u) == 0x7f800000u); } else bad |= ((v[j] & 0x7f800000u) == 0x7f800000u); } }
    if (__any(bad) && lane == 0) atomicMax((unsigned*)(F.ws + WS_CTL) + DBG_W_BAD, (unsigned)(100000 - id));
}
__device__ __forceinline__ void dbg_max(Frame& F, size_t off, size_t nbytes, bool is_bf) {
    PHASE_IDS();
    const u32x4* p = (const u32x4*)(F.ws + off); const size_t n = nbytes / 16; unsigned mx = 0u;
    for (size_t i = (size_t)F.vcu * NTHR + tid; i < n; i += (size_t)F.G * NTHR) { const u32x4 v = p[i];
#pragma unroll
        for (int j = 0; j < 4; ++j) { if (is_bf) { const unsigned a0 = (v[j] << 16) & 0x7fffffffu, a1 = v[j] & 0x7fff0000u; if (a0 < 0x7f800000u) mx = max(mx, a0); if (a1 < 0x7f800000u) mx = max(mx, a1); } else { const unsigned a0 = v[j] & 0x7fffffffu; if (a0 < 0x7f800000u) mx = max(mx, a0); } } }
#pragma unroll
    for (int o = 1; o < 64; o <<= 1) mx = max(mx, (unsigned)__shfl_xor((int)mx, o));
    if (lane == 0) atomicMax((unsigned*)(F.ws + WS_CTL) + DBG_W_MAX, mx);
}
#define DBGSCAN(id, off, nbytes, isbf) dbg_scan(F, (id), (off), (nbytes), (isbf))
#else
#define DBGSCAN(id, off, nbytes, isbf) do {} while (0)
#endif

#ifndef RES_ALIGN
#define RES_ALIGN true
#endif
#ifndef RES_SP2
#define RES_SP2 true
#endif
__global__ void __launch_bounds__(NTHR, 2) fwd_kernel(Args args) {
    extern __shared__ __attribute__((aligned(16))) unsigned char lds_raw[];
    Frame F;
    F.lds = (LAS unsigned char*)lds_raw;
    F.G = gridDim.x; { const int bx = blockIdx.x; F.vcu = (F.G % 8 == 0) ? (bx % 8) * (F.G / 8) + bx / 8 : bx; }
    F.a = &args; F.ws = args.ws;
    volatile LAS unsigned* ctlw = (volatile LAS unsigned*)(F.lds + LDS_CTL);
    if (threadIdx.x < 16) ctlw[threadIdx.x] = 0u;
    __syncthreads();
    XcdBarrier bar = xcd_barrier_post((unsigned*)(F.ws + WS_CTL) + 4096, ctlw);
#define GRID_BAR() xcd_barrier(bar)
#ifdef DBG_TIME
    unsigned long long t_prev = __builtin_amdgcn_s_memrealtime();
#define TSTAMP(cat) do { if (blockIdx.x == 0 && threadIdx.x == 0) { const unsigned long long t_now = __builtin_amdgcn_s_memrealtime(); unsigned long long* tw = (unsigned long long*)(F.ws + WS_CTL) + 64 + (cat); *tw = *tw + (t_now - t_prev); t_prev = t_now; } } while (0)
#else
#define TSTAMP(cat) do {} while (0)
#endif

#ifndef SK_P0
    p0a(F);
#ifdef DUP_P0
    p0a(F);
#endif
#endif
    GRID_BAR();
    p0b(F); GRID_BAR();
    DBGSCAN(1, WS_MOD, (size_t)4 * 2 * NADA * 4, false);
    init_x_by_owners(F);
    row_phase<0>(F, nullptr, nullptr, modp(F, 0, 0, 0), modp(F, 0, 0, 1), modp(F, 0, 1, 0), modp(F, 0, 1, 1)); GRID_BAR(); TSTAMP(0);
    DBGSCAN(2, WS_X, (size_t)T * DM * 4, false); DBGSCAN(3, WS_H, (size_t)T * DM * 2, true);

    const pg8::bf16_t* Hb = (const pg8::bf16_t*)(F.ws + WS_H);
    for (int s = 0; s < 3 * DEPTH; ++s) {
        const int l = s / 3, r = s % 3;
        const pg8::bf16_t* A2; const pg8::bf16_t* B2; int K2;
        if (r != 1) {
            const int f = r >> 1;
            pg8::Gemm g{Hb, (const pg8::bf16_t*)(F.ws + WS_WFI + (size_t)(l * 2 + f) * SZ_WFI), T, 2 * DFF, DM, DM, DM};
            pg8::StaticOrder S; S.init(T, 2 * DFF, F.G, (int)blockIdx.x);
            pg8::EpiSwiGLU E{(pg8::bf16_t*)(F.ws + WS_HID), DFF};
#ifndef SK_SW
            pg8::gemm_phase<pg8::EpiSwiGLU, pg8::StaticOrder>(F.lds, g, S, E);
#endif
#ifdef DUP_SW
            pg8::gemm_phase<pg8::EpiSwiGLU, pg8::StaticOrder>(F.lds, g, S, E);
#endif
            GRID_BAR(); TSTAMP(1);
            DBGSCAN(10 + 10 * s, WS_HID, (size_t)T * DFF * 2, true);
            A2 = (const pg8::bf16_t*)(F.ws + WS_HID); B2 = (const pg8::bf16_t*)(F.ws + WS_WFO + (size_t)(l * 2 + f) * SZ_WFO); K2 = DFF;
        } else if ((l & 1) == 0) {
            const int e = l >> 1;
            { pg8::Gemm g{Hb, (const pg8::bf16_t*)(F.ws + WS_EWI + (size_t)e * SZ_EWI), T, EV_N, DM, DM, DM};
              pg8::StaticOrder S; S.init(T, EV_N, F.G, (int)blockIdx.x);
              pg8::EpiBf16 E{(pg8::bf16_t*)(F.ws + WS_PROJ), EV_N};
#ifndef SK_G1
              pg8::gemm_phase<pg8::EpiBf16, pg8::StaticOrder>(F.lds, g, S, E);
#endif
            }
            GRID_BAR(); TSTAMP(4);
            DBGSCAN(10 + 10 * s, WS_PROJ, (size_t)T * EV_N * 2 - 0, true);
#ifdef DBG
            if (s == 1) dbg_max(F, WS_PROJ, (size_t)T * EV_N * 2, true);
#endif
#ifndef SK_S1
            s1_phase(F, e);
#ifdef DUP_S1
            s1_phase(F, e);
#endif
#endif
            GRID_BAR(); TSTAMP(5);
            DBGSCAN(11 + 10 * s, WS_U, SZ_U, true); DBGSCAN(16 + 10 * s, WS_OI, (size_t)T * DM * 4, false); DBGSCAN(17 + 10 * s, WS_QT, (size_t)2 * T * 1024 * 2, true); DBGSCAN(18 + 10 * s, WS_DEC, (size_t)2 * 8 * NCH * 128 * 4, false);
#ifndef SK_S2
            s2_phase(F);
#ifdef DUP_S2
            s2_phase(F);
#endif
#endif
            GRID_BAR(); TSTAMP(6);
            DBGSCAN(12 + 10 * s, WS_S, SZ_U, true);
#ifndef SK_S3
            s3_phase(F, e);
#ifdef DUP_S3
            s3_phase(F, e);
#endif
#endif
            GRID_BAR(); TSTAMP(7);
            DBGSCAN(13 + 10 * s, WS_MIX, (size_t)T * DM * 2, true);
            A2 = (const pg8::bf16_t*)(F.ws + WS_MIX); B2 = (const pg8::bf16_t*)(F.ws + WS_EWO + (size_t)e * SZ_SQ); K2 = DM;
        } else {
            const int o = l >> 1;
            { pg8::Gemm g{Hb, (const pg8::bf16_t*)(F.ws + WS_OWI + (size_t)o * SZ_OWI), T, OD_N, DM, DM, DM};
              pg8::StaticOrder S; S.init(T, OD_N, F.G, (int)blockIdx.x);
              pg8::EpiBf16 E{(pg8::bf16_t*)(F.ws + WS_PROJ), OD_N};
#ifndef SK_G2
              pg8::gemm_phase<pg8::EpiBf16, pg8::StaticOrder>(F.lds, g, S, E);
#endif
            }
            GRID_BAR();
#ifndef SK_E1
            e1_phase(F, o);
#endif
            GRID_BAR();
            DBGSCAN(11 + 10 * s, WS_CQN, (size_t)T * 512 * 2 * 2, true); DBGSCAN(11 + 10 * s, WS_KR, (size_t)T * 64 * 2, true);
            for (int q = 0; q < 2; ++q) {
                pg8::Gemm g{(const pg8::bf16_t*)(F.ws + (q ? WS_CKVN : WS_CQN)), (const pg8::bf16_t*)(F.ws + (q ? WS_OUKV + (size_t)o * SZ_OUKV : WS_OUQ + (size_t)o * SZ_OUQ)), T, q ? 4096 : 3072, 512, 512, 512};
                pg8::StaticOrder S; S.init(T, g.N, F.G, (int)blockIdx.x);
                pg8::EpiBf16 E{(pg8::bf16_t*)(F.ws + (q ? WS_KVB : WS_QB)), g.N};
#ifndef SK_G3
                pg8::gemm_phase<pg8::EpiBf16, pg8::StaticOrder>(F.lds, g, S, E);
#endif
            }
            GRID_BAR(); TSTAMP(8);
            DBGSCAN(12 + 10 * s, WS_QB, (size_t)T * 3072 * 2, true); DBGSCAN(12 + 10 * s, WS_KVB, (size_t)T * 4096 * 2, true);
#ifndef SK_ATT
            attn_phase(F);
#ifdef DUP_ATT
            attn_phase(F);
#endif
#endif
            GRID_BAR(); TSTAMP(9);
            DBGSCAN(13 + 10 * s, WS_MIX, (size_t)T * DM * 2, true);
            A2 = (const pg8::bf16_t*)(F.ws + WS_MIX); B2 = (const pg8::bf16_t*)(F.ws + WS_OWO + (size_t)o * SZ_SQ); K2 = DM;
        }
        {
            pg8::Gemm g{A2 + (size_t)NCTX * K2, B2, NLAT, DM, K2, K2, K2};
            pg8::StaticOrder S; S.init(NLAT, DM, F.G, (int)blockIdx.x);
            const int sp = s > 0 ? s - 1 : 0;
            const float* plng = F.a->in[6] + (size_t)sp * DM; const float* plnb = F.a->in[7] + (size_t)sp * DM; const float* stat = (const float*)(F.ws + WS_STAT);
            pg8::EpiResid E{(float*)(F.ws + WS_X) + (size_t)NCTX * DM, modp(F, l, 0, 3 * r + 2), (r != 1) ? 0.5f : 1.0f, stat + (size_t)NCTX * 2, plng, plnb, s > 0 ? 1 : 0};
            ctx_resid_small(F, (float*)(F.ws + WS_X), (const bf16*)A2, (const bf16*)B2, K2, modp(F, l, 1, 3 * r + 2), (r != 1) ? 0.5f : 1.0f, stat, plng, plnb, s > 0 ? 1 : 0, 1);
#ifndef SK_RES
            pg8::gemm_phase<pg8::EpiResid, pg8::StaticOrder, RES_ALIGN, RES_SP2>(F.lds, g, S, E);
#endif
            ctx_resid_small(F, (float*)(F.ws + WS_X), (const bf16*)A2, (const bf16*)B2, K2, modp(F, l, 1, 3 * r + 2), (r != 1) ? 0.5f : 1.0f, stat, plng, plnb, s > 0 ? 1 : 0, 0);
#ifdef DUP_SMALL_OFF
            ctx_resid_small(F, (float*)(F.ws + WS_OI), (const bf16*)A2, (const bf16*)B2, K2, modp(F, l, 1, 3 * r + 2), (r != 1) ? 0.5f : 1.0f);
            ctx_resid_small(F, (float*)(F.ws + WS_OI), (const bf16*)A2, (const bf16*)B2, K2, modp(F, l, 1, 3 * r + 2), (r != 1) ? 0.5f : 1.0f);
#endif
#ifdef DUP_RES
            { pg8::EpiResid E2{(float*)(F.ws + WS_OI) + (size_t)NCTX * DM, modp(F, l, 0, 3 * r + 2), 0.5f, stat, plng, plnb, 0};
              pg8::gemm_phase<pg8::EpiResid, pg8::StaticOrder>(F.lds, g, S, E2); }
#endif
        }
        GRID_BAR(); TSTAMP(r != 1 ? 2 : 10);
        DBGSCAN(14 + 10 * s, WS_X, (size_t)T * DM * 4, false);
        const float* lng = F.a->in[6] + (size_t)(l * 3 + r) * DM; const float* lnb = F.a->in[7] + (size_t)(l * 3 + r) * DM;
        if (s + 1 < 3 * DEPTH) { const int l2 = (s + 1) / 3, r2 = (s + 1) % 3;
            row_phase<1>(F, lng, lnb, modp(F, l2, 0, 3 * r2), modp(F, l2, 0, 3 * r2 + 1), modp(F, l2, 1, 3 * r2), modp(F, l2, 1, 3 * r2 + 1));
            GRID_BAR(); TSTAMP(3);
            DBGSCAN(15 + 10 * s, WS_X, (size_t)T * DM * 4, false); DBGSCAN(15 + 10 * s, WS_H, (size_t)T * DM * 2, true);
#if defined(DBG) && defined(DBG_STOP)
            if (s == DBG_STOP) break;
#endif
        } else {
#ifndef DBG
            row_phase<2>(F, lng, lnb, nullptr, nullptr, nullptr, nullptr);
#endif
        }
    }
#ifdef DBG_TIME
    {   PHASE_IDS(); GRID_BAR();
        const unsigned long long* tw = (const unsigned long long*)(F.ws + WS_CTL) + 64;
        const float tA = (float)__hip_atomic_load(tw + DBG_TA, RLX_AGENT) * 1e-5f, tB = (float)__hip_atomic_load(tw + DBG_TB, RLX_AGENT) * 1e-5f;
        const float cB = DBG_TSCALE * tB, cA = cB; (void)tA;
        float* out = F.a->out;
        for (size_t i = (size_t)F.vcu * NTHR + tid; i < (size_t)NLAT * DM; i += (size_t)F.G * NTHR) out[i] = (i == 12345) ? cA : cB;
    }
#endif
#ifdef DBG
    {
        PHASE_IDS();
        const float* X = (const float*)(F.ws + WS_X); float ssq = 0.f; float cnt = 0.f;
        for (size_t i = (size_t)F.vcu * NTHR + tid; i < (size_t)T * DM; i += (size_t)F.G * NTHR) { const float v = X[i]; if ((__float_as_uint(v) & 0x7f800000u) != 0x7f800000u) { ssq += v * v; cnt += 1.f; } }
        ssq = wave_sum(ssq); cnt = wave_sum(cnt);
        if (lane == 0) { atomicAdd((float*)(F.ws + WS_CTL) + DBG_W_SSQ, ssq); atomicAdd((float*)(F.ws + WS_CTL) + DBG_W_CNT, cnt); }
        GRID_BAR();
        const unsigned badw = __hip_atomic_load((unsigned*)(F.ws + WS_CTL) + DBG_W_BAD, RLX_AGENT);
        const float tss = __hip_atomic_load((float*)(F.ws + WS_CTL) + DBG_W_SSQ, RLX_AGENT), tcn = __hip_atomic_load((float*)(F.ws + WS_CTL) + DBG_W_CNT, RLX_AGENT);
        const float rms = sqrtf(tss / fmaxf(tcn, 1.f)); float cB = fminf(10.f * rms, 1000.f);
#ifdef DBG_REPORT_MAX
        { const unsigned mw = __hip_atomic_load((unsigned*)(F.ws + WS_CTL) + DBG_W_MAX, RLX_AGENT); cB = fminf(log2f(1.0f + __uint_as_float(mw)), 120.f); }
#endif
        const float cA = badw ? (float)(100000u - badw) * 10.f : 5.f;
        float* out = F.a->out;
        for (size_t i = (size_t)F.vcu * NTHR + tid; i < (size_t)NLAT * DM; i += (size_t)F.G * NTHR) out[i] = (i == 12345) ? cA + 0.f : cB;
        (void)cA;
    }
#endif
}

extern "C" void kernel_launch(void* const* d_in, const int* in_sizes, int n_in, void* d_out, int out_size, void* d_ws, size_t ws_size, hipStream_t stream) {
    static int grid = 0;
    if (grid == 0) {
        if (n_in != 23 || out_size != NLAT * DM || ws_size < WS_END) { fprintf(stderr, "kernel_launch: unexpected shapes: n_in %d out %d ws %zu (need %zu)\n", n_in, out_size, ws_size, (size_t)WS_END); grid = -1; return; }
        int dev = 0, cus = 0, per_cu = 0;
        if (hipGetDevice(&dev) != hipSuccess || hipDeviceGetAttribute(&cus, hipDeviceAttributeMultiprocessorCount, dev) != hipSuccess) { grid = -1; return; }
        if (hipFuncSetAttribute((const void*)fwd_kernel, hipFuncAttributeMaxDynamicSharedMemorySize, LDS_BYTES) != hipSuccess) { fprintf(stderr, "kernel_launch: hipFuncSetAttribute failed\n"); grid = -1; return; }
        if (hipOccupancyMaxActiveBlocksPerMultiprocessor(&per_cu, (const void*)fwd_kernel, NTHR, LDS_BYTES) != hipSuccess || per_cu < 1) fprintf(stderr, "kernel_launch: occupancy query reports %d\n", per_cu);
        (void)hipGetLastError();
        grid = cus;
    }
    if (grid < 0) return;
    (void)hipMemsetAsync((char*)d_ws + WS_CTL, 0, CTL_BYTES, stream);
    Args a{};
    for (int i = 0; i < 23; ++i) a.in[i] = (const float*)d_in[i];
    a.out = (float*)d_out; a.ws = (unsigned char*)d_ws;
    hipLaunchKernelGGL(fwd_kernel, dim3(grid), dim3(NTHR), LDS_BYTES, stream, a);
    const hipError_t le = hipPeekAtLastError();
    if (le != hipSuccess) fprintf(stderr, "kernel_launch: launch failed: %s\n", hipGetErrorName(le));
}
```

```cpp
#include <hip/hip_runtime.h>
#include <cstdio>
#include <cstdint>

#define GAS __attribute__((address_space(1)))
#define LAS __attribute__((address_space(3)))
typedef unsigned short bf16;
typedef short bf16x8 __attribute__((ext_vector_type(8)));
typedef short s16x4 __attribute__((ext_vector_type(4)));
typedef float f32x4 __attribute__((ext_vector_type(4)));
typedef float f32x2 __attribute__((ext_vector_type(2)));
typedef float f32x16 __attribute__((ext_vector_type(16)));
typedef unsigned u32x4 __attribute__((ext_vector_type(4)));
typedef unsigned u32x2 __attribute__((ext_vector_type(2)));

constexpr int DM = 2048, NCTX = 256, NLAT = 16384, T = NCTX + NLAT, DEPTH = 4, DFF = 5504;
constexpr int NADA = 9 * DM;
constexpr int EV_N = 6400, OD_N = 1280;
constexpr int NCH = T / 64;
constexpr float DN_ALPHA = 1.6817928305074290f;
constexpr float LN_EPS = 1e-5f, RMS_EPS = 1e-6f;
constexpr int NWAVES = 8, NTHR = 512;
constexpr int LDS_BYTES = 147456;
constexpr int LDS_CTL = LDS_BYTES - 256;

constexpr size_t al256(size_t x) { return (x + 255) / 256 * 256; }
constexpr size_t WS_CTL = 0, CTL_BYTES = 1u << 20;
constexpr size_t WS_MODP = WS_CTL + CTL_BYTES;
constexpr size_t WS_MOD = WS_MODP + al256((size_t)8 * 2 * 4 * NADA * 4);
constexpr size_t WS_RT = WS_MOD + al256((size_t)4 * 2 * NADA * 4);
constexpr size_t WS_AXR = WS_RT + al256((size_t)NLAT * 64 * 8);
constexpr size_t WS_AXC = WS_AXR + al256(256 * 16 * 8);
constexpr size_t WS_STAT = WS_AXC + al256(64 * 16 * 8);
constexpr size_t WS_WFI = WS_STAT + al256((size_t)T * 8);
constexpr size_t SZ_WFI = (size_t)2 * DFF * DM * 2;
constexpr size_t WS_WFO = WS_WFI + 8 * SZ_WFI;
constexpr size_t SZ_WFO = (size_t)DM * DFF * 2;
constexpr size_t WS_EWI = WS_WFO + 8 * SZ_WFO;
constexpr size_t SZ_EWI = (size_t)EV_N * DM * 2;
constexpr size_t WS_EWO = WS_EWI + 2 * SZ_EWI;
constexpr size_t SZ_SQ = (size_t)DM * DM * 2;
constexpr size_t WS_OWI = WS_EWO + 2 * SZ_SQ;
constexpr size_t SZ_OWI = (size_t)OD_N * DM * 2;
constexpr size_t WS_OUQ = WS_OWI + 2 * SZ_OWI;
constexpr size_t SZ_OUQ = (size_t)3072 * 512 * 2;
constexpr size_t WS_OUKV = WS_OUQ + 2 * SZ_OUQ;
constexpr size_t SZ_OUKV = (size_t)4096 * 512 * 2;
constexpr size_t WS_OWO = WS_OUKV + 2 * SZ_OUKV;
constexpr size_t WS_X = WS_OWO + 2 * SZ_SQ;
constexpr size_t WS_H = WS_X + (size_t)T * DM * 4;
constexpr size_t WS_HID = WS_H + (size_t)T * DM * 2;
constexpr size_t WS_MIX = WS_HID + (size_t)T * DFF * 2;
constexpr size_t WS_PROJ = WS_MIX + (size_t)T * DM * 2;
constexpr size_t WS_U = WS_PROJ + (size_t)T * EV_N * 2;
constexpr size_t SZ_U = (size_t)2 * 8 * NCH * 256 * 128 * 2;
constexpr size_t WS_S = WS_U + SZ_U;
constexpr size_t WS_OI = WS_S + SZ_U;
constexpr size_t WS_QT = WS_OI + (size_t)T * DM * 4;
constexpr size_t WS_DEC = WS_QT + (size_t)2 * T * 1024 * 2;
constexpr size_t WS_END_EVEN = WS_DEC + al256((size_t)2 * 8 * NCH * 128 * 4);
constexpr size_t WS_CQN = WS_U;
constexpr size_t WS_CKVN = WS_CQN + (size_t)T * 512 * 2;
constexpr size_t WS_KR = WS_CKVN + (size_t)T * 512 * 2;
constexpr size_t WS_QB = WS_KR + al256((size_t)T * 64 * 2);
constexpr size_t WS_KVB = WS_QB + (size_t)T * 3072 * 2;
constexpr size_t WS_END_ODD = WS_KVB + (size_t)T * 4096 * 2;
constexpr size_t WS_END = WS_END_EVEN > WS_END_ODD ? WS_END_EVEN : WS_END_ODD;

#define RLX_AGENT __ATOMIC_RELAXED, __HIP_MEMORY_SCOPE_AGENT
#define LDS_WAIT() asm volatile("s_waitcnt lgkmcnt(0)" ::: "memory")
#define VM_WAIT() asm volatile("s_waitcnt vmcnt(0)" ::: "memory")
__device__ __forceinline__ unsigned cvt_pk_bf16(float lo, float hi) { unsigned r; asm volatile("v_cvt_pk_bf16_f32 %0, %1, %2" : "=v"(r) : "v"(lo), "v"(hi)); return r; }
__device__ __forceinline__ float bflo(unsigned w) { return __uint_as_float(w << 16); }
__device__ __forceinline__ float bfhi(unsigned w) { return __uint_as_float(w & 0xffff0000u); }
__device__ __forceinline__ float bf2f(bf16 b) { return __uint_as_float(((unsigned)b) << 16); }
__device__ __forceinline__ bf16 f2bf(float f) { return (bf16)(cvt_pk_bf16(f, 0.f) & 0xffffu); }
__device__ __forceinline__ float wave_sum(float v) {
#pragma unroll
    for (int o = 1; o < 64; o <<= 1) v += __shfl_xor(v, o);
    return v;
}
__device__ __forceinline__ float silu_f(float g) { return g * __builtin_amdgcn_rcpf(1.0f + __builtin_amdgcn_exp2f(-1.4426950408889634f * g)); }

namespace pg8 {
#define PG8_LAS __attribute__((address_space(3)))
typedef unsigned short bf16_t;
constexpr int BM = 256, BK = 64, HALF = 128, HTB = HALF * BK * 2, STAGE_BYTES = 8 * HTB, NXCD = 8, WGM = 8;
__host__ __device__ __forceinline__ int lds_byte(int r, int c) { const int st = (r >> 4) * 2 + (c >> 5), rr = r & 15, cc = c & 31, ob = rr * 64 + cc * 2; return st * 1024 + (ob ^ (((ob >> 9) & 1) << 5)); }
__host__ __device__ __forceinline__ void stage_rc(int b, int& R, int& C) { const int st = b / 1024, sb = b % 1024, swz = sb ^ (((sb >> 9) & 1) << 5); R = (st >> 1) * 16 + swz / 64; C = (st & 1) * 32 + (swz % 64) / 2; }
__host__ __device__ __forceinline__ int perm32(int rho) { const int n = rho >> 4, i = rho & 15; return 8 * (i >> 2) + 4 * n + (i & 3); }
struct Unit { int pm, pn; };
struct Gemm { const bf16_t* A; const bf16_t* Bt; int M, N, K, lda, ldb; };
struct StaticOrder {
    int nM, nN, nwg, G, c;
    __host__ __device__ void init(int M, int N, int G_, int c_) { nM = M / BM; nN = N / BM; nwg = nM * nN; G = G_; c = c_; }
    __host__ __device__ bool next(int i, Unit& u) const {
        const long L = (long)i * G + c; if (L >= nwg) return false;
        int wgid = (int)L; { const int q = nwg / NXCD, r = nwg % NXCD, xcd = wgid % NXCD, off = wgid / NXCD; wgid = (xcd < r ? xcd * (q + 1) : r * (q + 1) + (xcd - r) * q) + off; }
        const int nig = WGM * nN, gid = wgid / nig, fm = gid * WGM, gsz = (nM - fm) < WGM ? (nM - fm) : WGM;
        u.pm = fm + ((wgid % nig) % gsz); u.pn = (wgid % nig) / gsz; return true;
    }
    __device__ __forceinline__ void a_ready(const Unit&) const {}
    __device__ __forceinline__ void done(const Unit&) const {}
};
struct EpiBf16 {
    static constexpr bool PERM = true;
    bf16_t* O; int ldc;
    __device__ __forceinline__ void operator()(const f32x4 (&acc)[2][2][4][2], const Unit& u, int wr, int wc, int fr, int fq) const {
        const int row0 = u.pm * BM + wr * 64 + fr, col0 = u.pn * BM + wc * 32 + 8 * fq;
        asm volatile("s_nop 15" ::: "memory");
#pragma unroll
        for (int ai = 0; ai < 2; ++ai)
#pragma unroll
            for (int m = 0; m < 4; ++m) { bf16_t* rowp = O + (size_t)(row0 + ai * HALF + m * 16) * ldc + col0;
#pragma unroll
                for (int bj = 0; bj < 2; ++bj) { const f32x4 v0 = acc[ai][bj][m][0], v1 = acc[ai][bj][m][1];
                    u32x4 w; w.x = cvt_pk_bf16(v0[0], v0[1]); w.y = cvt_pk_bf16(v0[2], v0[3]); w.z = cvt_pk_bf16(v1[0], v1[1]); w.w = cvt_pk_bf16(v1[2], v1[3]);
                    *(u32x4*)(rowp + bj * HALF) = w; } }
    }
};
struct EpiSwiGLU {
    static constexpr bool PERM = true;
    bf16_t* O; int ldc;
    __device__ __forceinline__ void operator()(const f32x4 (&acc)[2][2][4][2], const Unit& u, int wr, int wc, int fr, int fq) const {
        const int row0 = u.pm * BM + wr * 64 + fr, col0 = u.pn * HALF + wc * 32 + 8 * fq;
#pragma unroll
        for (int ai = 0; ai < 2; ++ai)
#pragma unroll
            for (int m = 0; m < 4; ++m) { bf16_t* rowp = O + (size_t)(row0 + ai * HALF + m * 16) * ldc + col0;
                float h[8];
#pragma unroll
                for (int n = 0; n < 2; ++n)
#pragma unroll
                    for (int j = 0; j < 4; ++j) h[n * 4 + j] = silu_f(acc[ai][0][m][n][j]) * acc[ai][1][m][n][j];
                u32x4 w; w.x = cvt_pk_bf16(h[0], h[1]); w.y = cvt_pk_bf16(h[2], h[3]); w.z = cvt_pk_bf16(h[4], h[5]); w.w = cvt_pk_bf16(h[6], h[7]);
                *(u32x4*)rowp = w; asm volatile("" ::: "memory"); }
    }
};
struct EpiResid {
    static constexpr bool PERM = true;
    float* X; const float* gv; float gs; const float* stat; const float* lng; const float* lnb; int has_ln;
    __device__ __forceinline__ void operator()(const f32x4 (&acc)[2][2][4][2], const Unit& u, int wr, int wc, int fr, int fq) const {
        const int row0 = u.pm * BM + wr * 64 + fr, col0 = u.pn * BM + wc * 32 + 8 * fq;
        f32x2 st[2][4];
#pragma unroll
        for (int ai = 0; ai < 2; ++ai)
#pragma unroll
            for (int m = 0; m < 4; ++m) { st[ai][m] = has_ln ? *(const f32x2*)(stat + (size_t)(row0 + ai * HALF + m * 16) * 2) : (f32x2){0.f, 1.f}; st[ai][m].y *= DN_ALPHA; }
#pragma unroll
        for (int bj = 0; bj < 2; ++bj) { const int c = col0 + bj * HALF;
            f32x4 g[2], G[2], B[2];
#pragma unroll
            for (int n = 0; n < 2; ++n) { g[n] = *(const f32x4*)(gv + c + 4 * n) * gs;
                G[n] = has_ln ? *(const f32x4*)(lng + c + 4 * n) : (f32x4){1.f, 1.f, 1.f, 1.f}; B[n] = has_ln ? *(const f32x4*)(lnb + c + 4 * n) * DN_ALPHA : (f32x4){0.f, 0.f, 0.f, 0.f}; }
#pragma unroll
            for (int ai = 0; ai < 2; ++ai)
#pragma unroll
                for (int m = 0; m < 4; ++m) { float* p = X + (size_t)(row0 + ai * HALF + m * 16) * DM + c;
                    const f32x4 z0 = *(const f32x4*)p, z1 = *(const f32x4*)(p + 4);
                    *(f32x4*)p = (z0 - st[ai][m].x) * st[ai][m].y * G[0] + B[0] + g[0] * acc[ai][bj][m][0];
                    *(f32x4*)(p + 4) = (z1 - st[ai][m].x) * st[ai][m].y * G[1] + B[1] + g[1] * acc[ai][bj][m][1]; }
            asm volatile("" ::: "memory"); }
    }
};

template <class Epi, class Sched, bool ALIGN_EPI = true, bool SP2 = true>
__device__ __forceinline__ void gemm_phase(PG8_LAS unsigned char* lds, const Gemm g, const Sched& S, const Epi& E) {
    int tid = threadIdx.x; asm volatile("" : "+v"(tid));
    const int wid = __builtin_amdgcn_readfirstlane(tid >> 6), lane = tid & 63, wr = wid >> 2, wc = wid & 3, fr = lane & 15, fq = lane >> 4;
    const int K = g.K, nt = K / BK;
    unsigned voffA[2], voffB[2];
#pragma unroll
    for (int i = 0; i < 2; ++i) { int R, C; stage_rc(tid * 16 + i * 8192, R, C); const int Rb = Epi::PERM ? ((R & ~31) + perm32(R & 31)) : R;
        voffA[i] = (unsigned)(R * g.lda + C) * 2u; voffB[i] = (unsigned)(Rb * g.ldb + C) * 2u; }
    const size_t kstep = (size_t)(BK * 2);
    const size_t hstepA = (size_t)HALF * g.lda * 2, hstepB = (size_t)HALF * g.ldb * 2;
    const size_t tstepA = 2 * hstepA, tstepB = 2 * hstepB;
    const unsigned ldsw = (unsigned)wid * 1024u;
    const int aoff = lds_byte(wr * 64 + fr, fq * 8), boff = lds_byte(wc * 32 + fr, fq * 8);
#define PG8_SA(b, h) (((b) * 2 + (h)) * HTB)
#define PG8_SB(b, h) ((4 + (b) * 2 + (h)) * HTB)
#define PG8_STAGE(bufoff, gbase, voff) do { _Pragma("unroll") for (int _i = 0; _i < 2; ++_i) \
        __builtin_amdgcn_global_load_lds((const unsigned*)((const char*)(gbase) + (voff)[_i]), (PG8_LAS unsigned*)(lds + (bufoff) + ldsw + _i * 8192), 16, 0, 0); } while (0)
#define PG8_LDA(dst, b, h) do { _Pragma("unroll") for (int m = 0; m < 4; ++m) _Pragma("unroll") for (int k = 0; k < 2; ++k) dst[m][k] = *(const PG8_LAS bf16x8*)(lds + PG8_SA(b, h) + aoff + m * 2048 + k * 1024); } while (0)
#define PG8_LDB(dst, b, h) do { _Pragma("unroll") for (int n = 0; n < 2; ++n) _Pragma("unroll") for (int k = 0; k < 2; ++k) dst[n][k] = *(const PG8_LAS bf16x8*)(lds + PG8_SB(b, h) + boff + n * 2048 + k * 1024); } while (0)
#define PG8_MMA(ai, bj, At, Bt) do { __builtin_amdgcn_s_setprio(1); _Pragma("unroll") for (int m = 0; m < 4; ++m) _Pragma("unroll") for (int n = 0; n < 2; ++n) _Pragma("unroll") for (int k = 0; k < 2; ++k) \
        acc[ai][bj][m][n] = __builtin_amdgcn_mfma_f32_16x16x32_bf16(Bt[n][k], At[m][k], acc[ai][bj][m][n], 0, 0, 0); __builtin_amdgcn_s_setprio(0); } while (0)
#define PG8_WAIT_V(n) asm volatile("s_waitcnt vmcnt(" #n ")" ::: "memory")
#define PG8_WAIT_L(n) asm volatile("s_waitcnt lgkmcnt(" #n ")" ::: "memory")
#define PG8_BAR __builtin_amdgcn_s_barrier()
#define PG8_SCHED __builtin_amdgcn_sched_barrier(0)
    Unit cur, nxt; int ui = 0;
    if (!S.next(0, cur)) return;
    f32x4 acc[2][2][4][2];
#pragma unroll
    for (int a = 0; a < 2; ++a)
#pragma unroll
        for (int b = 0; b < 2; ++b)
#pragma unroll
            for (int m = 0; m < 4; ++m)
#pragma unroll
                for (int n = 0; n < 2; ++n) acc[a][b][m][n] = (f32x4){0.f, 0.f, 0.f, 0.f};
    bf16x8 At[4][2], B0[2][2], B1[2][2];
    const char* cA = (const char*)g.A + (size_t)cur.pm * tstepA; const char* cB = (const char*)g.Bt + (size_t)cur.pn * tstepB;
    S.a_ready(cur);
    if constexpr (SP2) {
        PG8_STAGE(PG8_SB(0, 0), cB, voffB); PG8_STAGE(PG8_SB(0, 1), cB + hstepB, voffB); PG8_STAGE(PG8_SA(0, 0), cA, voffA); PG8_STAGE(PG8_SA(0, 1), cA + hstepA, voffA);
        if (wr == 1) PG8_BAR;
        PG8_WAIT_V(2); PG8_BAR;
        PG8_STAGE(PG8_SB(1, 0), cB + kstep, voffB); PG8_STAGE(PG8_SA(1, 0), cA + kstep, voffA); PG8_STAGE(PG8_SB(1, 1), cB + hstepB + kstep, voffB);
        PG8_WAIT_V(6); PG8_BAR;
    } else {
        PG8_STAGE(PG8_SB(0, 0), cB, voffB); PG8_STAGE(PG8_SA(0, 0), cA, voffA); PG8_STAGE(PG8_SB(0, 1), cB + hstepB, voffB); PG8_STAGE(PG8_SA(0, 1), cA + hstepA, voffA);
        if (wr == 1) PG8_BAR;
        PG8_WAIT_V(4); PG8_BAR;
        PG8_STAGE(PG8_SB(1, 0), cB + kstep, voffB); PG8_STAGE(PG8_SA(1, 0), cA + kstep, voffA); PG8_STAGE(PG8_SB(1, 1), cB + hstepB + kstep, voffB);
        PG8_WAIT_V(6); PG8_BAR;
    }
    for (;;) {
        const bool has_next = S.next(ui + 1, nxt);
        const char* nA = has_next ? (const char*)g.A + (size_t)nxt.pm * tstepA : cA; const char* nB = has_next ? (const char*)g.Bt + (size_t)nxt.pn * tstepB : cB;
        for (int t = 0; t < nt; t += 2) {
            const bool last = (t == nt - 2);
            const char* a1 = cA + (size_t)(t + 1) * kstep;
            const char* a2 = last ? nA : cA + (size_t)(t + 2) * kstep; const char* b2 = last ? nB : cB + (size_t)(t + 2) * kstep;
            const char* a3 = a2 + kstep; const char* b3 = b2 + kstep;
            if (last && has_next) S.a_ready(nxt);
            if constexpr (SP2) {
            PG8_LDB(B0, 0, 0); PG8_LDB(B1, 0, 1); PG8_SCHED; PG8_LDA(At, 0, 0); PG8_STAGE(PG8_SA(1, 1), a1 + hstepA, voffA);
            PG8_WAIT_V(8); PG8_WAIT_L(0); PG8_BAR; PG8_MMA(0, 0, At, B0); PG8_MMA(0, 1, At, B1); PG8_BAR; PG8_SCHED;
            PG8_LDA(At, 0, 1); PG8_STAGE(PG8_SB(0, 0), b2, voffB); PG8_STAGE(PG8_SB(0, 1), b2 + hstepB, voffB); PG8_STAGE(PG8_SA(0, 0), a2, voffA);
            PG8_WAIT_V(8); PG8_WAIT_L(0); PG8_BAR; PG8_MMA(1, 0, At, B0); PG8_MMA(1, 1, At, B1); PG8_BAR; PG8_SCHED;
            PG8_LDB(B0, 1, 0); PG8_LDB(B1, 1, 1); PG8_SCHED; PG8_LDA(At, 1, 0); PG8_STAGE(PG8_SA(0, 1), a2 + hstepA, voffA);
            PG8_WAIT_V(8); PG8_WAIT_L(0); PG8_BAR; PG8_MMA(0, 0, At, B0); PG8_MMA(0, 1, At, B1); PG8_BAR; PG8_SCHED;
            PG8_LDA(At, 1, 1); PG8_STAGE(PG8_SB(1, 0), b3, voffB); PG8_STAGE(PG8_SB(1, 1), b3 + hstepB, voffB); PG8_STAGE(PG8_SA(1, 0), a3, voffA);
            PG8_WAIT_V(8); PG8_WAIT_L(0); PG8_BAR; PG8_MMA(1, 0, At, B0); PG8_MMA(1, 1, At, B1); PG8_BAR; PG8_SCHED;
            } else {
            PG8_LDB(B0, 0, 0); PG8_SCHED; PG8_LDA(At, 0, 0); PG8_STAGE(PG8_SA(1, 1), a1 + hstepA, voffA);
            PG8_WAIT_L(8); PG8_BAR; PG8_WAIT_L(0); PG8_MMA(0, 0, At, B0); PG8_BAR; PG8_SCHED;
            PG8_LDB(B1, 0, 1); PG8_STAGE(PG8_SB(0, 0), b2, voffB);
            PG8_BAR; PG8_WAIT_L(0); PG8_MMA(0, 1, At, B1); PG8_BAR;
            PG8_LDA(At, 0, 1); PG8_STAGE(PG8_SA(0, 0), a2, voffA);
            PG8_BAR; PG8_WAIT_L(0); PG8_MMA(1, 0, At, B0); PG8_BAR; PG8_SCHED;
            PG8_STAGE(PG8_SB(0, 1), b2 + hstepB, voffB);
            PG8_WAIT_V(6); PG8_BAR; PG8_MMA(1, 1, At, B1); PG8_BAR;
            PG8_LDB(B0, 1, 0); PG8_SCHED; PG8_LDA(At, 1, 0); PG8_STAGE(PG8_SA(0, 1), a2 + hstepA, voffA);
            PG8_WAIT_L(8); PG8_BAR; PG8_WAIT_L(0); PG8_MMA(0, 0, At, B0); PG8_BAR; PG8_SCHED;
            PG8_LDB(B1, 1, 1); PG8_STAGE(PG8_SB(1, 0), b3, voffB);
            PG8_BAR; PG8_WAIT_L(0); PG8_MMA(0, 1, At, B1); PG8_BAR;
            PG8_LDA(At, 1, 1); PG8_STAGE(PG8_SA(1, 0), a3, voffA);
            PG8_BAR; PG8_WAIT_L(0); PG8_MMA(1, 0, At, B0); PG8_BAR; PG8_SCHED;
            PG8_STAGE(PG8_SB(1, 1), b3 + hstepB, voffB);
            PG8_WAIT_V(6); PG8_BAR; PG8_MMA(1, 1, At, B1); PG8_BAR;
            }
        }
        if constexpr (ALIGN_EPI) { if (wr == 0) PG8_BAR; }
        E(acc, cur, wr, wc, fr, fq); S.done(cur);
        if (!has_next) break;
#pragma unroll
        for (int a = 0; a < 2; ++a)
#pragma unroll
            for (int b = 0; b < 2; ++b)
#pragma unroll
                for (int m = 0; m < 4; ++m)
#pragma unroll
                    for (int n = 0; n < 2; ++n) acc[a][b][m][n] = (f32x4){0.f, 0.f, 0.f, 0.f};
        cur = nxt; cA = nA; cB = nB; ++ui;
        if constexpr (ALIGN_EPI) { if (wr == 1) PG8_BAR; }
    }
    PG8_WAIT_V(0);
    if constexpr (!ALIGN_EPI) { if (wr == 0) PG8_BAR; }
    PG8_BAR;
#undef PG8_SA
#undef PG8_SB
#undef PG8_STAGE
#undef PG8_LDA
#undef PG8_LDB
#undef PG8_MMA
#undef PG8_WAIT_V
#undef PG8_WAIT_L
#undef PG8_BAR
#undef PG8_SCHED
}
}

#define XB_TMO      128
#define XB_XCNT(j)  (256  + 64 * (j))
#define XB_XSUB(j)  (1280 + 64 * (j))
#define XB_XGEN(j)  (2304 + 64 * (j))
#define XB_TOP      3328
#define XB_TOPGEN   3392
#define XCD_BAR_WORDS 3456
#define XB_SPIN_CAP (1u << 18)
__device__ __forceinline__ unsigned xb_ld(unsigned* p)              { return __hip_atomic_load(p, __ATOMIC_RELAXED, __HIP_MEMORY_SCOPE_AGENT); }
__device__ __forceinline__ unsigned xb_add(unsigned* p, unsigned v) { return __hip_atomic_fetch_add(p, v, __ATOMIC_RELAXED, __HIP_MEMORY_SCOPE_AGENT); }
__device__ __forceinline__ unsigned xb_xcc_id() { return (unsigned)__builtin_amdgcn_s_getreg((3 << 11) | 20) & 0xFu; }
#define XB_SPIN(cond, bar) do { unsigned _sp = 0; while (cond) { __builtin_amdgcn_s_sleep(1); \
    if ((++_sp & 255u) == 0u) { if (xb_ld(&(bar)[XB_TMO])) break; if (_sp > XB_SPIN_CAP) { atomicAdd(&(bar)[XB_TMO], 1u); break; } } } } while (0)
struct XcdBarrier { unsigned* bar; unsigned x; volatile LAS unsigned* st; };
__device__ __forceinline__ XcdBarrier xcd_barrier_post(unsigned* bar, volatile LAS unsigned* st) {
    XcdBarrier b; b.bar = bar; b.x = xb_xcc_id(); b.st = st;
    if (threadIdx.x == 0) (void)xb_add(&bar[XB_XCNT(b.x)], 1u);
    return b;
}
__device__ __forceinline__ void xcd_barrier_complete(unsigned* bar, unsigned x, unsigned& nloc, unsigned& nx) {
    const unsigned G = gridDim.x * gridDim.y * gridDim.z;
    unsigned sum, cnt, mine, sp = 0u;
    for (;;) {
        sum = 0u; cnt = 0u; mine = 0u;
#pragma unroll
        for (unsigned j = 0; j < 16; ++j) { const unsigned c = xb_ld(&bar[XB_XCNT(j)]); sum += c; cnt += (c > 0u) ? 1u : 0u; mine = (j == x) ? c : mine; }
        if (sum == G) break;
        __builtin_amdgcn_s_sleep(1);
        if ((++sp & 255u) == 0u) { if (xb_ld(&bar[XB_TMO])) break; if (sp > XB_SPIN_CAP) { atomicAdd(&bar[XB_TMO], 1u); break; } }
    }
    nloc = mine > 0u ? mine : 1u; nx = cnt > 0u ? cnt : 1u;
}
__device__ __forceinline__ void xcd_barrier(const XcdBarrier& b0) {
    asm volatile("s_waitcnt vmcnt(0)" ::: "memory");
    __syncthreads();
    if (threadIdx.x == 0) {
        XcdBarrier b = b0; b.x = xb_xcc_id();
        unsigned* bar = b.bar;
        __builtin_amdgcn_s_waitcnt(0);
        unsigned nloc = b.st[0], nx = b.st[1];
        if (nloc == 0u) { xcd_barrier_complete(bar, b.x, nloc, nx); b.st[0] = nloc; b.st[1] = nx; }
        const unsigned old = xb_add(&bar[XB_XSUB(b.x)], 1u);
        const unsigned gen = old / nloc;
        if (old + 1u == (gen + 1u) * nloc) {
            __builtin_amdgcn_fence(__ATOMIC_RELEASE, "agent");
            asm volatile("s_waitcnt vmcnt(0)" ::: "memory");
            const unsigned og = xb_add(&bar[XB_TOP], 1u);
            const unsigned tg = og / nx;
            if (og + 1u == (tg + 1u) * nx) xb_add(&bar[XB_TOPGEN], 1u);
            else XB_SPIN(xb_ld(&bar[XB_TOPGEN]) == tg, bar);
            __builtin_amdgcn_fence(__ATOMIC_ACQUIRE, "agent");
            xb_add(&bar[XB_XGEN(b.x)], 1u);
            asm volatile("s_waitcnt vmcnt(0)" ::: "memory");
        } else {
            XB_SPIN(xb_ld(&bar[XB_XGEN(b.x)]) == gen, bar);
            __builtin_amdgcn_fence(__ATOMIC_ACQUIRE, "agent");
            asm volatile("s_waitcnt vmcnt(0)" ::: "memory");
        }
    }
    __syncthreads();
}

struct Args { const float* in[23]; float* out; unsigned char* ws; };
struct Frame {
    LAS unsigned char* lds;
    int vcu, G;
    const Args* a; unsigned char* ws;
};
#define PHASE_IDS() int tid = threadIdx.x; asm volatile("" : "+v"(tid)); const int lane = tid & 63, wave = __builtin_amdgcn_readfirstlane(tid >> 6); (void)lane; (void)wave
#define MFMA16(a, b, c) __builtin_amdgcn_mfma_f32_16x16x32_bf16((a), (b), (c), 0, 0, 0)
#define MFMA32(a, b, c) __builtin_amdgcn_mfma_f32_32x32x16_bf16((a), (b), (c), 0, 0, 0)

constexpr float ATT_QSCALE = 0.07216878364870322f * 1.4426950408889634f;
__device__ __forceinline__ void tr_item(const float* W, int N, int K, bf16* WT, int k0, int n0, int drow0, LAS float* scr, int lane, float sc = 1.0f) {
#pragma unroll 8
    for (int i = 0; i < 32; ++i) { const int kk = 2 * i + (lane >> 5); scr[kk * 33 + (lane & 31)] = W[(size_t)(k0 + kk) * N + n0 + (lane & 31)]; }
    LDS_WAIT(); asm volatile("" ::: "memory");
    const int c = lane & 7;
#pragma unroll
    for (int j = 0; j < 4; ++j) { const int n = (lane >> 3) + 8 * j; const LAS float* s = scr + (8 * c) * 33 + n;
        u32x4 o; o.x = cvt_pk_bf16(s[0 * 33] * sc, s[1 * 33] * sc); o.y = cvt_pk_bf16(s[2 * 33] * sc, s[3 * 33] * sc); o.z = cvt_pk_bf16(s[4 * 33] * sc, s[5 * 33] * sc); o.w = cvt_pk_bf16(s[6 * 33] * sc, s[7 * 33] * sc);
        *(u32x4*)(WT + (size_t)(drow0 + n) * K + k0 + 8 * c) = o; }
    LDS_WAIT(); asm volatile("" ::: "memory");
}
__device__ __forceinline__ void p0a(Frame& F) {
    PHASE_IDS();
    LAS float* scr = (LAS float*)(F.lds + wave * 8704);
    LAS float* sv = (LAS float*)(F.lds + 8 * 8704);
    for (int i = tid; i < 2 * DM; i += NTHR) { const float v = (i < DM) ? F.a->in[1][i] : F.a->in[3][i - DM]; sv[i] = v / (1.0f + __expf(-v)); }
    __syncthreads();
    const int gw = F.vcu * NWAVES + wave, NGW = F.G * NWAVES;
    constexpr int I0 = 8 * 32 * 344, I1 = 8 * 86 * 64, I2 = 2 * 32 * 193, I3 = 2 * 32 * 64, I4 = 2 * 32 * 34, I5 = 2 * 8 * 96, I6 = 2 * 8 * 128, I7 = 2 * 32 * 64;
    constexpr int NTR = I0 + I1 + I2 + I3 + I4 + I5 + I6 + I7, NADAI = 8 * 288;
    for (int it = gw; it < NTR + NADAI; it += NGW) {
        int r = it;
        if (r < I0) { const int mat = r / 11008, q = r % 11008, kb = q / 344, nb = q % 344, n0 = nb * 32;
            const int j = n0 < DFF ? n0 : n0 - DFF, drow = (j / 128) * 256 + (j % 128) + (n0 < DFF ? 0 : 128);
            tr_item(F.a->in[8] + (size_t)mat * DM * 2 * DFF, 2 * DFF, DM, (bf16*)(F.ws + WS_WFI + mat * SZ_WFI), kb * 64, n0, drow - 0, scr, lane); continue; } r -= I0;
        if (r < I1) { const int mat = r / 5504, q = r % 5504, kb = q / 64, nb = q % 64;
            tr_item(F.a->in[9] + (size_t)mat * DFF * DM, DM, DFF, (bf16*)(F.ws + WS_WFO + mat * SZ_WFO), kb * 64, nb * 32, nb * 32, scr, lane); continue; } r -= I1;
        if (r < I2) { const int mat = r / 6176, q = r % 6176, kb = q / 193, nb = q % 193, n0 = nb * 32;
            const int drow = n0 < 3072 ? n0 : (n0 < 3104 ? 6144 : n0 - 32);
            tr_item(F.a->in[10] + (size_t)mat * DM * 6176, 6176, DM, (bf16*)(F.ws + WS_EWI + mat * SZ_EWI), kb * 64, n0, drow, scr, lane); continue; } r -= I2;
        if (r < I3) { const int mat = r / 2048, q = r % 2048, kb = q / 64, nb = q % 64;
            tr_item(F.a->in[16] + (size_t)mat * DM * DM, DM, DM, (bf16*)(F.ws + WS_EWO + mat * SZ_SQ), kb * 64, nb * 32, nb * 32, scr, lane); continue; } r -= I3;
        if (r < I4) { const int mat = r / 1088, q = r % 1088, kb = q / 34, nb = q % 34;
            tr_item(F.a->in[17] + (size_t)mat * DM * 1088, 1088, DM, (bf16*)(F.ws + WS_OWI + mat * SZ_OWI), kb * 64, nb * 32, nb * 32, scr, lane); continue; } r -= I4;
        if (r < I5) { const int mat = r / 768, q = r % 768, kb = q / 96, nb = q % 96;
            tr_item(F.a->in[20] + (size_t)mat * 512 * 3072, 3072, 512, (bf16*)(F.ws + WS_OUQ + mat * SZ_OUQ), kb * 64, nb * 32, nb * 32, scr, lane, ATT_QSCALE); continue; } r -= I5;
        if (r < I6) { const int mat = r / 1024, q = r % 1024, kb = q / 128, nb = q % 128;
            tr_item(F.a->in[21] + (size_t)mat * 512 * 4096, 4096, 512, (bf16*)(F.ws + WS_OUKV + mat * SZ_OUKV), kb * 64, nb * 32, nb * 32, scr, lane); continue; } r -= I6;
        if (r < I7) { const int mat = r / 2048, q = r % 2048, kb = q / 64, nb = q % 64;
            tr_item(F.a->in[22] + (size_t)mat * DM * DM, DM, DM, (bf16*)(F.ws + WS_OWO + mat * SZ_SQ), kb * 64, nb * 32, nb * 32, scr, lane); continue; } r -= I7;
        {
            const int ks = r / 288, cg = r % 288, l = cg / 72, n = (cg % 72) * 256 + lane * 4;
            const float* w = F.a->in[4] + ((size_t)l * DM + ks * 256) * NADA + n;
            f32x4 al = {0.f, 0.f, 0.f, 0.f}, ac = {0.f, 0.f, 0.f, 0.f};
#pragma unroll 8
            for (int k = 0; k < 256; ++k) { const f32x4 wv = *(const f32x4*)(w + (size_t)k * NADA); al += wv * sv[ks * 256 + k]; ac += wv * sv[DM + ks * 256 + k]; }
            float* mp = (float*)(F.ws + WS_MODP);
            *(f32x4*)(mp + (size_t)(ks * 2 + 0) * 4 * NADA + l * NADA + n) = al;
            *(f32x4*)(mp + (size_t)(ks * 2 + 1) * 4 * NADA + l * NADA + n) = ac;
        }
    }
    const int gt = F.vcu * NTHR + tid, NGT = F.G * NTHR;
    for (int i = gt; i < NLAT * 64 + 256 * 16 + 64 * 16; i += NGT) {
        int pos, fi; float inv; f32x2* dst;
        if (i < NLAT * 64) { pos = i >> 6; fi = i & 63; inv = __builtin_amdgcn_exp2f(-(float)fi * (13.287712379549449f / 64.0f)); dst = (f32x2*)(F.ws + WS_RT) + i; }
        else if (i < NLAT * 64 + 4096) { const int j = i - NLAT * 64; pos = j >> 4; fi = j & 15; inv = __builtin_amdgcn_exp2f(-(float)fi * (13.287712379549449f / 16.0f)); dst = (f32x2*)(F.ws + WS_AXR) + j; }
        else { const int j = i - NLAT * 64 - 4096; pos = j >> 4; fi = j & 15; inv = __builtin_amdgcn_exp2f(-(float)fi * (13.287712379549449f / 16.0f)); dst = (f32x2*)(F.ws + WS_AXC) + j; }
        const float ang = (float)pos * inv;
        double rev = (double)ang * 0.15915494309189535; rev -= __builtin_floor(rev);
        const float rv = (float)rev;
        *dst = (f32x2){__builtin_amdgcn_cosf(rv), __builtin_amdgcn_sinf(rv)};
    }
}
__device__ __forceinline__ void p0b(Frame& F) {
    PHASE_IDS();
    const int gt = F.vcu * NTHR + tid, NGT = F.G * NTHR;
    const float* mp = (const float*)(F.ws + WS_MODP); float* mo = (float*)(F.ws + WS_MOD);
    for (int i = gt; i < 4 * 2 * NADA; i += NGT) { const int l = i / (2 * NADA), v = (i / NADA) & 1, n = i % NADA;
        float s = F.a->in[5][l * NADA + n];
#pragma unroll
        for (int ks = 0; ks < 8; ++ks) s += mp[(size_t)(ks * 2 + v) * 4 * NADA + l * NADA + n];
        mo[i] = s; }
}
__device__ __forceinline__ const float* modp(Frame& F, int l, int v, int idx) { return (const float*)(F.ws + WS_MOD) + ((size_t)(l * 2 + v) * 9 + idx) * DM; }

template <int MODE>
__device__ __forceinline__ void row_phase(Frame& F, const float* lng, const float* lnb, const float* sh_l, const float* sc_l, const float* sh_c, const float* sc_c) {
    PHASE_IDS();
    LAS float* V = (LAS float*)F.lds;
    for (int i = tid; i < DM; i += NTHR) { if (MODE != 0) { V[i] = lng[i]; V[DM + i] = lnb[i]; } if (MODE != 2) { V[2 * DM + i] = sh_l[i]; V[3 * DM + i] = sc_l[i]; V[4 * DM + i] = sh_c[i]; V[5 * DM + i] = sc_c[i]; } }
    __syncthreads();
    const int gw = F.vcu * NWAVES + wave, NGW = F.G * NWAVES;
    float* X = (float*)(F.ws + WS_X); bf16* H = (bf16*)(F.ws + WS_H);
    for (int t = gw; t < T; t += NGW) {
        if (MODE == 2 && t < NCTX) continue;
        const float* src = (MODE == 0) ? (t < NCTX ? F.a->in[2] + (size_t)t * DM : F.a->in[0] + (size_t)(t - NCTX) * DM) : X + (size_t)t * DM;
        f32x4 v[8]; float s = 0.f; float mean_ = 0.f, rstd_ = 1.f;
#pragma unroll
        for (int j = 0; j < 8; ++j) { v[j] = *((const f32x4*)src + lane + 64 * j); s += (v[j].x + v[j].y) + (v[j].z + v[j].w); }
        if (MODE != 0) {
            const float mean = wave_sum(s) * (1.f / DM); float s2 = 0.f;
#pragma unroll
            for (int j = 0; j < 8; ++j) { v[j] = v[j] - mean; s2 += (v[j].x * v[j].x + v[j].y * v[j].y) + (v[j].z * v[j].z + v[j].w * v[j].w); }
            const float rstd = 1.f / sqrtf(wave_sum(s2) * (1.f / DM) + LN_EPS); mean_ = mean; rstd_ = rstd;
#pragma unroll
            for (int j = 0; j < 8; ++j) { const f32x4 g = *((const LAS f32x4*)V + lane + 64 * j), b = *((const LAS f32x4*)(V + DM) + lane + 64 * j); v[j] = v[j] * rstd * g + b; }
        }
        if (MODE == 1 && lane == 0) *(f32x2*)((float*)(F.ws + WS_STAT) + (size_t)t * 2) = (f32x2){mean_, rstd_};
        if (MODE == 2) {
            float* o = F.a->out + (size_t)(t - NCTX) * DM;
#pragma unroll
            for (int j = 0; j < 8; ++j) *((f32x4*)o + lane + 64 * j) = v[j];
        } else {
            float* o = X + (size_t)t * DM; bf16* h = H + (size_t)t * DM;
            const LAS float* shv = V + (t < NCTX ? 4 * DM : 2 * DM); const LAS float* scv = V + (t < NCTX ? 5 * DM : 3 * DM);
#pragma unroll
            for (int j = 0; j < 8; ++j) {
                const f32x4 sh = *((const LAS f32x4*)shv + lane + 64 * j), sc = *((const LAS f32x4*)scv + lane + 64 * j);
                const f32x4 m = v[j] * (sc + 1.0f) + sh; u32x2 w; w.x = cvt_pk_bf16(m.x, m.y); w.y = cvt_pk_bf16(m.z, m.w);
                *((u32x2*)h + lane + 64 * j) = w; }
        }
    }
    __syncthreads();
}


__device__ __forceinline__ void ctx_resid_small(Frame& F, float* X, const bf16* A, const bf16* Bt, int K, const float* gv, float gs, const float* stat, const float* lng, const float* lnb, int has_ln, int parity) {
    if ((int)(blockIdx.x & 1) != parity) return;
    PHASE_IDS(); const int fr = lane & 15, fq = lane >> 4;
    const int nks = K >> 5, last = wave + 8 * ((nks - 1 - wave) >> 3), trips = (((nks + 7) >> 3) + 3) & ~3;
    for (int item = blockIdx.x; item < 256; item += F.G) {
        const int mt = item >> 5, nt = item & 31;
        f32x4 acc[2][4];
#pragma unroll
        for (int i = 0; i < 2; ++i)
#pragma unroll
            for (int j = 0; j < 4; ++j) acc[i][j] = (f32x4){0.f, 0.f, 0.f, 0.f};
        const bf16* Ap = A + (size_t)(32 * mt + fr) * K + 8 * fq;
        const bf16* Bp = Bt + (size_t)(64 * nt + fr) * K + 8 * fq;
        bf16x8 a0[2], b0[4], a1[2], b1[4], a2[2], b2[4], a3[2], b3[4];
#define CS_LOAD(a, b, i_) do { const int so_ = 32 * min(wave + 8 * (i_), last); _Pragma("unroll") for (int i = 0; i < 2; ++i) a[i] = *(const bf16x8*)(Ap + (size_t)(16 * i) * K + so_); \
        _Pragma("unroll") for (int i = 0; i < 4; ++i) b[i] = *(const bf16x8*)(Bp + (size_t)(16 * i) * K + so_); } while (0)
#define CS_MMA(a, b, i_) do { __builtin_amdgcn_sched_barrier(0); if (wave + 8 * (i_) < nks) { _Pragma("unroll") for (int i = 0; i < 2; ++i) _Pragma("unroll") for (int j = 0; j < 4; ++j) acc[i][j] = MFMA16(a[i], b[j], acc[i][j]); } __builtin_amdgcn_sched_barrier(0); } while (0)
        CS_LOAD(a0, b0, 0); CS_LOAD(a1, b1, 1); CS_LOAD(a2, b2, 2);
        for (int it = 0; it < trips; it += 4) {
            CS_LOAD(a3, b3, it + 3); CS_MMA(a0, b0, it);
            CS_LOAD(a0, b0, it + 4); CS_MMA(a1, b1, it + 1);
            CS_LOAD(a1, b1, it + 5); CS_MMA(a2, b2, it + 2);
            CS_LOAD(a2, b2, it + 6); CS_MMA(a3, b3, it + 3);
        }
#undef CS_LOAD
#undef CS_MMA
        LAS float* P = (LAS float*)F.lds + wave * 2048;
#pragma unroll
        for (int i = 0; i < 2; ++i)
#pragma unroll
            for (int j = 0; j < 4; ++j)
#pragma unroll
                for (int r = 0; r < 4; ++r) P[(16 * i + 4 * fq + r) * 64 + 16 * j + fr] = acc[i][j][r];
        __syncthreads();
        const int row = tid >> 4, c0 = (tid & 15) * 4;
        f32x4 s0 = {0.f, 0.f, 0.f, 0.f};
#pragma unroll
        for (int w = 0; w < 8; ++w) s0 += *(const LAS f32x4*)((LAS float*)F.lds + w * 2048 + row * 64 + c0);
        float* xp = X + (size_t)(32 * mt + row) * DM + 64 * nt + c0;
        const f32x4 g0 = *(const f32x4*)(gv + 64 * nt + c0) * gs;
        f32x4 x0 = *(const f32x4*)xp;
        if (has_ln) { const f32x2 st = *(const f32x2*)(stat + (size_t)(32 * mt + row) * 2); x0 = (x0 - st.x) * st.y * *(const f32x4*)(lng + 64 * nt + c0) + *(const f32x4*)(lnb + 64 * nt + c0); }
        *(f32x4*)xp = x0 * DN_ALPHA + g0 * s0;
        __syncthreads();
    }
}


__device__ __forceinline__ void init_x_by_owners(Frame& F) {
    PHASE_IDS();
    float* X = (float*)(F.ws + WS_X);
    pg8::StaticOrder S; S.init(NLAT, DM, F.G, (int)blockIdx.x); pg8::Unit u;
    for (int i = 0; S.next(i, u); ++i) {
        const int c4 = (tid & 63) * 4, r0 = tid >> 6;
#pragma unroll 4
        for (int rr = r0; rr < 256; rr += 8) { const size_t lr = (size_t)u.pm * 256 + rr; *(f32x4*)(X + (lr + NCTX) * DM + u.pn * 256 + c4) = *(const f32x4*)(F.a->in[0] + lr * DM + u.pn * 256 + c4); }
    }
    for (int item = blockIdx.x; item < 256; item += F.G) { const int mt = item >> 5, nt = item & 31, row = tid >> 4, c0 = (tid & 15) * 4;
        const size_t o = (size_t)(32 * mt + row) * DM + 64 * nt + c0; *(f32x4*)(X + o) = *(const f32x4*)(F.a->in[2] + o); }
}

constexpr int L1_QRAW = 0, L1_KRAW = 16384, L1_GD = 32768, L1_PART = 36864, L1_QT = 40960, L1_KT = 58368, L1_KTT = 75776, L1_VT = 94208, L1_P = 131072;
constexpr float INV_SQRT_DK = 0.08838834764831845f;

template <int DIR>
__device__ __forceinline__ void s1_dir(Frame& F, int e, int hh, int c, bool lat, f32x4 (&pacc)[2], const float (&wv)[16], const float bgv, const f32x2 (&csv)[16]) {
    const bool is_gla = hh < 4; const int hd = hh & 3, t0 = c * 64;
    PHASE_IDS(); const int w = wave, fr = lane & 15, fq = lane >> 4;
    LAS unsigned char* lds = F.lds;
    const int ch = tid & 127, tq = tid >> 7;
    float lgv[16];
    if (is_gla) {
#pragma unroll
        for (int i = 0; i < 16; ++i) { const int tt = 16 * tq + (DIR ? 15 - i : i);
            const u32x4 g0 = *(const LAS u32x4*)(lds + L1_GD + tt * 64 + DIR * 32), g1 = *(const LAS u32x4*)(lds + L1_GD + tt * 64 + DIR * 32 + 16);
            float x = bgv;
            x += bflo(g0.x) * wv[0] + bfhi(g0.x) * wv[1] + bflo(g0.y) * wv[2] + bfhi(g0.y) * wv[3] + bflo(g0.z) * wv[4] + bfhi(g0.z) * wv[5] + bflo(g0.w) * wv[6] + bfhi(g0.w) * wv[7];
            x += bflo(g1.x) * wv[8] + bfhi(g1.x) * wv[9] + bflo(g1.y) * wv[10] + bfhi(g1.y) * wv[11] + bflo(g1.z) * wv[12] + bfhi(g1.z) * wv[13] + bflo(g1.w) * wv[14] + bfhi(g1.w) * wv[15];
            lgv[i] = (fminf(x, 0.f) - __logf(1.0f + __expf(-fabsf(x)))) * (1.0f / 16.0f); }
    } else {
        const float lg = log1pf(-exp2f((DIR ? -5.5f : -5.0f) - (float)hd));
#pragma unroll
        for (int i = 0; i < 16; ++i) lgv[i] = lg;
    }
    float ls = 0.f;
#pragma unroll
    for (int i = 0; i < 16; ++i) ls += lgv[i];
    LAS float* part = (LAS float*)(lds + L1_PART);
    part[tq * 128 + ch] = ls;
    __syncthreads();
    float b = 0.f;
#pragma unroll
    for (int q = 0; q < 4; ++q) { const float pv = part[q * 128 + ch]; if (DIR ? (q > tq) : (q < tq)) b += pv; }
    bf16* QTg = (bf16*)(F.ws + WS_QT) + (size_t)DIR * T * 1024;
    float kt[16];
#pragma unroll
    for (int i = 0; i < 16; ++i) { const int tt = 16 * tq + (DIR ? 15 - i : i);
        b += lgv[i];
        float qv = bf2f(*(const LAS bf16*)(lds + L1_QRAW + tt * 256 + ch * 2)), kv = bf2f(*(const LAS bf16*)(lds + L1_KRAW + tt * 256 + ch * 2));
        if (!is_gla && lat) {
            const float qp = bf2f(*(const LAS bf16*)(lds + L1_QRAW + tt * 256 + (ch ^ 64) * 2)), kp = bf2f(*(const LAS bf16*)(lds + L1_KRAW + tt * 256 + (ch ^ 64) * 2));
            const f32x2 cs = csv[DIR ? 15 - i : i];
            if (ch < 64) { qv = qv * cs.x - qp * cs.y; kv = kv * cs.x - kp * cs.y; } else { qv = qv * cs.x + qp * cs.y; kv = kv * cs.x + kp * cs.y; }
        }
        const float eb = __expf(b), ebi = __expf(-b);
        const float qs = qv * eb * (is_gla ? INV_SQRT_DK : 1.0f), ks = kv * ebi * (is_gla ? 1.0f : INV_SQRT_DK);
        const bf16 qb = f2bf(qs);
        *(LAS bf16*)(lds + L1_QT + tt * 272 + ch * 2) = qb;
        *(LAS bf16*)(lds + L1_KT + tt * 272 + ch * 2) = f2bf(ks);
        kt[DIR ? 15 - i : i] = ks;
        if (i == 15 && tq == (DIR ? 0 : 3)) ((float*)(F.ws + WS_DEC))[((size_t)(DIR * 8 + hh) * NCH + c) * 128 + ch] = eb;
    }
    { u32x4 w0, w1; w0.x = cvt_pk_bf16(kt[0], kt[1]); w0.y = cvt_pk_bf16(kt[2], kt[3]); w0.z = cvt_pk_bf16(kt[4], kt[5]); w0.w = cvt_pk_bf16(kt[6], kt[7]);
      w1.x = cvt_pk_bf16(kt[8], kt[9]); w1.y = cvt_pk_bf16(kt[10], kt[11]); w1.z = cvt_pk_bf16(kt[12], kt[13]); w1.w = cvt_pk_bf16(kt[14], kt[15]);
      *(LAS u32x4*)(lds + L1_KTT + ch * 144 + tq * 32) = w0; *(LAS u32x4*)(lds + L1_KTT + ch * 144 + tq * 32 + 16) = w1; }
    __syncthreads();
#pragma unroll
    for (int i = 0; i < 2; ++i) { const int id = tid + 512 * i, r = id >> 4, cc = id & 15;
        *(u32x4*)(QTg + (size_t)(t0 + r) * 1024 + hh * 128 + cc * 8) = *(const LAS u32x4*)(lds + L1_QT + r * 272 + cc * 16); }
    { const int mi = w >> 1, nj0 = 2 * (w & 1);
      f32x4 pd[2] = {{0.f, 0.f, 0.f, 0.f}, {0.f, 0.f, 0.f, 0.f}};
#pragma unroll
      for (int ks = 0; ks < 4; ++ks) { const bf16x8 a = *(const LAS bf16x8*)(lds + L1_QT + (16 * mi + fr) * 272 + (32 * ks + 8 * fq) * 2);
#pragma unroll
          for (int j = 0; j < 2; ++j) { const bf16x8 bb = *(const LAS bf16x8*)(lds + L1_KT + (16 * (nj0 + j) + fr) * 272 + (32 * ks + 8 * fq) * 2); pd[j] = MFMA16(a, bb, pd[j]); } }
#pragma unroll
      for (int j = 0; j < 2; ++j)
#pragma unroll
          for (int r = 0; r < 4; ++r) { const int ii = 16 * mi + 4 * fq + r, jj = 16 * (nj0 + j) + fr; if (DIR ? (jj >= ii) : (jj <= ii)) pacc[j][r] += pd[j][r]; } }
    { bf16* Ug = (bf16*)(F.ws + WS_U) + ((size_t)(DIR * 8 + hh) * NCH + c) * 256 * 128;
      bf16x8 bv[2][2];
#pragma unroll
      for (int nj = 0; nj < 2; ++nj)
#pragma unroll
          for (int ks = 0; ks < 2; ++ks) bv[nj][ks] = *(const LAS bf16x8*)(lds + L1_VT + (32 * w + 16 * nj + fr) * 144 + (32 * ks + 8 * fq) * 2);
#pragma unroll
      for (int P = 0; P < 4; ++P) {
          f32x4 u[2][2] = {{{0.f, 0.f, 0.f, 0.f}, {0.f, 0.f, 0.f, 0.f}}, {{0.f, 0.f, 0.f, 0.f}, {0.f, 0.f, 0.f, 0.f}}};
#pragma unroll
          for (int t = 0; t < 2; ++t)
#pragma unroll
              for (int ks = 0; ks < 2; ++ks) { const bf16x8 a = *(const LAS bf16x8*)(lds + L1_KTT + (32 * P + 8 * (fr >> 2) + 4 * t + (fr & 3)) * 144 + (32 * ks + 8 * fq) * 2);
#pragma unroll
                  for (int nj = 0; nj < 2; ++nj) u[t][nj] = MFMA16(a, bv[nj][ks], u[t][nj]); }
          asm volatile("s_nop 15" : "+v"(u[0][0]), "+v"(u[0][1]), "+v"(u[1][0]), "+v"(u[1][1]));
#pragma unroll
          for (int nj = 0; nj < 2; ++nj) { u32x4 o; o.x = cvt_pk_bf16(u[0][nj][0], u[0][nj][1]); o.y = cvt_pk_bf16(u[0][nj][2], u[0][nj][3]); o.z = cvt_pk_bf16(u[1][nj][0], u[1][nj][1]); o.w = cvt_pk_bf16(u[1][nj][2], u[1][nj][3]);
              *(u32x4*)(Ug + (size_t)(32 * w + 16 * nj + fr) * 128 + 32 * P + 8 * fq) = o; } } }
    __syncthreads();
}

__device__ __forceinline__ void s1_phase(Frame& F, int e) {
    PHASE_IDS(); LAS unsigned char* lds = F.lds; const int w = wave, fr = lane & 15, fq = lane >> 4;
    const bf16* P = (const bf16*)(F.ws + WS_PROJ);
    for (int item = blockIdx.x; item < 8 * NCH; item += F.G) {
        const int c = item >> 3, hh = item & 7, hd = hh & 3, t0 = c * 64; const bool is_gla = hh < 4, lat = c >= 4;
        const int qcol = is_gla ? 128 * hd : 3072 + 128 * hd, kcol = qcol + 512, vcol = is_gla ? 1024 + 256 * hd : 4096 + 256 * hd;
#pragma unroll
        for (int i = 0; i < 2; ++i) { const int id = tid + 512 * i, r = id >> 4, cc = id & 15;
            *(LAS u32x4*)(lds + L1_QRAW + r * 256 + cc * 16) = *(const u32x4*)(P + (size_t)(t0 + r) * EV_N + qcol + cc * 8);
            *(LAS u32x4*)(lds + L1_KRAW + r * 256 + cc * 16) = *(const u32x4*)(P + (size_t)(t0 + r) * EV_N + kcol + cc * 8); }
#pragma unroll
        for (int i = 0; i < 4; ++i) { const int id = tid + 512 * i, r = id & 63, cc = id >> 6;
            const u32x4 v = *(const u32x4*)(P + (size_t)(t0 + r) * EV_N + vcol + cc * 8);
            LAS bf16* vt = (LAS bf16*)(lds + L1_VT) + (cc * 8) * 72 + r;
            vt[0 * 72] = (bf16)(v.x & 0xffff); vt[1 * 72] = (bf16)(v.x >> 16); vt[2 * 72] = (bf16)(v.y & 0xffff); vt[3 * 72] = (bf16)(v.y >> 16);
            vt[4 * 72] = (bf16)(v.z & 0xffff); vt[5 * 72] = (bf16)(v.z >> 16); vt[6 * 72] = (bf16)(v.w & 0xffff); vt[7 * 72] = (bf16)(v.w >> 16); }
        if (is_gla && tid < 256) { const int r = tid >> 2, cc = tid & 3; *(LAS u32x4*)(lds + L1_GD + r * 64 + cc * 16) = *(const u32x4*)(P + (size_t)(t0 + r) * EV_N + 6144 + cc * 8); }
        float wvf[16], wvb[16], bgf = 0.f, bgb = 0.f; f32x2 csv[16];
        { const int ch = tid & 127, tq = tid >> 7;
#pragma unroll
          for (int r = 0; r < 16; ++r) { wvf[r] = 0.f; wvb[r] = 0.f; csv[r] = (f32x2){1.f, 0.f}; }
          if (is_gla) {
              const float* wgf = F.a->in[11] + (size_t)e * 16 * 512 + hd * 128 + ch; const float* wgb = F.a->in[13] + (size_t)e * 16 * 512 + hd * 128 + ch;
#pragma unroll
              for (int r = 0; r < 16; ++r) { wvf[r] = wgf[r * 512]; wvb[r] = wgb[r * 512]; }
              bgf = F.a->in[12][e * 512 + hd * 128 + ch]; bgb = F.a->in[14][e * 512 + hd * 128 + ch];
          } else if (lat) {
              const f32x2* RT = (const f32x2*)(F.ws + WS_RT) + (size_t)(t0 + 16 * tq - NCTX) * 64 + (ch & 63);
#pragma unroll
              for (int r = 0; r < 16; ++r) csv[r] = RT[r * 64];
          } }
        __syncthreads();
        f32x4 pacc[2] = {{0.f, 0.f, 0.f, 0.f}, {0.f, 0.f, 0.f, 0.f}};
        s1_dir<0>(F, e, hh, c, lat, pacc, wvf, bgf, csv);
        s1_dir<1>(F, e, hh, c, lat, pacc, wvb, bgb, csv);
        { const int mi = w >> 1, nj0 = 2 * (w & 1);
#pragma unroll
          for (int j = 0; j < 2; ++j)
#pragma unroll
              for (int r = 0; r < 4; ++r) *(LAS bf16*)(lds + L1_P + (16 * mi + 4 * fq + r) * 144 + (16 * (nj0 + j) + fr) * 2) = f2bf(pacc[j][r]); }
        __syncthreads();
        { float* OI = (float*)(F.ws + WS_OI);
          bf16x8 bv[2][2];
#pragma unroll
          for (int nj = 0; nj < 2; ++nj)
#pragma unroll
              for (int ks = 0; ks < 2; ++ks) bv[nj][ks] = *(const LAS bf16x8*)(lds + L1_VT + (32 * w + 16 * nj + fr) * 144 + (32 * ks + 8 * fq) * 2);
#pragma unroll
          for (int mi = 0; mi < 4; ++mi) {
              f32x4 o[2] = {{0.f, 0.f, 0.f, 0.f}, {0.f, 0.f, 0.f, 0.f}};
#pragma unroll
              for (int ks = 0; ks < 2; ++ks) { const bf16x8 a = *(const LAS bf16x8*)(lds + L1_P + (16 * mi + fr) * 144 + (32 * ks + 8 * fq) * 2);
#pragma unroll
                  for (int nj = 0; nj < 2; ++nj) o[nj] = MFMA16(a, bv[nj][ks], o[nj]); }
#pragma unroll
              for (int nj = 0; nj < 2; ++nj)
#pragma unroll
                  for (int r = 0; r < 4; ++r) ((LAS float*)lds)[(16 * mi + 4 * fq + r) * 260 + 32 * w + 16 * nj + fr] = o[nj][r]; }
          __syncthreads();
#pragma unroll
          for (int i = 0; i < 8; ++i) { const int id = tid + 512 * i, r = id >> 6, cc = id & 63;
              *(f32x4*)(OI + (size_t)(t0 + r) * DM + hh * 256 + cc * 4) = *(const LAS f32x4*)((LAS float*)lds + r * 260 + cc * 4); } }
        __syncthreads();
    }
}

__device__ __forceinline__ void s2_phase(Frame& F) {
    PHASE_IDS();
    constexpr int SB = 13, NB = NCH / SB; static_assert(NB * SB == NCH, "NCH % 13");
    const int gt = F.vcu * NTHR + tid, NGT = F.G * NTHR;
    for (int idx = gt; idx < 2 * 8 * 256 * 32; idx += NGT) {
        const int dk4 = idx & 31, ee = (idx >> 5) & 255, dh = idx >> 13, dir = dh >> 3;
        const bf16* U = (const bf16*)(F.ws + WS_U) + (size_t)dh * NCH * 256 * 128 + (size_t)ee * 128 + dk4 * 4;
        bf16* S = (bf16*)(F.ws + WS_S) + (size_t)dh * NCH * 256 * 128 + (size_t)ee * 128 + dk4 * 4;
        const float* D = (const float*)(F.ws + WS_DEC) + (size_t)dh * NCH * 128 + dk4 * 4;
        f32x4 s = {0.f, 0.f, 0.f, 0.f};
        u32x2 un[SB]; f32x4 dn[SB];
#define S2_CH(step) (dir ? ((step) < 4 ? 3 - (step) : NCH + 3 - (step)) : (step))
#pragma unroll
        for (int i = 0; i < SB; ++i) { const int c = S2_CH(i); un[i] = *(const u32x2*)(U + (size_t)c * 256 * 128); dn[i] = *(const f32x4*)(D + (size_t)c * 128); }
#pragma nounroll
        for (int b = 0; b < NB; ++b) {
            u32x2 uc[SB]; f32x4 dc[SB];
#pragma unroll
            for (int i = 0; i < SB; ++i) { uc[i] = un[i]; dc[i] = dn[i]; }
            if (b + 1 < NB) {
#pragma unroll
                for (int i = 0; i < SB; ++i) { const int c = S2_CH((b + 1) * SB + i); un[i] = *(const u32x2*)(U + (size_t)c * 256 * 128); dn[i] = *(const f32x4*)(D + (size_t)c * 128); } }
#pragma unroll
            for (int i = 0; i < SB; ++i) { const int c = S2_CH(b * SB + i);
                u32x2 so; so.x = cvt_pk_bf16(s.x, s.y); so.y = cvt_pk_bf16(s.z, s.w);
                *(u32x2*)(S + (size_t)c * 256 * 128) = so;
                s.x = dc[i].x * (s.x + bflo(uc[i].x)); s.y = dc[i].y * (s.y + bfhi(uc[i].x)); s.z = dc[i].z * (s.z + bflo(uc[i].y)); s.w = dc[i].w * (s.w + bfhi(uc[i].y)); }
        }
#undef S2_CH
    }
}

constexpr int L3_QF = 0, L3_QB = 17408, L3_OL = 34816;
__device__ __forceinline__ void s3_phase(Frame& F, int e) {
    PHASE_IDS(); LAS unsigned char* lds = F.lds; const int w = wave, fr = lane & 15, fq = lane >> 4;
    const bf16* P = (const bf16*)(F.ws + WS_PROJ); const bf16* QTg = (const bf16*)(F.ws + WS_QT); const float* OI = (const float*)(F.ws + WS_OI);
    bf16* MIX = (bf16*)(F.ws + WS_MIX);
    for (int item = blockIdx.x; item < 8 * NCH; item += F.G) {
        const int c = item >> 3, hh = item & 7, hd = hh & 3, t0 = c * 64; const bool is_gla = hh < 4;
        const int gcol = is_gla ? 2048 + 256 * hd : 5120 + 256 * hd;
#pragma unroll
        for (int dir = 0; dir < 2; ++dir)
#pragma unroll
            for (int i = 0; i < 2; ++i) { const int id = tid + 512 * i, r = id >> 4, cc = id & 15;
                *(LAS u32x4*)(lds + (dir ? L3_QB : L3_QF) + r * 272 + cc * 16) = *(const u32x4*)(QTg + (size_t)dir * T * 1024 + (size_t)(t0 + r) * 1024 + hh * 128 + cc * 8); }
        bf16x8 bv[2][4][2];
#pragma unroll
        for (int dir = 0; dir < 2; ++dir) { const bf16* Sg = (const bf16*)(F.ws + WS_S) + ((size_t)(dir * 8 + hh) * NCH + c) * 256 * 128;
#pragma unroll
            for (int ks = 0; ks < 4; ++ks)
#pragma unroll
                for (int nj = 0; nj < 2; ++nj) bv[dir][ks][nj] = *(const bf16x8*)(Sg + (size_t)(32 * w + 16 * nj + fr) * 128 + 32 * ks + 8 * fq); }
        __builtin_amdgcn_sched_barrier(0);
        __syncthreads();
        f32x4 o[4][2];
#pragma unroll
        for (int mi = 0; mi < 4; ++mi)
#pragma unroll
            for (int nj = 0; nj < 2; ++nj) o[mi][nj] = (f32x4){0.f, 0.f, 0.f, 0.f};
#pragma unroll
        for (int dir = 0; dir < 2; ++dir) {
#pragma unroll
            for (int ks = 0; ks < 4; ++ks) {
#pragma unroll
                for (int mi = 0; mi < 4; ++mi) { const bf16x8 a = *(const LAS bf16x8*)(lds + (dir ? L3_QB : L3_QF) + (16 * mi + fr) * 272 + (32 * ks + 8 * fq) * 2);
#pragma unroll
                    for (int nj = 0; nj < 2; ++nj) o[mi][nj] = MFMA16(a, bv[dir][ks][nj], o[mi][nj]); } } }
        LAS float* OL = (LAS float*)(lds + L3_OL);
#pragma unroll
        for (int mi = 0; mi < 4; ++mi)
#pragma unroll
            for (int nj = 0; nj < 2; ++nj)
#pragma unroll
                for (int r = 0; r < 4; ++r) OL[(16 * mi + 4 * fq + r) * 260 + 32 * w + 16 * nj + fr] = o[mi][nj][r];
        __syncthreads();
        { const int tk = tid >> 3, seg = tid & 7;
          f32x4 v[4][2]; float sq = 0.f;
#pragma unroll
          for (int g = 0; g < 4; ++g) { const int ee = 64 * g + 8 * seg; const float* oi = OI + (size_t)(t0 + tk) * DM + hh * 256 + ee;
              v[g][0] = *(const LAS f32x4*)(OL + tk * 260 + ee) + *(const f32x4*)oi; v[g][1] = *(const LAS f32x4*)(OL + tk * 260 + ee + 4) + *(const f32x4*)(oi + 4);
              sq += (v[g][0].x * v[g][0].x + v[g][0].y * v[g][0].y) + (v[g][0].z * v[g][0].z + v[g][0].w * v[g][0].w) + (v[g][1].x * v[g][1].x + v[g][1].y * v[g][1].y) + (v[g][1].z * v[g][1].z + v[g][1].w * v[g][1].w); }
          sq += __shfl_xor(sq, 1); sq += __shfl_xor(sq, 2); sq += __shfl_xor(sq, 4);
          const float rstd = 1.0f / sqrtf(sq * (1.0f / 256.0f) + RMS_EPS);
#pragma unroll
          for (int g = 0; g < 4; ++g) { const int ee = 64 * g + 8 * seg;
              const u32x4 gt = *(const u32x4*)(P + (size_t)(t0 + tk) * EV_N + gcol + ee);
              f32x4 n0 = {1.f, 1.f, 1.f, 1.f}, n1 = {1.f, 1.f, 1.f, 1.f};
              if (is_gla) { n0 = *(const f32x4*)(F.a->in[15] + e * 256 + ee); n1 = *(const f32x4*)(F.a->in[15] + e * 256 + ee + 4); }
              const f32x4 a0 = v[g][0] * rstd * n0, a1 = v[g][1] * rstd * n1;
              u32x4 ow; ow.x = cvt_pk_bf16(a0.x * silu_f(bflo(gt.x)), a0.y * silu_f(bfhi(gt.x))); ow.y = cvt_pk_bf16(a0.z * silu_f(bflo(gt.y)), a0.w * silu_f(bfhi(gt.y)));
              ow.z = cvt_pk_bf16(a1.x * silu_f(bflo(gt.z)), a1.y * silu_f(bfhi(gt.z))); ow.w = cvt_pk_bf16(a1.z * silu_f(bflo(gt.w)), a1.w * silu_f(bfhi(gt.w)));
              *(u32x4*)(MIX + (size_t)(t0 + tk) * DM + hh * 256 + ee) = ow; } }
        __syncthreads();
    }
}

__device__ __forceinline__ void e1_phase(Frame& F, int o) {
    PHASE_IDS();
    const int gw = F.vcu * NWAVES + wave, NGW = F.G * NWAVES;
    const bf16* P = (const bf16*)(F.ws + WS_PROJ); bf16* CQN = (bf16*)(F.ws + WS_CQN); bf16* CKVN = (bf16*)(F.ws + WS_CKVN); bf16* KR = (bf16*)(F.ws + WS_KR);
    const float* wq = F.a->in[18] + o * 512 + lane * 8; const float* wkv = F.a->in[19] + o * 512 + lane * 8;
    const f32x4 wq0 = *(const f32x4*)wq, wq1 = *(const f32x4*)(wq + 4), wk0 = *(const f32x4*)wkv, wk1 = *(const f32x4*)(wkv + 4);
    const f32x2* AXR = (const f32x2*)(F.ws + WS_AXR); const f32x2* AXC = (const f32x2*)(F.ws + WS_AXC);
    for (int t = gw; t < T; t += NGW) {
        const bf16* p = P + (size_t)t * OD_N;
        const u32x4 a = *(const u32x4*)(p + lane * 8), b = *(const u32x4*)(p + 512 + lane * 8);
        float x[8] = {bflo(a.x), bfhi(a.x), bflo(a.y), bfhi(a.y), bflo(a.z), bfhi(a.z), bflo(a.w), bfhi(a.w)};
        float y[8] = {bflo(b.x), bfhi(b.x), bflo(b.y), bfhi(b.y), bflo(b.z), bfhi(b.z), bflo(b.w), bfhi(b.w)};
        float sx = 0.f, sy = 0.f;
#pragma unroll
        for (int j = 0; j < 8; ++j) { sx += x[j] * x[j]; sy += y[j] * y[j]; }
        const float rx = 1.0f / sqrtf(wave_sum(sx) * (1.0f / 512.0f) + RMS_EPS), ry = 1.0f / sqrtf(wave_sum(sy) * (1.0f / 512.0f) + RMS_EPS);
        u32x4 oq, ok;
        oq.x = cvt_pk_bf16(x[0] * rx * wq0.x, x[1] * rx * wq0.y); oq.y = cvt_pk_bf16(x[2] * rx * wq0.z, x[3] * rx * wq0.w); oq.z = cvt_pk_bf16(x[4] * rx * wq1.x, x[5] * rx * wq1.y); oq.w = cvt_pk_bf16(x[6] * rx * wq1.z, x[7] * rx * wq1.w);
        ok.x = cvt_pk_bf16(y[0] * ry * wk0.x, y[1] * ry * wk0.y); ok.y = cvt_pk_bf16(y[2] * ry * wk0.z, y[3] * ry * wk0.w); ok.z = cvt_pk_bf16(y[4] * ry * wk1.x, y[5] * ry * wk1.y); ok.w = cvt_pk_bf16(y[6] * ry * wk1.z, y[7] * ry * wk1.w);
        *(u32x4*)(CQN + (size_t)t * 512 + lane * 8) = oq; *(u32x4*)(CKVN + (size_t)t * 512 + lane * 8) = ok;
        float v = bf2f(p[1024 + lane]); const float pr = __shfl_xor(v, 16);
        if (t >= NCTX) { const int pp = t - NCTX, pos = (lane & 32) ? (pp & 63) : (pp >> 6); const f32x2 cs = ((lane & 32) ? AXC : AXR)[pos * 16 + (lane & 15)];
            v = (lane & 16) ? v * cs.x + pr * cs.y : v * cs.x - pr * cs.y; }
        KR[(size_t)t * 64 + lane] = f2bf(v);
    }
}

namespace att {
constexpr int KVBLK = 64;
constexpr float SCALE = 0.07216878364870322f;
constexpr float THR = 8.f;
constexpr int SHM_K = 64 * 384, SHM_V = 64 * 256;
constexpr int A_V = 0, A_K = 3 * SHM_V, A_WS = 3 * SHM_V + 3 * SHM_K;
#define SBAR() __builtin_amdgcn_sched_barrier(0)
__device__ __forceinline__ int crow(int r, int hi) { return (r & 3) + 8 * (r >> 2) + 4 * hi; }
constexpr float PLIM = 4096.f;
__device__ __forceinline__ void exp_sum(f32x16& p0, f32x16& p1, float& ps) {
#pragma unroll
    for (int r = 0; r < 16; ++r) p0[r] = __builtin_amdgcn_exp2f(p0[r]);
#pragma unroll
    for (int r = 0; r < 16; ++r) p1[r] = __builtin_amdgcn_exp2f(p1[r]);
    ps = p0[0];
#pragma unroll
    for (int r = 1; r < 16; ++r) ps += p0[r];
#pragma unroll
    for (int r = 0; r < 16; ++r) ps += p1[r];
}
__device__ __forceinline__ float row_max32(const f32x16& p0, const f32x16& p1) {
    float pmax = p0[0];
#pragma unroll
    for (int r = 1; r < 16; ++r) pmax = fmaxf(pmax, p0[r]);
#pragma unroll
    for (int r = 0; r < 16; ++r) pmax = fmaxf(pmax, p1[r]);
    auto rr = __builtin_amdgcn_permlane32_swap(__float_as_uint(pmax), __float_as_uint(pmax), false, false);
    return fmaxf(__uint_as_float(rr[0]), __uint_as_float(rr[1]));
}
__device__ __forceinline__ void pack_p(const f32x16& p0, const f32x16& p1, bf16x8& pa0, bf16x8& pa1, bf16x8& pa2, bf16x8& pa3) {
#define PK4(P, BASE, OUT) do { unsigned a0 = cvt_pk_bf16(P[BASE + 0], P[BASE + 1]), a1 = cvt_pk_bf16(P[BASE + 2], P[BASE + 3]);   \
    unsigned b0 = cvt_pk_bf16(P[BASE + 4], P[BASE + 5]), b1 = cvt_pk_bf16(P[BASE + 6], P[BASE + 7]);                              \
    auto r0 = __builtin_amdgcn_permlane32_swap(a0, b0, false, false); auto r1 = __builtin_amdgcn_permlane32_swap(a1, b1, false, false); \
    u32x4 w = {r0[0], r1[0], r0[1], r1[1]}; OUT = *reinterpret_cast<bf16x8*>(&w); } while (0)
    PK4(p0, 0, pa0); PK4(p0, 8, pa1); PK4(p1, 0, pa2); PK4(p1, 8, pa3);
#undef PK4
}
__device__ __forceinline__ int kswz(int row, int g) { return row * 384 + (((g & ~7) | ((g & 7) ^ ((row >> 1) & 7))) << 4); }
__device__ __forceinline__ void qkt(f32x16& p0, f32x16& p1, const LAS unsigned char* Ks, const bf16x8 (&qr)[12], const int (&kx)[4], const f32x16& init) {
    bf16x8 c0 = *(const LAS bf16x8*)(Ks + kx[0]), c1 = *(const LAS bf16x8*)(Ks + kx[0] + 32 * 384), n0, n1;
#pragma unroll
    for (int d0 = 0; d0 < 12; ++d0) {
        if (d0 < 11) { n0 = *(const LAS bf16x8*)(Ks + kx[(d0 + 1) & 3] + ((d0 + 1) >> 2) * 128); n1 = *(const LAS bf16x8*)(Ks + kx[(d0 + 1) & 3] + ((d0 + 1) >> 2) * 128 + 32 * 384); }
        __builtin_amdgcn_sched_barrier(0);
        p0 = MFMA32(c0, qr[d0], d0 == 0 ? init : p0);
        p1 = MFMA32(c1, qr[d0], d0 == 0 ? init : p1);
        __builtin_amdgcn_sched_barrier(0);
        c0 = n0; c1 = n1; }
}
__device__ __forceinline__ int v_st(int k, int c) { const int kk = (k & ~0xC) | ((k & 4) << 1) | ((k & 8) >> 1); return ((kk >> 3) * 4 + (c >> 5)) * 512 + ((kk & 7) * 32 + (c & 31)) * 2; }
__device__ __forceinline__ int v_rd_base(int lane) { return ((lane & 3) << 3) | (((lane >> 2) & 3) << 6) | (((lane >> 4) & 1) << 5) | (((lane >> 5) & 1) << 8); }
constexpr int v_rd_off(int d0, int ks, int half) { return d0 * 512 + ks * 4096 + half * 2048; }
template <int OFF> __device__ __forceinline__ s16x4 tr_read(int vb) {
    s16x4 r; asm volatile("ds_read_b64_tr_b16 %0, %1 offset:%2" : "=&v"(r) : "v"(vb), "i"(OFF) : "memory"); return r;
}
struct VF { s16x4 l0, h0, l1, h1, l2, h2, l3, h3; };
template <int D0> __device__ __forceinline__ void v_load(VF& f, int vb) {
    f.l0 = tr_read<v_rd_off(D0, 0, 0)>(vb); f.h0 = tr_read<v_rd_off(D0, 0, 1)>(vb); f.l1 = tr_read<v_rd_off(D0, 1, 0)>(vb); f.h1 = tr_read<v_rd_off(D0, 1, 1)>(vb);
    f.l2 = tr_read<v_rd_off(D0, 2, 0)>(vb); f.h2 = tr_read<v_rd_off(D0, 2, 1)>(vb); f.l3 = tr_read<v_rd_off(D0, 3, 0)>(vb); f.h3 = tr_read<v_rd_off(D0, 3, 1)>(vb);
}
__device__ __forceinline__ void pv_mma(f32x16& od, const VF& f, bf16x8 pa0, bf16x8 pa1, bf16x8 pa2, bf16x8 pa3) {
#define PK(L, H) (bf16x8){L[0], L[1], L[2], L[3], H[0], H[1], H[2], H[3]}
    od = MFMA32(pa0, PK(f.l0, f.h0), od);
    od = MFMA32(pa1, PK(f.l1, f.h1), od);
    od = MFMA32(pa2, PK(f.l2, f.h2), od);
    od = MFMA32(pa3, PK(f.l3, f.h3), od);
#undef PK
}
__device__ __forceinline__ void pv_d0(f32x16 (&o)[4], int vb, bf16x8 pa0, bf16x8 pa1, bf16x8 pa2, bf16x8 pa3) {
    VF fa, fb;
    v_load<0>(fa, vb); v_load<1>(fb, vb);
    asm volatile("s_waitcnt lgkmcnt(8)" ::: "memory"); SBAR(); pv_mma(o[0], fa, pa0, pa1, pa2, pa3); SBAR();
    v_load<2>(fa, vb);
    asm volatile("s_waitcnt lgkmcnt(8)" ::: "memory"); SBAR(); pv_mma(o[1], fb, pa0, pa1, pa2, pa3); SBAR();
    v_load<3>(fb, vb);
    asm volatile("s_waitcnt lgkmcnt(8)" ::: "memory"); SBAR(); pv_mma(o[2], fa, pa0, pa1, pa2, pa3); SBAR();
    asm volatile("s_waitcnt lgkmcnt(0)" ::: "memory"); SBAR(); pv_mma(o[3], fb, pa0, pa1, pa2, pa3);
}
__device__ __forceinline__ void rope_pair(bf16x8& a, bf16x8& b, const f32x2* cs) {
    u32x4 ua = *reinterpret_cast<u32x4*>(&a), ub = *reinterpret_cast<u32x4*>(&b); u32x4 oa, ob;
#pragma unroll
    for (int j = 0; j < 4; ++j) { const f32x2 c0 = cs[2 * j], c1 = cs[2 * j + 1];
        const float x1l = bflo(ua[j]), x1h = bfhi(ua[j]), x2l = bflo(ub[j]), x2h = bfhi(ub[j]);
        oa[j] = cvt_pk_bf16(x1l * c0.x - x2l * c0.y, x1h * c1.x - x2h * c1.y);
        ob[j] = cvt_pk_bf16(x2l * c0.x + x1l * c0.y, x2h * c1.x + x1h * c1.y); }
    a = *reinterpret_cast<bf16x8*>(&oa); b = *reinterpret_cast<bf16x8*>(&ob);
}
__device__ __forceinline__ void unit(Frame& F, int h, int qrow0, int nkeys) {
    LAS unsigned char* lds = F.lds;
    PHASE_IDS(); const int wid = wave, r32 = lane & 31, hi = lane >> 5;
    const bf16* QB = (const bf16*)(F.ws + WS_QB); const bf16* KVB = (const bf16*)(F.ws + WS_KVB); const bf16* KR = (const bf16*)(F.ws + WS_KR);
    LAS unsigned char* V_lds = lds + A_V; LAS unsigned char* K_lds = lds + A_K;
    LAS float* wsl = (LAS float*)(lds + A_WS) + wid * 64; LAS float* li_l = wsl; LAS float* al_l = wsl + 32;
    float m_reg = -1e30f, l_reg = 0; f32x16 o[4] = {}; bf16x8 qr[12]; f32x16 negm;
    const int qt = qrow0 + wid * 32 + r32;
    const bf16* Qw = QB + (size_t)qt * 3072 + 192 * h + hi * 8;
#pragma unroll
    for (int d0 = 0; d0 < 12; ++d0) qr[d0] = *(const bf16x8*)(Qw + d0 * 16);
    if (qt >= NCTX) { const int pp = qt - NCTX;
        rope_pair(qr[8], qr[9], (const f32x2*)(F.ws + WS_AXR) + (pp >> 6) * 16 + hi * 8);
        rope_pair(qr[10], qr[11], (const f32x2*)(F.ws + WS_AXC) + (pp & 63) * 16 + hi * 8); }
    const unsigned char* wsb = F.ws;
    unsigned koff[3], kfl = 0u; int kdst[3];
#pragma unroll
    for (int i = 0; i < 3; ++i) { const int id = tid + 512 * i, row = id / 24, g = id % 24;
        if (g < 16) { koff[i] = (unsigned)WS_KVB + (unsigned)(row * 4096 + 256 * h + g * 8) * 2u; kfl |= 1u << i; } else { koff[i] = (unsigned)WS_KR + (unsigned)(row * 64 + (g - 16) * 8) * 2u; }
        kdst[i] = kswz(row, g); }
    const int sr = tid >> 4, sc = (tid & 15) * 8, vst0 = v_st(sr, sc);
    const unsigned voff = (unsigned)WS_KVB + (unsigned)(sr * 4096 + 256 * h + 128 + sc) * 2u;
    const int vb0 = (int)(unsigned)(uintptr_t)V_lds + v_rd_base(lane);
    int kx[4];
#pragma unroll
    for (int q = 0; q < 4; ++q) kx[q] = r32 * 384 + ((((2 * q) | hi) ^ ((r32 >> 1) & 7)) << 4);
    bf16x8 sk0, sk1, sk2, sv0, sv1;
#define SLOAD(jt) do { const unsigned vo_ = voff + (unsigned)(jt) * (64u * 4096u * 2u); sv0 = *(const bf16x8*)(wsb + vo_); sv1 = *(const bf16x8*)(wsb + vo_ + 32u * 4096u * 2u); \
    const unsigned kt_ = (unsigned)(jt) * 8192u; \
    sk0 = *(const bf16x8*)(wsb + koff[0] + (kt_ << ((kfl & 1u) * 6u))); sk1 = *(const bf16x8*)(wsb + koff[1] + (kt_ << (((kfl >> 1) & 1u) * 6u))); sk2 = *(const bf16x8*)(wsb + koff[2] + (kt_ << (((kfl >> 2) & 1u) * 6u))); } while (0)
#define SWRITE(b) do { *(LAS bf16x8*)(V_lds + (b) * SHM_V + vst0) = sv0; *(LAS bf16x8*)(V_lds + (b) * SHM_V + vst0 + 8192) = sv1; \
    *(LAS bf16x8*)(K_lds + (b) * SHM_K + kdst[0]) = sk0; *(LAS bf16x8*)(K_lds + (b) * SHM_K + kdst[1]) = sk1; *(LAS bf16x8*)(K_lds + (b) * SHM_K + kdst[2]) = sk2; } while (0)
#define SWAIT() asm volatile("s_waitcnt vmcnt(0)" ::: "memory")
#define NEGM_SET(v) do { const float v_ = (v); _Pragma("unroll") for (int r = 0; r < 16; ++r) negm[r] = v_; asm volatile("" : "+v"(negm)); } while (0)
    f32x16 p0, p1; bf16x8 pa0, pa1, pa2, pa3; const int NT = nkeys / KVBLK;
    NEGM_SET(0.f);
#define ABAR() do { asm volatile("s_waitcnt lgkmcnt(0)" ::: "memory"); __builtin_amdgcn_s_barrier(); asm volatile("" ::: "memory"); } while (0)
#define ASTAGE(j) do { if ((j) + 1 < NT) { SWAIT(); SWRITE(b1); } if ((j) + 2 < NT) SLOAD((j) + 2); } while (0)
#define AQK(j) do { SBAR(); qkt(p0, p1, K_lds + b0 * SHM_K, qr, kx, negm); SBAR(); } while (0)
#define RARE(j) do { _Pragma("nounroll") for (int pass_ = 0; pass_ < 2; ++pass_) { NEGM_SET(pass_ ? -m_reg : 0.f); AQK(j); \
      if (pass_ == 0) { const float mnew_ = fmaxf(m_reg, row_max32(p0, p1)); const float a_ = __builtin_amdgcn_exp2f(m_reg - mnew_); m_reg = mnew_; l_reg *= a_; \
        if (hi == 0) al_l[r32] = a_; asm volatile("s_waitcnt lgkmcnt(0)" ::: "memory"); \
        _Pragma("unroll") for (int d = 0; d < 4; ++d) { SBAR(); _Pragma("unroll") for (int r = 0; r < 16; ++r) o[d][r] *= al_l[crow(r, hi)]; } SBAR(); } } } while (0)
#define ASP(j) do { float ps; exp_sum(p0, p1, ps); \
    if (__builtin_expect((j) == 0 || __any(!(ps <= PLIM)), 0)) { RARE(j); exp_sum(p0, p1, ps); } \
    { auto rr = __builtin_amdgcn_permlane32_swap(__float_as_uint(ps), __float_as_uint(ps), false, false); l_reg += __uint_as_float(rr[0]) + __uint_as_float(rr[1]); } \
    pack_p(p0, p1, pa0, pa1, pa2, pa3); SBAR(); pv_d0(o, vb0 + b0 * SHM_V, pa0, pa1, pa2, pa3); } while (0)
    SLOAD(0); SWAIT(); SWRITE(0); SLOAD(1); ABAR();
    { const bool g1 = __builtin_amdgcn_readfirstlane(wid >> 2) != 0;
      if (g1) ABAR();
      int b0 = 0;
      for (int j = 0; j < NT; ++j) { const int b1 = b0 == 2 ? 0 : b0 + 1; ASTAGE(j); AQK(j); ABAR(); ASP(j); ABAR(); b0 = b1; }
      if (!g1) ABAR(); }
#undef ABAR
#undef ASTAGE
#undef AQK
#undef ASP
#undef RARE
#undef NEGM_SET
    if (hi == 0) li_l[r32] = l_reg; asm volatile("s_waitcnt lgkmcnt(0)" ::: "memory");
    float rli[16];
#pragma unroll
    for (int r = 0; r < 16; ++r) rli[r] = __builtin_amdgcn_rcpf(li_l[crow(r, hi)]);
    unsigned orow0 = (unsigned)(qrow0 + wid * 32) * DM + 128 * h; asm volatile("" : "+v"(orow0));
    bf16* Ow = (bf16*)(F.ws + WS_MIX) + orow0;
#pragma unroll
    for (int r = 0; r < 16; ++r) { const int orow = crow(r, hi);
#pragma unroll
        for (int d0 = 0; d0 < 4; ++d0) Ow[(size_t)orow * DM + d0 * 32 + r32] = f2bf(o[d0][r] * rli[r]); }
    __syncthreads();
#undef SLOAD
#undef SWRITE
#undef SWAIT
}
}

__device__ __forceinline__ void attn_phase(Frame& F) {
    for (int u = F.vcu; u < 1024 + 16; u += F.G) {
        if (u < 1024) att::unit(F, u >> 6, NCTX + 256 * (u & 63), T);
        else att::unit(F, u - 1024, 0, NCTX);
    }
}

#ifdef DBG
constexpr int DBG_W_BAD = 64, DBG_W_SSQ = 65, DBG_W_CNT = 66, DBG_W_MAX = 67;
__device__ __forceinline__ void dbg_scan(Frame& F, int id, size_t off, size_t nbytes, bool is_bf) {
    PHASE_IDS();
    const u32x4* p = (const u32x4*)(F.ws + off); const size_t n = nbytes / 16; bool bad = false;
    for (size_t i = (size_t)F.vcu * NTHR + tid; i < n; i += (size_t)F.G * NTHR) { const u32x4 v = p[i];
#pragma unroll
        for (int j = 0; j < 4; ++j) { if (is_bf) { bad |= ((v[j] & 0x7f80u) == 0x7f80u) | ((v[j] & 0x7f800000u) == 0x7f800000u); } else bad |= ((v[j] & 0x7f800000u) == 0x7f800000u); } }
    if (__any(bad) && lane == 0) atomicMax((unsigned*)(F.ws + WS_CTL) + DBG_W_BAD, (unsigned)(100000 - id));
}
__device__ __forceinline__ void dbg_max(Frame& F, size_t off, size_t nbytes, bool is_bf) {
    PHASE_IDS();
    const u32x4* p = (const u32x4*)(F.ws + off); const size_t n = nbytes / 16; unsigned mx = 0u;
    for (size_t i = (size_t)F.vcu * NTHR + tid; i < n; i += (size_t)F.G * NTHR) { const u32x4 v = p[i];
#pragma unroll
        for (int j = 0; j < 4; ++j) { if (is_bf) { const unsigned a0 = (v[j] << 16) & 0x7fffffffu, a1 = v[j] & 0x7fff0000u; if (a0 < 0x7f800000u) mx = max(mx, a0); if (a1 < 0x7f800000u) mx = max(mx, a1); } else { const unsigned a0 = v[j] & 0x7fffffffu; if (a0 < 0x7f800000u) mx = max(mx, a0); } } }
#pragma unroll
    for (int o = 1; o < 64; o <<= 1) mx = max(mx, (unsigned)__shfl_xor((int)mx, o));
    if (lane == 0) atomicMax((unsigned*)(F.ws + WS_CTL) + DBG_W_MAX, mx);
}
#define DBGSCAN(id, off, nbytes, isbf) dbg_scan(F, (id), (off), (nbytes), (isbf))
#else
#define DBGSCAN(id, off, nbytes, isbf) do {} while (0)
#endif

#ifndef RES_ALIGN
#define RES_ALIGN true
#endif
#ifndef RES_SP2
#define RES_SP2 true
#endif
__global__ void __launch_bounds__(NTHR, 2) fwd_kernel(Args args) {
    extern __shared__ __attribute__((aligned(16))) unsigned char lds_raw[];
    Frame F;
    F.lds = (LAS unsigned char*)lds_raw;
    F.G = gridDim.x; { const int bx = blockIdx.x; F.vcu = (F.G % 8 == 0) ? (bx % 8) * (F.G / 8) + bx / 8 : bx; }
    F.a = &args; F.ws = args.ws;
    volatile LAS unsigned* ctlw = (volatile LAS unsigned*)(F.lds + LDS_CTL);
    if (threadIdx.x < 16) ctlw[threadIdx.x] = 0u;
    __syncthreads();
    XcdBarrier bar = xcd_barrier_post((unsigned*)(F.ws + WS_CTL) + 4096, ctlw);
#define GRID_BAR() xcd_barrier(bar)
#ifdef DBG_TIME
    unsigned long long t_prev = __builtin_amdgcn_s_memrealtime();
#define TSTAMP(cat) do { if (blockIdx.x == 0 && threadIdx.x == 0) { const unsigned long long t_now = __builtin_amdgcn_s_memrealtime(); unsigned long long* tw = (unsigned long long*)(F.ws + WS_CTL) + 64 + (cat); *tw = *tw + (t_now - t_prev); t_prev = t_now; } } while (0)
#else
#define TSTAMP(cat) do {} while (0)
#endif

#ifndef SK_P0
    p0a(F);
#ifdef DUP_P0
    p0a(F);
#endif
#endif
    GRID_BAR();
    p0b(F); GRID_BAR();
    DBGSCAN(1, WS_MOD, (size_t)4 * 2 * NADA * 4, false);
    init_x_by_owners(F);
    row_phase<0>(F, nullptr, nullptr, modp(F, 0, 0, 0), modp(F, 0, 0, 1), modp(F, 0, 1, 0), modp(F, 0, 1, 1)); GRID_BAR(); TSTAMP(0);
    DBGSCAN(2, WS_X, (size_t)T * DM * 4, false); DBGSCAN(3, WS_H, (size_t)T * DM * 2, true);

    const pg8::bf16_t* Hb = (const pg8::bf16_t*)(F.ws + WS_H);
    for (int s = 0; s < 3 * DEPTH; ++s) {
        const int l = s / 3, r = s % 3;
        const pg8::bf16_t* A2; const pg8::bf16_t* B2; int K2;
        if (r != 1) {
            const int f = r >> 1;
            pg8::Gemm g{Hb, (const pg8::bf16_t*)(F.ws + WS_WFI + (size_t)(l * 2 + f) * SZ_WFI), T, 2 * DFF, DM, DM, DM};
            pg8::StaticOrder S; S.init(T, 2 * DFF, F.G, (int)blockIdx.x);
            pg8::EpiSwiGLU E{(pg8::bf16_t*)(F.ws + WS_HID), DFF};
#ifndef SK_SW
            pg8::gemm_phase<pg8::EpiSwiGLU, pg8::StaticOrder>(F.lds, g, S, E);
#endif
#ifdef DUP_SW
            pg8::gemm_phase<pg8::EpiSwiGLU, pg8::StaticOrder>(F.lds, g, S, E);
#endif
            GRID_BAR(); TSTAMP(1);
            DBGSCAN(10 + 10 * s, WS_HID, (size_t)T * DFF * 2, true);
            A2 = (const pg8::bf16_t*)(F.ws + WS_HID); B2 = (const pg8::bf16_t*)(F.ws + WS_WFO + (size_t)(l * 2 + f) * SZ_WFO); K2 = DFF;
        } else if ((l & 1) == 0) {
            const int e = l >> 1;
            { pg8::Gemm g{Hb, (const pg8::bf16_t*)(F.ws + WS_EWI + (size_t)e * SZ_EWI), T, EV_N, DM, DM, DM};
              pg8::StaticOrder S; S.init(T, EV_N, F.G, (int)blockIdx.x);
              pg8::EpiBf16 E{(pg8::bf16_t*)(F.ws + WS_PROJ), EV_N};
#ifndef SK_G1
              pg8::gemm_phase<pg8::EpiBf16, pg8::StaticOrder>(F.lds, g, S, E);
#endif
            }
            GRID_BAR(); TSTAMP(4);
            DBGSCAN(10 + 10 * s, WS_PROJ, (size_t)T * EV_N * 2 - 0, true);
#ifdef DBG
            if (s == 1) dbg_max(F, WS_PROJ, (size_t)T * EV_N * 2, true);
#endif
#ifndef SK_S1
            s1_phase(F, e);
#ifdef DUP_S1
            s1_phase(F, e);
#endif
#endif
            GRID_BAR(); TSTAMP(5);
            DBGSCAN(11 + 10 * s, WS_U, SZ_U, true); DBGSCAN(16 + 10 * s, WS_OI, (size_t)T * DM * 4, false); DBGSCAN(17 + 10 * s, WS_QT, (size_t)2 * T * 1024 * 2, true); DBGSCAN(18 + 10 * s, WS_DEC, (size_t)2 * 8 * NCH * 128 * 4, false);
#ifndef SK_S2
            s2_phase(F);
#ifdef DUP_S2
            s2_phase(F);
#endif
#endif
            GRID_BAR(); TSTAMP(6);
            DBGSCAN(12 + 10 * s, WS_S, SZ_U, true);
#ifndef SK_S3
            s3_phase(F, e);
#ifdef DUP_S3
            s3_phase(F, e);
#endif
#endif
            GRID_BAR(); TSTAMP(7);
            DBGSCAN(13 + 10 * s, WS_MIX, (size_t)T * DM * 2, true);
            A2 = (const pg8::bf16_t*)(F.ws + WS_MIX); B2 = (const pg8::bf16_t*)(F.ws + WS_EWO + (size_t)e * SZ_SQ); K2 = DM;
        } else {
            const int o = l >> 1;
            { pg8::Gemm g{Hb, (const pg8::bf16_t*)(F.ws + WS_OWI + (size_t)o * SZ_OWI), T, OD_N, DM, DM, DM};
              pg8::StaticOrder S; S.init(T, OD_N, F.G, (int)blockIdx.x);
              pg8::EpiBf16 E{(pg8::bf16_t*)(F.ws + WS_PROJ), OD_N};
#ifndef SK_G2
              pg8::gemm_phase<pg8::EpiBf16, pg8::StaticOrder>(F.lds, g, S, E);
#endif
            }
            GRID_BAR();
#ifndef SK_E1
            e1_phase(F, o);
#endif
            GRID_BAR();
            DBGSCAN(11 + 10 * s, WS_CQN, (size_t)T * 512 * 2 * 2, true); DBGSCAN(11 + 10 * s, WS_KR, (size_t)T * 64 * 2, true);
            for (int q = 0; q < 2; ++q) {
                pg8::Gemm g{(const pg8::bf16_t*)(F.ws + (q ? WS_CKVN : WS_CQN)), (const pg8::bf16_t*)(F.ws + (q ? WS_OUKV + (size_t)o * SZ_OUKV : WS_OUQ + (size_t)o * SZ_OUQ)), T, q ? 4096 : 3072, 512, 512, 512};
                pg8::StaticOrder S; S.init(T, g.N, F.G, (int)blockIdx.x);
                pg8::EpiBf16 E{(pg8::bf16_t*)(F.ws + (q ? WS_KVB : WS_QB)), g.N};
#ifndef SK_G3
                pg8::gemm_phase<pg8::EpiBf16, pg8::StaticOrder>(F.lds, g, S, E);
#endif
            }
            GRID_BAR(); TSTAMP(8);
            DBGSCAN(12 + 10 * s, WS_QB, (size_t)T * 3072 * 2, true); DBGSCAN(12 + 10 * s, WS_KVB, (size_t)T * 4096 * 2, true);
#ifndef SK_ATT
            attn_phase(F);
#ifdef DUP_ATT
            attn_phase(F);
#endif
#endif
            GRID_BAR(); TSTAMP(9);
            DBGSCAN(13 + 10 * s, WS_MIX, (size_t)T * DM * 2, true);
            A2 = (const pg8::bf16_t*)(F.ws + WS_MIX); B2 = (const pg8::bf16_t*)(F.ws + WS_OWO + (size_t)o * SZ_SQ); K2 = DM;
        }
        {
            pg8::Gemm g{A2 + (size_t)NCTX * K2, B2, NLAT, DM, K2, K2, K2};
            pg8::StaticOrder S; S.init(NLAT, DM, F.G, (int)blockIdx.x);
            const int sp = s > 0 ? s - 1 : 0;
            const float* plng = F.a->in[6] + (size_t)sp * DM; const float* plnb = F.a->in[7] + (size_t)sp * DM; const float* stat = (const float*)(F.ws + WS_STAT);
            pg8::EpiResid E{(float*)(F.ws + WS_X) + (size_t)NCTX * DM, modp(F, l, 0, 3 * r + 2), (r != 1) ? 0.5f : 1.0f, stat + (size_t)NCTX * 2, plng, plnb, s > 0 ? 1 : 0};
            ctx_resid_small(F, (float*)(F.ws + WS_X), (const bf16*)A2, (const bf16*)B2, K2, modp(F, l, 1, 3 * r + 2), (r != 1) ? 0.5f : 1.0f, stat, plng, plnb, s > 0 ? 1 : 0, 1);
#ifndef SK_RES
            pg8::gemm_phase<pg8::EpiResid, pg8::StaticOrder, RES_ALIGN, RES_SP2>(F.lds, g, S, E);
#endif
            ctx_resid_small(F, (float*)(F.ws + WS_X), (const bf16*)A2, (const bf16*)B2, K2, modp(F, l, 1, 3 * r + 2), (r != 1) ? 0.5f : 1.0f, stat, plng, plnb, s > 0 ? 1 : 0, 0);
#ifdef DUP_SMALL_OFF
            ctx_resid_small(F, (float*)(F.ws + WS_OI), (const bf16*)A2, (const bf16*)B2, K2, modp(F, l, 1, 3 * r + 2), (r != 1) ? 0.5f : 1.0f);
            ctx_resid_small(F, (float*)(F.ws + WS_OI), (const bf16*)A2, (const bf16*)B2, K2, modp(F, l, 1, 3 * r + 2), (r != 1) ? 0.5f : 1.0f);
#endif
#ifdef DUP_RES
            { pg8::EpiResid E2{(float*)(F.ws + WS_OI) + (size_t)NCTX * DM, modp(F, l, 0, 3 * r + 2), 0.5f, stat, plng, plnb, 0};
              pg8::gemm_phase<pg8::EpiResid, pg8::StaticOrder>(F.lds, g, S, E2); }
#endif
        }
        GRID_BAR(); TSTAMP(r != 1 ? 2 : 10);
        DBGSCAN(14 + 10 * s, WS_X, (size_t)T * DM * 4, false);
        const float* lng = F.a->in[6] + (size_t)(l * 3 + r) * DM; const float* lnb = F.a->in[7] + (size_t)(l * 3 + r) * DM;
        if (s + 1 < 3 * DEPTH) { const int l2 = (s + 1) / 3, r2 = (s + 1) % 3;
            row_phase<1>(F, lng, lnb, modp(F, l2, 0, 3 * r2), modp(F, l2, 0, 3 * r2 + 1), modp(F, l2, 1, 3 * r2), modp(F, l2, 1, 3 * r2 + 1));
            GRID_BAR(); TSTAMP(3);
            DBGSCAN(15 + 10 * s, WS_X, (size_t)T * DM * 4, false); DBGSCAN(15 + 10 * s, WS_H, (size_t)T * DM * 2, true);
#if defined(DBG) && defined(DBG_STOP)
            if (s == DBG_STOP) break;
#endif
        } else {
#ifndef DBG
            row_phase<2>(F, lng, lnb, nullptr, nullptr, nullptr, nullptr);
#endif
        }
    }
#ifdef DBG_TIME
    {   PHASE_IDS(); GRID_BAR();
        const unsigned long long* tw = (const unsigned long long*)(F.ws + WS_CTL) + 64;
        const float tA = (float)__hip_atomic_load(tw + DBG_TA, RLX_AGENT) * 1e-5f, tB = (float)__hip_atomic_load(tw + DBG_TB, RLX_AGENT) * 1e-5f;
        const float cB = DBG_TSCALE * tB, cA = cB; (void)tA;
        float* out = F.a->out;
        for (size_t i = (size_t)F.vcu * NTHR + tid; i < (size_t)NLAT * DM; i += (size_t)F.G * NTHR) out[i] = (i == 12345) ? cA : cB;
    }
#endif
#ifdef DBG
    {
        PHASE_IDS();
        const float* X = (const float*)(F.ws + WS_X); float ssq = 0.f; float cnt = 0.f;
        for (size_t i = (size_t)F.vcu * NTHR + tid; i < (size_t)T * DM; i += (size_t)F.G * NTHR) { const float v = X[i]; if ((__float_as_uint(v) & 0x7f800000u) != 0x7f800000u) { ssq += v * v; cnt += 1.f; } }
        ssq = wave_sum(ssq); cnt = wave_sum(cnt);
        if (lane == 0) { atomicAdd((float*)(F.ws + WS_CTL) + DBG_W_SSQ, ssq); atomicAdd((float*)(F.ws + WS_CTL) + DBG_W_CNT, cnt); }
        GRID_BAR();
        const unsigned badw = __hip_atomic_load((unsigned*)(F.ws + WS_CTL) + DBG_W_BAD, RLX_AGENT);
        const float tss = __hip_atomic_load((float*)(F.ws + WS_CTL) + DBG_W_SSQ, RLX_AGENT), tcn = __hip_atomic_load((float*)(F.ws + WS_CTL) + DBG_W_CNT, RLX_AGENT);
        const float rms = sqrtf(tss / fmaxf(tcn, 1.f)); float cB = fminf(10.f * rms, 1000.f);
#ifdef DBG_REPORT_MAX
        { const unsigned mw = __hip_atomic_load((unsigned*)(F.ws + WS_CTL) + DBG_W_MAX, RLX_AGENT); cB = fminf(log2f(1.0f + __uint_as_float(mw)), 120.f); }
#endif
        const float cA = badw ? (float)(100000u - badw) * 10.f : 5.f;
        float* out = F.a->out;
        for (size_t i = (size_t)F.vcu * NTHR + tid; i < (size_t)NLAT * DM; i += (size_t)F.G * NTHR) out[i] = (i == 12345) ? cA + 0.f : cB;
        (void)cA;
    }
#endif
}

extern "C" void kernel_launch(void* const* d_in, const int* in_sizes, int n_in, void* d_out, int out_size, void* d_ws, size_t ws_size, hipStream_t stream) {
    static int grid = 0;
    if (grid == 0) {
        if (n_in != 23 || out_size != NLAT * DM || ws_size < WS_END) { fprintf(stderr, "kernel_launch: unexpected shapes: n_in %d out %d ws %zu (need %zu)\n", n_in, out_size, ws_size, (size_t)WS_END); grid = -1; return; }
        int dev = 0, cus = 0, per_cu = 0;
        if (hipGetDevice(&dev) != hipSuccess || hipDeviceGetAttribute(&cus, hipDeviceAttributeMultiprocessorCount, dev) != hipSuccess) { grid = -1; return; }
        if (hipFuncSetAttribute((const void*)fwd_kernel, hipFuncAttributeMaxDynamicSharedMemorySize, LDS_BYTES) != hipSuccess) { fprintf(stderr, "kernel_launch: hipFuncSetAttribute failed\n"); grid = -1; return; }
        if (hipOccupancyMaxActiveBlocksPerMultiprocessor(&per_cu, (const void*)fwd_kernel, NTHR, LDS_BYTES) != hipSuccess || per_cu < 1) fprintf(stderr, "kernel_launch: occupancy query reports %d\n", per_cu);
        (void)hipGetLastError();
        grid = cus;
    }
    if (grid < 0) return;
    (void)hipMemsetAsync((char*)d_ws + WS_CTL, 0, CTL_BYTES, stream);
    Args a{};
    for (int i = 0; i < 23; ++i) a.in[i] = (const float*)d_in[i];
    a.out = (float*)d_out; a.ws = (unsigned char*)d_ws;
    hipLaunchKernelGGL(fwd_kernel, dim3(grid), dim3(NTHR), LDS_BYTES, stream, a);
    const hipError_t le = hipPeekAtLastError();
    if (le != hipSuccess) fprintf(stderr, "kernel_launch: launch failed: %s\n", hipGetErrorName(le));
}
```

```cpp
#include <hip/hip_runtime.h>
#include <cstdio>
#include <cstdint>

#define GAS __attribute__((address_space(1)))
#define LAS __attribute__((address_space(3)))
typedef unsigned short bf16;
typedef short bf16x8 __attribute__((ext_vector_type(8)));
typedef short s16x4 __attribute__((ext_vector_type(4)));
typedef float f32x4 __attribute__((ext_vector_type(4)));
typedef float f32x2 __attribute__((ext_vector_type(2)));
typedef float f32x16 __attribute__((ext_vector_type(16)));
typedef unsigned u32x4 __attribute__((ext_vector_type(4)));
typedef unsigned u32x2 __attribute__((ext_vector_type(2)));

constexpr int DM = 2048, NCTX = 256, NLAT = 16384, T = NCTX + NLAT, DEPTH = 4, DFF = 5504;
constexpr int NADA = 9 * DM;
constexpr int EV_N = 6400, OD_N = 1280;
constexpr int NCH = T / 64;
constexpr float DN_ALPHA = 1.6817928305074290f;
constexpr float LN_EPS = 1e-5f, RMS_EPS = 1e-6f;
constexpr int NWAVES = 8, NTHR = 512;
constexpr int LDS_BYTES = 147456;
constexpr int LDS_CTL = LDS_BYTES - 256;

constexpr size_t al256(size_t x) { return (x + 255) / 256 * 256; }
constexpr size_t WS_CTL = 0, CTL_BYTES = 1u << 20;
constexpr size_t WS_MODP = WS_CTL + CTL_BYTES;
constexpr size_t WS_MOD = WS_MODP + al256((size_t)8 * 2 * 4 * NADA * 4);
constexpr size_t WS_RT = WS_MOD + al256((size_t)4 * 2 * NADA * 4);
constexpr size_t WS_AXR = WS_RT + al256((size_t)NLAT * 64 * 8);
constexpr size_t WS_AXC = WS_AXR + al256(256 * 16 * 8);
constexpr size_t WS_STAT = WS_AXC + al256(64 * 16 * 8);
constexpr size_t WS_WFI = WS_STAT + al256((size_t)T * 8);
constexpr size_t SZ_WFI = (size_t)2 * DFF * DM * 2;
constexpr size_t WS_WFO = WS_WFI + 8 * SZ_WFI;
constexpr size_t SZ_WFO = (size_t)DM * DFF * 2;
constexpr size_t WS_EWI = WS_WFO + 8 * SZ_WFO;
constexpr size_t SZ_EWI = (size_t)EV_N * DM * 2;
constexpr size_t WS_EWO = WS_EWI + 2 * SZ_EWI;
constexpr size_t SZ_SQ = (size_t)DM * DM * 2;
constexpr size_t WS_OWI = WS_EWO + 2 * SZ_SQ;
constexpr size_t SZ_OWI = (size_t)OD_N * DM * 2;
constexpr size_t WS_OUQ = WS_OWI + 2 * SZ_OWI;
constexpr size_t SZ_OUQ = (size_t)3072 * 512 * 2;
constexpr size_t WS_OUKV = WS_OUQ + 2 * SZ_OUQ;
constexpr size_t SZ_OUKV = (size_t)4096 * 512 * 2;
constexpr size_t WS_OWO = WS_OUKV + 2 * SZ_OUKV;
constexpr size_t WS_X = WS_OWO + 2 * SZ_SQ;
constexpr size_t WS_H = WS_X + (size_t)T * DM * 4;
constexpr size_t WS_HID = WS_H + (size_t)T * DM * 2;
constexpr size_t WS_MIX = WS_HID + (size_t)T * DFF * 2;
constexpr size_t WS_PROJ = WS_MIX + (size_t)T * DM * 2;
constexpr size_t WS_U = WS_PROJ + (size_t)T * EV_N * 2;
constexpr size_t SZ_U = (size_t)2 * 8 * NCH * 256 * 128 * 2;
constexpr size_t WS_S = WS_U + SZ_U;
constexpr size_t WS_OI = WS_S + SZ_U;
constexpr size_t WS_QT = WS_OI + (size_t)T * DM * 4;
constexpr size_t WS_DEC = WS_QT + (size_t)2 * T * 1024 * 2;
constexpr size_t WS_END_EVEN = WS_DEC + al256((size_t)2 * 8 * NCH * 128 * 4);
constexpr size_t WS_CQN = WS_U;
constexpr size_t WS_CKVN = WS_CQN + (size_t)T * 512 * 2;
constexpr size_t WS_KR = WS_CKVN + (size_t)T * 512 * 2;
constexpr size_t WS_QB = WS_KR + al256((size_t)T * 64 * 2);
constexpr size_t WS_KVB = WS_QB + (size_t)T * 3072 * 2;
constexpr size_t WS_END_ODD = WS_KVB + (size_t)T * 4096 * 2;
constexpr size_t WS_END = WS_END_EVEN > WS_END_ODD ? WS_END_EVEN : WS_END_ODD;

#define RLX_AGENT __ATOMIC_RELAXED, __HIP_MEMORY_SCOPE_AGENT
#define LDS_WAIT() asm volatile("s_waitcnt lgkmcnt(0)" ::: "memory")
#define VM_WAIT() asm volatile("s_waitcnt vmcnt(0)" ::: "memory")
__device__ __forceinline__ unsigned cvt_pk_bf16(float lo, float hi) { unsigned r; asm volatile("v_cvt_pk_bf16_f32 %0, %1, %2" : "=v"(r) : "v"(lo), "v"(hi)); return r; }
__device__ __forceinline__ float bflo(unsigned w) { return __uint_as_float(w << 16); }
__device__ __forceinline__ float bfhi(unsigned w) { return __uint_as_float(w & 0xffff0000u); }
__device__ __forceinline__ float bf2f(bf16 b) { return __uint_as_float(((unsigned)b) << 16); }
__device__ __forceinline__ bf16 f2bf(float f) { return (bf16)(cvt_pk_bf16(f, 0.f) & 0xffffu); }
__device__ __forceinline__ float wave_sum(float v) {
#pragma unroll
    for (int o = 1; o < 64; o <<= 1) v += __shfl_xor(v, o);
    return v;
}
__device__ __forceinline__ float silu_f(float g) { return g * __builtin_amdgcn_rcpf(1.0f + __builtin_amdgcn_exp2f(-1.4426950408889634f * g)); }

namespace pg8 {
#define PG8_LAS __attribute__((address_space(3)))
typedef unsigned short bf16_t;
constexpr int BM = 256, BK = 64, HALF = 128, HTB = HALF * BK * 2, STAGE_BYTES = 8 * HTB, NXCD = 8, WGM = 8;
__host__ __device__ __forceinline__ int lds_byte(int r, int c) { const int st = (r >> 4) * 2 + (c >> 5), rr = r & 15, cc = c & 31, ob = rr * 64 + cc * 2; return st * 1024 + (ob ^ (((ob >> 9) & 1) << 5)); }
__host__ __device__ __forceinline__ void stage_rc(int b, int& R, int& C) { const int st = b / 1024, sb = b % 1024, swz = sb ^ (((sb >> 9) & 1) << 5); R = (st >> 1) * 16 + swz / 64; C = (st & 1) * 32 + (swz % 64) / 2; }
__host__ __device__ __forceinline__ int perm32(int rho) { const int n = rho >> 4, i = rho & 15; return 8 * (i >> 2) + 4 * n + (i & 3); }
struct Unit { int pm, pn; };
struct Gemm { const bf16_t* A; const bf16_t* Bt; int M, N, K, lda, ldb; };
struct StaticOrder {
    int nM, nN, nwg, G, c;
    __host__ __device__ void init(int M, int N, int G_, int c_) { nM = M / BM; nN = N / BM; nwg = nM * nN; G = G_; c = c_; }
    __host__ __device__ bool next(int i, Unit& u) const {
        const long L = (long)i * G + c; if (L >= nwg) return false;
        int wgid = (int)L; { const int q = nwg / NXCD, r = nwg % NXCD, xcd = wgid % NXCD, off = wgid / NXCD; wgid = (xcd < r ? xcd * (q + 1) : r * (q + 1) + (xcd - r) * q) + off; }
        const int nig = WGM * nN, gid = wgid / nig, fm = gid * WGM, gsz = (nM - fm) < WGM ? (nM - fm) : WGM;
        u.pm = fm + ((wgid % nig) % gsz); u.pn = (wgid % nig) / gsz; return true;
    }
    __device__ __forceinline__ void a_ready(const Unit&) const {}
    __device__ __forceinline__ void done(const Unit&) const {}
};
struct EpiBf16 {
    static constexpr bool PERM = true;
    bf16_t* O; int ldc;
    __device__ __forceinline__ void operator()(const f32x4 (&acc)[2][2][4][2], const Unit& u, int wr, int wc, int fr, int fq) const {
        const int row0 = u.pm * BM + wr * 64 + fr, col0 = u.pn * BM + wc * 32 + 8 * fq;
        asm volatile("s_nop 15" ::: "memory");
#pragma unroll
        for (int ai = 0; ai < 2; ++ai)
#pragma unroll
            for (int m = 0; m < 4; ++m) { bf16_t* rowp = O + (size_t)(row0 + ai * HALF + m * 16) * ldc + col0;
#pragma unroll
                for (int bj = 0; bj < 2; ++bj) { const f32x4 v0 = acc[ai][bj][m][0], v1 = acc[ai][bj][m][1];
                    u32x4 w; w.x = cvt_pk_bf16(v0[0], v0[1]); w.y = cvt_pk_bf16(v0[2], v0[3]); w.z = cvt_pk_bf16(v1[0], v1[1]); w.w = cvt_pk_bf16(v1[2], v1[3]);
                    *(u32x4*)(rowp + bj * HALF) = w; } }
    }
};
struct EpiSwiGLU {
    static constexpr bool PERM = true;
    bf16_t* O; int ldc;
    __device__ __forceinline__ void operator()(const f32x4 (&acc)[2][2][4][2], const Unit& u, int wr, int wc, int fr, int fq) const {
        const int row0 = u.pm * BM + wr * 64 + fr, col0 = u.pn * HALF + wc * 32 + 8 * fq;
#pragma unroll
        for (int ai = 0; ai < 2; ++ai)
#pragma unroll
            for (int m = 0; m < 4; ++m) { bf16_t* rowp = O + (size_t)(row0 + ai * HALF + m * 16) * ldc + col0;
                float h[8];
#pragma unroll
                for (int n = 0; n < 2; ++n)
#pragma unroll
                    for (int j = 0; j < 4; ++j) h[n * 4 + j] = silu_f(acc[ai][0][m][n][j]) * acc[ai][1][m][n][j];
                u32x4 w; w.x = cvt_pk_bf16(h[0], h[1]); w.y = cvt_pk_bf16(h[2], h[3]); w.z = cvt_pk_bf16(h[4], h[5]); w.w = cvt_pk_bf16(h[6], h[7]);
                *(u32x4*)rowp = w; asm volatile("" ::: "memory"); }
    }
};
struct EpiResid {
    static constexpr bool PERM = true;
    float* X; const float* gv; float gs; const float* stat; const float* lng; const float* lnb; int has_ln;
    __device__ __forceinline__ void operator()(const f32x4 (&acc)[2][2][4][2], const Unit& u, int wr, int wc, int fr, int fq) const {
        const int row0 = u.pm * BM + wr * 64 + fr, col0 = u.pn * BM + wc * 32 + 8 * fq;
        f32x2 st[2][4];
#pragma unroll
        for (int ai = 0; ai < 2; ++ai)
#pragma unroll
            for (int m = 0; m < 4; ++m) { st[ai][m] = has_ln ? *(const f32x2*)(stat + (size_t)(row0 + ai * HALF + m * 16) * 2) : (f32x2){0.f, 1.f}; st[ai][m].y *= DN_ALPHA; }
#pragma unroll
        for (int bj = 0; bj < 2; ++bj) { const int c = col0 + bj * HALF;
            f32x4 g[2], G[2], B[2];
#pragma unroll
            for (int n = 0; n < 2; ++n) { g[n] = *(const f32x4*)(gv + c + 4 * n) * gs;
                G[n] = has_ln ? *(const f32x4*)(lng + c + 4 * n) : (f32x4){1.f, 1.f, 1.f, 1.f}; B[n] = has_ln ? *(const f32x4*)(lnb + c + 4 * n) * DN_ALPHA : (f32x4){0.f, 0.f, 0.f, 0.f}; }
#pragma unroll
            for (int ai = 0; ai < 2; ++ai)
#pragma unroll
                for (int m = 0; m < 4; ++m) { float* p = X + (size_t)(row0 + ai * HALF + m * 16) * DM + c;
                    const f32x4 z0 = *(const f32x4*)p, z1 = *(const f32x4*)(p + 4);
                    *(f32x4*)p = (z0 - st[ai][m].x) * st[ai][m].y * G[0] + B[0] + g[0] * acc[ai][bj][m][0];
                    *(f32x4*)(p + 4) = (z1 - st[ai][m].x) * st[ai][m].y * G[1] + B[1] + g[1] * acc[ai][bj][m][1]; }
            asm volatile("" ::: "memory"); }
    }
};

template <class Epi, class Sched, bool ALIGN_EPI = true, bool SP2 = true>
__device__ __forceinline__ void gemm_phase(PG8_LAS unsigned char* lds, const Gemm g, const Sched& S, const Epi& E) {
    int tid = threadIdx.x; asm volatile("" : "+v"(tid));
    const int wid = __builtin_amdgcn_readfirstlane(tid >> 6), lane = tid & 63, wr = wid >> 2, wc = wid & 3, fr = lane & 15, fq = lane >> 4;
    const int K = g.K, nt = K / BK;
    unsigned voffA[2], voffB[2];
#pragma unroll
    for (int i = 0; i < 2; ++i) { int R, C; stage_rc(tid * 16 + i * 8192, R, C); const int Rb = Epi::PERM ? ((R & ~31) + perm32(R & 31)) : R;
        voffA[i] = (unsigned)(R * g.lda + C) * 2u; voffB[i] = (unsigned)(Rb * g.ldb + C) * 2u; }
    const size_t kstep = (size_t)(BK * 2);
    const size_t hstepA = (size_t)HALF * g.lda * 2, hstepB = (size_t)HALF * g.ldb * 2;
    const size_t tstepA = 2 * hstepA, tstepB = 2 * hstepB;
    const unsigned ldsw = (unsigned)wid * 1024u;
    const int aoff = lds_byte(wr * 64 + fr, fq * 8), boff = lds_byte(wc * 32 + fr, fq * 8);
#define PG8_SA(b, h) (((b) * 2 + (h)) * HTB)
#define PG8_SB(b, h) ((4 + (b) * 2 + (h)) * HTB)
#define PG8_STAGE(bufoff, gbase, voff) do { _Pragma("unroll") for (int _i = 0; _i < 2; ++_i) \
        __builtin_amdgcn_global_load_lds((const unsigned*)((const char*)(gbase) + (voff)[_i]), (PG8_LAS unsigned*)(lds + (bufoff) + ldsw + _i * 8192), 16, 0, 0); } while (0)
#define PG8_LDA(dst, b, h) do { _Pragma("unroll") for (int m = 0; m < 4; ++m) _Pragma("unroll") for (int k = 0; k < 2; ++k) dst[m][k] = *(const PG8_LAS bf16x8*)(lds + PG8_SA(b, h) + aoff + m * 2048 + k * 1024); } while (0)
#define PG8_LDB(dst, b, h) do { _Pragma("unroll") for (int n = 0; n < 2; ++n) _Pragma("unroll") for (int k = 0; k < 2; ++k) dst[n][k] = *(const PG8_LAS bf16x8*)(lds + PG8_SB(b, h) + boff + n * 2048 + k * 1024); } while (0)
#define PG8_MMA(ai, bj, At, Bt) do { __builtin_amdgcn_s_setprio(1); _Pragma("unroll") for (int m = 0; m < 4; ++m) _Pragma("unroll") for (int n = 0; n < 2; ++n) _Pragma("unroll") for (int k = 0; k < 2; ++k) \
        acc[ai][bj][m][n] = __builtin_amdgcn_mfma_f32_16x16x32_bf16(Bt[n][k], At[m][k], acc[ai][bj][m][n], 0, 0, 0); __builtin_amdgcn_s_setprio(0); } while (0)
#define PG8_WAIT_V(n) asm volatile("s_waitcnt vmcnt(" #n ")" ::: "memory")
#define PG8_WAIT_L(n) asm volatile("s_waitcnt lgkmcnt(" #n ")" ::: "memory")
#define PG8_BAR __builtin_amdgcn_s_barrier()
#define PG8_SCHED __builtin_amdgcn_sched_barrier(0)
    Unit cur, nxt; int ui = 0;
    if (!S.next(0, cur)) return;
    f32x4 acc[2][2][4][2];
#pragma unroll
    for (int a = 0; a < 2; ++a)
#pragma unroll
        for (int b = 0; b < 2; ++b)
#pragma unroll
            for (int m = 0; m < 4; ++m)
#pragma unroll
                for (int n = 0; n < 2; ++n) acc[a][b][m][n] = (f32x4){0.f, 0.f, 0.f, 0.f};
    bf16x8 At[4][2], B0[2][2], B1[2][2];
    const char* cA = (const char*)g.A + (size_t)cur.pm * tstepA; const char* cB = (const char*)g.Bt + (size_t)cur.pn * tstepB;
    S.a_ready(cur);
    if constexpr (SP2) {
        PG8_STAGE(PG8_SB(0, 0), cB, voffB); PG8_STAGE(PG8_SB(0, 1), cB + hstepB, voffB); PG8_STAGE(PG8_SA(0, 0), cA, voffA); PG8_STAGE(PG8_SA(0, 1), cA + hstepA, voffA);
        if (wr == 1) PG8_BAR;
        PG8_WAIT_V(2); PG8_BAR;
        PG8_STAGE(PG8_SB(1, 0), cB + kstep, voffB); PG8_STAGE(PG8_SA(1, 0), cA + kstep, voffA); PG8_STAGE(PG8_SB(1, 1), cB + hstepB + kstep, voffB);
        PG8_WAIT_V(6); PG8_BAR;
    } else {
        PG8_STAGE(PG8_SB(0, 0), cB, voffB); PG8_STAGE(PG8_SA(0, 0), cA, voffA); PG8_STAGE(PG8_SB(0, 1), cB + hstepB, voffB); PG8_STAGE(PG8_SA(0, 1), cA + hstepA, voffA);
        if (wr == 1) PG8_BAR;
        PG8_WAIT_V(4); PG8_BAR;
        PG8_STAGE(PG8_SB(1, 0), cB + kstep, voffB); PG8_STAGE(PG8_SA(1, 0), cA + kstep, voffA); PG8_STAGE(PG8_SB(1, 1), cB + hstepB + kstep, voffB);
        PG8_WAIT_V(6); PG8_BAR;
    }
    for (;;) {
        const bool has_next = S.next(ui + 1, nxt);
        const char* nA = has_next ? (const char*)g.A + (size_t)nxt.pm * tstepA : cA; const char* nB = has_next ? (const char*)g.Bt + (size_t)nxt.pn * tstepB : cB;
        for (int t = 0; t < nt; t += 2) {
            const bool last = (t == nt - 2);
            const char* a1 = cA + (size_t)(t + 1) * kstep;
            const char* a2 = last ? nA : cA + (size_t)(t + 2) * kstep; const char* b2 = last ? nB : cB + (size_t)(t + 2) * kstep;
            const char* a3 = a2 + kstep; const char* b3 = b2 + kstep;
            if (last && has_next) S.a_ready(nxt);
            if constexpr (SP2) {
            PG8_LDB(B0, 0, 0); PG8_LDB(B1, 0, 1); PG8_SCHED; PG8_LDA(At, 0, 0); PG8_STAGE(PG8_SA(1, 1), a1 + hstepA, voffA);
            PG8_WAIT_V(8); PG8_WAIT_L(0); PG8_BAR; PG8_MMA(0, 0, At, B0); PG8_MMA(0, 1, At, B1); PG8_BAR; PG8_SCHED;
            PG8_LDA(At, 0, 1); PG8_STAGE(PG8_SB(0, 0), b2, voffB); PG8_STAGE(PG8_SB(0, 1), b2 + hstepB, voffB); PG8_STAGE(PG8_SA(0, 0), a2, voffA);
            PG8_WAIT_V(8); PG8_WAIT_L(0); PG8_BAR; PG8_MMA(1, 0, At, B0); PG8_MMA(1, 1, At, B1); PG8_BAR; PG8_SCHED;
            PG8_LDB(B0, 1, 0); PG8_LDB(B1, 1, 1); PG8_SCHED; PG8_LDA(At, 1, 0); PG8_STAGE(PG8_SA(0, 1), a2 + hstepA, voffA);
            PG8_WAIT_V(8); PG8_WAIT_L(0); PG8_BAR; PG8_MMA(0, 0, At, B0); PG8_MMA(0, 1, At, B1); PG8_BAR; PG8_SCHED;
            PG8_LDA(At, 1, 1); PG8_STAGE(PG8_SB(1, 0), b3, voffB); PG8_STAGE(PG8_SB(1, 1), b3 + hstepB, voffB); PG8_STAGE(PG8_SA(1, 0), a3, voffA);
            PG8_WAIT_V(8); PG8_WAIT_L(0); PG8_BAR; PG8_MMA(1, 0, At, B0); PG8_MMA(1, 1, At, B1); PG8_BAR; PG8_SCHED;
            } else {
            PG8_LDB(B0, 0, 0); PG8_SCHED; PG8_LDA(At, 0, 0); PG8_STAGE(PG8_SA(1, 1), a1 + hstepA, voffA);
            PG8_WAIT_L(8); PG8_BAR; PG8_WAIT_L(0); PG8_MMA(0, 0, At, B0); PG8_BAR; PG8_SCHED;
            PG8_LDB(B1, 0, 1); PG8_STAGE(PG8_SB(0, 0), b2, voffB);
            PG8_BAR; PG8_WAIT_L(0); PG8_MMA(0, 1, At, B1); PG8_BAR;
            PG8_LDA(At, 0, 1); PG8_STAGE(PG8_SA(0, 0), a2, voffA);
            PG8_BAR; PG8_WAIT_L(0); PG8_MMA(1, 0, At, B0); PG8_BAR; PG8_SCHED;
            PG8_STAGE(PG8_SB(0, 1), b2 + hstepB, voffB);
            PG8_WAIT_V(6); PG8_BAR; PG8_MMA(1, 1, At, B1); PG8_BAR;
            PG8_LDB(B0, 1, 0); PG8_SCHED; PG8_LDA(At, 1, 0); PG8_STAGE(PG8_SA(0, 1), a2 + hstepA, voffA);
            PG8_WAIT_L(8); PG8_BAR; PG8_WAIT_L(0); PG8_MMA(0, 0, At, B0); PG8_BAR; PG8_SCHED;
            PG8_LDB(B1, 1, 1); PG8_STAGE(PG8_SB(1, 0), b3, voffB);
            PG8_BAR; PG8_WAIT_L(0); PG8_MMA(0, 1, At, B1); PG8_BAR;
            PG8_LDA(At, 1, 1); PG8_STAGE(PG8_SA(1, 0), a3, voffA);
            PG8_BAR; PG8_WAIT_L(0); PG8_MMA(1, 0, At, B0); PG8_BAR; PG8_SCHED;
            PG8_STAGE(PG8_SB(1, 1), b3 + hstepB, voffB);
            PG8_WAIT_V(6); PG8_BAR; PG8_MMA(1, 1, At, B1); PG8_BAR;
            }
        }
        if constexpr (ALIGN_EPI) { if (wr == 0) PG8_BAR; }
        E(acc, cur, wr, wc, fr, fq); S.done(cur);
        if (!has_next) break;
#pragma unroll
        for (int a = 0; a < 2; ++a)
#pragma unroll
            for (int b = 0; b < 2; ++b)
#pragma unroll
                for (int m = 0; m < 4; ++m)
#pragma unroll
                    for (int n = 0; n < 2; ++n) acc[a][b][m][n] = (f32x4){0.f, 0.f, 0.f, 0.f};
        cur = nxt; cA = nA; cB = nB; ++ui;
        if constexpr (ALIGN_EPI) { if (wr == 1) PG8_BAR; }
    }
    PG8_WAIT_V(0);
    if constexpr (!ALIGN_EPI) { if (wr == 0) PG8_BAR; }
    PG8_BAR;
#undef PG8_SA
#undef PG8_SB
#undef PG8_STAGE
#undef PG8_LDA
#undef PG8_LDB
#undef PG8_MMA
#undef PG8_WAIT_V
#undef PG8_WAIT_L
#undef PG8_BAR
#undef PG8_SCHED
}
}

#define XB_TMO      128
#define XB_XCNT(j)  (256  + 64 * (j))
#define XB_XSUB(j)  (1280 + 64 * (j))
#define XB_XGEN(j)  (2304 + 64 * (j))
#define XB_TOP      3328
#define XB_TOPGEN   3392
#define XCD_BAR_WORDS 3456
#define XB_SPIN_CAP (1u << 18)
__device__ __forceinline__ unsigned xb_ld(unsigned* p)              { return __hip_atomic_load(p, __ATOMIC_RELAXED, __HIP_MEMORY_SCOPE_AGENT); }
__device__ __forceinline__ unsigned xb_add(unsigned* p, unsigned v) { return __hip_atomic_fetch_add(p, v, __ATOMIC_RELAXED, __HIP_MEMORY_SCOPE_AGENT); }
__device__ __forceinline__ unsigned xb_xcc_id() { return (unsigned)__builtin_amdgcn_s_getreg((3 << 11) | 20) & 0xFu; }
#define XB_SPIN(cond, bar) do { unsigned _sp = 0; while (cond) { __builtin_amdgcn_s_sleep(1); \
    if ((++_sp & 255u) == 0u) { if (xb_ld(&(bar)[XB_TMO])) break; if (_sp > XB_SPIN_CAP) { atomicAdd(&(bar)[XB_TMO], 1u); break; } } } } while (0)
struct XcdBarrier { unsigned* bar; unsigned x; volatile LAS unsigned* st; };
__device__ __forceinline__ XcdBarrier xcd_barrier_post(unsigned* bar, volatile LAS unsigned* st) {
    XcdBarrier b; b.bar = bar; b.x = xb_xcc_id(); b.st = st;
    if (threadIdx.x == 0) (void)xb_add(&bar[XB_XCNT(b.x)], 1u);
    return b;
}
__device__ __forceinline__ void xcd_barrier_complete(unsigned* bar, unsigned x, unsigned& nloc, unsigned& nx) {
    const unsigned G = gridDim.x * gridDim.y * gridDim.z;
    unsigned sum, cnt, mine, sp = 0u;
    for (;;) {
        sum = 0u; cnt = 0u; mine = 0u;
#pragma unroll
        for (unsigned j = 0; j < 16; ++j) { const unsigned c = xb_ld(&bar[XB_XCNT(j)]); sum += c; cnt += (c > 0u) ? 1u : 0u; mine = (j == x) ? c : mine; }
        if (sum == G) break;
        __builtin_amdgcn_s_sleep(1);
        if ((++sp & 255u) == 0u) { if (xb_ld(&bar[XB_TMO])) break; if (sp > XB_SPIN_CAP) { atomicAdd(&bar[XB_TMO], 1u); break; } }
    }
    nloc = mine > 0u ? mine : 1u; nx = cnt > 0u ? cnt : 1u;
}
__device__ __forceinline__ void xcd_barrier(const XcdBarrier& b0) {
    asm volatile("s_waitcnt vmcnt(0)" ::: "memory");
    __syncthreads();
    if (threadIdx.x == 0) {
        XcdBarrier b = b0; b.x = xb_xcc_id();
        unsigned* bar = b.bar;
        __builtin_amdgcn_s_waitcnt(0);
        unsigned nloc = b.st[0], nx = b.st[1];
        if (nloc == 0u) { xcd_barrier_complete(bar, b.x, nloc, nx); b.st[0] = nloc; b.st[1] = nx; }
        const unsigned old = xb_add(&bar[XB_XSUB(b.x)], 1u);
        const unsigned gen = old / nloc;
        if (old + 1u == (gen + 1u) * nloc) {
            __builtin_amdgcn_fence(__ATOMIC_RELEASE, "agent");
            asm volatile("s_waitcnt vmcnt(0)" ::: "memory");
            const unsigned og = xb_add(&bar[XB_TOP], 1u);
            const unsigned tg = og / nx;
            if (og + 1u == (tg + 1u) * nx) xb_add(&bar[XB_TOPGEN], 1u);
            else XB_SPIN(xb_ld(&bar[XB_TOPGEN]) == tg, bar);
            __builtin_amdgcn_fence(__ATOMIC_ACQUIRE, "agent");
            xb_add(&bar[XB_XGEN(b.x)], 1u);
            asm volatile("s_waitcnt vmcnt(0)" ::: "memory");
        } else {
            XB_SPIN(xb_ld(&bar[XB_XGEN(b.x)]) == gen, bar);
            __builtin_amdgcn_fence(__ATOMIC_ACQUIRE, "agent");
            asm volatile("s_waitcnt vmcnt(0)" ::: "memory");
        }
    }
    __syncthreads();
}

struct Args { const float* in[23]; float* out; unsigned char* ws; };
struct Frame {
    LAS unsigned char* lds;
    int vcu, G;
    const Args* a; unsigned char* ws;
};
#define PHASE_IDS() int tid = threadIdx.x; asm volatile("" : "+v"(tid)); const int lane = tid & 63, wave = __builtin_amdgcn_readfirstlane(tid >> 6); (void)lane; (void)wave
#define MFMA16(a, b, c) __builtin_amdgcn_mfma_f32_16x16x32_bf16((a), (b), (c), 0, 0, 0)
#define MFMA32(a, b, c) __builtin_amdgcn_mfma_f32_32x32x16_bf16((a), (b), (c), 0, 0, 0)

constexpr float ATT_QSCALE = 0.07216878364870322f * 1.4426950408889634f;
__device__ __forceinline__ void tr_item(const float* W, int N, int K, bf16* WT, int k0, int n0, int drow0, LAS float* scr, int lane, float sc = 1.0f) {
#pragma unroll 8
    for (int i = 0; i < 32; ++i) { const int kk = 2 * i + (lane >> 5); scr[kk * 33 + (lane & 31)] = W[(size_t)(k0 + kk) * N + n0 + (lane & 31)]; }
    LDS_WAIT(); asm volatile("" ::: "memory");
    const int c = lane & 7;
#pragma unroll
    for (int j = 0; j < 4; ++j) { const int n = (lane >> 3) + 8 * j; const LAS float* s = scr + (8 * c) * 33 + n;
        u32x4 o; o.x = cvt_pk_bf16(s[0 * 33] * sc, s[1 * 33] * sc); o.y = cvt_pk_bf16(s[2 * 33] * sc, s[3 * 33] * sc); o.z = cvt_pk_bf16(s[4 * 33] * sc, s[5 * 33] * sc); o.w = cvt_pk_bf16(s[6 * 33] * sc, s[7 * 33] * sc);
        *(u32x4*)(WT + (size_t)(drow0 + n) * K + k0 + 8 * c) = o; }
    LDS_WAIT(); asm volatile("" ::: "memory");
}
__device__ __forceinline__ void p0a(Frame& F) {
    PHASE_IDS();
    LAS float* scr = (LAS float*)(F.lds + wave * 8704);
    LAS float* sv = (LAS float*)(F.lds + 8 * 8704);
    for (int i = tid; i < 2 * DM; i += NTHR) { const float v = (i < DM) ? F.a->in[1][i] : F.a->in[3][i - DM]; sv[i] = v / (1.0f + __expf(-v)); }
    __syncthreads();
    const int gw = F.vcu * NWAVES + wave, NGW = F.G * NWAVES;
    constexpr int I0 = 8 * 32 * 344, I1 = 8 * 86 * 64, I2 = 2 * 32 * 193, I3 = 2 * 32 * 64, I4 = 2 * 32 * 34, I5 = 2 * 8 * 96, I6 = 2 * 8 * 128, I7 = 2 * 32 * 64;
    constexpr int NTR = I0 + I1 + I2 + I3 + I4 + I5 + I6 + I7, NADAI = 8 * 288;
    for (int it = gw; it < NTR + NADAI; it += NGW) {
        int r = it;
        if (r < I0) { const int mat = r / 11008, q = r % 11008, kb = q / 344, nb = q % 344, n0 = nb * 32;
            const int j = n0 < DFF ? n0 : n0 - DFF, drow = (j / 128) * 256 + (j % 128) + (n0 < DFF ? 0 : 128);
            tr_item(F.a->in[8] + (size_t)mat * DM * 2 * DFF, 2 * DFF, DM, (bf16*)(F.ws + WS_WFI + mat * SZ_WFI), kb * 64, n0, drow - 0, scr, lane); continue; } r -= I0;
        if (r < I1) { const int mat = r / 5504, q = r % 5504, kb = q / 64, nb = q % 64;
            tr_item(F.a->in[9] + (size_t)mat * DFF * DM, DM, DFF, (bf16*)(F.ws + WS_WFO + mat * SZ_WFO), kb * 64, nb * 32, nb * 32, scr, lane); continue; } r -= I1;
        if (r < I2) { const int mat = r / 6176, q = r % 6176, kb = q / 193, nb = q % 193, n0 = nb * 32;
            const int drow = n0 < 3072 ? n0 : (n0 < 3104 ? 6144 : n0 - 32);
            tr_item(F.a->in[10] + (size_t)mat * DM * 6176, 6176, DM, (bf16*)(F.ws + WS_EWI + mat * SZ_EWI), kb * 64, n0, drow, scr, lane); continue; } r -= I2;
        if (r < I3) { const int mat = r / 2048, q = r % 2048, kb = q / 64, nb = q % 64;
            tr_item(F.a->in[16] + (size_t)mat * DM * DM, DM, DM, (bf16*)(F.ws + WS_EWO + mat * SZ_SQ), kb * 64, nb * 32, nb * 32, scr, lane); continue; } r -= I3;
        if (r < I4) { const int mat = r / 1088, q = r % 1088, kb = q / 34, nb = q % 34;
            tr_item(F.a->in[17] + (size_t)mat * DM * 1088, 1088, DM, (bf16*)(F.ws + WS_OWI + mat * SZ_OWI), kb * 64, nb * 32, nb * 32, scr, lane); continue; } r -= I4;
        if (r < I5) { const int mat = r / 768, q = r % 768, kb = q / 96, nb = q % 96;
            tr_item(F.a->in[20] + (size_t)mat * 512 * 3072, 3072, 512, (bf16*)(F.ws + WS_OUQ + mat * SZ_OUQ), kb * 64, nb * 32, nb * 32, scr, lane, ATT_QSCALE); continue; } r -= I5;
        if (r < I6) { const int mat = r / 1024, q = r % 1024, kb = q / 128, nb = q % 128;
            tr_item(F.a->in[21] + (size_t)mat * 512 * 4096, 4096, 512, (bf16*)(F.ws + WS_OUKV + mat * SZ_OUKV), kb * 64, nb * 32, nb * 32, scr, lane); continue; } r -= I6;
        if (r < I7) { const int mat = r / 2048, q = r % 2048, kb = q / 64, nb = q % 64;
            tr_item(F.a->in[22] + (size_t)mat * DM * DM, DM, DM, (bf16*)(F.ws + WS_OWO + mat * SZ_SQ), kb * 64, nb * 32, nb * 32, scr, lane); continue; } r -= I7;
        {
            const int ks = r / 288, cg = r % 288, l = cg / 72, n = (cg % 72) * 256 + lane * 4;
            const float* w = F.a->in[4] + ((size_t)l * DM + ks * 256) * NADA + n;
            f32x4 al = {0.f, 0.f, 0.f, 0.f}, ac = {0.f, 0.f, 0.f, 0.f};
#pragma unroll 8
            for (int k = 0; k < 256; ++k) { const f32x4 wv = *(const f32x4*)(w + (size_t)k * NADA); al += wv * sv[ks * 256 + k]; ac += wv * sv[DM + ks * 256 + k]; }
            float* mp = (float*)(F.ws + WS_MODP);
            *(f32x4*)(mp + (size_t)(ks * 2 + 0) * 4 * NADA + l * NADA + n) = al;
            *(f32x4*)(mp + (size_t)(ks * 2 + 1) * 4 * NADA + l * NADA + n) = ac;
        }
    }
    const int gt = F.vcu * NTHR + tid, NGT = F.G * NTHR;
    for (int i = gt; i < NLAT * 64 + 256 * 16 + 64 * 16; i += NGT) {
        int pos, fi; float inv; f32x2* dst;
        if (i < NLAT * 64) { pos = i >> 6; fi = i & 63; inv = __builtin_amdgcn_exp2f(-(float)fi * (13.287712379549449f / 64.0f)); dst = (f32x2*)(F.ws + WS_RT) + i; }
        else if (i < NLAT * 64 + 4096) { const int j = i - NLAT * 64; pos = j >> 4; fi = j & 15; inv = __builtin_amdgcn_exp2f(-(float)fi * (13.287712379549449f / 16.0f)); dst = (f32x2*)(F.ws + WS_AXR) + j; }
        else { const int j = i - NLAT * 64 - 4096; pos = j >> 4; fi = j & 15; inv = __builtin_amdgcn_exp2f(-(float)fi * (13.287712379549449f / 16.0f)); dst = (f32x2*)(F.ws + WS_AXC) + j; }
        const float ang = (float)pos * inv;
        double rev = (double)ang * 0.15915494309189535; rev -= __builtin_floor(rev);
        const float rv = (float)rev;
        *dst = (f32x2){__builtin_amdgcn_cosf(rv), __builtin_amdgcn_sinf(rv)};
    }
}
__device__ __forceinline__ void p0b(Frame& F) {
    PHASE_IDS();
    const int gt = F.vcu * NTHR + tid, NGT = F.G * NTHR;
    const float* mp = (const float*)(F.ws + WS_MODP); float* mo = (float*)(F.ws + WS_MOD);
    for (int i = gt; i < 4 * 2 * NADA; i += NGT) { const int l = i / (2 * NADA), v = (i / NADA) & 1, n = i % NADA;
        float s = F.a->in[5][l * NADA + n];
#pragma unroll
        for (int ks = 0; ks < 8; ++ks) s += mp[(size_t)(ks * 2 + v) * 4 * NADA + l * NADA + n];
        mo[i] = s; }
}
__device__ __forceinline__ const float* modp(Frame& F, int l, int v, int idx) { return (const float*)(F.ws + WS_MOD) + ((size_t)(l * 2 + v) * 9 + idx) * DM; }

template <int MODE>
__device__ __forceinline__ void row_phase(Frame& F, const float* lng, const float* lnb, const float* sh_l, const float* sc_l, const float* sh_c, const float* sc_c) {
    PHASE_IDS();
    LAS float* V = (LAS float*)F.lds;
    for (int i = tid; i < DM; i += NTHR) { if (MODE != 0) { V[i] = lng[i]; V[DM + i] = lnb[i]; } if (MODE != 2) { V[2 * DM + i] = sh_l[i]; V[3 * DM + i] = sc_l[i]; V[4 * DM + i] = sh_c[i]; V[5 * DM + i] = sc_c[i]; } }
    __syncthreads();
    const int gw = F.vcu * NWAVES + wave, NGW = F.G * NWAVES;
    float* X = (float*)(F.ws + WS_X); bf16* H = (bf16*)(F.ws + WS_H);
    for (int t = gw; t < T; t += NGW) {
        if (MODE == 2 && t < NCTX) continue;
        const float* src = (MODE == 0) ? (t < NCTX ? F.a->in[2] + (size_t)t * DM : F.a->in[0] + (size_t)(t - NCTX) * DM) : X + (size_t)t * DM;
        f32x4 v[8]; float s = 0.f; float mean_ = 0.f, rstd_ = 1.f;
#pragma unroll
        for (int j = 0; j < 8; ++j) { v[j] = *((const f32x4*)src + lane + 64 * j); s += (v[j].x + v[j].y) + (v[j].z + v[j].w); }
        if (MODE != 0) {
            const float mean = wave_sum(s) * (1.f / DM); float s2 = 0.f;
#pragma unroll
            for (int j = 0; j < 8; ++j) { v[j] = v[j] - mean; s2 += (v[j].x * v[j].x + v[j].y * v[j].y) + (v[j].z * v[j].z + v[j].w * v[j].w); }
            const float rstd = 1.f / sqrtf(wave_sum(s2) * (1.f / DM) + LN_EPS); mean_ = mean; rstd_ = rstd;
#pragma unroll
            for (int j = 0; j < 8; ++j) { const f32x4 g = *((const LAS f32x4*)V + lane + 64 * j), b = *((const LAS f32x4*)(V + DM) + lane + 64 * j); v[j] = v[j] * rstd * g + b; }
        }
        if (MODE == 1 && lane == 0) *(f32x2*)((float*)(F.ws + WS_STAT) + (size_t)t * 2) = (f32x2){mean_, rstd_};
        if (MODE == 2) {
            float* o = F.a->out + (size_t)(t - NCTX) * DM;
#pragma unroll
            for (int j = 0; j < 8; ++j) *((f32x4*)o + lane + 64 * j) = v[j];
        } else {
            float* o = X + (size_t)t * DM; bf16* h = H + (size_t)t * DM;
            const LAS float* shv = V + (t < NCTX ? 4 * DM : 2 * DM); const LAS float* scv = V + (t < NCTX ? 5 * DM : 3 * DM);
#pragma unroll
            for (int j = 0; j < 8; ++j) {
                const f32x4 sh = *((const LAS f32x4*)shv + lane + 64 * j), sc = *((const LAS f32x4*)scv + lane + 64 * j);
                const f32x4 m = v[j] * (sc + 1.0f) + sh; u32x2 w; w.x = cvt_pk_bf16(m.x, m.y); w.y = cvt_pk_bf16(m.z, m.w);
                *((u32x2*)h + lane + 64 * j) = w; }
        }
    }
    __syncthreads();
}


__device__ __forceinline__ void ctx_resid_small(Frame& F, float* X, const bf16* A, const bf16* Bt, int K, const float* gv, float gs, const float* stat, const float* lng, const float* lnb, int has_ln, int parity) {
    if ((int)(blockIdx.x & 1) != parity) return;
    PHASE_IDS(); const int fr = lane & 15, fq = lane >> 4;
    const int nks = K >> 5, last = wave + 8 * ((nks - 1 - wave) >> 3), trips = (((nks + 7) >> 3) + 3) & ~3;
    for (int item = blockIdx.x; item < 256; item += F.G) {
        const int mt = item >> 5, nt = item & 31;
        f32x4 acc[2][4];
#pragma unroll
        for (int i = 0; i < 2; ++i)
#pragma unroll
            for (int j = 0; j < 4; ++j) acc[i][j] = (f32x4){0.f, 0.f, 0.f, 0.f};
        const bf16* Ap = A + (size_t)(32 * mt + fr) * K + 8 * fq;
        const bf16* Bp = Bt + (size_t)(64 * nt + fr) * K + 8 * fq;
        bf16x8 a0[2], b0[4], a1[2], b1[4], a2[2], b2[4], a3[2], b3[4];
#define CS_LOAD(a, b, i_) do { const int so_ = 32 * min(wave + 8 * (i_), last); _Pragma("unroll") for (int i = 0; i < 2; ++i) a[i] = *(const bf16x8*)(Ap + (size_t)(16 * i) * K + so_); \
        _Pragma("unroll") for (int i = 0; i < 4; ++i) b[i] = *(const bf16x8*)(Bp + (size_t)(16 * i) * K + so_); } while (0)
#define CS_MMA(a, b, i_) do { __builtin_amdgcn_sched_barrier(0); if (wave + 8 * (i_) < nks) { _Pragma("unroll") for (int i = 0; i < 2; ++i) _Pragma("unroll") for (int j = 0; j < 4; ++j) acc[i][j] = MFMA16(a[i], b[j], acc[i][j]); } __builtin_amdgcn_sched_barrier(0); } while (0)
        CS_LOAD(a0, b0, 0); CS_LOAD(a1, b1, 1); CS_LOAD(a2, b2, 2);
        for (int it = 0; it < trips; it += 4) {
            CS_LOAD(a3, b3, it + 3); CS_MMA(a0, b0, it);
            CS_LOAD(a0, b0, it + 4); CS_MMA(a1, b1, it + 1);
            CS_LOAD(a1, b1, it + 5); CS_MMA(a2, b2, it + 2);
            CS_LOAD(a2, b2, it + 6); CS_MMA(a3, b3, it + 3);
        }
#undef CS_LOAD
#undef CS_MMA
        LAS float* P = (LAS float*)F.lds + wave * 2048;
#pragma unroll
        for (int i = 0; i < 2; ++i)
#pragma unroll
            for (int j = 0; j < 4; ++j)
#pragma unroll
                for (int r = 0; r < 4; ++r) P[(16 * i + 4 * fq + r) * 64 + 16 * j + fr] = acc[i][j][r];
        __syncthreads();
        const int row = tid >> 4, c0 = (tid & 15) * 4;
        f32x4 s0 = {0.f, 0.f, 0.f, 0.f};
#pragma unroll
        for (int w = 0; w < 8; ++w) s0 += *(const LAS f32x4*)((LAS float*)F.lds + w * 2048 + row * 64 + c0);
        float* xp = X + (size_t)(32 * mt + row) * DM + 64 * nt + c0;
        const f32x4 g0 = *(const f32x4*)(gv + 64 * nt + c0) * gs;
        f32x4 x0 = *(const f32x4*)xp;
        if (has_ln) { const f32x2 st = *(const f32x2*)(stat + (size_t)(32 * mt + row) * 2); x0 = (x0 - st.x) * st.y * *(const f32x4*)(lng + 64 * nt + c0) + *(const f32x4*)(lnb + 64 * nt + c0); }
        *(f32x4*)xp = x0 * DN_ALPHA + g0 * s0;
        __syncthreads();
    }
}


__device__ __forceinline__ void init_x_by_owners(Frame& F) {
    PHASE_IDS();
    float* X = (float*)(F.ws + WS_X);
    pg8::StaticOrder S; S.init(NLAT, DM, F.G, (int)blockIdx.x); pg8::Unit u;
    for (int i = 0; S.next(i, u); ++i) {
        const int c4 = (tid & 63) * 4, r0 = tid >> 6;
#pragma unroll 4
        for (int rr = r0; rr < 256; rr += 8) { const size_t lr = (size_t)u.pm * 256 + rr; *(f32x4*)(X + (lr + NCTX) * DM + u.pn * 256 + c4) = *(const f32x4*)(F.a->in[0] + lr * DM + u.pn * 256 + c4); }
    }
    for (int item = blockIdx.x; item < 256; item += F.G) { const int mt = item >> 5, nt = item & 31, row = tid >> 4, c0 = (tid & 15) * 4;
        const size_t o = (size_t)(32 * mt + row) * DM + 64 * nt + c0; *(f32x4*)(X + o) = *(const f32x4*)(F.a->in[2] + o); }
}

constexpr int L1_QRAW = 0, L1_KRAW = 16384, L1_GD = 32768, L1_PART = 36864, L1_QT = 40960, L1_KT = 58368, L1_KTT = 75776, L1_VT = 94208, L1_P = 131072;
constexpr float INV_SQRT_DK = 0.08838834764831845f;

template <int DIR>
__device__ __forceinline__ void s1_dir(Frame& F, int e, int hh, int c, bool lat, f32x4 (&pacc)[2], const float (&wv)[16], const float bgv, const f32x2 (&csv)[16]) {
    const bool is_gla = hh < 4; const int hd = hh & 3, t0 = c * 64;
    PHASE_IDS(); const int w = wave, fr = lane & 15, fq = lane >> 4;
    LAS unsigned char* lds = F.lds;
    const int ch = tid & 127, tq = tid >> 7;
    float lgv[16];
    if (is_gla) {
#pragma unroll
        for (int i = 0; i < 16; ++i) { const int tt = 16 * tq + (DIR ? 15 - i : i);
            const u32x4 g0 = *(const LAS u32x4*)(lds + L1_GD + tt * 64 + DIR * 32), g1 = *(const LAS u32x4*)(lds + L1_GD + tt * 64 + DIR * 32 + 16);
            float x = bgv;
            x += bflo(g0.x) * wv[0] + bfhi(g0.x) * wv[1] + bflo(g0.y) * wv[2] + bfhi(g0.y) * wv[3] + bflo(g0.z) * wv[4] + bfhi(g0.z) * wv[5] + bflo(g0.w) * wv[6] + bfhi(g0.w) * wv[7];
            x += bflo(g1.x) * wv[8] + bfhi(g1.x) * wv[9] + bflo(g1.y) * wv[10] + bfhi(g1.y) * wv[11] + bflo(g1.z) * wv[12] + bfhi(g1.z) * wv[13] + bflo(g1.w) * wv[14] + bfhi(g1.w) * wv[15];
            lgv[i] = (fminf(x, 0.f) - __logf(1.0f + __expf(-fabsf(x)))) * (1.0f / 16.0f); }
    } else {
        const float lg = log1pf(-exp2f((DIR ? -5.5f : -5.0f) - (float)hd));
#pragma unroll
        for (int i = 0; i < 16; ++i) lgv[i] = lg;
    }
    float ls = 0.f;
#pragma unroll
    for (int i = 0; i < 16; ++i) ls += lgv[i];
    LAS float* part = (LAS float*)(lds + L1_PART);
    part[tq * 128 + ch] = ls;
    __syncthreads();
    float b = 0.f;
#pragma unroll
    for (int q = 0; q < 4; ++q) { const float pv = part[q * 128 + ch]; if (DIR ? (q > tq) : (q < tq)) b += pv; }
    bf16* QTg = (bf16*)(F.ws + WS_QT) + (size_t)DIR * T * 1024;
    float kt[16];
#pragma unroll
    for (int i = 0; i < 16; ++i) { const int tt = 16 * tq + (DIR ? 15 - i : i);
        b += lgv[i];
        float qv = bf2f(*(const LAS bf16*)(lds + L1_QRAW + tt * 256 + ch * 2)), kv = bf2f(*(const LAS bf16*)(lds + L1_KRAW + tt * 256 + ch * 2));
        if (!is_gla && lat) {
            const float qp = bf2f(*(const LAS bf16*)(lds + L1_QRAW + tt * 256 + (ch ^ 64) * 2)), kp = bf2f(*(const LAS bf16*)(lds + L1_KRAW + tt * 256 + (ch ^ 64) * 2));
            const f32x2 cs = csv[DIR ? 15 - i : i];
            if (ch < 64) { qv = qv * cs.x - qp * cs.y; kv = kv * cs.x - kp * cs.y; } else { qv = qv * cs.x + qp * cs.y; kv = kv * cs.x + kp * cs.y; }
        }
        const float eb = __expf(b), ebi = __expf(-b);
        const float qs = qv * eb * (is_gla ? INV_SQRT_DK : 1.0f), ks = kv * ebi * (is_gla ? 1.0f : INV_SQRT_DK);
        const bf16 qb = f2bf(qs);
        *(LAS bf16*)(lds + L1_QT + tt * 272 + ch * 2) = qb;
        *(LAS bf16*)(lds + L1_KT + tt * 272 + ch * 2) = f2bf(ks);
        kt[DIR ? 15 - i : i] = ks;
        if (i == 15 && tq == (DIR ? 0 : 3)) ((float*)(F.ws + WS_DEC))[((size_t)(DIR * 8 + hh) * NCH + c) * 128 + ch] = eb;
    }
    { u32x4 w0, w1; w0.x = cvt_pk_bf16(kt[0], kt[1]); w0.y = cvt_pk_bf16(kt[2], kt[3]); w0.z = cvt_pk_bf16(kt[4], kt[5]); w0.w = cvt_pk_bf16(kt[6], kt[7]);
      w1.x = cvt_pk_bf16(kt[8], kt[9]); w1.y = cvt_pk_bf16(kt[10], kt[11]); w1.z = cvt_pk_bf16(kt[12], kt[13]); w1.w = cvt_pk_bf16(kt[14], kt[15]);
      *(LAS u32x4*)(lds + L1_KTT + ch * 144 + tq * 32) = w0; *(LAS u32x4*)(lds + L1_KTT + ch * 144 + tq * 32 + 16) = w1; }
    __syncthreads();
#pragma unroll
    for (int i = 0; i < 2; ++i) { const int id = tid + 512 * i, r = id >> 4, cc = id & 15;
        *(u32x4*)(QTg + (size_t)(t0 + r) * 1024 + hh * 128 + cc * 8) = *(const LAS u32x4*)(lds + L1_QT + r * 272 + cc * 16); }
    { const int mi = w >> 1, nj0 = 2 * (w & 1);
      f32x4 pd[2] = {{0.f, 0.f, 0.f, 0.f}, {0.f, 0.f, 0.f, 0.f}};
#pragma unroll
      for (int ks = 0; ks < 4; ++ks) { const bf16x8 a = *(const LAS bf16x8*)(lds + L1_QT + (16 * mi + fr) * 272 + (32 * ks + 8 * fq) * 2);
#pragma unroll
          for (int j = 0; j < 2; ++j) { const bf16x8 bb = *(const LAS bf16x8*)(lds + L1_KT + (16 * (nj0 + j) + fr) * 272 + (32 * ks + 8 * fq) * 2); pd[j] = MFMA16(a, bb, pd[j]); } }
#pragma unroll
      for (int j = 0; j < 2; ++j)
#pragma unroll
          for (int r = 0; r < 4; ++r) { const int ii = 16 * mi + 4 * fq + r, jj = 16 * (nj0 + j) + fr; if (DIR ? (jj >= ii) : (jj <= ii)) pacc[j][r] += pd[j][r]; } }
    { bf16* Ug = (bf16*)(F.ws + WS_U) + ((size_t)(DIR * 8 + hh) * NCH + c) * 256 * 128;
      bf16x8 bv[2][2];
#pragma unroll
      for (int nj = 0; nj < 2; ++nj)
#pragma unroll
          for (int ks = 0; ks < 2; ++ks) bv[nj][ks] = *(const LAS bf16x8*)(lds + L1_VT + (32 * w + 16 * nj + fr) * 144 + (32 * ks + 8 * fq) * 2);
#pragma unroll
      for (int P = 0; P < 4; ++P) {
          f32x4 u[2][2] = {{{0.f, 0.f, 0.f, 0.f}, {0.f, 0.f, 0.f, 0.f}}, {{0.f, 0.f, 0.f, 0.f}, {0.f, 0.f, 0.f, 0.f}}};
#pragma unroll
          for (int t = 0; t < 2; ++t)
#pragma unroll
              for (int ks = 0; ks < 2; ++ks) { const bf16x8 a = *(const LAS bf16x8*)(lds + L1_KTT + (32 * P + 8 * (fr >> 2) + 4 * t + (fr & 3)) * 144 + (32 * ks + 8 * fq) * 2);
#pragma unroll
                  for (int nj = 0; nj < 2; ++nj) u[t][nj] = MFMA16(a, bv[nj][ks], u[t][nj]); }
          asm volatile("s_nop 15" : "+v"(u[0][0]), "+v"(u[0][1]), "+v"(u[1][0]), "+v"(u[1][1]));
#pragma unroll
          for (int nj = 0; nj < 2; ++nj) { u32x4 o; o.x = cvt_pk_bf16(u[0][nj][0], u[0][nj][1]); o.y = cvt_pk_bf16(u[0][nj][2], u[0][nj][3]); o.z = cvt_pk_bf16(u[1][nj][0], u[1][nj][1]); o.w = cvt_pk_bf16(u[1][nj][2], u[1][nj][3]);
              *(u32x4*)(Ug + (size_t)(32 * w + 16 * nj + fr) * 128 + 32 * P + 8 * fq) = o; } } }
    __syncthreads();
}

__device__ __forceinline__ void s1_phase(Frame& F, int e) {
    PHASE_IDS(); LAS unsigned char* lds = F.lds; const int w = wave, fr = lane & 15, fq = lane >> 4;
    const bf16* P = (const bf16*)(F.ws + WS_PROJ);
    for (int item = blockIdx.x; item < 8 * NCH; item += F.G) {
        const int c = item >> 3, hh = item & 7, hd = hh & 3, t0 = c * 64; const bool is_gla = hh < 4, lat = c >= 4;
        const int qcol = is_gla ? 128 * hd : 3072 + 128 * hd, kcol = qcol + 512, vcol = is_gla ? 1024 + 256 * hd : 4096 + 256 * hd;
#pragma unroll
        for (int i = 0; i < 2; ++i) { const int id = tid + 512 * i, r = id >> 4, cc = id & 15;
            *(LAS u32x4*)(lds + L1_QRAW + r * 256 + cc * 16) = *(const u32x4*)(P + (size_t)(t0 + r) * EV_N + qcol + cc * 8);
            *(LAS u32x4*)(lds + L1_KRAW + r * 256 + cc * 16) = *(const u32x4*)(P + (size_t)(t0 + r) * EV_N + kcol + cc * 8); }
#pragma unroll
        for (int i = 0; i < 4; ++i) { const int id = tid + 512 * i, r = id & 63, cc = id >> 6;
            const u32x4 v = *(const u32x4*)(P + (size_t)(t0 + r) * EV_N + vcol + cc * 8);
            LAS bf16* vt = (LAS bf16*)(lds + L1_VT) + (cc * 8) * 72 + r;
            vt[0 * 72] = (bf16)(v.x & 0xffff); vt[1 * 72] = (bf16)(v.x >> 16); vt[2 * 72] = (bf16)(v.y & 0xffff); vt[3 * 72] = (bf16)(v.y >> 16);
            vt[4 * 72] = (bf16)(v.z & 0xffff); vt[5 * 72] = (bf16)(v.z >> 16); vt[6 * 72] = (bf16)(v.w & 0xffff); vt[7 * 72] = (bf16)(v.w >> 16); }
        if (is_gla && tid < 256) { const int r = tid >> 2, cc = tid & 3; *(LAS u32x4*)(lds + L1_GD + r * 64 + cc * 16) = *(const u32x4*)(P + (size_t)(t0 + r) * EV_N + 6144 + cc * 8); }
        float wvf[16], wvb[16], bgf = 0.f, bgb = 0.f; f32x2 csv[16];
        { const int ch = tid & 127, tq = tid >> 7;
#pragma unroll
          for (int r = 0; r < 16; ++r) { wvf[r] = 0.f; wvb[r] = 0.f; csv[r] = (f32x2){1.f, 0.f}; }
          if (is_gla) {
              const float* wgf = F.a->in[11] + (size_t)e * 16 * 512 + hd * 128 + ch; const float* wgb = F.a->in[13] + (size_t)e * 16 * 512 + hd * 128 + ch;
#pragma unroll
              for (int r = 0; r < 16; ++r) { wvf[r] = wgf[r * 512]; wvb[r] = wgb[r * 512]; }
              bgf = F.a->in[12][e * 512 + hd * 128 + ch]; bgb = F.a->in[14][e * 512 + hd * 128 + ch];
          } else if (lat) {
              const f32x2* RT = (const f32x2*)(F.ws + WS_RT) + (size_t)(t0 + 16 * tq - NCTX) * 64 + (ch & 63);
#pragma unroll
              for (int r = 0; r < 16; ++r) csv[r] = RT[r * 64];
          } }
        __syncthreads();
        f32x4 pacc[2] = {{0.f, 0.f, 0.f, 0.f}, {0.f, 0.f, 0.f, 0.f}};
        s1_dir<0>(F, e, hh, c, lat, pacc, wvf, bgf, csv);
        s1_dir<1>(F, e, hh, c, lat, pacc, wvb, bgb, csv);
        { const int mi = w >> 1, nj0 = 2 * (w & 1);
#pragma unroll
          for (int j = 0; j < 2; ++j)
#pragma unroll
              for (int r = 0; r < 4; ++r) *(LAS bf16*)(lds + L1_P + (16 * mi + 4 * fq + r) * 144 + (16 * (nj0 + j) + fr) * 2) = f2bf(pacc[j][r]); }
        __syncthreads();
        { float* OI = (float*)(F.ws + WS_OI);
          bf16x8 bv[2][2];
#pragma unroll
          for (int nj = 0; nj < 2; ++nj)
#pragma unroll
              for (int ks = 0; ks < 2; ++ks) bv[nj][ks] = *(const LAS bf16x8*)(lds + L1_VT + (32 * w + 16 * nj + fr) * 144 + (32 * ks + 8 * fq) * 2);
#pragma unroll
          for (int mi = 0; mi < 4; ++mi) {
              f32x4 o[2] = {{0.f, 0.f, 0.f, 0.f}, {0.f, 0.f, 0.f, 0.f}};
#pragma unroll
              for (int ks = 0; ks < 2; ++ks) { const bf16x8 a = *(const LAS bf16x8*)(lds + L1_P + (16 * mi + fr) * 144 + (32 * ks + 8 * fq) * 2);
#pragma unroll
                  for (int nj = 0; nj < 2; ++nj) o[nj] = MFMA16(a, bv[nj][ks], o[nj]); }
#pragma unroll
              for (int nj = 0; nj < 2; ++nj)
#pragma unroll
                  for (int r = 0; r < 4; ++r) ((LAS float*)lds)[(16 * mi + 4 * fq + r) * 260 + 32 * w + 16 * nj + fr] = o[nj][r]; }
          __syncthreads();
#pragma unroll
          for (int i = 0; i < 8; ++i) { const int id = tid + 512 * i, r = id >> 6, cc = id & 63;
              *(f32x4*)(OI + (size_t)(t0 + r) * DM + hh * 256 + cc * 4) = *(const LAS f32x4*)((LAS float*)lds + r * 260 + cc * 4); } }
        __syncthreads();
    }
}

__device__ __forceinline__ void s2_phase(Frame& F) {
    PHASE_IDS();
    constexpr int SB = 13, NB = NCH / SB; static_assert(NB * SB == NCH, "NCH % 13");
    const int gt = F.vcu * NTHR + tid, NGT = F.G * NTHR;
    for (int idx = gt; idx < 2 * 8 * 256 * 32; idx += NGT) {
        const int dk4 = idx & 31, ee = (idx >> 5) & 255, dh = idx >> 13, dir = dh >> 3;
        const bf16* U = (const bf16*)(F.ws + WS_U) + (size_t)dh * NCH * 256 * 128 + (size_t)ee * 128 + dk4 * 4;
        bf16* S = (bf16*)(F.ws + WS_S) + (size_t)dh * NCH * 256 * 128 + (size_t)ee * 128 + dk4 * 4;
        const float* D = (const float*)(F.ws + WS_DEC) + (size_t)dh * NCH * 128 + dk4 * 4;
        f32x4 s = {0.f, 0.f, 0.f, 0.f};
        u32x2 un[SB]; f32x4 dn[SB];
#define S2_CH(step) (dir ? ((step) < 4 ? 3 - (step) : NCH + 3 - (step)) : (step))
#pragma unroll
        for (int i = 0; i < SB; ++i) { const int c = S2_CH(i); un[i] = *(const u32x2*)(U + (size_t)c * 256 * 128); dn[i] = *(const f32x4*)(D + (size_t)c * 128); }
#pragma nounroll
        for (int b = 0; b < NB; ++b) {
            u32x2 uc[SB]; f32x4 dc[SB];
#pragma unroll
            for (int i = 0; i < SB; ++i) { uc[i] = un[i]; dc[i] = dn[i]; }
            if (b + 1 < NB) {
#pragma unroll
                for (int i = 0; i < SB; ++i) { const int c = S2_CH((b + 1) * SB + i); un[i] = *(const u32x2*)(U + (size_t)c * 256 * 128); dn[i] = *(const f32x4*)(D + (size_t)c * 128); } }
#pragma unroll
            for (int i = 0; i < SB; ++i) { const int c = S2_CH(b * SB + i);
                u32x2 so; so.x = cvt_pk_bf16(s.x, s.y); so.y = cvt_pk_bf16(s.z, s.w);
                *(u32x2*)(S + (size_t)c * 256 * 128) = so;
                s.x = dc[i].x * (s.x + bflo(uc[i].x)); s.y = dc[i].y * (s.y + bfhi(uc[i].x)); s.z = dc[i].z * (s.z + bflo(uc[i].y)); s.w = dc[i].w * (s.w + bfhi(uc[i].y)); }
        }
#undef S2_CH
    }
}

constexpr int L3_QF = 0, L3_QB = 17408, L3_OL = 34816;
__device__ __forceinline__ void s3_phase(Frame& F, int e) {
    PHASE_IDS(); LAS unsigned char* lds = F.lds; const int w = wave, fr = lane & 15, fq = lane >> 4;
    const bf16* P = (const bf16*)(F.ws + WS_PROJ); const bf16* QTg = (const bf16*)(F.ws + WS_QT); const float* OI = (const float*)(F.ws + WS_OI);
    bf16* MIX = (bf16*)(F.ws + WS_MIX);
    for (int item = blockIdx.x; item < 8 * NCH; item += F.G) {
        const int c = item >> 3, hh = item & 7, hd = hh & 3, t0 = c * 64; const bool is_gla = hh < 4;
        const int gcol = is_gla ? 2048 + 256 * hd : 5120 + 256 * hd;
#pragma unroll
        for (int dir = 0; dir < 2; ++dir)
#pragma unroll
            for (int i = 0; i < 2; ++i) { const int id = tid + 512 * i, r = id >> 4, cc = id & 15;
                *(LAS u32x4*)(lds + (dir ? L3_QB : L3_QF) + r * 272 + cc * 16) = *(const u32x4*)(QTg + (size_t)dir * T * 1024 + (size_t)(t0 + r) * 1024 + hh * 128 + cc * 8); }
        bf16x8 bv[2][4][2];
#pragma unroll
        for (int dir = 0; dir < 2; ++dir) { const bf16* Sg = (const bf16*)(F.ws + WS_S) + ((size_t)(dir * 8 + hh) * NCH + c) * 256 * 128;
#pragma unroll
            for (int ks = 0; ks < 4; ++ks)
#pragma unroll
                for (int nj = 0; nj < 2; ++nj) bv[dir][ks][nj] = *(const bf16x8*)(Sg + (size_t)(32 * w + 16 * nj + fr) * 128 + 32 * ks + 8 * fq); }
        __builtin_amdgcn_sched_barrier(0);
        __syncthreads();
        f32x4 o[4][2];
#pragma unroll
        for (int mi = 0; mi < 4; ++mi)
#pragma unroll
            for (int nj = 0; nj < 2; ++nj) o[mi][nj] = (f32x4){0.f, 0.f, 0.f, 0.f};
#pragma unroll
        for (int dir = 0; dir < 2; ++dir) {
#pragma unroll
            for (int ks = 0; ks < 4; ++ks) {
#pragma unroll
                for (int mi = 0; mi < 4; ++mi) { const bf16x8 a = *(const LAS bf16x8*)(lds + (dir ? L3_QB : L3_QF) + (16 * mi + fr) * 272 + (32 * ks + 8 * fq) * 2);
#pragma unroll
                    for (int nj = 0; nj < 2; ++nj) o[mi][nj] = MFMA16(a, bv[dir][ks][nj], o[mi][nj]); } } }
        LAS float* OL = (LAS float*)(lds + L3_OL);
#pragma unroll
        for (int mi = 0; mi < 4; ++mi)
#pragma unroll
            for (int nj = 0; nj < 2; ++nj)
#pragma unroll
                for (int r = 0; r < 4; ++r) OL[(16 * mi + 4 * fq + r) * 260 + 32 * w + 16 * nj + fr] = o[mi][nj][r];
        __syncthreads();
        { const int tk = tid >> 3, seg = tid & 7;
          f32x4 v[4][2]; float sq = 0.f;
#pragma unroll
          for (int g = 0; g < 4; ++g) { const int ee = 64 * g + 8 * seg; const float* oi = OI + (size_t)(t0 + tk) * DM + hh * 256 + ee;
              v[g][0] = *(const LAS f32x4*)(OL + tk * 260 + ee) + *(const f32x4*)oi; v[g][1] = *(const LAS f32x4*)(OL + tk * 260 + ee + 4) + *(const f32x4*)(oi + 4);
              sq += (v[g][0].x * v[g][0].x + v[g][0].y * v[g][0].y) + (v[g][0].z * v[g][0].z + v[g][0].w * v[g][0].w) + (v[g][1].x * v[g][1].x + v[g][1].y * v[g][1].y) + (v[g][1].z * v[g][1].z + v[g][1].w * v[g][1].w); }
          sq += __shfl_xor(sq, 1); sq += __shfl_xor(sq, 2); sq += __shfl_xor(sq, 4);
          const float rstd = 1.0f / sqrtf(sq * (1.0f / 256.0f) + RMS_EPS);
#pragma unroll
          for (int g = 0; g < 4; ++g) { const int ee = 64 * g + 8 * seg;
              const u32x4 gt = *(const u32x4*)(P + (size_t)(t0 + tk) * EV_N + gcol + ee);
              f32x4 n0 = {1.f, 1.f, 1.f, 1.f}, n1 = {1.f, 1.f, 1.f, 1.f};
              if (is_gla) { n0 = *(const f32x4*)(F.a->in[15] + e * 256 + ee); n1 = *(const f32x4*)(F.a->in[15] + e * 256 + ee + 4); }
              const f32x4 a0 = v[g][0] * rstd * n0, a1 = v[g][1] * rstd * n1;
              u32x4 ow; ow.x = cvt_pk_bf16(a0.x * silu_f(bflo(gt.x)), a0.y * silu_f(bfhi(gt.x))); ow.y = cvt_pk_bf16(a0.z * silu_f(bflo(gt.y)), a0.w * silu_f(bfhi(gt.y)));
              ow.z = cvt_pk_bf16(a1.x * silu_f(bflo(gt.z)), a1.y * silu_f(bfhi(gt.z))); ow.w = cvt_pk_bf16(a1.z * silu_f(bflo(gt.w)), a1.w * silu_f(bfhi(gt.w)));
              *(u32x4*)(MIX + (size_t)(t0 + tk) * DM + hh * 256 + ee) = ow; } }
        __syncthreads();
    }
}

__device__ __forceinline__ void e1_phase(Frame& F, int o) {
    PHASE_IDS();
    const int gw = F.vcu * NWAVES + wave, NGW = F.G * NWAVES;
    const bf16* P = (const bf16*)(F.ws + WS_PROJ); bf16* CQN = (bf16*)(F.ws + WS_CQN); bf16* CKVN = (bf16*)(F.ws + WS_CKVN); bf16* KR = (bf16*)(F.ws + WS_KR);
    const float* wq = F.a->in[18] + o * 512 + lane * 8; const float* wkv = F.a->in[19] + o * 512 + lane * 8;
    const f32x4 wq0 = *(const f32x4*)wq, wq1 = *(const f32x4*)(wq + 4), wk0 = *(const f32x4*)wkv, wk1 = *(const f32x4*)(wkv + 4);
    const f32x2* AXR = (const f32x2*)(F.ws + WS_AXR); const f32x2* AXC = (const f32x2*)(F.ws + WS_AXC);
    for (int t = gw; t < T; t += NGW) {
        const bf16* p = P + (size_t)t * OD_N;
        const u32x4 a = *(const u32x4*)(p + lane * 8), b = *(const u32x4*)(p + 512 + lane * 8);
        float x[8] = {bflo(a.x), bfhi(a.x), bflo(a.y), bfhi(a.y), bflo(a.z), bfhi(a.z), bflo(a.w), bfhi(a.w)};
        float y[8] = {bflo(b.x), bfhi(b.x), bflo(b.y), bfhi(b.y), bflo(b.z), bfhi(b.z), bflo(b.w), bfhi(b.w)};
        float sx = 0.f, sy = 0.f;
#pragma unroll
        for (int j = 0; j < 8; ++j) { sx += x[j] * x[j]; sy += y[j] * y[j]; }
        const float rx = 1.0f / sqrtf(wave_sum(sx) * (1.0f / 512.0f) + RMS_EPS), ry = 1.0f / sqrtf(wave_sum(sy) * (1.0f / 512.0f) + RMS_EPS);
        u32x4 oq, ok;
        oq.x = cvt_pk_bf16(x[0] * rx * wq0.x, x[1] * rx * wq0.y); oq.y = cvt_pk_bf16(x[2] * rx * wq0.z, x[3] * rx * wq0.w); oq.z = cvt_pk_bf16(x[4] * rx * wq1.x, x[5] * rx * wq1.y); oq.w = cvt_pk_bf16(x[6] * rx * wq1.z, x[7] * rx * wq1.w);
        ok.x = cvt_pk_bf16(y[0] * ry * wk0.x, y[1] * ry * wk0.y); ok.y = cvt_pk_bf16(y[2] * ry * wk0.z, y[3] * ry * wk0.w); ok.z = cvt_pk_bf16(y[4] * ry * wk1.x, y[5] * ry * wk1.y); ok.w = cvt_pk_bf16(y[6] * ry * wk1.z, y[7] * ry * wk1.w);
        *(u32x4*)(CQN + (size_t)t * 512 + lane * 8) = oq; *(u32x4*)(CKVN + (size_t)t * 512 + lane * 8) = ok;
        float v = bf2f(p[1024 + lane]); const float pr = __shfl_xor(v, 16);
        if (t >= NCTX) { const int pp = t - NCTX, pos = (lane & 32) ? (pp & 63) : (pp >> 6); const f32x2 cs = ((lane & 32) ? AXC : AXR)[pos * 16 + (lane & 15)];
            v = (lane & 16) ? v * cs.x + pr * cs.y : v * cs.x - pr * cs.y; }
        KR[(size_t)t * 64 + lane] = f2bf(v);
    }
}

namespace att {
constexpr int KVBLK = 64;
constexpr float SCALE = 0.07216878364870322f;
constexpr float THR = 8.f;
constexpr int SHM_K = 64 * 384, SHM_V = 64 * 256;
constexpr int A_V = 0, A_K = 3 * SHM_V, A_WS = 3 * SHM_V + 3 * SHM_K;
#define SBAR() __builtin_amdgcn_sched_barrier(0)
__device__ __forceinline__ int crow(int r, int hi) { return (r & 3) + 8 * (r >> 2) + 4 * hi; }
constexpr float PLIM = 4096.f;
__device__ __forceinline__ void exp_sum(f32x16& p0, f32x16& p1, float& ps) {
#pragma unroll
    for (int r = 0; r < 16; ++r) p0[r] = __builtin_amdgcn_exp2f(p0[r]);
#pragma unroll
    for (int r = 0; r < 16; ++r) p1[r] = __builtin_amdgcn_exp2f(p1[r]);
    ps = p0[0];
#pragma unroll
    for (int r = 1; r < 16; ++r) ps += p0[r];
#pragma unroll
    for (int r = 0; r < 16; ++r) ps += p1[r];
}
__device__ __forceinline__ float row_max32(const f32x16& p0, const f32x16& p1) {
    float pmax = p0[0];
#pragma unroll
    for (int r = 1; r < 16; ++r) pmax = fmaxf(pmax, p0[r]);
#pragma unroll
    for (int r = 0; r < 16; ++r) pmax = fmaxf(pmax, p1[r]);
    auto rr = __builtin_amdgcn_permlane32_swap(__float_as_uint(pmax), __float_as_uint(pmax), false, false);
    return fmaxf(__uint_as_float(rr[0]), __uint_as_float(rr[1]));
}
__device__ __forceinline__ void pack_p(const f32x16& p0, const f32x16& p1, bf16x8& pa0, bf16x8& pa1, bf16x8& pa2, bf16x8& pa3) {
#define PK4(P, BASE, OUT) do { unsigned a0 = cvt_pk_bf16(P[BASE + 0], P[BASE + 1]), a1 = cvt_pk_bf16(P[BASE + 2], P[BASE + 3]);   \
    unsigned b0 = cvt_pk_bf16(P[BASE + 4], P[BASE + 5]), b1 = cvt_pk_bf16(P[BASE + 6], P[BASE + 7]);                              \
    auto r0 = __builtin_amdgcn_permlane32_swap(a0, b0, false, false); auto r1 = __builtin_amdgcn_permlane32_swap(a1, b1, false, false); \
    u32x4 w = {r0[0], r1[0], r0[1], r1[1]}; OUT = *reinterpret_cast<bf16x8*>(&w); } while (0)
    PK4(p0, 0, pa0); PK4(p0, 8, pa1); PK4(p1, 0, pa2); PK4(p1, 8, pa3);
#undef PK4
}
__device__ __forceinline__ int kswz(int row, int g) { return row * 384 + (((g & ~7) | ((g & 7) ^ ((row >> 1) & 7))) << 4); }
__device__ __forceinline__ void qkt(f32x16& p0, f32x16& p1, const LAS unsigned char* Ks, const bf16x8 (&qr)[12], const int (&kx)[4], const f32x16& init) {
    bf16x8 c0 = *(const LAS bf16x8*)(Ks + kx[0]), c1 = *(const LAS bf16x8*)(Ks + kx[0] + 32 * 384), n0, n1;
#pragma unroll
    for (int d0 = 0; d0 < 12; ++d0) {
        if (d0 < 11) { n0 = *(const LAS bf16x8*)(Ks + kx[(d0 + 1) & 3] + ((d0 + 1) >> 2) * 128); n1 = *(const LAS bf16x8*)(Ks + kx[(d0 + 1) & 3] + ((d0 + 1) >> 2) * 128 + 32 * 384); }
        __builtin_amdgcn_sched_barrier(0);
        p0 = MFMA32(c0, qr[d0], d0 == 0 ? init : p0);
        p1 = MFMA32(c1, qr[d0], d0 == 0 ? init : p1);
        __builtin_amdgcn_sched_barrier(0);
        c0 = n0; c1 = n1; }
}
__device__ __forceinline__ int v_st(int k, int c) { const int kk = (k & ~0xC) | ((k & 4) << 1) | ((k & 8) >> 1); return ((kk >> 3) * 4 + (c >> 5)) * 512 + ((kk & 7) * 32 + (c & 31)) * 2; }
__device__ __forceinline__ int v_rd_base(int lane) { return ((lane & 3) << 3) | (((lane >> 2) & 3) << 6) | (((lane >> 4) & 1) << 5) | (((lane >> 5) & 1) << 8); }
constexpr int v_rd_off(int d0, int ks, int half) { return d0 * 512 + ks * 4096 + half * 2048; }
template <int OFF> __device__ __forceinline__ s16x4 tr_read(int vb) {
    s16x4 r; asm volatile("ds_read_b64_tr_b16 %0, %1 offset:%2" : "=&v"(r) : "v"(vb), "i"(OFF) : "memory"); return r;
}
struct VF { s16x4 l0, h0, l1, h1, l2, h2, l3, h3; };
template <int KS> __device__ __forceinline__ void v_load(VF& f, int vb) {
    f.l0 = tr_read<v_rd_off(0, KS, 0)>(vb); f.h0 = tr_read<v_rd_off(0, KS, 1)>(vb); f.l1 = tr_read<v_rd_off(1, KS, 0)>(vb); f.h1 = tr_read<v_rd_off(1, KS, 1)>(vb);
    f.l2 = tr_read<v_rd_off(2, KS, 0)>(vb); f.h2 = tr_read<v_rd_off(2, KS, 1)>(vb); f.l3 = tr_read<v_rd_off(3, KS, 0)>(vb); f.h3 = tr_read<v_rd_off(3, KS, 1)>(vb);
}
__device__ __forceinline__ void pv_mma(f32x16 (&o)[4], const VF& f, bf16x8 pa) {
#define PK(L, H) (bf16x8){L[0], L[1], L[2], L[3], H[0], H[1], H[2], H[3]}
    o[0] = MFMA32(pa, PK(f.l0, f.h0), o[0]);
    o[1] = MFMA32(pa, PK(f.l1, f.h1), o[1]);
    o[2] = MFMA32(pa, PK(f.l2, f.h2), o[2]);
    o[3] = MFMA32(pa, PK(f.l3, f.h3), o[3]);
#undef PK
}
__device__ __forceinline__ void pv_d0(f32x16 (&o)[4], int vb, bf16x8 pa0, bf16x8 pa1, bf16x8 pa2, bf16x8 pa3) {
    VF fa, fb;
    v_load<0>(fa, vb); v_load<1>(fb, vb);
    asm volatile("s_waitcnt lgkmcnt(8)" ::: "memory"); SBAR(); pv_mma(o, fa, pa0); SBAR();
    v_load<2>(fa, vb);
    asm volatile("s_waitcnt lgkmcnt(8)" ::: "memory"); SBAR(); pv_mma(o, fb, pa1); SBAR();
    v_load<3>(fb, vb);
    asm volatile("s_waitcnt lgkmcnt(8)" ::: "memory"); SBAR(); pv_mma(o, fa, pa2); SBAR();
    asm volatile("s_waitcnt lgkmcnt(0)" ::: "memory"); SBAR(); pv_mma(o, fb, pa3);
}
__device__ __forceinline__ void rope_pair(bf16x8& a, bf16x8& b, const f32x2* cs) {
    u32x4 ua = *reinterpret_cast<u32x4*>(&a), ub = *reinterpret_cast<u32x4*>(&b); u32x4 oa, ob;
#pragma unroll
    for (int j = 0; j < 4; ++j) { const f32x2 c0 = cs[2 * j], c1 = cs[2 * j + 1];
        const float x1l = bflo(ua[j]), x1h = bfhi(ua[j]), x2l = bflo(ub[j]), x2h = bfhi(ub[j]);
        oa[j] = cvt_pk_bf16(x1l * c0.x - x2l * c0.y, x1h * c1.x - x2h * c1.y);
        ob[j] = cvt_pk_bf16(x2l * c0.x + x1l * c0.y, x2h * c1.x + x1h * c1.y); }
    a = *reinterpret_cast<bf16x8*>(&oa); b = *reinterpret_cast<bf16x8*>(&ob);
}
__device__ __forceinline__ void unit(Frame& F, int h, int qrow0, int nkeys) {
    LAS unsigned char* lds = F.lds;
    PHASE_IDS(); const int wid = wave, r32 = lane & 31, hi = lane >> 5;
    const bf16* QB = (const bf16*)(F.ws + WS_QB); const bf16* KVB = (const bf16*)(F.ws + WS_KVB); const bf16* KR = (const bf16*)(F.ws + WS_KR);
    LAS unsigned char* V_lds = lds + A_V; LAS unsigned char* K_lds = lds + A_K;
    LAS float* wsl = (LAS float*)(lds + A_WS) + wid * 64; LAS float* li_l = wsl; LAS float* al_l = wsl + 32;
    float m_reg = -1e30f, l_reg = 0; f32x16 o[4] = {}; bf16x8 qr[12]; f32x16 negm;
    const int qt = qrow0 + wid * 32 + r32;
    const bf16* Qw = QB + (size_t)qt * 3072 + 192 * h + hi * 8;
#pragma unroll
    for (int d0 = 0; d0 < 12; ++d0) qr[d0] = *(const bf16x8*)(Qw + d0 * 16);
    if (qt >= NCTX) { const int pp = qt - NCTX;
        rope_pair(qr[8], qr[9], (const f32x2*)(F.ws + WS_AXR) + (pp >> 6) * 16 + hi * 8);
        rope_pair(qr[10], qr[11], (const f32x2*)(F.ws + WS_AXC) + (pp & 63) * 16 + hi * 8); }
    const unsigned char* wsb = F.ws;
    unsigned koff[3], kfl = 0u; int kdst[3];
#pragma unroll
    for (int i = 0; i < 3; ++i) { const int id = tid + 512 * i, row = id / 24, g = id % 24;
        if (g < 16) { koff[i] = (unsigned)WS_KVB + (unsigned)(row * 4096 + 256 * h + g * 8) * 2u; kfl |= 1u << i; } else { koff[i] = (unsigned)WS_KR + (unsigned)(row * 64 + (g - 16) * 8) * 2u; }
        kdst[i] = kswz(row, g); }
    const int sr = tid >> 4, sc = (tid & 15) * 8, vst0 = v_st(sr, sc);
    const unsigned voff = (unsigned)WS_KVB + (unsigned)(sr * 4096 + 256 * h + 128 + sc) * 2u;
    const int vb0 = (int)(unsigned)(uintptr_t)V_lds + v_rd_base(lane);
    int kx[4];
#pragma unroll
    for (int q = 0; q < 4; ++q) kx[q] = r32 * 384 + ((((2 * q) | hi) ^ ((r32 >> 1) & 7)) << 4);
    bf16x8 sk0, sk1, sk2, sv0, sv1;
#define SLOAD(jt) do { const unsigned vo_ = voff + (unsigned)(jt) * (64u * 4096u * 2u); sv0 = *(const bf16x8*)(wsb + vo_); sv1 = *(const bf16x8*)(wsb + vo_ + 32u * 4096u * 2u); \
    const unsigned kt_ = (unsigned)(jt) * 8192u; \
    sk0 = *(const bf16x8*)(wsb + koff[0] + (kt_ << ((kfl & 1u) * 6u))); sk1 = *(const bf16x8*)(wsb + koff[1] + (kt_ << (((kfl >> 1) & 1u) * 6u))); sk2 = *(const bf16x8*)(wsb + koff[2] + (kt_ << (((kfl >> 2) & 1u) * 6u))); } while (0)
#define SWRITE(b) do { *(LAS bf16x8*)(V_lds + (b) * SHM_V + vst0) = sv0; *(LAS bf16x8*)(V_lds + (b) * SHM_V + vst0 + 8192) = sv1; \
    *(LAS bf16x8*)(K_lds + (b) * SHM_K + kdst[0]) = sk0; *(LAS bf16x8*)(K_lds + (b) * SHM_K + kdst[1]) = sk1; *(LAS bf16x8*)(K_lds + (b) * SHM_K + kdst[2]) = sk2; } while (0)
#define SWAIT() asm volatile("s_waitcnt vmcnt(0)" ::: "memory")
#define NEGM_SET(v) do { const float v_ = (v); _Pragma("unroll") for (int r = 0; r < 16; ++r) negm[r] = v_; asm volatile("" : "+v"(negm)); } while (0)
    f32x16 p0, p1; bf16x8 pa0, pa1, pa2, pa3; const int NT = nkeys / KVBLK;
    NEGM_SET(0.f);
#define ABAR() do { asm volatile("s_waitcnt lgkmcnt(0)" ::: "memory"); __builtin_amdgcn_s_barrier(); asm volatile("" ::: "memory"); } while (0)
#define ASTAGE(j) do { if ((j) + 1 < NT) { SWAIT(); SWRITE(b1); } if ((j) + 2 < NT) SLOAD((j) + 2); } while (0)
#define AQK(j) do { SBAR(); qkt(p0, p1, K_lds + b0 * SHM_K, qr, kx, negm); SBAR(); } while (0)
#define RARE(j) do { _Pragma("nounroll") for (int pass_ = 0; pass_ < 2; ++pass_) { NEGM_SET(pass_ ? -m_reg : 0.f); AQK(j); \
      if (pass_ == 0) { const float mnew_ = fmaxf(m_reg, row_max32(p0, p1)); const float a_ = __builtin_amdgcn_exp2f(m_reg - mnew_); m_reg = mnew_; l_reg *= a_; \
        if (hi == 0) al_l[r32] = a_; asm volatile("s_waitcnt lgkmcnt(0)" ::: "memory"); \
        _Pragma("unroll") for (int d = 0; d < 4; ++d) { SBAR(); _Pragma("unroll") for (int r = 0; r < 16; ++r) o[d][r] *= al_l[crow(r, hi)]; } SBAR(); } } } while (0)
#define ASP(j) do { float ps; exp_sum(p0, p1, ps); \
    if (__builtin_expect((j) == 0 || __any(!(ps <= PLIM)), 0)) { RARE(j); exp_sum(p0, p1, ps); } \
    { auto rr = __builtin_amdgcn_permlane32_swap(__float_as_uint(ps), __float_as_uint(ps), false, false); l_reg += __uint_as_float(rr[0]) + __uint_as_float(rr[1]); } \
    pack_p(p0, p1, pa0, pa1, pa2, pa3); SBAR(); pv_d0(o, vb0 + b0 * SHM_V, pa0, pa1, pa2, pa3); } while (0)
    SLOAD(0); SWAIT(); SWRITE(0); SLOAD(1); ABAR();
    { const bool g1 = __builtin_amdgcn_readfirstlane(wid >> 2) != 0;
      if (g1) ABAR();
      int b0 = 0;
      for (int j = 0; j < NT; ++j) { const int b1 = b0 == 2 ? 0 : b0 + 1; ASTAGE(j); AQK(j); ABAR(); ASP(j); ABAR(); b0 = b1; }
      if (!g1) ABAR(); }
#undef ABAR
#undef ASTAGE
#undef AQK
#undef ASP
#undef RARE
#undef NEGM_SET
    if (hi == 0) li_l[r32] = l_reg; asm volatile("s_waitcnt lgkmcnt(0)" ::: "memory");
    float rli[16];
#pragma unroll
    for (int r = 0; r < 16; ++r) rli[r] = __builtin_amdgcn_rcpf(li_l[crow(r, hi)]);
    unsigned orow0 = (unsigned)(qrow0 + wid * 32) * DM + 128 * h; asm volatile("" : "+v"(orow0));
    bf16* Ow = (bf16*)(F.ws + WS_MIX) + orow0;
#pragma unroll
    for (int r = 0; r < 16; ++r) { const int orow = crow(r, hi);
#pragma unroll
        for (int d0 = 0; d0 < 4; ++d0) Ow[(size_t)orow * DM + d0 * 32 + r32] = f2bf(o[d0][r] * rli[r]); }
    __syncthreads();
#undef SLOAD
#undef SWRITE
#undef SWAIT
}
}

__device__ __forceinline__ void attn_phase(Frame& F) {
    for (int u = F.vcu; u < 1024 + 16; u += F.G) {
        if (u < 1024) att::unit(F, u >> 6, NCTX + 256 * (u & 63), T);
        else att::unit(F, u - 1024, 0, NCTX);
    }
}

#ifdef DBG
constexpr int DBG_W_BAD = 64, DBG_W_SSQ = 65, DBG_W_CNT = 66, DBG_W_MAX = 67;
__device__ __forceinline__ void dbg_scan(Frame& F, int id, size_t off, size_t nbytes, bool is_bf) {
    PHASE_IDS();
    const u32x4* p = (const u32x4*)(F.ws + off); const size_t n = nbytes / 16; bool bad = false;
    for (size_t i = (size_t)F.vcu * NTHR + tid; i < n; i += (size_t)F.G * NTHR) { const u32x4 v = p[i];
#pragma unroll
        for (int j = 0; j < 4; ++j) { if (is_bf) { bad |= ((v[j] & 0x7f80u) == 0x7f80u) | ((v[j] & 0x7f800000u) == 0x7f800000u); } else bad |= ((v[j] & 0x7f800000u) == 0x7f800000u); } }
    if (__any(bad) && lane == 0) atomicMax((unsigned*)(F.ws + WS_CTL) + DBG_W_BAD, (unsigned)(100000 - id));
}
__device__ __forceinline__ void dbg_max(Frame& F, size_t off, size_t nbytes, bool is_bf) {
    PHASE_IDS();
    const u32x4* p = (const u32x4*)(F.ws + off); const size_t n = nbytes / 16; unsigned mx = 0u;
    for (size_t i = (size_t)F.vcu * NTHR + tid; i < n; i += (size_t)F.G * NTHR) { const u32x4 v = p[i];
#pragma unroll
        for (int j = 0; j < 4; ++j) { if (is_bf) { const unsigned a0 = (v[j] << 16) & 0x7fffffffu, a1 = v[j] & 0x7fff0000u; if (a0 < 0x7f800000u) mx = max(mx, a0); if (a1 < 0x7f800000u) mx = max(mx, a1); } else { const unsigned a0 = v[j] & 0x7fffffffu; if (a0 < 0x7f800000u) mx = max(mx, a0); } } }
#pragma unroll
    for (int o = 1; o < 64; o <<= 1) mx = max(mx, (unsigned)__shfl_xor((int)mx, o));
    if (lane == 0) atomicMax((unsigned*)(F.ws + WS_CTL) + DBG_W_MAX, mx);
}
#define DBGSCAN(id, off, nbytes, isbf) dbg_scan(F, (id), (off), (nbytes), (isbf))
#else
#define DBGSCAN(id, off, nbytes, isbf) do {} while (0)
#endif

#ifndef RES_ALIGN
#define RES_ALIGN true
#endif
#ifndef RES_SP2
#define RES_SP2 true
#endif
__global__ void __launch_bounds__(NTHR, 2) fwd_kernel(Args args) {
    extern __shared__ __attribute__((aligned(16))) unsigned char lds_raw[];
    Frame F;
    F.lds = (LAS unsigned char*)lds_raw;
    F.G = gridDim.x; { const int bx = blockIdx.x; F.vcu = (F.G % 8 == 0) ? (bx % 8) * (F.G / 8) + bx / 8 : bx; }
    F.a = &args; F.ws = args.ws;
    volatile LAS unsigned* ctlw = (volatile LAS unsigned*)(F.lds + LDS_CTL);
    if (threadIdx.x < 16) ctlw[threadIdx.x] = 0u;
    __syncthreads();
    XcdBarrier bar = xcd_barrier_post((unsigned*)(F.ws + WS_CTL) + 4096, ctlw);
#define GRID_BAR() xcd_barrier(bar)
#ifdef DBG_TIME
    unsigned long long t_prev = __builtin_amdgcn_s_memrealtime();
#define TSTAMP(cat) do { if (blockIdx.x == 0 && threadIdx.x == 0) { const unsigned long long t_now = __builtin_amdgcn_s_memrealtime(); unsigned long long* tw = (unsigned long long*)(F.ws + WS_CTL) + 64 + (cat); *tw = *tw + (t_now - t_prev); t_prev = t_now; } } while (0)
#else
#define TSTAMP(cat) do {} while (0)
#endif

#ifndef SK_P0
    p0a(F);
#ifdef DUP_P0
    p0a(F);
#endif
#endif
    GRID_BAR();
    p0b(F); GRID_BAR();
    DBGSCAN(1, WS_MOD, (size_t)4 * 2 * NADA * 4, false);
    init_x_by_owners(F);
    row_phase<0>(F, nullptr, nullptr, modp(F, 0, 0, 0), modp(F, 0, 0, 1), modp(F, 0, 1, 0), modp(F, 0, 1, 1)); GRID_BAR(); TSTAMP(0);
    DBGSCAN(2, WS_X, (size_t)T * DM * 4, false); DBGSCAN(3, WS_H, (size_t)T * DM * 2, true);

    const pg8::bf16_t* Hb = (const pg8::bf16_t*)(F.ws + WS_H);
    for (int s = 0; s < 3 * DEPTH; ++s) {
        const int l = s / 3, r = s % 3;
        const pg8::bf16_t* A2; const pg8::bf16_t* B2; int K2;
        if (r != 1) {
            const int f = r >> 1;
            pg8::Gemm g{Hb, (const pg8::bf16_t*)(F.ws + WS_WFI + (size_t)(l * 2 + f) * SZ_WFI), T, 2 * DFF, DM, DM, DM};
            pg8::StaticOrder S; S.init(T, 2 * DFF, F.G, (int)blockIdx.x);
            pg8::EpiSwiGLU E{(pg8::bf16_t*)(F.ws + WS_HID), DFF};
#ifndef SK_SW
            pg8::gemm_phase<pg8::EpiSwiGLU, pg8::StaticOrder>(F.lds, g, S, E);
#endif
#ifdef DUP_SW
            pg8::gemm_phase<pg8::EpiSwiGLU, pg8::StaticOrder>(F.lds, g, S, E);
#endif
            GRID_BAR(); TSTAMP(1);
            DBGSCAN(10 + 10 * s, WS_HID, (size_t)T * DFF * 2, true);
            A2 = (const pg8::bf16_t*)(F.ws + WS_HID); B2 = (const pg8::bf16_t*)(F.ws + WS_WFO + (size_t)(l * 2 + f) * SZ_WFO); K2 = DFF;
        } else if ((l & 1) == 0) {
            const int e = l >> 1;
            { pg8::Gemm g{Hb, (const pg8::bf16_t*)(F.ws + WS_EWI + (size_t)e * SZ_EWI), T, EV_N, DM, DM, DM};
              pg8::StaticOrder S; S.init(T, EV_N, F.G, (int)blockIdx.x);
              pg8::EpiBf16 E{(pg8::bf16_t*)(F.ws + WS_PROJ), EV_N};
#ifndef SK_G1
              pg8::gemm_phase<pg8::EpiBf16, pg8::StaticOrder>(F.lds, g, S, E);
#endif
            }
            GRID_BAR(); TSTAMP(4);
            DBGSCAN(10 + 10 * s, WS_PROJ, (size_t)T * EV_N * 2 - 0, true);
#ifdef DBG
            if (s == 1) dbg_max(F, WS_PROJ, (size_t)T * EV_N * 2, true);
#endif
#ifndef SK_S1
            s1_phase(F, e);
#ifdef DUP_S1
            s1_phase(F, e);
#endif
#endif
            GRID_BAR(); TSTAMP(5);
            DBGSCAN(11 + 10 * s, WS_U, SZ_U, true); DBGSCAN(16 + 10 * s, WS_OI, (size_t)T * DM * 4, false); DBGSCAN(17 + 10 * s, WS_QT, (size_t)2 * T * 1024 * 2, true); DBGSCAN(18 + 10 * s, WS_DEC, (size_t)2 * 8 * NCH * 128 * 4, false);
#ifndef SK_S2
            s2_phase(F);
#ifdef DUP_S2
            s2_phase(F);
#endif
#endif
            GRID_BAR(); TSTAMP(6);
            DBGSCAN(12 + 10 * s, WS_S, SZ_U, true);
#ifndef SK_S3
            s3_phase(F, e);
#ifdef DUP_S3
            s3_phase(F, e);
#endif
#endif
            GRID_BAR(); TSTAMP(7);
            DBGSCAN(13 + 10 * s, WS_MIX, (size_t)T * DM * 2, true);
            A2 = (const pg8::bf16_t*)(F.ws + WS_MIX); B2 = (const pg8::bf16_t*)(F.ws + WS_EWO + (size_t)e * SZ_SQ); K2 = DM;
        } else {
            const int o = l >> 1;
            { pg8::Gemm g{Hb, (const pg8::bf16_t*)(F.ws + WS_OWI + (size_t)o * SZ_OWI), T, OD_N, DM, DM, DM};
              pg8::StaticOrder S; S.init(T, OD_N, F.G, (int)blockIdx.x);
              pg8::EpiBf16 E{(pg8::bf16_t*)(F.ws + WS_PROJ), OD_N};
#ifndef SK_G2
              pg8::gemm_phase<pg8::EpiBf16, pg8::StaticOrder>(F.lds, g, S, E);
#endif
            }
            GRID_BAR();
#ifndef SK_E1
            e1_phase(F, o);
#endif
            GRID_BAR();
            DBGSCAN(11 + 10 * s, WS_CQN, (size_t)T * 512 * 2 * 2, true); DBGSCAN(11 + 10 * s, WS_KR, (size_t)T * 64 * 2, true);
            for (int q = 0; q < 2; ++q) {
                pg8::Gemm g{(const pg8::bf16_t*)(F.ws + (q ? WS_CKVN : WS_CQN)), (const pg8::bf16_t*)(F.ws + (q ? WS_OUKV + (size_t)o * SZ_OUKV : WS_OUQ + (size_t)o * SZ_OUQ)), T, q ? 4096 : 3072, 512, 512, 512};
                pg8::StaticOrder S; S.init(T, g.N, F.G, (int)blockIdx.x);
                pg8::EpiBf16 E{(pg8::bf16_t*)(F.ws + (q ? WS_KVB : WS_QB)), g.N};
#ifndef SK_G3
                pg8::gemm_phase<pg8::EpiBf16, pg8::StaticOrder>(F.lds, g, S, E);
#endif
            }
            GRID_BAR(); TSTAMP(8);
            DBGSCAN(12 + 10 * s, WS_QB, (size_t)T * 3072 * 2, true); DBGSCAN(12 + 10 * s, WS_KVB, (size_t)T * 4096 * 2, true);
#ifndef SK_ATT
            attn_phase(F);
#ifdef DUP_ATT
            attn_phase(F);
#endif
#endif
            GRID_BAR(); TSTAMP(9);
            DBGSCAN(13 + 10 * s, WS_MIX, (size_t)T * DM * 2, true);
            A2 = (const pg8::bf16_t*)(F.ws + WS_MIX); B2 = (const pg8::bf16_t*)(F.ws + WS_OWO + (size_t)o * SZ_SQ); K2 = DM;
        }
        {
            pg8::Gemm g{A2 + (size_t)NCTX * K2, B2, NLAT, DM, K2, K2, K2};
            pg8::StaticOrder S; S.init(NLAT, DM, F.G, (int)blockIdx.x);
            const int sp = s > 0 ? s - 1 : 0;
            const float* plng = F.a->in[6] + (size_t)sp * DM; const float* plnb = F.a->in[7] + (size_t)sp * DM; const float* stat = (const float*)(F.ws + WS_STAT);
            pg8::EpiResid E{(float*)(F.ws + WS_X) + (size_t)NCTX * DM, modp(F, l, 0, 3 * r + 2), (r != 1) ? 0.5f : 1.0f, stat + (size_t)NCTX * 2, plng, plnb, s > 0 ? 1 : 0};
            ctx_resid_small(F, (float*)(F.ws + WS_X), (const bf16*)A2, (const bf16*)B2, K2, modp(F, l, 1, 3 * r + 2), (r != 1) ? 0.5f : 1.0f, stat, plng, plnb, s > 0 ? 1 : 0, 1);
#ifndef SK_RES
            pg8::gemm_phase<pg8::EpiResid, pg8::StaticOrder, RES_ALIGN, RES_SP2>(F.lds, g, S, E);
#endif
            ctx_resid_small(F, (float*)(F.ws + WS_X), (const bf16*)A2, (const bf16*)B2, K2, modp(F, l, 1, 3 * r + 2), (r != 1) ? 0.5f : 1.0f, stat, plng, plnb, s > 0 ? 1 : 0, 0);
#ifdef DUP_SMALL_OFF
            ctx_resid_small(F, (float*)(F.ws + WS_OI), (const bf16*)A2, (const bf16*)B2, K2, modp(F, l, 1, 3 * r + 2), (r != 1) ? 0.5f : 1.0f);
            ctx_resid_small(F, (float*)(F.ws + WS_OI), (const bf16*)A2, (const bf16*)B2, K2, modp(F, l, 1, 3 * r + 2), (r != 1) ? 0.5f : 1.0f);
#endif
#ifdef DUP_RES
            { pg8::EpiResid E2{(float*)(F.ws + WS_OI) + (size_t)NCTX * DM, modp(F, l, 0, 3 * r + 2), 0.5f, stat, plng, plnb, 0};
              pg8::gemm_phase<pg8::EpiResid, pg8::StaticOrder>(F.lds, g, S, E2); }
#endif
        }
        GRID_BAR(); TSTAMP(r != 1 ? 2 : 10);
        DBGSCAN(14 + 10 * s, WS_X, (size_t)T * DM * 4, false);
        const float* lng = F.a->in[6] + (size_t)(l * 3 + r) * DM; const float* lnb = F.a->in[7] + (size_t)(l * 3 + r) * DM;
        if (s + 1 < 3 * DEPTH) { const int l2 = (s + 1) / 3, r2 = (s + 1) % 3;
            row_phase<1>(F, lng, lnb, modp(F, l2, 0, 3 * r2), modp(F, l2, 0, 3 * r2 + 1), modp(F, l2, 1, 3 * r2), modp(F, l2, 1, 3 * r2 + 1));
            GRID_BAR(); TSTAMP(3);
            DBGSCAN(15 + 10 * s, WS_X, (size_t)T * DM * 4, false); DBGSCAN(15 + 10 * s, WS_H, (size_t)T * DM * 2, true);
#if defined(DBG) && defined(DBG_STOP)
            if (s == DBG_STOP) break;
#endif
        } else {
#ifndef DBG
            row_phase<2>(F, lng, lnb, nullptr, nullptr, nullptr, nullptr);
#endif
        }
    }
#ifdef DBG_TIME
    {   PHASE_IDS(); GRID_BAR();
        const unsigned long long* tw = (const unsigned long long*)(F.ws + WS_CTL) + 64;
        const float tA = (float)__hip_atomic_load(tw + DBG_TA, RLX_AGENT) * 1e-5f, tB = (float)__hip_atomic_load(tw + DBG_TB, RLX_AGENT) * 1e-5f;
        const float cB = DBG_TSCALE * tB, cA = cB; (void)tA;
        float* out = F.a->out;
        for (size_t i = (size_t)F.vcu * NTHR + tid; i < (size_t)NLAT * DM; i += (size_t)F.G * NTHR) out[i] = (i == 12345) ? cA : cB;
    }
#endif
#ifdef DBG
    {
        PHASE_IDS();
        const float* X = (const float*)(F.ws + WS_X); float ssq = 0.f; float cnt = 0.f;
        for (size_t i = (size_t)F.vcu * NTHR + tid; i < (size_t)T * DM; i += (size_t)F.G * NTHR) { const float v = X[i]; if ((__float_as_uint(v) & 0x7f800000u) != 0x7f800000u) { ssq += v * v; cnt += 1.f; } }
        ssq = wave_sum(ssq); cnt = wave_sum(cnt);
        if (lane == 0) { atomicAdd((float*)(F.ws + WS_CTL) + DBG_W_SSQ, ssq); atomicAdd((float*)(F.ws + WS_CTL) + DBG_W_CNT, cnt); }
        GRID_BAR();
        const unsigned badw = __hip_atomic_load((unsigned*)(F.ws + WS_CTL) + DBG_W_BAD, RLX_AGENT);
        const float tss = __hip_atomic_load((float*)(F.ws + WS_CTL) + DBG_W_SSQ, RLX_AGENT), tcn = __hip_atomic_load((float*)(F.ws + WS_CTL) + DBG_W_CNT, RLX_AGENT);
        const float rms = sqrtf(tss / fmaxf(tcn, 1.f)); float cB = fminf(10.f * rms, 1000.f);
#ifdef DBG_REPORT_MAX
        { const unsigned mw = __hip_atomic_load((unsigned*)(F.ws + WS_CTL) + DBG_W_MAX, RLX_AGENT); cB = fminf(log2f(1.0f + __uint_as_float(mw)), 120.f); }
#endif
        const float cA = badw ? (float)(100000u - badw) * 10.f : 5.f;
        float* out = F.a->out;
        for (size_t i = (size_t)F.vcu * NTHR + tid; i < (size_t)NLAT * DM; i += (size_t)F.G * NTHR) out[i] = (i == 12345) ? cA + 0.f : cB;
        (void)cA;
    }
#endif
}

extern "C" void kernel_launch(void* const* d_in, const int* in_sizes, int n_in, void* d_out, int out_size, void* d_ws, size_t ws_size, hipStream_t stream) {
    static int grid = 0;
    if (grid == 0) {
        if (n_in != 23 || out_size != NLAT * DM || ws_size < WS_END) { fprintf(stderr, "kernel_launch: unexpected shapes: n_in %d out %d ws %zu (need %zu)\n", n_in, out_size, ws_size, (size_t)WS_END); grid = -1; return; }
        int dev = 0, cus = 0, per_cu = 0;
        if (hipGetDevice(&dev) != hipSuccess || hipDeviceGetAttribute(&cus, hipDeviceAttributeMultiprocessorCount, dev) != hipSuccess) { grid = -1; return; }
        if (hipFuncSetAttribute((const void*)fwd_kernel, hipFuncAttributeMaxDynamicSharedMemorySize, LDS_BYTES) != hipSuccess) { fprintf(stderr, "kernel_launch: hipFuncSetAttribute failed\n"); grid = -1; return; }
        if (hipOccupancyMaxActiveBlocksPerMultiprocessor(&per_cu, (const void*)fwd_kernel, NTHR, LDS_BYTES) != hipSuccess || per_cu < 1) fprintf(stderr, "kernel_launch: occupancy query reports %d\n", per_cu);
        (void)hipGetLastError();
        grid = cus;
    }
    if (grid < 0) return;
    (void)hipMemsetAsync((char*)d_ws + WS_CTL, 0, CTL_BYTES, stream);
    Args a{};
    for (int i = 0; i < 23; ++i) a.in[i] = (const float*)d_in[i];
    a.out = (float*)d_out; a.ws = (unsigned char*)d_ws;
    hipLaunchKernelGGL(fwd_kernel, dim3(grid), dim3(NTHR), LDS_BYTES, stream, a);
    const hipError_t le = hipPeekAtLastError();
    if (le != hipSuccess) fprintf(stderr, "kernel_launch: launch failed: %s\n", hipGetErrorName(le));
}
```

```cpp
#include <hip/hip_runtime.h>
#include <cstdio>
#include <cstdint>

#define GAS __attribute__((address_space(1)))
#define LAS __attribute__((address_space(3)))
typedef unsigned short bf16;
typedef short bf16x8 __attribute__((ext_vector_type(8)));
typedef short s16x4 __attribute__((ext_vector_type(4)));
typedef float f32x4 __attribute__((ext_vector_type(4)));
typedef float f32x2 __attribute__((ext_vector_type(2)));
typedef float f32x16 __attribute__((ext_vector_type(16)));
typedef unsigned u32x4 __attribute__((ext_vector_type(4)));
typedef unsigned u32x2 __attribute__((ext_vector_type(2)));

constexpr int DM = 2048, NCTX = 256, NLAT = 16384, T = NCTX + NLAT, DEPTH = 4, DFF = 5504;
constexpr int NADA = 9 * DM;
constexpr int EV_N = 6400, OD_N = 1280;
constexpr int NCH = T / 64;
constexpr float DN_ALPHA = 1.6817928305074290f;
constexpr float LN_EPS = 1e-5f, RMS_EPS = 1e-6f;
constexpr int NWAVES = 8, NTHR = 512;
constexpr int LDS_BYTES = 147456;
constexpr int LDS_CTL = LDS_BYTES - 256;

constexpr size_t al256(size_t x) { return (x + 255) / 256 * 256; }
constexpr size_t WS_CTL = 0, CTL_BYTES = 1u << 20;
constexpr size_t WS_MODP = WS_CTL + CTL_BYTES;
constexpr size_t WS_MOD = WS_MODP + al256((size_t)8 * 2 * 4 * NADA * 4);
constexpr size_t WS_RT = WS_MOD + al256((size_t)4 * 2 * NADA * 4);
constexpr size_t WS_AXR = WS_RT + al256((size_t)NLAT * 64 * 8);
constexpr size_t WS_AXC = WS_AXR + al256(256 * 16 * 8);
constexpr size_t WS_STAT = WS_AXC + al256(64 * 16 * 8);
constexpr size_t WS_WFI = WS_STAT + al256((size_t)T * 8);
constexpr size_t SZ_WFI = (size_t)2 * DFF * DM * 2;
constexpr size_t WS_WFO = WS_WFI + 8 * SZ_WFI;
constexpr size_t SZ_WFO = (size_t)DM * DFF * 2;
constexpr size_t WS_EWI = WS_WFO + 8 * SZ_WFO;
constexpr size_t SZ_EWI = (size_t)EV_N * DM * 2;
constexpr size_t WS_EWO = WS_EWI + 2 * SZ_EWI;
constexpr size_t SZ_SQ = (size_t)DM * DM * 2;
constexpr size_t WS_OWI = WS_EWO + 2 * SZ_SQ;
constexpr size_t SZ_OWI = (size_t)OD_N * DM * 2;
constexpr size_t WS_OUQ = WS_OWI + 2 * SZ_OWI;
constexpr size_t SZ_OUQ = (size_t)3072 * 512 * 2;
constexpr size_t WS_OUKV = WS_OUQ + 2 * SZ_OUQ;
constexpr size_t SZ_OUKV = (size_t)4096 * 512 * 2;
constexpr size_t WS_OWO = WS_OUKV + 2 * SZ_OUKV;
constexpr size_t WS_X = WS_OWO + 2 * SZ_SQ;
constexpr size_t WS_H = WS_X + (size_t)T * DM * 4;
constexpr size_t WS_HID = WS_H + (size_t)T * DM * 2;
constexpr size_t WS_MIX = WS_HID + (size_t)T * DFF * 2;
constexpr size_t WS_PROJ = WS_MIX + (size_t)T * DM * 2;
constexpr size_t WS_U = WS_PROJ + (size_t)T * EV_N * 2;
constexpr size_t SZ_U = (size_t)2 * 8 * NCH * 256 * 128 * 2;
constexpr size_t WS_S = WS_U + SZ_U;
constexpr size_t WS_OI = WS_S + SZ_U;
constexpr size_t WS_QT = WS_OI + (size_t)T * DM * 4;
constexpr size_t WS_DEC = WS_QT + (size_t)2 * T * 1024 * 2;
constexpr size_t WS_END_EVEN = WS_DEC + al256((size_t)2 * 8 * NCH * 128 * 4);
constexpr size_t WS_CQN = WS_U;
constexpr size_t WS_CKVN = WS_CQN + (size_t)T * 512 * 2;
constexpr size_t WS_KR = WS_CKVN + (size_t)T * 512 * 2;
constexpr size_t WS_QB = WS_KR + al256((size_t)T * 64 * 2);
constexpr size_t WS_KVB = WS_QB + (size_t)T * 3072 * 2;
constexpr size_t WS_END_ODD = WS_KVB + (size_t)T * 4096 * 2;
constexpr size_t WS_END = WS_END_EVEN > WS_END_ODD ? WS_END_EVEN : WS_END_ODD;

#define RLX_AGENT __ATOMIC_RELAXED, __HIP_MEMORY_SCOPE_AGENT
#define LDS_WAIT() asm volatile("s_waitcnt lgkmcnt(0)" ::: "memory")
#define VM_WAIT() asm volatile("s_waitcnt vmcnt(0)" ::: "memory")
__device__ __forceinline__ unsigned cvt_pk_bf16(float lo, float hi) { unsigned r; asm volatile("v_cvt_pk_bf16_f32 %0, %1, %2" : "=v"(r) : "v"(lo), "v"(hi)); return r; }
__device__ __forceinline__ float bflo(unsigned w) { return __uint_as_float(w << 16); }
__device__ __forceinline__ float bfhi(unsigned w) { return __uint_as_float(w & 0xffff0000u); }
__device__ __forceinline__ float bf2f(bf16 b) { return __uint_as_float(((unsigned)b) << 16); }
__device__ __forceinline__ bf16 f2bf(float f) { return (bf16)(cvt_pk_bf16(f, 0.f) & 0xffffu); }
__device__ __forceinline__ float wave_sum(float v) {
#pragma unroll
    for (int o = 1; o < 64; o <<= 1) v += __shfl_xor(v, o);
    return v;
}
__device__ __forceinline__ float silu_f(float g) { return g * __builtin_amdgcn_rcpf(1.0f + __builtin_amdgcn_exp2f(-1.4426950408889634f * g)); }

namespace pg8 {
#define PG8_LAS __attribute__((address_space(3)))
typedef unsigned short bf16_t;
constexpr int BM = 256, BK = 64, HALF = 128, HTB = HALF * BK * 2, STAGE_BYTES = 8 * HTB, NXCD = 8, WGM = 8;
__host__ __device__ __forceinline__ int lds_byte(int r, int c) { const int st = (r >> 4) * 2 + (c >> 5), rr = r & 15, cc = c & 31, ob = rr * 64 + cc * 2; return st * 1024 + (ob ^ (((ob >> 9) & 1) << 5)); }
__host__ __device__ __forceinline__ void stage_rc(int b, int& R, int& C) { const int st = b / 1024, sb = b % 1024, swz = sb ^ (((sb >> 9) & 1) << 5); R = (st >> 1) * 16 + swz / 64; C = (st & 1) * 32 + (swz % 64) / 2; }
__host__ __device__ __forceinline__ int perm32(int rho) { const int n = rho >> 4, i = rho & 15; return 8 * (i >> 2) + 4 * n + (i & 3); }
struct Unit { int pm, pn; };
struct Gemm { const bf16_t* A; const bf16_t* Bt; int M, N, K, lda, ldb; };
struct StaticOrder {
    int nM, nN, nwg, G, c;
    __host__ __device__ void init(int M, int N, int G_, int c_) { nM = M / BM; nN = N / BM; nwg = nM * nN; G = G_; c = c_; }
    __host__ __device__ bool next(int i, Unit& u) const {
        const long L = (long)i * G + c; if (L >= nwg) return false;
        int wgid = (int)L; { const int q = nwg / NXCD, r = nwg % NXCD, xcd = wgid % NXCD, off = wgid / NXCD; wgid = (xcd < r ? xcd * (q + 1) : r * (q + 1) + (xcd - r) * q) + off; }
        const int nig = WGM * nN, gid = wgid / nig, fm = gid * WGM, gsz = (nM - fm) < WGM ? (nM - fm) : WGM;
        u.pm = fm + ((wgid % nig) % gsz); u.pn = (wgid % nig) / gsz; return true;
    }
    __device__ __forceinline__ void a_ready(const Unit&) const {}
    __device__ __forceinline__ void done(const Unit&) const {}
};
struct EpiBf16 {
    static constexpr bool PERM = true;
    bf16_t* O; int ldc;
    __device__ __forceinline__ void operator()(const f32x4 (&acc)[2][2][4][2], const Unit& u, int wr, int wc, int fr, int fq) const {
        const int row0 = u.pm * BM + wr * 64 + fr, col0 = u.pn * BM + wc * 32 + 8 * fq;
        asm volatile("s_nop 15" ::: "memory");
#pragma unroll
        for (int ai = 0; ai < 2; ++ai)
#pragma unroll
            for (int m = 0; m < 4; ++m) { bf16_t* rowp = O + (size_t)(row0 + ai * HALF + m * 16) * ldc + col0;
#pragma unroll
                for (int bj = 0; bj < 2; ++bj) { const f32x4 v0 = acc[ai][bj][m][0], v1 = acc[ai][bj][m][1];
                    u32x4 w; w.x = cvt_pk_bf16(v0[0], v0[1]); w.y = cvt_pk_bf16(v0[2], v0[3]); w.z = cvt_pk_bf16(v1[0], v1[1]); w.w = cvt_pk_bf16(v1[2], v1[3]);
                    *(u32x4*)(rowp + bj * HALF) = w; } }
    }
};
struct EpiSwiGLU {
    static constexpr bool PERM = true;
    bf16_t* O; int ldc;
    __device__ __forceinline__ void operator()(const f32x4 (&acc)[2][2][4][2], const Unit& u, int wr, int wc, int fr, int fq) const {
        const int row0 = u.pm * BM + wr * 64 + fr, col0 = u.pn * HALF + wc * 32 + 8 * fq;
#pragma unroll
        for (int ai = 0; ai < 2; ++ai)
#pragma unroll
            for (int m = 0; m < 4; ++m) { bf16_t* rowp = O + (size_t)(row0 + ai * HALF + m * 16) * ldc + col0;
                float h[8];
#pragma unroll
                for (int n = 0; n < 2; ++n)
#pragma unroll
                    for (int j = 0; j < 4; ++j) h[n * 4 + j] = silu_f(acc[ai][0][m][n][j]) * acc[ai][1][m][n][j];
                u32x4 w; w.x = cvt_pk_bf16(h[0], h[1]); w.y = cvt_pk_bf16(h[2], h[3]); w.z = cvt_pk_bf16(h[4], h[5]); w.w = cvt_pk_bf16(h[6], h[7]);
                *(u32x4*)rowp = w; asm volatile("" ::: "memory"); }
    }
};
struct EpiResid {
    static constexpr bool PERM = true;
    float* X; const float* gv; float gs; const float* stat; const float* lng; const float* lnb; int has_ln;
    __device__ __forceinline__ void operator()(const f32x4 (&acc)[2][2][4][2], const Unit& u, int wr, int wc, int fr, int fq) const {
        const int row0 = u.pm * BM + wr * 64 + fr, col0 = u.pn * BM + wc * 32 + 8 * fq;
        f32x2 st[2][4];
#pragma unroll
        for (int ai = 0; ai < 2; ++ai)
#pragma unroll
            for (int m = 0; m < 4; ++m) { st[ai][m] = has_ln ? *(const f32x2*)(stat + (size_t)(row0 + ai * HALF + m * 16) * 2) : (f32x2){0.f, 1.f}; st[ai][m].y *= DN_ALPHA; }
#pragma unroll
        for (int bj = 0; bj < 2; ++bj) { const int c = col0 + bj * HALF;
            f32x4 g[2], G[2], B[2];
#pragma unroll
            for (int n = 0; n < 2; ++n) { g[n] = *(const f32x4*)(gv + c + 4 * n) * gs;
                G[n] = has_ln ? *(const f32x4*)(lng + c + 4 * n) : (f32x4){1.f, 1.f, 1.f, 1.f}; B[n] = has_ln ? *(const f32x4*)(lnb + c + 4 * n) * DN_ALPHA : (f32x4){0.f, 0.f, 0.f, 0.f}; }
#pragma unroll
            for (int ai = 0; ai < 2; ++ai)
#pragma unroll
                for (int m = 0; m < 4; ++m) { float* p = X + (size_t)(row0 + ai * HALF + m * 16) * DM + c;
                    const f32x4 z0 = *(const f32x4*)p, z1 = *(const f32x4*)(p + 4);
                    *(f32x4*)p = (z0 - st[ai][m].x) * st[ai][m].y * G[0] + B[0] + g[0] * acc[ai][bj][m][0];
                    *(f32x4*)(p + 4) = (z1 - st[ai][m].x) * st[ai][m].y * G[1] + B[1] + g[1] * acc[ai][bj][m][1]; }
            asm volatile("" ::: "memory"); }
    }
};

template <class Epi, class Sched, bool ALIGN_EPI = true, bool SP2 = true>
__device__ __forceinline__ void gemm_phase(PG8_LAS unsigned char* lds, const Gemm g, const Sched& S, const Epi& E) {
    int tid = threadIdx.x; asm volatile("" : "+v"(tid));
    const int wid = __builtin_amdgcn_readfirstlane(tid >> 6), lane = tid & 63, wr = wid >> 2, wc = wid & 3, fr = lane & 15, fq = lane >> 4;
    const int K = g.K, nt = K / BK;
    unsigned voffA[2], voffB[2];
#pragma unroll
    for (int i = 0; i < 2; ++i) { int R, C; stage_rc(tid * 16 + i * 8192, R, C); const int Rb = Epi::PERM ? ((R & ~31) + perm32(R & 31)) : R;
        voffA[i] = (unsigned)(R * g.lda + C) * 2u; voffB[i] = (unsigned)(Rb * g.ldb + C) * 2u; }
    const size_t kstep = (size_t)(BK * 2);
    const size_t hstepA = (size_t)HALF * g.lda * 2, hstepB = (size_t)HALF * g.ldb * 2;
    const size_t tstepA = 2 * hstepA, tstepB = 2 * hstepB;
    const unsigned ldsw = (unsigned)wid * 1024u;
    const int aoff = lds_byte(wr * 64 + fr, fq * 8), boff = lds_byte(wc * 32 + fr, fq * 8);
#define PG8_SA(b, h) (((b) * 2 + (h)) * HTB)
#define PG8_SB(b, h) ((4 + (b) * 2 + (h)) * HTB)
#define PG8_STAGE(bufoff, gbase, voff) do { _Pragma("unroll") for (int _i = 0; _i < 2; ++_i) \
        __builtin_amdgcn_global_load_lds((const unsigned*)((const char*)(gbase) + (voff)[_i]), (PG8_LAS unsigned*)(lds + (bufoff) + ldsw + _i * 8192), 16, 0, 0); } while (0)
#define PG8_LDA(dst, b, h) do { _Pragma("unroll") for (int m = 0; m < 4; ++m) _Pragma("unroll") for (int k = 0; k < 2; ++k) dst[m][k] = *(const PG8_LAS bf16x8*)(lds + PG8_SA(b, h) + aoff + m * 2048 + k * 1024); } while (0)
#define PG8_LDB(dst, b, h) do { _Pragma("unroll") for (int n = 0; n < 2; ++n) _Pragma("unroll") for (int k = 0; k < 2; ++k) dst[n][k] = *(const PG8_LAS bf16x8*)(lds + PG8_SB(b, h) + boff + n * 2048 + k * 1024); } while (0)
#define PG8_MMA(ai, bj, At, Bt) do { __builtin_amdgcn_s_setprio(1); _Pragma("unroll") for (int m = 0; m < 4; ++m) _Pragma("unroll") for (int n = 0; n < 2; ++n) _Pragma("unroll") for (int k = 0; k < 2; ++k) \
        acc[ai][bj][m][n] = __builtin_amdgcn_mfma_f32_16x16x32_bf16(Bt[n][k], At[m][k], acc[ai][bj][m][n], 0, 0, 0); __builtin_amdgcn_s_setprio(0); } while (0)
#define PG8_WAIT_V(n) asm volatile("s_waitcnt vmcnt(" #n ")" ::: "memory")
#define PG8_WAIT_L(n) asm volatile("s_waitcnt lgkmcnt(" #n ")" ::: "memory")
#define PG8_BAR __builtin_amdgcn_s_barrier()
#define PG8_SCHED __builtin_amdgcn_sched_barrier(0)
    Unit cur, nxt; int ui = 0;
    if (!S.next(0, cur)) return;
    f32x4 acc[2][2][4][2];
#pragma unroll
    for (int a = 0; a < 2; ++a)
#pragma unroll
        for (int b = 0; b < 2; ++b)
#pragma unroll
            for (int m = 0; m < 4; ++m)
#pragma unroll
                for (int n = 0; n < 2; ++n) acc[a][b][m][n] = (f32x4){0.f, 0.f, 0.f, 0.f};
    bf16x8 At[4][2], B0[2][2], B1[2][2];
    const char* cA = (const char*)g.A + (size_t)cur.pm * tstepA; const char* cB = (const char*)g.Bt + (size_t)cur.pn * tstepB;
    S.a_ready(cur);
    if constexpr (SP2) {
        PG8_STAGE(PG8_SB(0, 0), cB, voffB); PG8_STAGE(PG8_SB(0, 1), cB + hstepB, voffB); PG8_STAGE(PG8_SA(0, 0), cA, voffA); PG8_STAGE(PG8_SA(0, 1), cA + hstepA, voffA);
        if (wr == 1) PG8_BAR;
        PG8_WAIT_V(2); PG8_BAR;
        PG8_STAGE(PG8_SB(1, 0), cB + kstep, voffB); PG8_STAGE(PG8_SA(1, 0), cA + kstep, voffA); PG8_STAGE(PG8_SB(1, 1), cB + hstepB + kstep, voffB);
        PG8_WAIT_V(6); PG8_BAR;
    } else {
        PG8_STAGE(PG8_SB(0, 0), cB, voffB); PG8_STAGE(PG8_SA(0, 0), cA, voffA); PG8_STAGE(PG8_SB(0, 1), cB + hstepB, voffB); PG8_STAGE(PG8_SA(0, 1), cA + hstepA, voffA);
        if (wr == 1) PG8_BAR;
        PG8_WAIT_V(4); PG8_BAR;
        PG8_STAGE(PG8_SB(1, 0), cB + kstep, voffB); PG8_STAGE(PG8_SA(1, 0), cA + kstep, voffA); PG8_STAGE(PG8_SB(1, 1), cB + hstepB + kstep, voffB);
        PG8_WAIT_V(6); PG8_BAR;
    }
    for (;;) {
        const bool has_next = S.next(ui + 1, nxt);
        const char* nA = has_next ? (const char*)g.A + (size_t)nxt.pm * tstepA : cA; const char* nB = has_next ? (const char*)g.Bt + (size_t)nxt.pn * tstepB : cB;
        for (int t = 0; t < nt; t += 2) {
            const bool last = (t == nt - 2);
            const char* a1 = cA + (size_t)(t + 1) * kstep;
            const char* a2 = last ? nA : cA + (size_t)(t + 2) * kstep; const char* b2 = last ? nB : cB + (size_t)(t + 2) * kstep;
            const char* a3 = a2 + kstep; const char* b3 = b2 + kstep;
            if (last && has_next) S.a_ready(nxt);
            if constexpr (SP2) {
            PG8_LDB(B0, 0, 0); PG8_LDB(B1, 0, 1); PG8_SCHED; PG8_LDA(At, 0, 0); PG8_STAGE(PG8_SA(1, 1), a1 + hstepA, voffA);
            PG8_WAIT_V(8); PG8_WAIT_L(0); PG8_BAR; PG8_MMA(0, 0, At, B0); PG8_MMA(0, 1, At, B1); PG8_BAR; PG8_SCHED;
            PG8_LDA(At, 0, 1); PG8_STAGE(PG8_SB(0, 0), b2, voffB); PG8_STAGE(PG8_SB(0, 1), b2 + hstepB, voffB); PG8_STAGE(PG8_SA(0, 0), a2, voffA);
            PG8_WAIT_V(8); PG8_WAIT_L(0); PG8_BAR; PG8_MMA(1, 0, At, B0); PG8_MMA(1, 1, At, B1); PG8_BAR; PG8_SCHED;
            PG8_LDB(B0, 1, 0); PG8_LDB(B1, 1, 1); PG8_SCHED; PG8_LDA(At, 1, 0); PG8_STAGE(PG8_SA(0, 1), a2 + hstepA, voffA);
            PG8_WAIT_V(8); PG8_WAIT_L(0); PG8_BAR; PG8_MMA(0, 0, At, B0); PG8_MMA(0, 1, At, B1); PG8_BAR; PG8_SCHED;
            PG8_LDA(At, 1, 1); PG8_STAGE(PG8_SB(1, 0), b3, voffB); PG8_STAGE(PG8_SB(1, 1), b3 + hstepB, voffB); PG8_STAGE(PG8_SA(1, 0), a3, voffA);
            PG8_WAIT_V(8); PG8_WAIT_L(0); PG8_BAR; PG8_MMA(1, 0, At, B0); PG8_MMA(1, 1, At, B1); PG8_BAR; PG8_SCHED;
            } else {
            PG8_LDB(B0, 0, 0); PG8_SCHED; PG8_LDA(At, 0, 0); PG8_STAGE(PG8_SA(1, 1), a1 + hstepA, voffA);
            PG8_WAIT_L(8); PG8_BAR; PG8_WAIT_L(0); PG8_MMA(0, 0, At, B0); PG8_BAR; PG8_SCHED;
            PG8_LDB(B1, 0, 1); PG8_STAGE(PG8_SB(0, 0), b2, voffB);
            PG8_BAR; PG8_WAIT_L(0); PG8_MMA(0, 1, At, B1); PG8_BAR;
            PG8_LDA(At, 0, 1); PG8_STAGE(PG8_SA(0, 0), a2, voffA);
            PG8_BAR; PG8_WAIT_L(0); PG8_MMA(1, 0, At, B0); PG8_BAR; PG8_SCHED;
            PG8_STAGE(PG8_SB(0, 1), b2 + hstepB, voffB);
            PG8_WAIT_V(6); PG8_BAR; PG8_MMA(1, 1, At, B1); PG8_BAR;
            PG8_LDB(B0, 1, 0); PG8_SCHED; PG8_LDA(At, 1, 0); PG8_STAGE(PG8_SA(0, 1), a2 + hstepA, voffA);
            PG8_WAIT_L(8); PG8_BAR; PG8_WAIT_L(0); PG8_MMA(0, 0, At, B0); PG8_BAR; PG8_SCHED;
            PG8_LDB(B1, 1, 1); PG8_STAGE(PG8_SB(1, 0), b3, voffB);
            PG8_BAR; PG8_WAIT_L(0); PG8_MMA(0, 1, At, B1); PG8_BAR;
            PG8_LDA(At, 1, 1); PG8_STAGE(PG8_SA(1, 0), a3, voffA);
            PG8_BAR; PG8_WAIT_L(0); PG8_MMA(1, 0, At, B0); PG8_BAR; PG8_SCHED;
            PG8_STAGE(PG8_SB(1, 1), b3 + hstepB, voffB);
            PG8_WAIT_V(6); PG8_BAR; PG8_MMA(1, 1, At, B1); PG8_BAR;
            }
        }
        if constexpr (ALIGN_EPI) { if (wr == 0) PG8_BAR; }
        E(acc, cur, wr, wc, fr, fq); S.done(cur);
        if (!has_next) break;
#pragma unroll
        for (int a = 0; a < 2; ++a)
#pragma unroll
            for (int b = 0; b < 2; ++b)
#pragma unroll
                for (int m = 0; m < 4; ++m)
#pragma unroll
                    for (int n = 0; n < 2; ++n) acc[a][b][m][n] = (f32x4){0.f, 0.f, 0.f, 0.f};
        cur = nxt; cA = nA; cB = nB; ++ui;
        if constexpr (ALIGN_EPI) { if (wr == 1) PG8_BAR; }
    }
    PG8_WAIT_V(0);
    if constexpr (!ALIGN_EPI) { if (wr == 0) PG8_BAR; }
    PG8_BAR;
#undef PG8_SA
#undef PG8_SB
#undef PG8_STAGE
#undef PG8_LDA
#undef PG8_LDB
#undef PG8_MMA
#undef PG8_WAIT_V
#undef PG8_WAIT_L
#undef PG8_BAR
#undef PG8_SCHED
}
}

#define XB_TMO      128
#define XB_XCNT(j)  (256  + 64 * (j))
#define XB_XSUB(j)  (1280 + 64 * (j))
#define XB_XGEN(j)  (2304 + 64 * (j))
#define XB_TOP      3328
#define XB_TOPGEN   3392
#define XCD_BAR_WORDS 3456
#define XB_SPIN_CAP (1u << 18)
__device__ __forceinline__ unsigned xb_ld(unsigned* p)              { return __hip_atomic_load(p, __ATOMIC_RELAXED, __HIP_MEMORY_SCOPE_AGENT); }
__device__ __forceinline__ unsigned xb_add(unsigned* p, unsigned v) { return __hip_atomic_fetch_add(p, v, __ATOMIC_RELAXED, __HIP_MEMORY_SCOPE_AGENT); }
__device__ __forceinline__ unsigned xb_xcc_id() { return (unsigned)__builtin_amdgcn_s_getreg((3 << 11) | 20) & 0xFu; }
#define XB_SPIN(cond, bar) do { unsigned _sp = 0; while (cond) { __builtin_amdgcn_s_sleep(1); \
    if ((++_sp & 255u) == 0u) { if (xb_ld(&(bar)[XB_TMO])) break; if (_sp > XB_SPIN_CAP) { atomicAdd(&(bar)[XB_TMO], 1u); break; } } } } while (0)
struct XcdBarrier { unsigned* bar; unsigned x; volatile LAS unsigned* st; };
__device__ __forceinline__ XcdBarrier xcd_barrier_post(unsigned* bar, volatile LAS unsigned* st) {
    XcdBarrier b; b.bar = bar; b.x = xb_xcc_id(); b.st = st;
    if (threadIdx.x == 0) (void)xb_add(&bar[XB_XCNT(b.x)], 1u);
    return b;
}
__device__ __forceinline__ void xcd_barrier_complete(unsigned* bar, unsigned x, unsigned& nloc, unsigned& nx) {
    const unsigned G = gridDim.x * gridDim.y * gridDim.z;
    unsigned sum, cnt, mine, sp = 0u;
    for (;;) {
        sum = 0u; cnt = 0u; mine = 0u;
#pragma unroll
        for (unsigned j = 0; j < 16; ++j) { const unsigned c = xb_ld(&bar[XB_XCNT(j)]); sum += c; cnt += (c > 0u) ? 1u : 0u; mine = (j == x) ? c : mine; }
        if (sum == G) break;
        __builtin_amdgcn_s_sleep(1);
        if ((++sp & 255u) == 0u) { if (xb_ld(&bar[XB_TMO])) break; if (sp > XB_SPIN_CAP) { atomicAdd(&bar[XB_TMO], 1u); break; } }
    }
    nloc = mine > 0u ? mine : 1u; nx = cnt > 0u ? cnt : 1u;
}
__device__ __forceinline__ void xcd_barrier(const XcdBarrier& b0) {
    asm volatile("s_waitcnt vmcnt(0)" ::: "memory");
    __syncthreads();
    if (threadIdx.x == 0) {
        XcdBarrier b = b0; b.x = xb_xcc_id();
        unsigned* bar = b.bar;
        __builtin_amdgcn_s_waitcnt(0);
        unsigned nloc = b.st[0], nx = b.st[1];
        if (nloc == 0u) { xcd_barrier_complete(bar, b.x, nloc, nx); b.st[0] = nloc; b.st[1] = nx; }
        const unsigned old = xb_add(&bar[XB_XSUB(b.x)], 1u);
        const unsigned gen = old / nloc;
        if (old + 1u == (gen + 1u) * nloc) {
            __builtin_amdgcn_fence(__ATOMIC_RELEASE, "agent");
            asm volatile("s_waitcnt vmcnt(0)" ::: "memory");
            const unsigned og = xb_add(&bar[XB_TOP], 1u);
            const unsigned tg = og / nx;
            if (og + 1u == (tg + 1u) * nx) xb_add(&bar[XB_TOPGEN], 1u);
            else XB_SPIN(xb_ld(&bar[XB_TOPGEN]) == tg, bar);
            __builtin_amdgcn_fence(__ATOMIC_ACQUIRE, "agent");
            xb_add(&bar[XB_XGEN(b.x)], 1u);
            asm volatile("s_waitcnt vmcnt(0)" ::: "memory");
        } else {
            XB_SPIN(xb_ld(&bar[XB_XGEN(b.x)]) == gen, bar);
            __builtin_amdgcn_fence(__ATOMIC_ACQUIRE, "agent");
            asm volatile("s_waitcnt vmcnt(0)" ::: "memory");
        }
    }
    __syncthreads();
}

struct Args { const float* in[23]; float* out; unsigned char* ws; };
struct Frame {
    LAS unsigned char* lds;
    int vcu, G;
    const Args* a; unsigned char* ws;
};
#define PHASE_IDS() int tid = threadIdx.x; asm volatile("" : "+v"(tid)); const int lane = tid & 63, wave = __builtin_amdgcn_readfirstlane(tid >> 6); (void)lane; (void)wave
#define MFMA16(a, b, c) __builtin_amdgcn_mfma_f32_16x16x32_bf16((a), (b), (c), 0, 0, 0)
#define MFMA32(a, b, c) __builtin_amdgcn_mfma_f32_32x32x16_bf16((a), (b), (c), 0, 0, 0)

constexpr float ATT_QSCALE = 0.07216878364870322f * 1.4426950408889634f;
__device__ __forceinline__ void tr_item(const float* W, int N, int K, bf16* WT, int k0, int n0, int drow0, LAS float* scr, int lane, float sc = 1.0f) {
#pragma unroll 8
    for (int i = 0; i < 32; ++i) { const int kk = 2 * i + (lane >> 5); scr[kk * 33 + (lane & 31)] = W[(size_t)(k0 + kk) * N + n0 + (lane & 31)]; }
    LDS_WAIT(); asm volatile("" ::: "memory");
    const int c = lane & 7;
#pragma unroll
    for (int j = 0; j < 4; ++j) { const int n = (lane >> 3) + 8 * j; const LAS float* s = scr + (8 * c) * 33 + n;
        u32x4 o; o.x = cvt_pk_bf16(s[0 * 33] * sc, s[1 * 33] * sc); o.y = cvt_pk_bf16(s[2 * 33] * sc, s[3 * 33] * sc); o.z = cvt_pk_bf16(s[4 * 33] * sc, s[5 * 33] * sc); o.w = cvt_pk_bf16(s[6 * 33] * sc, s[7 * 33] * sc);
        *(u32x4*)(WT + (size_t)(drow0 + n) * K + k0 + 8 * c) = o; }
    LDS_WAIT(); asm volatile("" ::: "memory");
}
__device__ __forceinline__ void p0a(Frame& F) {
    PHASE_IDS();
    LAS float* scr = (LAS float*)(F.lds + wave * 8704);
    LAS float* sv = (LAS float*)(F.lds + 8 * 8704);
    for (int i = tid; i < 2 * DM; i += NTHR) { const float v = (i < DM) ? F.a->in[1][i] : F.a->in[3][i - DM]; sv[i] = v / (1.0f + __expf(-v)); }
    __syncthreads();
    const int gw = F.vcu * NWAVES + wave, NGW = F.G * NWAVES;
    constexpr int I0 = 8 * 32 * 344, I1 = 8 * 86 * 64, I2 = 2 * 32 * 193, I3 = 2 * 32 * 64, I4 = 2 * 32 * 34, I5 = 2 * 8 * 96, I6 = 2 * 8 * 128, I7 = 2 * 32 * 64;
    constexpr int NTR = I0 + I1 + I2 + I3 + I4 + I5 + I6 + I7, NADAI = 8 * 288;
    for (int it = gw; it < NTR + NADAI; it += NGW) {
        int r = it;
        if (r < I0) { const int mat = r / 11008, q = r % 11008, kb = q / 344, nb = q % 344, n0 = nb * 32;
            const int j = n0 < DFF ? n0 : n0 - DFF, drow = (j / 128) * 256 + (j % 128) + (n0 < DFF ? 0 : 128);
            tr_item(F.a->in[8] + (size_t)mat * DM * 2 * DFF, 2 * DFF, DM, (bf16*)(F.ws + WS_WFI + mat * SZ_WFI), kb * 64, n0, drow - 0, scr, lane); continue; } r -= I0;
        if (r < I1) { const int mat = r / 5504, q = r % 5504, kb = q / 64, nb = q % 64;
            tr_item(F.a->in[9] + (size_t)mat * DFF * DM, DM, DFF, (bf16*)(F.ws + WS_WFO + mat * SZ_WFO), kb * 64, nb * 32, nb * 32, scr, lane); continue; } r -= I1;
        if (r < I2) { const int mat = r / 6176, q = r % 6176, kb = q / 193, nb = q % 193, n0 = nb * 32;
            const int drow = n0 < 3072 ? n0 : (n0 < 3104 ? 6144 : n0 - 32);
            tr_item(F.a->in[10] + (size_t)mat * DM * 6176, 6176, DM, (bf16*)(F.ws + WS_EWI + mat * SZ_EWI), kb * 64, n0, drow, scr, lane); continue; } r -= I2;
        if (r < I3) { const int mat = r / 2048, q = r % 2048, kb = q / 64, nb = q % 64;
            tr_item(F.a->in[16] + (size_t)mat * DM * DM, DM, DM, (bf16*)(F.ws + WS_EWO + mat * SZ_SQ), kb * 64, nb * 32, nb * 32, scr, lane); continue; } r -= I3;
        if (r < I4) { const int mat = r / 1088, q = r % 1088, kb = q / 34, nb = q % 34;
            tr_item(F.a->in[17] + (size_t)mat * DM * 1088, 1088, DM, (bf16*)(F.ws + WS_OWI + mat * SZ_OWI), kb * 64, nb * 32, nb * 32, scr, lane); continue; } r -= I4;
        if (r < I5) { const int mat = r / 768, q = r % 768, kb = q / 96, nb = q % 96;
            tr_item(F.a->in[20] + (size_t)mat * 512 * 3072, 3072, 512, (bf16*)(F.ws + WS_OUQ + mat * SZ_OUQ), kb * 64, nb * 32, nb * 32, scr, lane, ATT_QSCALE); continue; } r -= I5;
        if (r < I6) { const int mat = r / 1024, q = r % 1024, kb = q / 128, nb = q % 128;
            tr_item(F.a->in[21] + (size_t)mat * 512 * 4096, 4096, 512, (bf16*)(F.ws + WS_OUKV + mat * SZ_OUKV), kb * 64, nb * 32, nb * 32, scr, lane); continue; } r -= I6;
        if (r < I7) { const int mat = r / 2048, q = r % 2048, kb = q / 64, nb = q % 64;
            tr_item(F.a->in[22] + (size_t)mat * DM * DM, DM, DM, (bf16*)(F.ws + WS_OWO + mat * SZ_SQ), kb * 64, nb * 32, nb * 32, scr, lane); continue; } r -= I7;
        {
            const int ks = r / 288, cg = r % 288, l = cg / 72, n = (cg % 72) * 256 + lane * 4;
            const float* w = F.a->in[4] + ((size_t)l * DM + ks * 256) * NADA + n;
            f32x4 al = {0.f, 0.f, 0.f, 0.f}, ac = {0.f, 0.f, 0.f, 0.f};
#pragma unroll 8
            for (int k = 0; k < 256; ++k) { const f32x4 wv = *(const f32x4*)(w + (size_t)k * NADA); al += wv * sv[ks * 256 + k]; ac += wv * sv[DM + ks * 256 + k]; }
            float* mp = (float*)(F.ws + WS_MODP);
            *(f32x4*)(mp + (size_t)(ks * 2 + 0) * 4 * NADA + l * NADA + n) = al;
            *(f32x4*)(mp + (size_t)(ks * 2 + 1) * 4 * NADA + l * NADA + n) = ac;
        }
    }
    const int gt = F.vcu * NTHR + tid, NGT = F.G * NTHR;
    for (int i = gt; i < NLAT * 64 + 256 * 16 + 64 * 16; i += NGT) {
        int pos, fi; float inv; f32x2* dst;
        if (i < NLAT * 64) { pos = i >> 6; fi = i & 63; inv = __builtin_amdgcn_exp2f(-(float)fi * (13.287712379549449f / 64.0f)); dst = (f32x2*)(F.ws + WS_RT) + i; }
        else if (i < NLAT * 64 + 4096) { const int j = i - NLAT * 64; pos = j >> 4; fi = j & 15; inv = __builtin_amdgcn_exp2f(-(float)fi * (13.287712379549449f / 16.0f)); dst = (f32x2*)(F.ws + WS_AXR) + j; }
        else { const int j = i - NLAT * 64 - 4096; pos = j >> 4; fi = j & 15; inv = __builtin_amdgcn_exp2f(-(float)fi * (13.287712379549449f / 16.0f)); dst = (f32x2*)(F.ws + WS_AXC) + j; }
        const float ang = (float)pos * inv;
        double rev = (double)ang * 0.15915494309189535; rev -= __builtin_floor(rev);
        const float rv = (float)rev;
        *dst = (f32x2){__builtin_amdgcn_cosf(rv), __builtin_amdgcn_sinf(rv)};
    }
}
__device__ __forceinline__ void p0b(Frame& F) {
    PHASE_IDS();
    const int gt = F.vcu * NTHR + tid, NGT = F.G * NTHR;
    const float* mp = (const float*)(F.ws + WS_MODP); float* mo = (float*)(F.ws + WS_MOD);
    for (int i = gt; i < 4 * 2 * NADA; i += NGT) { const int l = i / (2 * NADA), v = (i / NADA) & 1, n = i % NADA;
        float s = F.a->in[5][l * NADA + n];
#pragma unroll
        for (int ks = 0; ks < 8; ++ks) s += mp[(size_t)(ks * 2 + v) * 4 * NADA + l * NADA + n];
        mo[i] = s; }
}
__device__ __forceinline__ const float* modp(Frame& F, int l, int v, int idx) { return (const float*)(F.ws + WS_MOD) + ((size_t)(l * 2 + v) * 9 + idx) * DM; }

template <int MODE>
__device__ __forceinline__ void row_phase(Frame& F, const float* lng, const float* lnb, const float* sh_l, const float* sc_l, const float* sh_c, const float* sc_c) {
    PHASE_IDS();
    LAS float* V = (LAS float*)F.lds;
    for (int i = tid; i < DM; i += NTHR) { if (MODE != 0) { V[i] = lng[i]; V[DM + i] = lnb[i]; } if (MODE != 2) { V[2 * DM + i] = sh_l[i]; V[3 * DM + i] = sc_l[i]; V[4 * DM + i] = sh_c[i]; V[5 * DM + i] = sc_c[i]; } }
    __syncthreads();
    const int gw = F.vcu * NWAVES + wave, NGW = F.G * NWAVES;
    float* X = (float*)(F.ws + WS_X); bf16* H = (bf16*)(F.ws + WS_H);
    for (int t = gw; t < T; t += NGW) {
        if (MODE == 2 && t < NCTX) continue;
        const float* src = (MODE == 0) ? (t < NCTX ? F.a->in[2] + (size_t)t * DM : F.a->in[0] + (size_t)(t - NCTX) * DM) : X + (size_t)t * DM;
        f32x4 v[8]; float s = 0.f; float mean_ = 0.f, rstd_ = 1.f;
#pragma unroll
        for (int j = 0; j < 8; ++j) { v[j] = *((const f32x4*)src + lane + 64 * j); s += (v[j].x + v[j].y) + (v[j].z + v[j].w); }
        if (MODE != 0) {
            const float mean = wave_sum(s) * (1.f / DM); float s2 = 0.f;
#pragma unroll
            for (int j = 0; j < 8; ++j) { v[j] = v[j] - mean; s2 += (v[j].x * v[j].x + v[j].y * v[j].y) + (v[j].z * v[j].z + v[j].w * v[j].w); }
            const float rstd = 1.f / sqrtf(wave_sum(s2) * (1.f / DM) + LN_EPS); mean_ = mean; rstd_ = rstd;
#pragma unroll
            for (int j = 0; j < 8; ++j) { const f32x4 g = *((const LAS f32x4*)V + lane + 64 * j), b = *((const LAS f32x4*)(V + DM) + lane + 64 * j); v[j] = v[j] * rstd * g + b; }
        }
        if (MODE == 1 && lane == 0) *(f32x2*)((float*)(F.ws + WS_STAT) + (size_t)t * 2) = (f32x2){mean_, rstd_};
        if (MODE == 2) {
            float* o = F.a->out + (size_t)(t - NCTX) * DM;
#pragma unroll
            for (int j = 0; j < 8; ++j) *((f32x4*)o + lane + 64 * j) = v[j];
        } else {
            float* o = X + (size_t)t * DM; bf16* h = H + (size_t)t * DM;
            const LAS float* shv = V + (t < NCTX ? 4 * DM : 2 * DM); const LAS float* scv = V + (t < NCTX ? 5 * DM : 3 * DM);
#pragma unroll
            for (int j = 0; j < 8; ++j) {
                const f32x4 sh = *((const LAS f32x4*)shv + lane + 64 * j), sc = *((const LAS f32x4*)scv + lane + 64 * j);
                const f32x4 m = v[j] * (sc + 1.0f) + sh; u32x2 w; w.x = cvt_pk_bf16(m.x, m.y); w.y = cvt_pk_bf16(m.z, m.w);
                *((u32x2*)h + lane + 64 * j) = w; }
        }
    }
    __syncthreads();
}


__device__ __forceinline__ void ctx_resid_small(Frame& F, float* X, const bf16* A, const bf16* Bt, int K, const float* gv, float gs, const float* stat, const float* lng, const float* lnb, int has_ln, int parity) {
    if ((int)(blockIdx.x & 1) != parity) return;
    PHASE_IDS(); const int fr = lane & 15, fq = lane >> 4;
    const int nks = K >> 5, last = wave + 8 * ((nks - 1 - wave) >> 3), trips = (((nks + 7) >> 3) + 3) & ~3;
    for (int item = blockIdx.x; item < 256; item += F.G) {
        const int mt = item >> 5, nt = item & 31;
        f32x4 acc[2][4];
#pragma unroll
        for (int i = 0; i < 2; ++i)
#pragma unroll
            for (int j = 0; j < 4; ++j) acc[i][j] = (f32x4){0.f, 0.f, 0.f, 0.f};
        const bf16* Ap = A + (size_t)(32 * mt + fr) * K + 8 * fq;
        const bf16* Bp = Bt + (size_t)(64 * nt + fr) * K + 8 * fq;
        bf16x8 a0[2], b0[4], a1[2], b1[4], a2[2], b2[4], a3[2], b3[4];
#define CS_LOAD(a, b, i_) do { const int so_ = 32 * min(wave + 8 * (i_), last); _Pragma("unroll") for (int i = 0; i < 2; ++i) a[i] = *(const bf16x8*)(Ap + (size_t)(16 * i) * K + so_); \
        _Pragma("unroll") for (int i = 0; i < 4; ++i) b[i] = *(const bf16x8*)(Bp + (size_t)(16 * i) * K + so_); } while (0)
#define CS_MMA(a, b, i_) do { __builtin_amdgcn_sched_barrier(0); if (wave + 8 * (i_) < nks) { _Pragma("unroll") for (int i = 0; i < 2; ++i) _Pragma("unroll") for (int j = 0; j < 4; ++j) acc[i][j] = MFMA16(a[i], b[j], acc[i][j]); } __builtin_amdgcn_sched_barrier(0); } while (0)
        CS_LOAD(a0, b0, 0); CS_LOAD(a1, b1, 1); CS_LOAD(a2, b2, 2);
        for (int it = 0; it < trips; it += 4) {
            CS_LOAD(a3, b3, it + 3); CS_MMA(a0, b0, it);
            CS_LOAD(a0, b0, it + 4); CS_MMA(a1, b1, it + 1);
            CS_LOAD(a1, b1, it + 5); CS_MMA(a2, b2, it + 2);
            CS_LOAD(a2, b2, it + 6); CS_MMA(a3, b3, it + 3);
        }
#undef CS_LOAD
#undef CS_MMA
        LAS float* P = (LAS float*)F.lds + wave * 2048;
#pragma unroll
        for (int i = 0; i < 2; ++i)
#pragma unroll
            for (int j = 0; j < 4; ++j)
#pragma unroll
                for (int r = 0; r < 4; ++r) P[(16 * i + 4 * fq + r) * 64 + 16 * j + fr] = acc[i][j][r];
        __syncthreads();
        const int row = tid >> 4, c0 = (tid & 15) * 4;
        f32x4 s0 = {0.f, 0.f, 0.f, 0.f};
#pragma unroll
        for (int w = 0; w < 8; ++w) s0 += *(const LAS f32x4*)((LAS float*)F.lds + w * 2048 + row * 64 + c0);
        float* xp = X + (size_t)(32 * mt + row) * DM + 64 * nt + c0;
        const f32x4 g0 = *(const f32x4*)(gv + 64 * nt + c0) * gs;
        f32x4 x0 = *(const f32x4*)xp;
        if (has_ln) { const f32x2 st = *(const f32x2*)(stat + (size_t)(32 * mt + row) * 2); x0 = (x0 - st.x) * st.y * *(const f32x4*)(lng + 64 * nt + c0) + *(const f32x4*)(lnb + 64 * nt + c0); }
        *(f32x4*)xp = x0 * DN_ALPHA + g0 * s0;
        __syncthreads();
    }
}


__device__ __forceinline__ void init_x_by_owners(Frame& F) {
    PHASE_IDS();
    float* X = (float*)(F.ws + WS_X);
    pg8::StaticOrder S; S.init(NLAT, DM, F.G, (int)blockIdx.x); pg8::Unit u;
    for (int i = 0; S.next(i, u); ++i) {
        const int c4 = (tid & 63) * 4, r0 = tid >> 6;
#pragma unroll 4
        for (int rr = r0; rr < 256; rr += 8) { const size_t lr = (size_t)u.pm * 256 + rr; *(f32x4*)(X + (lr + NCTX) * DM + u.pn * 256 + c4) = *(const f32x4*)(F.a->in[0] + lr * DM + u.pn * 256 + c4); }
    }
    for (int item = blockIdx.x; item < 256; item += F.G) { const int mt = item >> 5, nt = item & 31, row = tid >> 4, c0 = (tid & 15) * 4;
        const size_t o = (size_t)(32 * mt + row) * DM + 64 * nt + c0; *(f32x4*)(X + o) = *(const f32x4*)(F.a->in[2] + o); }
}

constexpr int L1_QRAW = 0, L1_KRAW = 16384, L1_GD = 32768, L1_PART = 36864, L1_QT = 40960, L1_KT = 58368, L1_KTT = 75776, L1_VT = 94208, L1_P = 131072;
constexpr float INV_SQRT_DK = 0.08838834764831845f;

template <int DIR>
__device__ __forceinline__ void s1_dir(Frame& F, int e, int hh, int c, bool lat, f32x4 (&pacc)[2], const float (&wv)[16], const float bgv, const f32x2 (&csv)[16]) {
    const bool is_gla = hh < 4; const int hd = hh & 3, t0 = c * 64;
    PHASE_IDS(); const int w = wave, fr = lane & 15, fq = lane >> 4;
    LAS unsigned char* lds = F.lds;
    const int ch = tid & 127, tq = tid >> 7;
    float lgv[16];
    if (is_gla) {
#pragma unroll
        for (int i = 0; i < 16; ++i) { const int tt = 16 * tq + (DIR ? 15 - i : i);
            const u32x4 g0 = *(const LAS u32x4*)(lds + L1_GD + tt * 64 + DIR * 32), g1 = *(const LAS u32x4*)(lds + L1_GD + tt * 64 + DIR * 32 + 16);
            float x = bgv;
            x += bflo(g0.x) * wv[0] + bfhi(g0.x) * wv[1] + bflo(g0.y) * wv[2] + bfhi(g0.y) * wv[3] + bflo(g0.z) * wv[4] + bfhi(g0.z) * wv[5] + bflo(g0.w) * wv[6] + bfhi(g0.w) * wv[7];
            x += bflo(g1.x) * wv[8] + bfhi(g1.x) * wv[9] + bflo(g1.y) * wv[10] + bfhi(g1.y) * wv[11] + bflo(g1.z) * wv[12] + bfhi(g1.z) * wv[13] + bflo(g1.w) * wv[14] + bfhi(g1.w) * wv[15];
            lgv[i] = (fminf(x, 0.f) - __logf(1.0f + __expf(-fabsf(x)))) * (1.0f / 16.0f); }
    } else {
        const float lg = log1pf(-exp2f((DIR ? -5.5f : -5.0f) - (float)hd));
#pragma unroll
        for (int i = 0; i < 16; ++i) lgv[i] = lg;
    }
    float ls = 0.f;
#pragma unroll
    for (int i = 0; i < 16; ++i) ls += lgv[i];
    LAS float* part = (LAS float*)(lds + L1_PART);
    part[tq * 128 + ch] = ls;
    __syncthreads();
    float b = 0.f;
#pragma unroll
    for (int q = 0; q < 4; ++q) { const float pv = part[q * 128 + ch]; if (DIR ? (q > tq) : (q < tq)) b += pv; }
    bf16* QTg = (bf16*)(F.ws + WS_QT) + (size_t)DIR * T * 1024;
    float kt[16];
#pragma unroll
    for (int i = 0; i < 16; ++i) { const int tt = 16 * tq + (DIR ? 15 - i : i);
        b += lgv[i];
        float qv = bf2f(*(const LAS bf16*)(lds + L1_QRAW + tt * 256 + ch * 2)), kv = bf2f(*(const LAS bf16*)(lds + L1_KRAW + tt * 256 + ch * 2));
        if (!is_gla && lat) {
            const float qp = bf2f(*(const LAS bf16*)(lds + L1_QRAW + tt * 256 + (ch ^ 64) * 2)), kp = bf2f(*(const LAS bf16*)(lds + L1_KRAW + tt * 256 + (ch ^ 64) * 2));
            const f32x2 cs = csv[DIR ? 15 - i : i];
            if (ch < 64) { qv = qv * cs.x - qp * cs.y; kv = kv * cs.x - kp * cs.y; } else { qv = qv * cs.x + qp * cs.y; kv = kv * cs.x + kp * cs.y; }
        }
        const float eb = __expf(b), ebi = __expf(-b);
        const float qs = qv * eb * (is_gla ? INV_SQRT_DK : 1.0f), ks = kv * ebi * (is_gla ? 1.0f : INV_SQRT_DK);
        const bf16 qb = f2bf(qs);
        *(LAS bf16*)(lds + L1_QT + tt * 272 + ch * 2) = qb;
        *(LAS bf16*)(lds + L1_KT + tt * 272 + ch * 2) = f2bf(ks);
        kt[DIR ? 15 - i : i] = ks;
        if (i == 15 && tq == (DIR ? 0 : 3)) ((float*)(F.ws + WS_DEC))[((size_t)(DIR * 8 + hh) * NCH + c) * 128 + ch] = eb;
    }
    { u32x4 w0, w1; w0.x = cvt_pk_bf16(kt[0], kt[1]); w0.y = cvt_pk_bf16(kt[2], kt[3]); w0.z = cvt_pk_bf16(kt[4], kt[5]); w0.w = cvt_pk_bf16(kt[6], kt[7]);
      w1.x = cvt_pk_bf16(kt[8], kt[9]); w1.y = cvt_pk_bf16(kt[10], kt[11]); w1.z = cvt_pk_bf16(kt[12], kt[13]); w1.w = cvt_pk_bf16(kt[14], kt[15]);
      *(LAS u32x4*)(lds + L1_KTT + ch * 144 + tq * 32) = w0; *(LAS u32x4*)(lds + L1_KTT + ch * 144 + tq * 32 + 16) = w1; }
    __syncthreads();
#pragma unroll
    for (int i = 0; i < 2; ++i) { const int id = tid + 512 * i, r = id >> 4, cc = id & 15;
        *(u32x4*)(QTg + (size_t)(t0 + r) * 1024 + hh * 128 + cc * 8) = *(const LAS u32x4*)(lds + L1_QT + r * 272 + cc * 16); }
    { const int mi = w >> 1, nj0 = 2 * (w & 1);
      f32x4 pd[2] = {{0.f, 0.f, 0.f, 0.f}, {0.f, 0.f, 0.f, 0.f}};
#pragma unroll
      for (int ks = 0; ks < 4; ++ks) { const bf16x8 a = *(const LAS bf16x8*)(lds + L1_QT + (16 * mi + fr) * 272 + (32 * ks + 8 * fq) * 2);
#pragma unroll
          for (int j = 0; j < 2; ++j) { const bf16x8 bb = *(const LAS bf16x8*)(lds + L1_KT + (16 * (nj0 + j) + fr) * 272 + (32 * ks + 8 * fq) * 2); pd[j] = MFMA16(a, bb, pd[j]); } }
#pragma unroll
      for (int j = 0; j < 2; ++j)
#pragma unroll
          for (int r = 0; r < 4; ++r) { const int ii = 16 * mi + 4 * fq + r, jj = 16 * (nj0 + j) + fr; if (DIR ? (jj >= ii) : (jj <= ii)) pacc[j][r] += pd[j][r]; } }
    { bf16* Ug = (bf16*)(F.ws + WS_U) + ((size_t)(DIR * 8 + hh) * NCH + c) * 256 * 128;
      bf16x8 bv[2][2];
#pragma unroll
      for (int nj = 0; nj < 2; ++nj)
#pragma unroll
          for (int ks = 0; ks < 2; ++ks) bv[nj][ks] = *(const LAS bf16x8*)(lds + L1_VT + (32 * w + 16 * nj + fr) * 144 + (32 * ks + 8 * fq) * 2);
#pragma unroll
      for (int P = 0; P < 4; ++P) {
          f32x4 u[2][2] = {{{0.f, 0.f, 0.f, 0.f}, {0.f, 0.f, 0.f, 0.f}}, {{0.f, 0.f, 0.f, 0.f}, {0.f, 0.f, 0.f, 0.f}}};
#pragma unroll
          for (int t = 0; t < 2; ++t)
#pragma unroll
              for (int ks = 0; ks < 2; ++ks) { const bf16x8 a = *(const LAS bf16x8*)(lds + L1_KTT + (32 * P + 8 * (fr >> 2) + 4 * t + (fr & 3)) * 144 + (32 * ks + 8 * fq) * 2);
#pragma unroll
                  for (int nj = 0; nj < 2; ++nj) u[t][nj] = MFMA16(a, bv[nj][ks], u[t][nj]); }
          asm volatile("s_nop 15" : "+v"(u[0][0]), "+v"(u[0][1]), "+v"(u[1][0]), "+v"(u[1][1]));
#pragma unroll
          for (int nj = 0; nj < 2; ++nj) { u32x4 o; o.x = cvt_pk_bf16(u[0][nj][0], u[0][nj][1]); o.y = cvt_pk_bf16(u[0][nj][2], u[0][nj][3]); o.z = cvt_pk_bf16(u[1][nj][0], u[1][nj][1]); o.w = cvt_pk_bf16(u[1][nj][2], u[1][nj][3]);
              *(u32x4*)(Ug + (size_t)(32 * w + 16 * nj + fr) * 128 + 32 * P + 8 * fq) = o; } } }
    __syncthreads();
}

__device__ __forceinline__ void s1_phase(Frame& F, int e) {
    PHASE_IDS(); LAS unsigned char* lds = F.lds; const int w = wave, fr = lane & 15, fq = lane >> 4;
    const bf16* P = (const bf16*)(F.ws + WS_PROJ);
    for (int item = blockIdx.x; item < 8 * NCH; item += F.G) {
        const int c = item >> 3, hh = item & 7, hd = hh & 3, t0 = c * 64; const bool is_gla = hh < 4, lat = c >= 4;
        const int qcol = is_gla ? 128 * hd : 3072 + 128 * hd, kcol = qcol + 512, vcol = is_gla ? 1024 + 256 * hd : 4096 + 256 * hd;
#pragma unroll
        for (int i = 0; i < 2; ++i) { const int id = tid + 512 * i, r = id >> 4, cc = id & 15;
            *(LAS u32x4*)(lds + L1_QRAW + r * 256 + cc * 16) = *(const u32x4*)(P + (size_t)(t0 + r) * EV_N + qcol + cc * 8);
            *(LAS u32x4*)(lds + L1_KRAW + r * 256 + cc * 16) = *(const u32x4*)(P + (size_t)(t0 + r) * EV_N + kcol + cc * 8); }
#pragma unroll
        for (int i = 0; i < 4; ++i) { const int id = tid + 512 * i, r = id & 63, cc = id >> 6;
            const u32x4 v = *(const u32x4*)(P + (size_t)(t0 + r) * EV_N + vcol + cc * 8);
            LAS bf16* vt = (LAS bf16*)(lds + L1_VT) + (cc * 8) * 72 + r;
            vt[0 * 72] = (bf16)(v.x & 0xffff); vt[1 * 72] = (bf16)(v.x >> 16); vt[2 * 72] = (bf16)(v.y & 0xffff); vt[3 * 72] = (bf16)(v.y >> 16);
            vt[4 * 72] = (bf16)(v.z & 0xffff); vt[5 * 72] = (bf16)(v.z >> 16); vt[6 * 72] = (bf16)(v.w & 0xffff); vt[7 * 72] = (bf16)(v.w >> 16); }
        if (is_gla && tid < 256) { const int r = tid >> 2, cc = tid & 3; *(LAS u32x4*)(lds + L1_GD + r * 64 + cc * 16) = *(const u32x4*)(P + (size_t)(t0 + r) * EV_N + 6144 + cc * 8); }
        float wvf[16], wvb[16], bgf = 0.f, bgb = 0.f; f32x2 csv[16];
        { const int ch = tid & 127, tq = tid >> 7;
#pragma unroll
          for (int r = 0; r < 16; ++r) { wvf[r] = 0.f; wvb[r] = 0.f; csv[r] = (f32x2){1.f, 0.f}; }
          if (is_gla) {
              const float* wgf = F.a->in[11] + (size_t)e * 16 * 512 + hd * 128 + ch; const float* wgb = F.a->in[13] + (size_t)e * 16 * 512 + hd * 128 + ch;
#pragma unroll
              for (int r = 0; r < 16; ++r) { wvf[r] = wgf[r * 512]; wvb[r] = wgb[r * 512]; }
              bgf = F.a->in[12][e * 512 + hd * 128 + ch]; bgb = F.a->in[14][e * 512 + hd * 128 + ch];
          } else if (lat) {
              const f32x2* RT = (const f32x2*)(F.ws + WS_RT) + (size_t)(t0 + 16 * tq - NCTX) * 64 + (ch & 63);
#pragma unroll
              for (int r = 0; r < 16; ++r) csv[r] = RT[r * 64];
          } }
        __syncthreads();
        f32x4 pacc[2] = {{0.f, 0.f, 0.f, 0.f}, {0.f, 0.f, 0.f, 0.f}};
        s1_dir<0>(F, e, hh, c, lat, pacc, wvf, bgf, csv);
        s1_dir<1>(F, e, hh, c, lat, pacc, wvb, bgb, csv);
        { const int mi = w >> 1, nj0 = 2 * (w & 1);
#pragma unroll
          for (int j = 0; j < 2; ++j)
#pragma unroll
              for (int r = 0; r < 4; ++r) *(LAS bf16*)(lds + L1_P + (16 * mi + 4 * fq + r) * 144 + (16 * (nj0 + j) + fr) * 2) = f2bf(pacc[j][r]); }
        __syncthreads();
        { float* OI = (float*)(F.ws + WS_OI);
          bf16x8 bv[2][2];
#pragma unroll
          for (int nj = 0; nj < 2; ++nj)
#pragma unroll
              for (int ks = 0; ks < 2; ++ks) bv[nj][ks] = *(const LAS bf16x8*)(lds + L1_VT + (32 * w + 16 * nj + fr) * 144 + (32 * ks + 8 * fq) * 2);
#pragma unroll
          for (int mi = 0; mi < 4; ++mi) {
              f32x4 o[2] = {{0.f, 0.f, 0.f, 0.f}, {0.f, 0.f, 0.f, 0.f}};
#pragma unroll
              for (int ks = 0; ks < 2; ++ks) { const bf16x8 a = *(const LAS bf16x8*)(lds + L1_P + (16 * mi + fr) * 144 + (32 * ks + 8 * fq) * 2);
#pragma unroll
                  for (int nj = 0; nj < 2; ++nj) o[nj] = MFMA16(a, bv[nj][ks], o[nj]); }
#pragma unroll
              for (int nj = 0; nj < 2; ++nj)
#pragma unroll
                  for (int r = 0; r < 4; ++r) ((LAS float*)lds)[(16 * mi + 4 * fq + r) * 260 + 32 * w + 16 * nj + fr] = o[nj][r]; }
          __syncthreads();
#pragma unroll
          for (int i = 0; i < 8; ++i) { const int id = tid + 512 * i, r = id >> 6, cc = id & 63;
              *(f32x4*)(OI + (size_t)(t0 + r) * DM + hh * 256 + cc * 4) = *(const LAS f32x4*)((LAS float*)lds + r * 260 + cc * 4); } }
        __syncthreads();
    }
}

__device__ __forceinline__ void s2_phase(Frame& F) {
    PHASE_IDS();
    constexpr int SB = 13, NB = NCH / SB; static_assert(NB * SB == NCH, "NCH % 13");
    const int gt = F.vcu * NTHR + tid, NGT = F.G * NTHR;
    for (int idx = gt; idx < 2 * 8 * 256 * 32; idx += NGT) {
        const int dk4 = idx & 31, ee = (idx >> 5) & 255, dh = idx >> 13, dir = dh >> 3;
        const bf16* U = (const bf16*)(F.ws + WS_U) + (size_t)dh * NCH * 256 * 128 + (size_t)ee * 128 + dk4 * 4;
        bf16* S = (bf16*)(F.ws + WS_S) + (size_t)dh * NCH * 256 * 128 + (size_t)ee * 128 + dk4 * 4;
        const float* D = (const float*)(F.ws + WS_DEC) + (size_t)dh * NCH * 128 + dk4 * 4;
        f32x4 s = {0.f, 0.f, 0.f, 0.f};
        u32x2 un[SB]; f32x4 dn[SB];
#define S2_CH(step) (dir ? ((step) < 4 ? 3 - (step) : NCH + 3 - (step)) : (step))
#pragma unroll
        for (int i = 0; i < SB; ++i) { const int c = S2_CH(i); un[i] = *(const u32x2*)(U + (size_t)c * 256 * 128); dn[i] = *(const f32x4*)(D + (size_t)c * 128); }
#pragma nounroll
        for (int b = 0; b < NB; ++b) {
            u32x2 uc[SB]; f32x4 dc[SB];
#pragma unroll
            for (int i = 0; i < SB; ++i) { uc[i] = un[i]; dc[i] = dn[i]; }
            if (b + 1 < NB) {
#pragma unroll
                for (int i = 0; i < SB; ++i) { const int c = S2_CH((b + 1) * SB + i); un[i] = *(const u32x2*)(U + (size_t)c * 256 * 128); dn[i] = *(const f32x4*)(D + (size_t)c * 128); } }
#pragma unroll
            for (int i = 0; i < SB; ++i) { const int c = S2_CH(b * SB + i);
                u32x2 so; so.x = cvt_pk_bf16(s.x, s.y); so.y = cvt_pk_bf16(s.z, s.w);
                *(u32x2*)(S + (size_t)c * 256 * 128) = so;
                s.x = dc[i].x * (s.x + bflo(uc[i].x)); s.y = dc[i].y * (s.y + bfhi(uc[i].x)); s.z = dc[i].z * (s.z + bflo(uc[i].y)); s.w = dc[i].w * (s.w + bfhi(uc[i].y)); }
        }
#undef S2_CH
    }
}

constexpr int L3_QF = 0, L3_QB = 17408, L3_OL = 34816;
__device__ __forceinline__ void s3_phase(Frame& F, int e) {
    PHASE_IDS(); LAS unsigned char* lds = F.lds; const int w = wave, fr = lane & 15, fq = lane >> 4;
    const bf16* P = (const bf16*)(F.ws + WS_PROJ); const bf16* QTg = (const bf16*)(F.ws + WS_QT); const float* OI = (const float*)(F.ws + WS_OI);
    bf16* MIX = (bf16*)(F.ws + WS_MIX);
    for (int item = blockIdx.x; item < 8 * NCH; item += F.G) {
        const int c = item >> 3, hh = item & 7, hd = hh & 3, t0 = c * 64; const bool is_gla = hh < 4;
        const int gcol = is_gla ? 2048 + 256 * hd : 5120 + 256 * hd;
#pragma unroll
        for (int dir = 0; dir < 2; ++dir)
#pragma unroll
            for (int i = 0; i < 2; ++i) { const int id = tid + 512 * i, r = id >> 4, cc = id & 15;
                *(LAS u32x4*)(lds + (dir ? L3_QB : L3_QF) + r * 272 + cc * 16) = *(const u32x4*)(QTg + (size_t)dir * T * 1024 + (size_t)(t0 + r) * 1024 + hh * 128 + cc * 8); }
        bf16x8 bv[2][4][2];
#pragma unroll
        for (int dir = 0; dir < 2; ++dir) { const bf16* Sg = (const bf16*)(F.ws + WS_S) + ((size_t)(dir * 8 + hh) * NCH + c) * 256 * 128;
#pragma unroll
            for (int ks = 0; ks < 4; ++ks)
#pragma unroll
                for (int nj = 0; nj < 2; ++nj) bv[dir][ks][nj] = *(const bf16x8*)(Sg + (size_t)(32 * w + 16 * nj + fr) * 128 + 32 * ks + 8 * fq); }
        __builtin_amdgcn_sched_barrier(0);
        __syncthreads();
        f32x4 o[4][2];
#pragma unroll
        for (int mi = 0; mi < 4; ++mi)
#pragma unroll
            for (int nj = 0; nj < 2; ++nj) o[mi][nj] = (f32x4){0.f, 0.f, 0.f, 0.f};
#pragma unroll
        for (int dir = 0; dir < 2; ++dir) {
#pragma unroll
            for (int ks = 0; ks < 4; ++ks) {
#pragma unroll
                for (int mi = 0; mi < 4; ++mi) { const bf16x8 a = *(const LAS bf16x8*)(lds + (dir ? L3_QB : L3_QF) + (16 * mi + fr) * 272 + (32 * ks + 8 * fq) * 2);
#pragma unroll
                    for (int nj = 0; nj < 2; ++nj) o[mi][nj] = MFMA16(a, bv[dir][ks][nj], o[mi][nj]); } } }
        LAS float* OL = (LAS float*)(lds + L3_OL);
#pragma unroll
        for (int mi = 0; mi < 4; ++mi)
#pragma unroll
            for (int nj = 0; nj < 2; ++nj)
#pragma unroll
                for (int r = 0; r < 4; ++r) OL[(16 * mi + 4 * fq + r) * 260 + 32 * w + 16 * nj + fr] = o[mi][nj][r];
        __syncthreads();
        { const int tk = tid >> 3, seg = tid & 7;
          f32x4 v[4][2]; float sq = 0.f;
#pragma unroll
          for (int g = 0; g < 4; ++g) { const int ee = 64 * g + 8 * seg; const float* oi = OI + (size_t)(t0 + tk) * DM + hh * 256 + ee;
              v[g][0] = *(const LAS f32x4*)(OL + tk * 260 + ee) + *(const f32x4*)oi; v[g][1] = *(const LAS f32x4*)(OL + tk * 260 + ee + 4) + *(const f32x4*)(oi + 4);
              sq += (v[g][0].x * v[g][0].x + v[g][0].y * v[g][0].y) + (v[g][0].z * v[g][0].z + v[g][0].w * v[g][0].w) + (v[g][1].x * v[g][1].x + v[g][1].y * v[g][1].y) + (v[g][1].z * v[g][1].z + v[g][1].w * v[g][1].w); }
          sq += __shfl_xor(sq, 1); sq += __shfl_xor(sq, 2); sq += __shfl_xor(sq, 4);
          const float rstd = 1.0f / sqrtf(sq * (1.0f / 256.0f) + RMS_EPS);
#pragma unroll
          for (int g = 0; g < 4; ++g) { const int ee = 64 * g + 8 * seg;
              const u32x4 gt = *(const u32x4*)(P + (size_t)(t0 + tk) * EV_N + gcol + ee);
              f32x4 n0 = {1.f, 1.f, 1.f, 1.f}, n1 = {1.f, 1.f, 1.f, 1.f};
              if (is_gla) { n0 = *(const f32x4*)(F.a->in[15] + e * 256 + ee); n1 = *(const f32x4*)(F.a->in[15] + e * 256 + ee + 4); }
              const f32x4 a0 = v[g][0] * rstd * n0, a1 = v[g][1] * rstd * n1;
              u32x4 ow; ow.x = cvt_pk_bf16(a0.x * silu_f(bflo(gt.x)), a0.y * silu_f(bfhi(gt.x))); ow.y = cvt_pk_bf16(a0.z * silu_f(bflo(gt.y)), a0.w * silu_f(bfhi(gt.y)));
              ow.z = cvt_pk_bf16(a1.x * silu_f(bflo(gt.z)), a1.y * silu_f(bfhi(gt.z))); ow.w = cvt_pk_bf16(a1.z * silu_f(bflo(gt.w)), a1.w * silu_f(bfhi(gt.w)));
              *(u32x4*)(MIX + (size_t)(t0 + tk) * DM + hh * 256 + ee) = ow; } }
        __syncthreads();
    }
}

__device__ __forceinline__ void e1_phase(Frame& F, int o) {
    PHASE_IDS();
    const int gw = F.vcu * NWAVES + wave, NGW = F.G * NWAVES;
    const bf16* P = (const bf16*)(F.ws + WS_PROJ); bf16* CQN = (bf16*)(F.ws + WS_CQN); bf16* CKVN = (bf16*)(F.ws + WS_CKVN); bf16* KR = (bf16*)(F.ws + WS_KR);
    const float* wq = F.a->in[18] + o * 512 + lane * 8; const float* wkv = F.a->in[19] + o * 512 + lane * 8;
    const f32x4 wq0 = *(const f32x4*)wq, wq1 = *(const f32x4*)(wq + 4), wk0 = *(const f32x4*)wkv, wk1 = *(const f32x4*)(wkv + 4);
    const f32x2* AXR = (const f32x2*)(F.ws + WS_AXR); const f32x2* AXC = (const f32x2*)(F.ws + WS_AXC);
    for (int t = gw; t < T; t += NGW) {
        const bf16* p = P + (size_t)t * OD_N;
        const u32x4 a = *(const u32x4*)(p + lane * 8), b = *(const u32x4*)(p + 512 + lane * 8);
        float x[8] = {bflo(a.x), bfhi(a.x), bflo(a.y), bfhi(a.y), bflo(a.z), bfhi(a.z), bflo(a.w), bfhi(a.w)};
        float y[8] = {bflo(b.x), bfhi(b.x), bflo(b.y), bfhi(b.y), bflo(b.z), bfhi(b.z), bflo(b.w), bfhi(b.w)};
        float sx = 0.f, sy = 0.f;
#pragma unroll
        for (int j = 0; j < 8; ++j) { sx += x[j] * x[j]; sy += y[j] * y[j]; }
        const float rx = 1.0f / sqrtf(wave_sum(sx) * (1.0f / 512.0f) + RMS_EPS), ry = 1.0f / sqrtf(wave_sum(sy) * (1.0f / 512.0f) + RMS_EPS);
        u32x4 oq, ok;
        oq.x = cvt_pk_bf16(x[0] * rx * wq0.x, x[1] * rx * wq0.y); oq.y = cvt_pk_bf16(x[2] * rx * wq0.z, x[3] * rx * wq0.w); oq.z = cvt_pk_bf16(x[4] * rx * wq1.x, x[5] * rx * wq1.y); oq.w = cvt_pk_bf16(x[6] * rx * wq1.z, x[7] * rx * wq1.w);
        ok.x = cvt_pk_bf16(y[0] * ry * wk0.x, y[1] * ry * wk0.y); ok.y = cvt_pk_bf16(y[2] * ry * wk0.z, y[3] * ry * wk0.w); ok.z = cvt_pk_bf16(y[4] * ry * wk1.x, y[5] * ry * wk1.y); ok.w = cvt_pk_bf16(y[6] * ry * wk1.z, y[7] * ry * wk1.w);
        *(u32x4*)(CQN + (size_t)t * 512 + lane * 8) = oq; *(u32x4*)(CKVN + (size_t)t * 512 + lane * 8) = ok;
        float v = bf2f(p[1024 + lane]); const float pr = __shfl_xor(v, 16);
        if (t >= NCTX) { const int pp = t - NCTX, pos = (lane & 32) ? (pp & 63) : (pp >> 6); const f32x2 cs = ((lane & 32) ? AXC : AXR)[pos * 16 + (lane & 15)];
            v = (lane & 16) ? v * cs.x + pr * cs.y : v * cs.x - pr * cs.y; }
        KR[(size_t)t * 64 + lane] = f2bf(v);
    }
}

namespace att {
constexpr int KVBLK = 64;
constexpr float SCALE = 0.07216878364870322f;
constexpr float THR = 8.f;
constexpr int SHM_K = 64 * 384, SHM_V = 64 * 256;
constexpr int A_V = 0, A_K = 3 * SHM_V, A_WS = 3 * SHM_V + 3 * SHM_K;
#define SBAR() __builtin_amdgcn_sched_barrier(0)
__device__ __forceinline__ int crow(int r, int hi) { return (r & 3) + 8 * (r >> 2) + 4 * hi; }
constexpr float PLIM = 4096.f;
__device__ __forceinline__ void exp_sum(f32x16& p0, f32x16& p1, float& ps) {
#pragma unroll
    for (int r = 0; r < 16; ++r) p0[r] = __builtin_amdgcn_exp2f(p0[r]);
#pragma unroll
    for (int r = 0; r < 16; ++r) p1[r] = __builtin_amdgcn_exp2f(p1[r]);
    ps = p0[0];
#pragma unroll
    for (int r = 1; r < 16; ++r) ps += p0[r];
#pragma unroll
    for (int r = 0; r < 16; ++r) ps += p1[r];
}
__device__ __forceinline__ float row_max32(const f32x16& p0, const f32x16& p1) {
    float pmax = p0[0];
#pragma unroll
    for (int r = 1; r < 16; ++r) pmax = fmaxf(pmax, p0[r]);
#pragma unroll
    for (int r = 0; r < 16; ++r) pmax = fmaxf(pmax, p1[r]);
    auto rr = __builtin_amdgcn_permlane32_swap(__float_as_uint(pmax), __float_as_uint(pmax), false, false);
    return fmaxf(__uint_as_float(rr[0]), __uint_as_float(rr[1]));
}
__device__ __forceinline__ void pack_p(const f32x16& p0, const f32x16& p1, bf16x8& pa0, bf16x8& pa1, bf16x8& pa2, bf16x8& pa3) {
#define PK4(P, BASE, OUT) do { unsigned a0 = cvt_pk_bf16(P[BASE + 0], P[BASE + 1]), a1 = cvt_pk_bf16(P[BASE + 2], P[BASE + 3]);   \
    unsigned b0 = cvt_pk_bf16(P[BASE + 4], P[BASE + 5]), b1 = cvt_pk_bf16(P[BASE + 6], P[BASE + 7]);                              \
    auto r0 = __builtin_amdgcn_permlane32_swap(a0, b0, false, false); auto r1 = __builtin_amdgcn_permlane32_swap(a1, b1, false, false); \
    u32x4 w = {r0[0], r1[0], r0[1], r1[1]}; OUT = *reinterpret_cast<bf16x8*>(&w); } while (0)
    PK4(p0, 0, pa0); PK4(p0, 8, pa1); PK4(p1, 0, pa2); PK4(p1, 8, pa3);
#undef PK4
}
__device__ __forceinline__ int kswz(int row, int g) { return row * 384 + (((g & ~7) | ((g & 7) ^ ((row >> 1) & 7))) << 4); }
__device__ __forceinline__ void qkt(f32x16& p0, f32x16& p1, const LAS unsigned char* Ks, const bf16x8 (&qr)[12], const int (&kx)[4], const f32x16& init) {
    bf16x8 c0 = *(const LAS bf16x8*)(Ks + kx[0]), c1 = *(const LAS bf16x8*)(Ks + kx[0] + 32 * 384), n0, n1;
#pragma unroll
    for (int d0 = 0; d0 < 12; ++d0) {
        if (d0 < 11) { n0 = *(const LAS bf16x8*)(Ks + kx[(d0 + 1) & 3] + ((d0 + 1) >> 2) * 128); n1 = *(const LAS bf16x8*)(Ks + kx[(d0 + 1) & 3] + ((d0 + 1) >> 2) * 128 + 32 * 384); }
        __builtin_amdgcn_sched_barrier(0);
        p0 = MFMA32(c0, qr[d0], d0 == 0 ? init : p0);
        p1 = MFMA32(c1, qr[d0], d0 == 0 ? init : p1);
        __builtin_amdgcn_sched_barrier(0);
        c0 = n0; c1 = n1; }
}
__device__ __forceinline__ int v_st(int k, int c) { const int kk = (k & ~0xC) | ((k & 4) << 1) | ((k & 8) >> 1); return ((kk >> 3) * 4 + (c >> 5)) * 512 + ((kk & 7) * 32 + (c & 31)) * 2; }
__device__ __forceinline__ int v_rd_base(int lane) { return ((lane & 3) << 3) | (((lane >> 2) & 3) << 6) | (((lane >> 4) & 1) << 5) | (((lane >> 5) & 1) << 8); }
constexpr int v_rd_off(int d0, int ks, int half) { return d0 * 512 + ks * 4096 + half * 2048; }
template <int OFF> __device__ __forceinline__ s16x4 tr_read(int vb) {
    s16x4 r; asm volatile("ds_read_b64_tr_b16 %0, %1 offset:%2" : "=&v"(r) : "v"(vb), "i"(OFF) : "memory"); return r;
}
struct VF { s16x4 l0, h0, l1, h1, l2, h2, l3, h3; };
template <int KS> __device__ __forceinline__ void v_load(VF& f, int vb) {
    f.l0 = tr_read<v_rd_off(0, KS, 0)>(vb); f.h0 = tr_read<v_rd_off(0, KS, 1)>(vb); f.l1 = tr_read<v_rd_off(1, KS, 0)>(vb); f.h1 = tr_read<v_rd_off(1, KS, 1)>(vb);
    f.l2 = tr_read<v_rd_off(2, KS, 0)>(vb); f.h2 = tr_read<v_rd_off(2, KS, 1)>(vb); f.l3 = tr_read<v_rd_off(3, KS, 0)>(vb); f.h3 = tr_read<v_rd_off(3, KS, 1)>(vb);
}
__device__ __forceinline__ void pv_mma(f32x16 (&o)[4], const VF& f, bf16x8 pa) {
#define PK(L, H) (bf16x8){L[0], L[1], L[2], L[3], H[0], H[1], H[2], H[3]}
    o[0] = MFMA32(pa, PK(f.l0, f.h0), o[0]);
    o[1] = MFMA32(pa, PK(f.l1, f.h1), o[1]);
    o[2] = MFMA32(pa, PK(f.l2, f.h2), o[2]);
    o[3] = MFMA32(pa, PK(f.l3, f.h3), o[3]);
#undef PK
}
__device__ __forceinline__ void pv_d0(f32x16 (&o)[4], int vb, VF& fa, bf16x8 pa0, bf16x8 pa1, bf16x8 pa2, bf16x8 pa3) {
    VF fb;
    v_load<1>(fb, vb);
    asm volatile("s_waitcnt lgkmcnt(8)" ::: "memory"); SBAR(); pv_mma(o, fa, pa0); SBAR();
    v_load<2>(fa, vb);
    asm volatile("s_waitcnt lgkmcnt(8)" ::: "memory"); SBAR(); pv_mma(o, fb, pa1); SBAR();
    v_load<3>(fb, vb);
    asm volatile("s_waitcnt lgkmcnt(8)" ::: "memory"); SBAR(); pv_mma(o, fa, pa2); SBAR();
    asm volatile("s_waitcnt lgkmcnt(0)" ::: "memory"); SBAR(); pv_mma(o, fb, pa3);
}
__device__ __forceinline__ void rope_pair(bf16x8& a, bf16x8& b, const f32x2* cs) {
    u32x4 ua = *reinterpret_cast<u32x4*>(&a), ub = *reinterpret_cast<u32x4*>(&b); u32x4 oa, ob;
#pragma unroll
    for (int j = 0; j < 4; ++j) { const f32x2 c0 = cs[2 * j], c1 = cs[2 * j + 1];
        const float x1l = bflo(ua[j]), x1h = bfhi(ua[j]), x2l = bflo(ub[j]), x2h = bfhi(ub[j]);
        oa[j] = cvt_pk_bf16(x1l * c0.x - x2l * c0.y, x1h * c1.x - x2h * c1.y);
        ob[j] = cvt_pk_bf16(x2l * c0.x + x1l * c0.y, x2h * c1.x + x1h * c1.y); }
    a = *reinterpret_cast<bf16x8*>(&oa); b = *reinterpret_cast<bf16x8*>(&ob);
}
__device__ __forceinline__ void unit(Frame& F, int h, int qrow0, int nkeys) {
    LAS unsigned char* lds = F.lds;
    PHASE_IDS(); const int wid = wave, r32 = lane & 31, hi = lane >> 5;
    const bf16* QB = (const bf16*)(F.ws + WS_QB); const bf16* KVB = (const bf16*)(F.ws + WS_KVB); const bf16* KR = (const bf16*)(F.ws + WS_KR);
    LAS unsigned char* V_lds = lds + A_V; LAS unsigned char* K_lds = lds + A_K;
    LAS float* wsl = (LAS float*)(lds + A_WS) + wid * 64; LAS float* li_l = wsl; LAS float* al_l = wsl + 32;
    float m_reg = -1e30f, l_reg = 0; f32x16 o[4] = {}; bf16x8 qr[12]; f32x16 negm;
    const int qt = qrow0 + wid * 32 + r32;
    const bf16* Qw = QB + (size_t)qt * 3072 + 192 * h + hi * 8;
#pragma unroll
    for (int d0 = 0; d0 < 12; ++d0) qr[d0] = *(const bf16x8*)(Qw + d0 * 16);
    if (qt >= NCTX) { const int pp = qt - NCTX;
        rope_pair(qr[8], qr[9], (const f32x2*)(F.ws + WS_AXR) + (pp >> 6) * 16 + hi * 8);
        rope_pair(qr[10], qr[11], (const f32x2*)(F.ws + WS_AXC) + (pp & 63) * 16 + hi * 8); }
    const unsigned char* wsb = F.ws;
    unsigned koff[3], kfl = 0u; int kdst[3];
#pragma unroll
    for (int i = 0; i < 3; ++i) { const int id = tid + 512 * i, row = id / 24, g = id % 24;
        if (g < 16) { koff[i] = (unsigned)WS_KVB + (unsigned)(row * 4096 + 256 * h + g * 8) * 2u; kfl |= 1u << i; } else { koff[i] = (unsigned)WS_KR + (unsigned)(row * 64 + (g - 16) * 8) * 2u; }
        kdst[i] = kswz(row, g); }
    const int sr = tid >> 4, sc = (tid & 15) * 8, vst0 = v_st(sr, sc);
    const unsigned voff = (unsigned)WS_KVB + (unsigned)(sr * 4096 + 256 * h + 128 + sc) * 2u;
    const int vb0 = (int)(unsigned)(uintptr_t)V_lds + v_rd_base(lane);
    int kx[4];
#pragma unroll
    for (int q = 0; q < 4; ++q) kx[q] = r32 * 384 + ((((2 * q) | hi) ^ ((r32 >> 1) & 7)) << 4);
    bf16x8 sk0, sk1, sk2, sv0, sv1;
#define SLOAD(jt) do { const unsigned vo_ = voff + (unsigned)(jt) * (64u * 4096u * 2u); sv0 = *(const bf16x8*)(wsb + vo_); sv1 = *(const bf16x8*)(wsb + vo_ + 32u * 4096u * 2u); \
    const unsigned kt_ = (unsigned)(jt) * 8192u; \
    sk0 = *(const bf16x8*)(wsb + koff[0] + (kt_ << ((kfl & 1u) * 6u))); sk1 = *(const bf16x8*)(wsb + koff[1] + (kt_ << (((kfl >> 1) & 1u) * 6u))); sk2 = *(const bf16x8*)(wsb + koff[2] + (kt_ << (((kfl >> 2) & 1u) * 6u))); } while (0)
#define SWRITE(b) do { *(LAS bf16x8*)(V_lds + (b) * SHM_V + vst0) = sv0; *(LAS bf16x8*)(V_lds + (b) * SHM_V + vst0 + 8192) = sv1; \
    *(LAS bf16x8*)(K_lds + (b) * SHM_K + kdst[0]) = sk0; *(LAS bf16x8*)(K_lds + (b) * SHM_K + kdst[1]) = sk1; *(LAS bf16x8*)(K_lds + (b) * SHM_K + kdst[2]) = sk2; } while (0)
#define SWAIT() asm volatile("s_waitcnt vmcnt(0)" ::: "memory")
#define NEGM_SET(v) do { const float v_ = (v); _Pragma("unroll") for (int r = 0; r < 16; ++r) negm[r] = v_; asm volatile("" : "+v"(negm)); } while (0)
    f32x16 p0, p1; bf16x8 pa0, pa1, pa2, pa3; const int NT = nkeys / KVBLK;
    NEGM_SET(0.f);
#define ABAR() do { asm volatile("s_waitcnt lgkmcnt(0)" ::: "memory"); __builtin_amdgcn_s_barrier(); asm volatile("" ::: "memory"); } while (0)
#define ASTAGE(j) do { if ((j) + 1 < NT) { SWAIT(); SWRITE(b1); } if ((j) + 2 < NT) SLOAD((j) + 2); } while (0)
#define AQK(j) do { SBAR(); qkt(p0, p1, K_lds + b0 * SHM_K, qr, kx, negm); SBAR(); } while (0)
#define RARE(j) do { _Pragma("nounroll") for (int pass_ = 0; pass_ < 2; ++pass_) { NEGM_SET(pass_ ? -m_reg : 0.f); AQK(j); \
      if (pass_ == 0) { const float mnew_ = fmaxf(m_reg, row_max32(p0, p1)); const float a_ = __builtin_amdgcn_exp2f(m_reg - mnew_); m_reg = mnew_; l_reg *= a_; \
        if (hi == 0) al_l[r32] = a_; asm volatile("s_waitcnt lgkmcnt(0)" ::: "memory"); \
        _Pragma("unroll") for (int d = 0; d < 4; ++d) { SBAR(); _Pragma("unroll") for (int r = 0; r < 16; ++r) o[d][r] *= al_l[crow(r, hi)]; } SBAR(); } } } while (0)
#define ASP(j) do { float ps; VF fa_; v_load<0>(fa_, vb0 + b0 * SHM_V); SBAR(); exp_sum(p0, p1, ps); \
    if (__builtin_expect((j) == 0 || __any(!(ps <= PLIM)), 0)) { RARE(j); exp_sum(p0, p1, ps); } \
    { auto rr = __builtin_amdgcn_permlane32_swap(__float_as_uint(ps), __float_as_uint(ps), false, false); l_reg += __uint_as_float(rr[0]) + __uint_as_float(rr[1]); } \
    pack_p(p0, p1, pa0, pa1, pa2, pa3); SBAR(); pv_d0(o, vb0 + b0 * SHM_V, fa_, pa0, pa1, pa2, pa3); } while (0)
    SLOAD(0); SWAIT(); SWRITE(0); SLOAD(1); ABAR();
    { const bool g1 = __builtin_amdgcn_readfirstlane(wid >> 2) != 0;
      if (g1) ABAR();
      int b0 = 0;
      for (int j = 0; j < NT; ++j) { const int b1 = b0 == 2 ? 0 : b0 + 1; ASTAGE(j); AQK(j); ABAR(); ASP(j); ABAR(); b0 = b1; }
      if (!g1) ABAR(); }
#undef ABAR
#undef ASTAGE
#undef AQK
#undef ASP
#undef RARE
#undef NEGM_SET
    if (hi == 0) li_l[r32] = l_reg; asm volatile("s_waitcnt lgkmcnt(0)" ::: "memory");
    float rli[16];
#pragma unroll
    for (int r = 0; r < 16; ++r) rli[r] = __builtin_amdgcn_rcpf(li_l[crow(r, hi)]);
    unsigned orow0 = (unsigned)(qrow0 + wid * 32) * DM + 128 * h; asm volatile("" : "+v"(orow0));
    bf16* Ow = (bf16*)(F.ws + WS_MIX) + orow0;
#pragma unroll
    for (int r = 0; r < 16; ++r) { const int orow = crow(r, hi);
#pragma unroll
        for (int d0 = 0; d0 < 4; ++d0) Ow[(size_t)orow * DM + d0 * 32 + r32] = f2bf(o[d0][r] * rli[r]); }
    __syncthreads();
#undef SLOAD
#undef SWRITE
#undef SWAIT
}
}

__device__ __forceinline__ void attn_phase(Frame& F) {
    for (int u = F.vcu; u < 1024 + 16; u += F.G) {
        if (u < 1024) att::unit(F, u >> 6, NCTX + 256 * (u & 63), T);
        else att::unit(F, u - 1024, 0, NCTX);
    }
}

#ifdef DBG
constexpr int DBG_W_BAD = 64, DBG_W_SSQ = 65, DBG_W_CNT = 66, DBG_W_MAX = 67;
__device__ __forceinline__ void dbg_scan(Frame& F, int id, size_t off, size_t nbytes, bool is_bf) {
    PHASE_IDS();
    const u32x4* p = (const u32x4*)(F.ws + off); const size_t n = nbytes / 16; bool bad = false;
    for (size_t i = (size_t)F.vcu * NTHR + tid; i < n; i += (size_t)F.G * NTHR) { const u32x4 v = p[i];
#pragma unroll
        for (int j = 0; j < 4; ++j) { if (is_bf) { bad |= ((v[j] & 0x7f80u) == 0x7f80u) | ((v[j] & 0x7f800000u) == 0x7f800000u); } else bad |= ((v[j] & 0x7f800000u) == 0x7f800000u); } }
    if (__any(bad) && lane == 0) atomicMax((unsigned*)(F.ws + WS_CTL) + DBG_W_BAD, (unsigned)(100000 - id));
}
__device__ __forceinline__ void dbg_max(Frame& F, size_t off, size_t nbytes, bool is_bf) {
    PHASE_IDS();
    const u32x4* p = (const u32x4*)(F.ws + off); const size_t n = nbytes / 16; unsigned mx = 0u;
    for (size_t i = (size_t)F.vcu * NTHR + tid; i < n; i += (size_t)F.G * NTHR) { const u32x4 v = p[i];
#pragma unroll
        for (int j = 0; j < 4; ++j) { if (is_bf) { const unsigned a0 = (v[j] << 16) & 0x7fffffffu, a1 = v[j] & 0x7fff0000u; if (a0 < 0x7f800000u) mx = max(mx, a0); if (a1 < 0x7f800000u) mx = max(mx, a1); } else { const unsigned a0 = v[j] & 0x7fffffffu; if (a0 < 0x7f800000u) mx = max(mx, a0); } } }
#pragma unroll
    for (int o = 1; o < 64; o <<= 1) mx = max(mx, (unsigned)__shfl_xor((int)mx, o));
    if (lane == 0) atomicMax((unsigned*)(F.ws + WS_CTL) + DBG_W_MAX, mx);
}
#define DBGSCAN(id, off, nbytes, isbf) dbg_scan(F, (id), (off), (nbytes), (isbf))
#else
#define DBGSCAN(id, off, nbytes, isbf) do {} while (0)
#endif

#ifndef RES_ALIGN
#define RES_ALIGN true
#endif
#ifndef RES_SP2
#define RES_SP2 true
#endif
__global__ void __launch_bounds__(NTHR, 2) fwd_kernel(Args args) {
    extern __shared__ __attribute__((aligned(16))) unsigned char lds_raw[];
    Frame F;
    F.lds = (LAS unsigned char*)lds_raw;
    F.G = gridDim.x; { const int bx = blockIdx.x; F.vcu = (F.G % 8 == 0) ? (bx % 8) * (F.G / 8) + bx / 8 : bx; }
    F.a = &args; F.ws = args.ws;
    volatile LAS unsigned* ctlw = (volatile LAS unsigned*)(F.lds + LDS_CTL);
    if (threadIdx.x < 16) ctlw[threadIdx.x] = 0u;
    __syncthreads();
    XcdBarrier bar = xcd_barrier_post((unsigned*)(F.ws + WS_CTL) + 4096, ctlw);
#define GRID_BAR() xcd_barrier(bar)
#ifdef DBG_TIME
    unsigned long long t_prev = __builtin_amdgcn_s_memrealtime();
#define TSTAMP(cat) do { if (blockIdx.x == 0 && threadIdx.x == 0) { const unsigned long long t_now = __builtin_amdgcn_s_memrealtime(); unsigned long long* tw = (unsigned long long*)(F.ws + WS_CTL) + 64 + (cat); *tw = *tw + (t_now - t_prev); t_prev = t_now; } } while (0)
#else
#define TSTAMP(cat) do {} while (0)
#endif

#ifndef SK_P0
    p0a(F);
#ifdef DUP_P0
    p0a(F);
#endif
#endif
    GRID_BAR();
    p0b(F); GRID_BAR();
    DBGSCAN(1, WS_MOD, (size_t)4 * 2 * NADA * 4, false);
    init_x_by_owners(F);
    row_phase<0>(F, nullptr, nullptr, modp(F, 0, 0, 0), modp(F, 0, 0, 1), modp(F, 0, 1, 0), modp(F, 0, 1, 1)); GRID_BAR(); TSTAMP(0);
    DBGSCAN(2, WS_X, (size_t)T * DM * 4, false); DBGSCAN(3, WS_H, (size_t)T * DM * 2, true);

    const pg8::bf16_t* Hb = (const pg8::bf16_t*)(F.ws + WS_H);
    for (int s = 0; s < 3 * DEPTH; ++s) {
        const int l = s / 3, r = s % 3;
        const pg8::bf16_t* A2; const pg8::bf16_t* B2; int K2;
        if (r != 1) {
            const int f = r >> 1;
            pg8::Gemm g{Hb, (const pg8::bf16_t*)(F.ws + WS_WFI + (size_t)(l * 2 + f) * SZ_WFI), T, 2 * DFF, DM, DM, DM};
            pg8::StaticOrder S; S.init(T, 2 * DFF, F.G, (int)blockIdx.x);
            pg8::EpiSwiGLU E{(pg8::bf16_t*)(F.ws + WS_HID), DFF};
#ifndef SK_SW
            pg8::gemm_phase<pg8::EpiSwiGLU, pg8::StaticOrder>(F.lds, g, S, E);
#endif
#ifdef DUP_SW
            pg8::gemm_phase<pg8::EpiSwiGLU, pg8::StaticOrder>(F.lds, g, S, E);
#endif
            GRID_BAR(); TSTAMP(1);
            DBGSCAN(10 + 10 * s, WS_HID, (size_t)T * DFF * 2, true);
            A2 = (const pg8::bf16_t*)(F.ws + WS_HID); B2 = (const pg8::bf16_t*)(F.ws + WS_WFO + (size_t)(l * 2 + f) * SZ_WFO); K2 = DFF;
        } else if ((l & 1) == 0) {
            const int e = l >> 1;
            { pg8::Gemm g{Hb, (const pg8::bf16_t*)(F.ws + WS_EWI + (size_t)e * SZ_EWI), T, EV_N, DM, DM, DM};
              pg8::StaticOrder S; S.init(T, EV_N, F.G, (int)blockIdx.x);
              pg8::EpiBf16 E{(pg8::bf16_t*)(F.ws + WS_PROJ), EV_N};
#ifndef SK_G1
              pg8::gemm_phase<pg8::EpiBf16, pg8::StaticOrder>(F.lds, g, S, E);
#endif
            }
            GRID_BAR(); TSTAMP(4);
            DBGSCAN(10 + 10 * s, WS_PROJ, (size_t)T * EV_N * 2 - 0, true);
#ifdef DBG
            if (s == 1) dbg_max(F, WS_PROJ, (size_t)T * EV_N * 2, true);
#endif
#ifndef SK_S1
            s1_phase(F, e);
#ifdef DUP_S1
            s1_phase(F, e);
#endif
#endif
            GRID_BAR(); TSTAMP(5);
            DBGSCAN(11 + 10 * s, WS_U, SZ_U, true); DBGSCAN(16 + 10 * s, WS_OI, (size_t)T * DM * 4, false); DBGSCAN(17 + 10 * s, WS_QT, (size_t)2 * T * 1024 * 2, true); DBGSCAN(18 + 10 * s, WS_DEC, (size_t)2 * 8 * NCH * 128 * 4, false);
#ifndef SK_S2
            s2_phase(F);
#ifdef DUP_S2
            s2_phase(F);
#endif
#endif
            GRID_BAR(); TSTAMP(6);
            DBGSCAN(12 + 10 * s, WS_S, SZ_U, true);
#ifndef SK_S3
            s3_phase(F, e);
#ifdef DUP_S3
            s3_phase(F, e);
#endif
#endif
            GRID_BAR(); TSTAMP(7);
            DBGSCAN(13 + 10 * s, WS_MIX, (size_t)T * DM * 2, true);
            A2 = (const pg8::bf16_t*)(F.ws + WS_MIX); B2 = (const pg8::bf16_t*)(F.ws + WS_EWO + (size_t)e * SZ_SQ); K2 = DM;
        } else {
            const int o = l >> 1;
            { pg8::Gemm g{Hb, (const pg8::bf16_t*)(F.ws + WS_OWI + (size_t)o * SZ_OWI), T, OD_N, DM, DM, DM};
              pg8::StaticOrder S; S.init(T, OD_N, F.G, (int)blockIdx.x);
              pg8::EpiBf16 E{(pg8::bf16_t*)(F.ws + WS_PROJ), OD_N};
#ifndef SK_G2
              pg8::gemm_phase<pg8::EpiBf16, pg8::StaticOrder>(F.lds, g, S, E);
#endif
            }
            GRID_BAR();
#ifndef SK_E1
            e1_phase(F, o);
#endif
            GRID_BAR();
            DBGSCAN(11 + 10 * s, WS_CQN, (size_t)T * 512 * 2 * 2, true); DBGSCAN(11 + 10 * s, WS_KR, (size_t)T * 64 * 2, true);
            for (int q = 0; q < 2; ++q) {
                pg8::Gemm g{(const pg8::bf16_t*)(F.ws + (q ? WS_CKVN : WS_CQN)), (const pg8::bf16_t*)(F.ws + (q ? WS_OUKV + (size_t)o * SZ_OUKV : WS_OUQ + (size_t)o * SZ_OUQ)), T, q ? 4096 : 3072, 512, 512, 512};
                pg8::StaticOrder S; S.init(T, g.N, F.G, (int)blockIdx.x);
                pg8::EpiBf16 E{(pg8::bf16_t*)(F.ws + (q ? WS_KVB : WS_QB)), g.N};
#ifndef SK_G3
                pg8::gemm_phase<pg8::EpiBf16, pg8::StaticOrder>(F.lds, g, S, E);
#endif
            }
            GRID_BAR(); TSTAMP(8);
            DBGSCAN(12 + 10 * s, WS_QB, (size_t)T * 3072 * 2, true); DBGSCAN(12 + 10 * s, WS_KVB, (size_t)T * 4096 * 2, true);
#ifndef SK_ATT
            attn_phase(F);
#ifdef DUP_ATT
            attn_phase(F);
#endif
#endif
            GRID_BAR(); TSTAMP(9);
            DBGSCAN(13 + 10 * s, WS_MIX, (size_t)T * DM * 2, true);
            A2 = (const pg8::bf16_t*)(F.ws + WS_MIX); B2 = (const pg8::bf16_t*)(F.ws + WS_OWO + (size_t)o * SZ_SQ); K2 = DM;
        }
        {
            pg8::Gemm g{A2 + (size_t)NCTX * K2, B2, NLAT, DM, K2, K2, K2};
            pg8::StaticOrder S; S.init(NLAT, DM, F.G, (int)blockIdx.x);
            const int sp = s > 0 ? s - 1 : 0;
            const float* plng = F.a->in[6] + (size_t)sp * DM; const float* plnb = F.a->in[7] + (size_t)sp * DM; const float* stat = (const float*)(F.ws + WS_STAT);
            pg8::EpiResid E{(float*)(F.ws + WS_X) + (size_t)NCTX * DM, modp(F, l, 0, 3 * r + 2), (r != 1) ? 0.5f : 1.0f, stat + (size_t)NCTX * 2, plng, plnb, s > 0 ? 1 : 0};
            ctx_resid_small(F, (float*)(F.ws + WS_X), (const bf16*)A2, (const bf16*)B2, K2, modp(F, l, 1, 3 * r + 2), (r != 1) ? 0.5f : 1.0f, stat, plng, plnb, s > 0 ? 1 : 0, 1);
#ifndef SK_RES
            pg8::gemm_phase<pg8::EpiResid, pg8::StaticOrder, RES_ALIGN, RES_SP2>(F.lds, g, S, E);
#endif
            ctx_resid_small(F, (float*)(F.ws + WS_X), (const bf16*)A2, (const bf16*)B2, K2, modp(F, l, 1, 3 * r + 2), (r != 1) ? 0.5f : 1.0f, stat, plng, plnb, s > 0 ? 1 : 0, 0);
#ifdef DUP_SMALL_OFF
            ctx_resid_small(F, (float*)(F.ws + WS_OI), (const bf16*)A2, (const bf16*)B2, K2, modp(F, l, 1, 3 * r + 2), (r != 1) ? 0.5f : 1.0f);
            ctx_resid_small(F, (float*)(F.ws + WS_OI), (const bf16*)A2, (const bf16*)B2, K2, modp(F, l, 1, 3 * r + 2), (r != 1) ? 0.5f : 1.0f);
#endif
#ifdef DUP_RES
            { pg8::EpiResid E2{(float*)(F.ws + WS_OI) + (size_t)NCTX * DM, modp(F, l, 0, 3 * r + 2), 0.5f, stat, plng, plnb, 0};
              pg8::gemm_phase<pg8::EpiResid, pg8::StaticOrder>(F.lds, g, S, E2); }
#endif
        }
        GRID_BAR(); TSTAMP(r != 1 ? 2 : 10);
        DBGSCAN(14 + 10 * s, WS_X, (size_t)T * DM * 4, false);
        const float* lng = F.a->in[6] + (size_t)(l * 3 + r) * DM; const float* lnb = F.a->in[7] + (size_t)(l * 3 + r) * DM;
        if (s + 1 < 3 * DEPTH) { const int l2 = (s + 1) / 3, r2 = (s + 1) % 3;
            row_phase<1>(F, lng, lnb, modp(F, l2, 0, 3 * r2), modp(F, l2, 0, 3 * r2 + 1), modp(F, l2, 1, 3 * r2), modp(F, l2, 1, 3 * r2 + 1));
            GRID_BAR(); TSTAMP(3);
            DBGSCAN(15 + 10 * s, WS_X, (size_t)T * DM * 4, false); DBGSCAN(15 + 10 * s, WS_H, (size_t)T * DM * 2, true);
#if defined(DBG) && defined(DBG_STOP)
            if (s == DBG_STOP) break;
#endif
        } else {
#ifndef DBG
            row_phase<2>(F, lng, lnb, nullptr, nullptr, nullptr, nullptr);
#endif
        }
    }
#ifdef DBG_TIME
    {   PHASE_IDS(); GRID_BAR();
        const unsigned long long* tw = (const unsigned long long*)(F.ws + WS_CTL) + 64;
        const float tA = (float)__hip_atomic_load(tw + DBG_TA, RLX_AGENT) * 1e-5f, tB = (float)__hip_atomic_load(tw + DBG_TB, RLX_AGENT) * 1e-5f;
        const float cB = DBG_TSCALE * tB, cA = cB; (void)tA;
        float* out = F.a->out;
        for (size_t i = (size_t)F.vcu * NTHR + tid; i < (size_t)NLAT * DM; i += (size_t)F.G * NTHR) out[i] = (i == 12345) ? cA : cB;
    }
#endif
#ifdef DBG
    {
        PHASE_IDS();
        const float* X = (const float*)(F.ws + WS_X); float ssq = 0.f; float cnt = 0.f;
        for (size_t i = (size_t)F.vcu * NTHR + tid; i < (size_t)T * DM; i += (size_t)F.G * NTHR) { const float v = X[i]; if ((__float_as_uint(v) & 0x7f800000u) != 0x7f800000u) { ssq += v * v; cnt += 1.f; } }
        ssq = wave_sum(ssq); cnt = wave_sum(cnt);
        if (lane == 0) { atomicAdd((float*)(F.ws + WS_CTL) + DBG_W_SSQ, ssq); atomicAdd((float*)(F.ws + WS_CTL) + DBG_W_CNT, cnt); }
        GRID_BAR();
        const unsigned badw = __hip_atomic_load((unsigned*)(F.ws + WS_CTL) + DBG_W_BAD, RLX_AGENT);
        const float tss = __hip_atomic_load((float*)(F.ws + WS_CTL) + DBG_W_SSQ, RLX_AGENT), tcn = __hip_atomic_load((float*)(F.ws + WS_CTL) + DBG_W_CNT, RLX_AGENT);
        const float rms = sqrtf(tss / fmaxf(tcn, 1.f)); float cB = fminf(10.f * rms, 1000.f);
#ifdef DBG_REPORT_MAX
        { const unsigned mw = __hip_atomic_load((unsigned*)(F.ws + WS_CTL) + DBG_W_MAX, RLX_AGENT); cB = fminf(log2f(1.0f + __uint_as_float(mw)), 120.f); }
#endif
        const float cA = badw ? (float)(100000u - badw) * 10.f : 5.f;
        float* out = F.a->out;
        for (size_t i = (size_t)F.vcu * NTHR + tid; i < (size_t)NLAT * DM; i += (size_t)F.G * NTHR) out[i] = (i == 12345) ? cA + 0.f : cB;
        (void)cA;
    }
#endif
}

extern "C" void kernel_launch(void* const* d_in, const int* in_sizes, int n_in, void* d_out, int out_size, void* d_ws, size_t ws_size, hipStream_t stream) {
    static int grid = 0;
    if (grid == 0) {
        if (n_in != 23 || out_size != NLAT * DM || ws_size < WS_END) { fprintf(stderr, "kernel_launch: unexpected shapes: n_in %d out %d ws %zu (need %zu)\n", n_in, out_size, ws_size, (size_t)WS_END); grid = -1; return; }
        int dev = 0, cus = 0, per_cu = 0;
        if (hipGetDevice(&dev) != hipSuccess || hipDeviceGetAttribute(&cus, hipDeviceAttributeMultiprocessorCount, dev) != hipSuccess) { grid = -1; return; }
        if (hipFuncSetAttribute((const void*)fwd_kernel, hipFuncAttributeMaxDynamicSharedMemorySize, LDS_BYTES) != hipSuccess) { fprintf(stderr, "kernel_launch: hipFuncSetAttribute failed\n"); grid = -1; return; }
        if (hipOccupancyMaxActiveBlocksPerMultiprocessor(&per_cu, (const void*)fwd_kernel, NTHR, LDS_BYTES) != hipSuccess || per_cu < 1) fprintf(stderr, "kernel_launch: occupancy query reports %d\n", per_cu);
        (void)hipGetLastError();
        grid = cus;
    }
    if (grid < 0) return;
    (void)hipMemsetAsync((char*)d_ws + WS_CTL, 0, CTL_BYTES, stream);
    Args a{};
    for (int i = 0; i < 23; ++i) a.in[i] = (const float*)d_in[i];
    a.out = (float*)d_out; a.ws = (unsigned char*)d_ws;
    hipLaunchKernelGGL(fwd_kernel, dim3(grid), dim3(NTHR), LDS_BYTES, stream, a);
    const hipError_t le = hipPeekAtLastError();
    if (le != hipSuccess) fprintf(stderr, "kernel_launch: launch failed: %s\n", hipGetErrorName(le));
}
```

```cpp
#include <hip/hip_runtime.h>
#include <cstdio>
#include <cstdint>

#define GAS __attribute__((address_space(1)))
#define LAS __attribute__((address_space(3)))
typedef unsigned short bf16;
typedef short bf16x8 __attribute__((ext_vector_type(8)));
typedef short s16x4 __attribute__((ext_vector_type(4)));
typedef float f32x4 __attribute__((ext_vector_type(4)));
typedef float f32x2 __attribute__((ext_vector_type(2)));
typedef float f32x16 __attribute__((ext_vector_type(16)));
typedef unsigned u32x4 __attribute__((ext_vector_type(4)));
typedef unsigned u32x2 __attribute__((ext_vector_type(2)));

constexpr int DM = 2048, NCTX = 256, NLAT = 16384, T = NCTX + NLAT, DEPTH = 4, DFF = 5504;
constexpr int NADA = 9 * DM;
constexpr int EV_N = 6400, OD_N = 1280;
constexpr int NCH = T / 64;
constexpr float DN_ALPHA = 1.6817928305074290f;
constexpr float LN_EPS = 1e-5f, RMS_EPS = 1e-6f;
constexpr int NWAVES = 8, NTHR = 512;
constexpr int LDS_BYTES = 147456;
constexpr int LDS_CTL = LDS_BYTES - 256;

constexpr size_t al256(size_t x) { return (x + 255) / 256 * 256; }
constexpr size_t WS_CTL = 0, CTL_BYTES = 1u << 20;
constexpr size_t WS_MODP = WS_CTL + CTL_BYTES;
constexpr size_t WS_MOD = WS_MODP + al256((size_t)8 * 2 * 4 * NADA * 4);
constexpr size_t WS_RT = WS_MOD + al256((size_t)4 * 2 * NADA * 4);
constexpr size_t WS_AXR = WS_RT + al256((size_t)NLAT * 64 * 8);
constexpr size_t WS_AXC = WS_AXR + al256(256 * 16 * 8);
constexpr size_t WS_STAT = WS_AXC + al256(64 * 16 * 8);
constexpr size_t WS_WFI = WS_STAT + al256((size_t)T * 8);
constexpr size_t SZ_WFI = (size_t)2 * DFF * DM * 2;
constexpr size_t WS_WFO = WS_WFI + 8 * SZ_WFI;
constexpr size_t SZ_WFO = (size_t)DM * DFF * 2;
constexpr size_t WS_EWI = WS_WFO + 8 * SZ_WFO;
constexpr size_t SZ_EWI = (size_t)EV_N * DM * 2;
constexpr size_t WS_EWO = WS_EWI + 2 * SZ_EWI;
constexpr size_t SZ_SQ = (size_t)DM * DM * 2;
constexpr size_t WS_OWI = WS_EWO + 2 * SZ_SQ;
constexpr size_t SZ_OWI = (size_t)OD_N * DM * 2;
constexpr size_t WS_OUQ = WS_OWI + 2 * SZ_OWI;
constexpr size_t SZ_OUQ = (size_t)3072 * 512 * 2;
constexpr size_t WS_OUKV = WS_OUQ + 2 * SZ_OUQ;
constexpr size_t SZ_OUKV = (size_t)4096 * 512 * 2;
constexpr size_t WS_OWO = WS_OUKV + 2 * SZ_OUKV;
constexpr size_t WS_X = WS_OWO + 2 * SZ_SQ;
constexpr size_t WS_H = WS_X + (size_t)T * DM * 4;
constexpr size_t WS_HID = WS_H + (size_t)T * DM * 2;
constexpr size_t WS_MIX = WS_HID + (size_t)T * DFF * 2;
constexpr size_t WS_PROJ = WS_MIX + (size_t)T * DM * 2;
constexpr size_t WS_U = WS_PROJ + (size_t)T * EV_N * 2;
constexpr size_t SZ_U = (size_t)2 * 8 * NCH * 256 * 128 * 2;
constexpr size_t WS_S = WS_U + SZ_U;
constexpr size_t WS_OI = WS_S + SZ_U;
constexpr size_t WS_QT = WS_OI + (size_t)T * DM * 4;
constexpr size_t WS_DEC = WS_QT + (size_t)2 * T * 1024 * 2;
constexpr size_t WS_END_EVEN = WS_DEC + al256((size_t)2 * 8 * NCH * 128 * 4);
constexpr size_t WS_CQN = WS_U;
constexpr size_t WS_CKVN = WS_CQN + (size_t)T * 512 * 2;
constexpr size_t WS_KR = WS_CKVN + (size_t)T * 512 * 2;
constexpr size_t WS_QB = WS_KR + al256((size_t)T * 64 * 2);
constexpr size_t WS_KVB = WS_QB + (size_t)T * 3072 * 2;
constexpr size_t WS_END_ODD = WS_KVB + (size_t)T * 4096 * 2;
constexpr size_t WS_END = WS_END_EVEN > WS_END_ODD ? WS_END_EVEN : WS_END_ODD;

#define RLX_AGENT __ATOMIC_RELAXED, __HIP_MEMORY_SCOPE_AGENT
#define LDS_WAIT() asm volatile("s_waitcnt lgkmcnt(0)" ::: "memory")
#define VM_WAIT() asm volatile("s_waitcnt vmcnt(0)" ::: "memory")
__device__ __forceinline__ unsigned cvt_pk_bf16(float lo, float hi) { unsigned r; asm volatile("v_cvt_pk_bf16_f32 %0, %1, %2" : "=v"(r) : "v"(lo), "v"(hi)); return r; }
__device__ __forceinline__ float bflo(unsigned w) { return __uint_as_float(w << 16); }
__device__ __forceinline__ float bfhi(unsigned w) { return __uint_as_float(w & 0xffff0000u); }
__device__ __forceinline__ float bf2f(bf16 b) { return __uint_as_float(((unsigned)b) << 16); }
__device__ __forceinline__ bf16 f2bf(float f) { return (bf16)(cvt_pk_bf16(f, 0.f) & 0xffffu); }
__device__ __forceinline__ float wave_sum(float v) {
#pragma unroll
    for (int o = 1; o < 64; o <<= 1) v += __shfl_xor(v, o);
    return v;
}
__device__ __forceinline__ float silu_f(float g) { return g * __builtin_amdgcn_rcpf(1.0f + __builtin_amdgcn_exp2f(-1.4426950408889634f * g)); }

namespace pg8 {
#define PG8_LAS __attribute__((address_space(3)))
typedef unsigned short bf16_t;
constexpr int BM = 256, BK = 64, HALF = 128, HTB = HALF * BK * 2, STAGE_BYTES = 8 * HTB, NXCD = 8, WGM = 8;
__host__ __device__ __forceinline__ int lds_byte(int r, int c) { const int st = (r >> 4) * 2 + (c >> 5), rr = r & 15, cc = c & 31, ob = rr * 64 + cc * 2; return st * 1024 + (ob ^ (((ob >> 9) & 1) << 5)); }
__host__ __device__ __forceinline__ void stage_rc(int b, int& R, int& C) { const int st = b / 1024, sb = b % 1024, swz = sb ^ (((sb >> 9) & 1) << 5); R = (st >> 1) * 16 + swz / 64; C = (st & 1) * 32 + (swz % 64) / 2; }
__host__ __device__ __forceinline__ int perm32(int rho) { const int n = rho >> 4, i = rho & 15; return 8 * (i >> 2) + 4 * n + (i & 3); }
struct Unit { int pm, pn; };
struct Gemm { const bf16_t* A; const bf16_t* Bt; int M, N, K, lda, ldb; };
struct StaticOrder {
    int nM, nN, nwg, G, c;
    __host__ __device__ void init(int M, int N, int G_, int c_) { nM = M / BM; nN = N / BM; nwg = nM * nN; G = G_; c = c_; }
    __host__ __device__ bool next(int i, Unit& u) const {
        const long L = (long)i * G + c; if (L >= nwg) return false;
        int wgid = (int)L; { const int q = nwg / NXCD, r = nwg % NXCD, xcd = wgid % NXCD, off = wgid / NXCD; wgid = (xcd < r ? xcd * (q + 1) : r * (q + 1) + (xcd - r) * q) + off; }
        const int nig = WGM * nN, gid = wgid / nig, fm = gid * WGM, gsz = (nM - fm) < WGM ? (nM - fm) : WGM;
        u.pm = fm + ((wgid % nig) % gsz); u.pn = (wgid % nig) / gsz; return true;
    }
    __device__ __forceinline__ void a_ready(const Unit&) const {}
    __device__ __forceinline__ void done(const Unit&) const {}
};
struct EpiBf16 {
    static constexpr bool PERM = true;
    bf16_t* O; int ldc;
    __device__ __forceinline__ void operator()(const f32x4 (&acc)[2][2][4][2], const Unit& u, int wr, int wc, int fr, int fq) const {
        const int row0 = u.pm * BM + wr * 64 + fr, col0 = u.pn * BM + wc * 32 + 8 * fq;
        asm volatile("s_nop 15" ::: "memory");
#pragma unroll
        for (int ai = 0; ai < 2; ++ai)
#pragma unroll
            for (int m = 0; m < 4; ++m) { bf16_t* rowp = O + (size_t)(row0 + ai * HALF + m * 16) * ldc + col0;
#pragma unroll
                for (int bj = 0; bj < 2; ++bj) { const f32x4 v0 = acc[ai][bj][m][0], v1 = acc[ai][bj][m][1];
                    u32x4 w; w.x = cvt_pk_bf16(v0[0], v0[1]); w.y = cvt_pk_bf16(v0[2], v0[3]); w.z = cvt_pk_bf16(v1[0], v1[1]); w.w = cvt_pk_bf16(v1[2], v1[3]);
                    *(u32x4*)(rowp + bj * HALF) = w; } }
    }
};
struct EpiSwiGLU {
    static constexpr bool PERM = true;
    bf16_t* O; int ldc;
    __device__ __forceinline__ void operator()(const f32x4 (&acc)[2][2][4][2], const Unit& u, int wr, int wc, int fr, int fq) const {
        const int row0 = u.pm * BM + wr * 64 + fr, col0 = u.pn * HALF + wc * 32 + 8 * fq;
#pragma unroll
        for (int ai = 0; ai < 2; ++ai)
#pragma unroll
            for (int m = 0; m < 4; ++m) { bf16_t* rowp = O + (size_t)(row0 + ai * HALF + m * 16) * ldc + col0;
                float h[8];
#pragma unroll
                for (int n = 0; n < 2; ++n)
#pragma unroll
                    for (int j = 0; j < 4; ++j) h[n * 4 + j] = silu_f(acc[ai][0][m][n][j]) * acc[ai][1][m][n][j];
                u32x4 w; w.x = cvt_pk_bf16(h[0], h[1]); w.y = cvt_pk_bf16(h[2], h[3]); w.z = cvt_pk_bf16(h[4], h[5]); w.w = cvt_pk_bf16(h[6], h[7]);
                *(u32x4*)rowp = w; asm volatile("" ::: "memory"); }
    }
};
struct EpiResid {
    static constexpr bool PERM = true;
    float* X; const float* gv; float gs; const float* stat; const float* lng; const float* lnb; int has_ln;
    __device__ __forceinline__ void operator()(const f32x4 (&acc)[2][2][4][2], const Unit& u, int wr, int wc, int fr, int fq) const {
        const int row0 = u.pm * BM + wr * 64 + fr, col0 = u.pn * BM + wc * 32 + 8 * fq;
        f32x2 st[2][4];
#pragma unroll
        for (int ai = 0; ai < 2; ++ai)
#pragma unroll
            for (int m = 0; m < 4; ++m) { st[ai][m] = has_ln ? *(const f32x2*)(stat + (size_t)(row0 + ai * HALF + m * 16) * 2) : (f32x2){0.f, 1.f}; st[ai][m].y *= DN_ALPHA; }
#pragma unroll
        for (int bj = 0; bj < 2; ++bj) { const int c = col0 + bj * HALF;
            f32x4 g[2], G[2], B[2];
#pragma unroll
            for (int n = 0; n < 2; ++n) { g[n] = *(const f32x4*)(gv + c + 4 * n) * gs;
                G[n] = has_ln ? *(const f32x4*)(lng + c + 4 * n) : (f32x4){1.f, 1.f, 1.f, 1.f}; B[n] = has_ln ? *(const f32x4*)(lnb + c + 4 * n) * DN_ALPHA : (f32x4){0.f, 0.f, 0.f, 0.f}; }
#pragma unroll
            for (int ai = 0; ai < 2; ++ai)
#pragma unroll
                for (int m = 0; m < 4; ++m) { float* p = X + (size_t)(row0 + ai * HALF + m * 16) * DM + c;
                    const f32x4 z0 = *(const f32x4*)p, z1 = *(const f32x4*)(p + 4);
                    *(f32x4*)p = (z0 - st[ai][m].x) * st[ai][m].y * G[0] + B[0] + g[0] * acc[ai][bj][m][0];
                    *(f32x4*)(p + 4) = (z1 - st[ai][m].x) * st[ai][m].y * G[1] + B[1] + g[1] * acc[ai][bj][m][1]; }
            asm volatile("" ::: "memory"); }
    }
};

template <class Epi, class Sched, bool ALIGN_EPI = true, bool SP2 = true>
__device__ __forceinline__ void gemm_phase(PG8_LAS unsigned char* lds, const Gemm g, const Sched& S, const Epi& E) {
    int tid = threadIdx.x; asm volatile("" : "+v"(tid));
    const int wid = __builtin_amdgcn_readfirstlane(tid >> 6), lane = tid & 63, wr = wid >> 2, wc = wid & 3, fr = lane & 15, fq = lane >> 4;
    const int K = g.K, nt = K / BK;
    unsigned voffA[2], voffB[2];
#pragma unroll
    for (int i = 0; i < 2; ++i) { int R, C; stage_rc(tid * 16 + i * 8192, R, C); const int Rb = Epi::PERM ? ((R & ~31) + perm32(R & 31)) : R;
        voffA[i] = (unsigned)(R * g.lda + C) * 2u; voffB[i] = (unsigned)(Rb * g.ldb + C) * 2u; }
    const size_t kstep = (size_t)(BK * 2);
    const size_t hstepA = (size_t)HALF * g.lda * 2, hstepB = (size_t)HALF * g.ldb * 2;
    const size_t tstepA = 2 * hstepA, tstepB = 2 * hstepB;
    const unsigned ldsw = (unsigned)wid * 1024u;
    const int aoff = lds_byte(wr * 64 + fr, fq * 8), boff = lds_byte(wc * 32 + fr, fq * 8);
#define PG8_SA(b, h) (((b) * 2 + (h)) * HTB)
#define PG8_SB(b, h) ((4 + (b) * 2 + (h)) * HTB)
#define PG8_STAGE(bufoff, gbase, voff) do { _Pragma("unroll") for (int _i = 0; _i < 2; ++_i) \
        __builtin_amdgcn_global_load_lds((const unsigned*)((const char*)(gbase) + (voff)[_i]), (PG8_LAS unsigned*)(lds + (bufoff) + ldsw + _i * 8192), 16, 0, 0); } while (0)
#define PG8_LDA(dst, b, h) do { _Pragma("unroll") for (int m = 0; m < 4; ++m) _Pragma("unroll") for (int k = 0; k < 2; ++k) dst[m][k] = *(const PG8_LAS bf16x8*)(lds + PG8_SA(b, h) + aoff + m * 2048 + k * 1024); } while (0)
#define PG8_LDB(dst, b, h) do { _Pragma("unroll") for (int n = 0; n < 2; ++n) _Pragma("unroll") for (int k = 0; k < 2; ++k) dst[n][k] = *(const PG8_LAS bf16x8*)(lds + PG8_SB(b, h) + boff + n * 2048 + k * 1024); } while (0)
#define PG8_MMA(ai, bj, At, Bt) do { __builtin_amdgcn_s_setprio(1); _Pragma("unroll") for (int m = 0; m < 4; ++m) _Pragma("unroll") for (int n = 0; n < 2; ++n) _Pragma("unroll") for (int k = 0; k < 2; ++k) \
        acc[ai][bj][m][n] = __builtin_amdgcn_mfma_f32_16x16x32_bf16(Bt[n][k], At[m][k], acc[ai][bj][m][n], 0, 0, 0); __builtin_amdgcn_s_setprio(0); } while (0)
#define PG8_WAIT_V(n) asm volatile("s_waitcnt vmcnt(" #n ")" ::: "memory")
#define PG8_WAIT_L(n) asm volatile("s_waitcnt lgkmcnt(" #n ")" ::: "memory")
#define PG8_BAR __builtin_amdgcn_s_barrier()
#define PG8_SCHED __builtin_amdgcn_sched_barrier(0)
    Unit cur, nxt; int ui = 0;
    if (!S.next(0, cur)) return;
    f32x4 acc[2][2][4][2];
#pragma unroll
    for (int a = 0; a < 2; ++a)
#pragma unroll
        for (int b = 0; b < 2; ++b)
#pragma unroll
            for (int m = 0; m < 4; ++m)
#pragma unroll
                for (int n = 0; n < 2; ++n) acc[a][b][m][n] = (f32x4){0.f, 0.f, 0.f, 0.f};
    bf16x8 At[4][2], B0[2][2], B1[2][2];
    const char* cA = (const char*)g.A + (size_t)cur.pm * tstepA; const char* cB = (const char*)g.Bt + (size_t)cur.pn * tstepB;
    S.a_ready(cur);
    if constexpr (SP2) {
        PG8_STAGE(PG8_SB(0, 0), cB, voffB); PG8_STAGE(PG8_SB(0, 1), cB + hstepB, voffB); PG8_STAGE(PG8_SA(0, 0), cA, voffA); PG8_STAGE(PG8_SA(0, 1), cA + hstepA, voffA);
        if (wr == 1) PG8_BAR;
        PG8_WAIT_V(2); PG8_BAR;
        PG8_STAGE(PG8_SB(1, 0), cB + kstep, voffB); PG8_STAGE(PG8_SA(1, 0), cA + kstep, voffA); PG8_STAGE(PG8_SB(1, 1), cB + hstepB + kstep, voffB);
        PG8_WAIT_V(6); PG8_BAR;
    } else {
        PG8_STAGE(PG8_SB(0, 0), cB, voffB); PG8_STAGE(PG8_SA(0, 0), cA, voffA); PG8_STAGE(PG8_SB(0, 1), cB + hstepB, voffB); PG8_STAGE(PG8_SA(0, 1), cA + hstepA, voffA);
        if (wr == 1) PG8_BAR;
        PG8_WAIT_V(4); PG8_BAR;
        PG8_STAGE(PG8_SB(1, 0), cB + kstep, voffB); PG8_STAGE(PG8_SA(1, 0), cA + kstep, voffA); PG8_STAGE(PG8_SB(1, 1), cB + hstepB + kstep, voffB);
        PG8_WAIT_V(6); PG8_BAR;
    }
    for (;;) {
        const bool has_next = S.next(ui + 1, nxt);
        const char* nA = has_next ? (const char*)g.A + (size_t)nxt.pm * tstepA : cA; const char* nB = has_next ? (const char*)g.Bt + (size_t)nxt.pn * tstepB : cB;
        for (int t = 0; t < nt; t += 2) {
            const bool last = (t == nt - 2);
            const char* a1 = cA + (size_t)(t + 1) * kstep;
            const char* a2 = last ? nA : cA + (size_t)(t + 2) * kstep; const char* b2 = last ? nB : cB + (size_t)(t + 2) * kstep;
            const char* a3 = a2 + kstep; const char* b3 = b2 + kstep;
            if (last && has_next) S.a_ready(nxt);
            if constexpr (SP2) {
            PG8_LDB(B0, 0, 0); PG8_LDB(B1, 0, 1); PG8_SCHED; PG8_LDA(At, 0, 0); PG8_STAGE(PG8_SA(1, 1), a1 + hstepA, voffA);
            PG8_WAIT_V(8); PG8_WAIT_L(0); PG8_BAR; PG8_MMA(0, 0, At, B0); PG8_MMA(0, 1, At, B1); PG8_BAR; PG8_SCHED;
            PG8_LDA(At, 0, 1); PG8_STAGE(PG8_SB(0, 0), b2, voffB); PG8_STAGE(PG8_SB(0, 1), b2 + hstepB, voffB); PG8_STAGE(PG8_SA(0, 0), a2, voffA);
            PG8_WAIT_V(8); PG8_WAIT_L(0); PG8_BAR; PG8_MMA(1, 0, At, B0); PG8_MMA(1, 1, At, B1); PG8_BAR; PG8_SCHED;
            PG8_LDB(B0, 1, 0); PG8_LDB(B1, 1, 1); PG8_SCHED; PG8_LDA(At, 1, 0); PG8_STAGE(PG8_SA(0, 1), a2 + hstepA, voffA);
            PG8_WAIT_V(8); PG8_WAIT_L(0); PG8_BAR; PG8_MMA(0, 0, At, B0); PG8_MMA(0, 1, At, B1); PG8_BAR; PG8_SCHED;
            PG8_LDA(At, 1, 1); PG8_STAGE(PG8_SB(1, 0), b3, voffB); PG8_STAGE(PG8_SB(1, 1), b3 + hstepB, voffB); PG8_STAGE(PG8_SA(1, 0), a3, voffA);
            PG8_WAIT_V(8); PG8_WAIT_L(0); PG8_BAR; PG8_MMA(1, 0, At, B0); PG8_MMA(1, 1, At, B1); PG8_BAR; PG8_SCHED;
            } else {
            PG8_LDB(B0, 0, 0); PG8_SCHED; PG8_LDA(At, 0, 0); PG8_STAGE(PG8_SA(1, 1), a1 + hstepA, voffA);
            PG8_WAIT_L(8); PG8_BAR; PG8_WAIT_L(0); PG8_MMA(0, 0, At, B0); PG8_BAR; PG8_SCHED;
            PG8_LDB(B1, 0, 1); PG8_STAGE(PG8_SB(0, 0), b2, voffB);
            PG8_BAR; PG8_WAIT_L(0); PG8_MMA(0, 1, At, B1); PG8_BAR;
            PG8_LDA(At, 0, 1); PG8_STAGE(PG8_SA(0, 0), a2, voffA);
            PG8_BAR; PG8_WAIT_L(0); PG8_MMA(1, 0, At, B0); PG8_BAR; PG8_SCHED;
            PG8_STAGE(PG8_SB(0, 1), b2 + hstepB, voffB);
            PG8_WAIT_V(6); PG8_BAR; PG8_MMA(1, 1, At, B1); PG8_BAR;
            PG8_LDB(B0, 1, 0); PG8_SCHED; PG8_LDA(At, 1, 0); PG8_STAGE(PG8_SA(0, 1), a2 + hstepA, voffA);
            PG8_WAIT_L(8); PG8_BAR; PG8_WAIT_L(0); PG8_MMA(0, 0, At, B0); PG8_BAR; PG8_SCHED;
            PG8_LDB(B1, 1, 1); PG8_STAGE(PG8_SB(1, 0), b3, voffB);
            PG8_BAR; PG8_WAIT_L(0); PG8_MMA(0, 1, At, B1); PG8_BAR;
            PG8_LDA(At, 1, 1); PG8_STAGE(PG8_SA(1, 0), a3, voffA);
            PG8_BAR; PG8_WAIT_L(0); PG8_MMA(1, 0, At, B0); PG8_BAR; PG8_SCHED;
            PG8_STAGE(PG8_SB(1, 1), b3 + hstepB, voffB);
            PG8_WAIT_V(6); PG8_BAR; PG8_MMA(1, 1, At, B1); PG8_BAR;
            }
        }
        if constexpr (ALIGN_EPI) { if (wr == 0) PG8_BAR; }
        E(acc, cur, wr, wc, fr, fq); S.done(cur);
        if (!has_next) break;
#pragma unroll
        for (int a = 0; a < 2; ++a)
#pragma unroll
            for (int b = 0; b < 2; ++b)
#pragma unroll
                for (int m = 0; m < 4; ++m)
#pragma unroll
                    for (int n = 0; n < 2; ++n) acc[a][b][m][n] = (f32x4){0.f, 0.f, 0.f, 0.f};
        cur = nxt; cA = nA; cB = nB; ++ui;
        if constexpr (ALIGN_EPI) { if (wr == 1) PG8_BAR; }
    }
    PG8_WAIT_V(0);
    if constexpr (!ALIGN_EPI) { if (wr == 0) PG8_BAR; }
    PG8_BAR;
#undef PG8_SA
#undef PG8_SB
#undef PG8_STAGE
#undef PG8_LDA
#undef PG8_LDB
#undef PG8_MMA
#undef PG8_WAIT_V
#undef PG8_WAIT_L
#undef PG8_BAR
#undef PG8_SCHED
}
}

#define XB_TMO      128
#define XB_XCNT(j)  (256  + 64 * (j))
#define XB_XSUB(j)  (1280 + 64 * (j))
#define XB_XGEN(j)  (2304 + 64 * (j))
#define XB_TOP      3328
#define XB_TOPGEN   3392
#define XCD_BAR_WORDS 3456
#define XB_SPIN_CAP (1u << 18)
__device__ __forceinline__ unsigned xb_ld(unsigned* p)              { return __hip_atomic_load(p, __ATOMIC_RELAXED, __HIP_MEMORY_SCOPE_AGENT); }
__device__ __forceinline__ unsigned xb_add(unsigned* p, unsigned v) { return __hip_atomic_fetch_add(p, v, __ATOMIC_RELAXED, __HIP_MEMORY_SCOPE_AGENT); }
__device__ __forceinline__ unsigned xb_xcc_id() { return (unsigned)__builtin_amdgcn_s_getreg((3 << 11) | 20) & 0xFu; }
#define XB_SPIN(cond, bar) do { unsigned _sp = 0; while (cond) { __builtin_amdgcn_s_sleep(1); \
    if ((++_sp & 255u) == 0u) { if (xb_ld(&(bar)[XB_TMO])) break; if (_sp > XB_SPIN_CAP) { atomicAdd(&(bar)[XB_TMO], 1u); break; } } } } while (0)
struct XcdBarrier { unsigned* bar; unsigned x; volatile LAS unsigned* st; };
__device__ __forceinline__ XcdBarrier xcd_barrier_post(unsigned* bar, volatile LAS unsigned* st) {
    XcdBarrier b; b.bar = bar; b.x = xb_xcc_id(); b.st = st;
    if (threadIdx.x == 0) (void)xb_add(&bar[XB_XCNT(b.x)], 1u);
    return b;
}
__device__ __forceinline__ void xcd_barrier_complete(unsigned* bar, unsigned x, unsigned& nloc, unsigned& nx) {
    const unsigned G = gridDim.x * gridDim.y * gridDim.z;
    unsigned sum, cnt, mine, sp = 0u;
    for (;;) {
        sum = 0u; cnt = 0u; mine = 0u;
#pragma unroll
        for (unsigned j = 0; j < 16; ++j) { const unsigned c = xb_ld(&bar[XB_XCNT(j)]); sum += c; cnt += (c > 0u) ? 1u : 0u; mine = (j == x) ? c : mine; }
        if (sum == G) break;
        __builtin_amdgcn_s_sleep(1);
        if ((++sp & 255u) == 0u) { if (xb_ld(&bar[XB_TMO])) break; if (sp > XB_SPIN_CAP) { atomicAdd(&bar[XB_TMO], 1u); break; } }
    }
    nloc = mine > 0u ? mine : 1u; nx = cnt > 0u ? cnt : 1u;
}
__device__ __forceinline__ void xcd_barrier(const XcdBarrier& b0) {
    asm volatile("s_waitcnt vmcnt(0)" ::: "memory");
    __syncthreads();
    if (threadIdx.x == 0) {
        XcdBarrier b = b0; b.x = xb_xcc_id();
        unsigned* bar = b.bar;
        __builtin_amdgcn_s_waitcnt(0);
        unsigned nloc = b.st[0], nx = b.st[1];
        if (nloc == 0u) { xcd_barrier_complete(bar, b.x, nloc, nx); b.st[0] = nloc; b.st[1] = nx; }
        const unsigned old = xb_add(&bar[XB_XSUB(b.x)], 1u);
        const unsigned gen = old / nloc;
        if (old + 1u == (gen + 1u) * nloc) {
            __builtin_amdgcn_fence(__ATOMIC_RELEASE, "agent");
            asm volatile("s_waitcnt vmcnt(0)" ::: "memory");
            const unsigned og = xb_add(&bar[XB_TOP], 1u);
            const unsigned tg = og / nx;
            if (og + 1u == (tg + 1u) * nx) xb_add(&bar[XB_TOPGEN], 1u);
            else XB_SPIN(xb_ld(&bar[XB_TOPGEN]) == tg, bar);
            __builtin_amdgcn_fence(__ATOMIC_ACQUIRE, "agent");
            xb_add(&bar[XB_XGEN(b.x)], 1u);
            asm volatile("s_waitcnt vmcnt(0)" ::: "memory");
        } else {
            XB_SPIN(xb_ld(&bar[XB_XGEN(b.x)]) == gen, bar);
            __builtin_amdgcn_fence(__ATOMIC_ACQUIRE, "agent");
            asm volatile("s_waitcnt vmcnt(0)" ::: "memory");
        }
    }
    __syncthreads();
}

struct Args { const float* in[23]; float* out; unsigned char* ws; };
struct Frame {
    LAS unsigned char* lds;
    int vcu, G;
    const Args* a; unsigned char* ws;
};
#define PHASE_IDS() int tid = threadIdx.x; asm volatile("" : "+v"(tid)); const int lane = tid & 63, wave = __builtin_amdgcn_readfirstlane(tid >> 6); (void)lane; (void)wave
#define MFMA16(a, b, c) __builtin_amdgcn_mfma_f32_16x16x32_bf16((a), (b), (c), 0, 0, 0)
#define MFMA32(a, b, c) __builtin_amdgcn_mfma_f32_32x32x16_bf16((a), (b), (c), 0, 0, 0)

constexpr float ATT_QSCALE = 0.07216878364870322f * 1.4426950408889634f;
__device__ __forceinline__ void tr_item(const float* W, int N, int K, bf16* WT, int k0, int n0, int drow0, LAS float* scr, int lane, float sc = 1.0f) {
#pragma unroll 8
    for (int i = 0; i < 32; ++i) { const int kk = 2 * i + (lane >> 5); scr[kk * 33 + (lane & 31)] = W[(size_t)(k0 + kk) * N + n0 + (lane & 31)]; }
    LDS_WAIT(); asm volatile("" ::: "memory");
    const int c = lane & 7;
#pragma unroll
    for (int j = 0; j < 4; ++j) { const int n = (lane >> 3) + 8 * j; const LAS float* s = scr + (8 * c) * 33 + n;
        u32x4 o; o.x = cvt_pk_bf16(s[0 * 33] * sc, s[1 * 33] * sc); o.y = cvt_pk_bf16(s[2 * 33] * sc, s[3 * 33] * sc); o.z = cvt_pk_bf16(s[4 * 33] * sc, s[5 * 33] * sc); o.w = cvt_pk_bf16(s[6 * 33] * sc, s[7 * 33] * sc);
        *(u32x4*)(WT + (size_t)(drow0 + n) * K + k0 + 8 * c) = o; }
    LDS_WAIT(); asm volatile("" ::: "memory");
}
__device__ __forceinline__ void p0a(Frame& F) {
    PHASE_IDS();
    LAS float* scr = (LAS float*)(F.lds + wave * 8704);
    LAS float* sv = (LAS float*)(F.lds + 8 * 8704);
    for (int i = tid; i < 2 * DM; i += NTHR) { const float v = (i < DM) ? F.a->in[1][i] : F.a->in[3][i - DM]; sv[i] = v / (1.0f + __expf(-v)); }
    __syncthreads();
    const int gw = F.vcu * NWAVES + wave, NGW = F.G * NWAVES;
    constexpr int I0 = 8 * 32 * 344, I1 = 8 * 86 * 64, I2 = 2 * 32 * 193, I3 = 2 * 32 * 64, I4 = 2 * 32 * 34, I5 = 2 * 8 * 96, I6 = 2 * 8 * 128, I7 = 2 * 32 * 64;
    constexpr int NTR = I0 + I1 + I2 + I3 + I4 + I5 + I6 + I7, NADAI = 8 * 288;
    for (int it = gw; it < NTR + NADAI; it += NGW) {
        int r = it;
        if (r < I0) { const int mat = r / 11008, q = r % 11008, kb = q / 344, nb = q % 344, n0 = nb * 32;
            const int j = n0 < DFF ? n0 : n0 - DFF, drow = (j / 128) * 256 + (j % 128) + (n0 < DFF ? 0 : 128);
            tr_item(F.a->in[8] + (size_t)mat * DM * 2 * DFF, 2 * DFF, DM, (bf16*)(F.ws + WS_WFI + mat * SZ_WFI), kb * 64, n0, drow - 0, scr, lane); continue; } r -= I0;
        if (r < I1) { const int mat = r / 5504, q = r % 5504, kb = q / 64, nb = q % 64;
            tr_item(F.a->in[9] + (size_t)mat * DFF * DM, DM, DFF, (bf16*)(F.ws + WS_WFO + mat * SZ_WFO), kb * 64, nb * 32, nb * 32, scr, lane); continue; } r -= I1;
        if (r < I2) { const int mat = r / 6176, q = r % 6176, kb = q / 193, nb = q % 193, n0 = nb * 32;
            const int drow = n0 < 3072 ? n0 : (n0 < 3104 ? 6144 : n0 - 32);
            tr_item(F.a->in[10] + (size_t)mat * DM * 6176, 6176, DM, (bf16*)(F.ws + WS_EWI + mat * SZ_EWI), kb * 64, n0, drow, scr, lane); continue; } r -= I2;
        if (r < I3) { const int mat = r / 2048, q = r % 2048, kb = q / 64, nb = q % 64;
            tr_item(F.a->in[16] + (size_t)mat * DM * DM, DM, DM, (bf16*)(F.ws + WS_EWO + mat * SZ_SQ), kb * 64, nb * 32, nb * 32, scr, lane); continue; } r -= I3;
        if (r < I4) { const int mat = r / 1088, q = r % 1088, kb = q / 34, nb = q % 34;
            tr_item(F.a->in[17] + (size_t)mat * DM * 1088, 1088, DM, (bf16*)(F.ws + WS_OWI + mat * SZ_OWI), kb * 64, nb * 32, nb * 32, scr, lane); continue; } r -= I4;
        if (r < I5) { const int mat = r / 768, q = r % 768, kb = q / 96, nb = q % 96;
            tr_item(F.a->in[20] + (size_t)mat * 512 * 3072, 3072, 512, (bf16*)(F.ws + WS_OUQ + mat * SZ_OUQ), kb * 64, nb * 32, nb * 32, scr, lane, ATT_QSCALE); continue; } r -= I5;
        if (r < I6) { const int mat = r / 1024, q = r % 1024, kb = q / 128, nb = q % 128;
            tr_item(F.a->in[21] + (size_t)mat * 512 * 4096, 4096, 512, (bf16*)(F.ws + WS_OUKV + mat * SZ_OUKV), kb * 64, nb * 32, nb * 32, scr, lane); continue; } r -= I6;
        if (r < I7) { const int mat = r / 2048, q = r % 2048, kb = q / 64, nb = q % 64;
            tr_item(F.a->in[22] + (size_t)mat * DM * DM, DM, DM, (bf16*)(F.ws + WS_OWO + mat * SZ_SQ), kb * 64, nb * 32, nb * 32, scr, lane); continue; } r -= I7;
        {
            const int ks = r / 288, cg = r % 288, l = cg / 72, n = (cg % 72) * 256 + lane * 4;
            const float* w = F.a->in[4] + ((size_t)l * DM + ks * 256) * NADA + n;
            f32x4 al = {0.f, 0.f, 0.f, 0.f}, ac = {0.f, 0.f, 0.f, 0.f};
#pragma unroll 8
            for (int k = 0; k < 256; ++k) { const f32x4 wv = *(const f32x4*)(w + (size_t)k * NADA); al += wv * sv[ks * 256 + k]; ac += wv * sv[DM + ks * 256 + k]; }
            float* mp = (float*)(F.ws + WS_MODP);
            *(f32x4*)(mp + (size_t)(ks * 2 + 0) * 4 * NADA + l * NADA + n) = al;
            *(f32x4*)(mp + (size_t)(ks * 2 + 1) * 4 * NADA + l * NADA + n) = ac;
        }
    }
    const int gt = F.vcu * NTHR + tid, NGT = F.G * NTHR;
    for (int i = gt; i < NLAT * 64 + 256 * 16 + 64 * 16; i += NGT) {
        int pos, fi; float inv; f32x2* dst;
        if (i < NLAT * 64) { pos = i >> 6; fi = i & 63; inv = __builtin_amdgcn_exp2f(-(float)fi * (13.287712379549449f / 64.0f)); dst = (f32x2*)(F.ws + WS_RT) + i; }
        else if (i < NLAT * 64 + 4096) { const int j = i - NLAT * 64; pos = j >> 4; fi = j & 15; inv = __builtin_amdgcn_exp2f(-(float)fi * (13.287712379549449f / 16.0f)); dst = (f32x2*)(F.ws + WS_AXR) + j; }
        else { const int j = i - NLAT * 64 - 4096; pos = j >> 4; fi = j & 15; inv = __builtin_amdgcn_exp2f(-(float)fi * (13.287712379549449f / 16.0f)); dst = (f32x2*)(F.ws + WS_AXC) + j; }
        const float ang = (float)pos * inv;
        double rev = (double)ang * 0.15915494309189535; rev -= __builtin_floor(rev);
        const float rv = (float)rev;
        *dst = (f32x2){__builtin_amdgcn_cosf(rv), __builtin_amdgcn_sinf(rv)};
    }
}
__device__ __forceinline__ void p0b(Frame& F) {
    PHASE_IDS();
    const int gt = F.vcu * NTHR + tid, NGT = F.G * NTHR;
    const float* mp = (const float*)(F.ws + WS_MODP); float* mo = (float*)(F.ws + WS_MOD);
    for (int i = gt; i < 4 * 2 * NADA; i += NGT) { const int l = i / (2 * NADA), v = (i / NADA) & 1, n = i % NADA;
        float s = F.a->in[5][l * NADA + n];
#pragma unroll
        for (int ks = 0; ks < 8; ++ks) s += mp[(size_t)(ks * 2 + v) * 4 * NADA + l * NADA + n];
        mo[i] = s; }
}
__device__ __forceinline__ const float* modp(Frame& F, int l, int v, int idx) { return (const float*)(F.ws + WS_MOD) + ((size_t)(l * 2 + v) * 9 + idx) * DM; }

template <int MODE>
__device__ __forceinline__ void row_phase(Frame& F, const float* lng, const float* lnb, const float* sh_l, const float* sc_l, const float* sh_c, const float* sc_c) {
    PHASE_IDS();
    LAS float* V = (LAS float*)F.lds;
    for (int i = tid; i < DM; i += NTHR) { if (MODE != 0) { V[i] = lng[i]; V[DM + i] = lnb[i]; } if (MODE != 2) { V[2 * DM + i] = sh_l[i]; V[3 * DM + i] = sc_l[i]; V[4 * DM + i] = sh_c[i]; V[5 * DM + i] = sc_c[i]; } }
    __syncthreads();
    const int gw = F.vcu * NWAVES + wave, NGW = F.G * NWAVES;
    float* X = (float*)(F.ws + WS_X); bf16* H = (bf16*)(F.ws + WS_H);
    for (int t = gw; t < T; t += NGW) {
        if (MODE == 2 && t < NCTX) continue;
        const float* src = (MODE == 0) ? (t < NCTX ? F.a->in[2] + (size_t)t * DM : F.a->in[0] + (size_t)(t - NCTX) * DM) : X + (size_t)t * DM;
        f32x4 v[8]; float s = 0.f; float mean_ = 0.f, rstd_ = 1.f;
#pragma unroll
        for (int j = 0; j < 8; ++j) { v[j] = *((const f32x4*)src + lane + 64 * j); s += (v[j].x + v[j].y) + (v[j].z + v[j].w); }
        if (MODE != 0) {
            const float mean = wave_sum(s) * (1.f / DM); float s2 = 0.f;
#pragma unroll
            for (int j = 0; j < 8; ++j) { v[j] = v[j] - mean; s2 += (v[j].x * v[j].x + v[j].y * v[j].y) + (v[j].z * v[j].z + v[j].w * v[j].w); }
            const float rstd = 1.f / sqrtf(wave_sum(s2) * (1.f / DM) + LN_EPS); mean_ = mean; rstd_ = rstd;
#pragma unroll
            for (int j = 0; j < 8; ++j) { const f32x4 g = *((const LAS f32x4*)V + lane + 64 * j), b = *((const LAS f32x4*)(V + DM) + lane + 64 * j); v[j] = v[j] * rstd * g + b; }
        }
        if (MODE == 1 && lane == 0) *(f32x2*)((float*)(F.ws + WS_STAT) + (size_t)t * 2) = (f32x2){mean_, rstd_};
        if (MODE == 2) {
            float* o = F.a->out + (size_t)(t - NCTX) * DM;
#pragma unroll
            for (int j = 0; j < 8; ++j) *((f32x4*)o + lane + 64 * j) = v[j];
        } else {
            float* o = X + (size_t)t * DM; bf16* h = H + (size_t)t * DM;
            const LAS float* shv = V + (t < NCTX ? 4 * DM : 2 * DM); const LAS float* scv = V + (t < NCTX ? 5 * DM : 3 * DM);
#pragma unroll
            for (int j = 0; j < 8; ++j) {
                const f32x4 sh = *((const LAS f32x4*)shv + lane + 64 * j), sc = *((const LAS f32x4*)scv + lane + 64 * j);
                const f32x4 m = v[j] * (sc + 1.0f) + sh; u32x2 w; w.x = cvt_pk_bf16(m.x, m.y); w.y = cvt_pk_bf16(m.z, m.w);
                *((u32x2*)h + lane + 64 * j) = w; }
        }
    }
    __syncthreads();
}


__device__ __forceinline__ void ctx_resid_small(Frame& F, float* X, const bf16* A, const bf16* Bt, int K, const float* gv, float gs, const float* stat, const float* lng, const float* lnb, int has_ln, int parity) {
    if ((int)(blockIdx.x & 1) != parity) return;
    PHASE_IDS(); const int fr = lane & 15, fq = lane >> 4;
    const int nks = K >> 5, last = wave + 8 * ((nks - 1 - wave) >> 3), trips = (((nks + 7) >> 3) + 3) & ~3;
    for (int item = blockIdx.x; item < 256; item += F.G) {
        const int mt = item >> 5, nt = item & 31;
        f32x4 acc[2][4];
#pragma unroll
        for (int i = 0; i < 2; ++i)
#pragma unroll
            for (int j = 0; j < 4; ++j) acc[i][j] = (f32x4){0.f, 0.f, 0.f, 0.f};
        const bf16* Ap = A + (size_t)(32 * mt + fr) * K + 8 * fq;
        const bf16* Bp = Bt + (size_t)(64 * nt + fr) * K + 8 * fq;
        bf16x8 a0[2], b0[4], a1[2], b1[4], a2[2], b2[4], a3[2], b3[4];
#define CS_LOAD(a, b, i_) do { const int so_ = 32 * min(wave + 8 * (i_), last); _Pragma("unroll") for (int i = 0; i < 2; ++i) a[i] = *(const bf16x8*)(Ap + (size_t)(16 * i) * K + so_); \
        _Pragma("unroll") for (int i = 0; i < 4; ++i) b[i] = *(const bf16x8*)(Bp + (size_t)(16 * i) * K + so_); } while (0)
#define CS_MMA(a, b, i_) do { __builtin_amdgcn_sched_barrier(0); if (wave + 8 * (i_) < nks) { _Pragma("unroll") for (int i = 0; i < 2; ++i) _Pragma("unroll") for (int j = 0; j < 4; ++j) acc[i][j] = MFMA16(a[i], b[j], acc[i][j]); } __builtin_amdgcn_sched_barrier(0); } while (0)
        CS_LOAD(a0, b0, 0); CS_LOAD(a1, b1, 1); CS_LOAD(a2, b2, 2);
        for (int it = 0; it < trips; it += 4) {
            CS_LOAD(a3, b3, it + 3); CS_MMA(a0, b0, it);
            CS_LOAD(a0, b0, it + 4); CS_MMA(a1, b1, it + 1);
            CS_LOAD(a1, b1, it + 5); CS_MMA(a2, b2, it + 2);
            CS_LOAD(a2, b2, it + 6); CS_MMA(a3, b3, it + 3);
        }
#undef CS_LOAD
#undef CS_MMA
        LAS float* P = (LAS float*)F.lds + wave * 2048;
#pragma unroll
        for (int i = 0; i < 2; ++i)
#pragma unroll
            for (int j = 0; j < 4; ++j)
#pragma unroll
                for (int r = 0; r < 4; ++r) P[(16 * i + 4 * fq + r) * 64 + 16 * j + fr] = acc[i][j][r];
        __syncthreads();
        const int row = tid >> 4, c0 = (tid & 15) * 4;
        f32x4 s0 = {0.f, 0.f, 0.f, 0.f};
#pragma unroll
        for (int w = 0; w < 8; ++w) s0 += *(const LAS f32x4*)((LAS float*)F.lds + w * 2048 + row * 64 + c0);
        float* xp = X + (size_t)(32 * mt + row) * DM + 64 * nt + c0;
        const f32x4 g0 = *(const f32x4*)(gv + 64 * nt + c0) * gs;
        f32x4 x0 = *(const f32x4*)xp;
        if (has_ln) { const f32x2 st = *(const f32x2*)(stat + (size_t)(32 * mt + row) * 2); x0 = (x0 - st.x) * st.y * *(const f32x4*)(lng + 64 * nt + c0) + *(const f32x4*)(lnb + 64 * nt + c0); }
        *(f32x4*)xp = x0 * DN_ALPHA + g0 * s0;
        __syncthreads();
    }
}


__device__ __forceinline__ void init_x_by_owners(Frame& F) {
    PHASE_IDS();
    float* X = (float*)(F.ws + WS_X);
    pg8::StaticOrder S; S.init(NLAT, DM, F.G, (int)blockIdx.x); pg8::Unit u;
    for (int i = 0; S.next(i, u); ++i) {
        const int c4 = (tid & 63) * 4, r0 = tid >> 6;
#pragma unroll 4
        for (int rr = r0; rr < 256; rr += 8) { const size_t lr = (size_t)u.pm * 256 + rr; *(f32x4*)(X + (lr + NCTX) * DM + u.pn * 256 + c4) = *(const f32x4*)(F.a->in[0] + lr * DM + u.pn * 256 + c4); }
    }
    for (int item = blockIdx.x; item < 256; item += F.G) { const int mt = item >> 5, nt = item & 31, row = tid >> 4, c0 = (tid & 15) * 4;
        const size_t o = (size_t)(32 * mt + row) * DM + 64 * nt + c0; *(f32x4*)(X + o) = *(const f32x4*)(F.a->in[2] + o); }
}

constexpr int L1_QRAW = 0, L1_KRAW = 16384, L1_GD = 32768, L1_PART = 36864, L1_QT = 40960, L1_KT = 58368, L1_KTT = 75776, L1_VT = 94208, L1_P = 131072;
constexpr float INV_SQRT_DK = 0.08838834764831845f;

template <int DIR>
__device__ __forceinline__ void s1_dir(Frame& F, int e, int hh, int c, bool lat, f32x4 (&pacc)[2], const float (&wv)[16], const float bgv, const f32x2 (&csv)[16]) {
    const bool is_gla = hh < 4; const int hd = hh & 3, t0 = c * 64;
    PHASE_IDS(); const int w = wave, fr = lane & 15, fq = lane >> 4;
    LAS unsigned char* lds = F.lds;
    const int ch = tid & 127, tq = tid >> 7;
    float lgv[16];
    if (is_gla) {
#pragma unroll
        for (int i = 0; i < 16; ++i) { const int tt = 16 * tq + (DIR ? 15 - i : i);
            const u32x4 g0 = *(const LAS u32x4*)(lds + L1_GD + tt * 64 + DIR * 32), g1 = *(const LAS u32x4*)(lds + L1_GD + tt * 64 + DIR * 32 + 16);
            float x = bgv;
            x += bflo(g0.x) * wv[0] + bfhi(g0.x) * wv[1] + bflo(g0.y) * wv[2] + bfhi(g0.y) * wv[3] + bflo(g0.z) * wv[4] + bfhi(g0.z) * wv[5] + bflo(g0.w) * wv[6] + bfhi(g0.w) * wv[7];
            x += bflo(g1.x) * wv[8] + bfhi(g1.x) * wv[9] + bflo(g1.y) * wv[10] + bfhi(g1.y) * wv[11] + bflo(g1.z) * wv[12] + bfhi(g1.z) * wv[13] + bflo(g1.w) * wv[14] + bfhi(g1.w) * wv[15];
            lgv[i] = (fminf(x, 0.f) - __logf(1.0f + __expf(-fabsf(x)))) * (1.0f / 16.0f); }
    } else {
        const float lg = log1pf(-exp2f((DIR ? -5.5f : -5.0f) - (float)hd));
#pragma unroll
        for (int i = 0; i < 16; ++i) lgv[i] = lg;
    }
    float ls = 0.f;
#pragma unroll
    for (int i = 0; i < 16; ++i) ls += lgv[i];
    LAS float* part = (LAS float*)(lds + L1_PART);
    part[tq * 128 + ch] = ls;
    __syncthreads();
    float b = 0.f;
#pragma unroll
    for (int q = 0; q < 4; ++q) { const float pv = part[q * 128 + ch]; if (DIR ? (q > tq) : (q < tq)) b += pv; }
    bf16* QTg = (bf16*)(F.ws + WS_QT) + (size_t)DIR * T * 1024;
    float kt[16];
#pragma unroll
    for (int i = 0; i < 16; ++i) { const int tt = 16 * tq + (DIR ? 15 - i : i);
        b += lgv[i];
        float qv = bf2f(*(const LAS bf16*)(lds + L1_QRAW + tt * 256 + ch * 2)), kv = bf2f(*(const LAS bf16*)(lds + L1_KRAW + tt * 256 + ch * 2));
        if (!is_gla && lat) {
            const float qp = bf2f(*(const LAS bf16*)(lds + L1_QRAW + tt * 256 + (ch ^ 64) * 2)), kp = bf2f(*(const LAS bf16*)(lds + L1_KRAW + tt * 256 + (ch ^ 64) * 2));
            const f32x2 cs = csv[DIR ? 15 - i : i];
            if (ch < 64) { qv = qv * cs.x - qp * cs.y; kv = kv * cs.x - kp * cs.y; } else { qv = qv * cs.x + qp * cs.y; kv = kv * cs.x + kp * cs.y; }
        }
        const float eb = __expf(b), ebi = __expf(-b);
        const float qs = qv * eb * (is_gla ? INV_SQRT_DK : 1.0f), ks = kv * ebi * (is_gla ? 1.0f : INV_SQRT_DK);
        const bf16 qb = f2bf(qs);
        *(LAS bf16*)(lds + L1_QT + tt * 272 + ch * 2) = qb;
        *(LAS bf16*)(lds + L1_KT + tt * 272 + ch * 2) = f2bf(ks);
        kt[DIR ? 15 - i : i] = ks;
        if (i == 15 && tq == (DIR ? 0 : 3)) ((float*)(F.ws + WS_DEC))[((size_t)(DIR * 8 + hh) * NCH + c) * 128 + ch] = eb;
    }
    { u32x4 w0, w1; w0.x = cvt_pk_bf16(kt[0], kt[1]); w0.y = cvt_pk_bf16(kt[2], kt[3]); w0.z = cvt_pk_bf16(kt[4], kt[5]); w0.w = cvt_pk_bf16(kt[6], kt[7]);
      w1.x = cvt_pk_bf16(kt[8], kt[9]); w1.y = cvt_pk_bf16(kt[10], kt[11]); w1.z = cvt_pk_bf16(kt[12], kt[13]); w1.w = cvt_pk_bf16(kt[14], kt[15]);
      *(LAS u32x4*)(lds + L1_KTT + ch * 144 + tq * 32) = w0; *(LAS u32x4*)(lds + L1_KTT + ch * 144 + tq * 32 + 16) = w1; }
    __syncthreads();
#pragma unroll
    for (int i = 0; i < 2; ++i) { const int id = tid + 512 * i, r = id >> 4, cc = id & 15;
        *(u32x4*)(QTg + (size_t)(t0 + r) * 1024 + hh * 128 + cc * 8) = *(const LAS u32x4*)(lds + L1_QT + r * 272 + cc * 16); }
    { const int mi = w >> 1, nj0 = 2 * (w & 1);
      f32x4 pd[2] = {{0.f, 0.f, 0.f, 0.f}, {0.f, 0.f, 0.f, 0.f}};
#pragma unroll
      for (int ks = 0; ks < 4; ++ks) { const bf16x8 a = *(const LAS bf16x8*)(lds + L1_QT + (16 * mi + fr) * 272 + (32 * ks + 8 * fq) * 2);
#pragma unroll
          for (int j = 0; j < 2; ++j) { const bf16x8 bb = *(const LAS bf16x8*)(lds + L1_KT + (16 * (nj0 + j) + fr) * 272 + (32 * ks + 8 * fq) * 2); pd[j] = MFMA16(a, bb, pd[j]); } }
#pragma unroll
      for (int j = 0; j < 2; ++j)
#pragma unroll
          for (int r = 0; r < 4; ++r) { const int ii = 16 * mi + 4 * fq + r, jj = 16 * (nj0 + j) + fr; if (DIR ? (jj >= ii) : (jj <= ii)) pacc[j][r] += pd[j][r]; } }
    { bf16* Ug = (bf16*)(F.ws + WS_U) + ((size_t)(DIR * 8 + hh) * NCH + c) * 256 * 128;
      bf16x8 bv[2][2];
#pragma unroll
      for (int nj = 0; nj < 2; ++nj)
#pragma unroll
          for (int ks = 0; ks < 2; ++ks) bv[nj][ks] = *(const LAS bf16x8*)(lds + L1_VT + (32 * w + 16 * nj + fr) * 144 + (32 * ks + 8 * fq) * 2);
#pragma unroll
      for (int P = 0; P < 4; ++P) {
          f32x4 u[2][2] = {{{0.f, 0.f, 0.f, 0.f}, {0.f, 0.f, 0.f, 0.f}}, {{0.f, 0.f, 0.f, 0.f}, {0.f, 0.f, 0.f, 0.f}}};
#pragma unroll
          for (int t = 0; t < 2; ++t)
#pragma unroll
              for (int ks = 0; ks < 2; ++ks) { const bf16x8 a = *(const LAS bf16x8*)(lds + L1_KTT + (32 * P + 8 * (fr >> 2) + 4 * t + (fr & 3)) * 144 + (32 * ks + 8 * fq) * 2);
#pragma unroll
                  for (int nj = 0; nj < 2; ++nj) u[t][nj] = MFMA16(a, bv[nj][ks], u[t][nj]); }
          asm volatile("s_nop 15" : "+v"(u[0][0]), "+v"(u[0][1]), "+v"(u[1][0]), "+v"(u[1][1]));
#pragma unroll
          for (int nj = 0; nj < 2; ++nj) { u32x4 o; o.x = cvt_pk_bf16(u[0][nj][0], u[0][nj][1]); o.y = cvt_pk_bf16(u[0][nj][2], u[0][nj][3]); o.z = cvt_pk_bf16(u[1][nj][0], u[1][nj][1]); o.w = cvt_pk_bf16(u[1][nj][2], u[1][nj][3]);
              *(u32x4*)(Ug + (size_t)(32 * w + 16 * nj + fr) * 128 + 32 * P + 8 * fq) = o; } } }
    __syncthreads();
}

__device__ __forceinline__ void s1_phase(Frame& F, int e) {
    PHASE_IDS(); LAS unsigned char* lds = F.lds; const int w = wave, fr = lane & 15, fq = lane >> 4;
    const bf16* P = (const bf16*)(F.ws + WS_PROJ);
    for (int item = blockIdx.x; item < 8 * NCH; item += F.G) {
        const int c = item >> 3, hh = item & 7, hd = hh & 3, t0 = c * 64; const bool is_gla = hh < 4, lat = c >= 4;
        const int qcol = is_gla ? 128 * hd : 3072 + 128 * hd, kcol = qcol + 512, vcol = is_gla ? 1024 + 256 * hd : 4096 + 256 * hd;
#pragma unroll
        for (int i = 0; i < 2; ++i) { const int id = tid + 512 * i, r = id >> 4, cc = id & 15;
            *(LAS u32x4*)(lds + L1_QRAW + r * 256 + cc * 16) = *(const u32x4*)(P + (size_t)(t0 + r) * EV_N + qcol + cc * 8);
            *(LAS u32x4*)(lds + L1_KRAW + r * 256 + cc * 16) = *(const u32x4*)(P + (size_t)(t0 + r) * EV_N + kcol + cc * 8); }
#pragma unroll
        for (int i = 0; i < 4; ++i) { const int id = tid + 512 * i, r = id & 63, cc = id >> 6;
            const u32x4 v = *(const u32x4*)(P + (size_t)(t0 + r) * EV_N + vcol + cc * 8);
            LAS bf16* vt = (LAS bf16*)(lds + L1_VT) + (cc * 8) * 72 + r;
            vt[0 * 72] = (bf16)(v.x & 0xffff); vt[1 * 72] = (bf16)(v.x >> 16); vt[2 * 72] = (bf16)(v.y & 0xffff); vt[3 * 72] = (bf16)(v.y >> 16);
            vt[4 * 72] = (bf16)(v.z & 0xffff); vt[5 * 72] = (bf16)(v.z >> 16); vt[6 * 72] = (bf16)(v.w & 0xffff); vt[7 * 72] = (bf16)(v.w >> 16); }
        if (is_gla && tid < 256) { const int r = tid >> 2, cc = tid & 3; *(LAS u32x4*)(lds + L1_GD + r * 64 + cc * 16) = *(const u32x4*)(P + (size_t)(t0 + r) * EV_N + 6144 + cc * 8); }
        float wvf[16], wvb[16], bgf = 0.f, bgb = 0.f; f32x2 csv[16];
        { const int ch = tid & 127, tq = tid >> 7;
#pragma unroll
          for (int r = 0; r < 16; ++r) { wvf[r] = 0.f; wvb[r] = 0.f; csv[r] = (f32x2){1.f, 0.f}; }
          if (is_gla) {
              const float* wgf = F.a->in[11] + (size_t)e * 16 * 512 + hd * 128 + ch; const float* wgb = F.a->in[13] + (size_t)e * 16 * 512 + hd * 128 + ch;
#pragma unroll
              for (int r = 0; r < 16; ++r) { wvf[r] = wgf[r * 512]; wvb[r] = wgb[r * 512]; }
              bgf = F.a->in[12][e * 512 + hd * 128 + ch]; bgb = F.a->in[14][e * 512 + hd * 128 + ch];
          } else if (lat) {
              const f32x2* RT = (const f32x2*)(F.ws + WS_RT) + (size_t)(t0 + 16 * tq - NCTX) * 64 + (ch & 63);
#pragma unroll
              for (int r = 0; r < 16; ++r) csv[r] = RT[r * 64];
          } }
        __syncthreads();
        f32x4 pacc[2] = {{0.f, 0.f, 0.f, 0.f}, {0.f, 0.f, 0.f, 0.f}};
        s1_dir<0>(F, e, hh, c, lat, pacc, wvf, bgf, csv);
        s1_dir<1>(F, e, hh, c, lat, pacc, wvb, bgb, csv);
        { const int mi = w >> 1, nj0 = 2 * (w & 1);
#pragma unroll
          for (int j = 0; j < 2; ++j)
#pragma unroll
              for (int r = 0; r < 4; ++r) *(LAS bf16*)(lds + L1_P + (16 * mi + 4 * fq + r) * 144 + (16 * (nj0 + j) + fr) * 2) = f2bf(pacc[j][r]); }
        __syncthreads();
        { float* OI = (float*)(F.ws + WS_OI);
          bf16x8 bv[2][2];
#pragma unroll
          for (int nj = 0; nj < 2; ++nj)
#pragma unroll
              for (int ks = 0; ks < 2; ++ks) bv[nj][ks] = *(const LAS bf16x8*)(lds + L1_VT + (32 * w + 16 * nj + fr) * 144 + (32 * ks + 8 * fq) * 2);
#pragma unroll
          for (int mi = 0; mi < 4; ++mi) {
              f32x4 o[2] = {{0.f, 0.f, 0.f, 0.f}, {0.f, 0.f, 0.f, 0.f}};
#pragma unroll
              for (int ks = 0; ks < 2; ++ks) { const bf16x8 a = *(const LAS bf16x8*)(lds + L1_P + (16 * mi + fr) * 144 + (32 * ks + 8 * fq) * 2);
#pragma unroll
                  for (int nj = 0; nj < 2; ++nj) o[nj] = MFMA16(a, bv[nj][ks], o[nj]); }
#pragma unroll
              for (int nj = 0; nj < 2; ++nj)
#pragma unroll
                  for (int r = 0; r < 4; ++r) ((LAS float*)lds)[(16 * mi + 4 * fq + r) * 260 + 32 * w + 16 * nj + fr] = o[nj][r]; }
          __syncthreads();
#pragma unroll
          for (int i = 0; i < 8; ++i) { const int id = tid + 512 * i, r = id >> 6, cc = id & 63;
              *(f32x4*)(OI + (size_t)(t0 + r) * DM + hh * 256 + cc * 4) = *(const LAS f32x4*)((LAS float*)lds + r * 260 + cc * 4); } }
        __syncthreads();
    }
}

__device__ __forceinline__ void s2_phase(Frame& F) {
    PHASE_IDS();
    constexpr int SB = 13, NB = NCH / SB; static_assert(NB * SB == NCH, "NCH % 13");
    const int gt = F.vcu * NTHR + tid, NGT = F.G * NTHR;
    for (int idx = gt; idx < 2 * 8 * 256 * 32; idx += NGT) {
        const int dk4 = idx & 31, ee = (idx >> 5) & 255, dh = idx >> 13, dir = dh >> 3;
        const bf16* U = (const bf16*)(F.ws + WS_U) + (size_t)dh * NCH * 256 * 128 + (size_t)ee * 128 + dk4 * 4;
        bf16* S = (bf16*)(F.ws + WS_S) + (size_t)dh * NCH * 256 * 128 + (size_t)ee * 128 + dk4 * 4;
        const float* D = (const float*)(F.ws + WS_DEC) + (size_t)dh * NCH * 128 + dk4 * 4;
        f32x4 s = {0.f, 0.f, 0.f, 0.f};
        u32x2 un[SB]; f32x4 dn[SB];
#define S2_CH(step) (dir ? ((step) < 4 ? 3 - (step) : NCH + 3 - (step)) : (step))
#pragma unroll
        for (int i = 0; i < SB; ++i) { const int c = S2_CH(i); un[i] = *(const u32x2*)(U + (size_t)c * 256 * 128); dn[i] = *(const f32x4*)(D + (size_t)c * 128); }
#pragma nounroll
        for (int b = 0; b < NB; ++b) {
            u32x2 uc[SB]; f32x4 dc[SB];
#pragma unroll
            for (int i = 0; i < SB; ++i) { uc[i] = un[i]; dc[i] = dn[i]; }
            if (b + 1 < NB) {
#pragma unroll
                for (int i = 0; i < SB; ++i) { const int c = S2_CH((b + 1) * SB + i); un[i] = *(const u32x2*)(U + (size_t)c * 256 * 128); dn[i] = *(const f32x4*)(D + (size_t)c * 128); } }
#pragma unroll
            for (int i = 0; i < SB; ++i) { const int c = S2_CH(b * SB + i);
                u32x2 so; so.x = cvt_pk_bf16(s.x, s.y); so.y = cvt_pk_bf16(s.z, s.w);
                *(u32x2*)(S + (size_t)c * 256 * 128) = so;
                s.x = dc[i].x * (s.x + bflo(uc[i].x)); s.y = dc[i].y * (s.y + bfhi(uc[i].x)); s.z = dc[i].z * (s.z + bflo(uc[i].y)); s.w = dc[i].w * (s.w + bfhi(uc[i].y)); }
        }
#undef S2_CH
    }
}

constexpr int L3_QF = 0, L3_QB = 17408, L3_OL = 34816;
__device__ __forceinline__ void s3_phase(Frame& F, int e) {
    PHASE_IDS(); LAS unsigned char* lds = F.lds; const int w = wave, fr = lane & 15, fq = lane >> 4;
    const bf16* P = (const bf16*)(F.ws + WS_PROJ); const bf16* QTg = (const bf16*)(F.ws + WS_QT); const float* OI = (const float*)(F.ws + WS_OI);
    bf16* MIX = (bf16*)(F.ws + WS_MIX);
    for (int item = blockIdx.x; item < 8 * NCH; item += F.G) {
        const int c = item >> 3, hh = item & 7, hd = hh & 3, t0 = c * 64; const bool is_gla = hh < 4;
        const int gcol = is_gla ? 2048 + 256 * hd : 5120 + 256 * hd;
#pragma unroll
        for (int dir = 0; dir < 2; ++dir)
#pragma unroll
            for (int i = 0; i < 2; ++i) { const int id = tid + 512 * i, r = id >> 4, cc = id & 15;
                *(LAS u32x4*)(lds + (dir ? L3_QB : L3_QF) + r * 272 + cc * 16) = *(const u32x4*)(QTg + (size_t)dir * T * 1024 + (size_t)(t0 + r) * 1024 + hh * 128 + cc * 8); }
        bf16x8 bv[2][4][2];
#pragma unroll
        for (int dir = 0; dir < 2; ++dir) { const bf16* Sg = (const bf16*)(F.ws + WS_S) + ((size_t)(dir * 8 + hh) * NCH + c) * 256 * 128;
#pragma unroll
            for (int ks = 0; ks < 4; ++ks)
#pragma unroll
                for (int nj = 0; nj < 2; ++nj) bv[dir][ks][nj] = *(const bf16x8*)(Sg + (size_t)(32 * w + 16 * nj + fr) * 128 + 32 * ks + 8 * fq); }
        __builtin_amdgcn_sched_barrier(0);
        __syncthreads();
        f32x4 o[4][2];
#pragma unroll
        for (int mi = 0; mi < 4; ++mi)
#pragma unroll
            for (int nj = 0; nj < 2; ++nj) o[mi][nj] = (f32x4){0.f, 0.f, 0.f, 0.f};
#pragma unroll
        for (int dir = 0; dir < 2; ++dir) {
#pragma unroll
            for (int ks = 0; ks < 4; ++ks) {
#pragma unroll
                for (int mi = 0; mi < 4; ++mi) { const bf16x8 a = *(const LAS bf16x8*)(lds + (dir ? L3_QB : L3_QF) + (16 * mi + fr) * 272 + (32 * ks + 8 * fq) * 2);
#pragma unroll
                    for (int nj = 0; nj < 2; ++nj) o[mi][nj] = MFMA16(a, bv[dir][ks][nj], o[mi][nj]); } } }
        LAS float* OL = (LAS float*)(lds + L3_OL);
#pragma unroll
        for (int mi = 0; mi < 4; ++mi)
#pragma unroll
            for (int nj = 0; nj < 2; ++nj)
#pragma unroll
                for (int r = 0; r < 4; ++r) OL[(16 * mi + 4 * fq + r) * 260 + 32 * w + 16 * nj + fr] = o[mi][nj][r];
        __syncthreads();
        { const int tk = tid >> 3, seg = tid & 7;
          f32x4 v[4][2]; float sq = 0.f;
#pragma unroll
          for (int g = 0; g < 4; ++g) { const int ee = 64 * g + 8 * seg; const float* oi = OI + (size_t)(t0 + tk) * DM + hh * 256 + ee;
              v[g][0] = *(const LAS f32x4*)(OL + tk * 260 + ee) + *(const f32x4*)oi; v[g][1] = *(const LAS f32x4*)(OL + tk * 260 + ee + 4) + *(const f32x4*)(oi + 4);
              sq += (v[g][0].x * v[g][0].x + v[g][0].y * v[g][0].y) + (v[g][0].z * v[g][0].z + v[g][0].w * v[g][0].w) + (v[g][1].x * v[g][1].x + v[g][1].y * v[g][1].y) + (v[g][1].z * v[g][1].z + v[g][1].w * v[g][1].w); }
          sq += __shfl_xor(sq, 1); sq += __shfl_xor(sq, 2); sq += __shfl_xor(sq, 4);
          const float rstd = 1.0f / sqrtf(sq * (1.0f / 256.0f) + RMS_EPS);
#pragma unroll
          for (int g = 0; g < 4; ++g) { const int ee = 64 * g + 8 * seg;
              const u32x4 gt = *(const u32x4*)(P + (size_t)(t0 + tk) * EV_N + gcol + ee);
              f32x4 n0 = {1.f, 1.f, 1.f, 1.f}, n1 = {1.f, 1.f, 1.f, 1.f};
              if (is_gla) { n0 = *(const f32x4*)(F.a->in[15] + e * 256 + ee); n1 = *(const f32x4*)(F.a->in[15] + e * 256 + ee + 4); }
              const f32x4 a0 = v[g][0] * rstd * n0, a1 = v[g][1] * rstd * n1;
              u32x4 ow; ow.x = cvt_pk_bf16(a0.x * silu_f(bflo(gt.x)), a0.y * silu_f(bfhi(gt.x))); ow.y = cvt_pk_bf16(a0.z * silu_f(bflo(gt.y)), a0.w * silu_f(bfhi(gt.y)));
              ow.z = cvt_pk_bf16(a1.x * silu_f(bflo(gt.z)), a1.y * silu_f(bfhi(gt.z))); ow.w = cvt_pk_bf16(a1.z * silu_f(bflo(gt.w)), a1.w * silu_f(bfhi(gt.w)));
              *(u32x4*)(MIX + (size_t)(t0 + tk) * DM + hh * 256 + ee) = ow; } }
        __syncthreads();
    }
}

__device__ __forceinline__ void e1_phase(Frame& F, int o) {
    PHASE_IDS();
    const int gw = F.vcu * NWAVES + wave, NGW = F.G * NWAVES;
    const bf16* P = (const bf16*)(F.ws + WS_PROJ); bf16* CQN = (bf16*)(F.ws + WS_CQN); bf16* CKVN = (bf16*)(F.ws + WS_CKVN); bf16* KR = (bf16*)(F.ws + WS_KR);
    const float* wq = F.a->in[18] + o * 512 + lane * 8; const float* wkv = F.a->in[19] + o * 512 + lane * 8;
    const f32x4 wq0 = *(const f32x4*)wq, wq1 = *(const f32x4*)(wq + 4), wk0 = *(const f32x4*)wkv, wk1 = *(const f32x4*)(wkv + 4);
    const f32x2* AXR = (const f32x2*)(F.ws + WS_AXR); const f32x2* AXC = (const f32x2*)(F.ws + WS_AXC);
    for (int t = gw; t < T; t += NGW) {
        const bf16* p = P + (size_t)t * OD_N;
        const u32x4 a = *(const u32x4*)(p + lane * 8), b = *(const u32x4*)(p + 512 + lane * 8);
        float x[8] = {bflo(a.x), bfhi(a.x), bflo(a.y), bfhi(a.y), bflo(a.z), bfhi(a.z), bflo(a.w), bfhi(a.w)};
        float y[8] = {bflo(b.x), bfhi(b.x), bflo(b.y), bfhi(b.y), bflo(b.z), bfhi(b.z), bflo(b.w), bfhi(b.w)};
        float sx = 0.f, sy = 0.f;
#pragma unroll
        for (int j = 0; j < 8; ++j) { sx += x[j] * x[j]; sy += y[j] * y[j]; }
        const float rx = 1.0f / sqrtf(wave_sum(sx) * (1.0f / 512.0f) + RMS_EPS), ry = 1.0f / sqrtf(wave_sum(sy) * (1.0f / 512.0f) + RMS_EPS);
        u32x4 oq, ok;
        oq.x = cvt_pk_bf16(x[0] * rx * wq0.x, x[1] * rx * wq0.y); oq.y = cvt_pk_bf16(x[2] * rx * wq0.z, x[3] * rx * wq0.w); oq.z = cvt_pk_bf16(x[4] * rx * wq1.x, x[5] * rx * wq1.y); oq.w = cvt_pk_bf16(x[6] * rx * wq1.z, x[7] * rx * wq1.w);
        ok.x = cvt_pk_bf16(y[0] * ry * wk0.x, y[1] * ry * wk0.y); ok.y = cvt_pk_bf16(y[2] * ry * wk0.z, y[3] * ry * wk0.w); ok.z = cvt_pk_bf16(y[4] * ry * wk1.x, y[5] * ry * wk1.y); ok.w = cvt_pk_bf16(y[6] * ry * wk1.z, y[7] * ry * wk1.w);
        *(u32x4*)(CQN + (size_t)t * 512 + lane * 8) = oq; *(u32x4*)(CKVN + (size_t)t * 512 + lane * 8) = ok;
        float v = bf2f(p[1024 + lane]); const float pr = __shfl_xor(v, 16);
        if (t >= NCTX) { const int pp = t - NCTX, pos = (lane & 32) ? (pp & 63) : (pp >> 6); const f32x2 cs = ((lane & 32) ? AXC : AXR)[pos * 16 + (lane & 15)];
            v = (lane & 16) ? v * cs.x + pr * cs.y : v * cs.x - pr * cs.y; }
        KR[(size_t)t * 64 + lane] = f2bf(v);
    }
}

namespace att {
constexpr int KVBLK = 64;
constexpr float SCALE = 0.07216878364870322f;
constexpr float THR = 8.f;
constexpr int SHM_K = 64 * 384, SHM_V = 64 * 256;
constexpr int A_V = 0, A_K = 3 * SHM_V, A_WS = 3 * SHM_V + 3 * SHM_K;
#define SBAR() __builtin_amdgcn_sched_barrier(0)
__device__ __forceinline__ int crow(int r, int hi) { return (r & 3) + 8 * (r >> 2) + 4 * hi; }
constexpr float PLIM = 4096.f;
__device__ __forceinline__ void exp_sum(f32x16& p0, f32x16& p1, float& ps) {
#pragma unroll
    for (int r = 0; r < 16; ++r) p0[r] = __builtin_amdgcn_exp2f(p0[r]);
#pragma unroll
    for (int r = 0; r < 16; ++r) p1[r] = __builtin_amdgcn_exp2f(p1[r]);
    ps = p0[0];
#pragma unroll
    for (int r = 1; r < 16; ++r) ps += p0[r];
#pragma unroll
    for (int r = 0; r < 16; ++r) ps += p1[r];
}
__device__ __forceinline__ float row_max32(const f32x16& p0, const f32x16& p1) {
    float pmax = p0[0];
#pragma unroll
    for (int r = 1; r < 16; ++r) pmax = fmaxf(pmax, p0[r]);
#pragma unroll
    for (int r = 0; r < 16; ++r) pmax = fmaxf(pmax, p1[r]);
    auto rr = __builtin_amdgcn_permlane32_swap(__float_as_uint(pmax), __float_as_uint(pmax), false, false);
    return fmaxf(__uint_as_float(rr[0]), __uint_as_float(rr[1]));
}
__device__ __forceinline__ void pack_p(const f32x16& p0, const f32x16& p1, bf16x8& pa0, bf16x8& pa1, bf16x8& pa2, bf16x8& pa3) {
#define PK4(P, BASE, OUT) do { unsigned a0 = cvt_pk_bf16(P[BASE + 0], P[BASE + 1]), a1 = cvt_pk_bf16(P[BASE + 2], P[BASE + 3]);   \
    unsigned b0 = cvt_pk_bf16(P[BASE + 4], P[BASE + 5]), b1 = cvt_pk_bf16(P[BASE + 6], P[BASE + 7]);                              \
    auto r0 = __builtin_amdgcn_permlane32_swap(a0, b0, false, false); auto r1 = __builtin_amdgcn_permlane32_swap(a1, b1, false, false); \
    u32x4 w = {r0[0], r1[0], r0[1], r1[1]}; OUT = *reinterpret_cast<bf16x8*>(&w); } while (0)
    PK4(p0, 0, pa0); PK4(p0, 8, pa1); PK4(p1, 0, pa2); PK4(p1, 8, pa3);
#undef PK4
}
__device__ __forceinline__ int kswz(int row, int g) { return row * 384 + (((g & ~7) | ((g & 7) ^ ((row >> 1) & 7))) << 4); }
__device__ __forceinline__ void qkt(f32x16& p0, f32x16& p1, const LAS unsigned char* Ks, const bf16x8 (&qr)[12], const int (&kx)[4], const f32x16& init, bf16x8 c0, bf16x8 c1) {
    bf16x8 n0, n1;
#pragma unroll
    for (int d0 = 0; d0 < 12; ++d0) {
        if (d0 < 11) { n0 = *(const LAS bf16x8*)(Ks + kx[(d0 + 1) & 3] + ((d0 + 1) >> 2) * 128); n1 = *(const LAS bf16x8*)(Ks + kx[(d0 + 1) & 3] + ((d0 + 1) >> 2) * 128 + 32 * 384); }
        __builtin_amdgcn_sched_barrier(0);
        p0 = MFMA32(c0, qr[d0], d0 == 0 ? init : p0);
        p1 = MFMA32(c1, qr[d0], d0 == 0 ? init : p1);
        __builtin_amdgcn_sched_barrier(0);
        c0 = n0; c1 = n1; }
}
__device__ __forceinline__ int v_st(int k, int c) { const int kk = (k & ~0xC) | ((k & 4) << 1) | ((k & 8) >> 1); return ((kk >> 3) * 4 + (c >> 5)) * 512 + ((kk & 7) * 32 + (c & 31)) * 2; }
__device__ __forceinline__ int v_rd_base(int lane) { return ((lane & 3) << 3) | (((lane >> 2) & 3) << 6) | (((lane >> 4) & 1) << 5) | (((lane >> 5) & 1) << 8); }
constexpr int v_rd_off(int d0, int ks, int half) { return d0 * 512 + ks * 4096 + half * 2048; }
template <int OFF> __device__ __forceinline__ s16x4 tr_read(int vb) {
    s16x4 r; asm volatile("ds_read_b64_tr_b16 %0, %1 offset:%2" : "=&v"(r) : "v"(vb), "i"(OFF) : "memory"); return r;
}
struct VF { s16x4 l0, h0, l1, h1, l2, h2, l3, h3; };
template <int KS> __device__ __forceinline__ void v_load(VF& f, int vb) {
    f.l0 = tr_read<v_rd_off(0, KS, 0)>(vb); f.h0 = tr_read<v_rd_off(0, KS, 1)>(vb); f.l1 = tr_read<v_rd_off(1, KS, 0)>(vb); f.h1 = tr_read<v_rd_off(1, KS, 1)>(vb);
    f.l2 = tr_read<v_rd_off(2, KS, 0)>(vb); f.h2 = tr_read<v_rd_off(2, KS, 1)>(vb); f.l3 = tr_read<v_rd_off(3, KS, 0)>(vb); f.h3 = tr_read<v_rd_off(3, KS, 1)>(vb);
}
__device__ __forceinline__ void pv_mma(f32x16 (&o)[4], const VF& f, bf16x8 pa) {
#define PK(L, H) (bf16x8){L[0], L[1], L[2], L[3], H[0], H[1], H[2], H[3]}
    o[0] = MFMA32(pa, PK(f.l0, f.h0), o[0]);
    o[1] = MFMA32(pa, PK(f.l1, f.h1), o[1]);
    o[2] = MFMA32(pa, PK(f.l2, f.h2), o[2]);
    o[3] = MFMA32(pa, PK(f.l3, f.h3), o[3]);
#undef PK
}
__device__ __forceinline__ void pv_d0(f32x16 (&o)[4], int vb, VF& fa, bf16x8 pa0, bf16x8 pa1, bf16x8 pa2, bf16x8 pa3) {
    VF fb;
    v_load<1>(fb, vb);
    asm volatile("s_waitcnt lgkmcnt(8)" ::: "memory"); SBAR(); pv_mma(o, fa, pa0); SBAR();
    v_load<2>(fa, vb);
    asm volatile("s_waitcnt lgkmcnt(8)" ::: "memory"); SBAR(); pv_mma(o, fb, pa1); SBAR();
    v_load<3>(fb, vb);
    asm volatile("s_waitcnt lgkmcnt(8)" ::: "memory"); SBAR(); pv_mma(o, fa, pa2); SBAR();
    asm volatile("s_waitcnt lgkmcnt(0)" ::: "memory"); SBAR(); pv_mma(o, fb, pa3);
}
__device__ __forceinline__ void rope_pair(bf16x8& a, bf16x8& b, const f32x2* cs) {
    u32x4 ua = *reinterpret_cast<u32x4*>(&a), ub = *reinterpret_cast<u32x4*>(&b); u32x4 oa, ob;
#pragma unroll
    for (int j = 0; j < 4; ++j) { const f32x2 c0 = cs[2 * j], c1 = cs[2 * j + 1];
        const float x1l = bflo(ua[j]), x1h = bfhi(ua[j]), x2l = bflo(ub[j]), x2h = bfhi(ub[j]);
        oa[j] = cvt_pk_bf16(x1l * c0.x - x2l * c0.y, x1h * c1.x - x2h * c1.y);
        ob[j] = cvt_pk_bf16(x2l * c0.x + x1l * c0.y, x2h * c1.x + x1h * c1.y); }
    a = *reinterpret_cast<bf16x8*>(&oa); b = *reinterpret_cast<bf16x8*>(&ob);
}
__device__ __forceinline__ void unit(Frame& F, int h, int qrow0, int nkeys) {
    LAS unsigned char* lds = F.lds;
    PHASE_IDS(); const int wid = wave, r32 = lane & 31, hi = lane >> 5;
    const bf16* QB = (const bf16*)(F.ws + WS_QB); const bf16* KVB = (const bf16*)(F.ws + WS_KVB); const bf16* KR = (const bf16*)(F.ws + WS_KR);
    LAS unsigned char* V_lds = lds + A_V; LAS unsigned char* K_lds = lds + A_K;
    LAS float* wsl = (LAS float*)(lds + A_WS) + wid * 64; LAS float* li_l = wsl; LAS float* al_l = wsl + 32;
    float m_reg = -1e30f, l_reg = 0; f32x16 o[4] = {}; bf16x8 qr[12]; f32x16 negm;
    const int qt = qrow0 + wid * 32 + r32;
    const bf16* Qw = QB + (size_t)qt * 3072 + 192 * h + hi * 8;
#pragma unroll
    for (int d0 = 0; d0 < 12; ++d0) qr[d0] = *(const bf16x8*)(Qw + d0 * 16);
    if (qt >= NCTX) { const int pp = qt - NCTX;
        rope_pair(qr[8], qr[9], (const f32x2*)(F.ws + WS_AXR) + (pp >> 6) * 16 + hi * 8);
        rope_pair(qr[10], qr[11], (const f32x2*)(F.ws + WS_AXC) + (pp & 63) * 16 + hi * 8); }
    const unsigned char* wsb = F.ws;
    unsigned koff[3], kfl = 0u; int kdst[3];
#pragma unroll
    for (int i = 0; i < 3; ++i) { const int id = tid + 512 * i, row = id / 24, g = id % 24;
        if (g < 16) { koff[i] = (unsigned)WS_KVB + (unsigned)(row * 4096 + 256 * h + g * 8) * 2u; kfl |= 1u << i; } else { koff[i] = (unsigned)WS_KR + (unsigned)(row * 64 + (g - 16) * 8) * 2u; }
        kdst[i] = kswz(row, g); }
    const int sr = tid >> 4, sc = (tid & 15) * 8, vst0 = v_st(sr, sc);
    const unsigned voff = (unsigned)WS_KVB + (unsigned)(sr * 4096 + 256 * h + 128 + sc) * 2u;
    const int vb0 = (int)(unsigned)(uintptr_t)V_lds + v_rd_base(lane);
    int kx[4];
#pragma unroll
    for (int q = 0; q < 4; ++q) kx[q] = r32 * 384 + ((((2 * q) | hi) ^ ((r32 >> 1) & 7)) << 4);
    bf16x8 sk0, sk1, sk2, sv0, sv1;
#define SLOAD(jt) do { const unsigned vo_ = voff + (unsigned)(jt) * (64u * 4096u * 2u); sv0 = *(const bf16x8*)(wsb + vo_); sv1 = *(const bf16x8*)(wsb + vo_ + 32u * 4096u * 2u); \
    const unsigned kt_ = (unsigned)(jt) * 8192u; \
    sk0 = *(const bf16x8*)(wsb + koff[0] + (kt_ << ((kfl & 1u) * 6u))); sk1 = *(const bf16x8*)(wsb + koff[1] + (kt_ << (((kfl >> 1) & 1u) * 6u))); sk2 = *(const bf16x8*)(wsb + koff[2] + (kt_ << (((kfl >> 2) & 1u) * 6u))); } while (0)
#define SWRITE(b) do { *(LAS bf16x8*)(V_lds + (b) * SHM_V + vst0) = sv0; *(LAS bf16x8*)(V_lds + (b) * SHM_V + vst0 + 8192) = sv1; \
    *(LAS bf16x8*)(K_lds + (b) * SHM_K + kdst[0]) = sk0; *(LAS bf16x8*)(K_lds + (b) * SHM_K + kdst[1]) = sk1; *(LAS bf16x8*)(K_lds + (b) * SHM_K + kdst[2]) = sk2; } while (0)
#define SWAIT() asm volatile("s_waitcnt vmcnt(0)" ::: "memory")
#define NEGM_SET(v) do { const float v_ = (v); _Pragma("unroll") for (int r = 0; r < 16; ++r) negm[r] = v_; asm volatile("" : "+v"(negm)); } while (0)
    f32x16 p0, p1; bf16x8 pa0, pa1, pa2, pa3, kc0, kc1; const int NT = nkeys / KVBLK;
    NEGM_SET(0.f);
#define ABAR() do { asm volatile("s_waitcnt lgkmcnt(0)" ::: "memory"); __builtin_amdgcn_s_barrier(); asm volatile("" ::: "memory"); } while (0)
#define ASTAGE(j) do { if ((j) + 1 < NT) { SWAIT(); SWRITE(b1); } if ((j) + 2 < NT) SLOAD((j) + 2); } while (0)
#define KHEAD() do { kc0 = *(const LAS bf16x8*)(K_lds + b0 * SHM_K + kx[0]); kc1 = *(const LAS bf16x8*)(K_lds + b0 * SHM_K + kx[0] + 32 * 384); SBAR(); } while (0)
#define AQK(j) do { SBAR(); qkt(p0, p1, K_lds + b0 * SHM_K, qr, kx, negm, kc0, kc1); SBAR(); } while (0)
#define RARE(j) do { _Pragma("nounroll") for (int pass_ = 0; pass_ < 2; ++pass_) { NEGM_SET(pass_ ? -m_reg : 0.f); KHEAD(); AQK(j); \
      if (pass_ == 0) { const float mnew_ = fmaxf(m_reg, row_max32(p0, p1)); const float a_ = __builtin_amdgcn_exp2f(m_reg - mnew_); m_reg = mnew_; l_reg *= a_; \
        if (hi == 0) al_l[r32] = a_; asm volatile("s_waitcnt lgkmcnt(0)" ::: "memory"); \
        _Pragma("unroll") for (int d = 0; d < 4; ++d) { SBAR(); _Pragma("unroll") for (int r = 0; r < 16; ++r) o[d][r] *= al_l[crow(r, hi)]; } SBAR(); } } } while (0)
#define ASP(j) do { float ps; VF fa_; v_load<0>(fa_, vb0 + b0 * SHM_V); SBAR(); exp_sum(p0, p1, ps); \
    if (__builtin_expect((j) == 0 || __any(!(ps <= PLIM)), 0)) { RARE(j); exp_sum(p0, p1, ps); } \
    { auto rr = __builtin_amdgcn_permlane32_swap(__float_as_uint(ps), __float_as_uint(ps), false, false); l_reg += __uint_as_float(rr[0]) + __uint_as_float(rr[1]); } \
    pack_p(p0, p1, pa0, pa1, pa2, pa3); SBAR(); pv_d0(o, vb0 + b0 * SHM_V, fa_, pa0, pa1, pa2, pa3); } while (0)
    SLOAD(0); SWAIT(); SWRITE(0); SLOAD(1); ABAR();
    { const bool g1 = __builtin_amdgcn_readfirstlane(wid >> 2) != 0;
      if (g1) ABAR();
      int b0 = 0;
      for (int j = 0; j < NT; ++j) { const int b1 = b0 == 2 ? 0 : b0 + 1; KHEAD(); ASTAGE(j); AQK(j); ABAR(); ASP(j); ABAR(); b0 = b1; }
      if (!g1) ABAR(); }
#undef ABAR
#undef ASTAGE
#undef AQK
#undef KHEAD
#undef ASP
#undef RARE
#undef NEGM_SET
    if (hi == 0) li_l[r32] = l_reg; asm volatile("s_waitcnt lgkmcnt(0)" ::: "memory");
    float rli[16];
#pragma unroll
    for (int r = 0; r < 16; ++r) rli[r] = __builtin_amdgcn_rcpf(li_l[crow(r, hi)]);
    unsigned orow0 = (unsigned)(qrow0 + wid * 32) * DM + 128 * h; asm volatile("" : "+v"(orow0));
    bf16* Ow = (bf16*)(F.ws + WS_MIX) + orow0;
#pragma unroll
    for (int r = 0; r < 16; ++r) { const int orow = crow(r, hi);
#pragma unroll
        for (int d0 = 0; d0 < 4; ++d0) Ow[(size_t)orow * DM + d0 * 32 + r32] = f2bf(o[d0][r] * rli[r]); }
    __syncthreads();
#undef SLOAD
#undef SWRITE
#undef SWAIT
}
}

__device__ __forceinline__ void attn_phase(Frame& F) {
    for (int u = F.vcu; u < 1024 + 16; u += F.G) {
        if (u < 1024) att::unit(F, u >> 6, NCTX + 256 * (u & 63), T);
        else att::unit(F, u - 1024, 0, NCTX);
    }
}

#ifdef DBG
constexpr int DBG_W_BAD = 64, DBG_W_SSQ = 65, DBG_W_CNT = 66, DBG_W_MAX = 67;
__device__ __forceinline__ void dbg_scan(Frame& F, int id, size_t off, size_t nbytes, bool is_bf) {
    PHASE_IDS();
    const u32x4* p = (const u32x4*)(F.ws + off); const size_t n = nbytes / 16; bool bad = false;
    for (size_t i = (size_t)F.vcu * NTHR + tid; i < n; i += (size_t)F.G * NTHR) { const u32x4 v = p[i];
#pragma unroll
        for (int j = 0; j < 4; ++j) { if (is_bf) { bad |= ((v[j] & 0x7f80u) == 0x7f80u) | ((v[j] & 0x7f800000u) == 0x7f800000u); } else bad |= ((v[j] & 0x7f800000u) == 0x7f800000u); } }
    if (__any(bad) && lane == 0) atomicMax((unsigned*)(F.ws + WS_CTL) + DBG_W_BAD, (unsigned)(100000 - id));
}
__device__ __forceinline__ void dbg_max(Frame& F, size_t off, size_t nbytes, bool is_bf) {
    PHASE_IDS();
    const u32x4* p = (const u32x4*)(F.ws + off); const size_t n = nbytes / 16; unsigned mx = 0u;
    for (size_t i = (size_t)F.vcu * NTHR + tid; i < n; i += (size_t)F.G * NTHR) { const u32x4 v = p[i];
#pragma unroll
        for (int j = 0; j < 4; ++j) { if (is_bf) { const unsigned a0 = (v[j] << 16) & 0x7fffffffu, a1 = v[j] & 0x7fff0000u; if (a0 < 0x7f800000u) mx = max(mx, a0); if (a1 < 0x7f800000u) mx = max(mx, a1); } else { const unsigned a0 = v[j] & 0x7fffffffu; if (a0 < 0x7f800000u) mx = max(mx, a0); } } }
#pragma unroll
    for (int o = 1; o < 64; o <<= 1) mx = max(mx, (unsigned)__shfl_xor((int)mx, o));
    if (lane == 0) atomicMax((unsigned*)(F.ws + WS_CTL) + DBG_W_MAX, mx);
}
#define DBGSCAN(id, off, nbytes, isbf) dbg_scan(F, (id), (off), (nbytes), (isbf))
#else
#define DBGSCAN(id, off, nbytes, isbf) do {} while (0)
#endif

#ifndef RES_ALIGN
#define RES_ALIGN true
#endif
#ifndef RES_SP2
#define RES_SP2 true
#endif
__global__ void __launch_bounds__(NTHR, 2) fwd_kernel(Args args) {
    extern __shared__ __attribute__((aligned(16))) unsigned char lds_raw[];
    Frame F;
    F.lds = (LAS unsigned char*)lds_raw;
    F.G = gridDim.x; { const int bx = blockIdx.x; F.vcu = (F.G % 8 == 0) ? (bx % 8) * (F.G / 8) + bx / 8 : bx; }
    F.a = &args; F.ws = args.ws;
    volatile LAS unsigned* ctlw = (volatile LAS unsigned*)(F.lds + LDS_CTL);
    if (threadIdx.x < 16) ctlw[threadIdx.x] = 0u;
    __syncthreads();
    XcdBarrier bar = xcd_barrier_post((unsigned*)(F.ws + WS_CTL) + 4096, ctlw);
#define GRID_BAR() xcd_barrier(bar)
#ifdef DBG_TIME
    unsigned long long t_prev = __builtin_amdgcn_s_memrealtime();
#define TSTAMP(cat) do { if (blockIdx.x == 0 && threadIdx.x == 0) { const unsigned long long t_now = __builtin_amdgcn_s_memrealtime(); unsigned long long* tw = (unsigned long long*)(F.ws + WS_CTL) + 64 + (cat); *tw = *tw + (t_now - t_prev); t_prev = t_now; } } while (0)
#else
#define TSTAMP(cat) do {} while (0)
#endif

#ifndef SK_P0
    p0a(F);
#ifdef DUP_P0
    p0a(F);
#endif
#endif
    GRID_BAR();
    p0b(F); GRID_BAR();
    DBGSCAN(1, WS_MOD, (size_t)4 * 2 * NADA * 4, false);
    init_x_by_owners(F);
    row_phase<0>(F, nullptr, nullptr, modp(F, 0, 0, 0), modp(F, 0, 0, 1), modp(F, 0, 1, 0), modp(F, 0, 1, 1)); GRID_BAR(); TSTAMP(0);
    DBGSCAN(2, WS_X, (size_t)T * DM * 4, false); DBGSCAN(3, WS_H, (size_t)T * DM * 2, true);

    const pg8::bf16_t* Hb = (const pg8::bf16_t*)(F.ws + WS_H);
    for (int s = 0; s < 3 * DEPTH; ++s) {
        const int l = s / 3, r = s % 3;
        const pg8::bf16_t* A2; const pg8::bf16_t* B2; int K2;
        if (r != 1) {
            const int f = r >> 1;
            pg8::Gemm g{Hb, (const pg8::bf16_t*)(F.ws + WS_WFI + (size_t)(l * 2 + f) * SZ_WFI), T, 2 * DFF, DM, DM, DM};
            pg8::StaticOrder S; S.init(T, 2 * DFF, F.G, (int)blockIdx.x);
            pg8::EpiSwiGLU E{(pg8::bf16_t*)(F.ws + WS_HID), DFF};
#ifndef SK_SW
            pg8::gemm_phase<pg8::EpiSwiGLU, pg8::StaticOrder>(F.lds, g, S, E);
#endif
#ifdef DUP_SW
            pg8::gemm_phase<pg8::EpiSwiGLU, pg8::StaticOrder>(F.lds, g, S, E);
#endif
            GRID_BAR(); TSTAMP(1);
            DBGSCAN(10 + 10 * s, WS_HID, (size_t)T * DFF * 2, true);
            A2 = (const pg8::bf16_t*)(F.ws + WS_HID); B2 = (const pg8::bf16_t*)(F.ws + WS_WFO + (size_t)(l * 2 + f) * SZ_WFO); K2 = DFF;
        } else if ((l & 1) == 0) {
            const int e = l >> 1;
            { pg8::Gemm g{Hb, (const pg8::bf16_t*)(F.ws + WS_EWI + (size_t)e * SZ_EWI), T, EV_N, DM, DM, DM};
              pg8::StaticOrder S; S.init(T, EV_N, F.G, (int)blockIdx.x);
              pg8::EpiBf16 E{(pg8::bf16_t*)(F.ws + WS_PROJ), EV_N};
#ifndef SK_G1
              pg8::gemm_phase<pg8::EpiBf16, pg8::StaticOrder>(F.lds, g, S, E);
#endif
            }
            GRID_BAR(); TSTAMP(4);
            DBGSCAN(10 + 10 * s, WS_PROJ, (size_t)T * EV_N * 2 - 0, true);
#ifdef DBG
            if (s == 1) dbg_max(F, WS_PROJ, (size_t)T * EV_N * 2, true);
#endif
#ifndef SK_S1
            s1_phase(F, e);
#ifdef DUP_S1
            s1_phase(F, e);
#endif
#endif
            GRID_BAR(); TSTAMP(5);
            DBGSCAN(11 + 10 * s, WS_U, SZ_U, true); DBGSCAN(16 + 10 * s, WS_OI, (size_t)T * DM * 4, false); DBGSCAN(17 + 10 * s, WS_QT, (size_t)2 * T * 1024 * 2, true); DBGSCAN(18 + 10 * s, WS_DEC, (size_t)2 * 8 * NCH * 128 * 4, false);
#ifndef SK_S2
            s2_phase(F);
#ifdef DUP_S2
            s2_phase(F);
#endif
#endif
            GRID_BAR(); TSTAMP(6);
            DBGSCAN(12 + 10 * s, WS_S, SZ_U, true);
#ifndef SK_S3
            s3_phase(F, e);
#ifdef DUP_S3
            s3_phase(F, e);
#endif
#endif
            GRID_BAR(); TSTAMP(7);
            DBGSCAN(13 + 10 * s, WS_MIX, (size_t)T * DM * 2, true);
            A2 = (const pg8::bf16_t*)(F.ws + WS_MIX); B2 = (const pg8::bf16_t*)(F.ws + WS_EWO + (size_t)e * SZ_SQ); K2 = DM;
        } else {
            const int o = l >> 1;
            { pg8::Gemm g{Hb, (const pg8::bf16_t*)(F.ws + WS_OWI + (size_t)o * SZ_OWI), T, OD_N, DM, DM, DM};
              pg8::StaticOrder S; S.init(T, OD_N, F.G, (int)blockIdx.x);
              pg8::EpiBf16 E{(pg8::bf16_t*)(F.ws + WS_PROJ), OD_N};
#ifndef SK_G2
              pg8::gemm_phase<pg8::EpiBf16, pg8::StaticOrder>(F.lds, g, S, E);
#endif
            }
            GRID_BAR();
#ifndef SK_E1
            e1_phase(F, o);
#endif
            GRID_BAR();
            DBGSCAN(11 + 10 * s, WS_CQN, (size_t)T * 512 * 2 * 2, true); DBGSCAN(11 + 10 * s, WS_KR, (size_t)T * 64 * 2, true);
            for (int q = 0; q < 2; ++q) {
                pg8::Gemm g{(const pg8::bf16_t*)(F.ws + (q ? WS_CKVN : WS_CQN)), (const pg8::bf16_t*)(F.ws + (q ? WS_OUKV + (size_t)o * SZ_OUKV : WS_OUQ + (size_t)o * SZ_OUQ)), T, q ? 4096 : 3072, 512, 512, 512};
                pg8::StaticOrder S; S.init(T, g.N, F.G, (int)blockIdx.x);
                pg8::EpiBf16 E{(pg8::bf16_t*)(F.ws + (q ? WS_KVB : WS_QB)), g.N};
#ifndef SK_G3
                pg8::gemm_phase<pg8::EpiBf16, pg8::StaticOrder>(F.lds, g, S, E);
#endif
            }
            GRID_BAR(); TSTAMP(8);
            DBGSCAN(12 + 10 * s, WS_QB, (size_t)T * 3072 * 2, true); DBGSCAN(12 + 10 * s, WS_KVB, (size_t)T * 4096 * 2, true);
#ifndef SK_ATT
            attn_phase(F);
#ifdef DUP_ATT
            attn_phase(F);
#endif
#endif
            GRID_BAR(); TSTAMP(9);
            DBGSCAN(13 + 10 * s, WS_MIX, (size_t)T * DM * 2, true);
            A2 = (const pg8::bf16_t*)(F.ws + WS_MIX); B2 = (const pg8::bf16_t*)(F.ws + WS_OWO + (size_t)o * SZ_SQ); K2 = DM;
        }
        {
            pg8::Gemm g{A2 + (size_t)NCTX * K2, B2, NLAT, DM, K2, K2, K2};
            pg8::StaticOrder S; S.init(NLAT, DM, F.G, (int)blockIdx.x);
            const int sp = s > 0 ? s - 1 : 0;
            const float* plng = F.a->in[6] + (size_t)sp * DM; const float* plnb = F.a->in[7] + (size_t)sp * DM; const float* stat = (const float*)(F.ws + WS_STAT);
            pg8::EpiResid E{(float*)(F.ws + WS_X) + (size_t)NCTX * DM, modp(F, l, 0, 3 * r + 2), (r != 1) ? 0.5f : 1.0f, stat + (size_t)NCTX * 2, plng, plnb, s > 0 ? 1 : 0};
            ctx_resid_small(F, (float*)(F.ws + WS_X), (const bf16*)A2, (const bf16*)B2, K2, modp(F, l, 1, 3 * r + 2), (r != 1) ? 0.5f : 1.0f, stat, plng, plnb, s > 0 ? 1 : 0, 1);
#ifndef SK_RES
            pg8::gemm_phase<pg8::EpiResid, pg8::StaticOrder, RES_ALIGN, RES_SP2>(F.lds, g, S, E);
#endif
            ctx_resid_small(F, (float*)(F.ws + WS_X), (const bf16*)A2, (const bf16*)B2, K2, modp(F, l, 1, 3 * r + 2), (r != 1) ? 0.5f : 1.0f, stat, plng, plnb, s > 0 ? 1 : 0, 0);
#ifdef DUP_SMALL_OFF
            ctx_resid_small(F, (float*)(F.ws + WS_OI), (const bf16*)A2, (const bf16*)B2, K2, modp(F, l, 1, 3 * r + 2), (r != 1) ? 0.5f : 1.0f);
            ctx_resid_small(F, (float*)(F.ws + WS_OI), (const bf16*)A2, (const bf16*)B2, K2, modp(F, l, 1, 3 * r + 2), (r != 1) ? 0.5f : 1.0f);
#endif
#ifdef DUP_RES
            { pg8::EpiResid E2{(float*)(F.ws + WS_OI) + (size_t)NCTX * DM, modp(F, l, 0, 3 * r + 2), 0.5f, stat, plng, plnb, 0};
              pg8::gemm_phase<pg8::EpiResid, pg8::StaticOrder>(F.lds, g, S, E2); }
#endif
        }
        GRID_BAR(); TSTAMP(r != 1 ? 2 : 10);
        DBGSCAN(14 + 10 * s, WS_X, (size_t)T * DM * 4, false);
        const float* lng = F.a->in[6] + (size_t)(l * 3 + r) * DM; const float* lnb = F.a->in[7] + (size_t)(l * 3 + r) * DM;
        if (s + 1 < 3 * DEPTH) { const int l2 = (s + 1) / 3, r2 = (s + 1) % 3;
            row_phase<1>(F, lng, lnb, modp(F, l2, 0, 3 * r2), modp(F, l2, 0, 3 * r2 + 1), modp(F, l2, 1, 3 * r2), modp(F, l2, 1, 3 * r2 + 1));
            GRID_BAR(); TSTAMP(3);
            DBGSCAN(15 + 10 * s, WS_X, (size_t)T * DM * 4, false); DBGSCAN(15 + 10 * s, WS_H, (size_t)T * DM * 2, true);
#if defined(DBG) && defined(DBG_STOP)
            if (s == DBG_STOP) break;
#endif
        } else {
#ifndef DBG
            row_phase<2>(F, lng, lnb, nullptr, nullptr, nullptr, nullptr);
#endif
        }
    }
#ifdef DBG_TIME
    {   PHASE_IDS(); GRID_BAR();
        const unsigned long long* tw = (const unsigned long long*)(F.ws + WS_CTL) + 64;
        const float tA = (float)__hip_atomic_load(tw + DBG_TA, RLX_AGENT) * 1e-5f, tB = (float)__hip_atomic_load(tw + DBG_TB, RLX_AGENT) * 1e-5f;
        const float cB = DBG_TSCALE * tB, cA = cB; (void)tA;
        float* out = F.a->out;
        for (size_t i = (size_t)F.vcu * NTHR + tid; i < (size_t)NLAT * DM; i += (size_t)F.G * NTHR) out[i] = (i == 12345) ? cA : cB;
    }
#endif
#ifdef DBG
    {
        PHASE_IDS();
        const float* X = (const float*)(F.ws + WS_X); float ssq = 0.f; float cnt = 0.f;
        for (size_t i = (size_t)F.vcu * NTHR + tid; i < (size_t)T * DM; i += (size_t)F.G * NTHR) { const float v = X[i]; if ((__float_as_uint(v) & 0x7f800000u) != 0x7f800000u) { ssq += v * v; cnt += 1.f; } }
        ssq = wave_sum(ssq); cnt = wave_sum(cnt);
        if (lane == 0) { atomicAdd((float*)(F.ws + WS_CTL) + DBG_W_SSQ, ssq); atomicAdd((float*)(F.ws + WS_CTL) + DBG_W_CNT, cnt); }
        GRID_BAR();
        const unsigned badw = __hip_atomic_load((unsigned*)(F.ws + WS_CTL) + DBG_W_BAD, RLX_AGENT);
        const float tss = __hip_atomic_load((float*)(F.ws + WS_CTL) + DBG_W_SSQ, RLX_AGENT), tcn = __hip_atomic_load((float*)(F.ws + WS_CTL) + DBG_W_CNT, RLX_AGENT);
        const float rms = sqrtf(tss / fmaxf(tcn, 1.f)); float cB = fminf(10.f * rms, 1000.f);
#ifdef DBG_REPORT_MAX
        { const unsigned mw = __hip_atomic_load((unsigned*)(F.ws + WS_CTL) + DBG_W_MAX, RLX_AGENT); cB = fminf(log2f(1.0f + __uint_as_float(mw)), 120.f); }
#endif
        const float cA = badw ? (float)(100000u - badw) * 10.f : 5.f;
        float* out = F.a->out;
        for (size_t i = (size_t)F.vcu * NTHR + tid; i < (size_t)NLAT * DM; i += (size_t)F.G * NTHR) out[i] = (i == 12345) ? cA + 0.f : cB;
        (void)cA;
    }
#endif
}

extern "C" void kernel_launch(void* const* d_in, const int* in_sizes, int n_in, void* d_out, int out_size, void* d_ws, size_t ws_size, hipStream_t stream) {
    static int grid = 0;
    if (grid == 0) {
        if (n_in != 23 || out_size != NLAT * DM || ws_size < WS_END) { fprintf(stderr, "kernel_launch: unexpected shapes: n_in %d out %d ws %zu (need %zu)\n", n_in, out_size, ws_size, (size_t)WS_END); grid = -1; return; }
        int dev = 0, cus = 0, per_cu = 0;
        if (hipGetDevice(&dev) != hipSuccess || hipDeviceGetAttribute(&cus, hipDeviceAttributeMultiprocessorCount, dev) != hipSuccess) { grid = -1; return; }
        if (hipFuncSetAttribute((const void*)fwd_kernel, hipFuncAttributeMaxDynamicSharedMemorySize, LDS_BYTES) != hipSuccess) { fprintf(stderr, "kernel_launch: hipFuncSetAttribute failed\n"); grid = -1; return; }
        if (hipOccupancyMaxActiveBlocksPerMultiprocessor(&per_cu, (const void*)fwd_kernel, NTHR, LDS_BYTES) != hipSuccess || per_cu < 1) fprintf(stderr, "kernel_launch: occupancy query reports %d\n", per_cu);
        (void)hipGetLastError();
        grid = cus;
    }
    if (grid < 0) return;
    (void)hipMemsetAsync((char*)d_ws + WS_CTL, 0, CTL_BYTES, stream);
    Args a{};
    for (int i = 0; i < 23; ++i) a.in[i] = (const float*)d_in[i];
    a.out = (float*)d_out; a.ws = (unsigned char*)d_ws;
    hipLaunchKernelGGL(fwd_kernel, dim3(grid), dim3(NTHR), LDS_BYTES, stream, a);
    const hipError_t le = hipPeekAtLastError();
    if (le != hipSuccess) fprintf(stderr, "kernel_launch: launch failed: %s\n", hipGetErrorName(le));
}
```

```cpp
#include <hip/hip_runtime.h>
#include <cstdio>
#include <cstdint>

#define GAS __attribute__((address_space(1)))
#define LAS __attribute__((address_space(3)))
typedef unsigned short bf16;
typedef short bf16x8 __attribute__((ext_vector_type(8)));
typedef short s16x4 __attribute__((ext_vector_type(4)));
typedef float f32x4 __attribute__((ext_vector_type(4)));
typedef float f32x2 __attribute__((ext_vector_type(2)));
typedef float f32x16 __attribute__((ext_vector_type(16)));
typedef unsigned u32x4 __attribute__((ext_vector_type(4)));
typedef unsigned u32x2 __attribute__((ext_vector_type(2)));

constexpr int DM = 2048, NCTX = 256, NLAT = 16384, T = NCTX + NLAT, DEPTH = 4, DFF = 5504;
constexpr int NADA = 9 * DM;
constexpr int EV_N = 6400, OD_N = 1280;
constexpr int NCH = T / 64;
constexpr float DN_ALPHA = 1.6817928305074290f;
constexpr float LN_EPS = 1e-5f, RMS_EPS = 1e-6f;
constexpr int NWAVES = 8, NTHR = 512;
constexpr int LDS_BYTES = 147456;
constexpr int LDS_CTL = LDS_BYTES - 256;

constexpr size_t al256(size_t x) { return (x + 255) / 256 * 256; }
constexpr size_t WS_CTL = 0, CTL_BYTES = 1u << 20;
constexpr size_t WS_MODP = WS_CTL + CTL_BYTES;
constexpr size_t WS_MOD = WS_MODP + al256((size_t)8 * 2 * 4 * NADA * 4);
constexpr size_t WS_RT = WS_MOD + al256((size_t)4 * 2 * NADA * 4);
constexpr size_t WS_AXR = WS_RT + al256((size_t)NLAT * 64 * 8);
constexpr size_t WS_AXC = WS_AXR + al256(256 * 16 * 8);
constexpr size_t WS_STAT = WS_AXC + al256(64 * 16 * 8);
constexpr size_t WS_WFI = WS_STAT + al256((size_t)T * 8);
constexpr size_t SZ_WFI = (size_t)2 * DFF * DM * 2;
constexpr size_t WS_WFO = WS_WFI + 8 * SZ_WFI;
constexpr size_t SZ_WFO = (size_t)DM * DFF * 2;
constexpr size_t WS_EWI = WS_WFO + 8 * SZ_WFO;
constexpr size_t SZ_EWI = (size_t)EV_N * DM * 2;
constexpr size_t WS_EWO = WS_EWI + 2 * SZ_EWI;
constexpr size_t SZ_SQ = (size_t)DM * DM * 2;
constexpr size_t WS_OWI = WS_EWO + 2 * SZ_SQ;
constexpr size_t SZ_OWI = (size_t)OD_N * DM * 2;
constexpr size_t WS_OUQ = WS_OWI + 2 * SZ_OWI;
constexpr size_t SZ_OUQ = (size_t)3072 * 512 * 2;
constexpr size_t WS_OUKV = WS_OUQ + 2 * SZ_OUQ;
constexpr size_t SZ_OUKV = (size_t)4096 * 512 * 2;
constexpr size_t WS_OWO = WS_OUKV + 2 * SZ_OUKV;
constexpr size_t WS_X = WS_OWO + 2 * SZ_SQ;
constexpr size_t WS_H = WS_X + (size_t)T * DM * 4;
constexpr size_t WS_HID = WS_H + (size_t)T * DM * 2;
constexpr size_t WS_MIX = WS_HID + (size_t)T * DFF * 2;
constexpr size_t WS_PROJ = WS_MIX + (size_t)T * DM * 2;
constexpr size_t WS_U = WS_PROJ + (size_t)T * EV_N * 2;
constexpr size_t SZ_U = (size_t)2 * 8 * NCH * 256 * 128 * 2;
constexpr size_t WS_S = WS_U + SZ_U;
constexpr size_t WS_OI = WS_S + SZ_U;
constexpr size_t WS_QT = WS_OI + (size_t)T * DM * 4;
constexpr size_t WS_DEC = WS_QT + (size_t)2 * T * 1024 * 2;
constexpr size_t WS_END_EVEN = WS_DEC + al256((size_t)2 * 8 * NCH * 128 * 4);
constexpr size_t WS_CQN = WS_U;
constexpr size_t WS_CKVN = WS_CQN + (size_t)T * 512 * 2;
constexpr size_t WS_KR = WS_CKVN + (size_t)T * 512 * 2;
constexpr size_t WS_QB = WS_KR + al256((size_t)T * 64 * 2);
constexpr size_t WS_KVB = WS_QB + (size_t)T * 3072 * 2;
constexpr size_t WS_END_ODD = WS_KVB + (size_t)T * 4096 * 2;
constexpr size_t WS_END = WS_END_EVEN > WS_END_ODD ? WS_END_EVEN : WS_END_ODD;

#define RLX_AGENT __ATOMIC_RELAXED, __HIP_MEMORY_SCOPE_AGENT
#define LDS_WAIT() asm volatile("s_waitcnt lgkmcnt(0)" ::: "memory")
#define VM_WAIT() asm volatile("s_waitcnt vmcnt(0)" ::: "memory")
__device__ __forceinline__ unsigned cvt_pk_bf16(float lo, float hi) { unsigned r; asm volatile("v_cvt_pk_bf16_f32 %0, %1, %2" : "=v"(r) : "v"(lo), "v"(hi)); return r; }
__device__ __forceinline__ float bflo(unsigned w) { return __uint_as_float(w << 16); }
__device__ __forceinline__ float bfhi(unsigned w) { return __uint_as_float(w & 0xffff0000u); }
__device__ __forceinline__ float bf2f(bf16 b) { return __uint_as_float(((unsigned)b) << 16); }
__device__ __forceinline__ bf16 f2bf(float f) { return (bf16)(cvt_pk_bf16(f, 0.f) & 0xffffu); }
__device__ __forceinline__ float wave_sum(float v) {
#pragma unroll
    for (int o = 1; o < 64; o <<= 1) v += __shfl_xor(v, o);
    return v;
}
__device__ __forceinline__ float silu_f(float g) { return g * __builtin_amdgcn_rcpf(1.0f + __builtin_amdgcn_exp2f(-1.4426950408889634f * g)); }

namespace pg8 {
#define PG8_LAS __attribute__((address_space(3)))
typedef unsigned short bf16_t;
constexpr int BM = 256, BK = 64, HALF = 128, HTB = HALF * BK * 2, STAGE_BYTES = 8 * HTB, NXCD = 8, WGM = 8;
__host__ __device__ __forceinline__ int lds_byte(int r, int c) { const int st = (r >> 4) * 2 + (c >> 5), rr = r & 15, cc = c & 31, ob = rr * 64 + cc * 2; return st * 1024 + (ob ^ (((ob >> 9) & 1) << 5)); }
__host__ __device__ __forceinline__ void stage_rc(int b, int& R, int& C) { const int st = b / 1024, sb = b % 1024, swz = sb ^ (((sb >> 9) & 1) << 5); R = (st >> 1) * 16 + swz / 64; C = (st & 1) * 32 + (swz % 64) / 2; }
__host__ __device__ __forceinline__ int perm32(int rho) { const int n = rho >> 4, i = rho & 15; return 8 * (i >> 2) + 4 * n + (i & 3); }
struct Unit { int pm, pn; };
struct Gemm { const bf16_t* A; const bf16_t* Bt; int M, N, K, lda, ldb; };
struct StaticOrder {
    int nM, nN, nwg, G, c;
    __host__ __device__ void init(int M, int N, int G_, int c_) { nM = M / BM; nN = N / BM; nwg = nM * nN; G = G_; c = c_; }
    __host__ __device__ bool next(int i, Unit& u) const {
        const long L = (long)i * G + c; if (L >= nwg) return false;
        int wgid = (int)L; { const int q = nwg / NXCD, r = nwg % NXCD, xcd = wgid % NXCD, off = wgid / NXCD; wgid = (xcd < r ? xcd * (q + 1) : r * (q + 1) + (xcd - r) * q) + off; }
        const int nig = WGM * nN, gid = wgid / nig, fm = gid * WGM, gsz = (nM - fm) < WGM ? (nM - fm) : WGM;
        u.pm = fm + ((wgid % nig) % gsz); u.pn = (wgid % nig) / gsz; return true;
    }
    __device__ __forceinline__ void a_ready(const Unit&) const {}
    __device__ __forceinline__ void done(const Unit&) const {}
};
struct EpiBf16 {
    static constexpr bool PERM = true;
    bf16_t* O; int ldc;
    __device__ __forceinline__ void operator()(const f32x4 (&acc)[2][2][4][2], const Unit& u, int wr, int wc, int fr, int fq) const {
        const int row0 = u.pm * BM + wr * 64 + fr, col0 = u.pn * BM + wc * 32 + 8 * fq;
        asm volatile("s_nop 15" ::: "memory");
#pragma unroll
        for (int ai = 0; ai < 2; ++ai)
#pragma unroll
            for (int m = 0; m < 4; ++m) { bf16_t* rowp = O + (size_t)(row0 + ai * HALF + m * 16) * ldc + col0;
#pragma unroll
                for (int bj = 0; bj < 2; ++bj) { const f32x4 v0 = acc[ai][bj][m][0], v1 = acc[ai][bj][m][1];
                    u32x4 w; w.x = cvt_pk_bf16(v0[0], v0[1]); w.y = cvt_pk_bf16(v0[2], v0[3]); w.z = cvt_pk_bf16(v1[0], v1[1]); w.w = cvt_pk_bf16(v1[2], v1[3]);
                    *(u32x4*)(rowp + bj * HALF) = w; } }
    }
};
struct EpiSwiGLU {
    static constexpr bool PERM = true;
    bf16_t* O; int ldc;
    __device__ __forceinline__ void operator()(const f32x4 (&acc)[2][2][4][2], const Unit& u, int wr, int wc, int fr, int fq) const {
        const int row0 = u.pm * BM + wr * 64 + fr, col0 = u.pn * HALF + wc * 32 + 8 * fq;
#pragma unroll
        for (int ai = 0; ai < 2; ++ai)
#pragma unroll
            for (int m = 0; m < 4; ++m) { bf16_t* rowp = O + (size_t)(row0 + ai * HALF + m * 16) * ldc + col0;
                float h[8];
#pragma unroll
                for (int n = 0; n < 2; ++n)
#pragma unroll
                    for (int j = 0; j < 4; ++j) h[n * 4 + j] = silu_f(acc[ai][0][m][n][j]) * acc[ai][1][m][n][j];
                u32x4 w; w.x = cvt_pk_bf16(h[0], h[1]); w.y = cvt_pk_bf16(h[2], h[3]); w.z = cvt_pk_bf16(h[4], h[5]); w.w = cvt_pk_bf16(h[6], h[7]);
                *(u32x4*)rowp = w; asm volatile("" ::: "memory"); }
    }
};
struct EpiResid {
    static constexpr bool PERM = true;
    float* X; const float* gv; float gs; const float* stat; const float* lng; const float* lnb; int has_ln;
    __device__ __forceinline__ void operator()(const f32x4 (&acc)[2][2][4][2], const Unit& u, int wr, int wc, int fr, int fq) const {
        const int row0 = u.pm * BM + wr * 64 + fr, col0 = u.pn * BM + wc * 32 + 8 * fq;
        f32x2 st[2][4];
#pragma unroll
        for (int ai = 0; ai < 2; ++ai)
#pragma unroll
            for (int m = 0; m < 4; ++m) { st[ai][m] = has_ln ? *(const f32x2*)(stat + (size_t)(row0 + ai * HALF + m * 16) * 2) : (f32x2){0.f, 1.f}; st[ai][m].y *= DN_ALPHA; }
#pragma unroll
        for (int bj = 0; bj < 2; ++bj) { const int c = col0 + bj * HALF;
            f32x4 g[2], G[2], B[2];
#pragma unroll
            for (int n = 0; n < 2; ++n) { g[n] = *(const f32x4*)(gv + c + 4 * n) * gs;
                G[n] = has_ln ? *(const f32x4*)(lng + c + 4 * n) : (f32x4){1.f, 1.f, 1.f, 1.f}; B[n] = has_ln ? *(const f32x4*)(lnb + c + 4 * n) * DN_ALPHA : (f32x4){0.f, 0.f, 0.f, 0.f}; }
#pragma unroll
            for (int ai = 0; ai < 2; ++ai)
#pragma unroll
                for (int m = 0; m < 4; ++m) { float* p = X + (size_t)(row0 + ai * HALF + m * 16) * DM + c;
                    const f32x4 z0 = *(const f32x4*)p, z1 = *(const f32x4*)(p + 4);
                    *(f32x4*)p = (z0 - st[ai][m].x) * st[ai][m].y * G[0] + B[0] + g[0] * acc[ai][bj][m][0];
                    *(f32x4*)(p + 4) = (z1 - st[ai][m].x) * st[ai][m].y * G[1] + B[1] + g[1] * acc[ai][bj][m][1]; }
            asm volatile("" ::: "memory"); }
    }
};

template <class Epi, class Sched, bool ALIGN_EPI = true, bool SP2 = true>
__device__ __forceinline__ void gemm_phase(PG8_LAS unsigned char* lds, const Gemm g, const Sched& S, const Epi& E) {
    int tid = threadIdx.x; asm volatile("" : "+v"(tid));
    const int wid = __builtin_amdgcn_readfirstlane(tid >> 6), lane = tid & 63, wr = wid >> 2, wc = wid & 3, fr = lane & 15, fq = lane >> 4;
    const int K = g.K, nt = K / BK;
    unsigned voffA[2], voffB[2];
#pragma unroll
    for (int i = 0; i < 2; ++i) { int R, C; stage_rc(tid * 16 + i * 8192, R, C); const int Rb = Epi::PERM ? ((R & ~31) + perm32(R & 31)) : R;
        voffA[i] = (unsigned)(R * g.lda + C) * 2u; voffB[i] = (unsigned)(Rb * g.ldb + C) * 2u; }
    const size_t kstep = (size_t)(BK * 2);
    const size_t hstepA = (size_t)HALF * g.lda * 2, hstepB = (size_t)HALF * g.ldb * 2;
    const size_t tstepA = 2 * hstepA, tstepB = 2 * hstepB;
    const unsigned ldsw = (unsigned)wid * 1024u;
    const int aoff = lds_byte(wr * 64 + fr, fq * 8), boff = lds_byte(wc * 32 + fr, fq * 8);
#define PG8_SA(b, h) (((b) * 2 + (h)) * HTB)
#define PG8_SB(b, h) ((4 + (b) * 2 + (h)) * HTB)
#define PG8_STAGE(bufoff, gbase, voff) do { _Pragma("unroll") for (int _i = 0; _i < 2; ++_i) \
        __builtin_amdgcn_global_load_lds((const unsigned*)((const char*)(gbase) + (voff)[_i]), (PG8_LAS unsigned*)(lds + (bufoff) + ldsw + _i * 8192), 16, 0, 0); } while (0)
#define PG8_LDA(dst, b, h) do { _Pragma("unroll") for (int m = 0; m < 4; ++m) _Pragma("unroll") for (int k = 0; k < 2; ++k) dst[m][k] = *(const PG8_LAS bf16x8*)(lds + PG8_SA(b, h) + aoff + m * 2048 + k * 1024); } while (0)
#define PG8_LDB(dst, b, h) do { _Pragma("unroll") for (int n = 0; n < 2; ++n) _Pragma("unroll") for (int k = 0; k < 2; ++k) dst[n][k] = *(const PG8_LAS bf16x8*)(lds + PG8_SB(b, h) + boff + n * 2048 + k * 1024); } while (0)
#define PG8_MMA(ai, bj, At, Bt) do { __builtin_amdgcn_s_setprio(1); _Pragma("unroll") for (int m = 0; m < 4; ++m) _Pragma("unroll") for (int n = 0; n < 2; ++n) _Pragma("unroll") for (int k = 0; k < 2; ++k) \
        acc[ai][bj][m][n] = __builtin_amdgcn_mfma_f32_16x16x32_bf16(Bt[n][k], At[m][k], acc[ai][bj][m][n], 0, 0, 0); __builtin_amdgcn_s_setprio(0); } while (0)
#define PG8_WAIT_V(n) asm volatile("s_waitcnt vmcnt(" #n ")" ::: "memory")
#define PG8_WAIT_L(n) asm volatile("s_waitcnt lgkmcnt(" #n ")" ::: "memory")
#define PG8_BAR __builtin_amdgcn_s_barrier()
#define PG8_SCHED __builtin_amdgcn_sched_barrier(0)
    Unit cur, nxt; int ui = 0;
    if (!S.next(0, cur)) return;
    f32x4 acc[2][2][4][2];
#pragma unroll
    for (int a = 0; a < 2; ++a)
#pragma unroll
        for (int b = 0; b < 2; ++b)
#pragma unroll
            for (int m = 0; m < 4; ++m)
#pragma unroll
                for (int n = 0; n < 2; ++n) acc[a][b][m][n] = (f32x4){0.f, 0.f, 0.f, 0.f};
    bf16x8 At[4][2], B0[2][2], B1[2][2];
    const char* cA = (const char*)g.A + (size_t)cur.pm * tstepA; const char* cB = (const char*)g.Bt + (size_t)cur.pn * tstepB;
    S.a_ready(cur);
    if constexpr (SP2) {
        PG8_STAGE(PG8_SB(0, 0), cB, voffB); PG8_STAGE(PG8_SB(0, 1), cB + hstepB, voffB); PG8_STAGE(PG8_SA(0, 0), cA, voffA); PG8_STAGE(PG8_SA(0, 1), cA + hstepA, voffA);
        if (wr == 1) PG8_BAR;
        PG8_WAIT_V(2); PG8_BAR;
        PG8_STAGE(PG8_SB(1, 0), cB + kstep, voffB); PG8_STAGE(PG8_SA(1, 0), cA + kstep, voffA); PG8_STAGE(PG8_SB(1, 1), cB + hstepB + kstep, voffB);
        PG8_WAIT_V(6); PG8_BAR;
    } else {
        PG8_STAGE(PG8_SB(0, 0), cB, voffB); PG8_STAGE(PG8_SA(0, 0), cA, voffA); PG8_STAGE(PG8_SB(0, 1), cB + hstepB, voffB); PG8_STAGE(PG8_SA(0, 1), cA + hstepA, voffA);
        if (wr == 1) PG8_BAR;
        PG8_WAIT_V(4); PG8_BAR;
        PG8_STAGE(PG8_SB(1, 0), cB + kstep, voffB); PG8_STAGE(PG8_SA(1, 0), cA + kstep, voffA); PG8_STAGE(PG8_SB(1, 1), cB + hstepB + kstep, voffB);
        PG8_WAIT_V(6); PG8_BAR;
    }
    for (;;) {
        const bool has_next = S.next(ui + 1, nxt);
        const char* nA = has_next ? (const char*)g.A + (size_t)nxt.pm * tstepA : cA; const char* nB = has_next ? (const char*)g.Bt + (size_t)nxt.pn * tstepB : cB;
        for (int t = 0; t < nt; t += 2) {
            const bool last = (t == nt - 2);
            const char* a1 = cA + (size_t)(t + 1) * kstep;
            const char* a2 = last ? nA : cA + (size_t)(t + 2) * kstep; const char* b2 = last ? nB : cB + (size_t)(t + 2) * kstep;
            const char* a3 = a2 + kstep; const char* b3 = b2 + kstep;
            if (last && has_next) S.a_ready(nxt);
            if constexpr (SP2) {
            PG8_LDB(B0, 0, 0); PG8_LDB(B1, 0, 1); PG8_SCHED; PG8_LDA(At, 0, 0); PG8_STAGE(PG8_SA(1, 1), a1 + hstepA, voffA);
            PG8_WAIT_V(8); PG8_WAIT_L(0); PG8_BAR; PG8_MMA(0, 0, At, B0); PG8_MMA(0, 1, At, B1); PG8_BAR; PG8_SCHED;
            PG8_LDA(At, 0, 1); PG8_STAGE(PG8_SB(0, 0), b2, voffB); PG8_STAGE(PG8_SB(0, 1), b2 + hstepB, voffB); PG8_STAGE(PG8_SA(0, 0), a2, voffA);
            PG8_WAIT_V(8); PG8_WAIT_L(0); PG8_BAR; PG8_MMA(1, 0, At, B0); PG8_MMA(1, 1, At, B1); PG8_BAR; PG8_SCHED;
            PG8_LDB(B0, 1, 0); PG8_LDB(B1, 1, 1); PG8_SCHED; PG8_LDA(At, 1, 0); PG8_STAGE(PG8_SA(0, 1), a2 + hstepA, voffA);
            PG8_WAIT_V(8); PG8_WAIT_L(0); PG8_BAR; PG8_MMA(0, 0, At, B0); PG8_MMA(0, 1, At, B1); PG8_BAR; PG8_SCHED;
            PG8_LDA(At, 1, 1); PG8_STAGE(PG8_SB(1, 0), b3, voffB); PG8_STAGE(PG8_SB(1, 1), b3 + hstepB, voffB); PG8_STAGE(PG8_SA(1, 0), a3, voffA);
            PG8_WAIT_V(8); PG8_WAIT_L(0); PG8_BAR; PG8_MMA(1, 0, At, B0); PG8_MMA(1, 1, At, B1); PG8_BAR; PG8_SCHED;
            } else {
            PG8_LDB(B0, 0, 0); PG8_SCHED; PG8_LDA(At, 0, 0); PG8_STAGE(PG8_SA(1, 1), a1 + hstepA, voffA);
            PG8_WAIT_L(8); PG8_BAR; PG8_WAIT_L(0); PG8_MMA(0, 0, At, B0); PG8_BAR; PG8_SCHED;
            PG8_LDB(B1, 0, 1); PG8_STAGE(PG8_SB(0, 0), b2, voffB);
            PG8_BAR; PG8_WAIT_L(0); PG8_MMA(0, 1, At, B1); PG8_BAR;
            PG8_LDA(At, 0, 1); PG8_STAGE(PG8_SA(0, 0), a2, voffA);
            PG8_BAR; PG8_WAIT_L(0); PG8_MMA(1, 0, At, B0); PG8_BAR; PG8_SCHED;
            PG8_STAGE(PG8_SB(0, 1), b2 + hstepB, voffB);
            PG8_WAIT_V(6); PG8_BAR; PG8_MMA(1, 1, At, B1); PG8_BAR;
            PG8_LDB(B0, 1, 0); PG8_SCHED; PG8_LDA(At, 1, 0); PG8_STAGE(PG8_SA(0, 1), a2 + hstepA, voffA);
            PG8_WAIT_L(8); PG8_BAR; PG8_WAIT_L(0); PG8_MMA(0, 0, At, B0); PG8_BAR; PG8_SCHED;
            PG8_LDB(B1, 1, 1); PG8_STAGE(PG8_SB(1, 0), b3, voffB);
            PG8_BAR; PG8_WAIT_L(0); PG8_MMA(0, 1, At, B1); PG8_BAR;
            PG8_LDA(At, 1, 1); PG8_STAGE(PG8_SA(1, 0), a3, voffA);
            PG8_BAR; PG8_WAIT_L(0); PG8_MMA(1, 0, At, B0); PG8_BAR; PG8_SCHED;
            PG8_STAGE(PG8_SB(1, 1), b3 + hstepB, voffB);
            PG8_WAIT_V(6); PG8_BAR; PG8_MMA(1, 1, At, B1); PG8_BAR;
            }
        }
        if constexpr (ALIGN_EPI) { if (wr == 0) PG8_BAR; }
        E(acc, cur, wr, wc, fr, fq); S.done(cur);
        if (!has_next) break;
#pragma unroll
        for (int a = 0; a < 2; ++a)
#pragma unroll
            for (int b = 0; b < 2; ++b)
#pragma unroll
                for (int m = 0; m < 4; ++m)
#pragma unroll
                    for (int n = 0; n < 2; ++n) acc[a][b][m][n] = (f32x4){0.f, 0.f, 0.f, 0.f};
        cur = nxt; cA = nA; cB = nB; ++ui;
        if constexpr (ALIGN_EPI) { if (wr == 1) PG8_BAR; }
    }
    PG8_WAIT_V(0);
    if constexpr (!ALIGN_EPI) { if (wr == 0) PG8_BAR; }
    PG8_BAR;
#undef PG8_SA
#undef PG8_SB
#undef PG8_STAGE
#undef PG8_LDA
#undef PG8_LDB
#undef PG8_MMA
#undef PG8_WAIT_V
#undef PG8_WAIT_L
#undef PG8_BAR
#undef PG8_SCHED
}
}

#define XB_TMO      128
#define XB_XCNT(j)  (256  + 64 * (j))
#define XB_XSUB(j)  (1280 + 64 * (j))
#define XB_XGEN(j)  (2304 + 64 * (j))
#define XB_TOP      3328
#define XB_TOPGEN   3392
#define XCD_BAR_WORDS 3456
#define XB_SPIN_CAP (1u << 18)
__device__ __forceinline__ unsigned xb_ld(unsigned* p)              { return __hip_atomic_load(p, __ATOMIC_RELAXED, __HIP_MEMORY_SCOPE_AGENT); }
__device__ __forceinline__ unsigned xb_add(unsigned* p, unsigned v) { return __hip_atomic_fetch_add(p, v, __ATOMIC_RELAXED, __HIP_MEMORY_SCOPE_AGENT); }
__device__ __forceinline__ unsigned xb_xcc_id() { return (unsigned)__builtin_amdgcn_s_getreg((3 << 11) | 20) & 0xFu; }
#define XB_SPIN(cond, bar) do { unsigned _sp = 0; while (cond) { __builtin_amdgcn_s_sleep(1); \
    if ((++_sp & 255u) == 0u) { if (xb_ld(&(bar)[XB_TMO])) break; if (_sp > XB_SPIN_CAP) { atomicAdd(&(bar)[XB_TMO], 1u); break; } } } } while (0)
struct XcdBarrier { unsigned* bar; unsigned x; volatile LAS unsigned* st; };
__device__ __forceinline__ XcdBarrier xcd_barrier_post(unsigned* bar, volatile LAS unsigned* st) {
    XcdBarrier b; b.bar = bar; b.x = xb_xcc_id(); b.st = st;
    if (threadIdx.x == 0) (void)xb_add(&bar[XB_XCNT(b.x)], 1u);
    return b;
}
__device__ __forceinline__ void xcd_barrier_complete(unsigned* bar, unsigned x, unsigned& nloc, unsigned& nx) {
    const unsigned G = gridDim.x * gridDim.y * gridDim.z;
    unsigned sum, cnt, mine, sp = 0u;
    for (;;) {
        sum = 0u; cnt = 0u; mine = 0u;
#pragma unroll
        for (unsigned j = 0; j < 16; ++j) { const unsigned c = xb_ld(&bar[XB_XCNT(j)]); sum += c; cnt += (c > 0u) ? 1u : 0u; mine = (j == x) ? c : mine; }
        if (sum == G) break;
        __builtin_amdgcn_s_sleep(1);
        if ((++sp & 255u) == 0u) { if (xb_ld(&bar[XB_TMO])) break; if (sp > XB_SPIN_CAP) { atomicAdd(&bar[XB_TMO], 1u); break; } }
    }
    nloc = mine > 0u ? mine : 1u; nx = cnt > 0u ? cnt : 1u;
}
__device__ __forceinline__ void xcd_barrier(const XcdBarrier& b0) {
    asm volatile("s_waitcnt vmcnt(0)" ::: "memory");
    __syncthreads();
    if (threadIdx.x == 0) {
        XcdBarrier b = b0; b.x = xb_xcc_id();
        unsigned* bar = b.bar;
        __builtin_amdgcn_s_waitcnt(0);
        unsigned nloc = b.st[0], nx = b.st[1];
        if (nloc == 0u) { xcd_barrier_complete(bar, b.x, nloc, nx); b.st[0] = nloc; b.st[1] = nx; }
        const unsigned old = xb_add(&bar[XB_XSUB(b.x)], 1u);
        const unsigned gen = old / nloc;
        if (old + 1u == (gen + 1u) * nloc) {
            __builtin_amdgcn_fence(__ATOMIC_RELEASE, "agent");
            asm volatile("s_waitcnt vmcnt(0)" ::: "memory");
            const unsigned og = xb_add(&bar[XB_TOP], 1u);
            const unsigned tg = og / nx;
            if (og + 1u == (tg + 1u) * nx) xb_add(&bar[XB_TOPGEN], 1u);
            else XB_SPIN(xb_ld(&bar[XB_TOPGEN]) == tg, bar);
            __builtin_amdgcn_fence(__ATOMIC_ACQUIRE, "agent");
            xb_add(&bar[XB_XGEN(b.x)], 1u);
            asm volatile("s_waitcnt vmcnt(0)" ::: "memory");
        } else {
            XB_SPIN(xb_ld(&bar[XB_XGEN(b.x)]) == gen, bar);
            __builtin_amdgcn_fence(__ATOMIC_ACQUIRE, "agent");
            asm volatile("s_waitcnt vmcnt(0)" ::: "memory");
        }
    }
    __syncthreads();
}

struct Args { const float* in[23]; float* out; unsigned char* ws; };
struct Frame {
    LAS unsigned char* lds;
    int vcu, G;
    const Args* a; unsigned char* ws;
};
#define PHASE_IDS() int tid = threadIdx.x; asm volatile("" : "+v"(tid)); const int lane = tid & 63, wave = __builtin_amdgcn_readfirstlane(tid >> 6); (void)lane; (void)wave
#define MFMA16(a, b, c) __builtin_amdgcn_mfma_f32_16x16x32_bf16((a), (b), (c), 0, 0, 0)
#define MFMA32(a, b, c) __builtin_amdgcn_mfma_f32_32x32x16_bf16((a), (b), (c), 0, 0, 0)

constexpr float ATT_QSCALE = 0.07216878364870322f * 1.4426950408889634f;
__device__ __forceinline__ void tr_item(const float* W, int N, int K, bf16* WT, int k0, int n0, int drow0, LAS float* scr, int lane, float sc = 1.0f) {
#pragma unroll 8
    for (int i = 0; i < 32; ++i) { const int kk = 2 * i + (lane >> 5); scr[kk * 33 + (lane & 31)] = W[(size_t)(k0 + kk) * N + n0 + (lane & 31)]; }
    LDS_WAIT(); asm volatile("" ::: "memory");
    const int c = lane & 7;
#pragma unroll
    for (int j = 0; j < 4; ++j) { const int n = (lane >> 3) + 8 * j; const LAS float* s = scr + (8 * c) * 33 + n;
        u32x4 o; o.x = cvt_pk_bf16(s[0 * 33] * sc, s[1 * 33] * sc); o.y = cvt_pk_bf16(s[2 * 33] * sc, s[3 * 33] * sc); o.z = cvt_pk_bf16(s[4 * 33] * sc, s[5 * 33] * sc); o.w = cvt_pk_bf16(s[6 * 33] * sc, s[7 * 33] * sc);
        *(u32x4*)(WT + (size_t)(drow0 + n) * K + k0 + 8 * c) = o; }
    LDS_WAIT(); asm volatile("" ::: "memory");
}
__device__ __forceinline__ void p0a(Frame& F) {
    PHASE_IDS();
    LAS float* scr = (LAS float*)(F.lds + wave * 8704);
    LAS float* sv = (LAS float*)(F.lds + 8 * 8704);
    for (int i = tid; i < 2 * DM; i += NTHR) { const float v = (i < DM) ? F.a->in[1][i] : F.a->in[3][i - DM]; sv[i] = v / (1.0f + __expf(-v)); }
    __syncthreads();
    const int gw = F.vcu * NWAVES + wave, NGW = F.G * NWAVES;
    constexpr int I0 = 8 * 32 * 344, I1 = 8 * 86 * 64, I2 = 2 * 32 * 193, I3 = 2 * 32 * 64, I4 = 2 * 32 * 34, I5 = 2 * 8 * 96, I6 = 2 * 8 * 128, I7 = 2 * 32 * 64;
    constexpr int NTR = I0 + I1 + I2 + I3 + I4 + I5 + I6 + I7, NADAI = 8 * 288;
    for (int it = gw; it < NTR + NADAI; it += NGW) {
        int r = it;
        if (r < I0) { const int mat = r / 11008, q = r % 11008, kb = q / 344, nb = q % 344, n0 = nb * 32;
            const int j = n0 < DFF ? n0 : n0 - DFF, drow = (j / 128) * 256 + (j % 128) + (n0 < DFF ? 0 : 128);
            tr_item(F.a->in[8] + (size_t)mat * DM * 2 * DFF, 2 * DFF, DM, (bf16*)(F.ws + WS_WFI + mat * SZ_WFI), kb * 64, n0, drow - 0, scr, lane); continue; } r -= I0;
        if (r < I1) { const int mat = r / 5504, q = r % 5504, kb = q / 64, nb = q % 64;
            tr_item(F.a->in[9] + (size_t)mat * DFF * DM, DM, DFF, (bf16*)(F.ws + WS_WFO + mat * SZ_WFO), kb * 64, nb * 32, nb * 32, scr, lane); continue; } r -= I1;
        if (r < I2) { const int mat = r / 6176, q = r % 6176, kb = q / 193, nb = q % 193, n0 = nb * 32;
            const int drow = n0 < 3072 ? n0 : (n0 < 3104 ? 6144 : n0 - 32);
            tr_item(F.a->in[10] + (size_t)mat * DM * 6176, 6176, DM, (bf16*)(F.ws + WS_EWI + mat * SZ_EWI), kb * 64, n0, drow, scr, lane); continue; } r -= I2;
        if (r < I3) { const int mat = r / 2048, q = r % 2048, kb = q / 64, nb = q % 64;
            tr_item(F.a->in[16] + (size_t)mat * DM * DM, DM, DM, (bf16*)(F.ws + WS_EWO + mat * SZ_SQ), kb * 64, nb * 32, nb * 32, scr, lane); continue; } r -= I3;
        if (r < I4) { const int mat = r / 1088, q = r % 1088, kb = q / 34, nb = q % 34;
            tr_item(F.a->in[17] + (size_t)mat * DM * 1088, 1088, DM, (bf16*)(F.ws + WS_OWI + mat * SZ_OWI), kb * 64, nb * 32, nb * 32, scr, lane); continue; } r -= I4;
        if (r < I5) { const int mat = r / 768, q = r % 768, kb = q / 96, nb = q % 96;
            tr_item(F.a->in[20] + (size_t)mat * 512 * 3072, 3072, 512, (bf16*)(F.ws + WS_OUQ + mat * SZ_OUQ), kb * 64, nb * 32, nb * 32, scr, lane, ATT_QSCALE); continue; } r -= I5;
        if (r < I6) { const int mat = r / 1024, q = r % 1024, kb = q / 128, nb = q % 128;
            tr_item(F.a->in[21] + (size_t)mat * 512 * 4096, 4096, 512, (bf16*)(F.ws + WS_OUKV + mat * SZ_OUKV), kb * 64, nb * 32, nb * 32, scr, lane); continue; } r -= I6;
        if (r < I7) { const int mat = r / 2048, q = r % 2048, kb = q / 64, nb = q % 64;
            tr_item(F.a->in[22] + (size_t)mat * DM * DM, DM, DM, (bf16*)(F.ws + WS_OWO + mat * SZ_SQ), kb * 64, nb * 32, nb * 32, scr, lane); continue; } r -= I7;
        {
            const int ks = r / 288, cg = r % 288, l = cg / 72, n = (cg % 72) * 256 + lane * 4;
            const float* w = F.a->in[4] + ((size_t)l * DM + ks * 256) * NADA + n;
            f32x4 al = {0.f, 0.f, 0.f, 0.f}, ac = {0.f, 0.f, 0.f, 0.f};
#pragma unroll 8
            for (int k = 0; k < 256; ++k) { const f32x4 wv = *(const f32x4*)(w + (size_t)k * NADA); al += wv * sv[ks * 256 + k]; ac += wv * sv[DM + ks * 256 + k]; }
            float* mp = (float*)(F.ws + WS_MODP);
            *(f32x4*)(mp + (size_t)(ks * 2 + 0) * 4 * NADA + l * NADA + n) = al;
            *(f32x4*)(mp + (size_t)(ks * 2 + 1) * 4 * NADA + l * NADA + n) = ac;
        }
    }
    const int gt = F.vcu * NTHR + tid, NGT = F.G * NTHR;
    for (int i = gt; i < NLAT * 64 + 256 * 16 + 64 * 16; i += NGT) {
        int pos, fi; float inv; f32x2* dst;
        if (i < NLAT * 64) { pos = i >> 6; fi = i & 63; inv = __builtin_amdgcn_exp2f(-(float)fi * (13.287712379549449f / 64.0f)); dst = (f32x2*)(F.ws + WS_RT) + i; }
        else if (i < NLAT * 64 + 4096) { const int j = i - NLAT * 64; pos = j >> 4; fi = j & 15; inv = __builtin_amdgcn_exp2f(-(float)fi * (13.287712379549449f / 16.0f)); dst = (f32x2*)(F.ws + WS_AXR) + j; }
        else { const int j = i - NLAT * 64 - 4096; pos = j >> 4; fi = j & 15; inv = __builtin_amdgcn_exp2f(-(float)fi * (13.287712379549449f / 16.0f)); dst = (f32x2*)(F.ws + WS_AXC) + j; }
        const float ang = (float)pos * inv;
        double rev = (double)ang * 0.15915494309189535; rev -= __builtin_floor(rev);
        const float rv = (float)rev;
        *dst = (f32x2){__builtin_amdgcn_cosf(rv), __builtin_amdgcn_sinf(rv)};
    }
}
__device__ __forceinline__ void p0b(Frame& F) {
    PHASE_IDS();
    const int gt = F.vcu * NTHR + tid, NGT = F.G * NTHR;
    const float* mp = (const float*)(F.ws + WS_MODP); float* mo = (float*)(F.ws + WS_MOD);
    for (int i = gt; i < 4 * 2 * NADA; i += NGT) { const int l = i / (2 * NADA), v = (i / NADA) & 1, n = i % NADA;
        float s = F.a->in[5][l * NADA + n];
#pragma unroll
        for (int ks = 0; ks < 8; ++ks) s += mp[(size_t)(ks * 2 + v) * 4 * NADA + l * NADA + n];
        mo[i] = s; }
}
__device__ __forceinline__ const float* modp(Frame& F, int l, int v, int idx) { return (const float*)(F.ws + WS_MOD) + ((size_t)(l * 2 + v) * 9 + idx) * DM; }

template <int MODE>
__device__ __forceinline__ void row_phase(Frame& F, const float* lng, const float* lnb, const float* sh_l, const float* sc_l, const float* sh_c, const float* sc_c) {
    PHASE_IDS();
    LAS float* V = (LAS float*)F.lds;
    for (int i = tid; i < DM; i += NTHR) { if (MODE != 0) { V[i] = lng[i]; V[DM + i] = lnb[i]; } if (MODE != 2) { V[2 * DM + i] = sh_l[i]; V[3 * DM + i] = sc_l[i]; V[4 * DM + i] = sh_c[i]; V[5 * DM + i] = sc_c[i]; } }
    __syncthreads();
    const int gw = F.vcu * NWAVES + wave, NGW = F.G * NWAVES;
    float* X = (float*)(F.ws + WS_X); bf16* H = (bf16*)(F.ws + WS_H);
    for (int t = gw; t < T; t += NGW) {
        if (MODE == 2 && t < NCTX) continue;
        const float* src = (MODE == 0) ? (t < NCTX ? F.a->in[2] + (size_t)t * DM : F.a->in[0] + (size_t)(t - NCTX) * DM) : X + (size_t)t * DM;
        f32x4 v[8]; float s = 0.f; float mean_ = 0.f, rstd_ = 1.f;
#pragma unroll
        for (int j = 0; j < 8; ++j) { v[j] = *((const f32x4*)src + lane + 64 * j); s += (v[j].x + v[j].y) + (v[j].z + v[j].w); }
        if (MODE != 0) {
            const float mean = wave_sum(s) * (1.f / DM); float s2 = 0.f;
#pragma unroll
            for (int j = 0; j < 8; ++j) { v[j] = v[j] - mean; s2 += (v[j].x * v[j].x + v[j].y * v[j].y) + (v[j].z * v[j].z + v[j].w * v[j].w); }
            const float rstd = 1.f / sqrtf(wave_sum(s2) * (1.f / DM) + LN_EPS); mean_ = mean; rstd_ = rstd;
#pragma unroll
            for (int j = 0; j < 8; ++j) { const f32x4 g = *((const LAS f32x4*)V + lane + 64 * j), b = *((const LAS f32x4*)(V + DM) + lane + 64 * j); v[j] = v[j] * rstd * g + b; }
        }
        if (MODE == 1 && lane == 0) *(f32x2*)((float*)(F.ws + WS_STAT) + (size_t)t * 2) = (f32x2){mean_, rstd_};
        if (MODE == 2) {
            float* o = F.a->out + (size_t)(t - NCTX) * DM;
#pragma unroll
            for (int j = 0; j < 8; ++j) *((f32x4*)o + lane + 64 * j) = v[j];
        } else {
            float* o = X + (size_t)t * DM; bf16* h = H + (size_t)t * DM;
            const LAS float* shv = V + (t < NCTX ? 4 * DM : 2 * DM); const LAS float* scv = V + (t < NCTX ? 5 * DM : 3 * DM);
#pragma unroll
            for (int j = 0; j < 8; ++j) {
                const f32x4 sh = *((const LAS f32x4*)shv + lane + 64 * j), sc = *((const LAS f32x4*)scv + lane + 64 * j);
                const f32x4 m = v[j] * (sc + 1.0f) + sh; u32x2 w; w.x = cvt_pk_bf16(m.x, m.y); w.y = cvt_pk_bf16(m.z, m.w);
                *((u32x2*)h + lane + 64 * j) = w; }
        }
    }
    __syncthreads();
}


__device__ __forceinline__ void ctx_resid_small(Frame& F, float* X, const bf16* A, const bf16* Bt, int K, const float* gv, float gs, const float* stat, const float* lng, const float* lnb, int has_ln, int parity) {
    if ((int)(blockIdx.x & 1) != parity) return;
    PHASE_IDS(); const int fr = lane & 15, fq = lane >> 4;
    const int nks = K >> 5, last = wave + 8 * ((nks - 1 - wave) >> 3), trips = (((nks + 7) >> 3) + 3) & ~3;
    for (int item = blockIdx.x; item < 256; item += F.G) {
        const int mt = item >> 5, nt = item & 31;
        f32x4 acc[2][4];
#pragma unroll
        for (int i = 0; i < 2; ++i)
#pragma unroll
            for (int j = 0; j < 4; ++j) acc[i][j] = (f32x4){0.f, 0.f, 0.f, 0.f};
        const bf16* Ap = A + (size_t)(32 * mt + fr) * K + 8 * fq;
        const bf16* Bp = Bt + (size_t)(64 * nt + fr) * K + 8 * fq;
        bf16x8 a0[2], b0[4], a1[2], b1[4], a2[2], b2[4], a3[2], b3[4];
#define CS_LOAD(a, b, i_) do { const int so_ = 32 * min(wave + 8 * (i_), last); _Pragma("unroll") for (int i = 0; i < 2; ++i) a[i] = *(const bf16x8*)(Ap + (size_t)(16 * i) * K + so_); \
        _Pragma("unroll") for (int i = 0; i < 4; ++i) b[i] = *(const bf16x8*)(Bp + (size_t)(16 * i) * K + so_); } while (0)
#define CS_MMA(a, b, i_) do { __builtin_amdgcn_sched_barrier(0); if (wave + 8 * (i_) < nks) { _Pragma("unroll") for (int i = 0; i < 2; ++i) _Pragma("unroll") for (int j = 0; j < 4; ++j) acc[i][j] = MFMA16(a[i], b[j], acc[i][j]); } __builtin_amdgcn_sched_barrier(0); } while (0)
        CS_LOAD(a0, b0, 0); CS_LOAD(a1, b1, 1); CS_LOAD(a2, b2, 2);
        for (int it = 0; it < trips; it += 4) {
            CS_LOAD(a3, b3, it + 3); CS_MMA(a0, b0, it);
            CS_LOAD(a0, b0, it + 4); CS_MMA(a1, b1, it + 1);
            CS_LOAD(a1, b1, it + 5); CS_MMA(a2, b2, it + 2);
            CS_LOAD(a2, b2, it + 6); CS_MMA(a3, b3, it + 3);
        }
#undef CS_LOAD
#undef CS_MMA
        LAS float* P = (LAS float*)F.lds + wave * 2048;
#pragma unroll
        for (int i = 0; i < 2; ++i)
#pragma unroll
            for (int j = 0; j < 4; ++j)
#pragma unroll
                for (int r = 0; r < 4; ++r) P[(16 * i + 4 * fq + r) * 64 + 16 * j + fr] = acc[i][j][r];
        __syncthreads();
        const int row = tid >> 4, c0 = (tid & 15) * 4;
        f32x4 s0 = {0.f, 0.f, 0.f, 0.f};
#pragma unroll
        for (int w = 0; w < 8; ++w) s0 += *(const LAS f32x4*)((LAS float*)F.lds + w * 2048 + row * 64 + c0);
        float* xp = X + (size_t)(32 * mt + row) * DM + 64 * nt + c0;
        const f32x4 g0 = *(const f32x4*)(gv + 64 * nt + c0) * gs;
        f32x4 x0 = *(const f32x4*)xp;
        if (has_ln) { const f32x2 st = *(const f32x2*)(stat + (size_t)(32 * mt + row) * 2); x0 = (x0 - st.x) * st.y * *(const f32x4*)(lng + 64 * nt + c0) + *(const f32x4*)(lnb + 64 * nt + c0); }
        *(f32x4*)xp = x0 * DN_ALPHA + g0 * s0;
        __syncthreads();
    }
}


__device__ __forceinline__ void init_x_by_owners(Frame& F) {
    PHASE_IDS();
    float* X = (float*)(F.ws + WS_X);
    pg8::StaticOrder S; S.init(NLAT, DM, F.G, (int)blockIdx.x); pg8::Unit u;
    for (int i = 0; S.next(i, u); ++i) {
        const int c4 = (tid & 63) * 4, r0 = tid >> 6;
#pragma unroll 4
        for (int rr = r0; rr < 256; rr += 8) { const size_t lr = (size_t)u.pm * 256 + rr; *(f32x4*)(X + (lr + NCTX) * DM + u.pn * 256 + c4) = *(const f32x4*)(F.a->in[0] + lr * DM + u.pn * 256 + c4); }
    }
    for (int item = blockIdx.x; item < 256; item += F.G) { const int mt = item >> 5, nt = item & 31, row = tid >> 4, c0 = (tid & 15) * 4;
        const size_t o = (size_t)(32 * mt + row) * DM + 64 * nt + c0; *(f32x4*)(X + o) = *(const f32x4*)(F.a->in[2] + o); }
}

constexpr int L1_QRAW = 0, L1_KRAW = 16384, L1_GD = 32768, L1_PART = 36864, L1_QT = 40960, L1_KT = 58368, L1_KTT = 75776, L1_VT = 94208, L1_P = 131072;
constexpr float INV_SQRT_DK = 0.08838834764831845f;

template <int DIR>
__device__ __forceinline__ void s1_dir(Frame& F, int e, int hh, int c, bool lat, f32x4 (&pacc)[2], const float (&wv)[16], const float bgv, const f32x2 (&csv)[16]) {
    const bool is_gla = hh < 4; const int hd = hh & 3, t0 = c * 64;
    PHASE_IDS(); const int w = wave, fr = lane & 15, fq = lane >> 4;
    LAS unsigned char* lds = F.lds;
    const int ch = tid & 127, tq = tid >> 7;
    float lgv[16];
    if (is_gla) {
#pragma unroll
        for (int i = 0; i < 16; ++i) { const int tt = 16 * tq + (DIR ? 15 - i : i);
            const u32x4 g0 = *(const LAS u32x4*)(lds + L1_GD + tt * 64 + DIR * 32), g1 = *(const LAS u32x4*)(lds + L1_GD + tt * 64 + DIR * 32 + 16);
            float x = bgv;
            x += bflo(g0.x) * wv[0] + bfhi(g0.x) * wv[1] + bflo(g0.y) * wv[2] + bfhi(g0.y) * wv[3] + bflo(g0.z) * wv[4] + bfhi(g0.z) * wv[5] + bflo(g0.w) * wv[6] + bfhi(g0.w) * wv[7];
            x += bflo(g1.x) * wv[8] + bfhi(g1.x) * wv[9] + bflo(g1.y) * wv[10] + bfhi(g1.y) * wv[11] + bflo(g1.z) * wv[12] + bfhi(g1.z) * wv[13] + bflo(g1.w) * wv[14] + bfhi(g1.w) * wv[15];
            lgv[i] = (fminf(x, 0.f) - __logf(1.0f + __expf(-fabsf(x)))) * (1.0f / 16.0f); }
    } else {
        const float lg = log1pf(-exp2f((DIR ? -5.5f : -5.0f) - (float)hd));
#pragma unroll
        for (int i = 0; i < 16; ++i) lgv[i] = lg;
    }
    float ls = 0.f;
#pragma unroll
    for (int i = 0; i < 16; ++i) ls += lgv[i];
    LAS float* part = (LAS float*)(lds + L1_PART);
    part[tq * 128 + ch] = ls;
    __syncthreads();
    float b = 0.f;
#pragma unroll
    for (int q = 0; q < 4; ++q) { const float pv = part[q * 128 + ch]; if (DIR ? (q > tq) : (q < tq)) b += pv; }
    bf16* QTg = (bf16*)(F.ws + WS_QT) + (size_t)DIR * T * 1024;
    float kt[16];
#pragma unroll
    for (int i = 0; i < 16; ++i) { const int tt = 16 * tq + (DIR ? 15 - i : i);
        b += lgv[i];
        float qv = bf2f(*(const LAS bf16*)(lds + L1_QRAW + tt * 256 + ch * 2)), kv = bf2f(*(const LAS bf16*)(lds + L1_KRAW + tt * 256 + ch * 2));
        if (!is_gla && lat) {
            const float qp = bf2f(*(const LAS bf16*)(lds + L1_QRAW + tt * 256 + (ch ^ 64) * 2)), kp = bf2f(*(const LAS bf16*)(lds + L1_KRAW + tt * 256 + (ch ^ 64) * 2));
            const f32x2 cs = csv[DIR ? 15 - i : i];
            if (ch < 64) { qv = qv * cs.x - qp * cs.y; kv = kv * cs.x - kp * cs.y; } else { qv = qv * cs.x + qp * cs.y; kv = kv * cs.x + kp * cs.y; }
        }
        const float eb = __expf(b), ebi = __expf(-b);
        const float qs = qv * eb * (is_gla ? INV_SQRT_DK : 1.0f), ks = kv * ebi * (is_gla ? 1.0f : INV_SQRT_DK);
        const bf16 qb = f2bf(qs);
        *(LAS bf16*)(lds + L1_QT + tt * 272 + ch * 2) = qb;
        *(LAS bf16*)(lds + L1_KT + tt * 272 + ch * 2) = f2bf(ks);
        kt[DIR ? 15 - i : i] = ks;
        if (i == 15 && tq == (DIR ? 0 : 3)) ((float*)(F.ws + WS_DEC))[((size_t)(DIR * 8 + hh) * NCH + c) * 128 + ch] = eb;
    }
    { u32x4 w0, w1; w0.x = cvt_pk_bf16(kt[0], kt[1]); w0.y = cvt_pk_bf16(kt[2], kt[3]); w0.z = cvt_pk_bf16(kt[4], kt[5]); w0.w = cvt_pk_bf16(kt[6], kt[7]);
      w1.x = cvt_pk_bf16(kt[8], kt[9]); w1.y = cvt_pk_bf16(kt[10], kt[11]); w1.z = cvt_pk_bf16(kt[12], kt[13]); w1.w = cvt_pk_bf16(kt[14], kt[15]);
      *(LAS u32x4*)(lds + L1_KTT + ch * 144 + tq * 32) = w0; *(LAS u32x4*)(lds + L1_KTT + ch * 144 + tq * 32 + 16) = w1; }
    __syncthreads();
#pragma unroll
    for (int i = 0; i < 2; ++i) { const int id = tid + 512 * i, r = id >> 4, cc = id & 15;
        *(u32x4*)(QTg + (size_t)(t0 + r) * 1024 + hh * 128 + cc * 8) = *(const LAS u32x4*)(lds + L1_QT + r * 272 + cc * 16); }
    { const int mi = w >> 1, nj0 = 2 * (w & 1);
      f32x4 pd[2] = {{0.f, 0.f, 0.f, 0.f}, {0.f, 0.f, 0.f, 0.f}};
#pragma unroll
      for (int ks = 0; ks < 4; ++ks) { const bf16x8 a = *(const LAS bf16x8*)(lds + L1_QT + (16 * mi + fr) * 272 + (32 * ks + 8 * fq) * 2);
#pragma unroll
          for (int j = 0; j < 2; ++j) { const bf16x8 bb = *(const LAS bf16x8*)(lds + L1_KT + (16 * (nj0 + j) + fr) * 272 + (32 * ks + 8 * fq) * 2); pd[j] = MFMA16(a, bb, pd[j]); } }
#pragma unroll
      for (int j = 0; j < 2; ++j)
#pragma unroll
          for (int r = 0; r < 4; ++r) { const int ii = 16 * mi + 4 * fq + r, jj = 16 * (nj0 + j) + fr; if (DIR ? (jj >= ii) : (jj <= ii)) pacc[j][r] += pd[j][r]; } }
    { bf16* Ug = (bf16*)(F.ws + WS_U) + ((size_t)(DIR * 8 + hh) * NCH + c) * 256 * 128;
      bf16x8 bv[2][2];
#pragma unroll
      for (int nj = 0; nj < 2; ++nj)
#pragma unroll
          for (int ks = 0; ks < 2; ++ks) bv[nj][ks] = *(const LAS bf16x8*)(lds + L1_VT + (32 * w + 16 * nj + fr) * 144 + (32 * ks + 8 * fq) * 2);
#pragma unroll
      for (int P = 0; P < 4; ++P) {
          f32x4 u[2][2] = {{{0.f, 0.f, 0.f, 0.f}, {0.f, 0.f, 0.f, 0.f}}, {{0.f, 0.f, 0.f, 0.f}, {0.f, 0.f, 0.f, 0.f}}};
#pragma unroll
          for (int t = 0; t < 2; ++t)
#pragma unroll
              for (int ks = 0; ks < 2; ++ks) { const bf16x8 a = *(const LAS bf16x8*)(lds + L1_KTT + (32 * P + 8 * (fr >> 2) + 4 * t + (fr & 3)) * 144 + (32 * ks + 8 * fq) * 2);
#pragma unroll
                  for (int nj = 0; nj < 2; ++nj) u[t][nj] = MFMA16(a, bv[nj][ks], u[t][nj]); }
          asm volatile("s_nop 15" : "+v"(u[0][0]), "+v"(u[0][1]), "+v"(u[1][0]), "+v"(u[1][1]));
#pragma unroll
          for (int nj = 0; nj < 2; ++nj) { u32x4 o; o.x = cvt_pk_bf16(u[0][nj][0], u[0][nj][1]); o.y = cvt_pk_bf16(u[0][nj][2], u[0][nj][3]); o.z = cvt_pk_bf16(u[1][nj][0], u[1][nj][1]); o.w = cvt_pk_bf16(u[1][nj][2], u[1][nj][3]);
              *(u32x4*)(Ug + (size_t)(32 * w + 16 * nj + fr) * 128 + 32 * P + 8 * fq) = o; } } }
    __syncthreads();
}

__device__ __forceinline__ void s1_phase(Frame& F, int e) {
    PHASE_IDS(); LAS unsigned char* lds = F.lds; const int w = wave, fr = lane & 15, fq = lane >> 4;
    const bf16* P = (const bf16*)(F.ws + WS_PROJ);
    for (int item = blockIdx.x; item < 8 * NCH; item += F.G) {
        const int c = item >> 3, hh = item & 7, hd = hh & 3, t0 = c * 64; const bool is_gla = hh < 4, lat = c >= 4;
        const int qcol = is_gla ? 128 * hd : 3072 + 128 * hd, kcol = qcol + 512, vcol = is_gla ? 1024 + 256 * hd : 4096 + 256 * hd;
#pragma unroll
        for (int i = 0; i < 2; ++i) { const int id = tid + 512 * i, r = id >> 4, cc = id & 15;
            *(LAS u32x4*)(lds + L1_QRAW + r * 256 + cc * 16) = *(const u32x4*)(P + (size_t)(t0 + r) * EV_N + qcol + cc * 8);
            *(LAS u32x4*)(lds + L1_KRAW + r * 256 + cc * 16) = *(const u32x4*)(P + (size_t)(t0 + r) * EV_N + kcol + cc * 8); }
#pragma unroll
        for (int i = 0; i < 4; ++i) { const int id = tid + 512 * i, r = id & 63, cc = id >> 6;
            const u32x4 v = *(const u32x4*)(P + (size_t)(t0 + r) * EV_N + vcol + cc * 8);
            LAS bf16* vt = (LAS bf16*)(lds + L1_VT) + (cc * 8) * 72 + r;
            vt[0 * 72] = (bf16)(v.x & 0xffff); vt[1 * 72] = (bf16)(v.x >> 16); vt[2 * 72] = (bf16)(v.y & 0xffff); vt[3 * 72] = (bf16)(v.y >> 16);
            vt[4 * 72] = (bf16)(v.z & 0xffff); vt[5 * 72] = (bf16)(v.z >> 16); vt[6 * 72] = (bf16)(v.w & 0xffff); vt[7 * 72] = (bf16)(v.w >> 16); }
        if (is_gla && tid < 256) { const int r = tid >> 2, cc = tid & 3; *(LAS u32x4*)(lds + L1_GD + r * 64 + cc * 16) = *(const u32x4*)(P + (size_t)(t0 + r) * EV_N + 6144 + cc * 8); }
        float wvf[16], wvb[16], bgf = 0.f, bgb = 0.f; f32x2 csv[16];
        { const int ch = tid & 127, tq = tid >> 7;
#pragma unroll
          for (int r = 0; r < 16; ++r) { wvf[r] = 0.f; wvb[r] = 0.f; csv[r] = (f32x2){1.f, 0.f}; }
          if (is_gla) {
              const float* wgf = F.a->in[11] + (size_t)e * 16 * 512 + hd * 128 + ch; const float* wgb = F.a->in[13] + (size_t)e * 16 * 512 + hd * 128 + ch;
#pragma unroll
              for (int r = 0; r < 16; ++r) { wvf[r] = wgf[r * 512]; wvb[r] = wgb[r * 512]; }
              bgf = F.a->in[12][e * 512 + hd * 128 + ch]; bgb = F.a->in[14][e * 512 + hd * 128 + ch];
          } else if (lat) {
              const f32x2* RT = (const f32x2*)(F.ws + WS_RT) + (size_t)(t0 + 16 * tq - NCTX) * 64 + (ch & 63);
#pragma unroll
              for (int r = 0; r < 16; ++r) csv[r] = RT[r * 64];
          } }
        __syncthreads();
        f32x4 pacc[2] = {{0.f, 0.f, 0.f, 0.f}, {0.f, 0.f, 0.f, 0.f}};
        s1_dir<0>(F, e, hh, c, lat, pacc, wvf, bgf, csv);
        s1_dir<1>(F, e, hh, c, lat, pacc, wvb, bgb, csv);
        { const int mi = w >> 1, nj0 = 2 * (w & 1);
#pragma unroll
          for (int j = 0; j < 2; ++j)
#pragma unroll
              for (int r = 0; r < 4; ++r) *(LAS bf16*)(lds + L1_P + (16 * mi + 4 * fq + r) * 144 + (16 * (nj0 + j) + fr) * 2) = f2bf(pacc[j][r]); }
        __syncthreads();
        { float* OI = (float*)(F.ws + WS_OI);
          bf16x8 bv[2][2];
#pragma unroll
          for (int nj = 0; nj < 2; ++nj)
#pragma unroll
              for (int ks = 0; ks < 2; ++ks) bv[nj][ks] = *(const LAS bf16x8*)(lds + L1_VT + (32 * w + 16 * nj + fr) * 144 + (32 * ks + 8 * fq) * 2);
#pragma unroll
          for (int mi = 0; mi < 4; ++mi) {
              f32x4 o[2] = {{0.f, 0.f, 0.f, 0.f}, {0.f, 0.f, 0.f, 0.f}};
#pragma unroll
              for (int ks = 0; ks < 2; ++ks) { const bf16x8 a = *(const LAS bf16x8*)(lds + L1_P + (16 * mi + fr) * 144 + (32 * ks + 8 * fq) * 2);
#pragma unroll
                  for (int nj = 0; nj < 2; ++nj) o[nj] = MFMA16(a, bv[nj][ks], o[nj]); }
#pragma unroll
              for (int nj = 0; nj < 2; ++nj)
#pragma unroll
                  for (int r = 0; r < 4; ++r) ((LAS float*)lds)[(16 * mi + 4 * fq + r) * 260 + 32 * w + 16 * nj + fr] = o[nj][r]; }
          __syncthreads();
#pragma unroll
          for (int i = 0; i < 8; ++i) { const int id = tid + 512 * i, r = id >> 6, cc = id & 63;
              *(f32x4*)(OI + (size_t)(t0 + r) * DM + hh * 256 + cc * 4) = *(const LAS f32x4*)((LAS float*)lds + r * 260 + cc * 4); } }
        __syncthreads();
    }
}

__device__ __forceinline__ void s2_phase(Frame& F) {
    PHASE_IDS();
    constexpr int SB = 5, NB = NCH / SB; static_assert(NB * SB == NCH, "NCH % SB");
    const int gt = F.vcu * NTHR + tid, NGT = F.G * NTHR;
    for (int idx = gt; idx < 2 * 8 * 256 * 32; idx += NGT) {
        const int dk4 = idx & 31, ee = (idx >> 5) & 255, dh = idx >> 13, dir = dh >> 3;
        const bf16* U = (const bf16*)(F.ws + WS_U) + (size_t)dh * NCH * 256 * 128 + (size_t)ee * 128 + dk4 * 4;
        bf16* S = (bf16*)(F.ws + WS_S) + (size_t)dh * NCH * 256 * 128 + (size_t)ee * 128 + dk4 * 4;
        const float* D = (const float*)(F.ws + WS_DEC) + (size_t)dh * NCH * 128 + dk4 * 4;
        f32x4 s = {0.f, 0.f, 0.f, 0.f};
        u32x2 un[SB]; f32x4 dn[SB];
#define S2_CH(step) (dir ? ((step) < 4 ? 3 - (step) : NCH + 3 - (step)) : (step))
#pragma unroll
        for (int i = 0; i < SB; ++i) { const int c = S2_CH(i); un[i] = *(const u32x2*)(U + (size_t)c * 256 * 128); dn[i] = *(const f32x4*)(D + (size_t)c * 128); }
#pragma nounroll
        for (int b = 0; b < NB; ++b) {
            u32x2 uc[SB]; f32x4 dc[SB];
#pragma unroll
            for (int i = 0; i < SB; ++i) { uc[i] = un[i]; dc[i] = dn[i]; }
            if (b + 1 < NB) {
#pragma unroll
                for (int i = 0; i < SB; ++i) { const int c = S2_CH((b + 1) * SB + i); un[i] = *(const u32x2*)(U + (size_t)c * 256 * 128); dn[i] = *(const f32x4*)(D + (size_t)c * 128); } }
#pragma unroll
            for (int i = 0; i < SB; ++i) { const int c = S2_CH(b * SB + i);
                u32x2 so; so.x = cvt_pk_bf16(s.x, s.y); so.y = cvt_pk_bf16(s.z, s.w);
                *(u32x2*)(S + (size_t)c * 256 * 128) = so;
                s.x = dc[i].x * (s.x + bflo(uc[i].x)); s.y = dc[i].y * (s.y + bfhi(uc[i].x)); s.z = dc[i].z * (s.z + bflo(uc[i].y)); s.w = dc[i].w * (s.w + bfhi(uc[i].y)); }
        }
#undef S2_CH
    }
}

constexpr int L3_QF = 0, L3_QB = 17408, L3_OL = 34816;
__device__ __forceinline__ void s3_phase(Frame& F, int e) {
    PHASE_IDS(); LAS unsigned char* lds = F.lds; const int w = wave, fr = lane & 15, fq = lane >> 4;
    const bf16* P = (const bf16*)(F.ws + WS_PROJ); const bf16* QTg = (const bf16*)(F.ws + WS_QT); const float* OI = (const float*)(F.ws + WS_OI);
    bf16* MIX = (bf16*)(F.ws + WS_MIX);
    for (int item = blockIdx.x; item < 8 * NCH; item += F.G) {
        const int c = item >> 3, hh = item & 7, hd = hh & 3, t0 = c * 64; const bool is_gla = hh < 4;
        const int gcol = is_gla ? 2048 + 256 * hd : 5120 + 256 * hd;
#pragma unroll
        for (int dir = 0; dir < 2; ++dir)
#pragma unroll
            for (int i = 0; i < 2; ++i) { const int id = tid + 512 * i, r = id >> 4, cc = id & 15;
                *(LAS u32x4*)(lds + (dir ? L3_QB : L3_QF) + r * 272 + cc * 16) = *(const u32x4*)(QTg + (size_t)dir * T * 1024 + (size_t)(t0 + r) * 1024 + hh * 128 + cc * 8); }
        bf16x8 bv[2][4][2];
#pragma unroll
        for (int dir = 0; dir < 2; ++dir) { const bf16* Sg = (const bf16*)(F.ws + WS_S) + ((size_t)(dir * 8 + hh) * NCH + c) * 256 * 128;
#pragma unroll
            for (int ks = 0; ks < 4; ++ks)
#pragma unroll
                for (int nj = 0; nj < 2; ++nj) bv[dir][ks][nj] = *(const bf16x8*)(Sg + (size_t)(32 * w + 16 * nj + fr) * 128 + 32 * ks + 8 * fq); }
        __builtin_amdgcn_sched_barrier(0);
        __syncthreads();
        f32x4 o[4][2];
#pragma unroll
        for (int mi = 0; mi < 4; ++mi)
#pragma unroll
            for (int nj = 0; nj < 2; ++nj) o[mi][nj] = (f32x4){0.f, 0.f, 0.f, 0.f};
#pragma unroll
        for (int dir = 0; dir < 2; ++dir) {
#pragma unroll
            for (int ks = 0; ks < 4; ++ks) {
#pragma unroll
                for (int mi = 0; mi < 4; ++mi) { const bf16x8 a = *(const LAS bf16x8*)(lds + (dir ? L3_QB : L3_QF) + (16 * mi + fr) * 272 + (32 * ks + 8 * fq) * 2);
#pragma unroll
                    for (int nj = 0; nj < 2; ++nj) o[mi][nj] = MFMA16(a, bv[dir][ks][nj], o[mi][nj]); } } }
        LAS float* OL = (LAS float*)(lds + L3_OL);
#pragma unroll
        for (int mi = 0; mi < 4; ++mi)
#pragma unroll
            for (int nj = 0; nj < 2; ++nj)
#pragma unroll
                for (int r = 0; r < 4; ++r) OL[(16 * mi + 4 * fq + r) * 260 + 32 * w + 16 * nj + fr] = o[mi][nj][r];
        __syncthreads();
        { const int tk = tid >> 3, seg = tid & 7;
          f32x4 v[4][2]; float sq = 0.f;
#pragma unroll
          for (int g = 0; g < 4; ++g) { const int ee = 64 * g + 8 * seg; const float* oi = OI + (size_t)(t0 + tk) * DM + hh * 256 + ee;
              v[g][0] = *(const LAS f32x4*)(OL + tk * 260 + ee) + *(const f32x4*)oi; v[g][1] = *(const LAS f32x4*)(OL + tk * 260 + ee + 4) + *(const f32x4*)(oi + 4);
              sq += (v[g][0].x * v[g][0].x + v[g][0].y * v[g][0].y) + (v[g][0].z * v[g][0].z + v[g][0].w * v[g][0].w) + (v[g][1].x * v[g][1].x + v[g][1].y * v[g][1].y) + (v[g][1].z * v[g][1].z + v[g][1].w * v[g][1].w); }
          sq += __shfl_xor(sq, 1); sq += __shfl_xor(sq, 2); sq += __shfl_xor(sq, 4);
          const float rstd = 1.0f / sqrtf(sq * (1.0f / 256.0f) + RMS_EPS);
#pragma unroll
          for (int g = 0; g < 4; ++g) { const int ee = 64 * g + 8 * seg;
              const u32x4 gt = *(const u32x4*)(P + (size_t)(t0 + tk) * EV_N + gcol + ee);
              f32x4 n0 = {1.f, 1.f, 1.f, 1.f}, n1 = {1.f, 1.f, 1.f, 1.f};
              if (is_gla) { n0 = *(const f32x4*)(F.a->in[15] + e * 256 + ee); n1 = *(const f32x4*)(F.a->in[15] + e * 256 + ee + 4); }
              const f32x4 a0 = v[g][0] * rstd * n0, a1 = v[g][1] * rstd * n1;
              u32x4 ow; ow.x = cvt_pk_bf16(a0.x * silu_f(bflo(gt.x)), a0.y * silu_f(bfhi(gt.x))); ow.y = cvt_pk_bf16(a0.z * silu_f(bflo(gt.y)), a0.w * silu_f(bfhi(gt.y)));
              ow.z = cvt_pk_bf16(a1.x * silu_f(bflo(gt.z)), a1.y * silu_f(bfhi(gt.z))); ow.w = cvt_pk_bf16(a1.z * silu_f(bflo(gt.w)), a1.w * silu_f(bfhi(gt.w)));
              *(u32x4*)(MIX + (size_t)(t0 + tk) * DM + hh * 256 + ee) = ow; } }
        __syncthreads();
    }
}

__device__ __forceinline__ void e1_phase(Frame& F, int o) {
    PHASE_IDS();
    const int gw = F.vcu * NWAVES + wave, NGW = F.G * NWAVES;
    const bf16* P = (const bf16*)(F.ws + WS_PROJ); bf16* CQN = (bf16*)(F.ws + WS_CQN); bf16* CKVN = (bf16*)(F.ws + WS_CKVN); bf16* KR = (bf16*)(F.ws + WS_KR);
    const float* wq = F.a->in[18] + o * 512 + lane * 8; const float* wkv = F.a->in[19] + o * 512 + lane * 8;
    const f32x4 wq0 = *(const f32x4*)wq, wq1 = *(const f32x4*)(wq + 4), wk0 = *(const f32x4*)wkv, wk1 = *(const f32x4*)(wkv + 4);
    const f32x2* AXR = (const f32x2*)(F.ws + WS_AXR); const f32x2* AXC = (const f32x2*)(F.ws + WS_AXC);
    for (int t = gw; t < T; t += NGW) {
        const bf16* p = P + (size_t)t * OD_N;
        const u32x4 a = *(const u32x4*)(p + lane * 8), b = *(const u32x4*)(p + 512 + lane * 8);
        float x[8] = {bflo(a.x), bfhi(a.x), bflo(a.y), bfhi(a.y), bflo(a.z), bfhi(a.z), bflo(a.w), bfhi(a.w)};
        float y[8] = {bflo(b.x), bfhi(b.x), bflo(b.y), bfhi(b.y), bflo(b.z), bfhi(b.z), bflo(b.w), bfhi(b.w)};
        float sx = 0.f, sy = 0.f;
#pragma unroll
        for (int j = 0; j < 8; ++j) { sx += x[j] * x[j]; sy += y[j] * y[j]; }
        const float rx = 1.0f / sqrtf(wave_sum(sx) * (1.0f / 512.0f) + RMS_EPS), ry = 1.0f / sqrtf(wave_sum(sy) * (1.0f / 512.0f) + RMS_EPS);
        u32x4 oq, ok;
        oq.x = cvt_pk_bf16(x[0] * rx * wq0.x, x[1] * rx * wq0.y); oq.y = cvt_pk_bf16(x[2] * rx * wq0.z, x[3] * rx * wq0.w); oq.z = cvt_pk_bf16(x[4] * rx * wq1.x, x[5] * rx * wq1.y); oq.w = cvt_pk_bf16(x[6] * rx * wq1.z, x[7] * rx * wq1.w);
        ok.x = cvt_pk_bf16(y[0] * ry * wk0.x, y[1] * ry * wk0.y); ok.y = cvt_pk_bf16(y[2] * ry * wk0.z, y[3] * ry * wk0.w); ok.z = cvt_pk_bf16(y[4] * ry * wk1.x, y[5] * ry * wk1.y); ok.w = cvt_pk_bf16(y[6] * ry * wk1.z, y[7] * ry * wk1.w);
        *(u32x4*)(CQN + (size_t)t * 512 + lane * 8) = oq; *(u32x4*)(CKVN + (size_t)t * 512 + lane * 8) = ok;
        float v = bf2f(p[1024 + lane]); const float pr = __shfl_xor(v, 16);
        if (t >= NCTX) { const int pp = t - NCTX, pos = (lane & 32) ? (pp & 63) : (pp >> 6); const f32x2 cs = ((lane & 32) ? AXC : AXR)[pos * 16 + (lane & 15)];
            v = (lane & 16) ? v * cs.x + pr * cs.y : v * cs.x - pr * cs.y; }
        KR[(size_t)t * 64 + lane] = f2bf(v);
    }
}

namespace att {
constexpr int KVBLK = 64;
constexpr float SCALE = 0.07216878364870322f;
constexpr float THR = 8.f;
constexpr int SHM_K = 64 * 384, SHM_V = 64 * 256;
constexpr int A_V = 0, A_K = 3 * SHM_V, A_WS = 3 * SHM_V + 3 * SHM_K;
#define SBAR() __builtin_amdgcn_sched_barrier(0)
__device__ __forceinline__ int crow(int r, int hi) { return (r & 3) + 8 * (r >> 2) + 4 * hi; }
constexpr float PLIM = 4096.f;
__device__ __forceinline__ void exp_sum(f32x16& p0, f32x16& p1, float& ps) {
#pragma unroll
    for (int r = 0; r < 16; ++r) p0[r] = __builtin_amdgcn_exp2f(p0[r]);
#pragma unroll
    for (int r = 0; r < 16; ++r) p1[r] = __builtin_amdgcn_exp2f(p1[r]);
    ps = p0[0];
#pragma unroll
    for (int r = 1; r < 16; ++r) ps += p0[r];
#pragma unroll
    for (int r = 0; r < 16; ++r) ps += p1[r];
}
__device__ __forceinline__ float row_max32(const f32x16& p0, const f32x16& p1) {
    float pmax = p0[0];
#pragma unroll
    for (int r = 1; r < 16; ++r) pmax = fmaxf(pmax, p0[r]);
#pragma unroll
    for (int r = 0; r < 16; ++r) pmax = fmaxf(pmax, p1[r]);
    auto rr = __builtin_amdgcn_permlane32_swap(__float_as_uint(pmax), __float_as_uint(pmax), false, false);
    return fmaxf(__uint_as_float(rr[0]), __uint_as_float(rr[1]));
}
__device__ __forceinline__ void pack_p(const f32x16& p0, const f32x16& p1, bf16x8& pa0, bf16x8& pa1, bf16x8& pa2, bf16x8& pa3) {
#define PK4(P, BASE, OUT) do { unsigned a0 = cvt_pk_bf16(P[BASE + 0], P[BASE + 1]), a1 = cvt_pk_bf16(P[BASE + 2], P[BASE + 3]);   \
    unsigned b0 = cvt_pk_bf16(P[BASE + 4], P[BASE + 5]), b1 = cvt_pk_bf16(P[BASE + 6], P[BASE + 7]);                              \
    auto r0 = __builtin_amdgcn_permlane32_swap(a0, b0, false, false); auto r1 = __builtin_amdgcn_permlane32_swap(a1, b1, false, false); \
    u32x4 w = {r0[0], r1[0], r0[1], r1[1]}; OUT = *reinterpret_cast<bf16x8*>(&w); } while (0)
    PK4(p0, 0, pa0); PK4(p0, 8, pa1); PK4(p1, 0, pa2); PK4(p1, 8, pa3);
#undef PK4
}
__device__ __forceinline__ int kswz(int row, int g) { return row * 384 + (((g & ~7) | ((g & 7) ^ ((row >> 1) & 7))) << 4); }
__device__ __forceinline__ void qkt(f32x16& p0, f32x16& p1, const LAS unsigned char* Ks, const bf16x8 (&qr)[12], const int (&kx)[4], const f32x16& init, bf16x8 c0, bf16x8 c1) {
    bf16x8 n0, n1;
#pragma unroll
    for (int d0 = 0; d0 < 12; ++d0) {
        if (d0 < 11) { n0 = *(const LAS bf16x8*)(Ks + kx[(d0 + 1) & 3] + ((d0 + 1) >> 2) * 128); n1 = *(const LAS bf16x8*)(Ks + kx[(d0 + 1) & 3] + ((d0 + 1) >> 2) * 128 + 32 * 384); }
        __builtin_amdgcn_sched_barrier(0);
        p0 = MFMA32(c0, qr[d0], d0 == 0 ? init : p0);
        p1 = MFMA32(c1, qr[d0], d0 == 0 ? init : p1);
        __builtin_amdgcn_sched_barrier(0);
        c0 = n0; c1 = n1; }
}
__device__ __forceinline__ int v_st(int k, int c) { const int kk = (k & ~0xC) | ((k & 4) << 1) | ((k & 8) >> 1); return ((kk >> 3) * 4 + (c >> 5)) * 512 + ((kk & 7) * 32 + (c & 31)) * 2; }
__device__ __forceinline__ int v_rd_base(int lane) { return ((lane & 3) << 3) | (((lane >> 2) & 3) << 6) | (((lane >> 4) & 1) << 5) | (((lane >> 5) & 1) << 8); }
constexpr int v_rd_off(int d0, int ks, int half) { return d0 * 512 + ks * 4096 + half * 2048; }
template <int OFF> __device__ __forceinline__ s16x4 tr_read(int vb) {
    s16x4 r; asm volatile("ds_read_b64_tr_b16 %0, %1 offset:%2" : "=&v"(r) : "v"(vb), "i"(OFF) : "memory"); return r;
}
struct VF { s16x4 l0, h0, l1, h1, l2, h2, l3, h3; };
template <int KS> __device__ __forceinline__ void v_load(VF& f, int vb) {
    f.l0 = tr_read<v_rd_off(0, KS, 0)>(vb); f.h0 = tr_read<v_rd_off(0, KS, 1)>(vb); f.l1 = tr_read<v_rd_off(1, KS, 0)>(vb); f.h1 = tr_read<v_rd_off(1, KS, 1)>(vb);
    f.l2 = tr_read<v_rd_off(2, KS, 0)>(vb); f.h2 = tr_read<v_rd_off(2, KS, 1)>(vb); f.l3 = tr_read<v_rd_off(3, KS, 0)>(vb); f.h3 = tr_read<v_rd_off(3, KS, 1)>(vb);
}
__device__ __forceinline__ void pv_mma(f32x16 (&o)[4], const VF& f, bf16x8 pa) {
#define PK(L, H) (bf16x8){L[0], L[1], L[2], L[3], H[0], H[1], H[2], H[3]}
    o[0] = MFMA32(pa, PK(f.l0, f.h0), o[0]);
    o[1] = MFMA32(pa, PK(f.l1, f.h1), o[1]);
    o[2] = MFMA32(pa, PK(f.l2, f.h2), o[2]);
    o[3] = MFMA32(pa, PK(f.l3, f.h3), o[3]);
#undef PK
}
__device__ __forceinline__ void pv_d0(f32x16 (&o)[4], int vb, VF& fa, bf16x8 pa0, bf16x8 pa1, bf16x8 pa2, bf16x8 pa3) {
    VF fb;
    v_load<1>(fb, vb);
    asm volatile("s_waitcnt lgkmcnt(8)" ::: "memory"); SBAR(); pv_mma(o, fa, pa0); SBAR();
    v_load<2>(fa, vb);
    asm volatile("s_waitcnt lgkmcnt(8)" ::: "memory"); SBAR(); pv_mma(o, fb, pa1); SBAR();
    v_load<3>(fb, vb);
    asm volatile("s_waitcnt lgkmcnt(8)" ::: "memory"); SBAR(); pv_mma(o, fa, pa2); SBAR();
    asm volatile("s_waitcnt lgkmcnt(0)" ::: "memory"); SBAR(); pv_mma(o, fb, pa3);
}
__device__ __forceinline__ void rope_pair(bf16x8& a, bf16x8& b, const f32x2* cs) {
    u32x4 ua = *reinterpret_cast<u32x4*>(&a), ub = *reinterpret_cast<u32x4*>(&b); u32x4 oa, ob;
#pragma unroll
    for (int j = 0; j < 4; ++j) { const f32x2 c0 = cs[2 * j], c1 = cs[2 * j + 1];
        const float x1l = bflo(ua[j]), x1h = bfhi(ua[j]), x2l = bflo(ub[j]), x2h = bfhi(ub[j]);
        oa[j] = cvt_pk_bf16(x1l * c0.x - x2l * c0.y, x1h * c1.x - x2h * c1.y);
        ob[j] = cvt_pk_bf16(x2l * c0.x + x1l * c0.y, x2h * c1.x + x1h * c1.y); }
    a = *reinterpret_cast<bf16x8*>(&oa); b = *reinterpret_cast<bf16x8*>(&ob);
}
__device__ __forceinline__ void unit(Frame& F, int h, int qrow0, int nkeys) {
    LAS unsigned char* lds = F.lds;
    PHASE_IDS(); const int wid = wave, r32 = lane & 31, hi = lane >> 5;
    const bf16* QB = (const bf16*)(F.ws + WS_QB); const bf16* KVB = (const bf16*)(F.ws + WS_KVB); const bf16* KR = (const bf16*)(F.ws + WS_KR);
    LAS unsigned char* V_lds = lds + A_V; LAS unsigned char* K_lds = lds + A_K;
    LAS float* wsl = (LAS float*)(lds + A_WS) + wid * 64; LAS float* li_l = wsl; LAS float* al_l = wsl + 32;
    float m_reg = -1e30f, l_reg = 0; f32x16 o[4] = {}; bf16x8 qr[12]; f32x16 negm;
    const int qt = qrow0 + wid * 32 + r32;
    const bf16* Qw = QB + (size_t)qt * 3072 + 192 * h + hi * 8;
#pragma unroll
    for (int d0 = 0; d0 < 12; ++d0) qr[d0] = *(const bf16x8*)(Qw + d0 * 16);
    if (qt >= NCTX) { const int pp = qt - NCTX;
        rope_pair(qr[8], qr[9], (const f32x2*)(F.ws + WS_AXR) + (pp >> 6) * 16 + hi * 8);
        rope_pair(qr[10], qr[11], (const f32x2*)(F.ws + WS_AXC) + (pp & 63) * 16 + hi * 8); }
    const unsigned char* wsb = F.ws;
    unsigned koff[3], kfl = 0u; int kdst[3];
#pragma unroll
    for (int i = 0; i < 3; ++i) { const int id = tid + 512 * i, row = id / 24, g = id % 24;
        if (g < 16) { koff[i] = (unsigned)WS_KVB + (unsigned)(row * 4096 + 256 * h + g * 8) * 2u; kfl |= 1u << i; } else { koff[i] = (unsigned)WS_KR + (unsigned)(row * 64 + (g - 16) * 8) * 2u; }
        kdst[i] = kswz(row, g); }
    const int sr = tid >> 4, sc = (tid & 15) * 8, vst0 = v_st(sr, sc);
    const unsigned voff = (unsigned)WS_KVB + (unsigned)(sr * 4096 + 256 * h + 128 + sc) * 2u;
    const int vb0 = (int)(unsigned)(uintptr_t)V_lds + v_rd_base(lane);
    int kx[4];
#pragma unroll
    for (int q = 0; q < 4; ++q) kx[q] = r32 * 384 + ((((2 * q) | hi) ^ ((r32 >> 1) & 7)) << 4);
    bf16x8 sk0, sk1, sk2, sv0, sv1;
#define SLOAD(jt) do { const unsigned vo_ = voff + (unsigned)(jt) * (64u * 4096u * 2u); sv0 = *(const bf16x8*)(wsb + vo_); sv1 = *(const bf16x8*)(wsb + vo_ + 32u * 4096u * 2u); \
    const unsigned kt_ = (unsigned)(jt) * 8192u; \
    sk0 = *(const bf16x8*)(wsb + koff[0] + (kt_ << ((kfl & 1u) * 6u))); sk1 = *(const bf16x8*)(wsb + koff[1] + (kt_ << (((kfl >> 1) & 1u) * 6u))); sk2 = *(const bf16x8*)(wsb + koff[2] + (kt_ << (((kfl >> 2) & 1u) * 6u))); } while (0)
#define SWRITE(b) do { *(LAS bf16x8*)(V_lds + (b) * SHM_V + vst0) = sv0; *(LAS bf16x8*)(V_lds + (b) * SHM_V + vst0 + 8192) = sv1; \
    *(LAS bf16x8*)(K_lds + (b) * SHM_K + kdst[0]) = sk0; *(LAS bf16x8*)(K_lds + (b) * SHM_K + kdst[1]) = sk1; *(LAS bf16x8*)(K_lds + (b) * SHM_K + kdst[2]) = sk2; } while (0)
#define SWAIT() asm volatile("s_waitcnt vmcnt(0)" ::: "memory")
#define NEGM_SET(v) do { const float v_ = (v); _Pragma("unroll") for (int r = 0; r < 16; ++r) negm[r] = v_; asm volatile("" : "+v"(negm)); } while (0)
    f32x16 p0, p1; bf16x8 pa0, pa1, pa2, pa3, kc0, kc1; const int NT = nkeys / KVBLK;
    NEGM_SET(0.f);
#define ABAR() do { asm volatile("s_waitcnt lgkmcnt(0)" ::: "memory"); __builtin_amdgcn_s_barrier(); asm volatile("" ::: "memory"); } while (0)
#define ASTAGE(j) do { if ((j) + 1 < NT) { SWAIT(); SWRITE(b1); } if ((j) + 2 < NT) SLOAD((j) + 2); } while (0)
#define KHEAD() do { kc0 = *(const LAS bf16x8*)(K_lds + b0 * SHM_K + kx[0]); kc1 = *(const LAS bf16x8*)(K_lds + b0 * SHM_K + kx[0] + 32 * 384); SBAR(); } while (0)
#define AQK(j) do { SBAR(); qkt(p0, p1, K_lds + b0 * SHM_K, qr, kx, negm, kc0, kc1); SBAR(); } while (0)
#define RARE(j) do { _Pragma("nounroll") for (int pass_ = 0; pass_ < 2; ++pass_) { NEGM_SET(pass_ ? -m_reg : 0.f); KHEAD(); AQK(j); \
      if (pass_ == 0) { const float mnew_ = fmaxf(m_reg, row_max32(p0, p1)); const float a_ = __builtin_amdgcn_exp2f(m_reg - mnew_); m_reg = mnew_; l_reg *= a_; \
        if (hi == 0) al_l[r32] = a_; asm volatile("s_waitcnt lgkmcnt(0)" ::: "memory"); \
        _Pragma("unroll") for (int d = 0; d < 4; ++d) { SBAR(); _Pragma("unroll") for (int r = 0; r < 16; ++r) o[d][r] *= al_l[crow(r, hi)]; } SBAR(); } } } while (0)
#define ASP(j) do { float ps; VF fa_; v_load<0>(fa_, vb0 + b0 * SHM_V); SBAR(); exp_sum(p0, p1, ps); \
    if (__builtin_expect((j) == 0 || __any(!(ps <= PLIM)), 0)) { RARE(j); exp_sum(p0, p1, ps); } \
    { auto rr = __builtin_amdgcn_permlane32_swap(__float_as_uint(ps), __float_as_uint(ps), false, false); l_reg += __uint_as_float(rr[0]) + __uint_as_float(rr[1]); } \
    pack_p(p0, p1, pa0, pa1, pa2, pa3); SBAR(); pv_d0(o, vb0 + b0 * SHM_V, fa_, pa0, pa1, pa2, pa3); } while (0)
    SLOAD(0); SWAIT(); SWRITE(0); SLOAD(1); ABAR();
    { const bool g1 = __builtin_amdgcn_readfirstlane(wid >> 2) != 0;
      if (g1) ABAR();
      int b0 = 0;
      for (int j = 0; j < NT; ++j) { const int b1 = b0 == 2 ? 0 : b0 + 1; KHEAD(); ASTAGE(j); AQK(j); ABAR(); ASP(j); ABAR(); b0 = b1; }
      if (!g1) ABAR(); }
#undef ABAR
#undef ASTAGE
#undef AQK
#undef KHEAD
#undef ASP
#undef RARE
#undef NEGM_SET
    if (hi == 0) li_l[r32] = l_reg; asm volatile("s_waitcnt lgkmcnt(0)" ::: "memory");
    float rli[16];
#pragma unroll
    for (int r = 0; r < 16; ++r) rli[r] = __builtin_amdgcn_rcpf(li_l[crow(r, hi)]);
    unsigned orow0 = (unsigned)(qrow0 + wid * 32) * DM + 128 * h; asm volatile("" : "+v"(orow0));
    bf16* Ow = (bf16*)(F.ws + WS_MIX) + orow0;
#pragma unroll
    for (int r = 0; r < 16; ++r) { const int orow = crow(r, hi);
#pragma unroll
        for (int d0 = 0; d0 < 4; ++d0) Ow[(size_t)orow * DM + d0 * 32 + r32] = f2bf(o[d0][r] * rli[r]); }
    __syncthreads();
#undef SLOAD
#undef SWRITE
#undef SWAIT
}
}

__device__ __forceinline__ void attn_phase(Frame& F) {
    for (int u = F.vcu; u < 1024 + 16; u += F.G) {
        if (u < 1024) att::unit(F, u >> 6, NCTX + 256 * (u & 63), T);
        else att::unit(F, u - 1024, 0, NCTX);
    }
}

#ifdef DBG
constexpr int DBG_W_BAD = 64, DBG_W_SSQ = 65, DBG_W_CNT = 66, DBG_W_MAX = 67;
__device__ __forceinline__ void dbg_scan(Frame& F, int id, size_t off, size_t nbytes, bool is_bf) {
    PHASE_IDS();
    const u32x4* p = (const u32x4*)(F.ws + off); const size_t n = nbytes / 16; bool bad = false;
    for (size_t i = (size_t)F.vcu * NTHR + tid; i < n; i += (size_t)F.G * NTHR) { const u32x4 v = p[i];
#pragma unroll
        for (int j = 0; j < 4; ++j) { if (is_bf) { bad |= ((v[j] & 0x7f80u) == 0x7f80u) | ((v[j] & 0x7f800000u) == 0x7f800000u); } else bad |= ((v[j] & 0x7f800000u) == 0x7f800000u); } }
    if (__any(bad) && lane == 0) atomicMax((unsigned*)(F.ws + WS_CTL) + DBG_W_BAD, (unsigned)(100000 - id));
}
__device__ __forceinline__ void dbg_max(Frame& F, size_t off, size_t nbytes, bool is_bf) {
    PHASE_IDS();
    const u32x4* p = (const u32x4*)(F.ws + off); const size_t n = nbytes / 16; unsigned mx = 0u;
    for (size_t i = (size_t)F.vcu * NTHR + tid; i < n; i += (size_t)F.G * NTHR) { const u32x4 v = p[i];
#pragma unroll
        for (int j = 0; j < 4; ++j) { if (is_bf) { const unsigned a0 = (v[j] << 16) & 0x7fffffffu, a1 = v[j] & 0x7fff0000u; if (a0 < 0x7f800000u) mx = max(mx, a0); if (a1 < 0x7f800000u) mx = max(mx, a1); } else { const unsigned a0 = v[j] & 0x7fffffffu; if (a0 < 0x7f800000u) mx = max(mx, a0); } } }
#pragma unroll
    for (int o = 1; o < 64; o <<= 1) mx = max(mx, (unsigned)__shfl_xor((int)mx, o));
    if (lane == 0) atomicMax((unsigned*)(F.ws + WS_CTL) + DBG_W_MAX, mx);
}
#define DBGSCAN(id, off, nbytes, isbf) dbg_scan(F, (id), (off), (nbytes), (isbf))
#else
#define DBGSCAN(id, off, nbytes, isbf) do {} while (0)
#endif

#ifndef RES_ALIGN
#define RES_ALIGN true
#endif
#ifndef RES_SP2
#define RES_SP2 true
#endif
__global__ void __launch_bounds__(NTHR, 2) fwd_kernel(Args args) {
    extern __shared__ __attribute__((aligned(16))) unsigned char lds_raw[];
    Frame F;
    F.lds = (LAS unsigned char*)lds_raw;
    F.G = gridDim.x; { const int bx = blockIdx.x; F.vcu = (F.G % 8 == 0) ? (bx % 8) * (F.G / 8) + bx / 8 : bx; }
    F.a = &args; F.ws = args.ws;
    volatile LAS unsigned* ctlw = (volatile LAS unsigned*)(F.lds + LDS_CTL);
    if (threadIdx.x < 16) ctlw[threadIdx.x] = 0u;
    __syncthreads();
    XcdBarrier bar = xcd_barrier_post((unsigned*)(F.ws + WS_CTL) + 4096, ctlw);
#define GRID_BAR() xcd_barrier(bar)
#ifdef DBG_TIME
    unsigned long long t_prev = __builtin_amdgcn_s_memrealtime();
#define TSTAMP(cat) do { if (blockIdx.x == 0 && threadIdx.x == 0) { const unsigned long long t_now = __builtin_amdgcn_s_memrealtime(); unsigned long long* tw = (unsigned long long*)(F.ws + WS_CTL) + 64 + (cat); *tw = *tw + (t_now - t_prev); t_prev = t_now; } } while (0)
#else
#define TSTAMP(cat) do {} while (0)
#endif

#ifndef SK_P0
    p0a(F);
#ifdef DUP_P0
    p0a(F);
#endif
#endif
    GRID_BAR();
    p0b(F); GRID_BAR();
    DBGSCAN(1, WS_MOD, (size_t)4 * 2 * NADA * 4, false);
    init_x_by_owners(F);
    row_phase<0>(F, nullptr, nullptr, modp(F, 0, 0, 0), modp(F, 0, 0, 1), modp(F, 0, 1, 0), modp(F, 0, 1, 1)); GRID_BAR(); TSTAMP(0);
    DBGSCAN(2, WS_X, (size_t)T * DM * 4, false); DBGSCAN(3, WS_H, (size_t)T * DM * 2, true);

    const pg8::bf16_t* Hb = (const pg8::bf16_t*)(F.ws + WS_H);
    for (int s = 0; s < 3 * DEPTH; ++s) {
        const int l = s / 3, r = s % 3;
        const pg8::bf16_t* A2; const pg8::bf16_t* B2; int K2;
        if (r != 1) {
            const int f = r >> 1;
            pg8::Gemm g{Hb, (const pg8::bf16_t*)(F.ws + WS_WFI + (size_t)(l * 2 + f) * SZ_WFI), T, 2 * DFF, DM, DM, DM};
            pg8::StaticOrder S; S.init(T, 2 * DFF, F.G, (int)blockIdx.x);
            pg8::EpiSwiGLU E{(pg8::bf16_t*)(F.ws + WS_HID), DFF};
#ifndef SK_SW
            pg8::gemm_phase<pg8::EpiSwiGLU, pg8::StaticOrder>(F.lds, g, S, E);
#endif
#ifdef DUP_SW
            pg8::gemm_phase<pg8::EpiSwiGLU, pg8::StaticOrder>(F.lds, g, S, E);
#endif
            GRID_BAR(); TSTAMP(1);
            DBGSCAN(10 + 10 * s, WS_HID, (size_t)T * DFF * 2, true);
            A2 = (const pg8::bf16_t*)(F.ws + WS_HID); B2 = (const pg8::bf16_t*)(F.ws + WS_WFO + (size_t)(l * 2 + f) * SZ_WFO); K2 = DFF;
        } else if ((l & 1) == 0) {
            const int e = l >> 1;
            { pg8::Gemm g{Hb, (const pg8::bf16_t*)(F.ws + WS_EWI + (size_t)e * SZ_EWI), T, EV_N, DM, DM, DM};
              pg8::StaticOrder S; S.init(T, EV_N, F.G, (int)blockIdx.x);
              pg8::EpiBf16 E{(pg8::bf16_t*)(F.ws + WS_PROJ), EV_N};
#ifndef SK_G1
              pg8::gemm_phase<pg8::EpiBf16, pg8::StaticOrder>(F.lds, g, S, E);
#endif
            }
            GRID_BAR(); TSTAMP(4);
            DBGSCAN(10 + 10 * s, WS_PROJ, (size_t)T * EV_N * 2 - 0, true);
#ifdef DBG
            if (s == 1) dbg_max(F, WS_PROJ, (size_t)T * EV_N * 2, true);
#endif
#ifndef SK_S1
            s1_phase(F, e);
#ifdef DUP_S1
            s1_phase(F, e);
#endif
#endif
            GRID_BAR(); TSTAMP(5);
            DBGSCAN(11 + 10 * s, WS_U, SZ_U, true); DBGSCAN(16 + 10 * s, WS_OI, (size_t)T * DM * 4, false); DBGSCAN(17 + 10 * s, WS_QT, (size_t)2 * T * 1024 * 2, true); DBGSCAN(18 + 10 * s, WS_DEC, (size_t)2 * 8 * NCH * 128 * 4, false);
#ifndef SK_S2
            s2_phase(F);
#ifdef DUP_S2
            s2_phase(F);
#endif
#endif
            GRID_BAR(); TSTAMP(6);
            DBGSCAN(12 + 10 * s, WS_S, SZ_U, true);
#ifndef SK_S3
            s3_phase(F, e);
#ifdef DUP_S3
            s3_phase(F, e);
#endif
#endif
            GRID_BAR(); TSTAMP(7);
            DBGSCAN(13 + 10 * s, WS_MIX, (size_t)T * DM * 2, true);
            A2 = (const pg8::bf16_t*)(F.ws + WS_MIX); B2 = (const pg8::bf16_t*)(F.ws + WS_EWO + (size_t)e * SZ_SQ); K2 = DM;
        } else {
            const int o = l >> 1;
            { pg8::Gemm g{Hb, (const pg8::bf16_t*)(F.ws + WS_OWI + (size_t)o * SZ_OWI), T, OD_N, DM, DM, DM};
              pg8::StaticOrder S; S.init(T, OD_N, F.G, (int)blockIdx.x);
              pg8::EpiBf16 E{(pg8::bf16_t*)(F.ws + WS_PROJ), OD_N};
#ifndef SK_G2
              pg8::gemm_phase<pg8::EpiBf16, pg8::StaticOrder>(F.lds, g, S, E);
#endif
            }
            GRID_BAR();
#ifndef SK_E1
            e1_phase(F, o);
#endif
            GRID_BAR();
            DBGSCAN(11 + 10 * s, WS_CQN, (size_t)T * 512 * 2 * 2, true); DBGSCAN(11 + 10 * s, WS_KR, (size_t)T * 64 * 2, true);
            for (int q = 0; q < 2; ++q) {
                pg8::Gemm g{(const pg8::bf16_t*)(F.ws + (q ? WS_CKVN : WS_CQN)), (const pg8::bf16_t*)(F.ws + (q ? WS_OUKV + (size_t)o * SZ_OUKV : WS_OUQ + (size_t)o * SZ_OUQ)), T, q ? 4096 : 3072, 512, 512, 512};
                pg8::StaticOrder S; S.init(T, g.N, F.G, (int)blockIdx.x);
                pg8::EpiBf16 E{(pg8::bf16_t*)(F.ws + (q ? WS_KVB : WS_QB)), g.N};
#ifndef SK_G3
                pg8::gemm_phase<pg8::EpiBf16, pg8::StaticOrder>(F.lds, g, S, E);
#endif
            }
            GRID_BAR(); TSTAMP(8);
            DBGSCAN(12 + 10 * s, WS_QB, (size_t)T * 3072 * 2, true); DBGSCAN(12 + 10 * s, WS_KVB, (size_t)T * 4096 * 2, true);
#ifndef SK_ATT
            attn_phase(F);
#ifdef DUP_ATT
            attn_phase(F);
#endif
#endif
            GRID_BAR(); TSTAMP(9);
            DBGSCAN(13 + 10 * s, WS_MIX, (size_t)T * DM * 2, true);
            A2 = (const pg8::bf16_t*)(F.ws + WS_MIX); B2 = (const pg8::bf16_t*)(F.ws + WS_OWO + (size_t)o * SZ_SQ); K2 = DM;
        }
        {
            pg8::Gemm g{A2 + (size_t)NCTX * K2, B2, NLAT, DM, K2, K2, K2};
            pg8::StaticOrder S; S.init(NLAT, DM, F.G, (int)blockIdx.x);
            const int sp = s > 0 ? s - 1 : 0;
            const float* plng = F.a->in[6] + (size_t)sp * DM; const float* plnb = F.a->in[7] + (size_t)sp * DM; const float* stat = (const float*)(F.ws + WS_STAT);
            pg8::EpiResid E{(float*)(F.ws + WS_X) + (size_t)NCTX * DM, modp(F, l, 0, 3 * r + 2), (r != 1) ? 0.5f : 1.0f, stat + (size_t)NCTX * 2, plng, plnb, s > 0 ? 1 : 0};
            ctx_resid_small(F, (float*)(F.ws + WS_X), (const bf16*)A2, (const bf16*)B2, K2, modp(F, l, 1, 3 * r + 2), (r != 1) ? 0.5f : 1.0f, stat, plng, plnb, s > 0 ? 1 : 0, 1);
#ifndef SK_RES
            pg8::gemm_phase<pg8::EpiResid, pg8::StaticOrder, RES_ALIGN, RES_SP2>(F.lds, g, S, E);
#endif
            ctx_resid_small(F, (float*)(F.ws + WS_X), (const bf16*)A2, (const bf16*)B2, K2, modp(F, l, 1, 3 * r + 2), (r != 1) ? 0.5f : 1.0f, stat, plng, plnb, s > 0 ? 1 : 0, 0);
#ifdef DUP_SMALL_OFF
            ctx_resid_small(F, (float*)(F.ws + WS_OI), (const bf16*)A2, (const bf16*)B2, K2, modp(F, l, 1, 3 * r + 2), (r != 1) ? 0.5f : 1.0f);
            ctx_resid_small(F, (float*)(F.ws + WS_OI), (const bf16*)A2, (const bf16*)B2, K2, modp(F, l, 1, 3 * r + 2), (r != 1) ? 0.5f : 1.0f);
#endif
#ifdef DUP_RES
            { pg8::EpiResid E2{(float*)(F.ws + WS_OI) + (size_t)NCTX * DM, modp(F, l, 0, 3 * r + 2), 0.5f, stat, plng, plnb, 0};
              pg8::gemm_phase<pg8::EpiResid, pg8::StaticOrder>(F.lds, g, S, E2); }
#endif
        }
        GRID_BAR(); TSTAMP(r != 1 ? 2 : 10);
        DBGSCAN(14 + 10 * s, WS_X, (size_t)T * DM * 4, false);
        const float* lng = F.a->in[6] + (size_t)(l * 3 + r) * DM; const float* lnb = F.a->in[7] + (size_t)(l * 3 + r) * DM;
        if (s + 1 < 3 * DEPTH) { const int l2 = (s + 1) / 3, r2 = (s + 1) % 3;
            row_phase<1>(F, lng, lnb, modp(F, l2, 0, 3 * r2), modp(F, l2, 0, 3 * r2 + 1), modp(F, l2, 1, 3 * r2), modp(F, l2, 1, 3 * r2 + 1));
            GRID_BAR(); TSTAMP(3);
            DBGSCAN(15 + 10 * s, WS_X, (size_t)T * DM * 4, false); DBGSCAN(15 + 10 * s, WS_H, (size_t)T * DM * 2, true);
#if defined(DBG) && defined(DBG_STOP)
            if (s == DBG_STOP) break;
#endif
        } else {
#ifndef DBG
            row_phase<2>(F, lng, lnb, nullptr, nullptr, nullptr, nullptr);
#endif
        }
    }
#ifdef DBG_TIME
    {   PHASE_IDS(); GRID_BAR();
        const unsigned long long* tw = (const unsigned long long*)(F.ws + WS_CTL) + 64;
        const float tA = (float)__hip_atomic_load(tw + DBG_TA, RLX_AGENT) * 1e-5f, tB = (float)__hip_atomic_load(tw + DBG_TB, RLX_AGENT) * 1e-5f;
        const float cB = DBG_TSCALE * tB, cA = cB; (void)tA;
        float* out = F.a->out;
        for (size_t i = (size_t)F.vcu * NTHR + tid; i < (size_t)NLAT * DM; i += (size_t)F.G * NTHR) out[i] = (i == 12345) ? cA : cB;
    }
#endif
#ifdef DBG
    {
        PHASE_IDS();
        const float* X = (const float*)(F.ws + WS_X); float ssq = 0.f; float cnt = 0.f;
        for (size_t i = (size_t)F.vcu * NTHR + tid; i < (size_t)T * DM; i += (size_t)F.G * NTHR) { const float v = X[i]; if ((__float_as_uint(v) & 0x7f800000u) != 0x7f800000u) { ssq += v * v; cnt += 1.f; } }
        ssq = wave_sum(ssq); cnt = wave_sum(cnt);
        if (lane == 0) { atomicAdd((float*)(F.ws + WS_CTL) + DBG_W_SSQ, ssq); atomicAdd((float*)(F.ws + WS_CTL) + DBG_W_CNT, cnt); }
        GRID_BAR();
        const unsigned badw = __hip_atomic_load((unsigned*)(F.ws + WS_CTL) + DBG_W_BAD, RLX_AGENT);
        const float tss = __hip_atomic_load((float*)(F.ws + WS_CTL) + DBG_W_SSQ, RLX_AGENT), tcn = __hip_atomic_load((float*)(F.ws + WS_CTL) + DBG_W_CNT, RLX_AGENT);
        const float rms = sqrtf(tss / fmaxf(tcn, 1.f)); float cB = fminf(10.f * rms, 1000.f);
#ifdef DBG_REPORT_MAX
        { const unsigned mw = __hip_atomic_load((unsigned*)(F.ws + WS_CTL) + DBG_W_MAX, RLX_AGENT); cB = fminf(log2f(1.0f + __uint_as_float(mw)), 120.f); }
#endif
        const float cA = badw ? (float)(100000u - badw) * 10.f : 5.f;
        float* out = F.a->out;
        for (size_t i = (size_t)F.vcu * NTHR + tid; i < (size_t)NLAT * DM; i += (size_t)F.G * NTHR) out[i] = (i == 12345) ? cA + 0.f : cB;
        (void)cA;
    }
#endif
}

extern "C" void kernel_launch(void* const* d_in, const int* in_sizes, int n_in, void* d_out, int out_size, void* d_ws, size_t ws_size, hipStream_t stream) {
    static int grid = 0;
    if (grid == 0) {
        if (n_in != 23 || out_size != NLAT * DM || ws_size < WS_END) { fprintf(stderr, "kernel_launch: unexpected shapes: n_in %d out %d ws %zu (need %zu)\n", n_in, out_size, ws_size, (size_t)WS_END); grid = -1; return; }
        int dev = 0, cus = 0, per_cu = 0;
        if (hipGetDevice(&dev) != hipSuccess || hipDeviceGetAttribute(&cus, hipDeviceAttributeMultiprocessorCount, dev) != hipSuccess) { grid = -1; return; }
        if (hipFuncSetAttribute((const void*)fwd_kernel, hipFuncAttributeMaxDynamicSharedMemorySize, LDS_BYTES) != hipSuccess) { fprintf(stderr, "kernel_launch: hipFuncSetAttribute failed\n"); grid = -1; return; }
        if (hipOccupancyMaxActiveBlocksPerMultiprocessor(&per_cu, (const void*)fwd_kernel, NTHR, LDS_BYTES) != hipSuccess || per_cu < 1) fprintf(stderr, "kernel_launch: occupancy query reports %d\n", per_cu);
        (void)hipGetLastError();
        grid = cus;
    }
    if (grid < 0) return;
    (void)hipMemsetAsync((char*)d_ws + WS_CTL, 0, CTL_BYTES, stream);
    Args a{};
    for (int i = 0; i < 23; ++i) a.in[i] = (const float*)d_in[i];
    a.out = (float*)d_out; a.ws = (unsigned char*)d_ws;
    hipLaunchKernelGGL(fwd_kernel, dim3(grid), dim3(NTHR), LDS_BYTES, stream, a);
    const hipError_t le = hipPeekAtLastError();
    if (le != hipSuccess) fprintf(stderr, "kernel_launch: launch failed: %s\n", hipGetErrorName(le));
}
```
